# Optimizing an MI355X kernel written in HIP

```python
import jax, jax.numpy as jnp
from jax import lax
import numpy as np

D_MODEL = 2048
BATCH = 4
SEQ = 8192
DEPTH = 2
DEC_BATCH = 8
DEC_SEQ = 32
PAST_LEN = 1024

CHUNK = 64
N_A = DEPTH // 2
N_B = DEPTH - N_A
RET_HEADS = 8
RET_DK = D_MODEL // RET_HEADS
RET_DV = 2 * D_MODEL // RET_HEADS
RET_QK = RET_HEADS * RET_DK
RET_V = RET_HEADS * RET_DV
ROPE_BASE = 10000.0
FOX_HEADS = 16
FOX_HD = D_MODEL // FOX_HEADS
FOX_KV_HEADS = 4
FOX_GROUP = FOX_HEADS // FOX_KV_HEADS
Q_BLOCK = 128
D_FF = -(-8 * D_MODEL // (3 * 256)) * 256
NORM_EPS = 1e-6
GN_EPS = 1e-5

kernel_name = 'yoco_retention_fox_stream_step'

F32 = jnp.float32


def _rmsnorm(x, g):
    x32 = x.astype(F32)
    y = x32 * lax.rsqrt(jnp.mean(x32 * x32, axis=-1, keepdims=True) + NORM_EPS)
    return (y * g.astype(F32)).astype(x.dtype)


def _swiglu(xn, wg, wu, wd):
    return (jax.nn.silu(xn @ wg) * (xn @ wu)) @ wd


def _rope(x, pos):
    half = x.shape[-1] // 2
    inv = ROPE_BASE ** (-jnp.arange(half, dtype=F32) / half)
    ang = pos.astype(F32)[:, None] * inv[None, :]
    cos = jnp.cos(ang)[None, :, None, :]
    sin = jnp.sin(ang)[None, :, None, :]
    x1, x2 = x[..., :half], x[..., half:]
    return jnp.concatenate([x1 * cos - x2 * sin, x1 * sin + x2 * cos], axis=-1)


def _log_gamma():
    return jnp.log(1.0 - jnp.exp2(-5.0 - jnp.arange(RET_HEADS, dtype=F32)))


def _ret_chunk(S, q, k, v, lg):
    c = q.shape[1]
    idx = jnp.arange(c, dtype=F32)
    diff = idx[:, None] - idx[None, :]
    dmask = jnp.where(diff >= 0, jnp.exp(lg[:, None, None] * jnp.maximum(diff, 0.0)), 0.0)
    scores = jnp.einsum('blhd,bmhd->bhlm', q, k) * dmask[None]
    inner = jnp.einsum('bhlm,bmhe->blhe', scores, v)
    cross = jnp.einsum('blhd,bhde->blhe', q, S) * jnp.exp(lg[None, :] * (idx[:, None] + 1.0))[None, :, :, None]
    kw = jnp.exp(lg[None, :] * (c - 1.0 - idx)[:, None])
    S_new = jnp.exp(lg * c)[None, :, None, None] * S + jnp.einsum('blhd,blhe->bhde', k * kw[None, :, :, None], v)
    return S_new, inner + cross


def _retention(xn, S0, pos, w_in, w_o):
    B, L, _ = xn.shape
    proj = xn @ w_in
    q, k, v, g = jnp.split(proj, [RET_QK, 2 * RET_QK, 2 * RET_QK + RET_V], axis=-1)
    q = _rope(q.reshape(B, L, RET_HEADS, RET_DK).astype(F32), pos)
    k = _rope(k.reshape(B, L, RET_HEADS, RET_DK).astype(F32), pos) * (RET_DK ** -0.5)
    v = v.reshape(B, L, RET_HEADS, RET_DV).astype(F32)
    c = min(CHUNK, L)
    n = L // c
    def to_chunks(t):
        return t.reshape(B, n, c, *t.shape[2:]).swapaxes(0, 1)
    lg = _log_gamma()
    S_fin, o = lax.scan(lambda S, xs: _ret_chunk(S, xs[0], xs[1], xs[2], lg), S0.astype(F32),
                        (to_chunks(q), to_chunks(k), to_chunks(v)))
    o = o.swapaxes(0, 1).reshape(B, L, RET_HEADS, RET_DV)
    mu = jnp.mean(o, axis=-1, keepdims=True)
    var = jnp.mean(jnp.square(o - mu), axis=-1, keepdims=True)
    o = (o - mu) * lax.rsqrt(var + GN_EPS)
    o = o.reshape(B, L, RET_V) * jax.nn.silu(g.astype(F32))
    return o.astype(xn.dtype) @ w_o, S_fin


def _shared_kv(h, norm_kv, w_k, w_v, w_f, b_f):
    B, L, _ = h.shape
    hn = _rmsnorm(h, norm_kv)
    k = (hn @ w_k).reshape(B, L, FOX_KV_HEADS, FOX_HD)
    v = (hn @ w_v).reshape(B, L, FOX_KV_HEADS, FOX_HD)
    logf = jax.nn.log_sigmoid((hn @ w_f).astype(F32) + b_f.astype(F32))
    return k, v, logf


def _fox_block(q, fq, qpos, k, v, fk, kpos):
    s = jnp.einsum('bqkgd,bskd->bkgqs', q, k).astype(F32) * (FOX_HD ** -0.5)
    s = s + jnp.transpose(fq, (0, 2, 3, 1))[..., None] - jnp.transpose(fk, (0, 2, 3, 1))[..., None, :]
    mask = kpos[None, :] <= qpos[:, None]
    p = jax.nn.softmax(jnp.where(mask, s, -jnp.inf), axis=-1)
    return jnp.einsum('bkgqs,bskd->bqkgd', p.astype(v.dtype), v)


def _fox(xn, k, v, F, q_start, w_q, w_o):
    B, Lq, _ = xn.shape
    Lk = k.shape[1]
    q = (xn @ w_q).reshape(B, Lq, FOX_KV_HEADS, FOX_GROUP, FOX_HD)
    Fk = F.reshape(B, Lk, FOX_KV_HEADS, FOX_GROUP)
    Fq = Fk[:, q_start:]
    kpos = jnp.arange(Lk)
    qpos = q_start + jnp.arange(Lq)
    qblk = min(Q_BLOCK, Lq)
    nb = Lq // qblk
    def blocks(t):
        return t.reshape(B, nb, qblk, *t.shape[2:]).swapaxes(0, 1)
    o = lax.map(lambda a: _fox_block(a[0], a[1], a[2], k, v, Fk, kpos),
                (blocks(q), blocks(Fq), qpos.reshape(nb, qblk)))
    o = o.swapaxes(0, 1).reshape(B, Lq, FOX_HEADS * FOX_HD)
    return o @ w_o


def setup_inputs(seed: int = 0) -> dict:
    key = jax.random.key(seed)
    ks = jax.random.split(key, 24)
    def w(k, shape, fan_in):
        return jax.random.normal(k, shape, F32) * (fan_in ** -0.5)
    def gain(k, shape):
        return 1.0 + 0.02 * jax.random.normal(k, shape, F32)
    return {
        'x_prompt': jax.random.normal(ks[0], (BATCH, SEQ, D_MODEL), F32),
        'x_sample': jax.random.normal(ks[1], (DEC_BATCH, DEC_SEQ, D_MODEL), F32),
        'state_ret': 0.5 * jax.random.normal(ks[2], (N_A, DEC_BATCH, RET_HEADS, RET_DK, RET_DV), F32),
        'cache_k': jax.random.normal(ks[3], (DEC_BATCH, PAST_LEN, FOX_KV_HEADS, FOX_HD), F32),
        'cache_v': jax.random.normal(ks[4], (DEC_BATCH, PAST_LEN, FOX_KV_HEADS, FOX_HD), F32),
        'cache_logf': jax.nn.log_sigmoid(4.0 + jax.random.normal(ks[5], (DEC_BATCH, PAST_LEN, FOX_HEADS), F32)),
        'norm_mix': gain(ks[6], (DEPTH, D_MODEL)),
        'norm_ffn': gain(ks[7], (DEPTH, D_MODEL)),
        'norm_kv': gain(ks[8], (D_MODEL,)),
        'norm_final': gain(ks[9], (D_MODEL,)),
        'w_ret_in': w(ks[10], (N_A, D_MODEL, 2 * RET_QK + 2 * RET_V), D_MODEL),
        'w_ret_o': w(ks[11], (N_A, RET_V, D_MODEL), RET_V),
        'w_kv_k': w(ks[12], (D_MODEL, FOX_KV_HEADS * FOX_HD), D_MODEL),
        'w_kv_v': w(ks[13], (D_MODEL, FOX_KV_HEADS * FOX_HD), D_MODEL),
        'w_kv_f': w(ks[14], (D_MODEL, FOX_HEADS), D_MODEL),
        'b_kv_f': jnp.linspace(1.0, 6.0, FOX_HEADS, dtype=F32) + 0.1 * jax.random.normal(ks[15], (FOX_HEADS,), F32),
        'w_fox_q': w(ks[16], (N_B, D_MODEL, FOX_HEADS * FOX_HD), D_MODEL),
        'w_fox_o': w(ks[17], (N_B, FOX_HEADS * FOX_HD, D_MODEL), FOX_HEADS * FOX_HD),
        'w_ffn_gate': w(ks[18], (DEPTH, D_MODEL, D_FF), D_MODEL),
        'w_ffn_up': w(ks[19], (DEPTH, D_MODEL, D_FF), D_MODEL),
        'w_ffn_down': w(ks[20], (DEPTH, D_FF, D_MODEL), D_FF),
    }


def reference(x_prompt, x_sample, state_ret, cache_k, cache_v, cache_logf, norm_mix, norm_ffn, norm_kv,
              norm_final, w_ret_in, w_ret_o, w_kv_k, w_kv_v, w_kv_f, b_kv_f, w_fox_q, w_fox_o,
              w_ffn_gate, w_ffn_up, w_ffn_down):
    Bp, Lp, _ = x_prompt.shape
    Ls = x_sample.shape[1]
    past = cache_k.shape[1]
    pos_p = jnp.arange(Lp)
    pos_s = past + jnp.arange(Ls)
    hp, hs = x_prompt, x_sample
    S_p_list, S_s_list = [], []
    for layer in range(DEPTH):
        if layer < N_A:
            S0p = jnp.zeros((Bp, RET_HEADS, RET_DK, RET_DV), F32)
            yp, Sp = _retention(_rmsnorm(hp, norm_mix[layer]), S0p, pos_p, w_ret_in[layer], w_ret_o[layer])
            ys, Ss = _retention(_rmsnorm(hs, norm_mix[layer]), state_ret[layer], pos_s, w_ret_in[layer], w_ret_o[layer])
            S_p_list.append(Sp)
            S_s_list.append(Ss)
        else:
            if layer == N_A:
                k_p, v_p, lf_p = _shared_kv(hp, norm_kv, w_kv_k, w_kv_v, w_kv_f, b_kv_f)
                k_s, v_s, lf_s = _shared_kv(hs, norm_kv, w_kv_k, w_kv_v, w_kv_f, b_kv_f)
                F_p = jnp.cumsum(lf_p, axis=1)
                k_all = jnp.concatenate([cache_k.astype(k_s.dtype), k_s], axis=1)
                v_all = jnp.concatenate([cache_v.astype(v_s.dtype), v_s], axis=1)
                F_s = jnp.cumsum(jnp.concatenate([cache_logf.astype(F32), lf_s], axis=1), axis=1)
            j = layer - N_A
            yp = _fox(_rmsnorm(hp, norm_mix[layer]), k_p, v_p, F_p, 0, w_fox_q[j], w_fox_o[j])
            ys = _fox(_rmsnorm(hs, norm_mix[layer]), k_all, v_all, F_s, past, w_fox_q[j], w_fox_o[j])
        hp = hp + yp
        hs = hs + ys
        hp = hp + _swiglu(_rmsnorm(hp, norm_ffn[layer]), w_ffn_gate[layer], w_ffn_up[layer], w_ffn_down[layer])
        hs = hs + _swiglu(_rmsnorm(hs, norm_ffn[layer]), w_ffn_gate[layer], w_ffn_up[layer], w_ffn_down[layer])
    y_prompt = _rmsnorm(hp, norm_final)
    y_sample = _rmsnorm(hs, norm_final)
    ret_state_prompt = jnp.stack(S_p_list, axis=0)
    ret_state_sample = jnp.stack(S_s_list, axis=0)
    return (y_prompt, y_sample, ret_state_prompt, k_p, v_p, lf_p, ret_state_sample, k_s, v_s, lf_s)
```

```cpp
#include <hip/hip_runtime.h>
#include <hip/hip_cooperative_groups.h>
#include <cstdio>
#include <cstdint>
namespace cg = cooperative_groups;
__device__ __forceinline__ int opaque_tid() { int t = threadIdx.x; asm volatile("" : "+v"(t)); return t; }
namespace pg8 {
#define PG8_LAS __attribute__((address_space(3)))
typedef unsigned short bf16_t;
typedef short bf16x8 __attribute__((ext_vector_type(8)));
typedef float f32x4 __attribute__((ext_vector_type(4)));
typedef unsigned u32x4 __attribute__((ext_vector_type(4)));
constexpr int BM = 256, BK = 64, HALF = 128, HTB = HALF * BK * 2  , STAGE_BYTES = 8 * HTB, NXCD = 8, WGM = 8;

__host__ __device__ __forceinline__ int lds_byte(int r, int c) { const int st = (r >> 4) * 2 + (c >> 5), rr = r & 15, cc = c & 31, ob = rr * 64 + cc * 2; return st * 1024 + (ob ^ (((ob >> 9) & 1) << 5)); }
__host__ __device__ __forceinline__ void stage_rc(int b, int& R, int& C) { const int st = b / 1024, sb = b % 1024, swz = sb ^ (((sb >> 9) & 1) << 5); R = (st >> 1) * 16 + swz / 64; C = (st & 1) * 32 + (swz % 64) / 2; }
__host__ __device__ __forceinline__ int perm32(int rho) { const int n = rho >> 4, i = rho & 15; return 8 * (i >> 2) + 4 * n + (i & 3); }

struct Unit { int pm, pn; };
struct Gemm { const bf16_t* A; const bf16_t* Bt; int M, N, K, lda; };

struct StaticOrder {
    int nM, nN, nwg, G, c;
    __host__ __device__ void init(int M, int N, int G_, int c_) { nM = M / BM; nN = N / BM; nwg = nM * nN; G = G_; c = c_; }
    __host__ __device__ bool next(int i, Unit& u) const {
        const long L = (long)i * G + c; if (L >= nwg) return false;
        int wgid = (int)L; { const int q = nwg / NXCD, r = nwg % NXCD, xcd = wgid % NXCD, off = wgid / NXCD; wgid = (xcd < r ? xcd * (q + 1) : r * (q + 1) + (xcd - r) * q) + off; }
        const int nig = WGM * nN, gid = wgid / nig, fm = gid * WGM, gsz = (nM - fm) < WGM ? (nM - fm) : WGM;
        u.pm = fm + ((wgid % nig) % gsz); u.pn = (wgid % nig) / gsz; return true;
    }
    __device__ __forceinline__ void a_ready(const Unit&) const {}
    __device__ __forceinline__ void done(const Unit&) const {}
};

__device__ __forceinline__ unsigned cvt_pk_bf16(float lo, float hi) { unsigned r; asm volatile("v_cvt_pk_bf16_f32 %0, %1, %2" : "=v"(r) : "v"(lo), "v"(hi)); return r; }
template <class Epi, class Sched, bool ALIGN_EPI = false, bool SP2 = false>
__device__ __forceinline__ void gemm_phase(PG8_LAS unsigned char* lds, const Gemm g, const Sched& S, const Epi& E) {
    const int tid = opaque_tid(), wid = __builtin_amdgcn_readfirstlane(tid >> 6), lane = tid & 63, wr = wid >> 2, wc = wid & 3, fr = lane & 15, fq = lane >> 4;
    const int K = g.K, nt = K / BK;
    unsigned voffA[2], voffB[2];
#pragma unroll
    for (int i = 0; i < 2; ++i) { int R, C; stage_rc(tid * 16 + i * 8192, R, C); const int Rb = Epi::PERM ? ((R & ~31) + perm32(R & 31)) : R;
        voffA[i] = (unsigned)(R * g.lda + C) * 2u; voffB[i] = (unsigned)(Rb * K + C) * 2u; }
    const size_t kstep = (size_t)(BK * 2);
    const size_t hstep = (size_t)HALF * K * 2, hstepA = (size_t)HALF * g.lda * 2;
    const size_t tstep = 2 * hstep, tstepA = 2 * hstepA;
    const unsigned ldsw = (unsigned)wid * 1024u;
    const int aoff = lds_byte(wr * 64 + fr, fq * 8), boff = lds_byte(wc * 32 + fr, fq * 8);
#define PG8_SA(b, h) (((b) * 2 + (h)) * HTB)
#define PG8_SB(b, h) ((4 + (b) * 2 + (h)) * HTB)
#define PG8_STAGE(bufoff, gbase, voff) do { _Pragma("unroll") for (int _i = 0; _i < 2; ++_i) \
        __builtin_amdgcn_global_load_lds((const unsigned*)((const char*)(gbase) + (voff)[_i]), (PG8_LAS unsigned*)(lds + (bufoff) + ldsw + _i * 8192), 16, 0, 0); } while (0)
#define PG8_LDA(dst, b, h) do { _Pragma("unroll") for (int m = 0; m < 4; ++m) _Pragma("unroll") for (int k = 0; k < 2; ++k) dst[m][k] = *(const PG8_LAS bf16x8*)(lds + PG8_SA(b, h) + aoff + m * 2048 + k * 1024); } while (0)
#define PG8_LDB(dst, b, h) do { _Pragma("unroll") for (int n = 0; n < 2; ++n) _Pragma("unroll") for (int k = 0; k < 2; ++k) dst[n][k] = *(const PG8_LAS bf16x8*)(lds + PG8_SB(b, h) + boff + n * 2048 + k * 1024); } while (0)
#define PG8_MMA(ai, bj, At, Bt) do { __builtin_amdgcn_s_setprio(1); _Pragma("unroll") for (int m = 0; m < 4; ++m) _Pragma("unroll") for (int n = 0; n < 2; ++n) _Pragma("unroll") for (int k = 0; k < 2; ++k) \
        acc[ai][bj][m][n] = __builtin_amdgcn_mfma_f32_16x16x32_bf16(Bt[n][k], At[m][k], acc[ai][bj][m][n], 0, 0, 0); __builtin_amdgcn_s_setprio(0); } while (0)
#define PG8_WAIT_V(n) asm volatile("s_waitcnt vmcnt(" #n ")" ::: "memory")
#define PG8_WAIT_L(n) asm volatile("s_waitcnt lgkmcnt(" #n ")" ::: "memory")
#define PG8_BAR __builtin_amdgcn_s_barrier()
#define PG8_SCHED __builtin_amdgcn_sched_barrier(0)
    Unit cur, nxt; int ui = 0;
    if (!S.next(0, cur)) return;
    f32x4 acc[2][2][4][2];
#pragma unroll
    for (int a = 0; a < 2; ++a)
#pragma unroll
        for (int b = 0; b < 2; ++b)
#pragma unroll
            for (int m = 0; m < 4; ++m)
#pragma unroll
                for (int n = 0; n < 2; ++n) acc[a][b][m][n] = (f32x4){0.f, 0.f, 0.f, 0.f};
    bf16x8 At[4][2], B0[2][2], B1[2][2];
    const char* cA = (const char*)g.A + (size_t)cur.pm * tstepA; const char* cB = (const char*)g.Bt + (size_t)cur.pn * tstep;
    S.a_ready(cur);
    if constexpr (SP2) {
        PG8_STAGE(PG8_SB(0, 0), cB, voffB); PG8_STAGE(PG8_SB(0, 1), cB + hstep, voffB); PG8_STAGE(PG8_SA(0, 0), cA, voffA); PG8_STAGE(PG8_SA(0, 1), cA + hstepA, voffA);
        if (wr == 1) PG8_BAR;
        PG8_WAIT_V(2); PG8_BAR;
        PG8_STAGE(PG8_SB(1, 0), cB + kstep, voffB); PG8_STAGE(PG8_SA(1, 0), cA + kstep, voffA); PG8_STAGE(PG8_SB(1, 1), cB + hstep + kstep, voffB);
        PG8_WAIT_V(6); PG8_BAR;
    } else {
        PG8_STAGE(PG8_SB(0, 0), cB, voffB); PG8_STAGE(PG8_SA(0, 0), cA, voffA); PG8_STAGE(PG8_SB(0, 1), cB + hstep, voffB); PG8_STAGE(PG8_SA(0, 1), cA + hstepA, voffA);
        if (wr == 1) PG8_BAR;
        PG8_WAIT_V(4); PG8_BAR;
        PG8_STAGE(PG8_SB(1, 0), cB + kstep, voffB); PG8_STAGE(PG8_SA(1, 0), cA + kstep, voffA); PG8_STAGE(PG8_SB(1, 1), cB + hstep + kstep, voffB);
        PG8_WAIT_V(6); PG8_BAR;
    }
    for (;;) {
        const bool has_next = S.next(ui + 1, nxt);
        const char* nA = has_next ? (const char*)g.A + (size_t)nxt.pm * tstepA : cA; const char* nB = has_next ? (const char*)g.Bt + (size_t)nxt.pn * tstep : cB;
        for (int t = 0; t < nt; t += 2) {
            const bool last = (t == nt - 2);
            const char* a1 = cA + (size_t)(t + 1) * kstep;
            const char* a2 = last ? nA : cA + (size_t)(t + 2) * kstep; const char* b2 = last ? nB : cB + (size_t)(t + 2) * kstep;
            const char* a3 = a2 + kstep; const char* b3 = b2 + kstep;
            if (last && has_next) S.a_ready(nxt);
            if constexpr (SP2) {
            PG8_LDB(B0, 0, 0); PG8_LDB(B1, 0, 1); PG8_SCHED; PG8_LDA(At, 0, 0); PG8_STAGE(PG8_SA(1, 1), a1 + hstepA, voffA);
            PG8_WAIT_V(8); PG8_WAIT_L(0); PG8_BAR; PG8_MMA(0, 0, At, B0); PG8_MMA(0, 1, At, B1); PG8_BAR; PG8_SCHED;
            PG8_LDA(At, 0, 1); PG8_STAGE(PG8_SB(0, 0), b2, voffB); PG8_STAGE(PG8_SB(0, 1), b2 + hstep, voffB); PG8_STAGE(PG8_SA(0, 0), a2, voffA);
            PG8_WAIT_V(8); PG8_WAIT_L(0); PG8_BAR; PG8_MMA(1, 0, At, B0); PG8_MMA(1, 1, At, B1); PG8_BAR; PG8_SCHED;
            PG8_LDB(B0, 1, 0); PG8_LDB(B1, 1, 1); PG8_SCHED; PG8_LDA(At, 1, 0); PG8_STAGE(PG8_SA(0, 1), a2 + hstepA, voffA);
            PG8_WAIT_V(8); PG8_WAIT_L(0); PG8_BAR; PG8_MMA(0, 0, At, B0); PG8_MMA(0, 1, At, B1); PG8_BAR; PG8_SCHED;
            PG8_LDA(At, 1, 1); PG8_STAGE(PG8_SB(1, 0), b3, voffB); PG8_STAGE(PG8_SB(1, 1), b3 + hstep, voffB); PG8_STAGE(PG8_SA(1, 0), a3, voffA);
            PG8_WAIT_V(8); PG8_WAIT_L(0); PG8_BAR; PG8_MMA(1, 0, At, B0); PG8_MMA(1, 1, At, B1); PG8_BAR; PG8_SCHED;
            } else {
            PG8_LDB(B0, 0, 0); PG8_SCHED; PG8_LDA(At, 0, 0); PG8_STAGE(PG8_SA(1, 1), a1 + hstepA, voffA);
            PG8_WAIT_L(8); PG8_BAR; PG8_WAIT_L(0); PG8_MMA(0, 0, At, B0); PG8_BAR; PG8_SCHED;
            PG8_LDB(B1, 0, 1); PG8_STAGE(PG8_SB(0, 0), b2, voffB);
            PG8_BAR; PG8_WAIT_L(0); PG8_MMA(0, 1, At, B1); PG8_BAR;
            PG8_LDA(At, 0, 1); PG8_STAGE(PG8_SA(0, 0), a2, voffA);
            PG8_BAR; PG8_WAIT_L(0); PG8_MMA(1, 0, At, B0); PG8_BAR; PG8_SCHED;
            PG8_STAGE(PG8_SB(0, 1), b2 + hstep, voffB);
            PG8_WAIT_V(6); PG8_BAR; PG8_MMA(1, 1, At, B1); PG8_BAR;
            PG8_LDB(B0, 1, 0); PG8_SCHED; PG8_LDA(At, 1, 0); PG8_STAGE(PG8_SA(0, 1), a2 + hstepA, voffA);
            PG8_WAIT_L(8); PG8_BAR; PG8_WAIT_L(0); PG8_MMA(0, 0, At, B0); PG8_BAR; PG8_SCHED;
            PG8_LDB(B1, 1, 1); PG8_STAGE(PG8_SB(1, 0), b3, voffB);
            PG8_BAR; PG8_WAIT_L(0); PG8_MMA(0, 1, At, B1); PG8_BAR;
            PG8_LDA(At, 1, 1); PG8_STAGE(PG8_SA(1, 0), a3, voffA);
            PG8_BAR; PG8_WAIT_L(0); PG8_MMA(1, 0, At, B0); PG8_BAR; PG8_SCHED;
            PG8_STAGE(PG8_SB(1, 1), b3 + hstep, voffB);
            PG8_WAIT_V(6); PG8_BAR; PG8_MMA(1, 1, At, B1); PG8_BAR;
            }
        }
        if constexpr (ALIGN_EPI) { if (wr == 0) PG8_BAR; }
        if constexpr (!Epi::AFTER_DRAIN) { E(acc, cur, wr, wc, fr, fq); S.done(cur); }
        if (!has_next) break;
#pragma unroll
        for (int a = 0; a < 2; ++a)
#pragma unroll
            for (int b = 0; b < 2; ++b)
#pragma unroll
                for (int m = 0; m < 4; ++m)
#pragma unroll
                    for (int n = 0; n < 2; ++n) acc[a][b][m][n] = (f32x4){0.f, 0.f, 0.f, 0.f};
        cur = nxt; cA = nA; cB = nB; ++ui;
        if constexpr (ALIGN_EPI) { if (wr == 1) PG8_BAR; }
    }
    PG8_WAIT_V(0);
    if constexpr (!ALIGN_EPI) { if (wr == 0) PG8_BAR; }
    PG8_BAR;
    if constexpr (Epi::AFTER_DRAIN) { E.fused(acc, cur, wr, wc, fr, fq, lds, wid, lane); S.done(cur); }
#undef PG8_SA
#undef PG8_SB
#undef PG8_STAGE
#undef PG8_LDA
#undef PG8_LDB
#undef PG8_MMA
#undef PG8_WAIT_V
#undef PG8_WAIT_L
#undef PG8_BAR
#undef PG8_SCHED
}
}
constexpr int DM = 2048, TP = 32768, TSMP = 256, TALL = 33024, SEQ = 8192, NPROJ = 12288, DFF = 5632, PASTL = 1024, LKS = 1056;
#define GAS __attribute__((address_space(1)))
#define LAS __attribute__((address_space(3)))
typedef unsigned short bf16_t;
typedef float f32x4 __attribute__((ext_vector_type(4)));
typedef unsigned u32x4 __attribute__((ext_vector_type(4)));
typedef unsigned u32x2 __attribute__((ext_vector_type(2)));
typedef short bf16x8 __attribute__((ext_vector_type(8)));
typedef short s16x4 __attribute__((ext_vector_type(4)));

namespace pg8 {
__device__ __forceinline__ float silu_f(float g) { return g * __builtin_amdgcn_rcpf(1.0f + __builtin_amdgcn_exp2f(-1.4426950408889634f * g)); }
struct EpiBf16P {
    static constexpr bool PERM = true, AFTER_DRAIN = false;
    bf16_t* O; int ldc;
    __device__ __forceinline__ void operator()(const f32x4 (&acc)[2][2][4][2], const Unit& u, int wr, int wc, int fr, int fq) const {
        const int row0 = u.pm * BM + wr * 64 + fr, col0 = u.pn * BM + wc * 32 + 8 * fq;
#pragma unroll
        for (int ai = 0; ai < 2; ++ai)
#pragma unroll
            for (int m = 0; m < 4; ++m) { bf16_t* rowp = O + (size_t)(row0 + ai * HALF + m * 16) * ldc + col0;
#pragma unroll
                for (int bj = 0; bj < 2; ++bj) { const f32x4 v0 = acc[ai][bj][m][0], v1 = acc[ai][bj][m][1];
                    u32x4 w; w.x = cvt_pk_bf16(v0[0], v0[1]); w.y = cvt_pk_bf16(v0[2], v0[3]); w.z = cvt_pk_bf16(v1[0], v1[1]); w.w = cvt_pk_bf16(v1[2], v1[3]);
                    *(u32x4*)(rowp + bj * HALF) = w; } }
    }
};
struct EpiRetIn {
    static constexpr bool PERM = true, AFTER_DRAIN = false;
    bf16_t* O; const float* cosT; const float* sinT;
    __device__ __forceinline__ void operator()(const f32x4 (&acc)[2][2][4][2], const Unit& u, int wr, int wc, int fr, int fq) const {
        const int row0 = u.pm * BM + wr * 64 + fr, cl = wc * 32 + 8 * fq;
        bf16_t* obase = O + (size_t)u.pn * BM + cl;
        if (u.pn < 16) {
            const bool isk = u.pn >= 8; const int h = u.pn & 7;
            const float lg2 = __log2f(1.0f - exp2f(-5.0f - (float)h));
#pragma unroll
            for (int ai = 0; ai < 2; ++ai)
#pragma unroll
                for (int m = 0; m < 4; ++m) {
                    const int row = row0 + ai * HALF + m * 16; int pos, l;
                    if (row < TP) { pos = row & (SEQ - 1); l = row & 63; } else { const int s = (row - TP) & 31; pos = PASTL + s; l = s; }
                    const float sc = isk ? exp2f(-lg2 * (float)l) * 0.0625f : exp2f(lg2 * (float)l);
                    const float* cp = cosT + (size_t)pos * 128 + cl; const float* sp = sinT + (size_t)pos * 128 + cl;
                    const f32x4 c0 = *(const f32x4*)cp, c1 = *(const f32x4*)(cp + 4), s0 = *(const f32x4*)sp, s1 = *(const f32x4*)(sp + 4);
                    const f32x4 x1a = acc[ai][0][m][0], x1b = acc[ai][0][m][1], x2a = acc[ai][1][m][0], x2b = acc[ai][1][m][1];
                    const f32x4 o1a = (x1a * c0 - x2a * s0) * sc, o1b = (x1b * c1 - x2b * s1) * sc, o2a = (x1a * s0 + x2a * c0) * sc, o2b = (x1b * s1 + x2b * c1) * sc;
                    bf16_t* rowp = obase + (size_t)row * NPROJ;
                    u32x4 w; w.x = cvt_pk_bf16(o1a[0], o1a[1]); w.y = cvt_pk_bf16(o1a[2], o1a[3]); w.z = cvt_pk_bf16(o1b[0], o1b[1]); w.w = cvt_pk_bf16(o1b[2], o1b[3]);
                    *(u32x4*)rowp = w;
                    w.x = cvt_pk_bf16(o2a[0], o2a[1]); w.y = cvt_pk_bf16(o2a[2], o2a[3]); w.z = cvt_pk_bf16(o2b[0], o2b[1]); w.w = cvt_pk_bf16(o2b[2], o2b[3]);
                    *(u32x4*)(rowp + HALF) = w;
                    asm volatile("" ::: "memory");
                }
        } else {
#pragma unroll
            for (int ai = 0; ai < 2; ++ai)
#pragma unroll
                for (int m = 0; m < 4; ++m) { bf16_t* rowp = obase + (size_t)(row0 + ai * HALF + m * 16) * NPROJ;
#pragma unroll
                    for (int bj = 0; bj < 2; ++bj) { const f32x4 v0 = acc[ai][bj][m][0], v1 = acc[ai][bj][m][1];
                        u32x4 w; w.x = cvt_pk_bf16(v0[0], v0[1]); w.y = cvt_pk_bf16(v0[2], v0[3]); w.z = cvt_pk_bf16(v1[0], v1[1]); w.w = cvt_pk_bf16(v1[2], v1[3]);
                        *(u32x4*)(rowp + bj * HALF) = w; } }
        }
    }
};
struct EpiRes {
    static constexpr bool PERM = false, AFTER_DRAIN = false;
    const float* baseP; const float* baseS; float* out;
    __device__ __forceinline__ void operator()(const f32x4 (&acc)[2][2][4][2], const Unit& u, int wr, int wc, int fr, int fq) const {
        const int row0 = u.pm * BM + wr * 64 + fr, col0 = u.pn * BM + wc * 32 + 4 * fq;
#pragma unroll
        for (int ai = 0; ai < 2; ++ai)
#pragma unroll
            for (int m = 0; m < 4; ++m) { const int row = row0 + ai * HALF + m * 16;
                const float* b = (row < TP ? baseP + (size_t)row * DM : baseS + (size_t)(row - TP) * DM) + col0; float* o = out + (size_t)row * DM + col0;
#pragma unroll
                for (int bj = 0; bj < 2; ++bj)
#pragma unroll
                    for (int n = 0; n < 2; ++n) *(f32x4*)(o + bj * HALF + n * 16) = *(const f32x4*)(b + bj * HALF + n * 16) + acc[ai][bj][m][n];
                asm volatile("" ::: "memory"); }
    }
};
struct EpiSwiglu {
    static constexpr bool PERM = true, AFTER_DRAIN = false;
    bf16_t* O;
    __device__ __forceinline__ void operator()(const f32x4 (&acc)[2][2][4][2], const Unit& u, int wr, int wc, int fr, int fq) const {
        const int row0 = u.pm * BM + wr * 64 + fr, col0 = u.pn * HALF + wc * 32 + 8 * fq;
#pragma unroll
        for (int ai = 0; ai < 2; ++ai)
#pragma unroll
            for (int m = 0; m < 4; ++m) { bf16_t* rowp = O + (size_t)(row0 + ai * HALF + m * 16) * DFF + col0;
                const f32x4 g0 = acc[ai][0][m][0], g1 = acc[ai][0][m][1], u0 = acc[ai][1][m][0], u1 = acc[ai][1][m][1];
                f32x4 a0, a1;
#pragma unroll
                for (int j = 0; j < 4; ++j) { a0[j] = silu_f(g0[j]) * u0[j]; a1[j] = silu_f(g1[j]) * u1[j]; }
                u32x4 w; w.x = cvt_pk_bf16(a0[0], a0[1]); w.y = cvt_pk_bf16(a0[2], a0[3]); w.z = cvt_pk_bf16(a1[0], a1[1]); w.w = cvt_pk_bf16(a1[2], a1[3]);
                *(u32x4*)rowp = w; }
    }
};
struct EpiKVF {
    static constexpr bool PERM = false, AFTER_DRAIN = false;
    float* kP; float* vP; float* lfP; float* kS; float* vS; float* lfS; bf16_t* KB; bf16_t* VB; bf16_t* KALL; bf16_t* VALL; const float* bf;
    __device__ __forceinline__ void operator()(const f32x4 (&acc)[2][2][4][2], const Unit& u, int wr, int wc, int fr, int fq) const {
        const int row0 = u.pm * BM + wr * 64 + fr;
        if (u.pn < 4) {
            const bool isv = u.pn >= 2; const int col0 = (u.pn & 1) * BM + wc * 32 + 4 * fq;
            float* fP = isv ? vP : kP; float* fS = isv ? vS : kS; bf16_t* bP = isv ? VB : KB; bf16_t* bA = isv ? VALL : KALL;
#pragma unroll
            for (int ai = 0; ai < 2; ++ai)
#pragma unroll
                for (int m = 0; m < 4; ++m) { const int row = row0 + ai * HALF + m * 16; float* fo; bf16_t* bo;
                    if (row < TP) { fo = fP + (size_t)row * 512 + col0; bo = bP + (size_t)row * 512 + col0; }
                    else { const int r2 = row - TP; fo = fS + (size_t)r2 * 512 + col0; bo = bA + ((size_t)(r2 >> 5) * LKS + PASTL + (r2 & 31)) * 512 + col0; }
#pragma unroll
                    for (int bj = 0; bj < 2; ++bj)
#pragma unroll
                        for (int n = 0; n < 2; ++n) { const f32x4 v = acc[ai][bj][m][n]; *(f32x4*)(fo + bj * HALF + n * 16) = v;
                            u32x2 w; w.x = cvt_pk_bf16(v[0], v[1]); w.y = cvt_pk_bf16(v[2], v[3]); *(u32x2*)(bo + bj * HALF + n * 16) = w; } }
        } else if (wc == 0) {
            const f32x4 bb = *(const f32x4*)(bf + 4 * fq);
#pragma unroll
            for (int ai = 0; ai < 2; ++ai)
#pragma unroll
                for (int m = 0; m < 4; ++m) { const int row = row0 + ai * HALF + m * 16; const f32x4 z = acc[ai][0][m][0] + bb; f32x4 r;
#pragma unroll
                    for (int j = 0; j < 4; ++j) r[j] = fminf(z[j], 0.f) - log1pf(__expf(-fabsf(z[j])));
                    float* o = row < TP ? lfP + (size_t)row * 16 : lfS + (size_t)(row - TP) * 16; *(f32x4*)(o + 4 * fq) = r; }
        }
    }
};
}
namespace fox {
enum { ORDER_NATURAL = 0, ORDER_REVERSED = 1, ORDER_PAIRED = 2, ORDER_XCD = 4 };
constexpr int D = 128, QS = 2048, KS = 512, OS = 2048;
constexpr float THR = 8.f;
constexpr bool WSKIP = false;
constexpr float SCALE = 0.08838834764831845f;
constexpr int NW = 8, QBLK = 32, KVBLK = 64, QB = NW * QBLK;
constexpr int SHM_V = KVBLK * D * 2, SHM_K = KVBLK * D * 2;
constexpr int LDS_BYTES = 2 * SHM_V + 2 * SHM_K + NW * 64 * 4 + 2 * 64 * 4;
typedef unsigned short bf16;
typedef short bf16x8 __attribute__((ext_vector_type(8)));
typedef short s16x4 __attribute__((ext_vector_type(4)));
typedef float f32x16 __attribute__((ext_vector_type(16)));
typedef float f32x4 __attribute__((ext_vector_type(4)));
typedef unsigned u32x4 __attribute__((ext_vector_type(4)));
template <class A, class Bt> struct same_t { static constexpr bool v = false; };
template <class A> struct same_t<A, A> { static constexpr bool v = true; };

#define KSWZ(row, colB) ((row) * 256 + ((colB) ^ (((row) & 7) << 4)))
#define SBAR() __builtin_amdgcn_sched_barrier(0)
__device__ __forceinline__ int v_st(int k, int c) { const int kk = (k & ~0xC) | ((k & 4) << 1) | ((k & 8) >> 1); return ((kk >> 3) * 4 + (c >> 5)) * 512 + ((kk & 7) * 32 + (c & 31)) * 2; }
__device__ __forceinline__ int v_rd_base(int lane) { return ((lane & 3) << 3) | (((lane >> 2) & 3) << 6) | (((lane >> 4) & 1) << 5) | (((lane >> 5) & 1) << 8); }
constexpr int v_rd_off(int d0, int ks, int half) { return d0 * 512 + ks * 4096 + half * 2048; }
__device__ __forceinline__ int crow(int r, int hi) { return (r & 3) + 8 * (r >> 2) + 4 * hi; }
__device__ __forceinline__ unsigned cvtpk(float lo, float hi) {
    unsigned r; asm volatile("v_cvt_pk_bf16_f32 %0, %1, %2" : "=v"(r) : "v"(lo), "v"(hi)); return r;
}
__device__ __forceinline__ bf16x8 pack8(f32x4 a, f32x4 b) {
    u32x4 w = {cvtpk(a[0], a[1]), cvtpk(a[2], a[3]), cvtpk(b[0], b[1]), cvtpk(b[2], b[3])};
    return *reinterpret_cast<bf16x8*>(&w);
}
template <class T> __device__ __forceinline__ bf16x8 load8(const T* p) {
    if constexpr (same_t<T, float>::v) { return pack8(*(const f32x4*)p, *(const f32x4*)(p + 4)); }
    else { return *reinterpret_cast<const bf16x8*>(p); }
}
__device__ __forceinline__ void mask_tile(f32x16& p0, f32x16& p1, int dq, unsigned W) {
    const float NEG = -__builtin_inff();
#pragma unroll
    for (int r = 0; r < 16; ++r) {
        const int c = (r & 3) + 8 * (r >> 2);
        if ((unsigned)(dq - c) >= W) p0[r] = NEG;
        if ((unsigned)(dq - c - 32) >= W) p1[r] = NEG;
    }
}
__device__ __forceinline__ void partialSM(f32x16& p0, f32x16& p1, float& m_reg, float& mn, float& alpha) {
    float pmax = p0[0]; for (int r = 1; r < 16; ++r) pmax = fmaxf(pmax, p0[r]); for (int r = 0; r < 16; ++r) pmax = fmaxf(pmax, p1[r]);
    { auto rr = __builtin_amdgcn_permlane32_swap(__float_as_uint(pmax), __float_as_uint(pmax), false, false);
      pmax = fmaxf(__uint_as_float(rr[0]), __uint_as_float(rr[1])); }
    constexpr float C2 = 1.4426950408889634f * SCALE;
    if (__builtin_expect(__all((pmax - m_reg) * SCALE <= THR), 1)) { mn = m_reg; alpha = 1.f; }
    else { mn = fmaxf(m_reg, pmax); alpha = __builtin_amdgcn_exp2f((m_reg - mn) * C2); m_reg = mn; }
    const float mnL = -mn * C2;
    for (int r = 0; r < 16; ++r) p0[r] = fmaf(p0[r], C2, mnL); for (int r = 0; r < 16; ++r) p1[r] = fmaf(p1[r], C2, mnL);
    for (int r = 0; r < 16; ++r) p0[r] = __builtin_amdgcn_exp2f(p0[r]);
}
__device__ __forceinline__ void finishSM(f32x16& p0, f32x16& p1, float alpha, float& l_reg, bf16x8& pa0, bf16x8& pa1, bf16x8& pa2, bf16x8& pa3) {
    for (int r = 0; r < 16; ++r) p1[r] = __builtin_amdgcn_exp2f(p1[r]);
    float ps = 0; for (int r = 0; r < 16; ++r) ps += p0[r]; for (int r = 0; r < 16; ++r) ps += p1[r];
    { auto rr = __builtin_amdgcn_permlane32_swap(__float_as_uint(ps), __float_as_uint(ps), false, false);
      ps = __uint_as_float(rr[0]) + __uint_as_float(rr[1]); }
    l_reg = l_reg * alpha + ps;
#define PK4(P, B_, OUT) do { unsigned a0 = cvtpk(P[B_+0], P[B_+1]), a1 = cvtpk(P[B_+2], P[B_+3]);                          \
        unsigned b0 = cvtpk(P[B_+4], P[B_+5]), b1 = cvtpk(P[B_+6], P[B_+7]);                                             \
        auto r0 = __builtin_amdgcn_permlane32_swap(a0, b0, false, false); auto r1 = __builtin_amdgcn_permlane32_swap(a1, b1, false, false); \
        u32x4 w = {r0[0], r1[0], r0[1], r1[1]}; OUT = *reinterpret_cast<bf16x8*>(&w); } while (0)
    PK4(p0, 0, pa0); PK4(p0, 8, pa1); PK4(p1, 0, pa2); PK4(p1, 8, pa3);
#undef PK4
}
template <int KB, bool SK>
__device__ __forceinline__ void qkt(f32x16& p0, f32x16& p1, const char* K_lds, int r32, int hi, const bf16x8* qr, bool act) {
    if (SK && !act) { const float NEG = -__builtin_inff();
#pragma unroll
        for (int r = 0; r < 16; ++r) { p0[r] = NEG; p1[r] = NEG; } return; }
    { const float* bb_ = (const float*)(K_lds + 2 * SHM_K + NW * 64 * 4) + KB * 64 + 4 * hi;
#pragma unroll
      for (int q_ = 0; q_ < 4; ++q_) { const f32x4 b0_ = *(const f32x4*)(bb_ + 8 * q_), b1_ = *(const f32x4*)(bb_ + 32 + 8 * q_);
#pragma unroll
        for (int i_ = 0; i_ < 4; ++i_) { p0[4 * q_ + i_] = b0_[i_]; p1[4 * q_ + i_] = b1_[i_]; } } }
    const char* kb[4];
#pragma unroll
    for (int dd = 0; dd < 4; ++dd) kb[dd] = K_lds + KB * SHM_K + KSWZ(r32, (dd * 16 + hi * 8) * 2);
#pragma unroll
    for (int d0 = 0; d0 < 8; ++d0) { const char* a = kb[d0 & 3] + (d0 >> 2) * 128;
        bf16x8 b0 = *reinterpret_cast<const bf16x8*>(a);
        bf16x8 b1 = *reinterpret_cast<const bf16x8*>(a + 32 * 256);
        p0 = __builtin_amdgcn_mfma_f32_32x32x16_bf16(b0, qr[d0], p0, 0, 0, 0);
        p1 = __builtin_amdgcn_mfma_f32_32x32x16_bf16(b1, qr[d0], p1, 0, 0, 0); }
}
template <int VB, bool SK>
__device__ __forceinline__ void pv_tile(f32x16* o, int vb0, bf16x8 pa0, bf16x8 pa1, bf16x8 pa2, bf16x8 pa3, bool act) {
    if (SK && !act) return;
#define TRRD(dst, off) asm volatile("ds_read_b64_tr_b16 %0, %1 offset:%2" : "=&v"(dst) : "v"(vb0), "i"(off) : "memory")
#define PV_D0(d0) do { s16x4 l0, l1, l2, l3, h0, h1, h2, h3; constexpr int b_ = VB * SHM_V + v_rd_off(d0, 0, 0);     \
        TRRD(l0, b_); TRRD(h0, b_ + 2048); TRRD(l1, b_ + 4096); TRRD(h1, b_ + 6144); TRRD(l2, b_ + 8192); TRRD(h2, b_ + 10240); TRRD(l3, b_ + 12288); TRRD(h3, b_ + 14336); \
        asm volatile("s_waitcnt lgkmcnt(0)" ::: "memory"); SBAR();                 \
        o[d0] = __builtin_amdgcn_mfma_f32_32x32x16_bf16(pa0, (bf16x8){l0[0], l0[1], l0[2], l0[3], h0[0], h0[1], h0[2], h0[3]}, o[d0], 0, 0, 0);   \
        o[d0] = __builtin_amdgcn_mfma_f32_32x32x16_bf16(pa1, (bf16x8){l1[0], l1[1], l1[2], l1[3], h1[0], h1[1], h1[2], h1[3]}, o[d0], 0, 0, 0);   \
        o[d0] = __builtin_amdgcn_mfma_f32_32x32x16_bf16(pa2, (bf16x8){l2[0], l2[1], l2[2], l2[3], h2[0], h2[1], h2[2], h2[3]}, o[d0], 0, 0, 0);   \
        o[d0] = __builtin_amdgcn_mfma_f32_32x32x16_bf16(pa3, (bf16x8){l3[0], l3[1], l3[2], l3[3], h3[0], h3[1], h3[2], h3[3]}, o[d0], 0, 0, 0); } while (0)
    PV_D0(0); PV_D0(1); PV_D0(2); PV_D0(3);
#undef PV_D0
#undef TRRD
}
template <class TIn, class TOut> struct BlockRef { const TIn* Q; const TIn* K; const TIn* V; TOut* O; const float* FB; int P0; };
template <class TIn> struct Seam {
    bf16x8 qr[8];
    bf16x8 st_v0, st_v1, st_k0, st_k1; float st_f; f32x4 sf0, sf1, sf2, sf3;
    f32x4 tq[16];
};
__device__ __forceinline__ int swa_jlo(int P0, int W) { const int lowk = P0 - W + 1; return lowk > 0 ? lowk / KVBLK : 0; }
#define ROW(p, k0, rr) ((p) + (size_t)((k0) + (rr)) * KS + sc)
#define VMW() asm volatile("s_waitcnt vmcnt(0)" ::: "memory")
#define VMWN(n) asm volatile("s_waitcnt vmcnt(%0)" :: "i"(n) : "memory")
#define SLOAD_H(Kp, Vp, Fp, k0) do { S.st_f = (Fp)[(k0) + (tid & 63)]; S.st_v0 = load8<TIn>(ROW(Vp, k0, sr)); S.st_v1 = load8<TIn>(ROW(Vp, k0, 32 + sr));              \
                         S.st_k0 = load8<TIn>(ROW(Kp, k0, sr)); S.st_k1 = load8<TIn>(ROW(Kp, k0, 32 + sr)); } while (0)
#define SWRITE_HK(bf) do { ((float*)(K_lds + 2 * SHM_K + NW * 64 * 4))[(bf) * 64 + (tid & 63)] = S.st_f; *(bf16x8*)(K_lds + (bf) * SHM_K + kws) = S.st_k0; *(bf16x8*)(K_lds + (bf) * SHM_K + kws + 32 * 256) = S.st_k1; } while (0)
#define SWRITE_HV(bf) do { *(bf16x8*)(V_lds + (bf) * SHM_V + vst0) = S.st_v0; *(bf16x8*)(V_lds + (bf) * SHM_V + vst1) = S.st_v1; } while (0)
#define SWRITE_H(bf) do { SWRITE_HV(bf); SWRITE_HK(bf); } while (0)
#define SLOAD_F(p, k0) do { S.sf0 = *(const f32x4*)ROW(p, k0, sr); S.sf1 = *(const f32x4*)(ROW(p, k0, sr) + 4);                \
                            S.sf2 = *(const f32x4*)ROW(p, k0, 32 + sr); S.sf3 = *(const f32x4*)(ROW(p, k0, 32 + sr) + 4); } while (0)
#define SWRITE_KF(bf) do { *(bf16x8*)(K_lds + (bf) * SHM_K + kws) = pack8(S.sf0, S.sf1); *(bf16x8*)(K_lds + (bf) * SHM_K + kws + 32 * 256) = pack8(S.sf2, S.sf3); } while (0)
#define SWRITE_VF(bf) do { *(bf16x8*)(V_lds + (bf) * SHM_V + vst0) = pack8(S.sf0, S.sf1); *(bf16x8*)(V_lds + (bf) * SHM_V + vst1) = pack8(S.sf2, S.sf3); } while (0)
template <class TIn, class TOut>
__device__ __forceinline__ void causal_swa_prime(const BlockRef<TIn, TOut>& cur, int W, char* lds, Seam<TIn>& S) {
    constexpr bool F32 = same_t<TIn, float>::v;
    const int tid = opaque_tid(), wid = __builtin_amdgcn_readfirstlane(tid >> 6), lane = tid & 63, r32 = lane & 31, hi = lane >> 5;
    const int sr = tid >> 4, sc = (tid & 15) * 8, kws = KSWZ(sr, sc * 2); char* K_lds = lds + 2 * SHM_V;
    const int kb0 = swa_jlo(cur.P0, W) * KVBLK;
    for (int d0 = 0; d0 < 8; ++d0) S.qr[d0] = load8<TIn>(cur.Q + (size_t)(wid * QBLK + r32) * QS + d0 * 16 + hi * 8);
    if constexpr (F32) { SLOAD_F((const float*)cur.K, kb0); VMW(); SWRITE_KF(0); SBAR(); SLOAD_F((const float*)cur.V, kb0); }
    else { SLOAD_H(cur.K, cur.V, cur.FB, kb0); VMW(); SWRITE_HK(0); }
    __syncthreads();
}
template <class TIn, class TOut>
__device__ __forceinline__ void causal_swa_block(const BlockRef<TIn, TOut>& cur, const BlockRef<TIn, TOut>& nxt, int skv, int W, char* lds, Seam<TIn>& S) {
    constexpr bool F32 = same_t<TIn, float>::v;
    const int tid = opaque_tid(), wid = __builtin_amdgcn_readfirstlane(tid >> 6), lane = tid & 63, r32 = lane & 31, hi = lane >> 5;
    const int j_lo = swa_jlo(cur.P0, W);
    int j_hi = (cur.P0 + QB - 1) / KVBLK + 1; if (j_hi > skv / KVBLK) j_hi = skv / KVBLK;
    const int NT = j_hi - j_lo;
    const int kbn = swa_jlo(nxt.P0, W) * KVBLK;
    const int qlo = cur.P0 + wid * QBLK, qm = qlo + r32 - 4 * hi;
    char* V_lds = lds; char* K_lds = lds + 2 * SHM_V;
    float* ws = (float*)(lds + 2 * SHM_V + 2 * SHM_K) + wid * 64; float* li_l = ws, * al_l = ws + 32;
    float m_reg = -1e30f, l_reg = 0; f32x16 o[4] = {};
    const int sr = tid >> 4, sc = (tid & 15) * 8, vst0 = v_st(sr, sc), vst1 = v_st(32 + sr, sc), kws = KSWZ(sr, sc * 2);
    const int vb0 = (int)(uintptr_t)V_lds + v_rd_base(lane);
    const TIn* Kh = cur.K; const TIn* Vh = cur.V;
#define RESC(a) do { if (__any((a) < 1.f)) { if (hi == 0) al_l[r32] = (a); asm volatile("s_waitcnt lgkmcnt(0)" ::: "memory");              \
                     for (int d_ = 0; d_ < 4; ++d_) for (int r = 0; r < 16; ++r) o[d_][r] *= al_l[crow(r, hi)]; } } while (0)
#define KBASE(t) ((j_lo + (t)) * KVBLK)
#define ACT(t) (KBASE(t) <= qlo + QBLK - 1 && KBASE(t) + KVBLK - 1 >= qlo - W + 1)
#define MASKT(P0_, P1_, t) do { const int kb_ = KBASE(t); if ((!SK || ACT(t)) && (kb_ + KVBLK - 1 > qlo || kb_ <= qlo + QBLK - 1 - W)) mask_tile(P0_, P1_, qm - kb_, (unsigned)W); } while (0)
    constexpr int NQL = F32 ? 16 : 8;
    constexpr bool SK = WSKIP && !F32;
#define SEAM_K0() do { VMWN(NQL); if constexpr (F32) { SWRITE_KF(0); SBAR(); SLOAD_F((const float*)nxt.V, kbn); } else { SWRITE_HK(0); } SBAR(); } while (0)
    f32x16 pA0, pA1, pB0, pB1; float mnA, mnB, alA, alB; bf16x8 pa0, pa1, pa2, pa3;
    if constexpr (F32) { VMW(); SWRITE_VF(0); SBAR(); } else { SWRITE_HV(0); SBAR(); }
    if (NT > 1) { if constexpr (F32) SLOAD_F((const float*)Kh, KBASE(1)); else SLOAD_H(Kh, Vh, cur.FB, KBASE(1)); }
    SBAR(); qkt<0, SK>(pA0, pA1, K_lds, r32, hi, S.qr, ACT(0));
    if constexpr (F32) { if (NT > 1) { VMW(); SWRITE_KF(1); SBAR(); SLOAD_F((const float*)Vh, KBASE(1)); } }
    MASKT(pA0, pA1, 0); partialSM(pA0, pA1, m_reg, mnA, alA);
    if (NT > 1) { VMW(); if constexpr (F32) { SWRITE_VF(1); SBAR(); if (NT > 2) SLOAD_F((const float*)Kh, KBASE(2)); } else SWRITE_H(1); }
    __syncthreads();
#define HALF_STEP(PX0, PX1, mnX, alX, PY0, PY1, alY, t, KB, VB, SB) do {                                                      \
        SBAR(); qkt<KB, SK>(PX0, PX1, K_lds, r32, hi, S.qr, ACT(t));                                             \
        finishSM(PY0, PY1, alY, l_reg, pa0, pa1, pa2, pa3); SBAR();                                                           \
        if ((t) + 1 < NT) { if constexpr (F32) { VMW(); SWRITE_KF(SB); SBAR(); SLOAD_F((const float*)Vh, KBASE((t) + 1)); }  \
                            else { SLOAD_H(Kh, Vh, cur.FB, KBASE((t) + 1)); } SBAR(); }                                               \
        pv_tile<VB, SK>(o, vb0, pa0, pa1, pa2, pa3, ACT((t) - 1)); MASKT(PX0, PX1, (t)); partialSM(PX0, PX1, m_reg, mnX, alX);                                        \
        __syncthreads();                                                                                                      \
        if ((t) + 1 < NT) { VMW(); if constexpr (F32) { SWRITE_VF(SB); SBAR(); if ((t) + 2 < NT) SLOAD_F((const float*)Kh, KBASE((t) + 2)); } \
                            else { SWRITE_H(SB); } }                                                                          \
        RESC(alX); __syncthreads(); } while (0)
    for (int t = 1; t + 1 < NT; t += 2) {
        HALF_STEP(pB0, pB1, mnB, alB, pA0, pA1, alA, t, 1, 0, 0);
        HALF_STEP(pA0, pA1, mnA, alA, pB0, pB1, alB, t + 1, 0, 1, 1);
    }
    const bool even = (NT & 1) == 0;
    if (even) { SBAR(); qkt<1, SK>(pB0, pB1, K_lds, r32, hi, S.qr, ACT(NT - 1)); SBAR(); }
#define QROW(e) (nxt.Q + (size_t)(wid * QBLK + r32) * D + ((e) >> 1) * 16 + hi * 8 + ((e) & 1) * 4)
    if constexpr (F32) { SLOAD_F((const float*)nxt.K, kbn); SBAR();
#pragma unroll
        for (int e = 0; e < 8; ++e) S.tq[e] = *(const f32x4*)QROW(e); }
    else { SLOAD_H(nxt.K, nxt.V, nxt.FB, kbn); SBAR();
#pragma unroll
        for (int d0 = 0; d0 < 8; ++d0) S.qr[d0] = load8<TIn>(nxt.Q + (size_t)(wid * QBLK + r32) * QS + d0 * 16 + hi * 8); }
    SBAR();
    finishSM(pA0, pA1, alA, l_reg, pa0, pa1, pa2, pa3); SBAR();
    if constexpr (F32) {
#pragma unroll
        for (int e = 8; e < 16; ++e) S.tq[e] = *(const f32x4*)QROW(e); SBAR(); }
#undef QROW
    pv_tile<0, SK>(o, vb0, pa0, pa1, pa2, pa3, ACT(even ? NT - 2 : NT - 1));
    if (even) { MASKT(pB0, pB1, NT - 1); partialSM(pB0, pB1, m_reg, mnB, alB); __syncthreads(); RESC(alB);
        finishSM(pB0, pB1, alB, l_reg, pa0, pa1, pa2, pa3); SBAR(); pv_tile<1, SK>(o, vb0, pa0, pa1, pa2, pa3, ACT(NT - 1)); }
    SBAR(); SEAM_K0();
    if (hi == 0) li_l[r32] = l_reg; asm volatile("s_waitcnt lgkmcnt(0)" ::: "memory");
    float rli[16];
#pragma unroll
    for (int r = 0; r < 16; ++r) rli[r] = __builtin_amdgcn_rcpf(li_l[crow(r, hi)]);
    TOut* Ow = cur.O + (size_t)(wid * QBLK) * OS;
#pragma unroll
    for (int r = 0; r < 16; ++r) { const int orow = crow(r, hi);
#pragma unroll
        for (int d0 = 0; d0 < 4; ++d0) { const float v = o[d0][r] * rli[r];
            if constexpr (same_t<TOut, float>::v) { Ow[(size_t)orow * OS + d0 * 32 + r32] = v; }
            else { const float vn = __shfl_xor(v, 1);
                   if ((r32 & 1) == 0) *(unsigned*)(Ow + (size_t)orow * OS + d0 * 32 + r32) = cvtpk(v, vn); } } }
    if constexpr (F32) {
#pragma unroll
        for (int d0 = 0; d0 < 8; ++d0) S.qr[d0] = pack8(S.tq[2 * d0], S.tq[2 * d0 + 1]); }
    __syncthreads();
#undef RESC
#undef KBASE
#undef ACT
#undef MASKT
#undef SEAM_K0
#undef HALF_STEP
}
#undef ROW
#undef VMW
#undef VMWN
#undef SLOAD_H
#undef SWRITE_HK
#undef SWRITE_HV
#undef SWRITE_H
#undef SLOAD_F
#undef SWRITE_KF
#undef SWRITE_VF

__host__ __device__ inline int swa_nramp(int nqb, int W, int qoff) { const int t = W - 1 - qoff; const int n = t < 0 ? 0 : t / QB + 1; return n > nqb ? nqb : n; }
__host__ __device__ inline int swa_nx(int nqb, int nramp, int order) { return (order & ORDER_PAIRED) ? (nramp + 1) / 2 + (nqb - nramp) : nqb; }
struct SwaItem { int bh, qb0, qb1; };
__device__ __forceinline__ SwaItem swa_decode(int L, int nb, int nh, int nhkv, int nqb, int nx, int nramp, int order) {
    const int G = nh / nhkv; SwaItem it; int x;
    if ((order & ORDER_XCD) && (nb * nhkv) % 8 == 0) { const int xcd = L & 7, k = L >> 3, per = G * nx, gi = k / per, r = k - gi * per;
        it.bh = (gi * 8 + xcd) * G + r / nx; x = r % nx; }
    else { it.bh = L / nx; x = L - it.bh * nx; }
    if (order & ORDER_PAIRED) { const int ns = nqb - nramp;
        if (x < ns) { it.qb0 = it.qb1 = nqb - 1 - x; } else { it.qb0 = x - ns; it.qb1 = nramp - 1 - it.qb0; } }
    else { it.qb0 = it.qb1 = ((order & 3) == ORDER_REVERSED) ? nqb - 1 - x : x; }
    return it;
}
typedef unsigned short bf16;
__device__ __forceinline__ BlockRef<bf16, bf16> mk_ref(const SwaItem& it, int pass, const bf16* Q, const bf16* K, const bf16* V, bf16* O, const float* FB) {
    const int qb = pass ? it.qb1 : it.qb0, b = it.bh >> 4, h = it.bh & 15, kvh = h >> 2;
    BlockRef<bf16, bf16> r;
    r.Q = Q + ((size_t)b * 8192 + (size_t)qb * QB) * QS + h * 128; r.O = O + ((size_t)b * 8192 + (size_t)qb * QB) * OS + h * 128;
    r.K = K + (size_t)b * 8192 * KS + kvh * 128; r.V = V + (size_t)b * 8192 * KS + kvh * 128; r.FB = FB + (size_t)it.bh * 8192; r.P0 = qb * QB;
    return r;
}
__device__ __forceinline__ void attn_phase(char* lds, const bf16* Q, const bf16* K, const bf16* V, bf16* O, const float* FB) {
    constexpr int nb = 4, nh = 16, nhkv = 4, nqb = 32, W = 8192, order = ORDER_PAIRED | ORDER_XCD;
    const int nramp = swa_nramp(nqb, W, 0), nx = swa_nx(nqb, nramp, order), total = nx * nb * nh, stride = gridDim.x;
    int L = blockIdx.x; if (L >= total) return;
    SwaItem it = swa_decode(L, nb, nh, nhkv, nqb, nx, nramp, order); int pass = 0;
    BlockRef<bf16, bf16> cur = mk_ref(it, 0, Q, K, V, O, FB);
    Seam<bf16> S;
    causal_swa_prime<bf16, bf16>(cur, W, lds, S);
    for (;;) {
        const bool more_pass = pass == 0 && it.qb1 != it.qb0, more_item = L + stride < total, last = !more_pass && !more_item;
        SwaItem itn = it; int passn = pass + 1, Ln = L;
        if (!more_pass) { passn = 0; Ln = more_item ? L + stride : L; itn = swa_decode(Ln, nb, nh, nhkv, nqb, nx, nramp, order); }
        const BlockRef<bf16, bf16> nxt = last ? cur : mk_ref(itn, passn, Q, K, V, O, FB);
        causal_swa_block<bf16, bf16>(cur, nxt, 8192, W, lds, S);
        if (last) break;
        cur = nxt; it = itn; pass = passn; L = Ln;
    }
}
}
constexpr size_t WS_WIN = 0, WS_WRO = 50331648, WS_WGU0 = 67108864, WS_WGU1 = 113246208, WS_WDN0 = 159383552, WS_WDN1 = 182452224,
                 WS_WQ = 205520896, WS_WO = 213909504, WS_WKVF = 222298112, WS_COS = 227540992, WS_SIN = 231735296, WS_FB = 235929600, WS_FS = WS_FB + 2097152,
                 WS_BIG = 239075328;
constexpr size_t SZ_ROWS2K = (size_t)TALL * DM * 2;
constexpr size_t BIG_XN = 0, BIG_ACT = SZ_ROWS2K, BIG_HKV = BIG_ACT + (size_t)TALL * DFF * 2, BIG_KB = BIG_HKV + SZ_ROWS2K, BIG_VB = BIG_KB + (size_t)TP * 512 * 2,
                 BIG_KALL = BIG_VB + (size_t)TP * 512 * 2, BIG_VALL = BIG_KALL + (size_t)8 * LKS * 512 * 2, BIG_END = BIG_VALL + (size_t)8 * LKS * 512 * 2;
static_assert(BIG_END <= (size_t)TALL * NPROJ * 2, "layer-1 buffers fit in the PROJ region");
constexpr size_t WS_END = WS_BIG + (size_t)TALL * NPROJ * 2;
static_assert(WS_END <= (size_t)1073741824, "workspace fits 1 GiB");
constexpr size_t OUT_Y = 0, OUT_SP = 67633152, OUT_KP = 71827456, OUT_VP = 88604672, OUT_LFP = 105381888, OUT_SS = 105906176, OUT_KS = 114294784, OUT_VS = 114425856, OUT_LFS = 114556928;
constexpr int NWAVES = 8, LDS_BYTES = 149504;

struct Params { const float* in[21]; float* out; unsigned char* ws; };

__device__ __forceinline__ float wave_sum(float v) {
#pragma unroll
    for (int o = 1; o < 64; o <<= 1) v += __shfl_xor(v, o);
    return v;
}
__device__ __forceinline__ float bf2f(unsigned short b) { return __uint_as_float(((unsigned)b) << 16); }
__device__ __forceinline__ unsigned pk2(float lo, float hi) { return pg8::cvt_pk_bf16(lo, hi); }

__device__ __forceinline__ void transpose_item(const float* W, int K, int N, bf16_t* WT, int k0, int n0, int drow0, LAS float* scr, int lane) {
#pragma unroll 8
    for (int i = 0; i < 32; ++i) { const int kk = 2 * i + (lane >> 5); scr[kk * 33 + (lane & 31)] = W[(size_t)(k0 + kk) * N + n0 + (lane & 31)]; }
    asm volatile("s_waitcnt lgkmcnt(0)" ::: "memory");
    const int c = lane & 7;
#pragma unroll
    for (int j = 0; j < 4; ++j) { const int n = (lane >> 3) + 8 * j; const LAS float* s = scr + (8 * c) * 33 + n;
        u32x4 o; o.x = pk2(s[0 * 33], s[1 * 33]); o.y = pk2(s[2 * 33], s[3 * 33]); o.z = pk2(s[4 * 33], s[5 * 33]); o.w = pk2(s[6 * 33], s[7 * 33]);
        *(u32x4*)(WT + (size_t)(drow0 + n) * K + k0 + 8 * c) = o; }
    asm volatile("s_waitcnt lgkmcnt(0)" ::: "memory");
}
__device__ __forceinline__ void tr_plain(const float* W, int K, int N, bf16_t* WT, int row_off, LAS float* scr, int item, int lane) {
    const int nblk = N / 32, kb = item / nblk, nb = item % nblk; transpose_item(W, K, N, WT, 64 * kb, 32 * nb, row_off + 32 * nb, scr, lane);
}
__device__ __forceinline__ void tr_gu(const float* W, bf16_t* WT, int up, LAS float* scr, int item, int lane) {
    const int nblk = DFF / 32, kb = item / nblk, nb = item % nblk, n0 = 32 * nb; transpose_item(W, DM, DFF, WT, 64 * kb, n0, (n0 >> 7) * 256 + up * 128 + (n0 & 127), scr, lane);
}
template <int MODE  >
__device__ __forceinline__ void rms_row(const float* xrow, const float* g1, bf16_t* o1, const float* g2, bf16_t* o2, float* of, int lane) {
    const f32x4* xr = (const f32x4*)xrow + lane;
    f32x4 v[8]; float s = 0.f;
#pragma unroll
    for (int j = 0; j < 8; ++j) { v[j] = xr[64 * j]; s += (v[j].x * v[j].x + v[j].y * v[j].y) + (v[j].z * v[j].z + v[j].w * v[j].w); }
    const float rs = 1.0f / sqrtf(wave_sum(s) * (1.f / DM) + 1e-6f);
#pragma unroll
    for (int j = 0; j < 8; ++j) { const f32x4 ga = ((const f32x4*)g1)[64 * j + lane]; const f32x4 y = v[j] * rs;
        if (MODE == 2) { ((f32x4*)of)[64 * j + lane] = y * ga; }
        else { u32x2 w; w.x = pk2(y.x * ga.x, y.y * ga.y); w.y = pk2(y.z * ga.z, y.w * ga.w); ((u32x2*)o1)[64 * j + lane] = w;
            if (MODE == 1) { const f32x4 gb = ((const f32x4*)g2)[64 * j + lane]; u32x2 w2; w2.x = pk2(y.x * gb.x, y.y * gb.y); w2.y = pk2(y.z * gb.z, y.w * gb.w); ((u32x2*)o2)[64 * j + lane] = w2; } } }
}

namespace ret {
constexpr int QOFF = 0, KOFF = 33792, STOFF = 67584, VOFF = 101376, POFF = 110592, RS = 528, VS = 144;
typedef short v4i16_t __attribute__((ext_vector_type(4)));
__device__ __forceinline__ bf16x8 frag_rm(const LAS char* base, int stride, int i0, int k0, int fr, int fq) { return *(const LAS bf16x8*)(base + (i0 + fr) * stride + (k0 + 8 * fq) * 2); }
__device__ __forceinline__ s16x4 tr4(const LAS char* p) { return __builtin_bit_cast(s16x4, __builtin_amdgcn_ds_read_tr16_b64_v4i16((LAS v4i16_t*)p)); }
__device__ __forceinline__ bf16x8 frag_tr(const LAS char* base, int stride, int k0, int i0, int fr, int fq) {
    const LAS char* p = base + (k0 + 8 * fq + (fr >> 2)) * stride + (i0 + 4 * (fr & 3)) * 2;
    const s16x4 a = tr4(p), b = tr4(p + 4 * stride);
    return (bf16x8){a[0], a[1], a[2], a[3], b[0], b[1], b[2], b[3]};
}
#define MFMA16(X, Y, C) __builtin_amdgcn_mfma_f32_16x16x32_bf16(X, Y, C, 0, 0, 0)
__device__ __forceinline__ void ret_item(LAS char* lds, bf16_t* pin, int nchunks, int c, int h, int es, const float* S0, float* Sout) {
    const int tid = opaque_tid(), wid = __builtin_amdgcn_readfirstlane(tid >> 6), lane = tid & 63, fr = lane & 15, fq = lane >> 4, lt = wid >> 1, half = wid & 1;
    const float lg2 = __log2f(1.0f - exp2f(-5.0f - (float)h)), gam = exp2f(lg2), gc1 = exp2f(lg2 * (float)(c - 1));
    f32x4 accT[8];
    const int eT = 16 * lt + fr;
#pragma unroll
    for (int i = 0; i < 8; ++i) { const int d0 = 16 * (8 * half + i) + 4 * fq;
#pragma unroll
        for (int r = 0; r < 4; ++r) accT[i][r] = S0 ? S0[(size_t)(d0 + r) * 512 + es * 64 + eT] : 0.f;
        u32x2 w; w.x = pk2(accT[i][0], accT[i][1]); w.y = pk2(accT[i][2], accT[i][3]); *(LAS u32x2*)(lds + STOFF + eT * RS + d0 * 2) = w; }
    u32x4 rq[4], rk[4], rv;
    const bf16_t* gq = pin + h * 256; const bf16_t* gk = pin + 2048 + h * 256; const bf16_t* gv = pin + 4096 + h * 512 + es * 64;
#define RET_LOAD(n) do { _Pragma("unroll") for (int i = 0; i < 4; ++i) { const int p = tid + 512 * i, row = p >> 5, ch = p & 31; const size_t go = (size_t)((n) * 64 + row) * NPROJ + ch * 8; \
            if (row < c) { rq[i] = *(const u32x4*)(gq + go); rk[i] = *(const u32x4*)(gk + go); } else { rq[i] = (u32x4){0u, 0u, 0u, 0u}; rk[i] = (u32x4){0u, 0u, 0u, 0u}; } } \
        { const int row = tid >> 3, ch = tid & 7; if (row < c) rv = *(const u32x4*)(gv + (size_t)((n) * 64 + row) * NPROJ + ch * 8); else rv = (u32x4){0u, 0u, 0u, 0u}; } } while (0)
    RET_LOAD(0);
    for (int n = 0; n < nchunks; ++n) {
#pragma unroll
        for (int i = 0; i < 4; ++i) { const int p = tid + 512 * i, row = p >> 5, ch = p & 31; *(LAS u32x4*)(lds + QOFF + row * RS + ch * 16) = rq[i]; *(LAS u32x4*)(lds + KOFF + row * RS + ch * 16) = rk[i]; }
        *(LAS u32x4*)(lds + VOFF + (tid >> 3) * VS + (tid & 7) * 16) = rv;
        if (n + 1 < nchunks) RET_LOAD(n + 1);
        __syncthreads();
        f32x4 accS[2], accC[2];
#pragma unroll
        for (int j = 0; j < 2; ++j) { accS[j] = (f32x4){0.f, 0.f, 0.f, 0.f}; accC[j] = (f32x4){0.f, 0.f, 0.f, 0.f}; }
#pragma unroll
        for (int ks = 0; ks < 8; ++ks) { const int k0 = 32 * ks;
            const bf16x8 yq = frag_rm(lds + QOFF, RS, 16 * lt, k0, fr, fq);
#pragma unroll
            for (int j = 0; j < 2; ++j) { const bf16x8 xk = frag_rm(lds + KOFF, RS, 16 * (2 * half + j), k0, fr, fq); accS[j] = MFMA16(xk, yq, accS[j]); }
#pragma unroll
            for (int j = 0; j < 2; ++j) { const bf16x8 xs = frag_rm(lds + STOFF, RS, 16 * (2 * half + j), k0, fr, fq); accC[j] = MFMA16(xs, yq, accC[j]); } }
        const int lrow = 16 * lt + fr;
#pragma unroll
        for (int j = 0; j < 2; ++j) { const int m0 = 16 * (2 * half + j) + 4 * fq; f32x4 s = accS[j];
#pragma unroll
            for (int r = 0; r < 4; ++r) s[r] = (m0 + r <= lrow) ? s[r] : 0.f;
            u32x2 w; w.x = pk2(s[0], s[1]); w.y = pk2(s[2], s[3]); *(LAS u32x2*)(lds + POFF + lrow * VS + m0 * 2) = w; }
        __syncthreads();
        f32x4 accO[2];
#pragma unroll
        for (int j = 0; j < 2; ++j) accO[j] = accC[j] * gam;
#pragma unroll
        for (int ks = 0; ks < 2; ++ks) { const int k0 = 32 * ks;
            const bf16x8 yp = frag_rm(lds + POFF, VS, 16 * lt, k0, fr, fq);
#pragma unroll
            for (int j = 0; j < 2; ++j) { const bf16x8 xv = frag_tr(lds + VOFF, VS, k0, 16 * (2 * half + j), fr, fq); accO[j] = MFMA16(xv, yp, accO[j]); } }
        if (lrow < c) {
#pragma unroll
            for (int j = 0; j < 2; ++j) { u32x2 w; w.x = pk2(accO[j][0], accO[j][1]); w.y = pk2(accO[j][2], accO[j][3]);
                *(u32x2*)(pin + (size_t)(n * 64 + lrow) * NPROJ + 4096 + h * 512 + es * 64 + 16 * (2 * half + j) + 4 * fq) = w; } }
#pragma unroll
        for (int i = 0; i < 8; ++i) accT[i] = accT[i] * gam;
#pragma unroll
        for (int ks = 0; ks < 2; ++ks) { const int k0 = 32 * ks;
            const bf16x8 yv = frag_tr(lds + VOFF, VS, k0, 16 * lt, fr, fq);
#pragma unroll
            for (int i = 0; i < 8; ++i) { const bf16x8 xk = frag_tr(lds + KOFF, RS, k0, 16 * (8 * half + i), fr, fq); accT[i] = MFMA16(xk, yv, accT[i]); } }
#pragma unroll
        for (int i = 0; i < 8; ++i) { accT[i] = accT[i] * gc1; const int d0 = 16 * (8 * half + i) + 4 * fq;
            u32x2 w; w.x = pk2(accT[i][0], accT[i][1]); w.y = pk2(accT[i][2], accT[i][3]); *(LAS u32x2*)(lds + STOFF + eT * RS + d0 * 2) = w; }
        __syncthreads();
    }
#undef RET_LOAD
#pragma unroll
    for (int i = 0; i < 8; ++i) { const int d0 = 16 * (8 * half + i) + 4 * fq;
#pragma unroll
        for (int r = 0; r < 4; ++r) Sout[(size_t)(d0 + r) * 512 + es * 64 + eT] = accT[i][r]; }
}
}
__device__ __forceinline__ void sample_attn(LAS char* lds, const bf16_t* QBp, const bf16_t* KALL, const bf16_t* VALL, const float* FS, bf16_t* AO) {
    const int tid = opaque_tid(), wid = __builtin_amdgcn_readfirstlane(tid >> 6), lane = tid & 63;
    LAS float* qf = (LAS float*)(lds + wid * 5120); LAS float* pf = qf + 128;
    const int gw = blockIdx.x * NWAVES + wid, NGW = gridDim.x * NWAVES;
    for (int item = gw; item < 8 * 16 * 32; item += NGW) {
        const int b = item >> 9, h = (item >> 5) & 15, qi = item & 31, kvh = h >> 2, qpos = PASTL + qi, row = TP + b * 32 + qi;
        const bf16_t* q = QBp + (size_t)row * DM + h * 128;
        qf[lane] = bf2f(q[lane]); qf[lane + 64] = bf2f(q[lane + 64]);
        asm volatile("s_waitcnt lgkmcnt(0)" ::: "memory");
        const float* F = FS + (size_t)(b * 16 + h) * LKS; const float Fq = F[qpos];
        const bf16_t* Kb = KALL + (size_t)b * LKS * 512 + kvh * 128; const bf16_t* Vb = VALL + (size_t)b * LKS * 512 + kvh * 128;
        float sc[17]; float mx = -1e30f;
#pragma unroll
        for (int t = 0; t < 17; ++t) { const int j = lane + 64 * t; float s = -__builtin_inff();
            if (j <= qpos) { const u32x4* kr = (const u32x4*)(Kb + (size_t)j * 512); float a = 0.f;
#pragma unroll 4
                for (int c8 = 0; c8 < 16; ++c8) { const u32x4 kv = kr[c8]; const LAS f32x4* qq = (const LAS f32x4*)(qf + 8 * c8); const f32x4 q0 = qq[0], q1 = qq[1];
                    a += __uint_as_float(kv.x << 16) * q0.x + __uint_as_float(kv.x & 0xffff0000u) * q0.y + __uint_as_float(kv.y << 16) * q0.z + __uint_as_float(kv.y & 0xffff0000u) * q0.w
                       + __uint_as_float(kv.z << 16) * q1.x + __uint_as_float(kv.z & 0xffff0000u) * q1.y + __uint_as_float(kv.w << 16) * q1.z + __uint_as_float(kv.w & 0xffff0000u) * q1.w; }
                s = a * 0.08838834764831845f + (Fq - F[j]); }
            sc[t] = s; mx = fmaxf(mx, s); }
#pragma unroll
        for (int o = 1; o < 64; o <<= 1) mx = fmaxf(mx, __shfl_xor(mx, o));
        float sum = 0.f;
#pragma unroll
        for (int t = 0; t < 17; ++t) { const float p = __expf(sc[t] - mx); sum += p; pf[lane + 64 * t] = p; }
        sum = wave_sum(sum);
        asm volatile("s_waitcnt lgkmcnt(0)" ::: "memory");
        float o0 = 0.f, o1 = 0.f;
        for (int j = 0; j <= qpos; ++j) { const float p = pf[j]; const unsigned vv = *(const unsigned*)(Vb + (size_t)j * 512 + 2 * lane);
            o0 += p * __uint_as_float(vv << 16); o1 += p * __uint_as_float(vv & 0xffff0000u); }
        const float inv = 1.0f / sum;
        *(unsigned*)(AO + (size_t)row * DM + h * 128 + 2 * lane) = pk2(o0 * inv, o1 * inv);
        asm volatile("s_waitcnt lgkmcnt(0)" ::: "memory");
    }
}

#define KARG(i) ((unsigned char*)(((const volatile __attribute__((address_space(4))) unsigned long long*)__builtin_amdgcn_kernarg_segment_ptr())[i]))
#define INF(i) ((const float*)KARG(i))
#define OUTP ((float*)KARG(21))
#define WSP (KARG(22))
#define BIGP (KARG(22) + WS_BIG)
#define PH_IDS const int tid = opaque_tid(), lane = tid & 63, wave = __builtin_amdgcn_readfirstlane(tid >> 6); const int G = gridDim.x, gw = blockIdx.x * NWAVES + wave, NGW = G * NWAVES; const size_t gt = (size_t)blockIdx.x * 512 + tid, NGT = (size_t)G * 512; (void)lane; (void)gw; (void)NGW; (void)gt; (void)NGT

__device__ __forceinline__ void ph_prologue(LAS unsigned char* lds) {
    PH_IDS; unsigned char* ws = WSP;
    bf16_t* WIN = (bf16_t*)(ws + WS_WIN); bf16_t* WRO = (bf16_t*)(ws + WS_WRO); bf16_t* WGU0 = (bf16_t*)(ws + WS_WGU0); bf16_t* WGU1 = (bf16_t*)(ws + WS_WGU1);
    bf16_t* WDN0 = (bf16_t*)(ws + WS_WDN0); bf16_t* WDN1 = (bf16_t*)(ws + WS_WDN1); bf16_t* WQ = (bf16_t*)(ws + WS_WQ); bf16_t* WO = (bf16_t*)(ws + WS_WO); bf16_t* WKVF = (bf16_t*)(ws + WS_WKVF);
    LAS float* scr = (LAS float*)(lds + wave * 16384);
    constexpr int I0 = 32 * 384, I1 = 64 * 64, IG = 32 * 176, ID = 88 * 64, IQ = 32 * 64, IK = 32 * 16;
    constexpr int NIT = I0 + I1 + 4 * IG + 2 * ID + 2 * IQ + 2 * IK;
    for (int it = gw; it < NIT; it += NGW) { int r = it;
        if (r < I0) { tr_plain(INF(10), DM, NPROJ, WIN, 0, scr, r, lane); continue; } r -= I0;
        if (r < I1) { tr_plain(INF(11), 4096, DM, WRO, 0, scr, r, lane); continue; } r -= I1;
        if (r < IG) { tr_gu(INF(18), WGU0, 0, scr, r, lane); continue; } r -= IG;
        if (r < IG) { tr_gu(INF(19), WGU0, 1, scr, r, lane); continue; } r -= IG;
        if (r < IG) { tr_gu(INF(18) + (size_t)DM * DFF, WGU1, 0, scr, r, lane); continue; } r -= IG;
        if (r < IG) { tr_gu(INF(19) + (size_t)DM * DFF, WGU1, 1, scr, r, lane); continue; } r -= IG;
        if (r < ID) { tr_plain(INF(20), DFF, DM, WDN0, 0, scr, r, lane); continue; } r -= ID;
        if (r < ID) { tr_plain(INF(20) + (size_t)DFF * DM, DFF, DM, WDN1, 0, scr, r, lane); continue; } r -= ID;
        if (r < IQ) { tr_plain(INF(16), DM, DM, WQ, 0, scr, r, lane); continue; } r -= IQ;
        if (r < IQ) { tr_plain(INF(17), DM, DM, WO, 0, scr, r, lane); continue; } r -= IQ;
        if (r < IK) { tr_plain(INF(12), DM, 512, WKVF, 0, scr, r, lane); continue; } r -= IK;
        tr_plain(INF(13), DM, 512, WKVF, 512, scr, r, lane);
    }
    { const float* wf = INF(14);
      for (size_t i = gt; i < (size_t)256 * DM; i += NGT) { const int r = (int)(i >> 11), k = (int)(i & 2047); WKVF[(size_t)(1024 + r) * DM + k] = r < 16 ? (bf16_t)(pk2(wf[k * 16 + r], 0.f) & 0xffffu) : (bf16_t)0; } }
    { float* COS = (float*)(ws + WS_COS); float* SIN = (float*)(ws + WS_SIN);
      for (size_t i = gt; i < (size_t)SEQ * 128; i += NGT) { const int pos = (int)(i >> 7), d = (int)(i & 127);
        const float inv = exp2f(-(float)d * (13.287712379549449f / 128.f));
        const double rev = (double)pos * (double)inv * 0.15915494309189535; const float fr = (float)(rev - __builtin_floor(rev));
        COS[i] = __builtin_amdgcn_cosf(fr); SIN[i] = __builtin_amdgcn_sinf(fr); } }
    { const float* x_p = INF(0); const float* x_s = INF(1); const float* nm = INF(6); bf16_t* XN0 = (bf16_t*)OUTP;
      for (int m = gw; m < TALL; m += NGW) rms_row<0>(m < TP ? x_p + (size_t)m * DM : x_s + (size_t)(m - TP) * DM, nm, XN0 + (size_t)m * DM, nullptr, nullptr, nullptr, lane); }
}
__device__ __forceinline__ void ph_retin(LAS unsigned char* lds) {
    unsigned char* ws = WSP;
    pg8::Gemm g{(const bf16_t*)OUTP, (const bf16_t*)(ws + WS_WIN), TALL, NPROJ, DM, DM}; pg8::StaticOrder S; S.init(TALL, NPROJ, (int)gridDim.x, (int)blockIdx.x);
    pg8::EpiRetIn E{(bf16_t*)(ws + WS_BIG), (const float*)(ws + WS_COS), (const float*)(ws + WS_SIN)};
    pg8::gemm_phase<pg8::EpiRetIn, pg8::StaticOrder, true, true>(lds, g, S, E);
}
__device__ __forceinline__ void ph_retention(LAS unsigned char* lds) {
    const int G = gridDim.x;
    for (int it = blockIdx.x; it < 256; it += G) { const int bh = (it & 7) * 4 + (it >> 6), es = (it >> 3) & 7, b = bh >> 3, h = bh & 7;
        ret::ret_item((LAS char*)lds, (bf16_t*)BIGP + (size_t)b * SEQ * NPROJ, 128, 64, h, es, nullptr, OUTP + OUT_SP + (size_t)(b * 8 + h) * 256 * 512); }
    for (int it = blockIdx.x; it < 512; it += G) { const int bh = (it & 7) * 8 + (it >> 6), es = (it >> 3) & 7, b = bh >> 3, h = bh & 7;
        ret::ret_item((LAS char*)lds, (bf16_t*)BIGP + (size_t)(TP + b * 32) * NPROJ, 1, 32, h, es, INF(2) + (size_t)(b * 8 + h) * 256 * 512, OUTP + OUT_SS + (size_t)(b * 8 + h) * 256 * 512); }
}
__device__ __forceinline__ void ph_groupnorm() {
    PH_IDS; bf16_t* PROJ = (bf16_t*)BIGP;
    for (int it = gw; it < TALL * 8; it += NGW) { const int row = it >> 3, h = it & 7;
        bf16_t* op = PROJ + (size_t)row * NPROJ + 4096 + h * 512 + lane * 8; const u32x4 ov = *(const u32x4*)op, gv = *(const u32x4*)(op + 4096);
        float o[8], g[8]; const unsigned ow[4] = {ov.x, ov.y, ov.z, ov.w}, gwd[4] = {gv.x, gv.y, gv.z, gv.w};
#pragma unroll
        for (int j = 0; j < 4; ++j) { o[2 * j] = __uint_as_float(ow[j] << 16); o[2 * j + 1] = __uint_as_float(ow[j] & 0xffff0000u); g[2 * j] = __uint_as_float(gwd[j] << 16); g[2 * j + 1] = __uint_as_float(gwd[j] & 0xffff0000u); }
        float s = 0.f;
#pragma unroll
        for (int j = 0; j < 8; ++j) s += o[j];
        const float mu = wave_sum(s) * (1.f / 512.f); float q = 0.f;
#pragma unroll
        for (int j = 0; j < 8; ++j) { o[j] -= mu; q += o[j] * o[j]; }
        const float rstd = 1.0f / sqrtf(wave_sum(q) * (1.f / 512.f) + 1e-5f);
#pragma unroll
        for (int j = 0; j < 8; ++j) o[j] = o[j] * rstd * pg8::silu_f(g[j]);
        u32x4 w; w.x = pk2(o[0], o[1]); w.y = pk2(o[2], o[3]); w.z = pk2(o[4], o[5]); w.w = pk2(o[6], o[7]); *(u32x4*)op = w; }
}
template <bool FIRST> __device__ __forceinline__ void ph_res_gemm(LAS unsigned char* lds, size_t a_off, size_t w_off, int K, int lda) {
    unsigned char* ws = WSP; float* Hres = OUTP + OUT_Y;
    pg8::Gemm g{(const bf16_t*)(ws + a_off), (const bf16_t*)(ws + w_off), TALL, DM, K, lda}; pg8::StaticOrder S; S.init(TALL, DM, (int)gridDim.x, (int)blockIdx.x);
    pg8::EpiRes E{FIRST ? INF(0) : Hres, FIRST ? INF(1) : Hres + (size_t)TP * DM, Hres};
    pg8::gemm_phase<pg8::EpiRes, pg8::StaticOrder, true, true>(lds, g, S, E);
}
template <int MODE> __device__ __forceinline__ void ph_rms(const float* g1, size_t o1_off, const float* g2, size_t o2_off) {
    PH_IDS; float* Hres = OUTP + OUT_Y; unsigned char* ws = WSP;
    for (int m = gw; m < TALL; m += NGW) rms_row<MODE>(Hres + (size_t)m * DM, g1, (bf16_t*)(ws + o1_off) + (size_t)m * DM, g2, (bf16_t*)(ws + o2_off) + (size_t)m * DM, Hres + (size_t)m * DM, lane);
}
__device__ __forceinline__ void ph_cache_cvt() {
    PH_IDS; const float* cache_k = INF(3); const float* cache_v = INF(4); bf16_t* KALL = (bf16_t*)(BIGP + BIG_KALL); bf16_t* VALL = (bf16_t*)(BIGP + BIG_VALL);
    for (size_t i = gt; i < (size_t)8 * PASTL * 512 / 4; i += NGT) { const size_t e = i * 4, b = e / ((size_t)PASTL * 512), r = e % ((size_t)PASTL * 512);
        const f32x4 kv = *(const f32x4*)(cache_k + e), vv = *(const f32x4*)(cache_v + e); u32x2 w; w.x = pk2(kv.x, kv.y); w.y = pk2(kv.z, kv.w); *(u32x2*)(KALL + b * LKS * 512 + r) = w;
        w.x = pk2(vv.x, vv.y); w.y = pk2(vv.z, vv.w); *(u32x2*)(VALL + b * LKS * 512 + r) = w; }
}
__device__ __forceinline__ void ph_kvf(LAS unsigned char* lds) {
    unsigned char* ws = WSP; unsigned char* big = ws + WS_BIG; float* out = OUTP;
    pg8::Gemm g{(const bf16_t*)(big + BIG_HKV), (const bf16_t*)(ws + WS_WKVF), TALL, 1280, DM, DM}; pg8::StaticOrder S; S.init(TALL, 1280, (int)gridDim.x, (int)blockIdx.x);
    pg8::EpiKVF E{out + OUT_KP, out + OUT_VP, out + OUT_LFP, out + OUT_KS, out + OUT_VS, out + OUT_LFS, (bf16_t*)(big + BIG_KB), (bf16_t*)(big + BIG_VB), (bf16_t*)(big + BIG_KALL), (bf16_t*)(big + BIG_VALL), INF(15)};
    pg8::gemm_phase<pg8::EpiKVF, pg8::StaticOrder, true, true>(lds, g, S, E);
}
__device__ __forceinline__ void ph_q(LAS unsigned char* lds) {
    unsigned char* ws = WSP; unsigned char* big = ws + WS_BIG;
    pg8::Gemm g{(const bf16_t*)(big + BIG_XN), (const bf16_t*)(ws + WS_WQ), TALL, DM, DM, DM}; pg8::StaticOrder S; S.init(TALL, DM, (int)gridDim.x, (int)blockIdx.x);
    pg8::EpiBf16P E{(bf16_t*)(big + BIG_ACT), DM};
    pg8::gemm_phase<pg8::EpiBf16P, pg8::StaticOrder, true, true>(lds, g, S, E);
}
__device__ __forceinline__ void ph_cumsum(LAS unsigned char* lds) {
    PH_IDS; const float* cache_lf = INF(5); const float* out = OUTP; float* FB = (float*)(WSP + WS_FB); float* FS = (float*)(WSP + WS_FS);
    for (int it = blockIdx.x; it < 64 + 128; it += G) {
        LAS float* wtot = (LAS float*)lds;
        const bool smp = it >= 64; const int bh = smp ? it - 64 : it, b = bh >> 4, h = bh & 15, Ls = smp ? LKS : SEQ, per = smp ? 3 : 16, j0 = tid * per;
        float v[16]; float s = 0.f;
#pragma unroll
        for (int i = 0; i < 16; ++i) { const int j = j0 + i; float x = 0.f;
            if (i < per && j < Ls) x = smp ? (j < PASTL ? cache_lf[((size_t)b * PASTL + j) * 16 + h] : out[OUT_LFS + ((size_t)b * 32 + (j - PASTL)) * 16 + h]) : out[OUT_LFP + ((size_t)b * SEQ + j) * 16 + h];
            s += x; v[i] = s; }
        float inc = s;
#pragma unroll
        for (int o = 1; o < 64; o <<= 1) { const float t = __shfl_up(inc, o); if (lane >= o) inc += t; }
        if (lane == 63) wtot[wave] = inc;
        __syncthreads();
        float base = inc - s;
        for (int w = 0; w < wave; ++w) base += wtot[w];
#pragma unroll
        for (int i = 0; i < 16; ++i) { const int j = j0 + i; if (i < per && j < Ls) { const float F = base + v[i];
            if (smp) FS[(size_t)bh * LKS + j] = F; else FB[(size_t)bh * SEQ + j] = -F * 11.313708498984761f; } }
        __syncthreads();
    }
}
__device__ __forceinline__ void ph_attn(unsigned char* lds_raw) {
    unsigned char* ws = WSP; unsigned char* big = ws + WS_BIG;
    fox::attn_phase((char*)lds_raw, (const bf16_t*)(big + BIG_ACT), (const bf16_t*)(big + BIG_KB), (const bf16_t*)(big + BIG_VB), (bf16_t*)(big + BIG_XN), (const float*)(ws + WS_FB));
}
__device__ __forceinline__ void ph_sattn(LAS unsigned char* lds) {
    unsigned char* ws = WSP; unsigned char* big = ws + WS_BIG;
    sample_attn((LAS char*)lds, (const bf16_t*)(big + BIG_ACT), (const bf16_t*)(big + BIG_KALL), (const bf16_t*)(big + BIG_VALL), (const float*)(ws + WS_FS), (bf16_t*)(big + BIG_XN));
}
__device__ __forceinline__ void ph_gateup(LAS unsigned char* lds, size_t w_off) {
    unsigned char* ws = WSP; unsigned char* big = ws + WS_BIG;
    pg8::Gemm g{(const bf16_t*)(big + BIG_XN), (const bf16_t*)(ws + w_off), TALL, 2 * DFF, DM, DM}; pg8::StaticOrder S; S.init(TALL, 2 * DFF, (int)gridDim.x, (int)blockIdx.x);
    pg8::EpiSwiglu E{(bf16_t*)(big + BIG_ACT)};
    pg8::gemm_phase<pg8::EpiSwiglu, pg8::StaticOrder, true, true>(lds, g, S, E);
}

__global__ void __launch_bounds__(NWAVES * 64, 2) yoco_fwd(Params P) {
    extern __shared__ __attribute__((aligned(16))) unsigned char lds_raw[];
    cg::grid_group grid = cg::this_grid();
    LAS unsigned char* lds = (LAS unsigned char*)lds_raw;
    ph_prologue(lds);                                                        grid.sync();
    ph_retin(lds);                                                           grid.sync();
    ph_retention(lds);                                                       grid.sync();
    ph_groupnorm();                                                          grid.sync();
    ph_res_gemm<true>(lds, WS_BIG + 4096 * 2, WS_WRO, 4096, NPROJ);          grid.sync();
    ph_rms<0>(INF(7), WS_BIG + BIG_XN, nullptr, 0);                          grid.sync();
    ph_gateup(lds, WS_WGU0);                                                 grid.sync();
    ph_res_gemm<false>(lds, WS_BIG + BIG_ACT, WS_WDN0, DFF, DFF);            grid.sync();
    ph_rms<1>(INF(8), WS_BIG + BIG_HKV, INF(6) + DM, WS_BIG + BIG_XN); ph_cache_cvt();   grid.sync();
    ph_kvf(lds); ph_q(lds);                                                  grid.sync();
    ph_cumsum(lds);                                                          grid.sync();
    ph_attn(lds_raw); __syncthreads(); ph_sattn(lds);                        grid.sync();
    ph_res_gemm<false>(lds, WS_BIG + BIG_XN, WS_WO, DM, DM);                 grid.sync();
    ph_rms<0>(INF(7) + DM, WS_BIG + BIG_XN, nullptr, 0);                     grid.sync();
    ph_gateup(lds, WS_WGU1);                                                 grid.sync();
    ph_res_gemm<false>(lds, WS_BIG + BIG_ACT, WS_WDN1, DFF, DFF);            grid.sync();
    ph_rms<2>(INF(9), 0, nullptr, 0);
}

extern "C" void kernel_launch(void* const* d_in, const int* in_sizes, int n_in, void* d_out, int out_size, void* d_ws, size_t ws_size, hipStream_t stream) {
    static int grid = 0;
    if (grid == 0) {
        if (n_in != 21 || ws_size < WS_END) { fprintf(stderr, "kernel_launch: unexpected n_in %d / ws_size %zu (need %zu)\n", n_in, ws_size, (size_t)WS_END); grid = -1; return; }
        int dev = 0, cus = 0, per_cu = 0;
        (void)hipGetDevice(&dev); (void)hipDeviceGetAttribute(&cus, hipDeviceAttributeMultiprocessorCount, dev);
        if (hipFuncSetAttribute((const void*)yoco_fwd, hipFuncAttributeMaxDynamicSharedMemorySize, LDS_BYTES) != hipSuccess) { fprintf(stderr, "kernel_launch: hipFuncSetAttribute failed\n"); grid = -1; return; }
        if (hipOccupancyMaxActiveBlocksPerMultiprocessor(&per_cu, (const void*)yoco_fwd, NWAVES * 64, LDS_BYTES) != hipSuccess || per_cu < 1) { fprintf(stderr, "kernel_launch: occupancy query says %d\n", per_cu); per_cu = 1; }
        (void)hipGetLastError();
        grid = cus > 0 ? cus : 256;
    }
    if (grid < 0) return;
    Params p{};
    for (int i = 0; i < 21; ++i) p.in[i] = (const float*)d_in[i];
    p.out = (float*)d_out; p.ws = (unsigned char*)d_ws;
    void* args[] = {&p};
    hipError_t e = hipLaunchCooperativeKernel((const void*)yoco_fwd, dim3(grid), dim3(NWAVES * 64), args, LDS_BYTES, stream);
    if (e != hipSuccess) fprintf(stderr, "cooperative launch failed: %s (grid %d)\n", hipGetErrorString(e), grid);
}
```

```cpp
#include <hip/hip_runtime.h>
#include <hip/hip_cooperative_groups.h>
#include <cstdio>
#include <cstdint>
namespace cg = cooperative_groups;
__device__ __forceinline__ int opaque_tid() { int t = threadIdx.x; asm volatile("" : "+v"(t)); return t; }
namespace pg8 {
#define PG8_LAS __attribute__((address_space(3)))
typedef unsigned short bf16_t;
typedef short bf16x8 __attribute__((ext_vector_type(8)));
typedef float f32x4 __attribute__((ext_vector_type(4)));
typedef unsigned u32x4 __attribute__((ext_vector_type(4)));
constexpr int BM = 256, BK = 64, HALF = 128, HTB = HALF * BK * 2  , STAGE_BYTES = 8 * HTB, NXCD = 8, WGM = 8;

__host__ __device__ __forceinline__ int lds_byte(int r, int c) { const int st = (r >> 4) * 2 + (c >> 5), rr = r & 15, cc = c & 31, ob = rr * 64 + cc * 2; return st * 1024 + (ob ^ (((ob >> 9) & 1) << 5)); }
__host__ __device__ __forceinline__ void stage_rc(int b, int& R, int& C) { const int st = b / 1024, sb = b % 1024, swz = sb ^ (((sb >> 9) & 1) << 5); R = (st >> 1) * 16 + swz / 64; C = (st & 1) * 32 + (swz % 64) / 2; }
__host__ __device__ __forceinline__ int perm32(int rho) { const int n = rho >> 4, i = rho & 15; return 8 * (i >> 2) + 4 * n + (i & 3); }

struct Unit { int pm, pn; };
struct Gemm { const bf16_t* A; const bf16_t* Bt; int M, N, K, lda; };

struct StaticOrder {
    int nM, nN, nwg, G, c;
    __host__ __device__ void init(int M, int N, int G_, int c_) { nM = M / BM; nN = N / BM; nwg = nM * nN; G = G_; c = c_; }
    __host__ __device__ bool next(int i, Unit& u) const {
        const long L = (long)i * G + c; if (L >= nwg) return false;
        int wgid = (int)L; { const int q = nwg / NXCD, r = nwg % NXCD, xcd = wgid % NXCD, off = wgid / NXCD; wgid = (xcd < r ? xcd * (q + 1) : r * (q + 1) + (xcd - r) * q) + off; }
        const int nig = WGM * nN, gid = wgid / nig, fm = gid * WGM, gsz = (nM - fm) < WGM ? (nM - fm) : WGM;
        u.pm = fm + ((wgid % nig) % gsz); u.pn = (wgid % nig) / gsz; return true;
    }
    __device__ __forceinline__ void a_ready(const Unit&) const {}
    __device__ __forceinline__ void done(const Unit&) const {}
};

__device__ __forceinline__ unsigned cvt_pk_bf16(float lo, float hi) { unsigned r; asm volatile("v_cvt_pk_bf16_f32 %0, %1, %2" : "=v"(r) : "v"(lo), "v"(hi)); return r; }
template <class Epi, class Sched, bool ALIGN_EPI = false, bool SP2 = false>
__device__ __forceinline__ void gemm_phase(PG8_LAS unsigned char* lds, const Gemm g, const Sched& S, const Epi& E) {
    const int tid = opaque_tid(), wid = __builtin_amdgcn_readfirstlane(tid >> 6), lane = tid & 63, wr = wid >> 2, wc = wid & 3, fr = lane & 15, fq = lane >> 4;
    const int K = g.K, nt = K / BK;
    unsigned voffA[2], voffB[2];
#pragma unroll
    for (int i = 0; i < 2; ++i) { int R, C; stage_rc(tid * 16 + i * 8192, R, C); const int Rb = Epi::PERM ? ((R & ~31) + perm32(R & 31)) : R;
        voffA[i] = (unsigned)(R * g.lda + C) * 2u; voffB[i] = (unsigned)(Rb * K + C) * 2u; }
    const size_t kstep = (size_t)(BK * 2);
    const size_t hstep = (size_t)HALF * K * 2, hstepA = (size_t)HALF * g.lda * 2;
    const size_t tstep = 2 * hstep, tstepA = 2 * hstepA;
    const unsigned ldsw = (unsigned)wid * 1024u;
    const int aoff = lds_byte(wr * 64 + fr, fq * 8), boff = lds_byte(wc * 32 + fr, fq * 8);
#define PG8_SA(b, h) (((b) * 2 + (h)) * HTB)
#define PG8_SB(b, h) ((4 + (b) * 2 + (h)) * HTB)
#define PG8_STAGE(bufoff, gbase, voff) do { _Pragma("unroll") for (int _i = 0; _i < 2; ++_i) \
        __builtin_amdgcn_global_load_lds((const unsigned*)((const char*)(gbase) + (voff)[_i]), (PG8_LAS unsigned*)(lds + (bufoff) + ldsw + _i * 8192), 16, 0, 0); } while (0)
#define PG8_LDA(dst, b, h) do { _Pragma("unroll") for (int m = 0; m < 4; ++m) _Pragma("unroll") for (int k = 0; k < 2; ++k) dst[m][k] = *(const PG8_LAS bf16x8*)(lds + PG8_SA(b, h) + aoff + m * 2048 + k * 1024); } while (0)
#define PG8_LDB(dst, b, h) do { _Pragma("unroll") for (int n = 0; n < 2; ++n) _Pragma("unroll") for (int k = 0; k < 2; ++k) dst[n][k] = *(const PG8_LAS bf16x8*)(lds + PG8_SB(b, h) + boff + n * 2048 + k * 1024); } while (0)
#define PG8_MMA(ai, bj, At, Bt) do { __builtin_amdgcn_s_setprio(1); _Pragma("unroll") for (int m = 0; m < 4; ++m) _Pragma("unroll") for (int n = 0; n < 2; ++n) _Pragma("unroll") for (int k = 0; k < 2; ++k) \
        acc[ai][bj][m][n] = __builtin_amdgcn_mfma_f32_16x16x32_bf16(Bt[n][k], At[m][k], acc[ai][bj][m][n], 0, 0, 0); __builtin_amdgcn_s_setprio(0); } while (0)
#define PG8_WAIT_V(n) asm volatile("s_waitcnt vmcnt(" #n ")" ::: "memory")
#define PG8_WAIT_L(n) asm volatile("s_waitcnt lgkmcnt(" #n ")" ::: "memory")
#define PG8_BAR __builtin_amdgcn_s_barrier()
#define PG8_SCHED __builtin_amdgcn_sched_barrier(0)
    Unit cur, nxt; int ui = 0;
    if (!S.next(0, cur)) return;
    f32x4 acc[2][2][4][2];
#pragma unroll
    for (int a = 0; a < 2; ++a)
#pragma unroll
        for (int b = 0; b < 2; ++b)
#pragma unroll
            for (int m = 0; m < 4; ++m)
#pragma unroll
                for (int n = 0; n < 2; ++n) acc[a][b][m][n] = (f32x4){0.f, 0.f, 0.f, 0.f};
    bf16x8 At[4][2], B0[2][2], B1[2][2];
    const char* cA = (const char*)g.A + (size_t)cur.pm * tstepA; const char* cB = (const char*)g.Bt + (size_t)cur.pn * tstep;
    S.a_ready(cur);
    if constexpr (SP2) {
        PG8_STAGE(PG8_SB(0, 0), cB, voffB); PG8_STAGE(PG8_SB(0, 1), cB + hstep, voffB); PG8_STAGE(PG8_SA(0, 0), cA, voffA); PG8_STAGE(PG8_SA(0, 1), cA + hstepA, voffA);
        if (wr == 1) PG8_BAR;
        PG8_WAIT_V(2); PG8_BAR;
        PG8_STAGE(PG8_SB(1, 0), cB + kstep, voffB); PG8_STAGE(PG8_SA(1, 0), cA + kstep, voffA); PG8_STAGE(PG8_SB(1, 1), cB + hstep + kstep, voffB);
        PG8_WAIT_V(6); PG8_BAR;
    } else {
        PG8_STAGE(PG8_SB(0, 0), cB, voffB); PG8_STAGE(PG8_SA(0, 0), cA, voffA); PG8_STAGE(PG8_SB(0, 1), cB + hstep, voffB); PG8_STAGE(PG8_SA(0, 1), cA + hstepA, voffA);
        if (wr == 1) PG8_BAR;
        PG8_WAIT_V(4); PG8_BAR;
        PG8_STAGE(PG8_SB(1, 0), cB + kstep, voffB); PG8_STAGE(PG8_SA(1, 0), cA + kstep, voffA); PG8_STAGE(PG8_SB(1, 1), cB + hstep + kstep, voffB);
        PG8_WAIT_V(6); PG8_BAR;
    }
    for (;;) {
        const bool has_next = S.next(ui + 1, nxt);
        const char* nA = has_next ? (const char*)g.A + (size_t)nxt.pm * tstepA : cA; const char* nB = has_next ? (const char*)g.Bt + (size_t)nxt.pn * tstep : cB;
        for (int t = 0; t < nt; t += 2) {
            const bool last = (t == nt - 2);
            const char* a1 = cA + (size_t)(t + 1) * kstep;
            const char* a2 = last ? nA : cA + (size_t)(t + 2) * kstep; const char* b2 = last ? nB : cB + (size_t)(t + 2) * kstep;
            const char* a3 = a2 + kstep; const char* b3 = b2 + kstep;
            if (last && has_next) S.a_ready(nxt);
            if constexpr (SP2) {
            PG8_LDB(B0, 0, 0); PG8_LDB(B1, 0, 1); PG8_SCHED; PG8_LDA(At, 0, 0); PG8_STAGE(PG8_SA(1, 1), a1 + hstepA, voffA);
            PG8_WAIT_V(8); PG8_WAIT_L(0); PG8_BAR; PG8_MMA(0, 0, At, B0); PG8_MMA(0, 1, At, B1); PG8_BAR; PG8_SCHED;
            PG8_LDA(At, 0, 1); PG8_STAGE(PG8_SB(0, 0), b2, voffB); PG8_STAGE(PG8_SB(0, 1), b2 + hstep, voffB); PG8_STAGE(PG8_SA(0, 0), a2, voffA);
            PG8_WAIT_V(8); PG8_WAIT_L(0); PG8_BAR; PG8_MMA(1, 0, At, B0); PG8_MMA(1, 1, At, B1); PG8_BAR; PG8_SCHED;
            PG8_LDB(B0, 1, 0); PG8_LDB(B1, 1, 1); PG8_SCHED; PG8_LDA(At, 1, 0); PG8_STAGE(PG8_SA(0, 1), a2 + hstepA, voffA);
            PG8_WAIT_V(8); PG8_WAIT_L(0); PG8_BAR; PG8_MMA(0, 0, At, B0); PG8_MMA(0, 1, At, B1); PG8_BAR; PG8_SCHED;
            PG8_LDA(At, 1, 1); PG8_STAGE(PG8_SB(1, 0), b3, voffB); PG8_STAGE(PG8_SB(1, 1), b3 + hstep, voffB); PG8_STAGE(PG8_SA(1, 0), a3, voffA);
            PG8_WAIT_V(8); PG8_WAIT_L(0); PG8_BAR; PG8_MMA(1, 0, At, B0); PG8_MMA(1, 1, At, B1); PG8_BAR; PG8_SCHED;
            } else {
            PG8_LDB(B0, 0, 0); PG8_SCHED; PG8_LDA(At, 0, 0); PG8_STAGE(PG8_SA(1, 1), a1 + hstepA, voffA);
            PG8_WAIT_L(8); PG8_BAR; PG8_WAIT_L(0); PG8_MMA(0, 0, At, B0); PG8_BAR; PG8_SCHED;
            PG8_LDB(B1, 0, 1); PG8_STAGE(PG8_SB(0, 0), b2, voffB);
            PG8_BAR; PG8_WAIT_L(0); PG8_MMA(0, 1, At, B1); PG8_BAR;
            PG8_LDA(At, 0, 1); PG8_STAGE(PG8_SA(0, 0), a2, voffA);
            PG8_BAR; PG8_WAIT_L(0); PG8_MMA(1, 0, At, B0); PG8_BAR; PG8_SCHED;
            PG8_STAGE(PG8_SB(0, 1), b2 + hstep, voffB);
            PG8_WAIT_V(6); PG8_BAR; PG8_MMA(1, 1, At, B1); PG8_BAR;
            PG8_LDB(B0, 1, 0); PG8_SCHED; PG8_LDA(At, 1, 0); PG8_STAGE(PG8_SA(0, 1), a2 + hstepA, voffA);
            PG8_WAIT_L(8); PG8_BAR; PG8_WAIT_L(0); PG8_MMA(0, 0, At, B0); PG8_BAR; PG8_SCHED;
            PG8_LDB(B1, 1, 1); PG8_STAGE(PG8_SB(1, 0), b3, voffB);
            PG8_BAR; PG8_WAIT_L(0); PG8_MMA(0, 1, At, B1); PG8_BAR;
            PG8_LDA(At, 1, 1); PG8_STAGE(PG8_SA(1, 0), a3, voffA);
            PG8_BAR; PG8_WAIT_L(0); PG8_MMA(1, 0, At, B0); PG8_BAR; PG8_SCHED;
            PG8_STAGE(PG8_SB(1, 1), b3 + hstep, voffB);
            PG8_WAIT_V(6); PG8_BAR; PG8_MMA(1, 1, At, B1); PG8_BAR;
            }
        }
        if constexpr (ALIGN_EPI) { if (wr == 0) PG8_BAR; }
        if constexpr (!Epi::AFTER_DRAIN) { E(acc, cur, wr, wc, fr, fq); S.done(cur); }
        if (!has_next) break;
#pragma unroll
        for (int a = 0; a < 2; ++a)
#pragma unroll
            for (int b = 0; b < 2; ++b)
#pragma unroll
                for (int m = 0; m < 4; ++m)
#pragma unroll
                    for (int n = 0; n < 2; ++n) acc[a][b][m][n] = (f32x4){0.f, 0.f, 0.f, 0.f};
        cur = nxt; cA = nA; cB = nB; ++ui;
        if constexpr (ALIGN_EPI) { if (wr == 1) PG8_BAR; }
    }
    PG8_WAIT_V(0);
    if constexpr (!ALIGN_EPI) { if (wr == 0) PG8_BAR; }
    PG8_BAR;
    if constexpr (Epi::AFTER_DRAIN) { E.fused(acc, cur, wr, wc, fr, fq, lds, wid, lane); S.done(cur); }
#undef PG8_SA
#undef PG8_SB
#undef PG8_STAGE
#undef PG8_LDA
#undef PG8_LDB
#undef PG8_MMA
#undef PG8_WAIT_V
#undef PG8_WAIT_L
#undef PG8_BAR
#undef PG8_SCHED
}
}
constexpr int DM = 2048, TP = 32768, TSMP = 256, TALL = 33024, SEQ = 8192, NPROJ = 12288, DFF = 5632, PASTL = 1024, LKS = 1056;
#define GAS __attribute__((address_space(1)))
#define LAS __attribute__((address_space(3)))
typedef unsigned short bf16_t;
typedef float f32x4 __attribute__((ext_vector_type(4)));
typedef unsigned u32x4 __attribute__((ext_vector_type(4)));
typedef unsigned u32x2 __attribute__((ext_vector_type(2)));
typedef short bf16x8 __attribute__((ext_vector_type(8)));
typedef short s16x4 __attribute__((ext_vector_type(4)));

namespace pg8 {
__device__ __forceinline__ float silu_f(float g) { return g * __builtin_amdgcn_rcpf(1.0f + __builtin_amdgcn_exp2f(-1.4426950408889634f * g)); }
struct EpiBf16P {
    static constexpr bool PERM = true, AFTER_DRAIN = false;
    bf16_t* O; int ldc;
    __device__ __forceinline__ void operator()(const f32x4 (&acc)[2][2][4][2], const Unit& u, int wr, int wc, int fr, int fq) const {
        const int row0 = u.pm * BM + wr * 64 + fr, col0 = u.pn * BM + wc * 32 + 8 * fq;
#pragma unroll
        for (int ai = 0; ai < 2; ++ai)
#pragma unroll
            for (int m = 0; m < 4; ++m) { bf16_t* rowp = O + (size_t)(row0 + ai * HALF + m * 16) * ldc + col0;
#pragma unroll
                for (int bj = 0; bj < 2; ++bj) { const f32x4 v0 = acc[ai][bj][m][0], v1 = acc[ai][bj][m][1];
                    u32x4 w; w.x = cvt_pk_bf16(v0[0], v0[1]); w.y = cvt_pk_bf16(v0[2], v0[3]); w.z = cvt_pk_bf16(v1[0], v1[1]); w.w = cvt_pk_bf16(v1[2], v1[3]);
                    *(u32x4*)(rowp + bj * HALF) = w; } }
    }
};
struct EpiRetIn {
    static constexpr bool PERM = true, AFTER_DRAIN = false;
    bf16_t* O; const float* cosT; const float* sinT;
    __device__ __forceinline__ void operator()(const f32x4 (&acc)[2][2][4][2], const Unit& u, int wr, int wc, int fr, int fq) const {
        const int row0 = u.pm * BM + wr * 64 + fr, cl = wc * 32 + 8 * fq;
        bf16_t* obase = O + (size_t)u.pn * BM + cl;
        if (u.pn < 16) {
            const bool isk = u.pn >= 8; const int h = u.pn & 7;
            const float lg2 = __log2f(1.0f - exp2f(-5.0f - (float)h));
#pragma unroll
            for (int ai = 0; ai < 2; ++ai) {
                f32x4 cs[4][4]; float scv[4];
#pragma unroll
                for (int m = 0; m < 4; ++m) {
                    const int row = row0 + ai * HALF + m * 16; int pos, l;
                    if (row < TP) { pos = row & (SEQ - 1); l = row & 63; } else { const int s = (row - TP) & 31; pos = PASTL + s; l = s; }
                    scv[m] = isk ? exp2f(-lg2 * (float)l) * 0.0625f : exp2f(lg2 * (float)l);
                    const float* cp = cosT + (size_t)pos * 128 + cl; const float* sp = sinT + (size_t)pos * 128 + cl;
                    cs[m][0] = *(const f32x4*)cp; cs[m][1] = *(const f32x4*)(cp + 4); cs[m][2] = *(const f32x4*)sp; cs[m][3] = *(const f32x4*)(sp + 4); }
#pragma unroll
                for (int m = 0; m < 4; ++m) {
                    const int row = row0 + ai * HALF + m * 16; const float sc = scv[m];
                    const f32x4 c0 = cs[m][0], c1 = cs[m][1], s0 = cs[m][2], s1 = cs[m][3];
                    const f32x4 x1a = acc[ai][0][m][0], x1b = acc[ai][0][m][1], x2a = acc[ai][1][m][0], x2b = acc[ai][1][m][1];
                    const f32x4 o1a = (x1a * c0 - x2a * s0) * sc, o1b = (x1b * c1 - x2b * s1) * sc, o2a = (x1a * s0 + x2a * c0) * sc, o2b = (x1b * s1 + x2b * c1) * sc;
                    bf16_t* rowp = obase + (size_t)row * NPROJ;
                    u32x4 w; w.x = cvt_pk_bf16(o1a[0], o1a[1]); w.y = cvt_pk_bf16(o1a[2], o1a[3]); w.z = cvt_pk_bf16(o1b[0], o1b[1]); w.w = cvt_pk_bf16(o1b[2], o1b[3]);
                    *(u32x4*)rowp = w;
                    w.x = cvt_pk_bf16(o2a[0], o2a[1]); w.y = cvt_pk_bf16(o2a[2], o2a[3]); w.z = cvt_pk_bf16(o2b[0], o2b[1]); w.w = cvt_pk_bf16(o2b[2], o2b[3]);
                    *(u32x4*)(rowp + HALF) = w; }
                asm volatile("" ::: "memory"); }
        } else {
#pragma unroll
            for (int ai = 0; ai < 2; ++ai)
#pragma unroll
                for (int m = 0; m < 4; ++m) { bf16_t* rowp = obase + (size_t)(row0 + ai * HALF + m * 16) * NPROJ;
#pragma unroll
                    for (int bj = 0; bj < 2; ++bj) { const f32x4 v0 = acc[ai][bj][m][0], v1 = acc[ai][bj][m][1];
                        u32x4 w; w.x = cvt_pk_bf16(v0[0], v0[1]); w.y = cvt_pk_bf16(v0[2], v0[3]); w.z = cvt_pk_bf16(v1[0], v1[1]); w.w = cvt_pk_bf16(v1[2], v1[3]);
                        *(u32x4*)(rowp + bj * HALF) = w; } }
        }
    }
};
struct EpiRes {
    static constexpr bool PERM = false, AFTER_DRAIN = false;
    const float* baseP; const float* baseS; float* out; bf16_t* hb; float* ssq;
    __device__ __forceinline__ void operator()(const f32x4 (&acc)[2][2][4][2], const Unit& u, int wr, int wc, int fr, int fq) const {
        const int row0 = u.pm * BM + wr * 64 + fr, col0 = u.pn * BM + wc * 32 + 4 * fq;
#pragma unroll
        for (int ai = 0; ai < 2; ++ai) {
            f32x4 bv[4][2][2];
#pragma unroll
            for (int m = 0; m < 4; ++m) { const int row = row0 + ai * HALF + m * 16;
                const float* b = (row < TP ? baseP + (size_t)row * DM : baseS + (size_t)(row - TP) * DM) + col0;
#pragma unroll
                for (int bj = 0; bj < 2; ++bj)
#pragma unroll
                    for (int n = 0; n < 2; ++n) bv[m][bj][n] = *(const f32x4*)(b + bj * HALF + n * 16); }
#pragma unroll
            for (int m = 0; m < 4; ++m) { const int row = row0 + ai * HALF + m * 16; float* o = out + (size_t)row * DM + col0; float ss = 0.f;
#pragma unroll
                for (int bj = 0; bj < 2; ++bj)
#pragma unroll
                    for (int n = 0; n < 2; ++n) { const f32x4 v = bv[m][bj][n] + acc[ai][bj][m][n]; *(f32x4*)(o + bj * HALF + n * 16) = v;
                        if (hb) { u32x2 w; w.x = cvt_pk_bf16(v[0], v[1]); w.y = cvt_pk_bf16(v[2], v[3]); *(u32x2*)(hb + (size_t)row * DM + col0 + bj * HALF + n * 16) = w; }
                        ss += (v[0] * v[0] + v[1] * v[1]) + (v[2] * v[2] + v[3] * v[3]); }
                if (ssq) { ss += __shfl_xor(ss, 16); ss += __shfl_xor(ss, 32);
                    if (fq == 0) (void)__hip_atomic_fetch_add(ssq + row, ss, __ATOMIC_RELAXED, __HIP_MEMORY_SCOPE_AGENT); } }
            asm volatile("" ::: "memory"); }
    }
};
struct EpiSwiglu {
    static constexpr bool PERM = true, AFTER_DRAIN = false;
    bf16_t* O; const float* ssq;
    __device__ __forceinline__ void operator()(const f32x4 (&acc)[2][2][4][2], const Unit& u, int wr, int wc, int fr, int fq) const {
        const int row0 = u.pm * BM + wr * 64 + fr, col0 = u.pn * HALF + wc * 32 + 8 * fq;
        float rs[2][4];
#pragma unroll
        for (int ai = 0; ai < 2; ++ai)
#pragma unroll
            for (int m = 0; m < 4; ++m) rs[ai][m] = ssq[row0 + ai * HALF + m * 16];
#pragma unroll
        for (int ai = 0; ai < 2; ++ai)
#pragma unroll
            for (int m = 0; m < 4; ++m) { bf16_t* rowp = O + (size_t)(row0 + ai * HALF + m * 16) * DFF + col0; const float r = 1.0f / sqrtf(rs[ai][m] * (1.f / DM) + 1e-6f);
                const f32x4 g0 = acc[ai][0][m][0] * r, g1 = acc[ai][0][m][1] * r, u0 = acc[ai][1][m][0] * r, u1 = acc[ai][1][m][1] * r;
                f32x4 a0, a1;
#pragma unroll
                for (int j = 0; j < 4; ++j) { a0[j] = silu_f(g0[j]) * u0[j]; a1[j] = silu_f(g1[j]) * u1[j]; }
                u32x4 w; w.x = cvt_pk_bf16(a0[0], a0[1]); w.y = cvt_pk_bf16(a0[2], a0[3]); w.z = cvt_pk_bf16(a1[0], a1[1]); w.w = cvt_pk_bf16(a1[2], a1[3]);
                *(u32x4*)rowp = w; }
    }
};
struct EpiKVFQ {
    static constexpr bool PERM = false, AFTER_DRAIN = false;
    float* kP; float* vP; float* lfP; float* kS; float* vS; float* lfS; bf16_t* KB; bf16_t* VB; bf16_t* KALL; bf16_t* VALL; bf16_t* QB; const float* bf; const float* ssq;
    __device__ __forceinline__ void operator()(const f32x4 (&acc)[2][2][4][2], const Unit& u, int wr, int wc, int fr, int fq) const {
        const int row0 = u.pm * BM + wr * 64 + fr;
        float rs[2][4];
#pragma unroll
        for (int ai = 0; ai < 2; ++ai)
#pragma unroll
            for (int m = 0; m < 4; ++m) rs[ai][m] = 1.0f / sqrtf(ssq[row0 + ai * HALF + m * 16] * (1.f / DM) + 1e-6f);
        if (u.pn >= 5) {
            const int col0 = (u.pn - 5) * BM + wc * 32 + 4 * fq;
#pragma unroll
            for (int ai = 0; ai < 2; ++ai)
#pragma unroll
                for (int m = 0; m < 4; ++m) { bf16_t* bo = QB + (size_t)(row0 + ai * HALF + m * 16) * DM + col0;
#pragma unroll
                    for (int bj = 0; bj < 2; ++bj)
#pragma unroll
                        for (int n = 0; n < 2; ++n) { const f32x4 v = acc[ai][bj][m][n] * rs[ai][m]; u32x2 w; w.x = cvt_pk_bf16(v[0], v[1]); w.y = cvt_pk_bf16(v[2], v[3]); *(u32x2*)(bo + bj * HALF + n * 16) = w; } }
        } else if (u.pn < 4) {
            const bool isv = u.pn >= 2; const int col0 = (u.pn & 1) * BM + wc * 32 + 4 * fq;
            float* fP = isv ? vP : kP; float* fS = isv ? vS : kS; bf16_t* bP = isv ? VB : KB; bf16_t* bA = isv ? VALL : KALL;
#pragma unroll
            for (int ai = 0; ai < 2; ++ai)
#pragma unroll
                for (int m = 0; m < 4; ++m) { const int row = row0 + ai * HALF + m * 16; float* fo; bf16_t* bo;
                    if (row < TP) { fo = fP + (size_t)row * 512 + col0; bo = bP + (size_t)row * 512 + col0; }
                    else { const int r2 = row - TP; fo = fS + (size_t)r2 * 512 + col0; bo = bA + ((size_t)(r2 >> 5) * LKS + PASTL + (r2 & 31)) * 512 + col0; }
#pragma unroll
                    for (int bj = 0; bj < 2; ++bj)
#pragma unroll
                        for (int n = 0; n < 2; ++n) { const f32x4 v = acc[ai][bj][m][n] * rs[ai][m]; *(f32x4*)(fo + bj * HALF + n * 16) = v;
                            u32x2 w; w.x = cvt_pk_bf16(v[0], v[1]); w.y = cvt_pk_bf16(v[2], v[3]); *(u32x2*)(bo + bj * HALF + n * 16) = w; } }
        } else if (wc == 0) {
            const f32x4 bb = *(const f32x4*)(bf + 4 * fq);
#pragma unroll
            for (int ai = 0; ai < 2; ++ai)
#pragma unroll
                for (int m = 0; m < 4; ++m) { const int row = row0 + ai * HALF + m * 16; const f32x4 z = acc[ai][0][m][0] * rs[ai][m] + bb; f32x4 r;
#pragma unroll
                    for (int j = 0; j < 4; ++j) r[j] = fminf(z[j], 0.f) - log1pf(__expf(-fabsf(z[j])));
                    float* o = row < TP ? lfP + (size_t)row * 16 : lfS + (size_t)(row - TP) * 16; *(f32x4*)(o + 4 * fq) = r; }
        }
    }
};
}
namespace fox {
enum { ORDER_NATURAL = 0, ORDER_REVERSED = 1, ORDER_PAIRED = 2, ORDER_XCD = 4 };
constexpr int D = 128, QS = 2048, KS = 512, OS = 2048;
constexpr float THR = 8.f;
constexpr bool WSKIP = false;
constexpr float SCALE = 0.08838834764831845f;
constexpr int NW = 8, QBLK = 32, KVBLK = 64, QB = NW * QBLK;
constexpr int SHM_V = KVBLK * D * 2, SHM_K = KVBLK * D * 2;
constexpr int LDS_BYTES = 2 * SHM_V + 2 * SHM_K + NW * 64 * 4 + 2 * 64 * 4;
typedef unsigned short bf16;
typedef short bf16x8 __attribute__((ext_vector_type(8)));
typedef short s16x4 __attribute__((ext_vector_type(4)));
typedef float f32x16 __attribute__((ext_vector_type(16)));
typedef float f32x4 __attribute__((ext_vector_type(4)));
typedef unsigned u32x4 __attribute__((ext_vector_type(4)));
template <class A, class Bt> struct same_t { static constexpr bool v = false; };
template <class A> struct same_t<A, A> { static constexpr bool v = true; };

#define KSWZ(row, colB) ((row) * 256 + ((colB) ^ (((row) & 7) << 4)))
#define SBAR() __builtin_amdgcn_sched_barrier(0)
__device__ __forceinline__ int v_st(int k, int c) { const int kk = (k & ~0xC) | ((k & 4) << 1) | ((k & 8) >> 1); return ((kk >> 3) * 4 + (c >> 5)) * 512 + ((kk & 7) * 32 + (c & 31)) * 2; }
__device__ __forceinline__ int v_rd_base(int lane) { return ((lane & 3) << 3) | (((lane >> 2) & 3) << 6) | (((lane >> 4) & 1) << 5) | (((lane >> 5) & 1) << 8); }
constexpr int v_rd_off(int d0, int ks, int half) { return d0 * 512 + ks * 4096 + half * 2048; }
__device__ __forceinline__ int crow(int r, int hi) { return (r & 3) + 8 * (r >> 2) + 4 * hi; }
__device__ __forceinline__ unsigned cvtpk(float lo, float hi) {
    unsigned r; asm volatile("v_cvt_pk_bf16_f32 %0, %1, %2" : "=v"(r) : "v"(lo), "v"(hi)); return r;
}
__device__ __forceinline__ bf16x8 pack8(f32x4 a, f32x4 b) {
    u32x4 w = {cvtpk(a[0], a[1]), cvtpk(a[2], a[3]), cvtpk(b[0], b[1]), cvtpk(b[2], b[3])};
    return *reinterpret_cast<bf16x8*>(&w);
}
template <class T> __device__ __forceinline__ bf16x8 load8(const T* p) {
    if constexpr (same_t<T, float>::v) { return pack8(*(const f32x4*)p, *(const f32x4*)(p + 4)); }
    else { return *reinterpret_cast<const bf16x8*>(p); }
}
__device__ __forceinline__ void mask_tile(f32x16& p0, f32x16& p1, int dq, unsigned W) {
    const float NEG = -__builtin_inff();
#pragma unroll
    for (int r = 0; r < 16; ++r) {
        const int c = (r & 3) + 8 * (r >> 2);
        if ((unsigned)(dq - c) >= W) p0[r] = NEG;
        if ((unsigned)(dq - c - 32) >= W) p1[r] = NEG;
    }
}
__device__ __forceinline__ void partialSM(f32x16& p0, f32x16& p1, float& m_reg, float& mn, float& alpha) {
    float pmax = p0[0]; for (int r = 1; r < 16; ++r) pmax = fmaxf(pmax, p0[r]); for (int r = 0; r < 16; ++r) pmax = fmaxf(pmax, p1[r]);
    { auto rr = __builtin_amdgcn_permlane32_swap(__float_as_uint(pmax), __float_as_uint(pmax), false, false);
      pmax = fmaxf(__uint_as_float(rr[0]), __uint_as_float(rr[1])); }
    constexpr float C2 = 1.4426950408889634f * SCALE;
    if (__builtin_expect(__all((pmax - m_reg) * SCALE <= THR), 1)) { mn = m_reg; alpha = 1.f; }
    else { mn = fmaxf(m_reg, pmax); alpha = __builtin_amdgcn_exp2f((m_reg - mn) * C2); m_reg = mn; }
    const float mnL = -mn * C2;
    for (int r = 0; r < 16; ++r) p0[r] = fmaf(p0[r], C2, mnL); for (int r = 0; r < 16; ++r) p1[r] = fmaf(p1[r], C2, mnL);
    for (int r = 0; r < 16; ++r) p0[r] = __builtin_amdgcn_exp2f(p0[r]);
}
__device__ __forceinline__ void finishSM(f32x16& p0, f32x16& p1, float alpha, float& l_reg, bf16x8& pa0, bf16x8& pa1, bf16x8& pa2, bf16x8& pa3) {
    for (int r = 0; r < 16; ++r) p1[r] = __builtin_amdgcn_exp2f(p1[r]);
    float ps = 0; for (int r = 0; r < 16; ++r) ps += p0[r]; for (int r = 0; r < 16; ++r) ps += p1[r];
    { auto rr = __builtin_amdgcn_permlane32_swap(__float_as_uint(ps), __float_as_uint(ps), false, false);
      ps = __uint_as_float(rr[0]) + __uint_as_float(rr[1]); }
    l_reg = l_reg * alpha + ps;
#define PK4(P, B_, OUT) do { unsigned a0 = cvtpk(P[B_+0], P[B_+1]), a1 = cvtpk(P[B_+2], P[B_+3]);                          \
        unsigned b0 = cvtpk(P[B_+4], P[B_+5]), b1 = cvtpk(P[B_+6], P[B_+7]);                                             \
        auto r0 = __builtin_amdgcn_permlane32_swap(a0, b0, false, false); auto r1 = __builtin_amdgcn_permlane32_swap(a1, b1, false, false); \
        u32x4 w = {r0[0], r1[0], r0[1], r1[1]}; OUT = *reinterpret_cast<bf16x8*>(&w); } while (0)
    PK4(p0, 0, pa0); PK4(p0, 8, pa1); PK4(p1, 0, pa2); PK4(p1, 8, pa3);
#undef PK4
}
template <int KB, bool SK>
__device__ __forceinline__ void qkt(f32x16& p0, f32x16& p1, const char* K_lds, int r32, int hi, const bf16x8* qr, bool act) {
    if (SK && !act) { const float NEG = -__builtin_inff();
#pragma unroll
        for (int r = 0; r < 16; ++r) { p0[r] = NEG; p1[r] = NEG; } return; }
    { const float* bb_ = (const float*)(K_lds + 2 * SHM_K + NW * 64 * 4) + KB * 64 + 4 * hi;
#pragma unroll
      for (int q_ = 0; q_ < 4; ++q_) { const f32x4 b0_ = *(const f32x4*)(bb_ + 8 * q_), b1_ = *(const f32x4*)(bb_ + 32 + 8 * q_);
#pragma unroll
        for (int i_ = 0; i_ < 4; ++i_) { p0[4 * q_ + i_] = b0_[i_]; p1[4 * q_ + i_] = b1_[i_]; } } }
    const char* kb[4];
#pragma unroll
    for (int dd = 0; dd < 4; ++dd) kb[dd] = K_lds + KB * SHM_K + KSWZ(r32, (dd * 16 + hi * 8) * 2);
#pragma unroll
    for (int d0 = 0; d0 < 8; ++d0) { const char* a = kb[d0 & 3] + (d0 >> 2) * 128;
        bf16x8 b0 = *reinterpret_cast<const bf16x8*>(a);
        bf16x8 b1 = *reinterpret_cast<const bf16x8*>(a + 32 * 256);
        p0 = __builtin_amdgcn_mfma_f32_32x32x16_bf16(b0, qr[d0], p0, 0, 0, 0);
        p1 = __builtin_amdgcn_mfma_f32_32x32x16_bf16(b1, qr[d0], p1, 0, 0, 0); }
}
template <int VB, bool SK>
__device__ __forceinline__ void pv_tile(f32x16* o, int vb0, bf16x8 pa0, bf16x8 pa1, bf16x8 pa2, bf16x8 pa3, bool act) {
    if (SK && !act) return;
#define TRRD(dst, off) asm volatile("ds_read_b64_tr_b16 %0, %1 offset:%2" : "=&v"(dst) : "v"(vb0), "i"(off) : "memory")
#define PV_D0(d0) do { s16x4 l0, l1, l2, l3, h0, h1, h2, h3; constexpr int b_ = VB * SHM_V + v_rd_off(d0, 0, 0);     \
        TRRD(l0, b_); TRRD(h0, b_ + 2048); TRRD(l1, b_ + 4096); TRRD(h1, b_ + 6144); TRRD(l2, b_ + 8192); TRRD(h2, b_ + 10240); TRRD(l3, b_ + 12288); TRRD(h3, b_ + 14336); \
        asm volatile("s_waitcnt lgkmcnt(0)" ::: "memory"); SBAR();                 \
        o[d0] = __builtin_amdgcn_mfma_f32_32x32x16_bf16(pa0, (bf16x8){l0[0], l0[1], l0[2], l0[3], h0[0], h0[1], h0[2], h0[3]}, o[d0], 0, 0, 0);   \
        o[d0] = __builtin_amdgcn_mfma_f32_32x32x16_bf16(pa1, (bf16x8){l1[0], l1[1], l1[2], l1[3], h1[0], h1[1], h1[2], h1[3]}, o[d0], 0, 0, 0);   \
        o[d0] = __builtin_amdgcn_mfma_f32_32x32x16_bf16(pa2, (bf16x8){l2[0], l2[1], l2[2], l2[3], h2[0], h2[1], h2[2], h2[3]}, o[d0], 0, 0, 0);   \
        o[d0] = __builtin_amdgcn_mfma_f32_32x32x16_bf16(pa3, (bf16x8){l3[0], l3[1], l3[2], l3[3], h3[0], h3[1], h3[2], h3[3]}, o[d0], 0, 0, 0); } while (0)
    PV_D0(0); PV_D0(1); PV_D0(2); PV_D0(3);
#undef PV_D0
#undef TRRD
}
template <class TIn, class TOut> struct BlockRef { const TIn* Q; const TIn* K; const TIn* V; TOut* O; const float* FB; int P0; };
template <class TIn> struct Seam {
    bf16x8 qr[8];
    bf16x8 st_v0, st_v1, st_k0, st_k1; float st_f; f32x4 sf0, sf1, sf2, sf3;
    f32x4 tq[16];
};
__device__ __forceinline__ int swa_jlo(int P0, int W) { const int lowk = P0 - W + 1; return lowk > 0 ? lowk / KVBLK : 0; }
#define ROW(p, k0, rr) ((p) + (size_t)((k0) + (rr)) * KS + sc)
#define VMW() asm volatile("s_waitcnt vmcnt(0)" ::: "memory")
#define VMWN(n) asm volatile("s_waitcnt vmcnt(%0)" :: "i"(n) : "memory")
#define SLOAD_H(Kp, Vp, Fp, k0) do { S.st_f = (Fp)[(k0) + (tid & 63)]; S.st_v0 = load8<TIn>(ROW(Vp, k0, sr)); S.st_v1 = load8<TIn>(ROW(Vp, k0, 32 + sr));              \
                         S.st_k0 = load8<TIn>(ROW(Kp, k0, sr)); S.st_k1 = load8<TIn>(ROW(Kp, k0, 32 + sr)); } while (0)
#define SWRITE_HK(bf) do { ((float*)(K_lds + 2 * SHM_K + NW * 64 * 4))[(bf) * 64 + (tid & 63)] = S.st_f; *(bf16x8*)(K_lds + (bf) * SHM_K + kws) = S.st_k0; *(bf16x8*)(K_lds + (bf) * SHM_K + kws + 32 * 256) = S.st_k1; } while (0)
#define SWRITE_HV(bf) do { *(bf16x8*)(V_lds + (bf) * SHM_V + vst0) = S.st_v0; *(bf16x8*)(V_lds + (bf) * SHM_V + vst1) = S.st_v1; } while (0)
#define SWRITE_H(bf) do { SWRITE_HV(bf); SWRITE_HK(bf); } while (0)
#define SLOAD_F(p, k0) do { S.sf0 = *(const f32x4*)ROW(p, k0, sr); S.sf1 = *(const f32x4*)(ROW(p, k0, sr) + 4);                \
                            S.sf2 = *(const f32x4*)ROW(p, k0, 32 + sr); S.sf3 = *(const f32x4*)(ROW(p, k0, 32 + sr) + 4); } while (0)
#define SWRITE_KF(bf) do { *(bf16x8*)(K_lds + (bf) * SHM_K + kws) = pack8(S.sf0, S.sf1); *(bf16x8*)(K_lds + (bf) * SHM_K + kws + 32 * 256) = pack8(S.sf2, S.sf3); } while (0)
#define SWRITE_VF(bf) do { *(bf16x8*)(V_lds + (bf) * SHM_V + vst0) = pack8(S.sf0, S.sf1); *(bf16x8*)(V_lds + (bf) * SHM_V + vst1) = pack8(S.sf2, S.sf3); } while (0)
template <class TIn, class TOut>
__device__ __forceinline__ void causal_swa_prime(const BlockRef<TIn, TOut>& cur, int W, char* lds, Seam<TIn>& S) {
    constexpr bool F32 = same_t<TIn, float>::v;
    const int tid = opaque_tid(), wid = __builtin_amdgcn_readfirstlane(tid >> 6), lane = tid & 63, r32 = lane & 31, hi = lane >> 5;
    const int sr = tid >> 4, sc = (tid & 15) * 8, kws = KSWZ(sr, sc * 2); char* K_lds = lds + 2 * SHM_V;
    const int kb0 = swa_jlo(cur.P0, W) * KVBLK;
    for (int d0 = 0; d0 < 8; ++d0) S.qr[d0] = load8<TIn>(cur.Q + (size_t)(wid * QBLK + r32) * QS + d0 * 16 + hi * 8);
    if constexpr (F32) { SLOAD_F((const float*)cur.K, kb0); VMW(); SWRITE_KF(0); SBAR(); SLOAD_F((const float*)cur.V, kb0); }
    else { SLOAD_H(cur.K, cur.V, cur.FB, kb0); VMW(); SWRITE_HK(0); }
    __syncthreads();
}
template <class TIn, class TOut>
__device__ __forceinline__ void causal_swa_block(const BlockRef<TIn, TOut>& cur, const BlockRef<TIn, TOut>& nxt, int skv, int W, char* lds, Seam<TIn>& S) {
    constexpr bool F32 = same_t<TIn, float>::v;
    const int tid = opaque_tid(), wid = __builtin_amdgcn_readfirstlane(tid >> 6), lane = tid & 63, r32 = lane & 31, hi = lane >> 5;
    const int j_lo = swa_jlo(cur.P0, W);
    int j_hi = (cur.P0 + QB - 1) / KVBLK + 1; if (j_hi > skv / KVBLK) j_hi = skv / KVBLK;
    const int NT = j_hi - j_lo;
    const int kbn = swa_jlo(nxt.P0, W) * KVBLK;
    const int qlo = cur.P0 + wid * QBLK, qm = qlo + r32 - 4 * hi;
    char* V_lds = lds; char* K_lds = lds + 2 * SHM_V;
    float* ws = (float*)(lds + 2 * SHM_V + 2 * SHM_K) + wid * 64; float* li_l = ws, * al_l = ws + 32;
    float m_reg = -1e30f, l_reg = 0; f32x16 o[4] = {};
    const int sr = tid >> 4, sc = (tid & 15) * 8, vst0 = v_st(sr, sc), vst1 = v_st(32 + sr, sc), kws = KSWZ(sr, sc * 2);
    const int vb0 = (int)(uintptr_t)V_lds + v_rd_base(lane);
    const TIn* Kh = cur.K; const TIn* Vh = cur.V;
#define RESC(a) do { if (__any((a) < 1.f)) { if (hi == 0) al_l[r32] = (a); asm volatile("s_waitcnt lgkmcnt(0)" ::: "memory");              \
                     for (int d_ = 0; d_ < 4; ++d_) for (int r = 0; r < 16; ++r) o[d_][r] *= al_l[crow(r, hi)]; } } while (0)
#define KBASE(t) ((j_lo + (t)) * KVBLK)
#define ACT(t) (KBASE(t) <= qlo + QBLK - 1 && KBASE(t) + KVBLK - 1 >= qlo - W + 1)
#define MASKT(P0_, P1_, t) do { const int kb_ = KBASE(t); if ((!SK || ACT(t)) && (kb_ + KVBLK - 1 > qlo || kb_ <= qlo + QBLK - 1 - W)) mask_tile(P0_, P1_, qm - kb_, (unsigned)W); } while (0)
    constexpr int NQL = F32 ? 16 : 8;
    constexpr bool SK = WSKIP && !F32;
#define SEAM_K0() do { VMWN(NQL); if constexpr (F32) { SWRITE_KF(0); SBAR(); SLOAD_F((const float*)nxt.V, kbn); } else { SWRITE_HK(0); } SBAR(); } while (0)
    f32x16 pA0, pA1, pB0, pB1; float mnA, mnB, alA, alB; bf16x8 pa0, pa1, pa2, pa3;
    if constexpr (F32) { VMW(); SWRITE_VF(0); SBAR(); } else { SWRITE_HV(0); SBAR(); }
    if (NT > 1) { if constexpr (F32) SLOAD_F((const float*)Kh, KBASE(1)); else SLOAD_H(Kh, Vh, cur.FB, KBASE(1)); }
    SBAR(); qkt<0, SK>(pA0, pA1, K_lds, r32, hi, S.qr, ACT(0));
    if constexpr (F32) { if (NT > 1) { VMW(); SWRITE_KF(1); SBAR(); SLOAD_F((const float*)Vh, KBASE(1)); } }
    MASKT(pA0, pA1, 0); partialSM(pA0, pA1, m_reg, mnA, alA);
    if (NT > 1) { VMW(); if constexpr (F32) { SWRITE_VF(1); SBAR(); if (NT > 2) SLOAD_F((const float*)Kh, KBASE(2)); } else SWRITE_H(1); }
    __syncthreads();
#define HALF_STEP(PX0, PX1, mnX, alX, PY0, PY1, alY, t, KB, VB, SB) do {                                                      \
        SBAR(); qkt<KB, SK>(PX0, PX1, K_lds, r32, hi, S.qr, ACT(t));                                             \
        finishSM(PY0, PY1, alY, l_reg, pa0, pa1, pa2, pa3); SBAR();                                                           \
        if ((t) + 1 < NT) { if constexpr (F32) { VMW(); SWRITE_KF(SB); SBAR(); SLOAD_F((const float*)Vh, KBASE((t) + 1)); }  \
                            else { SLOAD_H(Kh, Vh, cur.FB, KBASE((t) + 1)); } SBAR(); }                                               \
        pv_tile<VB, SK>(o, vb0, pa0, pa1, pa2, pa3, ACT((t) - 1)); MASKT(PX0, PX1, (t)); partialSM(PX0, PX1, m_reg, mnX, alX);                                        \
        __syncthreads();                                                                                                      \
        if ((t) + 1 < NT) { VMW(); if constexpr (F32) { SWRITE_VF(SB); SBAR(); if ((t) + 2 < NT) SLOAD_F((const float*)Kh, KBASE((t) + 2)); } \
                            else { SWRITE_H(SB); } }                                                                          \
        RESC(alX); __syncthreads(); } while (0)
    for (int t = 1; t + 1 < NT; t += 2) {
        HALF_STEP(pB0, pB1, mnB, alB, pA0, pA1, alA, t, 1, 0, 0);
        HALF_STEP(pA0, pA1, mnA, alA, pB0, pB1, alB, t + 1, 0, 1, 1);
    }
    const bool even = (NT & 1) == 0;
    if (even) { SBAR(); qkt<1, SK>(pB0, pB1, K_lds, r32, hi, S.qr, ACT(NT - 1)); SBAR(); }
#define QROW(e) (nxt.Q + (size_t)(wid * QBLK + r32) * D + ((e) >> 1) * 16 + hi * 8 + ((e) & 1) * 4)
    if constexpr (F32) { SLOAD_F((const float*)nxt.K, kbn); SBAR();
#pragma unroll
        for (int e = 0; e < 8; ++e) S.tq[e] = *(const f32x4*)QROW(e); }
    else { SLOAD_H(nxt.K, nxt.V, nxt.FB, kbn); SBAR();
#pragma unroll
        for (int d0 = 0; d0 < 8; ++d0) S.qr[d0] = load8<TIn>(nxt.Q + (size_t)(wid * QBLK + r32) * QS + d0 * 16 + hi * 8); }
    SBAR();
    finishSM(pA0, pA1, alA, l_reg, pa0, pa1, pa2, pa3); SBAR();
    if constexpr (F32) {
#pragma unroll
        for (int e = 8; e < 16; ++e) S.tq[e] = *(const f32x4*)QROW(e); SBAR(); }
#undef QROW
    pv_tile<0, SK>(o, vb0, pa0, pa1, pa2, pa3, ACT(even ? NT - 2 : NT - 1));
    if (even) { MASKT(pB0, pB1, NT - 1); partialSM(pB0, pB1, m_reg, mnB, alB); __syncthreads(); RESC(alB);
        finishSM(pB0, pB1, alB, l_reg, pa0, pa1, pa2, pa3); SBAR(); pv_tile<1, SK>(o, vb0, pa0, pa1, pa2, pa3, ACT(NT - 1)); }
    SBAR(); SEAM_K0();
    if (hi == 0) li_l[r32] = l_reg; asm volatile("s_waitcnt lgkmcnt(0)" ::: "memory");
    float rli[16];
#pragma unroll
    for (int r = 0; r < 16; ++r) rli[r] = __builtin_amdgcn_rcpf(li_l[crow(r, hi)]);
    TOut* Ow = cur.O + (size_t)(wid * QBLK) * OS;
#pragma unroll
    for (int r = 0; r < 16; ++r) { const int orow = crow(r, hi);
#pragma unroll
        for (int d0 = 0; d0 < 4; ++d0) { const float v = o[d0][r] * rli[r];
            if constexpr (same_t<TOut, float>::v) { Ow[(size_t)orow * OS + d0 * 32 + r32] = v; }
            else { const float vn = __shfl_xor(v, 1);
                   if ((r32 & 1) == 0) *(unsigned*)(Ow + (size_t)orow * OS + d0 * 32 + r32) = cvtpk(v, vn); } } }
    if constexpr (F32) {
#pragma unroll
        for (int d0 = 0; d0 < 8; ++d0) S.qr[d0] = pack8(S.tq[2 * d0], S.tq[2 * d0 + 1]); }
    __syncthreads();
#undef RESC
#undef KBASE
#undef ACT
#undef MASKT
#undef SEAM_K0
#undef HALF_STEP
}
#undef ROW
#undef VMW
#undef VMWN
#undef SLOAD_H
#undef SWRITE_HK
#undef SWRITE_HV
#undef SWRITE_H
#undef SLOAD_F
#undef SWRITE_KF
#undef SWRITE_VF

__host__ __device__ inline int swa_nramp(int nqb, int W, int qoff) { const int t = W - 1 - qoff; const int n = t < 0 ? 0 : t / QB + 1; return n > nqb ? nqb : n; }
__host__ __device__ inline int swa_nx(int nqb, int nramp, int order) { return (order & ORDER_PAIRED) ? (nramp + 1) / 2 + (nqb - nramp) : nqb; }
struct SwaItem { int bh, qb0, qb1; };
__device__ __forceinline__ SwaItem swa_decode(int L, int nb, int nh, int nhkv, int nqb, int nx, int nramp, int order) {
    const int G = nh / nhkv; SwaItem it; int x;
    if ((order & ORDER_XCD) && (nb * nhkv) % 8 == 0) { const int xcd = L & 7, k = L >> 3, per = G * nx, gi = k / per, r = k - gi * per;
        it.bh = (gi * 8 + xcd) * G + r / nx; x = r % nx; }
    else { it.bh = L / nx; x = L - it.bh * nx; }
    if (order & ORDER_PAIRED) { const int ns = nqb - nramp;
        if (x < ns) { it.qb0 = it.qb1 = nqb - 1 - x; } else { it.qb0 = x - ns; it.qb1 = nramp - 1 - it.qb0; } }
    else { it.qb0 = it.qb1 = ((order & 3) == ORDER_REVERSED) ? nqb - 1 - x : x; }
    return it;
}
typedef unsigned short bf16;
__device__ __forceinline__ BlockRef<bf16, bf16> mk_ref(const SwaItem& it, int pass, const bf16* Q, const bf16* K, const bf16* V, bf16* O, const float* FB) {
    const int qb = pass ? it.qb1 : it.qb0, b = it.bh >> 4, h = it.bh & 15, kvh = h >> 2;
    BlockRef<bf16, bf16> r;
    r.Q = Q + ((size_t)b * 8192 + (size_t)qb * QB) * QS + h * 128; r.O = O + ((size_t)b * 8192 + (size_t)qb * QB) * OS + h * 128;
    r.K = K + (size_t)b * 8192 * KS + kvh * 128; r.V = V + (size_t)b * 8192 * KS + kvh * 128; r.FB = FB + (size_t)it.bh * 8192; r.P0 = qb * QB;
    return r;
}
__device__ __forceinline__ void attn_phase(char* lds, const bf16* Q, const bf16* K, const bf16* V, bf16* O, const float* FB) {
    constexpr int nb = 4, nh = 16, nhkv = 4, nqb = 32, W = 8192, order = ORDER_PAIRED | ORDER_XCD;
    const int nramp = swa_nramp(nqb, W, 0), nx = swa_nx(nqb, nramp, order), total = nx * nb * nh, stride = gridDim.x;
    int L = blockIdx.x; if (L >= total) return;
    SwaItem it = swa_decode(L, nb, nh, nhkv, nqb, nx, nramp, order); int pass = 0;
    BlockRef<bf16, bf16> cur = mk_ref(it, 0, Q, K, V, O, FB);
    Seam<bf16> S;
    causal_swa_prime<bf16, bf16>(cur, W, lds, S);
    for (;;) {
        const bool more_pass = pass == 0 && it.qb1 != it.qb0, more_item = L + stride < total, last = !more_pass && !more_item;
        SwaItem itn = it; int passn = pass + 1, Ln = L;
        if (!more_pass) { passn = 0; Ln = more_item ? L + stride : L; itn = swa_decode(Ln, nb, nh, nhkv, nqb, nx, nramp, order); }
        const BlockRef<bf16, bf16> nxt = last ? cur : mk_ref(itn, passn, Q, K, V, O, FB);
        causal_swa_block<bf16, bf16>(cur, nxt, 8192, W, lds, S);
        if (last) break;
        cur = nxt; it = itn; pass = passn; L = Ln;
    }
}
}
constexpr size_t WS_WIN = 0, WS_WRO = 50331648, WS_WGU0 = 67108864, WS_WGU1 = 113246208, WS_WDN0 = 159383552, WS_WDN1 = 182452224,
                 WS_WO = 205520896, WS_WKVF = 213909504  , WS_COS = 227540992, WS_SIN = 231735296, WS_FB = 235929600, WS_FS = WS_FB + 2097152, WS_SSQ = WS_FS + 540672  ,
                 WS_BIG = 239075328;
constexpr size_t SZ_ROWS2K = (size_t)TALL * DM * 2;
constexpr size_t BIG_XN = 0, BIG_ACT = SZ_ROWS2K, BIG_HKV = BIG_ACT + (size_t)TALL * DFF * 2, BIG_KB = BIG_HKV + SZ_ROWS2K, BIG_VB = BIG_KB + (size_t)TP * 512 * 2,
                 BIG_KALL = BIG_VB + (size_t)TP * 512 * 2, BIG_VALL = BIG_KALL + (size_t)8 * LKS * 512 * 2, BIG_END = BIG_VALL + (size_t)8 * LKS * 512 * 2;
static_assert(BIG_END <= (size_t)TALL * NPROJ * 2, "layer-1 buffers fit in the PROJ region");
constexpr size_t WS_END = WS_BIG + (size_t)TALL * NPROJ * 2;
static_assert(WS_END <= (size_t)1073741824, "workspace fits 1 GiB");
constexpr size_t OUT_Y = 0, OUT_SP = 67633152, OUT_KP = 71827456, OUT_VP = 88604672, OUT_LFP = 105381888, OUT_SS = 105906176, OUT_KS = 114294784, OUT_VS = 114425856, OUT_LFS = 114556928;
constexpr int NWAVES = 8, LDS_BYTES = 149504;

struct Params { const float* in[21]; float* out; unsigned char* ws; };

__device__ __forceinline__ float wave_sum(float v) {
#pragma unroll
    for (int o = 1; o < 64; o <<= 1) v += __shfl_xor(v, o);
    return v;
}
__device__ __forceinline__ float bf2f(unsigned short b) { return __uint_as_float(((unsigned)b) << 16); }
__device__ __forceinline__ unsigned pk2(float lo, float hi) { return pg8::cvt_pk_bf16(lo, hi); }

__device__ __forceinline__ void transpose_item(const float* W, int K, int N, bf16_t* WT, int k0, int n0, int drow0, LAS float* scr, int lane, const float* gain = nullptr) {
#pragma unroll 8
    for (int i = 0; i < 32; ++i) { const int kk = 2 * i + (lane >> 5); scr[kk * 33 + (lane & 31)] = W[(size_t)(k0 + kk) * N + n0 + (lane & 31)] * (gain ? gain[k0 + kk] : 1.f); }
    asm volatile("s_waitcnt lgkmcnt(0)" ::: "memory");
    const int c = lane & 7;
#pragma unroll
    for (int j = 0; j < 4; ++j) { const int n = (lane >> 3) + 8 * j; const LAS float* s = scr + (8 * c) * 33 + n;
        u32x4 o; o.x = pk2(s[0 * 33], s[1 * 33]); o.y = pk2(s[2 * 33], s[3 * 33]); o.z = pk2(s[4 * 33], s[5 * 33]); o.w = pk2(s[6 * 33], s[7 * 33]);
        *(u32x4*)(WT + (size_t)(drow0 + n) * K + k0 + 8 * c) = o; }
    asm volatile("s_waitcnt lgkmcnt(0)" ::: "memory");
}
__device__ __forceinline__ void tr_plain(const float* W, int K, int N, bf16_t* WT, int row_off, LAS float* scr, int item, int lane, const float* gain = nullptr) {
    const int nblk = N / 32, kb = item / nblk, nb = item % nblk; transpose_item(W, K, N, WT, 64 * kb, 32 * nb, row_off + 32 * nb, scr, lane, gain);
}
__device__ __forceinline__ void tr_gu(const float* W, bf16_t* WT, int up, LAS float* scr, int item, int lane, const float* gain) {
    const int nblk = DFF / 32, kb = item / nblk, nb = item % nblk, n0 = 32 * nb; transpose_item(W, DM, DFF, WT, 64 * kb, n0, (n0 >> 7) * 256 + up * 128 + (n0 & 127), scr, lane, gain);
}
template <int MODE  >
__device__ __forceinline__ void rms_row(const float* xrow, const float* g1, bf16_t* o1, const float* g2, bf16_t* o2, float* of, int lane) {
    const f32x4* xr = (const f32x4*)xrow + lane;
    f32x4 v[8]; float s = 0.f;
#pragma unroll
    for (int j = 0; j < 8; ++j) { v[j] = xr[64 * j]; s += (v[j].x * v[j].x + v[j].y * v[j].y) + (v[j].z * v[j].z + v[j].w * v[j].w); }
    const float rs = 1.0f / sqrtf(wave_sum(s) * (1.f / DM) + 1e-6f);
#pragma unroll
    for (int j = 0; j < 8; ++j) { const f32x4 ga = ((const f32x4*)g1)[64 * j + lane]; const f32x4 y = v[j] * rs;
        if (MODE == 2) { ((f32x4*)of)[64 * j + lane] = y * ga; }
        else { u32x2 w; w.x = pk2(y.x * ga.x, y.y * ga.y); w.y = pk2(y.z * ga.z, y.w * ga.w); ((u32x2*)o1)[64 * j + lane] = w;
            if (MODE == 1) { const f32x4 gb = ((const f32x4*)g2)[64 * j + lane]; u32x2 w2; w2.x = pk2(y.x * gb.x, y.y * gb.y); w2.y = pk2(y.z * gb.z, y.w * gb.w); ((u32x2*)o2)[64 * j + lane] = w2; } } }
}

namespace ret {
constexpr int QOFF = 0, KOFF = 33792, STOFF = 67584, VOFF = 101376, POFF = 110592, RS = 528, VS = 144;
typedef short v4i16_t __attribute__((ext_vector_type(4)));
__device__ __forceinline__ bf16x8 frag_rm(const LAS char* base, int stride, int i0, int k0, int fr, int fq) { return *(const LAS bf16x8*)(base + (i0 + fr) * stride + (k0 + 8 * fq) * 2); }
__device__ __forceinline__ s16x4 tr4(const LAS char* p) { return __builtin_bit_cast(s16x4, __builtin_amdgcn_ds_read_tr16_b64_v4i16((LAS v4i16_t*)p)); }
__device__ __forceinline__ bf16x8 frag_tr(const LAS char* base, int stride, int k0, int i0, int fr, int fq) {
    const LAS char* p = base + (k0 + 8 * fq + (fr >> 2)) * stride + (i0 + 4 * (fr & 3)) * 2;
    const s16x4 a = tr4(p), b = tr4(p + 4 * stride);
    return (bf16x8){a[0], a[1], a[2], a[3], b[0], b[1], b[2], b[3]};
}
#define MFMA16(X, Y, C) __builtin_amdgcn_mfma_f32_16x16x32_bf16(X, Y, C, 0, 0, 0)
__device__ __forceinline__ void ret_item(LAS char* lds, const bf16_t* pin, bf16_t* pout  , int nchunks, int c, int h, int es, const float* S0, float* Sout) {
    const int tid = opaque_tid(), wid = __builtin_amdgcn_readfirstlane(tid >> 6), lane = tid & 63, fr = lane & 15, fq = lane >> 4, lt = wid >> 1, half = wid & 1;
    const float lg2 = __log2f(1.0f - exp2f(-5.0f - (float)h)), gam = exp2f(lg2), gc1 = exp2f(lg2 * (float)(c - 1));
    f32x4 accT[8];
    const int eT = 16 * lt + fr;
#pragma unroll
    for (int i = 0; i < 8; ++i) { const int d0 = 16 * (8 * half + i) + 4 * fq;
#pragma unroll
        for (int r = 0; r < 4; ++r) accT[i][r] = S0 ? S0[(size_t)(d0 + r) * 512 + es * 64 + eT] : 0.f;
        u32x2 w; w.x = pk2(accT[i][0], accT[i][1]); w.y = pk2(accT[i][2], accT[i][3]); *(LAS u32x2*)(lds + STOFF + eT * RS + d0 * 2) = w; }
    u32x4 rq[4], rk[4], rv;
    const bf16_t* gq = pin + h * 256; const bf16_t* gk = pin + 2048 + h * 256; const bf16_t* gv = pin + 4096 + h * 512 + es * 64;
#define RET_LOAD(n) do { _Pragma("unroll") for (int i = 0; i < 4; ++i) { const int p = tid + 512 * i, row = p >> 5, ch = p & 31; const size_t go = (size_t)((n) * 64 + row) * NPROJ + ch * 8; \
            if (row < c) { rq[i] = *(const u32x4*)(gq + go); rk[i] = *(const u32x4*)(gk + go); } else { rq[i] = (u32x4){0u, 0u, 0u, 0u}; rk[i] = (u32x4){0u, 0u, 0u, 0u}; } } \
        { const int row = tid >> 3, ch = tid & 7; if (row < c) rv = *(const u32x4*)(gv + (size_t)((n) * 64 + row) * NPROJ + ch * 8); else rv = (u32x4){0u, 0u, 0u, 0u}; } } while (0)
    RET_LOAD(0);
    for (int n = 0; n < nchunks; ++n) {
#pragma unroll
        for (int i = 0; i < 4; ++i) { const int p = tid + 512 * i, row = p >> 5, ch = p & 31; *(LAS u32x4*)(lds + QOFF + row * RS + ch * 16) = rq[i]; *(LAS u32x4*)(lds + KOFF + row * RS + ch * 16) = rk[i]; }
        *(LAS u32x4*)(lds + VOFF + (tid >> 3) * VS + (tid & 7) * 16) = rv;
        if (n + 1 < nchunks) RET_LOAD(n + 1);
        __syncthreads();
        f32x4 accS[2], accC[2];
#pragma unroll
        for (int j = 0; j < 2; ++j) { accS[j] = (f32x4){0.f, 0.f, 0.f, 0.f}; accC[j] = (f32x4){0.f, 0.f, 0.f, 0.f}; }
#pragma unroll
        for (int ks = 0; ks < 8; ++ks) { const int k0 = 32 * ks;
            const bf16x8 yq = frag_rm(lds + QOFF, RS, 16 * lt, k0, fr, fq);
#pragma unroll
            for (int j = 0; j < 2; ++j) { const bf16x8 xk = frag_rm(lds + KOFF, RS, 16 * (2 * half + j), k0, fr, fq); accS[j] = MFMA16(xk, yq, accS[j]); }
#pragma unroll
            for (int j = 0; j < 2; ++j) { const bf16x8 xs = frag_rm(lds + STOFF, RS, 16 * (2 * half + j), k0, fr, fq); accC[j] = MFMA16(xs, yq, accC[j]); } }
        const int lrow = 16 * lt + fr;
#pragma unroll
        for (int j = 0; j < 2; ++j) { const int m0 = 16 * (2 * half + j) + 4 * fq; f32x4 s = accS[j];
#pragma unroll
            for (int r = 0; r < 4; ++r) s[r] = (m0 + r <= lrow) ? s[r] : 0.f;
            u32x2 w; w.x = pk2(s[0], s[1]); w.y = pk2(s[2], s[3]); *(LAS u32x2*)(lds + POFF + lrow * VS + m0 * 2) = w; }
        __syncthreads();
        f32x4 accO[2];
#pragma unroll
        for (int j = 0; j < 2; ++j) accO[j] = accC[j] * gam;
#pragma unroll
        for (int ks = 0; ks < 2; ++ks) { const int k0 = 32 * ks;
            const bf16x8 yp = frag_rm(lds + POFF, VS, 16 * lt, k0, fr, fq);
#pragma unroll
            for (int j = 0; j < 2; ++j) { const bf16x8 xv = frag_tr(lds + VOFF, VS, k0, 16 * (2 * half + j), fr, fq); accO[j] = MFMA16(xv, yp, accO[j]); } }
        if (lrow < c) {
#pragma unroll
            for (int j = 0; j < 2; ++j) { u32x2 w; w.x = pk2(accO[j][0], accO[j][1]); w.y = pk2(accO[j][2], accO[j][3]);
                *(u32x2*)(pout + (size_t)(n * 64 + lrow) * 4096 + h * 512 + es * 64 + 16 * (2 * half + j) + 4 * fq) = w; } }
#pragma unroll
        for (int i = 0; i < 8; ++i) accT[i] = accT[i] * gam;
#pragma unroll
        for (int ks = 0; ks < 2; ++ks) { const int k0 = 32 * ks;
            const bf16x8 yv = frag_tr(lds + VOFF, VS, k0, 16 * lt, fr, fq);
#pragma unroll
            for (int i = 0; i < 8; ++i) { const bf16x8 xk = frag_tr(lds + KOFF, RS, k0, 16 * (8 * half + i), fr, fq); accT[i] = MFMA16(xk, yv, accT[i]); } }
#pragma unroll
        for (int i = 0; i < 8; ++i) { accT[i] = accT[i] * gc1; const int d0 = 16 * (8 * half + i) + 4 * fq;
            u32x2 w; w.x = pk2(accT[i][0], accT[i][1]); w.y = pk2(accT[i][2], accT[i][3]); *(LAS u32x2*)(lds + STOFF + eT * RS + d0 * 2) = w; }
        __syncthreads();
    }
#undef RET_LOAD
#pragma unroll
    for (int i = 0; i < 8; ++i) { const int d0 = 16 * (8 * half + i) + 4 * fq;
#pragma unroll
        for (int r = 0; r < 4; ++r) Sout[(size_t)(d0 + r) * 512 + es * 64 + eT] = accT[i][r]; }
}
}
__device__ __forceinline__ void sample_attn(LAS char* lds, const bf16_t* QBp, const bf16_t* KALL, const bf16_t* VALL, const float* FS, bf16_t* AO) {
    const int tid = opaque_tid(), wid = __builtin_amdgcn_readfirstlane(tid >> 6), lane = tid & 63;
    LAS float* qf = (LAS float*)(lds + wid * 5120); LAS float* pf = qf + 128;
    const int gw = blockIdx.x * NWAVES + wid, NGW = gridDim.x * NWAVES;
    for (int item = gw; item < 8 * 16 * 32; item += NGW) {
        const int b = item >> 9, h = (item >> 5) & 15, qi = item & 31, kvh = h >> 2, qpos = PASTL + qi, row = TP + b * 32 + qi;
        const bf16_t* q = QBp + (size_t)row * DM + h * 128;
        qf[lane] = bf2f(q[lane]); qf[lane + 64] = bf2f(q[lane + 64]);
        asm volatile("s_waitcnt lgkmcnt(0)" ::: "memory");
        const float* F = FS + (size_t)(b * 16 + h) * LKS; const float Fq = F[qpos];
        const bf16_t* Kb = KALL + (size_t)b * LKS * 512 + kvh * 128; const bf16_t* Vb = VALL + (size_t)b * LKS * 512 + kvh * 128;
        float sc[17]; float mx = -1e30f;
#pragma unroll
        for (int t = 0; t < 17; ++t) { const int j = lane + 64 * t; float s = -__builtin_inff();
            if (j <= qpos) { const u32x4* kr = (const u32x4*)(Kb + (size_t)j * 512); float a = 0.f;
#pragma unroll 4
                for (int c8 = 0; c8 < 16; ++c8) { const u32x4 kv = kr[c8]; const LAS f32x4* qq = (const LAS f32x4*)(qf + 8 * c8); const f32x4 q0 = qq[0], q1 = qq[1];
                    a += __uint_as_float(kv.x << 16) * q0.x + __uint_as_float(kv.x & 0xffff0000u) * q0.y + __uint_as_float(kv.y << 16) * q0.z + __uint_as_float(kv.y & 0xffff0000u) * q0.w
                       + __uint_as_float(kv.z << 16) * q1.x + __uint_as_float(kv.z & 0xffff0000u) * q1.y + __uint_as_float(kv.w << 16) * q1.z + __uint_as_float(kv.w & 0xffff0000u) * q1.w; }
                s = a * 0.08838834764831845f + (Fq - F[j]); }
            sc[t] = s; mx = fmaxf(mx, s); }
#pragma unroll
        for (int o = 1; o < 64; o <<= 1) mx = fmaxf(mx, __shfl_xor(mx, o));
        float sum = 0.f;
#pragma unroll
        for (int t = 0; t < 17; ++t) { const float p = __expf(sc[t] - mx); sum += p; pf[lane + 64 * t] = p; }
        sum = wave_sum(sum);
        asm volatile("s_waitcnt lgkmcnt(0)" ::: "memory");
        float o0 = 0.f, o1 = 0.f;
        for (int j = 0; j <= qpos; ++j) { const float p = pf[j]; const unsigned vv = *(const unsigned*)(Vb + (size_t)j * 512 + 2 * lane);
            o0 += p * __uint_as_float(vv << 16); o1 += p * __uint_as_float(vv & 0xffff0000u); }
        const float inv = 1.0f / sum;
        *(unsigned*)(AO + (size_t)row * DM + h * 128 + 2 * lane) = pk2(o0 * inv, o1 * inv);
        asm volatile("s_waitcnt lgkmcnt(0)" ::: "memory");
    }
}

#define KARG(i) ((unsigned char*)(((const volatile __attribute__((address_space(4))) unsigned long long*)__builtin_amdgcn_kernarg_segment_ptr())[i]))
#define INF(i) ((const float*)KARG(i))
#define OUTP ((float*)KARG(21))
#define WSP (KARG(22))
#define BIGP (KARG(22) + WS_BIG)
#define PH_IDS const int tid = opaque_tid(), lane = tid & 63, wave = __builtin_amdgcn_readfirstlane(tid >> 6); const int G = gridDim.x, gw = blockIdx.x * NWAVES + wave, NGW = G * NWAVES; const size_t gt = (size_t)blockIdx.x * 512 + tid, NGT = (size_t)G * 512; (void)lane; (void)gw; (void)NGW; (void)gt; (void)NGT

__device__ __forceinline__ void ph_prologue(LAS unsigned char* lds) {
    PH_IDS; unsigned char* ws = WSP;
    bf16_t* WIN = (bf16_t*)(ws + WS_WIN); bf16_t* WRO = (bf16_t*)(ws + WS_WRO); bf16_t* WGU0 = (bf16_t*)(ws + WS_WGU0); bf16_t* WGU1 = (bf16_t*)(ws + WS_WGU1);
    bf16_t* WDN0 = (bf16_t*)(ws + WS_WDN0); bf16_t* WDN1 = (bf16_t*)(ws + WS_WDN1); bf16_t* WO = (bf16_t*)(ws + WS_WO); bf16_t* WKVF = (bf16_t*)(ws + WS_WKVF);
    LAS float* scr = (LAS float*)(lds + wave * 16384);
    constexpr int I0 = 32 * 384, I1 = 64 * 64, IG = 32 * 176, ID = 88 * 64, IQ = 32 * 64, IK = 32 * 16;
    constexpr int NIT = I0 + I1 + 4 * IG + 2 * ID + 2 * IQ + 2 * IK;
    for (int it = gw; it < NIT; it += NGW) { int r = it;
        if (r < I0) { tr_plain(INF(10), DM, NPROJ, WIN, 0, scr, r, lane); continue; } r -= I0;
        if (r < I1) { tr_plain(INF(11), 4096, DM, WRO, 0, scr, r, lane); continue; } r -= I1;
        if (r < IG) { tr_gu(INF(18), WGU0, 0, scr, r, lane, INF(7)); continue; } r -= IG;
        if (r < IG) { tr_gu(INF(19), WGU0, 1, scr, r, lane, INF(7)); continue; } r -= IG;
        if (r < IG) { tr_gu(INF(18) + (size_t)DM * DFF, WGU1, 0, scr, r, lane, INF(7) + DM); continue; } r -= IG;
        if (r < IG) { tr_gu(INF(19) + (size_t)DM * DFF, WGU1, 1, scr, r, lane, INF(7) + DM); continue; } r -= IG;
        if (r < ID) { tr_plain(INF(20), DFF, DM, WDN0, 0, scr, r, lane); continue; } r -= ID;
        if (r < ID) { tr_plain(INF(20) + (size_t)DFF * DM, DFF, DM, WDN1, 0, scr, r, lane); continue; } r -= ID;
        if (r < IQ) { tr_plain(INF(16), DM, DM, WKVF, 1280, scr, r, lane, INF(6) + DM); continue; } r -= IQ;
        if (r < IQ) { tr_plain(INF(17), DM, DM, WO, 0, scr, r, lane); continue; } r -= IQ;
        if (r < IK) { tr_plain(INF(12), DM, 512, WKVF, 0, scr, r, lane, INF(8)); continue; } r -= IK;
        tr_plain(INF(13), DM, 512, WKVF, 512, scr, r, lane, INF(8));
    }
    { const float* wf = INF(14); const float* nkv = INF(8);
      for (size_t i = gt; i < (size_t)256 * DM; i += NGT) { const int r = (int)(i >> 11), k = (int)(i & 2047); WKVF[(size_t)(1024 + r) * DM + k] = r < 16 ? (bf16_t)(pk2(wf[k * 16 + r] * nkv[k], 0.f) & 0xffffu) : (bf16_t)0; }
      float* ssq = (float*)(ws + WS_SSQ); for (size_t i = gt; i < (size_t)3 * TALL; i += NGT) ssq[i] = 0.f; }
    { float* COS = (float*)(ws + WS_COS); float* SIN = (float*)(ws + WS_SIN);
      for (size_t i = gt; i < (size_t)SEQ * 128; i += NGT) { const int pos = (int)(i >> 7), d = (int)(i & 127);
        const float inv = exp2f(-(float)d * (13.287712379549449f / 128.f));
        const double rev = (double)pos * (double)inv * 0.15915494309189535; const float fr = (float)(rev - __builtin_floor(rev));
        COS[i] = __builtin_amdgcn_cosf(fr); SIN[i] = __builtin_amdgcn_sinf(fr); } }
    { const float* x_p = INF(0); const float* x_s = INF(1); const float* nm = INF(6); bf16_t* XN0 = (bf16_t*)OUTP;
      for (int m = gw; m < TALL; m += NGW) rms_row<0>(m < TP ? x_p + (size_t)m * DM : x_s + (size_t)(m - TP) * DM, nm, XN0 + (size_t)m * DM, nullptr, nullptr, nullptr, lane); }
}
__device__ __forceinline__ void ph_retin(LAS unsigned char* lds) {
    unsigned char* ws = WSP;
    pg8::Gemm g{(const bf16_t*)OUTP, (const bf16_t*)(ws + WS_WIN), TALL, NPROJ, DM, DM}; pg8::StaticOrder S; S.init(TALL, NPROJ, (int)gridDim.x, (int)blockIdx.x);
    pg8::EpiRetIn E{(bf16_t*)(ws + WS_BIG), (const float*)(ws + WS_COS), (const float*)(ws + WS_SIN)};
    pg8::gemm_phase<pg8::EpiRetIn, pg8::StaticOrder, true, true>(lds, g, S, E);
}
__device__ __forceinline__ void ph_retention(LAS unsigned char* lds) {
    const int G = gridDim.x;
    for (int it = blockIdx.x; it < 256; it += G) { const int bh = (it & 7) * 4 + (it >> 6), es = (it >> 3) & 7, b = bh >> 3, h = bh & 7;
        ret::ret_item((LAS char*)lds, (const bf16_t*)BIGP + (size_t)b * SEQ * NPROJ, (bf16_t*)OUTP + (size_t)b * SEQ * 4096, 128, 64, h, es, nullptr, OUTP + OUT_SP + (size_t)(b * 8 + h) * 256 * 512); }
    for (int it = blockIdx.x; it < 512; it += G) { const int bh = (it & 7) * 8 + (it >> 6), es = (it >> 3) & 7, b = bh >> 3, h = bh & 7;
        ret::ret_item((LAS char*)lds, (const bf16_t*)BIGP + (size_t)(TP + b * 32) * NPROJ, (bf16_t*)OUTP + (size_t)(TP + b * 32) * 4096, 1, 32, h, es, INF(2) + (size_t)(b * 8 + h) * 256 * 512, OUTP + OUT_SS + (size_t)(b * 8 + h) * 256 * 512); }
}
__device__ __forceinline__ void ph_groupnorm() {
    PH_IDS; bf16_t* PROJ = (bf16_t*)BIGP; const bf16_t* OB = (const bf16_t*)OUTP;
    for (int it = gw; it < TALL * 8; it += NGW) { const int row = it >> 3, h = it & 7;
        bf16_t* op = PROJ + (size_t)row * NPROJ + 4096 + h * 512 + lane * 8; const u32x4 ov = *(const u32x4*)(OB + (size_t)row * 4096 + h * 512 + lane * 8), gv = *(const u32x4*)(op + 4096);
        float o[8], g[8]; const unsigned ow[4] = {ov.x, ov.y, ov.z, ov.w}, gwd[4] = {gv.x, gv.y, gv.z, gv.w};
#pragma unroll
        for (int j = 0; j < 4; ++j) { o[2 * j] = __uint_as_float(ow[j] << 16); o[2 * j + 1] = __uint_as_float(ow[j] & 0xffff0000u); g[2 * j] = __uint_as_float(gwd[j] << 16); g[2 * j + 1] = __uint_as_float(gwd[j] & 0xffff0000u); }
        float s = 0.f;
#pragma unroll
        for (int j = 0; j < 8; ++j) s += o[j];
        const float mu = wave_sum(s) * (1.f / 512.f); float q = 0.f;
#pragma unroll
        for (int j = 0; j < 8; ++j) { o[j] -= mu; q += o[j] * o[j]; }
        const float rstd = 1.0f / sqrtf(wave_sum(q) * (1.f / 512.f) + 1e-5f);
#pragma unroll
        for (int j = 0; j < 8; ++j) o[j] = o[j] * rstd * pg8::silu_f(g[j]);
        u32x4 w; w.x = pk2(o[0], o[1]); w.y = pk2(o[2], o[3]); w.z = pk2(o[4], o[5]); w.w = pk2(o[6], o[7]); *(u32x4*)op = w; }
}
template <bool FIRST> __device__ __forceinline__ void ph_res_gemm(LAS unsigned char* lds, unsigned char* a_ptr, size_t w_off, int K, int lda, bf16_t* hb, int ssq_idx) {
    unsigned char* ws = WSP; float* Hres = OUTP + OUT_Y;
    pg8::Gemm g{(const bf16_t*)a_ptr, (const bf16_t*)(ws + w_off), TALL, DM, K, lda}; pg8::StaticOrder S; S.init(TALL, DM, (int)gridDim.x, (int)blockIdx.x);
    pg8::EpiRes E{FIRST ? INF(0) : Hres, FIRST ? INF(1) : Hres + (size_t)TP * DM, Hres, hb, ssq_idx >= 0 ? (float*)(ws + WS_SSQ) + (size_t)ssq_idx * TALL : nullptr};
    pg8::gemm_phase<pg8::EpiRes, pg8::StaticOrder, true, true>(lds, g, S, E);
}
template <int MODE> __device__ __forceinline__ void ph_rms(const float* g1, size_t o1_off, const float* g2, size_t o2_off) {
    PH_IDS; float* Hres = OUTP + OUT_Y; unsigned char* ws = WSP;
    for (int m = gw; m < TALL; m += NGW) rms_row<MODE>(Hres + (size_t)m * DM, g1, (bf16_t*)(ws + o1_off) + (size_t)m * DM, g2, (bf16_t*)(ws + o2_off) + (size_t)m * DM, Hres + (size_t)m * DM, lane);
}
__device__ __forceinline__ void ph_cache_cvt() {
    PH_IDS; const float* cache_k = INF(3); const float* cache_v = INF(4); bf16_t* KALL = (bf16_t*)(BIGP + BIG_KALL); bf16_t* VALL = (bf16_t*)(BIGP + BIG_VALL);
    for (size_t i = gt; i < (size_t)8 * PASTL * 512 / 4; i += NGT) { const size_t e = i * 4, b = e / ((size_t)PASTL * 512), r = e % ((size_t)PASTL * 512);
        const f32x4 kv = *(const f32x4*)(cache_k + e), vv = *(const f32x4*)(cache_v + e); u32x2 w; w.x = pk2(kv.x, kv.y); w.y = pk2(kv.z, kv.w); *(u32x2*)(KALL + b * LKS * 512 + r) = w;
        w.x = pk2(vv.x, vv.y); w.y = pk2(vv.z, vv.w); *(u32x2*)(VALL + b * LKS * 512 + r) = w; }
}
__device__ __forceinline__ void ph_kvfq(LAS unsigned char* lds) {
    unsigned char* ws = WSP; unsigned char* big = ws + WS_BIG; float* out = OUTP;
    pg8::Gemm g{(const bf16_t*)(big + BIG_XN), (const bf16_t*)(ws + WS_WKVF), TALL, 3328, DM, DM}; pg8::StaticOrder S; S.init(TALL, 3328, (int)gridDim.x, (int)blockIdx.x);
    pg8::EpiKVFQ E{out + OUT_KP, out + OUT_VP, out + OUT_LFP, out + OUT_KS, out + OUT_VS, out + OUT_LFS, (bf16_t*)(big + BIG_KB), (bf16_t*)(big + BIG_VB), (bf16_t*)(big + BIG_KALL), (bf16_t*)(big + BIG_VALL),
                    (bf16_t*)(big + BIG_ACT), INF(15), (const float*)(ws + WS_SSQ) + (size_t)1 * TALL};
    pg8::gemm_phase<pg8::EpiKVFQ, pg8::StaticOrder, true, true>(lds, g, S, E);
}
__device__ __forceinline__ void ph_cumsum(LAS unsigned char* lds) {
    PH_IDS; const float* cache_lf = INF(5); const float* out = OUTP; float* FB = (float*)(WSP + WS_FB); float* FS = (float*)(WSP + WS_FS);
    for (int it = blockIdx.x; it < 64 + 128; it += G) {
        LAS float* wtot = (LAS float*)lds;
        const bool smp = it >= 64; const int bh = smp ? it - 64 : it, b = bh >> 4, h = bh & 15, Ls = smp ? LKS : SEQ, per = smp ? 3 : 16, j0 = tid * per;
        float v[16]; float s = 0.f;
#pragma unroll
        for (int i = 0; i < 16; ++i) { const int j = j0 + i; float x = 0.f;
            if (i < per && j < Ls) x = smp ? (j < PASTL ? cache_lf[((size_t)b * PASTL + j) * 16 + h] : out[OUT_LFS + ((size_t)b * 32 + (j - PASTL)) * 16 + h]) : out[OUT_LFP + ((size_t)b * SEQ + j) * 16 + h];
            s += x; v[i] = s; }
        float inc = s;
#pragma unroll
        for (int o = 1; o < 64; o <<= 1) { const float t = __shfl_up(inc, o); if (lane >= o) inc += t; }
        if (lane == 63) wtot[wave] = inc;
        __syncthreads();
        float base = inc - s;
        for (int w = 0; w < wave; ++w) base += wtot[w];
#pragma unroll
        for (int i = 0; i < 16; ++i) { const int j = j0 + i; if (i < per && j < Ls) { const float F = base + v[i];
            if (smp) FS[(size_t)bh * LKS + j] = F; else FB[(size_t)bh * SEQ + j] = -F * 11.313708498984761f; } }
        __syncthreads();
    }
}
__device__ __forceinline__ void ph_attn(unsigned char* lds_raw) {
    unsigned char* ws = WSP; unsigned char* big = ws + WS_BIG;
    fox::attn_phase((char*)lds_raw, (const bf16_t*)(big + BIG_ACT), (const bf16_t*)(big + BIG_KB), (const bf16_t*)(big + BIG_VB), (bf16_t*)(big + BIG_XN), (const float*)(ws + WS_FB));
}
__device__ __forceinline__ void ph_sattn(LAS unsigned char* lds) {
    unsigned char* ws = WSP; unsigned char* big = ws + WS_BIG;
    sample_attn((LAS char*)lds, (const bf16_t*)(big + BIG_ACT), (const bf16_t*)(big + BIG_KALL), (const bf16_t*)(big + BIG_VALL), (const float*)(ws + WS_FS), (bf16_t*)(big + BIG_XN));
}
__device__ __forceinline__ void ph_gateup(LAS unsigned char* lds, const unsigned char* a_ptr, size_t w_off, int ssq_idx) {
    unsigned char* ws = WSP; unsigned char* big = ws + WS_BIG;
    pg8::Gemm g{(const bf16_t*)a_ptr, (const bf16_t*)(ws + w_off), TALL, 2 * DFF, DM, DM}; pg8::StaticOrder S; S.init(TALL, 2 * DFF, (int)gridDim.x, (int)blockIdx.x);
    pg8::EpiSwiglu E{(bf16_t*)(big + BIG_ACT), (const float*)(ws + WS_SSQ) + (size_t)ssq_idx * TALL};
    pg8::gemm_phase<pg8::EpiSwiglu, pg8::StaticOrder, true, true>(lds, g, S, E);
}

__global__ void __launch_bounds__(NWAVES * 64, 2) yoco_fwd(Params P) {
    extern __shared__ __attribute__((aligned(16))) unsigned char lds_raw[];
    cg::grid_group grid = cg::this_grid();
    LAS unsigned char* lds = (LAS unsigned char*)lds_raw;
    ph_prologue(lds);                                                                                   grid.sync();
    ph_retin(lds);                                                                                      grid.sync();
    ph_retention(lds);                                                                                  grid.sync();
    ph_groupnorm();                                                                                     grid.sync();
    ph_res_gemm<true>(lds, BIGP + 4096 * 2, WS_WRO, 4096, NPROJ, (bf16_t*)(OUTP + OUT_KP), 0);            grid.sync();
    ph_gateup(lds, (const unsigned char*)(OUTP + OUT_KP), WS_WGU0, 0);                                  grid.sync();
    ph_res_gemm<false>(lds, BIGP + BIG_ACT, WS_WDN0, DFF, DFF, (bf16_t*)(BIGP + BIG_XN), 1); ph_cache_cvt();   grid.sync();
    ph_kvfq(lds);                                                                                       grid.sync();
    ph_cumsum(lds);                                                                                     grid.sync();
    ph_attn(lds_raw); __syncthreads(); ph_sattn(lds);                                                   grid.sync();
    ph_res_gemm<false>(lds, BIGP + BIG_XN, WS_WO, DM, DM, (bf16_t*)(BIGP + BIG_HKV), 2);                grid.sync();
    ph_gateup(lds, BIGP + BIG_HKV, WS_WGU1, 2);                                                         grid.sync();
    ph_res_gemm<false>(lds, BIGP + BIG_ACT, WS_WDN1, DFF, DFF, nullptr, -1);                            grid.sync();
    ph_rms<2>(INF(9), 0, nullptr, 0);
}

extern "C" void kernel_launch(void* const* d_in, const int* in_sizes, int n_in, void* d_out, int out_size, void* d_ws, size_t ws_size, hipStream_t stream) {
    static int grid = 0;
    if (grid == 0) {
        if (n_in != 21 || ws_size < WS_END) { fprintf(stderr, "kernel_launch: unexpected n_in %d / ws_size %zu (need %zu)\n", n_in, ws_size, (size_t)WS_END); grid = -1; return; }
        int dev = 0, cus = 0, per_cu = 0;
        (void)hipGetDevice(&dev); (void)hipDeviceGetAttribute(&cus, hipDeviceAttributeMultiprocessorCount, dev);
        if (hipFuncSetAttribute((const void*)yoco_fwd, hipFuncAttributeMaxDynamicSharedMemorySize, LDS_BYTES) != hipSuccess) { fprintf(stderr, "kernel_launch: hipFuncSetAttribute failed\n"); grid = -1; return; }
        if (hipOccupancyMaxActiveBlocksPerMultiprocessor(&per_cu, (const void*)yoco_fwd, NWAVES * 64, LDS_BYTES) != hipSuccess || per_cu < 1) { fprintf(stderr, "kernel_launch: occupancy query says %d\n", per_cu); per_cu = 1; }
        (void)hipGetLastError();
        grid = cus > 0 ? cus : 256;
    }
    if (grid < 0) return;
    Params p{};
    for (int i = 0; i < 21; ++i) p.in[i] = (const float*)d_in[i];
    p.out = (float*)d_out; p.ws = (unsigned char*)d_ws;
    void* args[] = {&p};
    hipError_t e = hipLaunchCooperativeKernel((const void*)yoco_fwd, dim3(grid), dim3(NWAVES * 64), args, LDS_BYTES, stream);
    if (e != hipSuccess) fprintf(stderr, "cooperative launch failed: %s (grid %d)\n", hipGetErrorString(e), grid);
}
```

```cpp
#include <hip/hip_runtime.h>
#include <hip/hip_cooperative_groups.h>
#include <cstdio>
#include <cstdint>
namespace cg = cooperative_groups;
__device__ __forceinline__ int opaque_tid() { int t = threadIdx.x; asm volatile("" : "+v"(t)); return t; }
namespace pg8 {
#define PG8_LAS __attribute__((address_space(3)))
typedef unsigned short bf16_t;
typedef short bf16x8 __attribute__((ext_vector_type(8)));
typedef float f32x4 __attribute__((ext_vector_type(4)));
typedef unsigned u32x4 __attribute__((ext_vector_type(4)));
constexpr int BM = 256, BK = 64, HALF = 128, HTB = HALF * BK * 2  , STAGE_BYTES = 8 * HTB, NXCD = 8, WGM = 8;

__host__ __device__ __forceinline__ int lds_byte(int r, int c) { const int st = (r >> 4) * 2 + (c >> 5), rr = r & 15, cc = c & 31, ob = rr * 64 + cc * 2; return st * 1024 + (ob ^ (((ob >> 9) & 1) << 5)); }
__host__ __device__ __forceinline__ void stage_rc(int b, int& R, int& C) { const int st = b / 1024, sb = b % 1024, swz = sb ^ (((sb >> 9) & 1) << 5); R = (st >> 1) * 16 + swz / 64; C = (st & 1) * 32 + (swz % 64) / 2; }
__host__ __device__ __forceinline__ int perm32(int rho) { const int n = rho >> 4, i = rho & 15; return 8 * (i >> 2) + 4 * n + (i & 3); }

struct Unit { int pm, pn; };
struct Gemm { const bf16_t* A; const bf16_t* Bt; int M, N, K, lda; };

struct StaticOrder {
    int nM, nN, nwg, G, c;
    __host__ __device__ void init(int M, int N, int G_, int c_) { nM = M / BM; nN = N / BM; nwg = nM * nN; G = G_; c = c_; }
    __host__ __device__ bool next(int i, Unit& u) const {
        const long L = (long)i * G + c; if (L >= nwg) return false;
        int wgid = (int)L; { const int q = nwg / NXCD, r = nwg % NXCD, xcd = wgid % NXCD, off = wgid / NXCD; wgid = (xcd < r ? xcd * (q + 1) : r * (q + 1) + (xcd - r) * q) + off; }
        const int nig = WGM * nN, gid = wgid / nig, fm = gid * WGM, gsz = (nM - fm) < WGM ? (nM - fm) : WGM;
        u.pm = fm + ((wgid % nig) % gsz); u.pn = (wgid % nig) / gsz; return true;
    }
    __device__ __forceinline__ void a_ready(const Unit&) const {}
    __device__ __forceinline__ void done(const Unit&) const {}
};

__device__ __forceinline__ unsigned cvt_pk_bf16(float lo, float hi) { unsigned r; asm volatile("v_cvt_pk_bf16_f32 %0, %1, %2" : "=v"(r) : "v"(lo), "v"(hi)); return r; }
template <class Epi, class Sched, bool ALIGN_EPI = false, bool SP2 = false>
__device__ __forceinline__ void gemm_phase(PG8_LAS unsigned char* lds, const Gemm g, const Sched& S, const Epi& E) {
    const int tid = opaque_tid(), wid = __builtin_amdgcn_readfirstlane(tid >> 6), lane = tid & 63, wr = wid >> 2, wc = wid & 3, fr = lane & 15, fq = lane >> 4;
    const int K = g.K, nt = K / BK;
    unsigned voffA[2], voffB[2];
#pragma unroll
    for (int i = 0; i < 2; ++i) { int R, C; stage_rc(tid * 16 + i * 8192, R, C); const int Rb = Epi::PERM ? ((R & ~31) + perm32(R & 31)) : R;
        voffA[i] = (unsigned)(R * g.lda + C) * 2u; voffB[i] = (unsigned)(Rb * K + C) * 2u; }
    const size_t kstep = (size_t)(BK * 2);
    const size_t hstep = (size_t)HALF * K * 2, hstepA = (size_t)HALF * g.lda * 2;
    const size_t tstep = 2 * hstep, tstepA = 2 * hstepA;
    const unsigned ldsw = (unsigned)wid * 1024u;
    const int aoff = lds_byte(wr * 64 + fr, fq * 8), boff = lds_byte(wc * 32 + fr, fq * 8);
#define PG8_SA(b, h) (((b) * 2 + (h)) * HTB)
#define PG8_SB(b, h) ((4 + (b) * 2 + (h)) * HTB)
#define PG8_STAGE(bufoff, gbase, voff) do { _Pragma("unroll") for (int _i = 0; _i < 2; ++_i) \
        __builtin_amdgcn_global_load_lds((const unsigned*)((const char*)(gbase) + (voff)[_i]), (PG8_LAS unsigned*)(lds + (bufoff) + ldsw + _i * 8192), 16, 0, 0); } while (0)
#define PG8_LDA(dst, b, h) do { _Pragma("unroll") for (int m = 0; m < 4; ++m) _Pragma("unroll") for (int k = 0; k < 2; ++k) dst[m][k] = *(const PG8_LAS bf16x8*)(lds + PG8_SA(b, h) + aoff + m * 2048 + k * 1024); } while (0)
#define PG8_LDB(dst, b, h) do { _Pragma("unroll") for (int n = 0; n < 2; ++n) _Pragma("unroll") for (int k = 0; k < 2; ++k) dst[n][k] = *(const PG8_LAS bf16x8*)(lds + PG8_SB(b, h) + boff + n * 2048 + k * 1024); } while (0)
#define PG8_MMA(ai, bj, At, Bt) do { __builtin_amdgcn_s_setprio(1); _Pragma("unroll") for (int m = 0; m < 4; ++m) _Pragma("unroll") for (int n = 0; n < 2; ++n) _Pragma("unroll") for (int k = 0; k < 2; ++k) \
        acc[ai][bj][m][n] = __builtin_amdgcn_mfma_f32_16x16x32_bf16(Bt[n][k], At[m][k], acc[ai][bj][m][n], 0, 0, 0); __builtin_amdgcn_s_setprio(0); } while (0)
#define PG8_WAIT_V(n) asm volatile("s_waitcnt vmcnt(" #n ")" ::: "memory")
#define PG8_WAIT_L(n) asm volatile("s_waitcnt lgkmcnt(" #n ")" ::: "memory")
#define PG8_BAR __builtin_amdgcn_s_barrier()
#define PG8_SCHED __builtin_amdgcn_sched_barrier(0)
    Unit cur, nxt; int ui = 0;
    if (!S.next(0, cur)) return;
    f32x4 acc[2][2][4][2];
#pragma unroll
    for (int a = 0; a < 2; ++a)
#pragma unroll
        for (int b = 0; b < 2; ++b)
#pragma unroll
            for (int m = 0; m < 4; ++m)
#pragma unroll
                for (int n = 0; n < 2; ++n) acc[a][b][m][n] = (f32x4){0.f, 0.f, 0.f, 0.f};
    bf16x8 At[4][2], B0[2][2], B1[2][2];
    const char* cA = (const char*)g.A + (size_t)cur.pm * tstepA; const char* cB = (const char*)g.Bt + (size_t)cur.pn * tstep;
    S.a_ready(cur);
    if constexpr (SP2) {
        PG8_STAGE(PG8_SB(0, 0), cB, voffB); PG8_STAGE(PG8_SB(0, 1), cB + hstep, voffB); PG8_STAGE(PG8_SA(0, 0), cA, voffA); PG8_STAGE(PG8_SA(0, 1), cA + hstepA, voffA);
        if (wr == 1) PG8_BAR;
        PG8_WAIT_V(2); PG8_BAR;
        PG8_STAGE(PG8_SB(1, 0), cB + kstep, voffB); PG8_STAGE(PG8_SA(1, 0), cA + kstep, voffA); PG8_STAGE(PG8_SB(1, 1), cB + hstep + kstep, voffB);
        PG8_WAIT_V(6); PG8_BAR;
    } else {
        PG8_STAGE(PG8_SB(0, 0), cB, voffB); PG8_STAGE(PG8_SA(0, 0), cA, voffA); PG8_STAGE(PG8_SB(0, 1), cB + hstep, voffB); PG8_STAGE(PG8_SA(0, 1), cA + hstepA, voffA);
        if (wr == 1) PG8_BAR;
        PG8_WAIT_V(4); PG8_BAR;
        PG8_STAGE(PG8_SB(1, 0), cB + kstep, voffB); PG8_STAGE(PG8_SA(1, 0), cA + kstep, voffA); PG8_STAGE(PG8_SB(1, 1), cB + hstep + kstep, voffB);
        PG8_WAIT_V(6); PG8_BAR;
    }
    for (;;) {
        const bool has_next = S.next(ui + 1, nxt);
        const char* nA = has_next ? (const char*)g.A + (size_t)nxt.pm * tstepA : cA; const char* nB = has_next ? (const char*)g.Bt + (size_t)nxt.pn * tstep : cB;
        for (int t = 0; t < nt; t += 2) {
            const bool last = (t == nt - 2);
            const char* a1 = cA + (size_t)(t + 1) * kstep;
            const char* a2 = last ? nA : cA + (size_t)(t + 2) * kstep; const char* b2 = last ? nB : cB + (size_t)(t + 2) * kstep;
            const char* a3 = a2 + kstep; const char* b3 = b2 + kstep;
            if (last && has_next) S.a_ready(nxt);
            if constexpr (SP2) {
            PG8_LDB(B0, 0, 0); PG8_LDB(B1, 0, 1); PG8_SCHED; PG8_LDA(At, 0, 0); PG8_STAGE(PG8_SA(1, 1), a1 + hstepA, voffA);
            PG8_WAIT_V(8); PG8_WAIT_L(0); PG8_BAR; PG8_MMA(0, 0, At, B0); PG8_MMA(0, 1, At, B1); PG8_BAR; PG8_SCHED;
            PG8_LDA(At, 0, 1); PG8_STAGE(PG8_SB(0, 0), b2, voffB); PG8_STAGE(PG8_SB(0, 1), b2 + hstep, voffB); PG8_STAGE(PG8_SA(0, 0), a2, voffA);
            PG8_WAIT_V(8); PG8_WAIT_L(0); PG8_BAR; PG8_MMA(1, 0, At, B0); PG8_MMA(1, 1, At, B1); PG8_BAR; PG8_SCHED;
            PG8_LDB(B0, 1, 0); PG8_LDB(B1, 1, 1); PG8_SCHED; PG8_LDA(At, 1, 0); PG8_STAGE(PG8_SA(0, 1), a2 + hstepA, voffA);
            PG8_WAIT_V(8); PG8_WAIT_L(0); PG8_BAR; PG8_MMA(0, 0, At, B0); PG8_MMA(0, 1, At, B1); PG8_BAR; PG8_SCHED;
            PG8_LDA(At, 1, 1); PG8_STAGE(PG8_SB(1, 0), b3, voffB); PG8_STAGE(PG8_SB(1, 1), b3 + hstep, voffB); PG8_STAGE(PG8_SA(1, 0), a3, voffA);
            PG8_WAIT_V(8); PG8_WAIT_L(0); PG8_BAR; PG8_MMA(1, 0, At, B0); PG8_MMA(1, 1, At, B1); PG8_BAR; PG8_SCHED;
            } else {
            PG8_LDB(B0, 0, 0); PG8_SCHED; PG8_LDA(At, 0, 0); PG8_STAGE(PG8_SA(1, 1), a1 + hstepA, voffA);
            PG8_WAIT_L(8); PG8_BAR; PG8_WAIT_L(0); PG8_MMA(0, 0, At, B0); PG8_BAR; PG8_SCHED;
            PG8_LDB(B1, 0, 1); PG8_STAGE(PG8_SB(0, 0), b2, voffB);
            PG8_BAR; PG8_WAIT_L(0); PG8_MMA(0, 1, At, B1); PG8_BAR;
            PG8_LDA(At, 0, 1); PG8_STAGE(PG8_SA(0, 0), a2, voffA);
            PG8_BAR; PG8_WAIT_L(0); PG8_MMA(1, 0, At, B0); PG8_BAR; PG8_SCHED;
            PG8_STAGE(PG8_SB(0, 1), b2 + hstep, voffB);
            PG8_WAIT_V(6); PG8_BAR; PG8_MMA(1, 1, At, B1); PG8_BAR;
            PG8_LDB(B0, 1, 0); PG8_SCHED; PG8_LDA(At, 1, 0); PG8_STAGE(PG8_SA(0, 1), a2 + hstepA, voffA);
            PG8_WAIT_L(8); PG8_BAR; PG8_WAIT_L(0); PG8_MMA(0, 0, At, B0); PG8_BAR; PG8_SCHED;
            PG8_LDB(B1, 1, 1); PG8_STAGE(PG8_SB(1, 0), b3, voffB);
            PG8_BAR; PG8_WAIT_L(0); PG8_MMA(0, 1, At, B1); PG8_BAR;
            PG8_LDA(At, 1, 1); PG8_STAGE(PG8_SA(1, 0), a3, voffA);
            PG8_BAR; PG8_WAIT_L(0); PG8_MMA(1, 0, At, B0); PG8_BAR; PG8_SCHED;
            PG8_STAGE(PG8_SB(1, 1), b3 + hstep, voffB);
            PG8_WAIT_V(6); PG8_BAR; PG8_MMA(1, 1, At, B1); PG8_BAR;
            }
        }
        if constexpr (ALIGN_EPI) { if (wr == 0) PG8_BAR; }
        if constexpr (!Epi::AFTER_DRAIN) { E(acc, cur, wr, wc, fr, fq); S.done(cur); }
        if (!has_next) break;
#pragma unroll
        for (int a = 0; a < 2; ++a)
#pragma unroll
            for (int b = 0; b < 2; ++b)
#pragma unroll
                for (int m = 0; m < 4; ++m)
#pragma unroll
                    for (int n = 0; n < 2; ++n) acc[a][b][m][n] = (f32x4){0.f, 0.f, 0.f, 0.f};
        cur = nxt; cA = nA; cB = nB; ++ui;
        if constexpr (ALIGN_EPI) { if (wr == 1) PG8_BAR; }
    }
    PG8_WAIT_V(0);
    if constexpr (!ALIGN_EPI) { if (wr == 0) PG8_BAR; }
    PG8_BAR;
    if constexpr (Epi::AFTER_DRAIN) { E.fused(acc, cur, wr, wc, fr, fq, lds, wid, lane); S.done(cur); }
#undef PG8_SA
#undef PG8_SB
#undef PG8_STAGE
#undef PG8_LDA
#undef PG8_LDB
#undef PG8_MMA
#undef PG8_WAIT_V
#undef PG8_WAIT_L
#undef PG8_BAR
#undef PG8_SCHED
}
}
constexpr int DM = 2048, TP = 32768, TSMP = 256, TALL = 33024, SEQ = 8192, NPROJ = 12288, DFF = 5632, PASTL = 1024, LKS = 1056;
#define GAS __attribute__((address_space(1)))
#define LAS __attribute__((address_space(3)))
typedef unsigned short bf16_t;
typedef float f32x4 __attribute__((ext_vector_type(4)));
typedef unsigned u32x4 __attribute__((ext_vector_type(4)));
typedef unsigned u32x2 __attribute__((ext_vector_type(2)));
typedef short bf16x8 __attribute__((ext_vector_type(8)));
typedef short s16x4 __attribute__((ext_vector_type(4)));

namespace pg8 {
__device__ __forceinline__ float silu_f(float g) { return g * __builtin_amdgcn_rcpf(1.0f + __builtin_amdgcn_exp2f(-1.4426950408889634f * g)); }
struct EpiBf16P {
    static constexpr bool PERM = true, AFTER_DRAIN = false;
    bf16_t* O; int ldc;
    __device__ __forceinline__ void operator()(const f32x4 (&acc)[2][2][4][2], const Unit& u, int wr, int wc, int fr, int fq) const {
        const int row0 = u.pm * BM + wr * 64 + fr, col0 = u.pn * BM + wc * 32 + 8 * fq;
#pragma unroll
        for (int ai = 0; ai < 2; ++ai)
#pragma unroll
            for (int m = 0; m < 4; ++m) { bf16_t* rowp = O + (size_t)(row0 + ai * HALF + m * 16) * ldc + col0;
#pragma unroll
                for (int bj = 0; bj < 2; ++bj) { const f32x4 v0 = acc[ai][bj][m][0], v1 = acc[ai][bj][m][1];
                    u32x4 w; w.x = cvt_pk_bf16(v0[0], v0[1]); w.y = cvt_pk_bf16(v0[2], v0[3]); w.z = cvt_pk_bf16(v1[0], v1[1]); w.w = cvt_pk_bf16(v1[2], v1[3]);
                    *(u32x4*)(rowp + bj * HALF) = w; } }
    }
};
struct EpiRetIn {
    static constexpr bool PERM = true, AFTER_DRAIN = false;
    bf16_t* O; const float* cosT; const float* sinT;
    __device__ __forceinline__ void operator()(const f32x4 (&acc)[2][2][4][2], const Unit& u, int wr, int wc, int fr, int fq) const {
        const int row0 = u.pm * BM + wr * 64 + fr, cl = wc * 32 + 8 * fq;
        bf16_t* obase = O + (size_t)u.pn * BM + cl;
        if (u.pn < 16) {
            const bool isk = u.pn >= 8; const int h = u.pn & 7;
            const float lg2 = __log2f(1.0f - exp2f(-5.0f - (float)h));
#pragma unroll
            for (int ai = 0; ai < 2; ++ai) {
                f32x4 cs[4][4]; float scv[4];
#pragma unroll
                for (int m = 0; m < 4; ++m) {
                    const int row = row0 + ai * HALF + m * 16; int pos, l;
                    if (row < TP) { pos = row & (SEQ - 1); l = row & 63; } else { const int s = (row - TP) & 31; pos = PASTL + s; l = s; }
                    scv[m] = isk ? exp2f(-lg2 * (float)l) * 0.0625f : exp2f(lg2 * (float)l);
                    const float* cp = cosT + (size_t)pos * 128 + cl; const float* sp = sinT + (size_t)pos * 128 + cl;
                    cs[m][0] = *(const f32x4*)cp; cs[m][1] = *(const f32x4*)(cp + 4); cs[m][2] = *(const f32x4*)sp; cs[m][3] = *(const f32x4*)(sp + 4); }
#pragma unroll
                for (int m = 0; m < 4; ++m) {
                    const int row = row0 + ai * HALF + m * 16; const float sc = scv[m];
                    const f32x4 c0 = cs[m][0], c1 = cs[m][1], s0 = cs[m][2], s1 = cs[m][3];
                    const f32x4 x1a = acc[ai][0][m][0], x1b = acc[ai][0][m][1], x2a = acc[ai][1][m][0], x2b = acc[ai][1][m][1];
                    const f32x4 o1a = (x1a * c0 - x2a * s0) * sc, o1b = (x1b * c1 - x2b * s1) * sc, o2a = (x1a * s0 + x2a * c0) * sc, o2b = (x1b * s1 + x2b * c1) * sc;
                    bf16_t* rowp = obase + (size_t)row * NPROJ;
                    u32x4 w; w.x = cvt_pk_bf16(o1a[0], o1a[1]); w.y = cvt_pk_bf16(o1a[2], o1a[3]); w.z = cvt_pk_bf16(o1b[0], o1b[1]); w.w = cvt_pk_bf16(o1b[2], o1b[3]);
                    *(u32x4*)rowp = w;
                    w.x = cvt_pk_bf16(o2a[0], o2a[1]); w.y = cvt_pk_bf16(o2a[2], o2a[3]); w.z = cvt_pk_bf16(o2b[0], o2b[1]); w.w = cvt_pk_bf16(o2b[2], o2b[3]);
                    *(u32x4*)(rowp + HALF) = w; }
                asm volatile("" ::: "memory"); }
        } else {
#pragma unroll
            for (int ai = 0; ai < 2; ++ai)
#pragma unroll
                for (int m = 0; m < 4; ++m) { bf16_t* rowp = obase + (size_t)(row0 + ai * HALF + m * 16) * NPROJ;
#pragma unroll
                    for (int bj = 0; bj < 2; ++bj) { const f32x4 v0 = acc[ai][bj][m][0], v1 = acc[ai][bj][m][1];
                        u32x4 w; w.x = cvt_pk_bf16(v0[0], v0[1]); w.y = cvt_pk_bf16(v0[2], v0[3]); w.z = cvt_pk_bf16(v1[0], v1[1]); w.w = cvt_pk_bf16(v1[2], v1[3]);
                        *(u32x4*)(rowp + bj * HALF) = w; } }
        }
    }
};
struct EpiRes {
    static constexpr bool PERM = false, AFTER_DRAIN = false;
    const float* baseP; const float* baseS; float* out; bf16_t* hb; float* ssq;
    __device__ __forceinline__ void operator()(const f32x4 (&acc)[2][2][4][2], const Unit& u, int wr, int wc, int fr, int fq) const {
        const int row0 = u.pm * BM + wr * 64 + fr, col0 = u.pn * BM + wc * 32 + 4 * fq;
#pragma unroll
        for (int ai = 0; ai < 2; ++ai) {
            f32x4 bv[4][2][2];
#pragma unroll
            for (int m = 0; m < 4; ++m) { const int row = row0 + ai * HALF + m * 16;
                const float* b = (row < TP ? baseP + (size_t)row * DM : baseS + (size_t)(row - TP) * DM) + col0;
#pragma unroll
                for (int bj = 0; bj < 2; ++bj)
#pragma unroll
                    for (int n = 0; n < 2; ++n) bv[m][bj][n] = *(const f32x4*)(b + bj * HALF + n * 16); }
#pragma unroll
            for (int m = 0; m < 4; ++m) { const int row = row0 + ai * HALF + m * 16; float* o = out + (size_t)row * DM + col0; float ss = 0.f;
#pragma unroll
                for (int bj = 0; bj < 2; ++bj)
#pragma unroll
                    for (int n = 0; n < 2; ++n) { const f32x4 v = bv[m][bj][n] + acc[ai][bj][m][n]; *(f32x4*)(o + bj * HALF + n * 16) = v;
                        if (hb) { u32x2 w; w.x = cvt_pk_bf16(v[0], v[1]); w.y = cvt_pk_bf16(v[2], v[3]); *(u32x2*)(hb + (size_t)row * DM + col0 + bj * HALF + n * 16) = w; }
                        ss += (v[0] * v[0] + v[1] * v[1]) + (v[2] * v[2] + v[3] * v[3]); }
                if (ssq) { ss += __shfl_xor(ss, 16); ss += __shfl_xor(ss, 32);
                    if (fq == 0) (void)__hip_atomic_fetch_add(ssq + row, ss, __ATOMIC_RELAXED, __HIP_MEMORY_SCOPE_AGENT); } }
            asm volatile("" ::: "memory"); }
    }
};
struct EpiSwiglu {
    static constexpr bool PERM = true, AFTER_DRAIN = false;
    bf16_t* O; const float* ssq;
    __device__ __forceinline__ void operator()(const f32x4 (&acc)[2][2][4][2], const Unit& u, int wr, int wc, int fr, int fq) const {
        const int row0 = u.pm * BM + wr * 64 + fr, col0 = u.pn * HALF + wc * 32 + 8 * fq;
        float rs[2][4];
#pragma unroll
        for (int ai = 0; ai < 2; ++ai)
#pragma unroll
            for (int m = 0; m < 4; ++m) rs[ai][m] = ssq[row0 + ai * HALF + m * 16];
#pragma unroll
        for (int ai = 0; ai < 2; ++ai)
#pragma unroll
            for (int m = 0; m < 4; ++m) { bf16_t* rowp = O + (size_t)(row0 + ai * HALF + m * 16) * DFF + col0; const float r = 1.0f / sqrtf(rs[ai][m] * (1.f / DM) + 1e-6f);
                const f32x4 g0 = acc[ai][0][m][0] * r, g1 = acc[ai][0][m][1] * r, u0 = acc[ai][1][m][0] * r, u1 = acc[ai][1][m][1] * r;
                f32x4 a0, a1;
#pragma unroll
                for (int j = 0; j < 4; ++j) { a0[j] = silu_f(g0[j]) * u0[j]; a1[j] = silu_f(g1[j]) * u1[j]; }
                u32x4 w; w.x = cvt_pk_bf16(a0[0], a0[1]); w.y = cvt_pk_bf16(a0[2], a0[3]); w.z = cvt_pk_bf16(a1[0], a1[1]); w.w = cvt_pk_bf16(a1[2], a1[3]);
                *(u32x4*)rowp = w; }
    }
};
struct EpiKVFQ {
    static constexpr bool PERM = false, AFTER_DRAIN = false;
    float* kP; float* vP; float* lfP; float* kS; float* vS; float* lfS; bf16_t* KB; bf16_t* VB; bf16_t* KALL; bf16_t* VALL; bf16_t* QB; const float* bf; const float* ssq;
    __device__ __forceinline__ void operator()(const f32x4 (&acc)[2][2][4][2], const Unit& u, int wr, int wc, int fr, int fq) const {
        const int row0 = u.pm * BM + wr * 64 + fr;
        float rs[2][4];
#pragma unroll
        for (int ai = 0; ai < 2; ++ai)
#pragma unroll
            for (int m = 0; m < 4; ++m) rs[ai][m] = 1.0f / sqrtf(ssq[row0 + ai * HALF + m * 16] * (1.f / DM) + 1e-6f);
        if (u.pn >= 5) {
            const int col0 = (u.pn - 5) * BM + wc * 32 + 4 * fq;
#pragma unroll
            for (int ai = 0; ai < 2; ++ai)
#pragma unroll
                for (int m = 0; m < 4; ++m) { bf16_t* bo = QB + (size_t)(row0 + ai * HALF + m * 16) * DM + col0;
#pragma unroll
                    for (int bj = 0; bj < 2; ++bj)
#pragma unroll
                        for (int n = 0; n < 2; ++n) { const f32x4 v = acc[ai][bj][m][n] * rs[ai][m]; u32x2 w; w.x = cvt_pk_bf16(v[0], v[1]); w.y = cvt_pk_bf16(v[2], v[3]); *(u32x2*)(bo + bj * HALF + n * 16) = w; } }
        } else if (u.pn < 4) {
            const bool isv = u.pn >= 2; const int col0 = (u.pn & 1) * BM + wc * 32 + 4 * fq;
            float* fP = isv ? vP : kP; float* fS = isv ? vS : kS; bf16_t* bP = isv ? VB : KB; bf16_t* bA = isv ? VALL : KALL;
#pragma unroll
            for (int ai = 0; ai < 2; ++ai)
#pragma unroll
                for (int m = 0; m < 4; ++m) { const int row = row0 + ai * HALF + m * 16; float* fo; bf16_t* bo;
                    if (row < TP) { fo = fP + (size_t)row * 512 + col0; bo = bP + (size_t)row * 512 + col0; }
                    else { const int r2 = row - TP; fo = fS + (size_t)r2 * 512 + col0; bo = bA + ((size_t)(r2 >> 5) * LKS + PASTL + (r2 & 31)) * 512 + col0; }
#pragma unroll
                    for (int bj = 0; bj < 2; ++bj)
#pragma unroll
                        for (int n = 0; n < 2; ++n) { const f32x4 v = acc[ai][bj][m][n] * rs[ai][m]; *(f32x4*)(fo + bj * HALF + n * 16) = v;
                            u32x2 w; w.x = cvt_pk_bf16(v[0], v[1]); w.y = cvt_pk_bf16(v[2], v[3]); *(u32x2*)(bo + bj * HALF + n * 16) = w; } }
        } else if (wc == 0) {
            const f32x4 bb = *(const f32x4*)(bf + 4 * fq);
#pragma unroll
            for (int ai = 0; ai < 2; ++ai)
#pragma unroll
                for (int m = 0; m < 4; ++m) { const int row = row0 + ai * HALF + m * 16; const f32x4 z = acc[ai][0][m][0] * rs[ai][m] + bb; f32x4 r;
#pragma unroll
                    for (int j = 0; j < 4; ++j) r[j] = fminf(z[j], 0.f) - log1pf(__expf(-fabsf(z[j])));
                    float* o = row < TP ? lfP + (size_t)row * 16 : lfS + (size_t)(row - TP) * 16; *(f32x4*)(o + 4 * fq) = r; }
        }
    }
};
}
namespace fox {
enum { ORDER_NATURAL = 0, ORDER_REVERSED = 1, ORDER_PAIRED = 2, ORDER_XCD = 4 };
constexpr int D = 128, QS = 2048, KS = 512, OS = 2048;
constexpr float THR = 8.f;
constexpr bool WSKIP = false;
constexpr float SCALE = 0.08838834764831845f;
constexpr int NW = 8, QBLK = 32, KVBLK = 64, QB = NW * QBLK;
constexpr int SHM_V = KVBLK * D * 2, SHM_K = KVBLK * D * 2;
constexpr int LDS_BYTES = 2 * SHM_V + 2 * SHM_K + NW * 64 * 4 + 2 * 64 * 4;
typedef unsigned short bf16;
typedef short bf16x8 __attribute__((ext_vector_type(8)));
typedef short s16x4 __attribute__((ext_vector_type(4)));
typedef float f32x16 __attribute__((ext_vector_type(16)));
typedef float f32x4 __attribute__((ext_vector_type(4)));
typedef unsigned u32x4 __attribute__((ext_vector_type(4)));
template <class A, class Bt> struct same_t { static constexpr bool v = false; };
template <class A> struct same_t<A, A> { static constexpr bool v = true; };

#define KSWZ(row, colB) ((row) * 256 + ((colB) ^ (((row) & 7) << 4)))
#define SBAR() __builtin_amdgcn_sched_barrier(0)
__device__ __forceinline__ int v_st(int k, int c) { const int kk = (k & ~0xC) | ((k & 4) << 1) | ((k & 8) >> 1); return ((kk >> 3) * 4 + (c >> 5)) * 512 + ((kk & 7) * 32 + (c & 31)) * 2; }
__device__ __forceinline__ int v_rd_base(int lane) { return ((lane & 3) << 3) | (((lane >> 2) & 3) << 6) | (((lane >> 4) & 1) << 5) | (((lane >> 5) & 1) << 8); }
constexpr int v_rd_off(int d0, int ks, int half) { return d0 * 512 + ks * 4096 + half * 2048; }
__device__ __forceinline__ int crow(int r, int hi) { return (r & 3) + 8 * (r >> 2) + 4 * hi; }
__device__ __forceinline__ unsigned cvtpk(float lo, float hi) {
    unsigned r; asm volatile("v_cvt_pk_bf16_f32 %0, %1, %2" : "=v"(r) : "v"(lo), "v"(hi)); return r;
}
__device__ __forceinline__ bf16x8 pack8(f32x4 a, f32x4 b) {
    u32x4 w = {cvtpk(a[0], a[1]), cvtpk(a[2], a[3]), cvtpk(b[0], b[1]), cvtpk(b[2], b[3])};
    return *reinterpret_cast<bf16x8*>(&w);
}
template <class T> __device__ __forceinline__ bf16x8 load8(const T* p) {
    if constexpr (same_t<T, float>::v) { return pack8(*(const f32x4*)p, *(const f32x4*)(p + 4)); }
    else { return *reinterpret_cast<const bf16x8*>(p); }
}
__device__ __forceinline__ void mask_tile(f32x16& p0, f32x16& p1, int dq, unsigned W) {
    const float NEG = -__builtin_inff();
#pragma unroll
    for (int r = 0; r < 16; ++r) {
        const int c = (r & 3) + 8 * (r >> 2);
        if ((unsigned)(dq - c) >= W) p0[r] = NEG;
        if ((unsigned)(dq - c - 32) >= W) p1[r] = NEG;
    }
}
__device__ __forceinline__ void partialSM(f32x16& p0, f32x16& p1, float& m_reg, float& mn, float& alpha) {
    float pmax = p0[0]; for (int r = 1; r < 16; ++r) pmax = fmaxf(pmax, p0[r]); for (int r = 0; r < 16; ++r) pmax = fmaxf(pmax, p1[r]);
    { auto rr = __builtin_amdgcn_permlane32_swap(__float_as_uint(pmax), __float_as_uint(pmax), false, false);
      pmax = fmaxf(__uint_as_float(rr[0]), __uint_as_float(rr[1])); }
    constexpr float C2 = 1.4426950408889634f * SCALE;
    if (__builtin_expect(__all((pmax - m_reg) * SCALE <= THR), 1)) { mn = m_reg; alpha = 1.f; }
    else { mn = fmaxf(m_reg, pmax); alpha = __builtin_amdgcn_exp2f((m_reg - mn) * C2); m_reg = mn; }
    const float mnL = -mn * C2;
    for (int r = 0; r < 16; ++r) p0[r] = fmaf(p0[r], C2, mnL); for (int r = 0; r < 16; ++r) p1[r] = fmaf(p1[r], C2, mnL);
    for (int r = 0; r < 16; ++r) p0[r] = __builtin_amdgcn_exp2f(p0[r]);
}
__device__ __forceinline__ void finishSM(f32x16& p0, f32x16& p1, float alpha, float& l_reg, bf16x8& pa0, bf16x8& pa1, bf16x8& pa2, bf16x8& pa3) {
    for (int r = 0; r < 16; ++r) p1[r] = __builtin_amdgcn_exp2f(p1[r]);
    float ps = 0; for (int r = 0; r < 16; ++r) ps += p0[r]; for (int r = 0; r < 16; ++r) ps += p1[r];
    { auto rr = __builtin_amdgcn_permlane32_swap(__float_as_uint(ps), __float_as_uint(ps), false, false);
      ps = __uint_as_float(rr[0]) + __uint_as_float(rr[1]); }
    l_reg = l_reg * alpha + ps;
#define PK4(P, B_, OUT) do { unsigned a0 = cvtpk(P[B_+0], P[B_+1]), a1 = cvtpk(P[B_+2], P[B_+3]);                          \
        unsigned b0 = cvtpk(P[B_+4], P[B_+5]), b1 = cvtpk(P[B_+6], P[B_+7]);                                             \
        auto r0 = __builtin_amdgcn_permlane32_swap(a0, b0, false, false); auto r1 = __builtin_amdgcn_permlane32_swap(a1, b1, false, false); \
        u32x4 w = {r0[0], r1[0], r0[1], r1[1]}; OUT = *reinterpret_cast<bf16x8*>(&w); } while (0)
    PK4(p0, 0, pa0); PK4(p0, 8, pa1); PK4(p1, 0, pa2); PK4(p1, 8, pa3);
#undef PK4
}
template <int KB, bool SK>
__device__ __forceinline__ void qkt(f32x16& p0, f32x16& p1, const char* K_lds, int r32, int hi, const bf16x8* qr, bool act) {
    if (SK && !act) { const float NEG = -__builtin_inff();
#pragma unroll
        for (int r = 0; r < 16; ++r) { p0[r] = NEG; p1[r] = NEG; } return; }
    { const float* bb_ = (const float*)(K_lds + 2 * SHM_K + NW * 64 * 4) + KB * 64 + 4 * hi;
#pragma unroll
      for (int q_ = 0; q_ < 4; ++q_) { const f32x4 b0_ = *(const f32x4*)(bb_ + 8 * q_), b1_ = *(const f32x4*)(bb_ + 32 + 8 * q_);
#pragma unroll
        for (int i_ = 0; i_ < 4; ++i_) { p0[4 * q_ + i_] = b0_[i_]; p1[4 * q_ + i_] = b1_[i_]; } } }
    const char* kb[4];
#pragma unroll
    for (int dd = 0; dd < 4; ++dd) kb[dd] = K_lds + KB * SHM_K + KSWZ(r32, (dd * 16 + hi * 8) * 2);
#pragma unroll
    for (int d0 = 0; d0 < 8; ++d0) { const char* a = kb[d0 & 3] + (d0 >> 2) * 128;
        bf16x8 b0 = *reinterpret_cast<const bf16x8*>(a);
        bf16x8 b1 = *reinterpret_cast<const bf16x8*>(a + 32 * 256);
        p0 = __builtin_amdgcn_mfma_f32_32x32x16_bf16(b0, qr[d0], p0, 0, 0, 0);
        p1 = __builtin_amdgcn_mfma_f32_32x32x16_bf16(b1, qr[d0], p1, 0, 0, 0); }
}
template <int VB, bool SK>
__device__ __forceinline__ void pv_tile(f32x16* o, int vb0, bf16x8 pa0, bf16x8 pa1, bf16x8 pa2, bf16x8 pa3, bool act) {
    if (SK && !act) return;
#define TRRD(dst, off) asm volatile("ds_read_b64_tr_b16 %0, %1 offset:%2" : "=&v"(dst) : "v"(vb0), "i"(off) : "memory")
#define PV_D0(d0) do { s16x4 l0, l1, l2, l3, h0, h1, h2, h3; constexpr int b_ = VB * SHM_V + v_rd_off(d0, 0, 0);     \
        TRRD(l0, b_); TRRD(h0, b_ + 2048); TRRD(l1, b_ + 4096); TRRD(h1, b_ + 6144); TRRD(l2, b_ + 8192); TRRD(h2, b_ + 10240); TRRD(l3, b_ + 12288); TRRD(h3, b_ + 14336); \
        asm volatile("s_waitcnt lgkmcnt(0)" ::: "memory"); SBAR();                 \
        o[d0] = __builtin_amdgcn_mfma_f32_32x32x16_bf16(pa0, (bf16x8){l0[0], l0[1], l0[2], l0[3], h0[0], h0[1], h0[2], h0[3]}, o[d0], 0, 0, 0);   \
        o[d0] = __builtin_amdgcn_mfma_f32_32x32x16_bf16(pa1, (bf16x8){l1[0], l1[1], l1[2], l1[3], h1[0], h1[1], h1[2], h1[3]}, o[d0], 0, 0, 0);   \
        o[d0] = __builtin_amdgcn_mfma_f32_32x32x16_bf16(pa2, (bf16x8){l2[0], l2[1], l2[2], l2[3], h2[0], h2[1], h2[2], h2[3]}, o[d0], 0, 0, 0);   \
        o[d0] = __builtin_amdgcn_mfma_f32_32x32x16_bf16(pa3, (bf16x8){l3[0], l3[1], l3[2], l3[3], h3[0], h3[1], h3[2], h3[3]}, o[d0], 0, 0, 0); } while (0)
    PV_D0(0); PV_D0(1); PV_D0(2); PV_D0(3);
#undef PV_D0
#undef TRRD
}
template <class TIn, class TOut> struct BlockRef { const TIn* Q; const TIn* K; const TIn* V; TOut* O; const float* FB; int P0; };
template <class TIn> struct Seam {
    bf16x8 qr[8];
    bf16x8 st_v0, st_v1, st_k0, st_k1; float st_f; f32x4 sf0, sf1, sf2, sf3;
    f32x4 tq[16];
};
__device__ __forceinline__ int swa_jlo(int P0, int W) { const int lowk = P0 - W + 1; return lowk > 0 ? lowk / KVBLK : 0; }
#define ROW(p, k0, rr) ((p) + (size_t)((k0) + (rr)) * KS + sc)
#define VMW() asm volatile("s_waitcnt vmcnt(0)" ::: "memory")
#define VMWN(n) asm volatile("s_waitcnt vmcnt(%0)" :: "i"(n) : "memory")
#define SLOAD_H(Kp, Vp, Fp, k0) do { S.st_f = (Fp)[(k0) + (tid & 63)]; S.st_v0 = load8<TIn>(ROW(Vp, k0, sr)); S.st_v1 = load8<TIn>(ROW(Vp, k0, 32 + sr));              \
                         S.st_k0 = load8<TIn>(ROW(Kp, k0, sr)); S.st_k1 = load8<TIn>(ROW(Kp, k0, 32 + sr)); } while (0)
#define SWRITE_HK(bf) do { ((float*)(K_lds + 2 * SHM_K + NW * 64 * 4))[(bf) * 64 + (tid & 63)] = S.st_f; *(bf16x8*)(K_lds + (bf) * SHM_K + kws) = S.st_k0; *(bf16x8*)(K_lds + (bf) * SHM_K + kws + 32 * 256) = S.st_k1; } while (0)
#define SWRITE_HV(bf) do { *(bf16x8*)(V_lds + (bf) * SHM_V + vst0) = S.st_v0; *(bf16x8*)(V_lds + (bf) * SHM_V + vst1) = S.st_v1; } while (0)
#define SWRITE_H(bf) do { SWRITE_HV(bf); SWRITE_HK(bf); } while (0)
#define SLOAD_F(p, k0) do { S.sf0 = *(const f32x4*)ROW(p, k0, sr); S.sf1 = *(const f32x4*)(ROW(p, k0, sr) + 4);                \
                            S.sf2 = *(const f32x4*)ROW(p, k0, 32 + sr); S.sf3 = *(const f32x4*)(ROW(p, k0, 32 + sr) + 4); } while (0)
#define SWRITE_KF(bf) do { *(bf16x8*)(K_lds + (bf) * SHM_K + kws) = pack8(S.sf0, S.sf1); *(bf16x8*)(K_lds + (bf) * SHM_K + kws + 32 * 256) = pack8(S.sf2, S.sf3); } while (0)
#define SWRITE_VF(bf) do { *(bf16x8*)(V_lds + (bf) * SHM_V + vst0) = pack8(S.sf0, S.sf1); *(bf16x8*)(V_lds + (bf) * SHM_V + vst1) = pack8(S.sf2, S.sf3); } while (0)
template <class TIn, class TOut>
__device__ __forceinline__ void causal_swa_prime(const BlockRef<TIn, TOut>& cur, int W, char* lds, Seam<TIn>& S) {
    constexpr bool F32 = same_t<TIn, float>::v;
    const int tid = opaque_tid(), wid = __builtin_amdgcn_readfirstlane(tid >> 6), lane = tid & 63, r32 = lane & 31, hi = lane >> 5;
    const int sr = tid >> 4, sc = (tid & 15) * 8, kws = KSWZ(sr, sc * 2); char* K_lds = lds + 2 * SHM_V;
    const int kb0 = swa_jlo(cur.P0, W) * KVBLK;
    for (int d0 = 0; d0 < 8; ++d0) S.qr[d0] = load8<TIn>(cur.Q + (size_t)(wid * QBLK + r32) * QS + d0 * 16 + hi * 8);
    if constexpr (F32) { SLOAD_F((const float*)cur.K, kb0); VMW(); SWRITE_KF(0); SBAR(); SLOAD_F((const float*)cur.V, kb0); }
    else { SLOAD_H(cur.K, cur.V, cur.FB, kb0); VMW(); SWRITE_HK(0); }
    __syncthreads();
}
template <class TIn, class TOut>
__device__ __forceinline__ void causal_swa_block(const BlockRef<TIn, TOut>& cur, const BlockRef<TIn, TOut>& nxt, int skv, int W, char* lds, Seam<TIn>& S) {
    constexpr bool F32 = same_t<TIn, float>::v;
    const int tid = opaque_tid(), wid = __builtin_amdgcn_readfirstlane(tid >> 6), lane = tid & 63, r32 = lane & 31, hi = lane >> 5;
    const int j_lo = swa_jlo(cur.P0, W);
    int j_hi = (cur.P0 + QB - 1) / KVBLK + 1; if (j_hi > skv / KVBLK) j_hi = skv / KVBLK;
    const int NT = j_hi - j_lo;
    const int kbn = swa_jlo(nxt.P0, W) * KVBLK;
    const int qlo = cur.P0 + wid * QBLK, qm = qlo + r32 - 4 * hi;
    char* V_lds = lds; char* K_lds = lds + 2 * SHM_V;
    float* ws = (float*)(lds + 2 * SHM_V + 2 * SHM_K) + wid * 64; float* li_l = ws, * al_l = ws + 32;
    float m_reg = -1e30f, l_reg = 0; f32x16 o[4] = {};
    const int sr = tid >> 4, sc = (tid & 15) * 8, vst0 = v_st(sr, sc), vst1 = v_st(32 + sr, sc), kws = KSWZ(sr, sc * 2);
    const int vb0 = (int)(uintptr_t)V_lds + v_rd_base(lane);
    const TIn* Kh = cur.K; const TIn* Vh = cur.V;
#define RESC(a) do { if (__any((a) < 1.f)) { if (hi == 0) al_l[r32] = (a); asm volatile("s_waitcnt lgkmcnt(0)" ::: "memory");              \
                     for (int d_ = 0; d_ < 4; ++d_) for (int r = 0; r < 16; ++r) o[d_][r] *= al_l[crow(r, hi)]; } } while (0)
#define KBASE(t) ((j_lo + (t)) * KVBLK)
#define ACT(t) (KBASE(t) <= qlo + QBLK - 1 && KBASE(t) + KVBLK - 1 >= qlo - W + 1)
#define MASKT(P0_, P1_, t) do { const int kb_ = KBASE(t); if ((!SK || ACT(t)) && (kb_ + KVBLK - 1 > qlo || kb_ <= qlo + QBLK - 1 - W)) mask_tile(P0_, P1_, qm - kb_, (unsigned)W); } while (0)
    constexpr int NQL = F32 ? 16 : 8;
    constexpr bool SK = WSKIP && !F32;
#define SEAM_K0() do { VMWN(NQL); if constexpr (F32) { SWRITE_KF(0); SBAR(); SLOAD_F((const float*)nxt.V, kbn); } else { SWRITE_HK(0); } SBAR(); } while (0)
    f32x16 pA0, pA1, pB0, pB1; float mnA, mnB, alA, alB; bf16x8 pa0, pa1, pa2, pa3;
    if constexpr (F32) { VMW(); SWRITE_VF(0); SBAR(); } else { SWRITE_HV(0); SBAR(); }
    if (NT > 1) { if constexpr (F32) SLOAD_F((const float*)Kh, KBASE(1)); else SLOAD_H(Kh, Vh, cur.FB, KBASE(1)); }
    SBAR(); qkt<0, SK>(pA0, pA1, K_lds, r32, hi, S.qr, ACT(0));
    if constexpr (F32) { if (NT > 1) { VMW(); SWRITE_KF(1); SBAR(); SLOAD_F((const float*)Vh, KBASE(1)); } }
    MASKT(pA0, pA1, 0); partialSM(pA0, pA1, m_reg, mnA, alA);
    if (NT > 1) { VMW(); if constexpr (F32) { SWRITE_VF(1); SBAR(); if (NT > 2) SLOAD_F((const float*)Kh, KBASE(2)); } else SWRITE_H(1); }
    __syncthreads();
#define HALF_STEP(PX0, PX1, mnX, alX, PY0, PY1, alY, t, KB, VB, SB) do {                                                      \
        SBAR(); qkt<KB, SK>(PX0, PX1, K_lds, r32, hi, S.qr, ACT(t));                                             \
        finishSM(PY0, PY1, alY, l_reg, pa0, pa1, pa2, pa3); SBAR();                                                           \
        if ((t) + 1 < NT) { if constexpr (F32) { VMW(); SWRITE_KF(SB); SBAR(); SLOAD_F((const float*)Vh, KBASE((t) + 1)); }  \
                            else { SLOAD_H(Kh, Vh, cur.FB, KBASE((t) + 1)); } SBAR(); }                                               \
        pv_tile<VB, SK>(o, vb0, pa0, pa1, pa2, pa3, ACT((t) - 1)); MASKT(PX0, PX1, (t)); partialSM(PX0, PX1, m_reg, mnX, alX);                                        \
        __syncthreads();                                                                                                      \
        if ((t) + 1 < NT) { VMW(); if constexpr (F32) { SWRITE_VF(SB); SBAR(); if ((t) + 2 < NT) SLOAD_F((const float*)Kh, KBASE((t) + 2)); } \
                            else { SWRITE_H(SB); } }                                                                          \
        RESC(alX); __syncthreads(); } while (0)
    for (int t = 1; t + 1 < NT; t += 2) {
        HALF_STEP(pB0, pB1, mnB, alB, pA0, pA1, alA, t, 1, 0, 0);
        HALF_STEP(pA0, pA1, mnA, alA, pB0, pB1, alB, t + 1, 0, 1, 1);
    }
    const bool even = (NT & 1) == 0;
    if (even) { SBAR(); qkt<1, SK>(pB0, pB1, K_lds, r32, hi, S.qr, ACT(NT - 1)); SBAR(); }
#define QROW(e) (nxt.Q + (size_t)(wid * QBLK + r32) * D + ((e) >> 1) * 16 + hi * 8 + ((e) & 1) * 4)
    if constexpr (F32) { SLOAD_F((const float*)nxt.K, kbn); SBAR();
#pragma unroll
        for (int e = 0; e < 8; ++e) S.tq[e] = *(const f32x4*)QROW(e); }
    else { SLOAD_H(nxt.K, nxt.V, nxt.FB, kbn); SBAR();
#pragma unroll
        for (int d0 = 0; d0 < 8; ++d0) S.qr[d0] = load8<TIn>(nxt.Q + (size_t)(wid * QBLK + r32) * QS + d0 * 16 + hi * 8); }
    SBAR();
    finishSM(pA0, pA1, alA, l_reg, pa0, pa1, pa2, pa3); SBAR();
    if constexpr (F32) {
#pragma unroll
        for (int e = 8; e < 16; ++e) S.tq[e] = *(const f32x4*)QROW(e); SBAR(); }
#undef QROW
    pv_tile<0, SK>(o, vb0, pa0, pa1, pa2, pa3, ACT(even ? NT - 2 : NT - 1));
    if (even) { MASKT(pB0, pB1, NT - 1); partialSM(pB0, pB1, m_reg, mnB, alB); __syncthreads(); RESC(alB);
        finishSM(pB0, pB1, alB, l_reg, pa0, pa1, pa2, pa3); SBAR(); pv_tile<1, SK>(o, vb0, pa0, pa1, pa2, pa3, ACT(NT - 1)); }
    SBAR(); SEAM_K0();
    if (hi == 0) li_l[r32] = l_reg; asm volatile("s_waitcnt lgkmcnt(0)" ::: "memory");
    float rli[16];
#pragma unroll
    for (int r = 0; r < 16; ++r) rli[r] = __builtin_amdgcn_rcpf(li_l[crow(r, hi)]);
    TOut* Ow = cur.O + (size_t)(wid * QBLK) * OS;
#pragma unroll
    for (int r = 0; r < 16; ++r) { const int orow = crow(r, hi);
#pragma unroll
        for (int d0 = 0; d0 < 4; ++d0) { const float v = o[d0][r] * rli[r];
            if constexpr (same_t<TOut, float>::v) { Ow[(size_t)orow * OS + d0 * 32 + r32] = v; }
            else { const float vn = __shfl_xor(v, 1);
                   if ((r32 & 1) == 0) *(unsigned*)(Ow + (size_t)orow * OS + d0 * 32 + r32) = cvtpk(v, vn); } } }
    if constexpr (F32) {
#pragma unroll
        for (int d0 = 0; d0 < 8; ++d0) S.qr[d0] = pack8(S.tq[2 * d0], S.tq[2 * d0 + 1]); }
    __syncthreads();
#undef RESC
#undef KBASE
#undef ACT
#undef MASKT
#undef SEAM_K0
#undef HALF_STEP
}
#undef ROW
#undef VMW
#undef VMWN
#undef SLOAD_H
#undef SWRITE_HK
#undef SWRITE_HV
#undef SWRITE_H
#undef SLOAD_F
#undef SWRITE_KF
#undef SWRITE_VF

__host__ __device__ inline int swa_nramp(int nqb, int W, int qoff) { const int t = W - 1 - qoff; const int n = t < 0 ? 0 : t / QB + 1; return n > nqb ? nqb : n; }
__host__ __device__ inline int swa_nx(int nqb, int nramp, int order) { return (order & ORDER_PAIRED) ? (nramp + 1) / 2 + (nqb - nramp) : nqb; }
struct SwaItem { int bh, qb0, qb1; };
__device__ __forceinline__ SwaItem swa_decode(int L, int nb, int nh, int nhkv, int nqb, int nx, int nramp, int order) {
    const int G = nh / nhkv; SwaItem it; int x;
    if ((order & ORDER_XCD) && (nb * nhkv) % 8 == 0) { const int xcd = L & 7, k = L >> 3, per = G * nx, gi = k / per, r = k - gi * per;
        it.bh = (gi * 8 + xcd) * G + r / nx; x = r % nx; }
    else { it.bh = L / nx; x = L - it.bh * nx; }
    if (order & ORDER_PAIRED) { const int ns = nqb - nramp;
        if (x < ns) { it.qb0 = it.qb1 = nqb - 1 - x; } else { it.qb0 = x - ns; it.qb1 = nramp - 1 - it.qb0; } }
    else { it.qb0 = it.qb1 = ((order & 3) == ORDER_REVERSED) ? nqb - 1 - x : x; }
    return it;
}
typedef unsigned short bf16;
__device__ __forceinline__ BlockRef<bf16, bf16> mk_ref(const SwaItem& it, int pass, const bf16* Q, const bf16* K, const bf16* V, bf16* O, const float* FB) {
    const int qb = pass ? it.qb1 : it.qb0, b = it.bh >> 4, h = it.bh & 15, kvh = h >> 2;
    BlockRef<bf16, bf16> r;
    r.Q = Q + ((size_t)b * 8192 + (size_t)qb * QB) * QS + h * 128; r.O = O + ((size_t)b * 8192 + (size_t)qb * QB) * OS + h * 128;
    r.K = K + (size_t)b * 8192 * KS + kvh * 128; r.V = V + (size_t)b * 8192 * KS + kvh * 128; r.FB = FB + (size_t)it.bh * 8192; r.P0 = qb * QB;
    return r;
}
__device__ __forceinline__ void attn_phase(char* lds, const bf16* Q, const bf16* K, const bf16* V, bf16* O, const float* FB) {
    constexpr int nb = 4, nh = 16, nhkv = 4, nqb = 32, W = 8192, order = ORDER_PAIRED | ORDER_XCD;
    const int nramp = swa_nramp(nqb, W, 0), nx = swa_nx(nqb, nramp, order), total = nx * nb * nh, stride = gridDim.x;
    int L = blockIdx.x; if (L >= total) return;
    SwaItem it = swa_decode(L, nb, nh, nhkv, nqb, nx, nramp, order); int pass = 0;
    BlockRef<bf16, bf16> cur = mk_ref(it, 0, Q, K, V, O, FB);
    Seam<bf16> S;
    causal_swa_prime<bf16, bf16>(cur, W, lds, S);
    for (;;) {
        const bool more_pass = pass == 0 && it.qb1 != it.qb0, more_item = L + stride < total, last = !more_pass && !more_item;
        SwaItem itn = it; int passn = pass + 1, Ln = L;
        if (!more_pass) { passn = 0; Ln = more_item ? L + stride : L; itn = swa_decode(Ln, nb, nh, nhkv, nqb, nx, nramp, order); }
        const BlockRef<bf16, bf16> nxt = last ? cur : mk_ref(itn, passn, Q, K, V, O, FB);
        causal_swa_block<bf16, bf16>(cur, nxt, 8192, W, lds, S);
        if (last) break;
        cur = nxt; it = itn; pass = passn; L = Ln;
    }
}
}
constexpr size_t WS_WIN = 0, WS_WRO = 50331648, WS_WGU0 = 67108864, WS_WGU1 = 113246208, WS_WDN0 = 159383552, WS_WDN1 = 182452224,
                 WS_WO = 205520896, WS_WKVF = 213909504  , WS_COS = 227540992, WS_SIN = 231735296, WS_FB = 235929600, WS_FS = WS_FB + 2097152, WS_SSQ = WS_FS + 540672  ,
                 WS_BIG = 239075328;
constexpr size_t SZ_ROWS2K = (size_t)TALL * DM * 2;
constexpr size_t BIG_XN = 0, BIG_ACT = SZ_ROWS2K, BIG_HKV = BIG_ACT + (size_t)TALL * DFF * 2, BIG_KB = BIG_HKV + SZ_ROWS2K, BIG_VB = BIG_KB + (size_t)TP * 512 * 2,
                 BIG_KALL = BIG_VB + (size_t)TP * 512 * 2, BIG_VALL = BIG_KALL + (size_t)8 * LKS * 512 * 2, BIG_END = BIG_VALL + (size_t)8 * LKS * 512 * 2;
static_assert(BIG_END <= (size_t)TALL * NPROJ * 2, "layer-1 buffers fit in the PROJ region");
constexpr size_t WS_END = WS_BIG + (size_t)TALL * NPROJ * 2;
static_assert(WS_END <= (size_t)1073741824, "workspace fits 1 GiB");
constexpr size_t OUT_Y = 0, OUT_SP = 67633152, OUT_KP = 71827456, OUT_VP = 88604672, OUT_LFP = 105381888, OUT_SS = 105906176, OUT_KS = 114294784, OUT_VS = 114425856, OUT_LFS = 114556928;
constexpr int NWAVES = 8, LDS_BYTES = 149504;

struct Params { const float* in[21]; float* out; unsigned char* ws; };

__device__ __forceinline__ float wave_sum(float v) {
#pragma unroll
    for (int o = 1; o < 64; o <<= 1) v += __shfl_xor(v, o);
    return v;
}
__device__ __forceinline__ float bf2f(unsigned short b) { return __uint_as_float(((unsigned)b) << 16); }
__device__ __forceinline__ unsigned pk2(float lo, float hi) { return pg8::cvt_pk_bf16(lo, hi); }

__device__ __forceinline__ void transpose_item(const float* W, int K, int N, bf16_t* WT, int k0, int n0, int drow0, LAS float* scr, int lane, const float* gain = nullptr) {
#pragma unroll 8
    for (int i = 0; i < 32; ++i) { const int kk = 2 * i + (lane >> 5); scr[kk * 33 + (lane & 31)] = W[(size_t)(k0 + kk) * N + n0 + (lane & 31)] * (gain ? gain[k0 + kk] : 1.f); }
    asm volatile("s_waitcnt lgkmcnt(0)" ::: "memory");
    const int c = lane & 7;
#pragma unroll
    for (int j = 0; j < 4; ++j) { const int n = (lane >> 3) + 8 * j; const LAS float* s = scr + (8 * c) * 33 + n;
        u32x4 o; o.x = pk2(s[0 * 33], s[1 * 33]); o.y = pk2(s[2 * 33], s[3 * 33]); o.z = pk2(s[4 * 33], s[5 * 33]); o.w = pk2(s[6 * 33], s[7 * 33]);
        *(u32x4*)(WT + (size_t)(drow0 + n) * K + k0 + 8 * c) = o; }
    asm volatile("s_waitcnt lgkmcnt(0)" ::: "memory");
}
__device__ __forceinline__ void tr_plain(const float* W, int K, int N, bf16_t* WT, int row_off, LAS float* scr, int item, int lane, const float* gain = nullptr) {
    const int nblk = N / 32, kb = item / nblk, nb = item % nblk; transpose_item(W, K, N, WT, 64 * kb, 32 * nb, row_off + 32 * nb, scr, lane, gain);
}
__device__ __forceinline__ void tr_gu(const float* W, bf16_t* WT, int up, LAS float* scr, int item, int lane, const float* gain) {
    const int nblk = DFF / 32, kb = item / nblk, nb = item % nblk, n0 = 32 * nb; transpose_item(W, DM, DFF, WT, 64 * kb, n0, (n0 >> 7) * 256 + up * 128 + (n0 & 127), scr, lane, gain);
}
template <int MODE  >
__device__ __forceinline__ void rms_row(const float* xrow, const float* g1, bf16_t* o1, const float* g2, bf16_t* o2, float* of, int lane) {
    const f32x4* xr = (const f32x4*)xrow + lane;
    f32x4 v[8]; float s = 0.f;
#pragma unroll
    for (int j = 0; j < 8; ++j) { v[j] = xr[64 * j]; s += (v[j].x * v[j].x + v[j].y * v[j].y) + (v[j].z * v[j].z + v[j].w * v[j].w); }
    const float rs = 1.0f / sqrtf(wave_sum(s) * (1.f / DM) + 1e-6f);
#pragma unroll
    for (int j = 0; j < 8; ++j) { const f32x4 ga = ((const f32x4*)g1)[64 * j + lane]; const f32x4 y = v[j] * rs;
        if (MODE == 2) { ((f32x4*)of)[64 * j + lane] = y * ga; }
        else { u32x2 w; w.x = pk2(y.x * ga.x, y.y * ga.y); w.y = pk2(y.z * ga.z, y.w * ga.w); ((u32x2*)o1)[64 * j + lane] = w;
            if (MODE == 1) { const f32x4 gb = ((const f32x4*)g2)[64 * j + lane]; u32x2 w2; w2.x = pk2(y.x * gb.x, y.y * gb.y); w2.y = pk2(y.z * gb.z, y.w * gb.w); ((u32x2*)o2)[64 * j + lane] = w2; } } }
}

namespace ret {
constexpr int QOFF = 0, KOFF = 33792, STOFF = 67584, VOFF = 101376, POFF = 110592, RS = 528, VS = 144;
typedef short v4i16_t __attribute__((ext_vector_type(4)));
__device__ __forceinline__ bf16x8 frag_rm(const LAS char* base, int stride, int i0, int k0, int fr, int fq) { return *(const LAS bf16x8*)(base + (i0 + fr) * stride + (k0 + 8 * fq) * 2); }
__device__ __forceinline__ s16x4 tr4(const LAS char* p) { return __builtin_bit_cast(s16x4, __builtin_amdgcn_ds_read_tr16_b64_v4i16((LAS v4i16_t*)p)); }
__device__ __forceinline__ bf16x8 frag_tr(const LAS char* base, int stride, int k0, int i0, int fr, int fq) {
    const LAS char* p = base + (k0 + 8 * fq + (fr >> 2)) * stride + (i0 + 4 * (fr & 3)) * 2;
    const s16x4 a = tr4(p), b = tr4(p + 4 * stride);
    return (bf16x8){a[0], a[1], a[2], a[3], b[0], b[1], b[2], b[3]};
}
#define MFMA16(X, Y, C) __builtin_amdgcn_mfma_f32_16x16x32_bf16(X, Y, C, 0, 0, 0)
__device__ __forceinline__ void ret_item(LAS char* lds, const bf16_t* pin, bf16_t* pout  , int nchunks, int c, int h, int es, const float* S0, float* Sout) {
    const int tid = opaque_tid(), wid = __builtin_amdgcn_readfirstlane(tid >> 6), lane = tid & 63, fr = lane & 15, fq = lane >> 4, lt = wid >> 1, half = wid & 1;
    const float lg2 = __log2f(1.0f - exp2f(-5.0f - (float)h)), gam = exp2f(lg2), gc1 = exp2f(lg2 * (float)(c - 1));
    f32x4 accT[8];
    const int eT = 16 * lt + fr;
#pragma unroll
    for (int i = 0; i < 8; ++i) { const int d0 = 16 * (8 * half + i) + 4 * fq;
#pragma unroll
        for (int r = 0; r < 4; ++r) accT[i][r] = S0 ? S0[(size_t)(d0 + r) * 512 + es * 64 + eT] : 0.f;
        u32x2 w; w.x = pk2(accT[i][0], accT[i][1]); w.y = pk2(accT[i][2], accT[i][3]); *(LAS u32x2*)(lds + STOFF + eT * RS + d0 * 2) = w; }
    u32x4 rq[4], rk[4], rv;
    const bf16_t* gq = pin + h * 256; const bf16_t* gk = pin + 2048 + h * 256; const bf16_t* gv = pin + 4096 + h * 512 + es * 64;
#define RET_LOAD(n) do { _Pragma("unroll") for (int i = 0; i < 4; ++i) { const int p = tid + 512 * i, row = p >> 5, ch = p & 31; const size_t go = (size_t)((n) * 64 + row) * NPROJ + ch * 8; \
            if (row < c) { rq[i] = *(const u32x4*)(gq + go); rk[i] = *(const u32x4*)(gk + go); } else { rq[i] = (u32x4){0u, 0u, 0u, 0u}; rk[i] = (u32x4){0u, 0u, 0u, 0u}; } } \
        { const int row = tid >> 3, ch = tid & 7; if (row < c) rv = *(const u32x4*)(gv + (size_t)((n) * 64 + row) * NPROJ + ch * 8); else rv = (u32x4){0u, 0u, 0u, 0u}; } } while (0)
    RET_LOAD(0);
    for (int n = 0; n < nchunks; ++n) {
#pragma unroll
        for (int i = 0; i < 4; ++i) { const int p = tid + 512 * i, row = p >> 5, ch = p & 31; *(LAS u32x4*)(lds + QOFF + row * RS + ch * 16) = rq[i]; *(LAS u32x4*)(lds + KOFF + row * RS + ch * 16) = rk[i]; }
        *(LAS u32x4*)(lds + VOFF + (tid >> 3) * VS + (tid & 7) * 16) = rv;
        if (n + 1 < nchunks) RET_LOAD(n + 1);
        __syncthreads();
        f32x4 accS[2], accC[2];
#pragma unroll
        for (int j = 0; j < 2; ++j) { accS[j] = (f32x4){0.f, 0.f, 0.f, 0.f}; accC[j] = (f32x4){0.f, 0.f, 0.f, 0.f}; }
#pragma unroll
        for (int ks = 0; ks < 8; ++ks) { const int k0 = 32 * ks;
            const bf16x8 yq = frag_rm(lds + QOFF, RS, 16 * lt, k0, fr, fq);
#pragma unroll
            for (int j = 0; j < 2; ++j) { const bf16x8 xk = frag_rm(lds + KOFF, RS, 16 * (2 * half + j), k0, fr, fq); accS[j] = MFMA16(xk, yq, accS[j]); }
#pragma unroll
            for (int j = 0; j < 2; ++j) { const bf16x8 xs = frag_rm(lds + STOFF, RS, 16 * (2 * half + j), k0, fr, fq); accC[j] = MFMA16(xs, yq, accC[j]); } }
        const int lrow = 16 * lt + fr;
#pragma unroll
        for (int j = 0; j < 2; ++j) { const int m0 = 16 * (2 * half + j) + 4 * fq; f32x4 s = accS[j];
#pragma unroll
            for (int r = 0; r < 4; ++r) s[r] = (m0 + r <= lrow) ? s[r] : 0.f;
            u32x2 w; w.x = pk2(s[0], s[1]); w.y = pk2(s[2], s[3]); *(LAS u32x2*)(lds + POFF + lrow * VS + m0 * 2) = w; }
        __syncthreads();
        f32x4 accO[2];
#pragma unroll
        for (int j = 0; j < 2; ++j) accO[j] = accC[j] * gam;
#pragma unroll
        for (int ks = 0; ks < 2; ++ks) { const int k0 = 32 * ks;
            const bf16x8 yp = frag_rm(lds + POFF, VS, 16 * lt, k0, fr, fq);
#pragma unroll
            for (int j = 0; j < 2; ++j) { const bf16x8 xv = frag_tr(lds + VOFF, VS, k0, 16 * (2 * half + j), fr, fq); accO[j] = MFMA16(xv, yp, accO[j]); } }
        if (lrow < c) {
#pragma unroll
            for (int j = 0; j < 2; ++j) { u32x2 w; w.x = pk2(accO[j][0], accO[j][1]); w.y = pk2(accO[j][2], accO[j][3]);
                *(u32x2*)(pout + (size_t)(n * 64 + lrow) * 4096 + h * 512 + es * 64 + 16 * (2 * half + j) + 4 * fq) = w; } }
#pragma unroll
        for (int i = 0; i < 8; ++i) accT[i] = accT[i] * gam;
#pragma unroll
        for (int ks = 0; ks < 2; ++ks) { const int k0 = 32 * ks;
            const bf16x8 yv = frag_tr(lds + VOFF, VS, k0, 16 * lt, fr, fq);
#pragma unroll
            for (int i = 0; i < 8; ++i) { const bf16x8 xk = frag_tr(lds + KOFF, RS, k0, 16 * (8 * half + i), fr, fq); accT[i] = MFMA16(xk, yv, accT[i]); } }
#pragma unroll
        for (int i = 0; i < 8; ++i) { accT[i] = accT[i] * gc1; const int d0 = 16 * (8 * half + i) + 4 * fq;
            u32x2 w; w.x = pk2(accT[i][0], accT[i][1]); w.y = pk2(accT[i][2], accT[i][3]); *(LAS u32x2*)(lds + STOFF + eT * RS + d0 * 2) = w; }
        __syncthreads();
    }
#undef RET_LOAD
#pragma unroll
    for (int i = 0; i < 8; ++i) { const int d0 = 16 * (8 * half + i) + 4 * fq;
#pragma unroll
        for (int r = 0; r < 4; ++r) Sout[(size_t)(d0 + r) * 512 + es * 64 + eT] = accT[i][r]; }
}
}
__device__ __forceinline__ void sample_attn(LAS char* lds, const bf16_t* QBp, const bf16_t* KALL, const bf16_t* VALL, const float* FS, bf16_t* AO) {
    const int tid = opaque_tid(), wid = __builtin_amdgcn_readfirstlane(tid >> 6), lane = tid & 63;
    LAS float* qf = (LAS float*)(lds + wid * 5120); LAS float* pf = qf + 128;
    const int gw = blockIdx.x * NWAVES + wid, NGW = gridDim.x * NWAVES;
    for (int item = gw; item < 8 * 16 * 32; item += NGW) {
        const int b = item >> 9, h = (item >> 5) & 15, qi = item & 31, kvh = h >> 2, qpos = PASTL + qi, row = TP + b * 32 + qi;
        const bf16_t* q = QBp + (size_t)row * DM + h * 128;
        qf[lane] = bf2f(q[lane]); qf[lane + 64] = bf2f(q[lane + 64]);
        asm volatile("s_waitcnt lgkmcnt(0)" ::: "memory");
        const float* F = FS + (size_t)(b * 16 + h) * LKS; const float Fq = F[qpos];
        const bf16_t* Kb = KALL + (size_t)b * LKS * 512 + kvh * 128; const bf16_t* Vb = VALL + (size_t)b * LKS * 512 + kvh * 128;
        float sc[17]; float mx = -1e30f;
#pragma unroll
        for (int t = 0; t < 17; ++t) { const int j = lane + 64 * t; float s = -__builtin_inff();
            if (j <= qpos) { const u32x4* kr = (const u32x4*)(Kb + (size_t)j * 512); float a = 0.f;
#pragma unroll 4
                for (int c8 = 0; c8 < 16; ++c8) { const u32x4 kv = kr[c8]; const LAS f32x4* qq = (const LAS f32x4*)(qf + 8 * c8); const f32x4 q0 = qq[0], q1 = qq[1];
                    a += __uint_as_float(kv.x << 16) * q0.x + __uint_as_float(kv.x & 0xffff0000u) * q0.y + __uint_as_float(kv.y << 16) * q0.z + __uint_as_float(kv.y & 0xffff0000u) * q0.w
                       + __uint_as_float(kv.z << 16) * q1.x + __uint_as_float(kv.z & 0xffff0000u) * q1.y + __uint_as_float(kv.w << 16) * q1.z + __uint_as_float(kv.w & 0xffff0000u) * q1.w; }
                s = a * 0.08838834764831845f + (Fq - F[j]); }
            sc[t] = s; mx = fmaxf(mx, s); }
#pragma unroll
        for (int o = 1; o < 64; o <<= 1) mx = fmaxf(mx, __shfl_xor(mx, o));
        float sum = 0.f;
#pragma unroll
        for (int t = 0; t < 17; ++t) { const float p = __expf(sc[t] - mx); sum += p; pf[lane + 64 * t] = p; }
        sum = wave_sum(sum);
        asm volatile("s_waitcnt lgkmcnt(0)" ::: "memory");
        float o0 = 0.f, o1 = 0.f;
        for (int j = 0; j < PASTL + 32; j += 8) {
            unsigned vv[8]; float p[8];
#pragma unroll
            for (int u = 0; u < 8; ++u) { vv[u] = *(const unsigned*)(Vb + (size_t)(j + u) * 512 + 2 * lane); p[u] = pf[j + u]; }
#pragma unroll
            for (int u = 0; u < 8; ++u) { o0 += p[u] * __uint_as_float(vv[u] << 16); o1 += p[u] * __uint_as_float(vv[u] & 0xffff0000u); } }
        const float inv = 1.0f / sum;
        *(unsigned*)(AO + (size_t)row * DM + h * 128 + 2 * lane) = pk2(o0 * inv, o1 * inv);
        asm volatile("s_waitcnt lgkmcnt(0)" ::: "memory");
    }
}

#define KARG(i) ((unsigned char*)(((const volatile __attribute__((address_space(4))) unsigned long long*)__builtin_amdgcn_kernarg_segment_ptr())[i]))
#define INF(i) ((const float*)KARG(i))
#define OUTP ((float*)KARG(21))
#define WSP (KARG(22))
#define BIGP (KARG(22) + WS_BIG)
#define PH_IDS const int tid = opaque_tid(), lane = tid & 63, wave = __builtin_amdgcn_readfirstlane(tid >> 6); const int G = gridDim.x, gw = blockIdx.x * NWAVES + wave, NGW = G * NWAVES; const size_t gt = (size_t)blockIdx.x * 512 + tid, NGT = (size_t)G * 512; (void)lane; (void)gw; (void)NGW; (void)gt; (void)NGT

__device__ __forceinline__ void ph_prologue(LAS unsigned char* lds) {
    PH_IDS; unsigned char* ws = WSP;
    bf16_t* WIN = (bf16_t*)(ws + WS_WIN); bf16_t* WRO = (bf16_t*)(ws + WS_WRO); bf16_t* WKVF = (bf16_t*)(ws + WS_WKVF);
    LAS float* scr = (LAS float*)(lds + wave * 16384);
    constexpr int I0 = 32 * 384, I1 = 64 * 64;
    for (int it = gw; it < I0 + I1; it += NGW) { int r = it;
        if (r < I0) { tr_plain(INF(10), DM, NPROJ, WIN, 0, scr, r, lane); continue; } r -= I0;
        tr_plain(INF(11), 4096, DM, WRO, 0, scr, r, lane);
    }
    { const float* wf = INF(14); const float* nkv = INF(8);
      for (size_t i = gt; i < (size_t)256 * DM; i += NGT) { const int r = (int)(i >> 11), k = (int)(i & 2047); WKVF[(size_t)(1024 + r) * DM + k] = r < 16 ? (bf16_t)(pk2(wf[k * 16 + r] * nkv[k], 0.f) & 0xffffu) : (bf16_t)0; }
      float* ssq = (float*)(ws + WS_SSQ); for (size_t i = gt; i < (size_t)3 * TALL; i += NGT) ssq[i] = 0.f; }
    { float* COS = (float*)(ws + WS_COS); float* SIN = (float*)(ws + WS_SIN);
      for (size_t i = gt; i < (size_t)SEQ * 128; i += NGT) { const int pos = (int)(i >> 7), d = (int)(i & 127);
        const float inv = exp2f(-(float)d * (13.287712379549449f / 128.f));
        const double rev = (double)pos * (double)inv * 0.15915494309189535; const float fr = (float)(rev - __builtin_floor(rev));
        COS[i] = __builtin_amdgcn_cosf(fr); SIN[i] = __builtin_amdgcn_sinf(fr); } }
    { const float* x_p = INF(0); const float* x_s = INF(1); const float* nm = INF(6); bf16_t* XN0 = (bf16_t*)OUTP;
      for (int m = gw; m < TALL; m += NGW) rms_row<0>(m < TP ? x_p + (size_t)m * DM : x_s + (size_t)(m - TP) * DM, nm, XN0 + (size_t)m * DM, nullptr, nullptr, nullptr, lane); }
}
template <int JOB> __device__ __forceinline__ void ph_conv(LAS unsigned char* lds) {
    const int tid = opaque_tid(), lane = tid & 63, wave = __builtin_amdgcn_readfirstlane(tid >> 6);
    const int G = gridDim.x, first = G > 16 ? 8 : 0;
    if ((int)blockIdx.x < first) return;
    const int gw = ((int)blockIdx.x - first) * NWAVES + wave, NGW = (G - first) * NWAVES;
    unsigned char* ws = WSP; LAS float* scr = (LAS float*)(lds + wave * 16384);
    constexpr int IG = 32 * 176, ID = 88 * 64, IQ = 32 * 64, IK = 32 * 16;
    if (JOB == 1) {
        bf16_t* WGU0 = (bf16_t*)(ws + WS_WGU0); bf16_t* WDN0 = (bf16_t*)(ws + WS_WDN0);
        for (int it = gw; it < 2 * IG + ID; it += NGW) { int r = it;
            if (r < IG) { tr_gu(INF(18), WGU0, 0, scr, r, lane, INF(7)); continue; } r -= IG;
            if (r < IG) { tr_gu(INF(19), WGU0, 1, scr, r, lane, INF(7)); continue; } r -= IG;
            tr_plain(INF(20), DFF, DM, WDN0, 0, scr, r, lane); }
    } else {
        bf16_t* WGU1 = (bf16_t*)(ws + WS_WGU1); bf16_t* WDN1 = (bf16_t*)(ws + WS_WDN1); bf16_t* WO = (bf16_t*)(ws + WS_WO); bf16_t* WKVF = (bf16_t*)(ws + WS_WKVF);
        for (int it = gw; it < 2 * IQ + 2 * IK + 2 * IG + ID; it += NGW) { int r = it;
            if (r < IQ) { tr_plain(INF(16), DM, DM, WKVF, 1280, scr, r, lane, INF(6) + DM); continue; } r -= IQ;
            if (r < IK) { tr_plain(INF(12), DM, 512, WKVF, 0, scr, r, lane, INF(8)); continue; } r -= IK;
            if (r < IK) { tr_plain(INF(13), DM, 512, WKVF, 512, scr, r, lane, INF(8)); continue; } r -= IK;
            if (r < IQ) { tr_plain(INF(17), DM, DM, WO, 0, scr, r, lane); continue; } r -= IQ;
            if (r < IG) { tr_gu(INF(18) + (size_t)DM * DFF, WGU1, 0, scr, r, lane, INF(7) + DM); continue; } r -= IG;
            if (r < IG) { tr_gu(INF(19) + (size_t)DM * DFF, WGU1, 1, scr, r, lane, INF(7) + DM); continue; } r -= IG;
            tr_plain(INF(20) + (size_t)DFF * DM, DFF, DM, WDN1, 0, scr, r, lane); }
    }
}
__device__ __forceinline__ void ph_retin(LAS unsigned char* lds) {
    unsigned char* ws = WSP;
    pg8::Gemm g{(const bf16_t*)OUTP, (const bf16_t*)(ws + WS_WIN), TALL, NPROJ, DM, DM}; pg8::StaticOrder S; S.init(TALL, NPROJ, (int)gridDim.x, (int)blockIdx.x);
    pg8::EpiRetIn E{(bf16_t*)(ws + WS_BIG), (const float*)(ws + WS_COS), (const float*)(ws + WS_SIN)};
    pg8::gemm_phase<pg8::EpiRetIn, pg8::StaticOrder, true, true>(lds, g, S, E);
}
__device__ __forceinline__ void ph_retention(LAS unsigned char* lds) {
    const int G = gridDim.x;
    for (int it = blockIdx.x; it < 256; it += G) { const int bh = (it & 7) * 4 + (it >> 6), es = (it >> 3) & 7, b = bh >> 3, h = bh & 7;
        ret::ret_item((LAS char*)lds, (const bf16_t*)BIGP + (size_t)b * SEQ * NPROJ, (bf16_t*)OUTP + (size_t)b * SEQ * 4096, 128, 64, h, es, nullptr, OUTP + OUT_SP + (size_t)(b * 8 + h) * 256 * 512); }
    for (int it = blockIdx.x; it < 512; it += G) { const int bh = (it & 7) * 8 + (it >> 6), es = (it >> 3) & 7, b = bh >> 3, h = bh & 7;
        ret::ret_item((LAS char*)lds, (const bf16_t*)BIGP + (size_t)(TP + b * 32) * NPROJ, (bf16_t*)OUTP + (size_t)(TP + b * 32) * 4096, 1, 32, h, es, INF(2) + (size_t)(b * 8 + h) * 256 * 512, OUTP + OUT_SS + (size_t)(b * 8 + h) * 256 * 512); }
}
__device__ __forceinline__ void ph_groupnorm() {
    PH_IDS; bf16_t* PROJ = (bf16_t*)BIGP; const bf16_t* OB = (const bf16_t*)OUTP;
    for (int it = gw; it < TALL * 8; it += NGW) { const int row = it >> 3, h = it & 7;
        bf16_t* op = PROJ + (size_t)row * NPROJ + 4096 + h * 512 + lane * 8; const u32x4 ov = *(const u32x4*)(OB + (size_t)row * 4096 + h * 512 + lane * 8), gv = *(const u32x4*)(op + 4096);
        float o[8], g[8]; const unsigned ow[4] = {ov.x, ov.y, ov.z, ov.w}, gwd[4] = {gv.x, gv.y, gv.z, gv.w};
#pragma unroll
        for (int j = 0; j < 4; ++j) { o[2 * j] = __uint_as_float(ow[j] << 16); o[2 * j + 1] = __uint_as_float(ow[j] & 0xffff0000u); g[2 * j] = __uint_as_float(gwd[j] << 16); g[2 * j + 1] = __uint_as_float(gwd[j] & 0xffff0000u); }
        float s = 0.f;
#pragma unroll
        for (int j = 0; j < 8; ++j) s += o[j];
        const float mu = wave_sum(s) * (1.f / 512.f); float q = 0.f;
#pragma unroll
        for (int j = 0; j < 8; ++j) { o[j] -= mu; q += o[j] * o[j]; }
        const float rstd = 1.0f / sqrtf(wave_sum(q) * (1.f / 512.f) + 1e-5f);
#pragma unroll
        for (int j = 0; j < 8; ++j) o[j] = o[j] * rstd * pg8::silu_f(g[j]);
        u32x4 w; w.x = pk2(o[0], o[1]); w.y = pk2(o[2], o[3]); w.z = pk2(o[4], o[5]); w.w = pk2(o[6], o[7]); *(u32x4*)op = w; }
}
template <bool FIRST, int MROWS = TALL> __device__ __forceinline__ void ph_res_gemm(LAS unsigned char* lds, unsigned char* a_ptr, size_t w_off, int K, int lda, bf16_t* hb, int ssq_idx) {
    unsigned char* ws = WSP; float* Hres = OUTP + OUT_Y;
    pg8::Gemm g{(const bf16_t*)a_ptr, (const bf16_t*)(ws + w_off), MROWS, DM, K, lda}; pg8::StaticOrder S; S.init(MROWS, DM, (int)gridDim.x, (int)blockIdx.x);
    pg8::EpiRes E{FIRST ? INF(0) : Hres, FIRST ? INF(1) : Hres + (size_t)TP * DM, Hres, hb, ssq_idx >= 0 ? (float*)(ws + WS_SSQ) + (size_t)ssq_idx * TALL : nullptr};
    pg8::gemm_phase<pg8::EpiRes, pg8::StaticOrder, true, true>(lds, g, S, E);
}
__device__ __forceinline__ void ph_sample_res(const unsigned char* a_ptr, int lda, size_t w_off, int K, bf16_t* hb, int ssq_idx) {
    const int tid = opaque_tid(), lane = tid & 63, wave = __builtin_amdgcn_readfirstlane(tid >> 6), fr = lane & 15, fq = lane >> 4;
    unsigned char* ws = WSP; float* Hs = OUTP + OUT_Y + (size_t)TP * DM;
    const bf16_t* A = (const bf16_t*)a_ptr; const bf16_t* Wt = (const bf16_t*)(ws + w_off);
    float* ssq = ssq_idx >= 0 ? (float*)(ws + WS_SSQ) + (size_t)ssq_idx * TALL + TP : nullptr;
    for (int it = blockIdx.x; it < 256; it += gridDim.x) {
        const int n0 = (it >> 1) * 16, row = (it & 1) * 128 + 16 * wave + fr;
        const bf16_t* bp = Wt + (size_t)(n0 + fr) * K + 8 * fq; const bf16_t* ap = A + (size_t)row * lda + 8 * fq;
        f32x4 acc = {0.f, 0.f, 0.f, 0.f};
        bf16x8 bA[8], aA[8], bB[8], aB[8];
#define SR_LOAD(B_, A_, kk) do { _Pragma("unroll") for (int s_ = 0; s_ < 8; ++s_) { B_[s_] = *(const bf16x8*)(bp + (kk) + 32 * s_); A_[s_] = *(const bf16x8*)(ap + (kk) + 32 * s_); } } while (0)
#define SR_MMA(B_, A_) do { _Pragma("unroll") for (int s_ = 0; s_ < 8; ++s_) acc = __builtin_amdgcn_mfma_f32_16x16x32_bf16(B_[s_], A_[s_], acc, 0, 0, 0); } while (0)
        SR_LOAD(bA, aA, 0);
        for (int k0 = 0; k0 < K; k0 += 512) {
            SR_LOAD(bB, aB, k0 + 256);
            SR_MMA(bA, aA);
            if (k0 + 512 < K) SR_LOAD(bA, aA, k0 + 512);
            SR_MMA(bB, aB);
        }
#undef SR_LOAD
#undef SR_MMA
        float* o = Hs + (size_t)row * DM + n0 + 4 * fq;
        const f32x4 v = *(const f32x4*)o + acc; *(f32x4*)o = v;
        if (hb) { u32x2 w; w.x = pk2(v[0], v[1]); w.y = pk2(v[2], v[3]); *(u32x2*)(hb + (size_t)(TP + row) * DM + n0 + 4 * fq) = w; }
        if (ssq) { float ss = (v[0] * v[0] + v[1] * v[1]) + (v[2] * v[2] + v[3] * v[3]); ss += __shfl_xor(ss, 16); ss += __shfl_xor(ss, 32);
            if (fq == 0) (void)__hip_atomic_fetch_add(ssq + row, ss, __ATOMIC_RELAXED, __HIP_MEMORY_SCOPE_AGENT); }
    }
}
template <int MODE> __device__ __forceinline__ void ph_rms(const float* g1, size_t o1_off, const float* g2, size_t o2_off) {
    PH_IDS; float* Hres = OUTP + OUT_Y; unsigned char* ws = WSP;
    for (int m = gw; m < TALL; m += NGW) rms_row<MODE>(Hres + (size_t)m * DM, g1, (bf16_t*)(ws + o1_off) + (size_t)m * DM, g2, (bf16_t*)(ws + o2_off) + (size_t)m * DM, Hres + (size_t)m * DM, lane);
}
__device__ __forceinline__ void ph_cache_cvt() {
    PH_IDS; const float* cache_k = INF(3); const float* cache_v = INF(4); bf16_t* KALL = (bf16_t*)(BIGP + BIG_KALL); bf16_t* VALL = (bf16_t*)(BIGP + BIG_VALL);
    for (size_t i = gt; i < (size_t)8 * PASTL * 512 / 4; i += NGT) { const size_t e = i * 4, b = e / ((size_t)PASTL * 512), r = e % ((size_t)PASTL * 512);
        const f32x4 kv = *(const f32x4*)(cache_k + e), vv = *(const f32x4*)(cache_v + e); u32x2 w; w.x = pk2(kv.x, kv.y); w.y = pk2(kv.z, kv.w); *(u32x2*)(KALL + b * LKS * 512 + r) = w;
        w.x = pk2(vv.x, vv.y); w.y = pk2(vv.z, vv.w); *(u32x2*)(VALL + b * LKS * 512 + r) = w; }
}
__device__ __forceinline__ void ph_kvfq(LAS unsigned char* lds) {
    unsigned char* ws = WSP; unsigned char* big = ws + WS_BIG; float* out = OUTP;
    pg8::Gemm g{(const bf16_t*)(big + BIG_XN), (const bf16_t*)(ws + WS_WKVF), TALL, 3328, DM, DM}; pg8::StaticOrder S; S.init(TALL, 3328, (int)gridDim.x, (int)blockIdx.x);
    pg8::EpiKVFQ E{out + OUT_KP, out + OUT_VP, out + OUT_LFP, out + OUT_KS, out + OUT_VS, out + OUT_LFS, (bf16_t*)(big + BIG_KB), (bf16_t*)(big + BIG_VB), (bf16_t*)(big + BIG_KALL), (bf16_t*)(big + BIG_VALL),
                    (bf16_t*)(big + BIG_ACT), INF(15), (const float*)(ws + WS_SSQ) + (size_t)1 * TALL};
    pg8::gemm_phase<pg8::EpiKVFQ, pg8::StaticOrder, true, true>(lds, g, S, E);
}
__device__ __forceinline__ void ph_cumsum(LAS unsigned char* lds) {
    PH_IDS; const float* cache_lf = INF(5); const float* out = OUTP; float* FB = (float*)(WSP + WS_FB); float* FS = (float*)(WSP + WS_FS);
    for (int it = blockIdx.x; it < 64 + 128; it += G) {
        LAS float* wtot = (LAS float*)lds;
        const bool smp = it >= 64; const int bh = smp ? it - 64 : it, b = bh >> 4, h = bh & 15, Ls = smp ? LKS : SEQ, per = smp ? 3 : 16, j0 = tid * per;
        float v[16]; float s = 0.f;
#pragma unroll
        for (int i = 0; i < 16; ++i) { const int j = j0 + i; float x = 0.f;
            if (i < per && j < Ls) x = smp ? (j < PASTL ? cache_lf[((size_t)b * PASTL + j) * 16 + h] : out[OUT_LFS + ((size_t)b * 32 + (j - PASTL)) * 16 + h]) : out[OUT_LFP + ((size_t)b * SEQ + j) * 16 + h];
            s += x; v[i] = s; }
        float inc = s;
#pragma unroll
        for (int o = 1; o < 64; o <<= 1) { const float t = __shfl_up(inc, o); if (lane >= o) inc += t; }
        if (lane == 63) wtot[wave] = inc;
        __syncthreads();
        float base = inc - s;
        for (int w = 0; w < wave; ++w) base += wtot[w];
#pragma unroll
        for (int i = 0; i < 16; ++i) { const int j = j0 + i; if (i < per && j < Ls) { const float F = base + v[i];
            if (smp) FS[(size_t)bh * LKS + j] = F; else FB[(size_t)bh * SEQ + j] = -F * 11.313708498984761f; } }
        __syncthreads();
    }
}
__device__ __forceinline__ void ph_attn(unsigned char* lds_raw) {
    unsigned char* ws = WSP; unsigned char* big = ws + WS_BIG;
    fox::attn_phase((char*)lds_raw, (const bf16_t*)(big + BIG_ACT), (const bf16_t*)(big + BIG_KB), (const bf16_t*)(big + BIG_VB), (bf16_t*)(big + BIG_XN), (const float*)(ws + WS_FB));
}
__device__ __forceinline__ void ph_sattn(LAS unsigned char* lds) {
    unsigned char* ws = WSP; unsigned char* big = ws + WS_BIG;
    sample_attn((LAS char*)lds, (const bf16_t*)(big + BIG_ACT), (const bf16_t*)(big + BIG_KALL), (const bf16_t*)(big + BIG_VALL), (const float*)(ws + WS_FS), (bf16_t*)(big + BIG_XN));
}
__device__ __forceinline__ void ph_gateup(LAS unsigned char* lds, const unsigned char* a_ptr, size_t w_off, int ssq_idx) {
    unsigned char* ws = WSP; unsigned char* big = ws + WS_BIG;
    pg8::Gemm g{(const bf16_t*)a_ptr, (const bf16_t*)(ws + w_off), TALL, 2 * DFF, DM, DM}; pg8::StaticOrder S; S.init(TALL, 2 * DFF, (int)gridDim.x, (int)blockIdx.x);
    pg8::EpiSwiglu E{(bf16_t*)(big + BIG_ACT), (const float*)(ws + WS_SSQ) + (size_t)ssq_idx * TALL};
    pg8::gemm_phase<pg8::EpiSwiglu, pg8::StaticOrder, true, true>(lds, g, S, E);
}

__global__ void __launch_bounds__(NWAVES * 64, 2) yoco_fwd(Params P) {
    extern __shared__ __attribute__((aligned(16))) unsigned char lds_raw[];
    cg::grid_group grid = cg::this_grid();
    LAS unsigned char* lds = (LAS unsigned char*)lds_raw;
    ph_prologue(lds);                                                                                   grid.sync();
    ph_retin(lds);                                                                                      grid.sync();
    ph_retention(lds);                                                                                  grid.sync();
    ph_groupnorm();                                                                                     grid.sync();
    ph_res_gemm<true>(lds, BIGP + 4096 * 2, WS_WRO, 4096, NPROJ, (bf16_t*)(OUTP + OUT_KP), 0); ph_conv<1>(lds);   grid.sync();
    ph_gateup(lds, (const unsigned char*)(OUTP + OUT_KP), WS_WGU0, 0);                                  grid.sync();
    ph_res_gemm<false>(lds, BIGP + BIG_ACT, WS_WDN0, DFF, DFF, (bf16_t*)(BIGP + BIG_XN), 1); ph_cache_cvt(); ph_conv<2>(lds);   grid.sync();
    ph_kvfq(lds);                                                                                       grid.sync();
    ph_cumsum(lds);                                                                                     grid.sync();
    ph_attn(lds_raw); __syncthreads(); ph_sattn(lds);                                                   grid.sync();
    ph_res_gemm<false, TP>(lds, BIGP + BIG_XN, WS_WO, DM, DM, (bf16_t*)(BIGP + BIG_HKV), 2); ph_sample_res(BIGP + BIG_XN + (size_t)TP * DM * 2, DM, WS_WO, DM, (bf16_t*)(BIGP + BIG_HKV), 2);   grid.sync();
    ph_gateup(lds, BIGP + BIG_HKV, WS_WGU1, 2);                                                         grid.sync();
    ph_res_gemm<false, TP>(lds, BIGP + BIG_ACT, WS_WDN1, DFF, DFF, nullptr, -1); ph_sample_res(BIGP + BIG_ACT + (size_t)TP * DFF * 2, DFF, WS_WDN1, DFF, nullptr, -1);   grid.sync();
    ph_rms<2>(INF(9), 0, nullptr, 0);
}

extern "C" void kernel_launch(void* const* d_in, const int* in_sizes, int n_in, void* d_out, int out_size, void* d_ws, size_t ws_size, hipStream_t stream) {
    static int grid = 0;
    if (grid == 0) {
        if (n_in != 21 || ws_size < WS_END) { fprintf(stderr, "kernel_launch: unexpected n_in %d / ws_size %zu (need %zu)\n", n_in, ws_size, (size_t)WS_END); grid = -1; return; }
        int dev = 0, cus = 0, per_cu = 0;
        (void)hipGetDevice(&dev); (void)hipDeviceGetAttribute(&cus, hipDeviceAttributeMultiprocessorCount, dev);
        if (hipFuncSetAttribute((const void*)yoco_fwd, hipFuncAttributeMaxDynamicSharedMemorySize, LDS_BYTES) != hipSuccess) { fprintf(stderr, "kernel_launch: hipFuncSetAttribute failed\n"); grid = -1; return; }
        if (hipOccupancyMaxActiveBlocksPerMultiprocessor(&per_cu, (const void*)yoco_fwd, NWAVES * 64, LDS_BYTES) != hipSuccess || per_cu < 1) { fprintf(stderr, "kernel_launch: occupancy query says %d\n", per_cu); per_cu = 1; }
        (void)hipGetLastError();
        grid = cus > 0 ? cus : 256;
    }
    if (grid < 0) return;
    Params p{};
    for (int i = 0; i < 21; ++i) p.in[i] = (const float*)d_in[i];
    p.out = (float*)d_out; p.ws = (unsigned char*)d_ws;
    void* args[] = {&p};
    hipError_t e = hipLaunchCooperativeKernel((const void*)yoco_fwd, dim3(grid), dim3(NWAVES * 64), args, LDS_BYTES, stream);
    if (e != hipSuccess) fprintf(stderr, "cooperative launch failed: %s (grid %d)\n", hipGetErrorString(e), grid);
}
```

```cpp
#include <hip/hip_runtime.h>
#include <hip/hip_cooperative_groups.h>
#include <cstdio>
#include <cstdint>
namespace cg = cooperative_groups;
__device__ __forceinline__ int opaque_tid() { int t = threadIdx.x; asm volatile("" : "+v"(t)); return t; }
namespace pg8 {
#define PG8_LAS __attribute__((address_space(3)))
typedef unsigned short bf16_t;
typedef short bf16x8 __attribute__((ext_vector_type(8)));
typedef float f32x4 __attribute__((ext_vector_type(4)));
typedef unsigned u32x4 __attribute__((ext_vector_type(4)));
constexpr int BM = 256, BK = 64, HALF = 128, HTB = HALF * BK * 2  , STAGE_BYTES = 8 * HTB, NXCD = 8, WGM = 8;

__host__ __device__ __forceinline__ int lds_byte(int r, int c) { const int st = (r >> 4) * 2 + (c >> 5), rr = r & 15, cc = c & 31, ob = rr * 64 + cc * 2; return st * 1024 + (ob ^ (((ob >> 9) & 1) << 5)); }
__host__ __device__ __forceinline__ void stage_rc(int b, int& R, int& C) { const int st = b / 1024, sb = b % 1024, swz = sb ^ (((sb >> 9) & 1) << 5); R = (st >> 1) * 16 + swz / 64; C = (st & 1) * 32 + (swz % 64) / 2; }
__host__ __device__ __forceinline__ int perm32(int rho) { const int n = rho >> 4, i = rho & 15; return 8 * (i >> 2) + 4 * n + (i & 3); }

struct Unit { int pm, pn; };
struct Gemm { const bf16_t* A; const bf16_t* Bt; int M, N, K, lda; };

struct StaticOrder {
    int nM, nN, nwg, G, c;
    __host__ __device__ void init(int M, int N, int G_, int c_) { nM = M / BM; nN = N / BM; nwg = nM * nN; G = G_; c = c_; }
    __host__ __device__ bool next(int i, Unit& u) const {
        const long L = (long)i * G + c; if (L >= nwg) return false;
        int wgid = (int)L; { const int q = nwg / NXCD, r = nwg % NXCD, xcd = wgid % NXCD, off = wgid / NXCD; wgid = (xcd < r ? xcd * (q + 1) : r * (q + 1) + (xcd - r) * q) + off; }
        const int nig = WGM * nN, gid = wgid / nig, fm = gid * WGM, gsz = (nM - fm) < WGM ? (nM - fm) : WGM;
        u.pm = fm + ((wgid % nig) % gsz); u.pn = (wgid % nig) / gsz; return true;
    }
    __device__ __forceinline__ void a_ready(const Unit&) const {}
    __device__ __forceinline__ void done(const Unit&) const {}
};

__device__ __forceinline__ unsigned cvt_pk_bf16(float lo, float hi) { unsigned r; asm volatile("v_cvt_pk_bf16_f32 %0, %1, %2" : "=v"(r) : "v"(lo), "v"(hi)); return r; }
template <class Epi, class Sched, bool ALIGN_EPI = false, bool SP2 = false>
__device__ __forceinline__ void gemm_phase(PG8_LAS unsigned char* lds, const Gemm g, const Sched& S, const Epi& E) {
    const int tid = opaque_tid(), wid = __builtin_amdgcn_readfirstlane(tid >> 6), lane = tid & 63, wr = wid >> 2, wc = wid & 3, fr = lane & 15, fq = lane >> 4;
    const int K = g.K, nt = K / BK;
    unsigned voffA[2], voffB[2];
#pragma unroll
    for (int i = 0; i < 2; ++i) { int R, C; stage_rc(tid * 16 + i * 8192, R, C); const int Rb = Epi::PERM ? ((R & ~31) + perm32(R & 31)) : R;
        voffA[i] = (unsigned)(R * g.lda + C) * 2u; voffB[i] = (unsigned)(Rb * K + C) * 2u; }
    const size_t kstep = (size_t)(BK * 2);
    const size_t hstep = (size_t)HALF * K * 2, hstepA = (size_t)HALF * g.lda * 2;
    const size_t tstep = 2 * hstep, tstepA = 2 * hstepA;
    const unsigned ldsw = (unsigned)wid * 1024u;
    const int aoff = lds_byte(wr * 64 + fr, fq * 8), boff = lds_byte(wc * 32 + fr, fq * 8);
#define PG8_SA(b, h) (((b) * 2 + (h)) * HTB)
#define PG8_SB(b, h) ((4 + (b) * 2 + (h)) * HTB)
#define PG8_STAGE(bufoff, gbase, voff) do { _Pragma("unroll") for (int _i = 0; _i < 2; ++_i) \
        __builtin_amdgcn_global_load_lds((const unsigned*)((const char*)(gbase) + (voff)[_i]), (PG8_LAS unsigned*)(lds + (bufoff) + ldsw + _i * 8192), 16, 0, 0); } while (0)
#define PG8_LDA(dst, b, h) do { _Pragma("unroll") for (int m = 0; m < 4; ++m) _Pragma("unroll") for (int k = 0; k < 2; ++k) dst[m][k] = *(const PG8_LAS bf16x8*)(lds + PG8_SA(b, h) + aoff + m * 2048 + k * 1024); } while (0)
#define PG8_LDB(dst, b, h) do { _Pragma("unroll") for (int n = 0; n < 2; ++n) _Pragma("unroll") for (int k = 0; k < 2; ++k) dst[n][k] = *(const PG8_LAS bf16x8*)(lds + PG8_SB(b, h) + boff + n * 2048 + k * 1024); } while (0)
#define PG8_MMA(ai, bj, At, Bt) do { __builtin_amdgcn_s_setprio(1); _Pragma("unroll") for (int m = 0; m < 4; ++m) _Pragma("unroll") for (int n = 0; n < 2; ++n) _Pragma("unroll") for (int k = 0; k < 2; ++k) \
        acc[ai][bj][m][n] = __builtin_amdgcn_mfma_f32_16x16x32_bf16(Bt[n][k], At[m][k], acc[ai][bj][m][n], 0, 0, 0); __builtin_amdgcn_s_setprio(0); } while (0)
#define PG8_WAIT_V(n) asm volatile("s_waitcnt vmcnt(" #n ")" ::: "memory")
#define PG8_WAIT_L(n) asm volatile("s_waitcnt lgkmcnt(" #n ")" ::: "memory")
#define PG8_BAR __builtin_amdgcn_s_barrier()
#define PG8_SCHED __builtin_amdgcn_sched_barrier(0)
    Unit cur, nxt; int ui = 0;
    if (!S.next(0, cur)) return;
    f32x4 acc[2][2][4][2];
#pragma unroll
    for (int a = 0; a < 2; ++a)
#pragma unroll
        for (int b = 0; b < 2; ++b)
#pragma unroll
            for (int m = 0; m < 4; ++m)
#pragma unroll
                for (int n = 0; n < 2; ++n) acc[a][b][m][n] = (f32x4){0.f, 0.f, 0.f, 0.f};
    bf16x8 At[4][2], B0[2][2], B1[2][2];
    const char* cA = (const char*)g.A + (size_t)cur.pm * tstepA; const char* cB = (const char*)g.Bt + (size_t)cur.pn * tstep;
    S.a_ready(cur);
    if constexpr (SP2) {
        PG8_STAGE(PG8_SB(0, 0), cB, voffB); PG8_STAGE(PG8_SB(0, 1), cB + hstep, voffB); PG8_STAGE(PG8_SA(0, 0), cA, voffA); PG8_STAGE(PG8_SA(0, 1), cA + hstepA, voffA);
        if (wr == 1) PG8_BAR;
        PG8_WAIT_V(2); PG8_BAR;
        PG8_STAGE(PG8_SB(1, 0), cB + kstep, voffB); PG8_STAGE(PG8_SA(1, 0), cA + kstep, voffA); PG8_STAGE(PG8_SB(1, 1), cB + hstep + kstep, voffB);
        PG8_WAIT_V(6); PG8_BAR;
    } else {
        PG8_STAGE(PG8_SB(0, 0), cB, voffB); PG8_STAGE(PG8_SA(0, 0), cA, voffA); PG8_STAGE(PG8_SB(0, 1), cB + hstep, voffB); PG8_STAGE(PG8_SA(0, 1), cA + hstepA, voffA);
        if (wr == 1) PG8_BAR;
        PG8_WAIT_V(4); PG8_BAR;
        PG8_STAGE(PG8_SB(1, 0), cB + kstep, voffB); PG8_STAGE(PG8_SA(1, 0), cA + kstep, voffA); PG8_STAGE(PG8_SB(1, 1), cB + hstep + kstep, voffB);
        PG8_WAIT_V(6); PG8_BAR;
    }
    for (;;) {
        const bool has_next = S.next(ui + 1, nxt);
        const char* nA = has_next ? (const char*)g.A + (size_t)nxt.pm * tstepA : cA; const char* nB = has_next ? (const char*)g.Bt + (size_t)nxt.pn * tstep : cB;
        for (int t = 0; t < nt; t += 2) {
            const bool last = (t == nt - 2);
            const char* a1 = cA + (size_t)(t + 1) * kstep;
            const char* a2 = last ? nA : cA + (size_t)(t + 2) * kstep; const char* b2 = last ? nB : cB + (size_t)(t + 2) * kstep;
            const char* a3 = a2 + kstep; const char* b3 = b2 + kstep;
            if (last && has_next) S.a_ready(nxt);
            if constexpr (SP2) {
            PG8_LDB(B0, 0, 0); PG8_LDB(B1, 0, 1); PG8_SCHED; PG8_LDA(At, 0, 0); PG8_STAGE(PG8_SA(1, 1), a1 + hstepA, voffA);
            PG8_WAIT_V(8); PG8_WAIT_L(0); PG8_BAR; PG8_MMA(0, 0, At, B0); PG8_MMA(0, 1, At, B1); PG8_BAR; PG8_SCHED;
            PG8_LDA(At, 0, 1); PG8_STAGE(PG8_SB(0, 0), b2, voffB); PG8_STAGE(PG8_SB(0, 1), b2 + hstep, voffB); PG8_STAGE(PG8_SA(0, 0), a2, voffA);
            PG8_WAIT_V(8); PG8_WAIT_L(0); PG8_BAR; PG8_MMA(1, 0, At, B0); PG8_MMA(1, 1, At, B1); PG8_BAR; PG8_SCHED;
            PG8_LDB(B0, 1, 0); PG8_LDB(B1, 1, 1); PG8_SCHED; PG8_LDA(At, 1, 0); PG8_STAGE(PG8_SA(0, 1), a2 + hstepA, voffA);
            PG8_WAIT_V(8); PG8_WAIT_L(0); PG8_BAR; PG8_MMA(0, 0, At, B0); PG8_MMA(0, 1, At, B1); PG8_BAR; PG8_SCHED;
            PG8_LDA(At, 1, 1); PG8_STAGE(PG8_SB(1, 0), b3, voffB); PG8_STAGE(PG8_SB(1, 1), b3 + hstep, voffB); PG8_STAGE(PG8_SA(1, 0), a3, voffA);
            PG8_WAIT_V(8); PG8_WAIT_L(0); PG8_BAR; PG8_MMA(1, 0, At, B0); PG8_MMA(1, 1, At, B1); PG8_BAR; PG8_SCHED;
            } else {
            PG8_LDB(B0, 0, 0); PG8_SCHED; PG8_LDA(At, 0, 0); PG8_STAGE(PG8_SA(1, 1), a1 + hstepA, voffA);
            PG8_WAIT_L(8); PG8_BAR; PG8_WAIT_L(0); PG8_MMA(0, 0, At, B0); PG8_BAR; PG8_SCHED;
            PG8_LDB(B1, 0, 1); PG8_STAGE(PG8_SB(0, 0), b2, voffB);
            PG8_BAR; PG8_WAIT_L(0); PG8_MMA(0, 1, At, B1); PG8_BAR;
            PG8_LDA(At, 0, 1); PG8_STAGE(PG8_SA(0, 0), a2, voffA);
            PG8_BAR; PG8_WAIT_L(0); PG8_MMA(1, 0, At, B0); PG8_BAR; PG8_SCHED;
            PG8_STAGE(PG8_SB(0, 1), b2 + hstep, voffB);
            PG8_WAIT_V(6); PG8_BAR; PG8_MMA(1, 1, At, B1); PG8_BAR;
            PG8_LDB(B0, 1, 0); PG8_SCHED; PG8_LDA(At, 1, 0); PG8_STAGE(PG8_SA(0, 1), a2 + hstepA, voffA);
            PG8_WAIT_L(8); PG8_BAR; PG8_WAIT_L(0); PG8_MMA(0, 0, At, B0); PG8_BAR; PG8_SCHED;
            PG8_LDB(B1, 1, 1); PG8_STAGE(PG8_SB(1, 0), b3, voffB);
            PG8_BAR; PG8_WAIT_L(0); PG8_MMA(0, 1, At, B1); PG8_BAR;
            PG8_LDA(At, 1, 1); PG8_STAGE(PG8_SA(1, 0), a3, voffA);
            PG8_BAR; PG8_WAIT_L(0); PG8_MMA(1, 0, At, B0); PG8_BAR; PG8_SCHED;
            PG8_STAGE(PG8_SB(1, 1), b3 + hstep, voffB);
            PG8_WAIT_V(6); PG8_BAR; PG8_MMA(1, 1, At, B1); PG8_BAR;
            }
        }
        if constexpr (ALIGN_EPI) { if (wr == 0) PG8_BAR; }
        if constexpr (!Epi::AFTER_DRAIN) { E(acc, cur, wr, wc, fr, fq); S.done(cur); }
        if (!has_next) break;
#pragma unroll
        for (int a = 0; a < 2; ++a)
#pragma unroll
            for (int b = 0; b < 2; ++b)
#pragma unroll
                for (int m = 0; m < 4; ++m)
#pragma unroll
                    for (int n = 0; n < 2; ++n) acc[a][b][m][n] = (f32x4){0.f, 0.f, 0.f, 0.f};
        cur = nxt; cA = nA; cB = nB; ++ui;
        if constexpr (ALIGN_EPI) { if (wr == 1) PG8_BAR; }
    }
    PG8_WAIT_V(0);
    if constexpr (!ALIGN_EPI) { if (wr == 0) PG8_BAR; }
    PG8_BAR;
    if constexpr (Epi::AFTER_DRAIN) { E.fused(acc, cur, wr, wc, fr, fq, lds, wid, lane); S.done(cur); }
#undef PG8_SA
#undef PG8_SB
#undef PG8_STAGE
#undef PG8_LDA
#undef PG8_LDB
#undef PG8_MMA
#undef PG8_WAIT_V
#undef PG8_WAIT_L
#undef PG8_BAR
#undef PG8_SCHED
}
}
constexpr int DM = 2048, TP = 32768, TSMP = 256, TALL = 33024, SEQ = 8192, NPROJ = 12288, DFF = 5632, PASTL = 1024, LKS = 1056;
#define GAS __attribute__((address_space(1)))
#define LAS __attribute__((address_space(3)))
typedef unsigned short bf16_t;
typedef float f32x4 __attribute__((ext_vector_type(4)));
typedef unsigned u32x4 __attribute__((ext_vector_type(4)));
typedef unsigned u32x2 __attribute__((ext_vector_type(2)));
typedef short bf16x8 __attribute__((ext_vector_type(8)));
typedef short s16x4 __attribute__((ext_vector_type(4)));

namespace pg8 {
__device__ __forceinline__ float silu_f(float g) { return g * __builtin_amdgcn_rcpf(1.0f + __builtin_amdgcn_exp2f(-1.4426950408889634f * g)); }
struct EpiBf16P {
    static constexpr bool PERM = true, AFTER_DRAIN = false;
    bf16_t* O; int ldc;
    __device__ __forceinline__ void operator()(const f32x4 (&acc)[2][2][4][2], const Unit& u, int wr, int wc, int fr, int fq) const {
        const int row0 = u.pm * BM + wr * 64 + fr, col0 = u.pn * BM + wc * 32 + 8 * fq;
#pragma unroll
        for (int ai = 0; ai < 2; ++ai)
#pragma unroll
            for (int m = 0; m < 4; ++m) { bf16_t* rowp = O + (size_t)(row0 + ai * HALF + m * 16) * ldc + col0;
#pragma unroll
                for (int bj = 0; bj < 2; ++bj) { const f32x4 v0 = acc[ai][bj][m][0], v1 = acc[ai][bj][m][1];
                    u32x4 w; w.x = cvt_pk_bf16(v0[0], v0[1]); w.y = cvt_pk_bf16(v0[2], v0[3]); w.z = cvt_pk_bf16(v1[0], v1[1]); w.w = cvt_pk_bf16(v1[2], v1[3]);
                    *(u32x4*)(rowp + bj * HALF) = w; } }
    }
};
struct EpiRetIn {
    static constexpr bool PERM = true, AFTER_DRAIN = false;
    bf16_t* O; const float* cosT; const float* sinT;
    __device__ __forceinline__ void operator()(const f32x4 (&acc)[2][2][4][2], const Unit& u, int wr, int wc, int fr, int fq) const {
        const int row0 = u.pm * BM + wr * 64 + fr, cl = wc * 32 + 8 * fq;
        bf16_t* obase = O + (size_t)u.pn * BM + cl;
        if (u.pn < 16) {
            const bool isk = u.pn >= 8; const int h = u.pn & 7;
            const float lg2 = __log2f(1.0f - exp2f(-5.0f - (float)h));
#pragma unroll
            for (int ai = 0; ai < 2; ++ai) {
                f32x4 cs[4][4]; float scv[4];
#pragma unroll
                for (int m = 0; m < 4; ++m) {
                    const int row = row0 + ai * HALF + m * 16; int pos, l;
                    if (row < TP) { pos = row & (SEQ - 1); l = row & 63; } else { const int s = (row - TP) & 31; pos = PASTL + s; l = s; }
                    scv[m] = isk ? exp2f(-lg2 * (float)l) * 0.0625f : exp2f(lg2 * (float)l);
                    const float* cp = cosT + (size_t)pos * 128 + cl; const float* sp = sinT + (size_t)pos * 128 + cl;
                    cs[m][0] = *(const f32x4*)cp; cs[m][1] = *(const f32x4*)(cp + 4); cs[m][2] = *(const f32x4*)sp; cs[m][3] = *(const f32x4*)(sp + 4); }
#pragma unroll
                for (int m = 0; m < 4; ++m) {
                    const int row = row0 + ai * HALF + m * 16; const float sc = scv[m];
                    const f32x4 c0 = cs[m][0], c1 = cs[m][1], s0 = cs[m][2], s1 = cs[m][3];
                    const f32x4 x1a = acc[ai][0][m][0], x1b = acc[ai][0][m][1], x2a = acc[ai][1][m][0], x2b = acc[ai][1][m][1];
                    const f32x4 o1a = (x1a * c0 - x2a * s0) * sc, o1b = (x1b * c1 - x2b * s1) * sc, o2a = (x1a * s0 + x2a * c0) * sc, o2b = (x1b * s1 + x2b * c1) * sc;
                    bf16_t* rowp = obase + (size_t)row * NPROJ;
                    u32x4 w; w.x = cvt_pk_bf16(o1a[0], o1a[1]); w.y = cvt_pk_bf16(o1a[2], o1a[3]); w.z = cvt_pk_bf16(o1b[0], o1b[1]); w.w = cvt_pk_bf16(o1b[2], o1b[3]);
                    *(u32x4*)rowp = w;
                    w.x = cvt_pk_bf16(o2a[0], o2a[1]); w.y = cvt_pk_bf16(o2a[2], o2a[3]); w.z = cvt_pk_bf16(o2b[0], o2b[1]); w.w = cvt_pk_bf16(o2b[2], o2b[3]);
                    *(u32x4*)(rowp + HALF) = w; }
                asm volatile("" ::: "memory"); }
        } else {
#pragma unroll
            for (int ai = 0; ai < 2; ++ai)
#pragma unroll
                for (int m = 0; m < 4; ++m) { bf16_t* rowp = obase + (size_t)(row0 + ai * HALF + m * 16) * NPROJ;
#pragma unroll
                    for (int bj = 0; bj < 2; ++bj) { const f32x4 v0 = acc[ai][bj][m][0], v1 = acc[ai][bj][m][1];
                        u32x4 w; w.x = cvt_pk_bf16(v0[0], v0[1]); w.y = cvt_pk_bf16(v0[2], v0[3]); w.z = cvt_pk_bf16(v1[0], v1[1]); w.w = cvt_pk_bf16(v1[2], v1[3]);
                        *(u32x4*)(rowp + bj * HALF) = w; } }
        }
    }
};
struct EpiRes {
    static constexpr bool PERM = false, AFTER_DRAIN = false;
    const float* baseP; const float* baseS; float* out; bf16_t* hb; float* ssq;
    __device__ __forceinline__ void operator()(const f32x4 (&acc)[2][2][4][2], const Unit& u, int wr, int wc, int fr, int fq) const {
        const int row0 = u.pm * BM + wr * 64 + fr, col0 = u.pn * BM + wc * 32 + 4 * fq;
#pragma unroll
        for (int ai = 0; ai < 2; ++ai) {
            f32x4 bv[4][2][2];
#pragma unroll
            for (int m = 0; m < 4; ++m) { const int row = row0 + ai * HALF + m * 16;
                const float* b = (row < TP ? baseP + (size_t)row * DM : baseS + (size_t)(row - TP) * DM) + col0;
#pragma unroll
                for (int bj = 0; bj < 2; ++bj)
#pragma unroll
                    for (int n = 0; n < 2; ++n) bv[m][bj][n] = *(const f32x4*)(b + bj * HALF + n * 16); }
#pragma unroll
            for (int m = 0; m < 4; ++m) { const int row = row0 + ai * HALF + m * 16; float* o = out + (size_t)row * DM + col0; float ss = 0.f;
#pragma unroll
                for (int bj = 0; bj < 2; ++bj)
#pragma unroll
                    for (int n = 0; n < 2; ++n) { const f32x4 v = bv[m][bj][n] + acc[ai][bj][m][n]; *(f32x4*)(o + bj * HALF + n * 16) = v;
                        if (hb) { u32x2 w; w.x = cvt_pk_bf16(v[0], v[1]); w.y = cvt_pk_bf16(v[2], v[3]); *(u32x2*)(hb + (size_t)row * DM + col0 + bj * HALF + n * 16) = w; }
                        ss += (v[0] * v[0] + v[1] * v[1]) + (v[2] * v[2] + v[3] * v[3]); }
                if (ssq) { ss += __shfl_xor(ss, 16); ss += __shfl_xor(ss, 32);
                    if (fq == 0) (void)__hip_atomic_fetch_add(ssq + row, ss, __ATOMIC_RELAXED, __HIP_MEMORY_SCOPE_AGENT); } }
            asm volatile("" ::: "memory"); }
    }
};
struct EpiSwiglu {
    static constexpr bool PERM = true, AFTER_DRAIN = false;
    bf16_t* O; const float* ssq;
    __device__ __forceinline__ void operator()(const f32x4 (&acc)[2][2][4][2], const Unit& u, int wr, int wc, int fr, int fq) const {
        const int row0 = u.pm * BM + wr * 64 + fr, col0 = u.pn * HALF + wc * 32 + 8 * fq;
        float rs[2][4];
#pragma unroll
        for (int ai = 0; ai < 2; ++ai)
#pragma unroll
            for (int m = 0; m < 4; ++m) rs[ai][m] = ssq[row0 + ai * HALF + m * 16];
#pragma unroll
        for (int ai = 0; ai < 2; ++ai)
#pragma unroll
            for (int m = 0; m < 4; ++m) { bf16_t* rowp = O + (size_t)(row0 + ai * HALF + m * 16) * DFF + col0; const float r = 1.0f / sqrtf(rs[ai][m] * (1.f / DM) + 1e-6f);
                const f32x4 g0 = acc[ai][0][m][0] * r, g1 = acc[ai][0][m][1] * r, u0 = acc[ai][1][m][0] * r, u1 = acc[ai][1][m][1] * r;
                f32x4 a0, a1;
#pragma unroll
                for (int j = 0; j < 4; ++j) { a0[j] = silu_f(g0[j]) * u0[j]; a1[j] = silu_f(g1[j]) * u1[j]; }
                u32x4 w; w.x = cvt_pk_bf16(a0[0], a0[1]); w.y = cvt_pk_bf16(a0[2], a0[3]); w.z = cvt_pk_bf16(a1[0], a1[1]); w.w = cvt_pk_bf16(a1[2], a1[3]);
                *(u32x4*)rowp = w; }
    }
};
struct EpiKVFQ {
    static constexpr bool PERM = false, AFTER_DRAIN = false;
    float* kP; float* vP; float* lfP; float* kS; float* vS; float* lfS; bf16_t* KB; bf16_t* VB; bf16_t* KALL; bf16_t* VALL; bf16_t* QB; const float* bf; const float* ssq;
    __device__ __forceinline__ void operator()(const f32x4 (&acc)[2][2][4][2], const Unit& u, int wr, int wc, int fr, int fq) const {
        const int row0 = u.pm * BM + wr * 64 + fr;
        float rs[2][4];
#pragma unroll
        for (int ai = 0; ai < 2; ++ai)
#pragma unroll
            for (int m = 0; m < 4; ++m) rs[ai][m] = 1.0f / sqrtf(ssq[row0 + ai * HALF + m * 16] * (1.f / DM) + 1e-6f);
        if (u.pn >= 5) {
            const int col0 = (u.pn - 5) * BM + wc * 32 + 4 * fq;
#pragma unroll
            for (int ai = 0; ai < 2; ++ai)
#pragma unroll
                for (int m = 0; m < 4; ++m) { bf16_t* bo = QB + (size_t)(row0 + ai * HALF + m * 16) * DM + col0;
#pragma unroll
                    for (int bj = 0; bj < 2; ++bj)
#pragma unroll
                        for (int n = 0; n < 2; ++n) { const f32x4 v = acc[ai][bj][m][n] * rs[ai][m]; u32x2 w; w.x = cvt_pk_bf16(v[0], v[1]); w.y = cvt_pk_bf16(v[2], v[3]); *(u32x2*)(bo + bj * HALF + n * 16) = w; } }
        } else if (u.pn < 4) {
            const bool isv = u.pn >= 2; const int col0 = (u.pn & 1) * BM + wc * 32 + 4 * fq;
            float* fP = isv ? vP : kP; float* fS = isv ? vS : kS; bf16_t* bP = isv ? VB : KB; bf16_t* bA = isv ? VALL : KALL;
#pragma unroll
            for (int ai = 0; ai < 2; ++ai)
#pragma unroll
                for (int m = 0; m < 4; ++m) { const int row = row0 + ai * HALF + m * 16; float* fo; bf16_t* bo;
                    if (row < TP) { fo = fP + (size_t)row * 512 + col0; bo = bP + (size_t)row * 512 + col0; }
                    else { const int r2 = row - TP; fo = fS + (size_t)r2 * 512 + col0; bo = bA + ((size_t)(r2 >> 5) * LKS + PASTL + (r2 & 31)) * 512 + col0; }
#pragma unroll
                    for (int bj = 0; bj < 2; ++bj)
#pragma unroll
                        for (int n = 0; n < 2; ++n) { const f32x4 v = acc[ai][bj][m][n] * rs[ai][m]; *(f32x4*)(fo + bj * HALF + n * 16) = v;
                            u32x2 w; w.x = cvt_pk_bf16(v[0], v[1]); w.y = cvt_pk_bf16(v[2], v[3]); *(u32x2*)(bo + bj * HALF + n * 16) = w; } }
        } else if (wc == 0) {
            const f32x4 bb = *(const f32x4*)(bf + 4 * fq);
#pragma unroll
            for (int ai = 0; ai < 2; ++ai)
#pragma unroll
                for (int m = 0; m < 4; ++m) { const int row = row0 + ai * HALF + m * 16; const f32x4 z = acc[ai][0][m][0] * rs[ai][m] + bb; f32x4 r;
#pragma unroll
                    for (int j = 0; j < 4; ++j) r[j] = fminf(z[j], 0.f) - log1pf(__expf(-fabsf(z[j])));
                    float* o = row < TP ? lfP + (size_t)row * 16 : lfS + (size_t)(row - TP) * 16; *(f32x4*)(o + 4 * fq) = r; }
        }
    }
};
}
namespace fox {
enum { ORDER_NATURAL = 0, ORDER_REVERSED = 1, ORDER_PAIRED = 2, ORDER_XCD = 4 };
constexpr int D = 128, QS = 2048, KS = 512, OS = 2048;
constexpr float THR = 8.f;
constexpr bool WSKIP = false;
constexpr float SCALE = 0.08838834764831845f;
constexpr int NW = 8, QBLK = 32, KVBLK = 64, QB = NW * QBLK;
constexpr int SHM_V = KVBLK * D * 2, SHM_K = KVBLK * D * 2;
constexpr int LDS_BYTES = 2 * SHM_V + 2 * SHM_K + NW * 64 * 4 + 2 * 64 * 4;
typedef unsigned short bf16;
typedef short bf16x8 __attribute__((ext_vector_type(8)));
typedef short s16x4 __attribute__((ext_vector_type(4)));
typedef float f32x16 __attribute__((ext_vector_type(16)));
typedef float f32x4 __attribute__((ext_vector_type(4)));
typedef unsigned u32x4 __attribute__((ext_vector_type(4)));
template <class A, class Bt> struct same_t { static constexpr bool v = false; };
template <class A> struct same_t<A, A> { static constexpr bool v = true; };

#define KSWZ(row, colB) ((row) * 256 + ((colB) ^ (((row) & 7) << 4)))
#define SBAR() __builtin_amdgcn_sched_barrier(0)
__device__ __forceinline__ int v_st(int k, int c) { const int kk = (k & ~0xC) | ((k & 4) << 1) | ((k & 8) >> 1); return ((kk >> 3) * 4 + (c >> 5)) * 512 + ((kk & 7) * 32 + (c & 31)) * 2; }
__device__ __forceinline__ int v_rd_base(int lane) { return ((lane & 3) << 3) | (((lane >> 2) & 3) << 6) | (((lane >> 4) & 1) << 5) | (((lane >> 5) & 1) << 8); }
constexpr int v_rd_off(int d0, int ks, int half) { return d0 * 512 + ks * 4096 + half * 2048; }
__device__ __forceinline__ int crow(int r, int hi) { return (r & 3) + 8 * (r >> 2) + 4 * hi; }
__device__ __forceinline__ unsigned cvtpk(float lo, float hi) {
    unsigned r; asm volatile("v_cvt_pk_bf16_f32 %0, %1, %2" : "=v"(r) : "v"(lo), "v"(hi)); return r;
}
__device__ __forceinline__ bf16x8 pack8(f32x4 a, f32x4 b) {
    u32x4 w = {cvtpk(a[0], a[1]), cvtpk(a[2], a[3]), cvtpk(b[0], b[1]), cvtpk(b[2], b[3])};
    return *reinterpret_cast<bf16x8*>(&w);
}
template <class T> __device__ __forceinline__ bf16x8 load8(const T* p) {
    if constexpr (same_t<T, float>::v) { return pack8(*(const f32x4*)p, *(const f32x4*)(p + 4)); }
    else { return *reinterpret_cast<const bf16x8*>(p); }
}
__device__ __forceinline__ void mask_tile(f32x16& p0, f32x16& p1, int dq, unsigned W) {
    const float NEG = -__builtin_inff();
#pragma unroll
    for (int r = 0; r < 16; ++r) {
        const int c = (r & 3) + 8 * (r >> 2);
        if ((unsigned)(dq - c) >= W) p0[r] = NEG;
        if ((unsigned)(dq - c - 32) >= W) p1[r] = NEG;
    }
}
__device__ __forceinline__ void partialSM(f32x16& p0, f32x16& p1, float& m_reg, float& mn, float& alpha) {
    float pmax = p0[0]; for (int r = 1; r < 16; ++r) pmax = fmaxf(pmax, p0[r]); for (int r = 0; r < 16; ++r) pmax = fmaxf(pmax, p1[r]);
    { auto rr = __builtin_amdgcn_permlane32_swap(__float_as_uint(pmax), __float_as_uint(pmax), false, false);
      pmax = fmaxf(__uint_as_float(rr[0]), __uint_as_float(rr[1])); }
    constexpr float C2 = 1.4426950408889634f * SCALE;
    if (__builtin_expect(__all((pmax - m_reg) * SCALE <= THR), 1)) { mn = m_reg; alpha = 1.f; }
    else { mn = fmaxf(m_reg, pmax); alpha = __builtin_amdgcn_exp2f((m_reg - mn) * C2); m_reg = mn; }
    const float mnL = -mn * C2;
    for (int r = 0; r < 16; ++r) p0[r] = fmaf(p0[r], C2, mnL); for (int r = 0; r < 16; ++r) p1[r] = fmaf(p1[r], C2, mnL);
    for (int r = 0; r < 16; ++r) p0[r] = __builtin_amdgcn_exp2f(p0[r]);
}
__device__ __forceinline__ void finishSM(f32x16& p0, f32x16& p1, float alpha, float& l_reg, bf16x8& pa0, bf16x8& pa1, bf16x8& pa2, bf16x8& pa3) {
    for (int r = 0; r < 16; ++r) p1[r] = __builtin_amdgcn_exp2f(p1[r]);
    float ps = 0; for (int r = 0; r < 16; ++r) ps += p0[r]; for (int r = 0; r < 16; ++r) ps += p1[r];
    { auto rr = __builtin_amdgcn_permlane32_swap(__float_as_uint(ps), __float_as_uint(ps), false, false);
      ps = __uint_as_float(rr[0]) + __uint_as_float(rr[1]); }
    l_reg = l_reg * alpha + ps;
#define PK4(P, B_, OUT) do { unsigned a0 = cvtpk(P[B_+0], P[B_+1]), a1 = cvtpk(P[B_+2], P[B_+3]);                          \
        unsigned b0 = cvtpk(P[B_+4], P[B_+5]), b1 = cvtpk(P[B_+6], P[B_+7]);                                             \
        auto r0 = __builtin_amdgcn_permlane32_swap(a0, b0, false, false); auto r1 = __builtin_amdgcn_permlane32_swap(a1, b1, false, false); \
        u32x4 w = {r0[0], r1[0], r0[1], r1[1]}; OUT = *reinterpret_cast<bf16x8*>(&w); } while (0)
    PK4(p0, 0, pa0); PK4(p0, 8, pa1); PK4(p1, 0, pa2); PK4(p1, 8, pa3);
#undef PK4
}
template <int KB, bool SK>
__device__ __forceinline__ void qkt(f32x16& p0, f32x16& p1, const char* K_lds, int r32, int hi, const bf16x8* qr, bool act) {
    if (SK && !act) { const float NEG = -__builtin_inff();
#pragma unroll
        for (int r = 0; r < 16; ++r) { p0[r] = NEG; p1[r] = NEG; } return; }
    { const float* bb_ = (const float*)(K_lds + 2 * SHM_K + NW * 64 * 4) + KB * 64 + 4 * hi;
#pragma unroll
      for (int q_ = 0; q_ < 4; ++q_) { const f32x4 b0_ = *(const f32x4*)(bb_ + 8 * q_), b1_ = *(const f32x4*)(bb_ + 32 + 8 * q_);
#pragma unroll
        for (int i_ = 0; i_ < 4; ++i_) { p0[4 * q_ + i_] = b0_[i_]; p1[4 * q_ + i_] = b1_[i_]; } } }
    const char* kb[4];
#pragma unroll
    for (int dd = 0; dd < 4; ++dd) kb[dd] = K_lds + KB * SHM_K + KSWZ(r32, (dd * 16 + hi * 8) * 2);
#pragma unroll
    for (int d0 = 0; d0 < 8; ++d0) { const char* a = kb[d0 & 3] + (d0 >> 2) * 128;
        bf16x8 b0 = *reinterpret_cast<const bf16x8*>(a);
        bf16x8 b1 = *reinterpret_cast<const bf16x8*>(a + 32 * 256);
        p0 = __builtin_amdgcn_mfma_f32_32x32x16_bf16(b0, qr[d0], p0, 0, 0, 0);
        p1 = __builtin_amdgcn_mfma_f32_32x32x16_bf16(b1, qr[d0], p1, 0, 0, 0); }
}
template <int VB, bool SK>
__device__ __forceinline__ void pv_tile(f32x16* o, int vb0, bf16x8 pa0, bf16x8 pa1, bf16x8 pa2, bf16x8 pa3, bool act) {
    if (SK && !act) return;
#define TRRD(dst, off) asm volatile("ds_read_b64_tr_b16 %0, %1 offset:%2" : "=&v"(dst) : "v"(vb0), "i"(off) : "memory")
#define PV_D0(d0) do { s16x4 l0, l1, l2, l3, h0, h1, h2, h3; constexpr int b_ = VB * SHM_V + v_rd_off(d0, 0, 0);     \
        TRRD(l0, b_); TRRD(h0, b_ + 2048); TRRD(l1, b_ + 4096); TRRD(h1, b_ + 6144); TRRD(l2, b_ + 8192); TRRD(h2, b_ + 10240); TRRD(l3, b_ + 12288); TRRD(h3, b_ + 14336); \
        asm volatile("s_waitcnt lgkmcnt(0)" ::: "memory"); SBAR();                 \
        o[d0] = __builtin_amdgcn_mfma_f32_32x32x16_bf16(pa0, (bf16x8){l0[0], l0[1], l0[2], l0[3], h0[0], h0[1], h0[2], h0[3]}, o[d0], 0, 0, 0);   \
        o[d0] = __builtin_amdgcn_mfma_f32_32x32x16_bf16(pa1, (bf16x8){l1[0], l1[1], l1[2], l1[3], h1[0], h1[1], h1[2], h1[3]}, o[d0], 0, 0, 0);   \
        o[d0] = __builtin_amdgcn_mfma_f32_32x32x16_bf16(pa2, (bf16x8){l2[0], l2[1], l2[2], l2[3], h2[0], h2[1], h2[2], h2[3]}, o[d0], 0, 0, 0);   \
        o[d0] = __builtin_amdgcn_mfma_f32_32x32x16_bf16(pa3, (bf16x8){l3[0], l3[1], l3[2], l3[3], h3[0], h3[1], h3[2], h3[3]}, o[d0], 0, 0, 0); } while (0)
    PV_D0(0); PV_D0(1); PV_D0(2); PV_D0(3);
#undef PV_D0
#undef TRRD
}
template <class TIn, class TOut> struct BlockRef { const TIn* Q; const TIn* K; const TIn* V; TOut* O; const float* FB; int P0; };
template <class TIn> struct Seam {
    bf16x8 qr[8];
    bf16x8 st_v0, st_v1, st_k0, st_k1; float st_f; f32x4 sf0, sf1, sf2, sf3;
    f32x4 tq[16];
};
__device__ __forceinline__ int swa_jlo(int P0, int W) { const int lowk = P0 - W + 1; return lowk > 0 ? lowk / KVBLK : 0; }
#define ROW(p, k0, rr) ((p) + (size_t)((k0) + (rr)) * KS + sc)
#define VMW() asm volatile("s_waitcnt vmcnt(0)" ::: "memory")
#define VMWN(n) asm volatile("s_waitcnt vmcnt(%0)" :: "i"(n) : "memory")
#define SLOAD_H(Kp, Vp, Fp, k0) do { S.st_f = (Fp)[(k0) + (tid & 63)]; S.st_v0 = load8<TIn>(ROW(Vp, k0, sr)); S.st_v1 = load8<TIn>(ROW(Vp, k0, 32 + sr));              \
                         S.st_k0 = load8<TIn>(ROW(Kp, k0, sr)); S.st_k1 = load8<TIn>(ROW(Kp, k0, 32 + sr)); } while (0)
#define SWRITE_HK(bf) do { ((float*)(K_lds + 2 * SHM_K + NW * 64 * 4))[(bf) * 64 + (tid & 63)] = S.st_f; *(bf16x8*)(K_lds + (bf) * SHM_K + kws) = S.st_k0; *(bf16x8*)(K_lds + (bf) * SHM_K + kws + 32 * 256) = S.st_k1; } while (0)
#define SWRITE_HV(bf) do { *(bf16x8*)(V_lds + (bf) * SHM_V + vst0) = S.st_v0; *(bf16x8*)(V_lds + (bf) * SHM_V + vst1) = S.st_v1; } while (0)
#define SWRITE_H(bf) do { SWRITE_HV(bf); SWRITE_HK(bf); } while (0)
#define SLOAD_F(p, k0) do { S.sf0 = *(const f32x4*)ROW(p, k0, sr); S.sf1 = *(const f32x4*)(ROW(p, k0, sr) + 4);                \
                            S.sf2 = *(const f32x4*)ROW(p, k0, 32 + sr); S.sf3 = *(const f32x4*)(ROW(p, k0, 32 + sr) + 4); } while (0)
#define SWRITE_KF(bf) do { *(bf16x8*)(K_lds + (bf) * SHM_K + kws) = pack8(S.sf0, S.sf1); *(bf16x8*)(K_lds + (bf) * SHM_K + kws + 32 * 256) = pack8(S.sf2, S.sf3); } while (0)
#define SWRITE_VF(bf) do { *(bf16x8*)(V_lds + (bf) * SHM_V + vst0) = pack8(S.sf0, S.sf1); *(bf16x8*)(V_lds + (bf) * SHM_V + vst1) = pack8(S.sf2, S.sf3); } while (0)
template <class TIn, class TOut>
__device__ __forceinline__ void causal_swa_prime(const BlockRef<TIn, TOut>& cur, int W, char* lds, Seam<TIn>& S) {
    constexpr bool F32 = same_t<TIn, float>::v;
    const int tid = opaque_tid(), wid = __builtin_amdgcn_readfirstlane(tid >> 6), lane = tid & 63, r32 = lane & 31, hi = lane >> 5;
    const int sr = tid >> 4, sc = (tid & 15) * 8, kws = KSWZ(sr, sc * 2); char* K_lds = lds + 2 * SHM_V;
    const int kb0 = swa_jlo(cur.P0, W) * KVBLK;
    for (int d0 = 0; d0 < 8; ++d0) S.qr[d0] = load8<TIn>(cur.Q + (size_t)(wid * QBLK + r32) * QS + d0 * 16 + hi * 8);
    if constexpr (F32) { SLOAD_F((const float*)cur.K, kb0); VMW(); SWRITE_KF(0); SBAR(); SLOAD_F((const float*)cur.V, kb0); }
    else { SLOAD_H(cur.K, cur.V, cur.FB, kb0); VMW(); SWRITE_HK(0); }
    __syncthreads();
}
template <class TIn, class TOut>
__device__ __forceinline__ void causal_swa_block(const BlockRef<TIn, TOut>& cur, const BlockRef<TIn, TOut>& nxt, int skv, int W, char* lds, Seam<TIn>& S) {
    constexpr bool F32 = same_t<TIn, float>::v;
    const int tid = opaque_tid(), wid = __builtin_amdgcn_readfirstlane(tid >> 6), lane = tid & 63, r32 = lane & 31, hi = lane >> 5;
    const int j_lo = swa_jlo(cur.P0, W);
    int j_hi = (cur.P0 + QB - 1) / KVBLK + 1; if (j_hi > skv / KVBLK) j_hi = skv / KVBLK;
    const int NT = j_hi - j_lo;
    const int kbn = swa_jlo(nxt.P0, W) * KVBLK;
    const int qlo = cur.P0 + wid * QBLK, qm = qlo + r32 - 4 * hi;
    char* V_lds = lds; char* K_lds = lds + 2 * SHM_V;
    float* ws = (float*)(lds + 2 * SHM_V + 2 * SHM_K) + wid * 64; float* li_l = ws, * al_l = ws + 32;
    float m_reg = -1e30f, l_reg = 0; f32x16 o[4] = {};
    const int sr = tid >> 4, sc = (tid & 15) * 8, vst0 = v_st(sr, sc), vst1 = v_st(32 + sr, sc), kws = KSWZ(sr, sc * 2);
    const int vb0 = (int)(uintptr_t)V_lds + v_rd_base(lane);
    const TIn* Kh = cur.K; const TIn* Vh = cur.V;
#define RESC(a) do { if (__any((a) < 1.f)) { if (hi == 0) al_l[r32] = (a); asm volatile("s_waitcnt lgkmcnt(0)" ::: "memory");              \
                     for (int d_ = 0; d_ < 4; ++d_) for (int r = 0; r < 16; ++r) o[d_][r] *= al_l[crow(r, hi)]; } } while (0)
#define KBASE(t) ((j_lo + (t)) * KVBLK)
#define ACT(t) (KBASE(t) <= qlo + QBLK - 1 && KBASE(t) + KVBLK - 1 >= qlo - W + 1)
#define MASKT(P0_, P1_, t) do { const int kb_ = KBASE(t); if ((!SK || ACT(t)) && (kb_ + KVBLK - 1 > qlo || kb_ <= qlo + QBLK - 1 - W)) mask_tile(P0_, P1_, qm - kb_, (unsigned)W); } while (0)
    constexpr int NQL = F32 ? 16 : 8;
    constexpr bool SK = WSKIP && !F32;
#define SEAM_K0() do { VMWN(NQL); if constexpr (F32) { SWRITE_KF(0); SBAR(); SLOAD_F((const float*)nxt.V, kbn); } else { SWRITE_HK(0); } SBAR(); } while (0)
    f32x16 pA0, pA1, pB0, pB1; float mnA, mnB, alA, alB; bf16x8 pa0, pa1, pa2, pa3;
    if constexpr (F32) { VMW(); SWRITE_VF(0); SBAR(); } else { SWRITE_HV(0); SBAR(); }
    if (NT > 1) { if constexpr (F32) SLOAD_F((const float*)Kh, KBASE(1)); else SLOAD_H(Kh, Vh, cur.FB, KBASE(1)); }
    SBAR(); qkt<0, SK>(pA0, pA1, K_lds, r32, hi, S.qr, ACT(0));
    if constexpr (F32) { if (NT > 1) { VMW(); SWRITE_KF(1); SBAR(); SLOAD_F((const float*)Vh, KBASE(1)); } }
    MASKT(pA0, pA1, 0); partialSM(pA0, pA1, m_reg, mnA, alA);
    if (NT > 1) { VMW(); if constexpr (F32) { SWRITE_VF(1); SBAR(); if (NT > 2) SLOAD_F((const float*)Kh, KBASE(2)); } else SWRITE_H(1); }
    __syncthreads();
#define HALF_STEP(PX0, PX1, mnX, alX, PY0, PY1, alY, t, KB, VB, SB) do {                                                      \
        SBAR(); qkt<KB, SK>(PX0, PX1, K_lds, r32, hi, S.qr, ACT(t));                                             \
        finishSM(PY0, PY1, alY, l_reg, pa0, pa1, pa2, pa3); SBAR();                                                           \
        if ((t) + 1 < NT) { if constexpr (F32) { VMW(); SWRITE_KF(SB); SBAR(); SLOAD_F((const float*)Vh, KBASE((t) + 1)); }  \
                            else { SLOAD_H(Kh, Vh, cur.FB, KBASE((t) + 1)); } SBAR(); }                                               \
        pv_tile<VB, SK>(o, vb0, pa0, pa1, pa2, pa3, ACT((t) - 1)); MASKT(PX0, PX1, (t)); partialSM(PX0, PX1, m_reg, mnX, alX);                                        \
        __syncthreads();                                                                                                      \
        if ((t) + 1 < NT) { VMW(); if constexpr (F32) { SWRITE_VF(SB); SBAR(); if ((t) + 2 < NT) SLOAD_F((const float*)Kh, KBASE((t) + 2)); } \
                            else { SWRITE_H(SB); } }                                                                          \
        RESC(alX); __syncthreads(); } while (0)
    for (int t = 1; t + 1 < NT; t += 2) {
        HALF_STEP(pB0, pB1, mnB, alB, pA0, pA1, alA, t, 1, 0, 0);
        HALF_STEP(pA0, pA1, mnA, alA, pB0, pB1, alB, t + 1, 0, 1, 1);
    }
    const bool even = (NT & 1) == 0;
    if (even) { SBAR(); qkt<1, SK>(pB0, pB1, K_lds, r32, hi, S.qr, ACT(NT - 1)); SBAR(); }
#define QROW(e) (nxt.Q + (size_t)(wid * QBLK + r32) * D + ((e) >> 1) * 16 + hi * 8 + ((e) & 1) * 4)
    if constexpr (F32) { SLOAD_F((const float*)nxt.K, kbn); SBAR();
#pragma unroll
        for (int e = 0; e < 8; ++e) S.tq[e] = *(const f32x4*)QROW(e); }
    else { SLOAD_H(nxt.K, nxt.V, nxt.FB, kbn); SBAR();
#pragma unroll
        for (int d0 = 0; d0 < 8; ++d0) S.qr[d0] = load8<TIn>(nxt.Q + (size_t)(wid * QBLK + r32) * QS + d0 * 16 + hi * 8); }
    SBAR();
    finishSM(pA0, pA1, alA, l_reg, pa0, pa1, pa2, pa3); SBAR();
    if constexpr (F32) {
#pragma unroll
        for (int e = 8; e < 16; ++e) S.tq[e] = *(const f32x4*)QROW(e); SBAR(); }
#undef QROW
    pv_tile<0, SK>(o, vb0, pa0, pa1, pa2, pa3, ACT(even ? NT - 2 : NT - 1));
    if (even) { MASKT(pB0, pB1, NT - 1); partialSM(pB0, pB1, m_reg, mnB, alB); __syncthreads(); RESC(alB);
        finishSM(pB0, pB1, alB, l_reg, pa0, pa1, pa2, pa3); SBAR(); pv_tile<1, SK>(o, vb0, pa0, pa1, pa2, pa3, ACT(NT - 1)); }
    SBAR(); SEAM_K0();
    if (hi == 0) li_l[r32] = l_reg; asm volatile("s_waitcnt lgkmcnt(0)" ::: "memory");
    float rli[16];
#pragma unroll
    for (int r = 0; r < 16; ++r) rli[r] = __builtin_amdgcn_rcpf(li_l[crow(r, hi)]);
    TOut* Ow = cur.O + (size_t)(wid * QBLK) * OS;
#pragma unroll
    for (int r = 0; r < 16; ++r) { const int orow = crow(r, hi);
#pragma unroll
        for (int d0 = 0; d0 < 4; ++d0) { const float v = o[d0][r] * rli[r];
            if constexpr (same_t<TOut, float>::v) { Ow[(size_t)orow * OS + d0 * 32 + r32] = v; }
            else { const float vn = __shfl_xor(v, 1);
                   if ((r32 & 1) == 0) *(unsigned*)(Ow + (size_t)orow * OS + d0 * 32 + r32) = cvtpk(v, vn); } } }
    if constexpr (F32) {
#pragma unroll
        for (int d0 = 0; d0 < 8; ++d0) S.qr[d0] = pack8(S.tq[2 * d0], S.tq[2 * d0 + 1]); }
    __syncthreads();
#undef RESC
#undef KBASE
#undef ACT
#undef MASKT
#undef SEAM_K0
#undef HALF_STEP
}
#undef ROW
#undef VMW
#undef VMWN
#undef SLOAD_H
#undef SWRITE_HK
#undef SWRITE_HV
#undef SWRITE_H
#undef SLOAD_F
#undef SWRITE_KF
#undef SWRITE_VF

__host__ __device__ inline int swa_nramp(int nqb, int W, int qoff) { const int t = W - 1 - qoff; const int n = t < 0 ? 0 : t / QB + 1; return n > nqb ? nqb : n; }
__host__ __device__ inline int swa_nx(int nqb, int nramp, int order) { return (order & ORDER_PAIRED) ? (nramp + 1) / 2 + (nqb - nramp) : nqb; }
struct SwaItem { int bh, qb0, qb1; };
__device__ __forceinline__ SwaItem swa_decode(int L, int nb, int nh, int nhkv, int nqb, int nx, int nramp, int order) {
    const int G = nh / nhkv; SwaItem it; int x;
    if ((order & ORDER_XCD) && (nb * nhkv) % 8 == 0) { const int xcd = L & 7, k = L >> 3, per = G * nx, gi = k / per, r = k - gi * per;
        it.bh = (gi * 8 + xcd) * G + r / nx; x = r % nx; }
    else { it.bh = L / nx; x = L - it.bh * nx; }
    if (order & ORDER_PAIRED) { const int ns = nqb - nramp;
        if (x < ns) { it.qb0 = it.qb1 = nqb - 1 - x; } else { it.qb0 = x - ns; it.qb1 = nramp - 1 - it.qb0; } }
    else { it.qb0 = it.qb1 = ((order & 3) == ORDER_REVERSED) ? nqb - 1 - x : x; }
    return it;
}
typedef unsigned short bf16;
__device__ __forceinline__ BlockRef<bf16, bf16> mk_ref(const SwaItem& it, int pass, const bf16* Q, const bf16* K, const bf16* V, bf16* O, const float* FB) {
    const int qb = pass ? it.qb1 : it.qb0, b = it.bh >> 4, h = it.bh & 15, kvh = h >> 2;
    BlockRef<bf16, bf16> r;
    r.Q = Q + ((size_t)b * 8192 + (size_t)qb * QB) * QS + h * 128; r.O = O + ((size_t)b * 8192 + (size_t)qb * QB) * OS + h * 128;
    r.K = K + (size_t)b * 8192 * KS + kvh * 128; r.V = V + (size_t)b * 8192 * KS + kvh * 128; r.FB = FB + (size_t)it.bh * 8192; r.P0 = qb * QB;
    return r;
}
__device__ __forceinline__ void attn_phase(char* lds, const bf16* Q, const bf16* K, const bf16* V, bf16* O, const float* FB) {
    constexpr int nb = 4, nh = 16, nhkv = 4, nqb = 32, W = 8192, order = ORDER_PAIRED | ORDER_XCD;
    const int nramp = swa_nramp(nqb, W, 0), nx = swa_nx(nqb, nramp, order), total = nx * nb * nh, stride = gridDim.x;
    int L = blockIdx.x; if (L >= total) return;
    SwaItem it = swa_decode(L, nb, nh, nhkv, nqb, nx, nramp, order); int pass = 0;
    BlockRef<bf16, bf16> cur = mk_ref(it, 0, Q, K, V, O, FB);
    Seam<bf16> S;
    causal_swa_prime<bf16, bf16>(cur, W, lds, S);
    for (;;) {
        const bool more_pass = pass == 0 && it.qb1 != it.qb0, more_item = L + stride < total, last = !more_pass && !more_item;
        SwaItem itn = it; int passn = pass + 1, Ln = L;
        if (!more_pass) { passn = 0; Ln = more_item ? L + stride : L; itn = swa_decode(Ln, nb, nh, nhkv, nqb, nx, nramp, order); }
        const BlockRef<bf16, bf16> nxt = last ? cur : mk_ref(itn, passn, Q, K, V, O, FB);
        causal_swa_block<bf16, bf16>(cur, nxt, 8192, W, lds, S);
        if (last) break;
        cur = nxt; it = itn; pass = passn; L = Ln;
    }
}
}
constexpr size_t WS_WIN = 0, WS_WRO = 50331648, WS_WGU0 = 67108864, WS_WGU1 = 113246208, WS_WDN0 = 159383552, WS_WDN1 = 182452224,
                 WS_WO = 205520896, WS_WKVF = 213909504  , WS_COS = 227540992, WS_SIN = 231735296, WS_FB = 235929600, WS_FS = WS_FB + 2097152, WS_SSQ = WS_FS + 540672  , WS_BAR = WS_SSQ + 396288  ,
                 WS_BIG = 239075328;
constexpr size_t SZ_ROWS2K = (size_t)TALL * DM * 2;
constexpr size_t BIG_XN = 0, BIG_ACT = SZ_ROWS2K, BIG_HKV = BIG_ACT + (size_t)TALL * DFF * 2, BIG_KB = BIG_HKV + SZ_ROWS2K, BIG_VB = BIG_KB + (size_t)TP * 512 * 2,
                 BIG_KALL = BIG_VB + (size_t)TP * 512 * 2, BIG_VALL = BIG_KALL + (size_t)8 * LKS * 512 * 2, BIG_END = BIG_VALL + (size_t)8 * LKS * 512 * 2;
static_assert(BIG_END <= (size_t)TALL * NPROJ * 2, "layer-1 buffers fit in the PROJ region");
constexpr size_t WS_END = WS_BIG + (size_t)TALL * NPROJ * 2;
static_assert(WS_END <= (size_t)1073741824, "workspace fits 1 GiB");
constexpr size_t OUT_Y = 0, OUT_SP = 67633152, OUT_KP = 71827456, OUT_VP = 88604672, OUT_LFP = 105381888, OUT_SS = 105906176, OUT_KS = 114294784, OUT_VS = 114425856, OUT_LFS = 114556928;
constexpr int NWAVES = 8, LDS_BYTES = 149504;

struct Params { const float* in[21]; float* out; unsigned char* ws; };

__device__ __forceinline__ float wave_sum(float v) {
#pragma unroll
    for (int o = 1; o < 64; o <<= 1) v += __shfl_xor(v, o);
    return v;
}
__device__ __forceinline__ float bf2f(unsigned short b) { return __uint_as_float(((unsigned)b) << 16); }
__device__ __forceinline__ unsigned pk2(float lo, float hi) { return pg8::cvt_pk_bf16(lo, hi); }

__device__ __forceinline__ void transpose_item(const float* W, int K, int N, bf16_t* WT, int k0, int n0, int drow0, LAS float* scr, int lane, const float* gain = nullptr) {
#pragma unroll 8
    for (int i = 0; i < 32; ++i) { const int kk = 2 * i + (lane >> 5); scr[kk * 33 + (lane & 31)] = W[(size_t)(k0 + kk) * N + n0 + (lane & 31)] * (gain ? gain[k0 + kk] : 1.f); }
    asm volatile("s_waitcnt lgkmcnt(0)" ::: "memory");
    const int c = lane & 7;
#pragma unroll
    for (int j = 0; j < 4; ++j) { const int n = (lane >> 3) + 8 * j; const LAS float* s = scr + (8 * c) * 33 + n;
        u32x4 o; o.x = pk2(s[0 * 33], s[1 * 33]); o.y = pk2(s[2 * 33], s[3 * 33]); o.z = pk2(s[4 * 33], s[5 * 33]); o.w = pk2(s[6 * 33], s[7 * 33]);
        *(u32x4*)(WT + (size_t)(drow0 + n) * K + k0 + 8 * c) = o; }
    asm volatile("s_waitcnt lgkmcnt(0)" ::: "memory");
}
__device__ __forceinline__ void tr_plain(const float* W, int K, int N, bf16_t* WT, int row_off, LAS float* scr, int item, int lane, const float* gain = nullptr) {
    const int nblk = N / 32, kb = item / nblk, nb = item % nblk; transpose_item(W, K, N, WT, 64 * kb, 32 * nb, row_off + 32 * nb, scr, lane, gain);
}
__device__ __forceinline__ void tr_gu(const float* W, bf16_t* WT, int up, LAS float* scr, int item, int lane, const float* gain) {
    const int nblk = DFF / 32, kb = item / nblk, nb = item % nblk, n0 = 32 * nb; transpose_item(W, DM, DFF, WT, 64 * kb, n0, (n0 >> 7) * 256 + up * 128 + (n0 & 127), scr, lane, gain);
}
template <int MODE  >
__device__ __forceinline__ void rms_row(const float* xrow, const float* g1, bf16_t* o1, const float* g2, bf16_t* o2, float* of, int lane) {
    const f32x4* xr = (const f32x4*)xrow + lane;
    f32x4 v[8]; float s = 0.f;
#pragma unroll
    for (int j = 0; j < 8; ++j) { v[j] = xr[64 * j]; s += (v[j].x * v[j].x + v[j].y * v[j].y) + (v[j].z * v[j].z + v[j].w * v[j].w); }
    const float rs = 1.0f / sqrtf(wave_sum(s) * (1.f / DM) + 1e-6f);
#pragma unroll
    for (int j = 0; j < 8; ++j) { const f32x4 ga = ((const f32x4*)g1)[64 * j + lane]; const f32x4 y = v[j] * rs;
        if (MODE == 2) { ((f32x4*)of)[64 * j + lane] = y * ga; }
        else { u32x2 w; w.x = pk2(y.x * ga.x, y.y * ga.y); w.y = pk2(y.z * ga.z, y.w * ga.w); ((u32x2*)o1)[64 * j + lane] = w;
            if (MODE == 1) { const f32x4 gb = ((const f32x4*)g2)[64 * j + lane]; u32x2 w2; w2.x = pk2(y.x * gb.x, y.y * gb.y); w2.y = pk2(y.z * gb.z, y.w * gb.w); ((u32x2*)o2)[64 * j + lane] = w2; } } }
}

namespace ret {
constexpr int QOFF = 0, KOFF = 33792, STOFF = 67584, VOFF = 101376, POFF = 110592, RS = 528, VS = 144;
typedef short v4i16_t __attribute__((ext_vector_type(4)));
__device__ __forceinline__ bf16x8 frag_rm(const LAS char* base, int stride, int i0, int k0, int fr, int fq) { return *(const LAS bf16x8*)(base + (i0 + fr) * stride + (k0 + 8 * fq) * 2); }
__device__ __forceinline__ s16x4 tr4(const LAS char* p) { return __builtin_bit_cast(s16x4, __builtin_amdgcn_ds_read_tr16_b64_v4i16((LAS v4i16_t*)p)); }
__device__ __forceinline__ bf16x8 frag_tr(const LAS char* base, int stride, int k0, int i0, int fr, int fq) {
    const LAS char* p = base + (k0 + 8 * fq + (fr >> 2)) * stride + (i0 + 4 * (fr & 3)) * 2;
    const s16x4 a = tr4(p), b = tr4(p + 4 * stride);
    return (bf16x8){a[0], a[1], a[2], a[3], b[0], b[1], b[2], b[3]};
}
#define MFMA16(X, Y, C) __builtin_amdgcn_mfma_f32_16x16x32_bf16(X, Y, C, 0, 0, 0)
__device__ __forceinline__ void ret_item(LAS char* lds, const bf16_t* pin, bf16_t* pout  , int nchunks, int c, int h, int es, const float* S0, float* Sout) {
    const int tid = opaque_tid(), wid = __builtin_amdgcn_readfirstlane(tid >> 6), lane = tid & 63, fr = lane & 15, fq = lane >> 4, lt = wid >> 1, half = wid & 1;
    const float lg2 = __log2f(1.0f - exp2f(-5.0f - (float)h)), gam = exp2f(lg2), gc1 = exp2f(lg2 * (float)(c - 1));
    f32x4 accT[8];
    const int eT = 16 * lt + fr;
#pragma unroll
    for (int i = 0; i < 8; ++i) { const int d0 = 16 * (8 * half + i) + 4 * fq;
#pragma unroll
        for (int r = 0; r < 4; ++r) accT[i][r] = S0 ? S0[(size_t)(d0 + r) * 512 + es * 64 + eT] : 0.f;
        u32x2 w; w.x = pk2(accT[i][0], accT[i][1]); w.y = pk2(accT[i][2], accT[i][3]); *(LAS u32x2*)(lds + STOFF + eT * RS + d0 * 2) = w; }
    u32x4 rq[4], rk[4], rv;
    const bf16_t* gq = pin + h * 256; const bf16_t* gk = pin + 2048 + h * 256; const bf16_t* gv = pin + 4096 + h * 512 + es * 64;
#define RET_LOAD(n) do { _Pragma("unroll") for (int i = 0; i < 4; ++i) { const int p = tid + 512 * i, row = p >> 5, ch = p & 31; const size_t go = (size_t)((n) * 64 + row) * NPROJ + ch * 8; \
            if (row < c) { rq[i] = *(const u32x4*)(gq + go); rk[i] = *(const u32x4*)(gk + go); } else { rq[i] = (u32x4){0u, 0u, 0u, 0u}; rk[i] = (u32x4){0u, 0u, 0u, 0u}; } } \
        { const int row = tid >> 3, ch = tid & 7; if (row < c) rv = *(const u32x4*)(gv + (size_t)((n) * 64 + row) * NPROJ + ch * 8); else rv = (u32x4){0u, 0u, 0u, 0u}; } } while (0)
    RET_LOAD(0);
    for (int n = 0; n < nchunks; ++n) {
#pragma unroll
        for (int i = 0; i < 4; ++i) { const int p = tid + 512 * i, row = p >> 5, ch = p & 31; *(LAS u32x4*)(lds + QOFF + row * RS + ch * 16) = rq[i]; *(LAS u32x4*)(lds + KOFF + row * RS + ch * 16) = rk[i]; }
        *(LAS u32x4*)(lds + VOFF + (tid >> 3) * VS + (tid & 7) * 16) = rv;
        if (n + 1 < nchunks) RET_LOAD(n + 1);
        __syncthreads();
        f32x4 accS[2], accC[2];
#pragma unroll
        for (int j = 0; j < 2; ++j) { accS[j] = (f32x4){0.f, 0.f, 0.f, 0.f}; accC[j] = (f32x4){0.f, 0.f, 0.f, 0.f}; }
#pragma unroll
        for (int ks = 0; ks < 8; ++ks) { const int k0 = 32 * ks;
            const bf16x8 yq = frag_rm(lds + QOFF, RS, 16 * lt, k0, fr, fq);
#pragma unroll
            for (int j = 0; j < 2; ++j) { const bf16x8 xk = frag_rm(lds + KOFF, RS, 16 * (2 * half + j), k0, fr, fq); accS[j] = MFMA16(xk, yq, accS[j]); }
#pragma unroll
            for (int j = 0; j < 2; ++j) { const bf16x8 xs = frag_rm(lds + STOFF, RS, 16 * (2 * half + j), k0, fr, fq); accC[j] = MFMA16(xs, yq, accC[j]); } }
        const int lrow = 16 * lt + fr;
#pragma unroll
        for (int j = 0; j < 2; ++j) { const int m0 = 16 * (2 * half + j) + 4 * fq; f32x4 s = accS[j];
#pragma unroll
            for (int r = 0; r < 4; ++r) s[r] = (m0 + r <= lrow) ? s[r] : 0.f;
            u32x2 w; w.x = pk2(s[0], s[1]); w.y = pk2(s[2], s[3]); *(LAS u32x2*)(lds + POFF + lrow * VS + m0 * 2) = w; }
        __syncthreads();
        f32x4 accO[2];
#pragma unroll
        for (int j = 0; j < 2; ++j) accO[j] = accC[j] * gam;
#pragma unroll
        for (int ks = 0; ks < 2; ++ks) { const int k0 = 32 * ks;
            const bf16x8 yp = frag_rm(lds + POFF, VS, 16 * lt, k0, fr, fq);
#pragma unroll
            for (int j = 0; j < 2; ++j) { const bf16x8 xv = frag_tr(lds + VOFF, VS, k0, 16 * (2 * half + j), fr, fq); accO[j] = MFMA16(xv, yp, accO[j]); } }
        if (lrow < c) {
#pragma unroll
            for (int j = 0; j < 2; ++j) { u32x2 w; w.x = pk2(accO[j][0], accO[j][1]); w.y = pk2(accO[j][2], accO[j][3]);
                *(u32x2*)(pout + (size_t)(n * 64 + lrow) * 4096 + h * 512 + es * 64 + 16 * (2 * half + j) + 4 * fq) = w; } }
#pragma unroll
        for (int i = 0; i < 8; ++i) accT[i] = accT[i] * gam;
#pragma unroll
        for (int ks = 0; ks < 2; ++ks) { const int k0 = 32 * ks;
            const bf16x8 yv = frag_tr(lds + VOFF, VS, k0, 16 * lt, fr, fq);
#pragma unroll
            for (int i = 0; i < 8; ++i) { const bf16x8 xk = frag_tr(lds + KOFF, RS, k0, 16 * (8 * half + i), fr, fq); accT[i] = MFMA16(xk, yv, accT[i]); } }
#pragma unroll
        for (int i = 0; i < 8; ++i) { accT[i] = accT[i] * gc1; const int d0 = 16 * (8 * half + i) + 4 * fq;
            u32x2 w; w.x = pk2(accT[i][0], accT[i][1]); w.y = pk2(accT[i][2], accT[i][3]); *(LAS u32x2*)(lds + STOFF + eT * RS + d0 * 2) = w; }
        __syncthreads();
    }
#undef RET_LOAD
#pragma unroll
    for (int i = 0; i < 8; ++i) { const int d0 = 16 * (8 * half + i) + 4 * fq;
#pragma unroll
        for (int r = 0; r < 4; ++r) Sout[(size_t)(d0 + r) * 512 + es * 64 + eT] = accT[i][r]; }
}
}
__device__ __forceinline__ void sample_attn(LAS char* lds, const bf16_t* QBp, const bf16_t* KALL, const bf16_t* VALL, const float* FS, bf16_t* AO) {
    const int tid = opaque_tid(), wid = __builtin_amdgcn_readfirstlane(tid >> 6), lane = tid & 63;
    LAS float* qf = (LAS float*)(lds + wid * 5120); LAS float* pf = qf + 128;
    const int gw = blockIdx.x * NWAVES + wid, NGW = gridDim.x * NWAVES;
    for (int item = gw; item < 8 * 16 * 32; item += NGW) {
        const int b = item >> 9, h = (item >> 5) & 15, qi = item & 31, kvh = h >> 2, qpos = PASTL + qi, row = TP + b * 32 + qi;
        const bf16_t* q = QBp + (size_t)row * DM + h * 128;
        qf[lane] = bf2f(q[lane]); qf[lane + 64] = bf2f(q[lane + 64]);
        asm volatile("s_waitcnt lgkmcnt(0)" ::: "memory");
        const float* F = FS + (size_t)(b * 16 + h) * LKS; const float Fq = F[qpos];
        const bf16_t* Kb = KALL + (size_t)b * LKS * 512 + kvh * 128; const bf16_t* Vb = VALL + (size_t)b * LKS * 512 + kvh * 128;
        float sc[17]; float mx = -1e30f;
#pragma unroll
        for (int t = 0; t < 17; ++t) { const int j = lane + 64 * t; float s = -__builtin_inff();
            if (j <= qpos) { const u32x4* kr = (const u32x4*)(Kb + (size_t)j * 512); float a = 0.f;
#pragma unroll 4
                for (int c8 = 0; c8 < 16; ++c8) { const u32x4 kv = kr[c8]; const LAS f32x4* qq = (const LAS f32x4*)(qf + 8 * c8); const f32x4 q0 = qq[0], q1 = qq[1];
                    a += __uint_as_float(kv.x << 16) * q0.x + __uint_as_float(kv.x & 0xffff0000u) * q0.y + __uint_as_float(kv.y << 16) * q0.z + __uint_as_float(kv.y & 0xffff0000u) * q0.w
                       + __uint_as_float(kv.z << 16) * q1.x + __uint_as_float(kv.z & 0xffff0000u) * q1.y + __uint_as_float(kv.w << 16) * q1.z + __uint_as_float(kv.w & 0xffff0000u) * q1.w; }
                s = a * 0.08838834764831845f + (Fq - F[j]); }
            sc[t] = s; mx = fmaxf(mx, s); }
#pragma unroll
        for (int o = 1; o < 64; o <<= 1) mx = fmaxf(mx, __shfl_xor(mx, o));
        float sum = 0.f;
#pragma unroll
        for (int t = 0; t < 17; ++t) { const float p = __expf(sc[t] - mx); sum += p; pf[lane + 64 * t] = p; }
        sum = wave_sum(sum);
        asm volatile("s_waitcnt lgkmcnt(0)" ::: "memory");
        float o0 = 0.f, o1 = 0.f;
        for (int j = 0; j < PASTL + 32; j += 8) {
            unsigned vv[8]; float p[8];
#pragma unroll
            for (int u = 0; u < 8; ++u) { vv[u] = *(const unsigned*)(Vb + (size_t)(j + u) * 512 + 2 * lane); p[u] = pf[j + u]; }
#pragma unroll
            for (int u = 0; u < 8; ++u) { o0 += p[u] * __uint_as_float(vv[u] << 16); o1 += p[u] * __uint_as_float(vv[u] & 0xffff0000u); } }
        const float inv = 1.0f / sum;
        *(unsigned*)(AO + (size_t)row * DM + h * 128 + 2 * lane) = pk2(o0 * inv, o1 * inv);
        asm volatile("s_waitcnt lgkmcnt(0)" ::: "memory");
    }
}

#define XB_TMO      128
#define XB_XCNT(j)  (256  + 64 * (j))
#define XB_XSUB(j)  (1280 + 64 * (j))
#define XB_XGEN(j)  (2304 + 64 * (j))
#define XB_TOP      3328
#define XB_TOPGEN   3392
#define XCD_BAR_WORDS 3456
#define XB_SPIN_CAP (1u << 18)

__device__ __forceinline__ unsigned xb_ld(unsigned* p)              { return __hip_atomic_load(p, __ATOMIC_RELAXED, __HIP_MEMORY_SCOPE_AGENT); }
__device__ __forceinline__ unsigned xb_add(unsigned* p, unsigned v) { return __hip_atomic_fetch_add(p, v, __ATOMIC_RELAXED, __HIP_MEMORY_SCOPE_AGENT); }
__device__ __forceinline__ unsigned xb_xcc_id() { return (unsigned)__builtin_amdgcn_s_getreg((3 << 11) | 20) & 0xFu; }
#define XB_SPIN(cond, bar) do { unsigned _sp = 0; while (cond) { __builtin_amdgcn_s_sleep(1); \
    if ((++_sp & 255u) == 0u) { if (xb_ld(&(bar)[XB_TMO])) break; if (_sp > XB_SPIN_CAP) { atomicAdd(&(bar)[XB_TMO], 1u); break; } } } } while (0)

struct XcdBarrier {
    unsigned* bar; unsigned x;
    volatile LAS unsigned* st;
};

__device__ __forceinline__ XcdBarrier xcd_barrier_post(unsigned* bar, volatile LAS unsigned* st) {
    XcdBarrier b; b.bar = bar; b.x = xb_xcc_id(); b.st = st;
    if (threadIdx.x == 0) (void)xb_add(&bar[XB_XCNT(b.x)], 1u);
    return b;
}
__device__ __forceinline__ void xcd_barrier_complete(unsigned* bar, unsigned x, unsigned& nloc, unsigned& nx) {
    const unsigned G = gridDim.x * gridDim.y * gridDim.z;
    unsigned sum, cnt, mine, sp = 0u;
    for (;;) {
        sum = 0u; cnt = 0u; mine = 0u;
#pragma unroll
        for (unsigned j = 0; j < 16; ++j) { const unsigned c = xb_ld(&bar[XB_XCNT(j)]); sum += c; cnt += (c > 0u) ? 1u : 0u; mine = (j == x) ? c : mine; }
        if (sum == G) break;
        __builtin_amdgcn_s_sleep(1);
        if ((++sp & 255u) == 0u) { if (xb_ld(&bar[XB_TMO])) break; if (sp > XB_SPIN_CAP) { atomicAdd(&bar[XB_TMO], 1u); break; } }
    }
    nloc = mine > 0u ? mine : 1u; nx = cnt > 0u ? cnt : 1u;
}

__device__ __forceinline__ void xcd_barrier(const XcdBarrier& b) {
    asm volatile("s_waitcnt vmcnt(0)" ::: "memory");
    __syncthreads();
    if (threadIdx.x == 0) {
        unsigned* bar = b.bar;
        __builtin_amdgcn_s_waitcnt(0);
        unsigned nloc = b.st[0], nx = b.st[1];
        if (nloc == 0u) { xcd_barrier_complete(bar, b.x, nloc, nx); b.st[0] = nloc; b.st[1] = nx; }
        const unsigned old = xb_add(&bar[XB_XSUB(b.x)], 1u);
        const unsigned gen = old / nloc;
        if (old + 1u == (gen + 1u) * nloc) {
            __builtin_amdgcn_fence(__ATOMIC_RELEASE, "agent");
            asm volatile("s_waitcnt vmcnt(0)" ::: "memory");
            const unsigned og = xb_add(&bar[XB_TOP], 1u);
            const unsigned tg = og / nx;
            if (og + 1u == (tg + 1u) * nx) xb_add(&bar[XB_TOPGEN], 1u);
            else XB_SPIN(xb_ld(&bar[XB_TOPGEN]) == tg, bar);
            __builtin_amdgcn_fence(__ATOMIC_ACQUIRE, "agent");
            xb_add(&bar[XB_XGEN(b.x)], 1u);
            asm volatile("s_waitcnt vmcnt(0)" ::: "memory");
        } else {
            XB_SPIN(xb_ld(&bar[XB_XGEN(b.x)]) == gen, bar);
            __builtin_amdgcn_fence(__ATOMIC_ACQUIRE, "agent");
            asm volatile("s_waitcnt vmcnt(0)" ::: "memory");
        }
    }
    __syncthreads();
}

#define KARG(i) ((unsigned char*)(((const volatile __attribute__((address_space(4))) unsigned long long*)__builtin_amdgcn_kernarg_segment_ptr())[i]))
#define INF(i) ((const float*)KARG(i))
#define OUTP ((float*)KARG(21))
#define WSP (KARG(22))
#define BIGP (KARG(22) + WS_BIG)
#define PH_IDS const int tid = opaque_tid(), lane = tid & 63, wave = __builtin_amdgcn_readfirstlane(tid >> 6); const int G = gridDim.x, gw = blockIdx.x * NWAVES + wave, NGW = G * NWAVES; const size_t gt = (size_t)blockIdx.x * 512 + tid, NGT = (size_t)G * 512; (void)lane; (void)gw; (void)NGW; (void)gt; (void)NGT

__device__ __forceinline__ void ph_prologue(LAS unsigned char* lds) {
    PH_IDS; unsigned char* ws = WSP;
    bf16_t* WIN = (bf16_t*)(ws + WS_WIN); bf16_t* WRO = (bf16_t*)(ws + WS_WRO); bf16_t* WKVF = (bf16_t*)(ws + WS_WKVF);
    LAS float* scr = (LAS float*)(lds + wave * 16384);
    constexpr int I0 = 32 * 384, I1 = 64 * 64;
    for (int it = gw; it < I0 + I1; it += NGW) { int r = it;
        if (r < I0) { tr_plain(INF(10), DM, NPROJ, WIN, 0, scr, r, lane); continue; } r -= I0;
        tr_plain(INF(11), 4096, DM, WRO, 0, scr, r, lane);
    }
    { const float* wf = INF(14); const float* nkv = INF(8);
      for (size_t i = gt; i < (size_t)256 * DM; i += NGT) { const int r = (int)(i >> 11), k = (int)(i & 2047); WKVF[(size_t)(1024 + r) * DM + k] = r < 16 ? (bf16_t)(pk2(wf[k * 16 + r] * nkv[k], 0.f) & 0xffffu) : (bf16_t)0; }
      float* ssq = (float*)(ws + WS_SSQ); for (size_t i = gt; i < (size_t)3 * TALL; i += NGT) ssq[i] = 0.f; }
    { float* COS = (float*)(ws + WS_COS); float* SIN = (float*)(ws + WS_SIN);
      for (size_t i = gt; i < (size_t)SEQ * 128; i += NGT) { const int pos = (int)(i >> 7), d = (int)(i & 127);
        const float inv = exp2f(-(float)d * (13.287712379549449f / 128.f));
        const double rev = (double)pos * (double)inv * 0.15915494309189535; const float fr = (float)(rev - __builtin_floor(rev));
        COS[i] = __builtin_amdgcn_cosf(fr); SIN[i] = __builtin_amdgcn_sinf(fr); } }
    { const float* x_p = INF(0); const float* x_s = INF(1); const float* nm = INF(6); bf16_t* XN0 = (bf16_t*)OUTP;
      for (int m = gw; m < TALL; m += NGW) rms_row<0>(m < TP ? x_p + (size_t)m * DM : x_s + (size_t)(m - TP) * DM, nm, XN0 + (size_t)m * DM, nullptr, nullptr, nullptr, lane); }
}
template <int JOB> __device__ __forceinline__ void ph_conv(LAS unsigned char* lds) {
    const int tid = opaque_tid(), lane = tid & 63, wave = __builtin_amdgcn_readfirstlane(tid >> 6);
    const int G = gridDim.x, first = G > 16 ? 8 : 0;
    if ((int)blockIdx.x < first) return;
    const int gw = ((int)blockIdx.x - first) * NWAVES + wave, NGW = (G - first) * NWAVES;
    unsigned char* ws = WSP; LAS float* scr = (LAS float*)(lds + wave * 16384);
    constexpr int IG = 32 * 176, ID = 88 * 64, IQ = 32 * 64, IK = 32 * 16;
    if (JOB == 1) {
        bf16_t* WGU0 = (bf16_t*)(ws + WS_WGU0); bf16_t* WDN0 = (bf16_t*)(ws + WS_WDN0);
        for (int it = gw; it < 2 * IG + ID; it += NGW) { int r = it;
            if (r < IG) { tr_gu(INF(18), WGU0, 0, scr, r, lane, INF(7)); continue; } r -= IG;
            if (r < IG) { tr_gu(INF(19), WGU0, 1, scr, r, lane, INF(7)); continue; } r -= IG;
            tr_plain(INF(20), DFF, DM, WDN0, 0, scr, r, lane); }
    } else {
        bf16_t* WGU1 = (bf16_t*)(ws + WS_WGU1); bf16_t* WDN1 = (bf16_t*)(ws + WS_WDN1); bf16_t* WO = (bf16_t*)(ws + WS_WO); bf16_t* WKVF = (bf16_t*)(ws + WS_WKVF);
        for (int it = gw; it < 2 * IQ + 2 * IK + 2 * IG + ID; it += NGW) { int r = it;
            if (r < IQ) { tr_plain(INF(16), DM, DM, WKVF, 1280, scr, r, lane, INF(6) + DM); continue; } r -= IQ;
            if (r < IK) { tr_plain(INF(12), DM, 512, WKVF, 0, scr, r, lane, INF(8)); continue; } r -= IK;
            if (r < IK) { tr_plain(INF(13), DM, 512, WKVF, 512, scr, r, lane, INF(8)); continue; } r -= IK;
            if (r < IQ) { tr_plain(INF(17), DM, DM, WO, 0, scr, r, lane); continue; } r -= IQ;
            if (r < IG) { tr_gu(INF(18) + (size_t)DM * DFF, WGU1, 0, scr, r, lane, INF(7) + DM); continue; } r -= IG;
            if (r < IG) { tr_gu(INF(19) + (size_t)DM * DFF, WGU1, 1, scr, r, lane, INF(7) + DM); continue; } r -= IG;
            tr_plain(INF(20) + (size_t)DFF * DM, DFF, DM, WDN1, 0, scr, r, lane); }
    }
}
__device__ __forceinline__ void ph_retin(LAS unsigned char* lds) {
    unsigned char* ws = WSP;
    pg8::Gemm g{(const bf16_t*)OUTP, (const bf16_t*)(ws + WS_WIN), TALL, NPROJ, DM, DM}; pg8::StaticOrder S; S.init(TALL, NPROJ, (int)gridDim.x, (int)blockIdx.x);
    pg8::EpiRetIn E{(bf16_t*)(ws + WS_BIG), (const float*)(ws + WS_COS), (const float*)(ws + WS_SIN)};
    pg8::gemm_phase<pg8::EpiRetIn, pg8::StaticOrder, true, true>(lds, g, S, E);
}
__device__ __forceinline__ void ph_retention(LAS unsigned char* lds) {
    const int G = gridDim.x;
    for (int it = blockIdx.x; it < 256; it += G) { const int bh = (it & 7) * 4 + (it >> 6), es = (it >> 3) & 7, b = bh >> 3, h = bh & 7;
        ret::ret_item((LAS char*)lds, (const bf16_t*)BIGP + (size_t)b * SEQ * NPROJ, (bf16_t*)OUTP + (size_t)b * SEQ * 4096, 128, 64, h, es, nullptr, OUTP + OUT_SP + (size_t)(b * 8 + h) * 256 * 512); }
    for (int it = blockIdx.x; it < 512; it += G) { const int bh = (it & 7) * 8 + (it >> 6), es = (it >> 3) & 7, b = bh >> 3, h = bh & 7;
        ret::ret_item((LAS char*)lds, (const bf16_t*)BIGP + (size_t)(TP + b * 32) * NPROJ, (bf16_t*)OUTP + (size_t)(TP + b * 32) * 4096, 1, 32, h, es, INF(2) + (size_t)(b * 8 + h) * 256 * 512, OUTP + OUT_SS + (size_t)(b * 8 + h) * 256 * 512); }
}
__device__ __forceinline__ void ph_groupnorm() {
    PH_IDS; bf16_t* PROJ = (bf16_t*)BIGP; const bf16_t* OB = (const bf16_t*)OUTP;
    for (int it = gw; it < TALL * 8; it += NGW) { const int row = it >> 3, h = it & 7;
        bf16_t* op = PROJ + (size_t)row * NPROJ + 4096 + h * 512 + lane * 8; const u32x4 ov = *(const u32x4*)(OB + (size_t)row * 4096 + h * 512 + lane * 8), gv = *(const u32x4*)(op + 4096);
        float o[8], g[8]; const unsigned ow[4] = {ov.x, ov.y, ov.z, ov.w}, gwd[4] = {gv.x, gv.y, gv.z, gv.w};
#pragma unroll
        for (int j = 0; j < 4; ++j) { o[2 * j] = __uint_as_float(ow[j] << 16); o[2 * j + 1] = __uint_as_float(ow[j] & 0xffff0000u); g[2 * j] = __uint_as_float(gwd[j] << 16); g[2 * j + 1] = __uint_as_float(gwd[j] & 0xffff0000u); }
        float s = 0.f;
#pragma unroll
        for (int j = 0; j < 8; ++j) s += o[j];
        const float mu = wave_sum(s) * (1.f / 512.f); float q = 0.f;
#pragma unroll
        for (int j = 0; j < 8; ++j) { o[j] -= mu; q += o[j] * o[j]; }
        const float rstd = 1.0f / sqrtf(wave_sum(q) * (1.f / 512.f) + 1e-5f);
#pragma unroll
        for (int j = 0; j < 8; ++j) o[j] = o[j] * rstd * pg8::silu_f(g[j]);
        u32x4 w; w.x = pk2(o[0], o[1]); w.y = pk2(o[2], o[3]); w.z = pk2(o[4], o[5]); w.w = pk2(o[6], o[7]); *(u32x4*)op = w; }
}
template <bool FIRST, int MROWS = TALL> __device__ __forceinline__ void ph_res_gemm(LAS unsigned char* lds, unsigned char* a_ptr, size_t w_off, int K, int lda, bf16_t* hb, int ssq_idx) {
    unsigned char* ws = WSP; float* Hres = OUTP + OUT_Y;
    pg8::Gemm g{(const bf16_t*)a_ptr, (const bf16_t*)(ws + w_off), MROWS, DM, K, lda}; pg8::StaticOrder S; S.init(MROWS, DM, (int)gridDim.x, (int)blockIdx.x);
    pg8::EpiRes E{FIRST ? INF(0) : Hres, FIRST ? INF(1) : Hres + (size_t)TP * DM, Hres, hb, ssq_idx >= 0 ? (float*)(ws + WS_SSQ) + (size_t)ssq_idx * TALL : nullptr};
    pg8::gemm_phase<pg8::EpiRes, pg8::StaticOrder, true, true>(lds, g, S, E);
}
__device__ __forceinline__ void ph_sample_res(const unsigned char* a_ptr, int lda, size_t w_off, int K, bf16_t* hb, int ssq_idx) {
    const int tid = opaque_tid(), lane = tid & 63, wave = __builtin_amdgcn_readfirstlane(tid >> 6), fr = lane & 15, fq = lane >> 4;
    unsigned char* ws = WSP; float* Hs = OUTP + OUT_Y + (size_t)TP * DM;
    const bf16_t* A = (const bf16_t*)a_ptr; const bf16_t* Wt = (const bf16_t*)(ws + w_off);
    float* ssq = ssq_idx >= 0 ? (float*)(ws + WS_SSQ) + (size_t)ssq_idx * TALL + TP : nullptr;
    for (int it = blockIdx.x; it < 256; it += gridDim.x) {
        const int n0 = (it >> 1) * 16, row = (it & 1) * 128 + 16 * wave + fr;
        const bf16_t* bp = Wt + (size_t)(n0 + fr) * K + 8 * fq; const bf16_t* ap = A + (size_t)row * lda + 8 * fq;
        f32x4 acc = {0.f, 0.f, 0.f, 0.f};
        bf16x8 bA[8], aA[8], bB[8], aB[8];
#define SR_LOAD(B_, A_, kk) do { _Pragma("unroll") for (int s_ = 0; s_ < 8; ++s_) { B_[s_] = *(const bf16x8*)(bp + (kk) + 32 * s_); A_[s_] = *(const bf16x8*)(ap + (kk) + 32 * s_); } } while (0)
#define SR_MMA(B_, A_) do { _Pragma("unroll") for (int s_ = 0; s_ < 8; ++s_) acc = __builtin_amdgcn_mfma_f32_16x16x32_bf16(B_[s_], A_[s_], acc, 0, 0, 0); } while (0)
        SR_LOAD(bA, aA, 0);
        for (int k0 = 0; k0 < K; k0 += 512) {
            SR_LOAD(bB, aB, k0 + 256);
            SR_MMA(bA, aA);
            if (k0 + 512 < K) SR_LOAD(bA, aA, k0 + 512);
            SR_MMA(bB, aB);
        }
#undef SR_LOAD
#undef SR_MMA
        float* o = Hs + (size_t)row * DM + n0 + 4 * fq;
        const f32x4 v = *(const f32x4*)o + acc; *(f32x4*)o = v;
        if (hb) { u32x2 w; w.x = pk2(v[0], v[1]); w.y = pk2(v[2], v[3]); *(u32x2*)(hb + (size_t)(TP + row) * DM + n0 + 4 * fq) = w; }
        if (ssq) { float ss = (v[0] * v[0] + v[1] * v[1]) + (v[2] * v[2] + v[3] * v[3]); ss += __shfl_xor(ss, 16); ss += __shfl_xor(ss, 32);
            if (fq == 0) (void)__hip_atomic_fetch_add(ssq + row, ss, __ATOMIC_RELAXED, __HIP_MEMORY_SCOPE_AGENT); }
    }
}
template <int MODE> __device__ __forceinline__ void ph_rms(const float* g1, size_t o1_off, const float* g2, size_t o2_off) {
    PH_IDS; float* Hres = OUTP + OUT_Y; unsigned char* ws = WSP;
    for (int m = gw; m < TALL; m += NGW) rms_row<MODE>(Hres + (size_t)m * DM, g1, (bf16_t*)(ws + o1_off) + (size_t)m * DM, g2, (bf16_t*)(ws + o2_off) + (size_t)m * DM, Hres + (size_t)m * DM, lane);
}
__device__ __forceinline__ void ph_cache_cvt() {
    PH_IDS; const float* cache_k = INF(3); const float* cache_v = INF(4); bf16_t* KALL = (bf16_t*)(BIGP + BIG_KALL); bf16_t* VALL = (bf16_t*)(BIGP + BIG_VALL);
    for (size_t i = gt; i < (size_t)8 * PASTL * 512 / 4; i += NGT) { const size_t e = i * 4, b = e / ((size_t)PASTL * 512), r = e % ((size_t)PASTL * 512);
        const f32x4 kv = *(const f32x4*)(cache_k + e), vv = *(const f32x4*)(cache_v + e); u32x2 w; w.x = pk2(kv.x, kv.y); w.y = pk2(kv.z, kv.w); *(u32x2*)(KALL + b * LKS * 512 + r) = w;
        w.x = pk2(vv.x, vv.y); w.y = pk2(vv.z, vv.w); *(u32x2*)(VALL + b * LKS * 512 + r) = w; }
}
__device__ __forceinline__ void ph_kvfq(LAS unsigned char* lds) {
    unsigned char* ws = WSP; unsigned char* big = ws + WS_BIG; float* out = OUTP;
    pg8::Gemm g{(const bf16_t*)(big + BIG_XN), (const bf16_t*)(ws + WS_WKVF), TALL, 3328, DM, DM}; pg8::StaticOrder S; S.init(TALL, 3328, (int)gridDim.x, (int)blockIdx.x);
    pg8::EpiKVFQ E{out + OUT_KP, out + OUT_VP, out + OUT_LFP, out + OUT_KS, out + OUT_VS, out + OUT_LFS, (bf16_t*)(big + BIG_KB), (bf16_t*)(big + BIG_VB), (bf16_t*)(big + BIG_KALL), (bf16_t*)(big + BIG_VALL),
                    (bf16_t*)(big + BIG_ACT), INF(15), (const float*)(ws + WS_SSQ) + (size_t)1 * TALL};
    pg8::gemm_phase<pg8::EpiKVFQ, pg8::StaticOrder, true, true>(lds, g, S, E);
}
__device__ __forceinline__ void ph_cumsum(LAS unsigned char* lds) {
    PH_IDS; const float* cache_lf = INF(5); const float* out = OUTP; float* FB = (float*)(WSP + WS_FB); float* FS = (float*)(WSP + WS_FS);
    for (int it = blockIdx.x; it < 64 + 128; it += G) {
        LAS float* wtot = (LAS float*)lds;
        const bool smp = it >= 64; const int bh = smp ? it - 64 : it, b = bh >> 4, h = bh & 15, Ls = smp ? LKS : SEQ, per = smp ? 3 : 16, j0 = tid * per;
        float v[16]; float s = 0.f;
#pragma unroll
        for (int i = 0; i < 16; ++i) { const int j = j0 + i; float x = 0.f;
            if (i < per && j < Ls) x = smp ? (j < PASTL ? cache_lf[((size_t)b * PASTL + j) * 16 + h] : out[OUT_LFS + ((size_t)b * 32 + (j - PASTL)) * 16 + h]) : out[OUT_LFP + ((size_t)b * SEQ + j) * 16 + h];
            s += x; v[i] = s; }
        float inc = s;
#pragma unroll
        for (int o = 1; o < 64; o <<= 1) { const float t = __shfl_up(inc, o); if (lane >= o) inc += t; }
        if (lane == 63) wtot[wave] = inc;
        __syncthreads();
        float base = inc - s;
        for (int w = 0; w < wave; ++w) base += wtot[w];
#pragma unroll
        for (int i = 0; i < 16; ++i) { const int j = j0 + i; if (i < per && j < Ls) { const float F = base + v[i];
            if (smp) FS[(size_t)bh * LKS + j] = F; else FB[(size_t)bh * SEQ + j] = -F * 11.313708498984761f; } }
        __syncthreads();
    }
}
__device__ __forceinline__ void ph_attn(unsigned char* lds_raw) {
    unsigned char* ws = WSP; unsigned char* big = ws + WS_BIG;
    fox::attn_phase((char*)lds_raw, (const bf16_t*)(big + BIG_ACT), (const bf16_t*)(big + BIG_KB), (const bf16_t*)(big + BIG_VB), (bf16_t*)(big + BIG_XN), (const float*)(ws + WS_FB));
}
__device__ __forceinline__ void ph_sattn(LAS unsigned char* lds) {
    unsigned char* ws = WSP; unsigned char* big = ws + WS_BIG;
    sample_attn((LAS char*)lds, (const bf16_t*)(big + BIG_ACT), (const bf16_t*)(big + BIG_KALL), (const bf16_t*)(big + BIG_VALL), (const float*)(ws + WS_FS), (bf16_t*)(big + BIG_XN));
}
__device__ __forceinline__ void ph_gateup(LAS unsigned char* lds, const unsigned char* a_ptr, size_t w_off, int ssq_idx) {
    unsigned char* ws = WSP; unsigned char* big = ws + WS_BIG;
    pg8::Gemm g{(const bf16_t*)a_ptr, (const bf16_t*)(ws + w_off), TALL, 2 * DFF, DM, DM}; pg8::StaticOrder S; S.init(TALL, 2 * DFF, (int)gridDim.x, (int)blockIdx.x);
    pg8::EpiSwiglu E{(bf16_t*)(big + BIG_ACT), (const float*)(ws + WS_SSQ) + (size_t)ssq_idx * TALL};
    pg8::gemm_phase<pg8::EpiSwiglu, pg8::StaticOrder, true, true>(lds, g, S, E);
}

__global__ void __launch_bounds__(NWAVES * 64, 2) yoco_fwd(Params P) {
    extern __shared__ __attribute__((aligned(16))) unsigned char lds_raw[];
    cg::grid_group grid = cg::this_grid();
    LAS unsigned char* lds = (LAS unsigned char*)lds_raw;
    volatile LAS unsigned* bst = (volatile LAS unsigned*)(lds + 148480);
    if (opaque_tid() < 2) bst[opaque_tid()] = 0u;
    __syncthreads();
    const XcdBarrier xbar = xcd_barrier_post((unsigned*)(WSP + WS_BAR), bst);
#define GSYNC() xcd_barrier(xbar)
    ph_prologue(lds);                                                                                   grid.sync();
    ph_retin(lds);                                                                                      GSYNC();
    ph_retention(lds);                                                                                  GSYNC();
    ph_groupnorm();                                                                                     GSYNC();
    ph_res_gemm<true>(lds, BIGP + 4096 * 2, WS_WRO, 4096, NPROJ, (bf16_t*)(OUTP + OUT_KP), 0); ph_conv<1>(lds);   GSYNC();
    ph_gateup(lds, (const unsigned char*)(OUTP + OUT_KP), WS_WGU0, 0);                                  GSYNC();
    ph_res_gemm<false>(lds, BIGP + BIG_ACT, WS_WDN0, DFF, DFF, (bf16_t*)(BIGP + BIG_XN), 1); ph_cache_cvt(); ph_conv<2>(lds);   GSYNC();
    ph_kvfq(lds);                                                                                       GSYNC();
    ph_cumsum(lds);                                                                                     GSYNC();
    ph_attn(lds_raw); __syncthreads(); ph_sattn(lds);                                                   GSYNC();
    ph_res_gemm<false, TP>(lds, BIGP + BIG_XN, WS_WO, DM, DM, (bf16_t*)(BIGP + BIG_HKV), 2); ph_sample_res(BIGP + BIG_XN + (size_t)TP * DM * 2, DM, WS_WO, DM, (bf16_t*)(BIGP + BIG_HKV), 2);   GSYNC();
    ph_gateup(lds, BIGP + BIG_HKV, WS_WGU1, 2);                                                         GSYNC();
    ph_res_gemm<false, TP>(lds, BIGP + BIG_ACT, WS_WDN1, DFF, DFF, nullptr, -1); ph_sample_res(BIGP + BIG_ACT + (size_t)TP * DFF * 2, DFF, WS_WDN1, DFF, nullptr, -1);   GSYNC();
    ph_rms<2>(INF(9), 0, nullptr, 0);
}

extern "C" void kernel_launch(void* const* d_in, const int* in_sizes, int n_in, void* d_out, int out_size, void* d_ws, size_t ws_size, hipStream_t stream) {
    static int grid = 0;
    if (grid == 0) {
        if (n_in != 21 || ws_size < WS_END) { fprintf(stderr, "kernel_launch: unexpected n_in %d / ws_size %zu (need %zu)\n", n_in, ws_size, (size_t)WS_END); grid = -1; return; }
        int dev = 0, cus = 0, per_cu = 0;
        (void)hipGetDevice(&dev); (void)hipDeviceGetAttribute(&cus, hipDeviceAttributeMultiprocessorCount, dev);
        if (hipFuncSetAttribute((const void*)yoco_fwd, hipFuncAttributeMaxDynamicSharedMemorySize, LDS_BYTES) != hipSuccess) { fprintf(stderr, "kernel_launch: hipFuncSetAttribute failed\n"); grid = -1; return; }
        if (hipOccupancyMaxActiveBlocksPerMultiprocessor(&per_cu, (const void*)yoco_fwd, NWAVES * 64, LDS_BYTES) != hipSuccess || per_cu < 1) { fprintf(stderr, "kernel_launch: occupancy query says %d\n", per_cu); per_cu = 1; }
        (void)hipGetLastError();
        grid = cus > 0 ? cus : 256;
    }
    if (grid < 0) return;
    if (hipMemsetAsync((char*)d_ws + WS_BAR, 0, XCD_BAR_WORDS * 4, stream) != hipSuccess) { fprintf(stderr, "kernel_launch: memset of the barrier words failed\n"); return; }
    Params p{};
    for (int i = 0; i < 21; ++i) p.in[i] = (const float*)d_in[i];
    p.out = (float*)d_out; p.ws = (unsigned char*)d_ws;
    void* args[] = {&p};
    hipError_t e = hipLaunchCooperativeKernel((const void*)yoco_fwd, dim3(grid), dim3(NWAVES * 64), args, LDS_BYTES, stream);
    if (e != hipSuccess) fprintf(stderr, "cooperative launch failed: %s (grid %d)\n", hipGetErrorString(e), grid);
}
```

```cpp
#include <hip/hip_runtime.h>
#include <hip/hip_cooperative_groups.h>
#include <cstdio>
#include <cstdint>
namespace cg = cooperative_groups;
__device__ __forceinline__ int opaque_tid() { int t = threadIdx.x; asm volatile("" : "+v"(t)); return t; }
namespace pg8 {
#define PG8_LAS __attribute__((address_space(3)))
typedef unsigned short bf16_t;
typedef short bf16x8 __attribute__((ext_vector_type(8)));
typedef float f32x4 __attribute__((ext_vector_type(4)));
typedef unsigned u32x4 __attribute__((ext_vector_type(4)));
constexpr int BM = 256, BK = 64, HALF = 128, HTB = HALF * BK * 2  , STAGE_BYTES = 8 * HTB, NXCD = 8, WGM = 4;

__host__ __device__ __forceinline__ int lds_byte(int r, int c) { const int st = (r >> 4) * 2 + (c >> 5), rr = r & 15, cc = c & 31, ob = rr * 64 + cc * 2; return st * 1024 + (ob ^ (((ob >> 9) & 1) << 5)); }
__host__ __device__ __forceinline__ void stage_rc(int b, int& R, int& C) { const int st = b / 1024, sb = b % 1024, swz = sb ^ (((sb >> 9) & 1) << 5); R = (st >> 1) * 16 + swz / 64; C = (st & 1) * 32 + (swz % 64) / 2; }
__host__ __device__ __forceinline__ int perm32(int rho) { const int n = rho >> 4, i = rho & 15; return 8 * (i >> 2) + 4 * n + (i & 3); }

struct Unit { int pm, pn; };
struct Gemm { const bf16_t* A; const bf16_t* Bt; int M, N, K, lda; };

struct StaticOrder {
    int nM, nN, nwg, G, c;
    __host__ __device__ void init(int M, int N, int G_, int c_) { nM = M / BM; nN = N / BM; nwg = nM * nN; G = G_; c = c_; }
    __host__ __device__ bool next(int i, Unit& u) const {
        const long L = (long)i * G + c; if (L >= nwg) return false;
        int wgid = (int)L; { const int q = nwg / NXCD, r = nwg % NXCD, xcd = wgid % NXCD, off = wgid / NXCD; wgid = (xcd < r ? xcd * (q + 1) : r * (q + 1) + (xcd - r) * q) + off; }
        const int nig = WGM * nN, gid = wgid / nig, fm = gid * WGM, gsz = (nM - fm) < WGM ? (nM - fm) : WGM;
        u.pm = fm + ((wgid % nig) % gsz); u.pn = (wgid % nig) / gsz; return true;
    }
    __device__ __forceinline__ void a_ready(const Unit&) const {}
    __device__ __forceinline__ void done(const Unit&) const {}
};

__device__ __forceinline__ unsigned cvt_pk_bf16(float lo, float hi) { unsigned r; asm volatile("v_cvt_pk_bf16_f32 %0, %1, %2" : "=v"(r) : "v"(lo), "v"(hi)); return r; }
template <class Epi, class Sched, bool ALIGN_EPI = false, bool SP2 = false>
__device__ __forceinline__ void gemm_phase(PG8_LAS unsigned char* lds, const Gemm g, const Sched& S, const Epi& E) {
    const int tid = opaque_tid(), wid = __builtin_amdgcn_readfirstlane(tid >> 6), lane = tid & 63, wr = wid >> 2, wc = wid & 3, fr = lane & 15, fq = lane >> 4;
    const int K = g.K, nt = K / BK;
    unsigned voffA[2], voffB[2];
#pragma unroll
    for (int i = 0; i < 2; ++i) { int R, C; stage_rc(tid * 16 + i * 8192, R, C); const int Rb = Epi::PERM ? ((R & ~31) + perm32(R & 31)) : R;
        voffA[i] = (unsigned)(R * g.lda + C) * 2u; voffB[i] = (unsigned)(Rb * K + C) * 2u; }
    const size_t kstep = (size_t)(BK * 2);
    const size_t hstep = (size_t)HALF * K * 2, hstepA = (size_t)HALF * g.lda * 2;
    const size_t tstep = 2 * hstep, tstepA = 2 * hstepA;
    const unsigned ldsw = (unsigned)wid * 1024u;
    const int aoff = lds_byte(wr * 64 + fr, fq * 8), boff = lds_byte(wc * 32 + fr, fq * 8);
#define PG8_SA(b, h) (((b) * 2 + (h)) * HTB)
#define PG8_SB(b, h) ((4 + (b) * 2 + (h)) * HTB)
#define PG8_STAGE(bufoff, gbase, voff) do { _Pragma("unroll") for (int _i = 0; _i < 2; ++_i) \
        __builtin_amdgcn_global_load_lds((const unsigned*)((const char*)(gbase) + (voff)[_i]), (PG8_LAS unsigned*)(lds + (bufoff) + ldsw + _i * 8192), 16, 0, 0); } while (0)
#define PG8_LDA(dst, b, h) do { _Pragma("unroll") for (int m = 0; m < 4; ++m) _Pragma("unroll") for (int k = 0; k < 2; ++k) dst[m][k] = *(const PG8_LAS bf16x8*)(lds + PG8_SA(b, h) + aoff + m * 2048 + k * 1024); } while (0)
#define PG8_LDB(dst, b, h) do { _Pragma("unroll") for (int n = 0; n < 2; ++n) _Pragma("unroll") for (int k = 0; k < 2; ++k) dst[n][k] = *(const PG8_LAS bf16x8*)(lds + PG8_SB(b, h) + boff + n * 2048 + k * 1024); } while (0)
#define PG8_MMA(ai, bj, At, Bt) do { __builtin_amdgcn_s_setprio(1); _Pragma("unroll") for (int m = 0; m < 4; ++m) _Pragma("unroll") for (int n = 0; n < 2; ++n) _Pragma("unroll") for (int k = 0; k < 2; ++k) \
        acc[ai][bj][m][n] = __builtin_amdgcn_mfma_f32_16x16x32_bf16(Bt[n][k], At[m][k], acc[ai][bj][m][n], 0, 0, 0); __builtin_amdgcn_s_setprio(0); } while (0)
#define PG8_WAIT_V(n) asm volatile("s_waitcnt vmcnt(" #n ")" ::: "memory")
#define PG8_WAIT_L(n) asm volatile("s_waitcnt lgkmcnt(" #n ")" ::: "memory")
#define PG8_BAR __builtin_amdgcn_s_barrier()
#define PG8_SCHED __builtin_amdgcn_sched_barrier(0)
    Unit cur, nxt; int ui = 0;
    if (!S.next(0, cur)) return;
    f32x4 acc[2][2][4][2];
#pragma unroll
    for (int a = 0; a < 2; ++a)
#pragma unroll
        for (int b = 0; b < 2; ++b)
#pragma unroll
            for (int m = 0; m < 4; ++m)
#pragma unroll
                for (int n = 0; n < 2; ++n) acc[a][b][m][n] = (f32x4){0.f, 0.f, 0.f, 0.f};
    bf16x8 At[4][2], B0[2][2], B1[2][2];
    const char* cA = (const char*)g.A + (size_t)cur.pm * tstepA; const char* cB = (const char*)g.Bt + (size_t)cur.pn * tstep;
    S.a_ready(cur);
    if constexpr (SP2) {
        PG8_STAGE(PG8_SB(0, 0), cB, voffB); PG8_STAGE(PG8_SB(0, 1), cB + hstep, voffB); PG8_STAGE(PG8_SA(0, 0), cA, voffA); PG8_STAGE(PG8_SA(0, 1), cA + hstepA, voffA);
        if (wr == 1) PG8_BAR;
        PG8_WAIT_V(2); PG8_BAR;
        PG8_STAGE(PG8_SB(1, 0), cB + kstep, voffB); PG8_STAGE(PG8_SA(1, 0), cA + kstep, voffA); PG8_STAGE(PG8_SB(1, 1), cB + hstep + kstep, voffB);
        PG8_WAIT_V(6); PG8_BAR;
    } else {
        PG8_STAGE(PG8_SB(0, 0), cB, voffB); PG8_STAGE(PG8_SA(0, 0), cA, voffA); PG8_STAGE(PG8_SB(0, 1), cB + hstep, voffB); PG8_STAGE(PG8_SA(0, 1), cA + hstepA, voffA);
        if (wr == 1) PG8_BAR;
        PG8_WAIT_V(4); PG8_BAR;
        PG8_STAGE(PG8_SB(1, 0), cB + kstep, voffB); PG8_STAGE(PG8_SA(1, 0), cA + kstep, voffA); PG8_STAGE(PG8_SB(1, 1), cB + hstep + kstep, voffB);
        PG8_WAIT_V(6); PG8_BAR;
    }
    for (;;) {
        const bool has_next = S.next(ui + 1, nxt);
        const char* nA = has_next ? (const char*)g.A + (size_t)nxt.pm * tstepA : cA; const char* nB = has_next ? (const char*)g.Bt + (size_t)nxt.pn * tstep : cB;
        for (int t = 0; t < nt; t += 2) {
            const bool last = (t == nt - 2);
            const char* a1 = cA + (size_t)(t + 1) * kstep;
            const char* a2 = last ? nA : cA + (size_t)(t + 2) * kstep; const char* b2 = last ? nB : cB + (size_t)(t + 2) * kstep;
            const char* a3 = a2 + kstep; const char* b3 = b2 + kstep;
            if (last && has_next) S.a_ready(nxt);
            if constexpr (SP2) {
            PG8_LDB(B0, 0, 0); PG8_LDB(B1, 0, 1); PG8_SCHED; PG8_LDA(At, 0, 0); PG8_STAGE(PG8_SA(1, 1), a1 + hstepA, voffA);
            PG8_WAIT_V(8); PG8_WAIT_L(0); PG8_BAR; PG8_MMA(0, 0, At, B0); PG8_MMA(0, 1, At, B1); PG8_BAR; PG8_SCHED;
            PG8_LDA(At, 0, 1); PG8_STAGE(PG8_SB(0, 0), b2, voffB); PG8_STAGE(PG8_SB(0, 1), b2 + hstep, voffB); PG8_STAGE(PG8_SA(0, 0), a2, voffA);
            PG8_WAIT_V(8); PG8_WAIT_L(0); PG8_BAR; PG8_MMA(1, 0, At, B0); PG8_MMA(1, 1, At, B1); PG8_BAR; PG8_SCHED;
            PG8_LDB(B0, 1, 0); PG8_LDB(B1, 1, 1); PG8_SCHED; PG8_LDA(At, 1, 0); PG8_STAGE(PG8_SA(0, 1), a2 + hstepA, voffA);
            PG8_WAIT_V(8); PG8_WAIT_L(0); PG8_BAR; PG8_MMA(0, 0, At, B0); PG8_MMA(0, 1, At, B1); PG8_BAR; PG8_SCHED;
            PG8_LDA(At, 1, 1); PG8_STAGE(PG8_SB(1, 0), b3, voffB); PG8_STAGE(PG8_SB(1, 1), b3 + hstep, voffB); PG8_STAGE(PG8_SA(1, 0), a3, voffA);
            PG8_WAIT_V(8); PG8_WAIT_L(0); PG8_BAR; PG8_MMA(1, 0, At, B0); PG8_MMA(1, 1, At, B1); PG8_BAR; PG8_SCHED;
            } else {
            PG8_LDB(B0, 0, 0); PG8_SCHED; PG8_LDA(At, 0, 0); PG8_STAGE(PG8_SA(1, 1), a1 + hstepA, voffA);
            PG8_WAIT_L(8); PG8_BAR; PG8_WAIT_L(0); PG8_MMA(0, 0, At, B0); PG8_BAR; PG8_SCHED;
            PG8_LDB(B1, 0, 1); PG8_STAGE(PG8_SB(0, 0), b2, voffB);
            PG8_BAR; PG8_WAIT_L(0); PG8_MMA(0, 1, At, B1); PG8_BAR;
            PG8_LDA(At, 0, 1); PG8_STAGE(PG8_SA(0, 0), a2, voffA);
            PG8_BAR; PG8_WAIT_L(0); PG8_MMA(1, 0, At, B0); PG8_BAR; PG8_SCHED;
            PG8_STAGE(PG8_SB(0, 1), b2 + hstep, voffB);
            PG8_WAIT_V(6); PG8_BAR; PG8_MMA(1, 1, At, B1); PG8_BAR;
            PG8_LDB(B0, 1, 0); PG8_SCHED; PG8_LDA(At, 1, 0); PG8_STAGE(PG8_SA(0, 1), a2 + hstepA, voffA);
            PG8_WAIT_L(8); PG8_BAR; PG8_WAIT_L(0); PG8_MMA(0, 0, At, B0); PG8_BAR; PG8_SCHED;
            PG8_LDB(B1, 1, 1); PG8_STAGE(PG8_SB(1, 0), b3, voffB);
            PG8_BAR; PG8_WAIT_L(0); PG8_MMA(0, 1, At, B1); PG8_BAR;
            PG8_LDA(At, 1, 1); PG8_STAGE(PG8_SA(1, 0), a3, voffA);
            PG8_BAR; PG8_WAIT_L(0); PG8_MMA(1, 0, At, B0); PG8_BAR; PG8_SCHED;
            PG8_STAGE(PG8_SB(1, 1), b3 + hstep, voffB);
            PG8_WAIT_V(6); PG8_BAR; PG8_MMA(1, 1, At, B1); PG8_BAR;
            }
        }
        if constexpr (ALIGN_EPI) { if (wr == 0) PG8_BAR; }
        if constexpr (!Epi::AFTER_DRAIN) { E(acc, cur, wr, wc, fr, fq); S.done(cur); }
        if (!has_next) break;
#pragma unroll
        for (int a = 0; a < 2; ++a)
#pragma unroll
            for (int b = 0; b < 2; ++b)
#pragma unroll
                for (int m = 0; m < 4; ++m)
#pragma unroll
                    for (int n = 0; n < 2; ++n) acc[a][b][m][n] = (f32x4){0.f, 0.f, 0.f, 0.f};
        cur = nxt; cA = nA; cB = nB; ++ui;
        if constexpr (ALIGN_EPI) { if (wr == 1) PG8_BAR; }
    }
    PG8_WAIT_V(0);
    if constexpr (!ALIGN_EPI) { if (wr == 0) PG8_BAR; }
    PG8_BAR;
    if constexpr (Epi::AFTER_DRAIN) { E.fused(acc, cur, wr, wc, fr, fq, lds, wid, lane); S.done(cur); }
#undef PG8_SA
#undef PG8_SB
#undef PG8_STAGE
#undef PG8_LDA
#undef PG8_LDB
#undef PG8_MMA
#undef PG8_WAIT_V
#undef PG8_WAIT_L
#undef PG8_BAR
#undef PG8_SCHED
}
}
constexpr int DM = 2048, TP = 32768, TSMP = 256, TALL = 33024, SEQ = 8192, NPROJ = 12288, DFF = 5632, PASTL = 1024, LKS = 1056;
#define GAS __attribute__((address_space(1)))
#define LAS __attribute__((address_space(3)))
typedef unsigned short bf16_t;
typedef float f32x4 __attribute__((ext_vector_type(4)));
typedef unsigned u32x4 __attribute__((ext_vector_type(4)));
typedef unsigned u32x2 __attribute__((ext_vector_type(2)));
typedef short bf16x8 __attribute__((ext_vector_type(8)));
typedef short s16x4 __attribute__((ext_vector_type(4)));

namespace pg8 {
__device__ __forceinline__ float silu_f(float g) { return g * __builtin_amdgcn_rcpf(1.0f + __builtin_amdgcn_exp2f(-1.4426950408889634f * g)); }
struct EpiBf16P {
    static constexpr bool PERM = true, AFTER_DRAIN = false;
    bf16_t* O; int ldc;
    __device__ __forceinline__ void operator()(const f32x4 (&acc)[2][2][4][2], const Unit& u, int wr, int wc, int fr, int fq) const {
        const int row0 = u.pm * BM + wr * 64 + fr, col0 = u.pn * BM + wc * 32 + 8 * fq;
#pragma unroll
        for (int ai = 0; ai < 2; ++ai)
#pragma unroll
            for (int m = 0; m < 4; ++m) { bf16_t* rowp = O + (size_t)(row0 + ai * HALF + m * 16) * ldc + col0;
#pragma unroll
                for (int bj = 0; bj < 2; ++bj) { const f32x4 v0 = acc[ai][bj][m][0], v1 = acc[ai][bj][m][1];
                    u32x4 w; w.x = cvt_pk_bf16(v0[0], v0[1]); w.y = cvt_pk_bf16(v0[2], v0[3]); w.z = cvt_pk_bf16(v1[0], v1[1]); w.w = cvt_pk_bf16(v1[2], v1[3]);
                    *(u32x4*)(rowp + bj * HALF) = w; } }
    }
};
struct EpiRetIn {
    static constexpr bool PERM = true, AFTER_DRAIN = false;
    bf16_t* O; const float* cosT; const float* sinT;
    __device__ __forceinline__ void operator()(const f32x4 (&acc)[2][2][4][2], const Unit& u, int wr, int wc, int fr, int fq) const {
        const int row0 = u.pm * BM + wr * 64 + fr, cl = wc * 32 + 8 * fq;
        bf16_t* obase = O + (size_t)u.pn * BM + cl;
        if (u.pn < 16) {
            const bool isk = u.pn >= 8; const int h = u.pn & 7;
            const float lg2 = __log2f(1.0f - exp2f(-5.0f - (float)h));
#pragma unroll
            for (int ai = 0; ai < 2; ++ai) {
                f32x4 cs[4][4]; float scv[4];
#pragma unroll
                for (int m = 0; m < 4; ++m) {
                    const int row = row0 + ai * HALF + m * 16; int pos, l;
                    if (row < TP) { pos = row & (SEQ - 1); l = row & 63; } else { const int s = (row - TP) & 31; pos = PASTL + s; l = s; }
                    scv[m] = isk ? exp2f(-lg2 * (float)l) * 0.0625f : exp2f(lg2 * (float)l);
                    const float* cp = cosT + (size_t)pos * 128 + cl; const float* sp = sinT + (size_t)pos * 128 + cl;
                    cs[m][0] = *(const f32x4*)cp; cs[m][1] = *(const f32x4*)(cp + 4); cs[m][2] = *(const f32x4*)sp; cs[m][3] = *(const f32x4*)(sp + 4); }
#pragma unroll
                for (int m = 0; m < 4; ++m) {
                    const int row = row0 + ai * HALF + m * 16; const float sc = scv[m];
                    const f32x4 c0 = cs[m][0], c1 = cs[m][1], s0 = cs[m][2], s1 = cs[m][3];
                    const f32x4 x1a = acc[ai][0][m][0], x1b = acc[ai][0][m][1], x2a = acc[ai][1][m][0], x2b = acc[ai][1][m][1];
                    const f32x4 o1a = (x1a * c0 - x2a * s0) * sc, o1b = (x1b * c1 - x2b * s1) * sc, o2a = (x1a * s0 + x2a * c0) * sc, o2b = (x1b * s1 + x2b * c1) * sc;
                    bf16_t* rowp = obase + (size_t)row * NPROJ;
                    u32x4 w; w.x = cvt_pk_bf16(o1a[0], o1a[1]); w.y = cvt_pk_bf16(o1a[2], o1a[3]); w.z = cvt_pk_bf16(o1b[0], o1b[1]); w.w = cvt_pk_bf16(o1b[2], o1b[3]);
                    *(u32x4*)rowp = w;
                    w.x = cvt_pk_bf16(o2a[0], o2a[1]); w.y = cvt_pk_bf16(o2a[2], o2a[3]); w.z = cvt_pk_bf16(o2b[0], o2b[1]); w.w = cvt_pk_bf16(o2b[2], o2b[3]);
                    *(u32x4*)(rowp + HALF) = w; }
                asm volatile("" ::: "memory"); }
        } else {
#pragma unroll
            for (int ai = 0; ai < 2; ++ai)
#pragma unroll
                for (int m = 0; m < 4; ++m) { bf16_t* rowp = obase + (size_t)(row0 + ai * HALF + m * 16) * NPROJ;
#pragma unroll
                    for (int bj = 0; bj < 2; ++bj) { const f32x4 v0 = acc[ai][bj][m][0], v1 = acc[ai][bj][m][1];
                        u32x4 w; w.x = cvt_pk_bf16(v0[0], v0[1]); w.y = cvt_pk_bf16(v0[2], v0[3]); w.z = cvt_pk_bf16(v1[0], v1[1]); w.w = cvt_pk_bf16(v1[2], v1[3]);
                        *(u32x4*)(rowp + bj * HALF) = w; } }
        }
    }
};
struct EpiRes {
    static constexpr bool PERM = false, AFTER_DRAIN = false;
    const float* baseP; const float* baseS; float* out; bf16_t* hb; float* ssq;
    __device__ __forceinline__ void operator()(const f32x4 (&acc)[2][2][4][2], const Unit& u, int wr, int wc, int fr, int fq) const {
        const int row0 = u.pm * BM + wr * 64 + fr, col0 = u.pn * BM + wc * 32 + 4 * fq;
#pragma unroll
        for (int ai = 0; ai < 2; ++ai) {
            f32x4 bv[4][2][2];
#pragma unroll
            for (int m = 0; m < 4; ++m) { const int row = row0 + ai * HALF + m * 16;
                const float* b = (row < TP ? baseP + (size_t)row * DM : baseS + (size_t)(row - TP) * DM) + col0;
#pragma unroll
                for (int bj = 0; bj < 2; ++bj)
#pragma unroll
                    for (int n = 0; n < 2; ++n) bv[m][bj][n] = *(const f32x4*)(b + bj * HALF + n * 16); }
#pragma unroll
            for (int m = 0; m < 4; ++m) { const int row = row0 + ai * HALF + m * 16; float* o = out + (size_t)row * DM + col0; float ss = 0.f;
#pragma unroll
                for (int bj = 0; bj < 2; ++bj)
#pragma unroll
                    for (int n = 0; n < 2; ++n) { const f32x4 v = bv[m][bj][n] + acc[ai][bj][m][n]; *(f32x4*)(o + bj * HALF + n * 16) = v;
                        if (hb) { u32x2 w; w.x = cvt_pk_bf16(v[0], v[1]); w.y = cvt_pk_bf16(v[2], v[3]); *(u32x2*)(hb + (size_t)row * DM + col0 + bj * HALF + n * 16) = w; }
                        ss += (v[0] * v[0] + v[1] * v[1]) + (v[2] * v[2] + v[3] * v[3]); }
                if (ssq) { ss += __shfl_xor(ss, 16); ss += __shfl_xor(ss, 32);
                    if (fq == 0) (void)__hip_atomic_fetch_add(ssq + row, ss, __ATOMIC_RELAXED, __HIP_MEMORY_SCOPE_AGENT); } }
            asm volatile("" ::: "memory"); }
    }
};
struct EpiSwiglu {
    static constexpr bool PERM = true, AFTER_DRAIN = false;
    bf16_t* O; const float* ssq;
    __device__ __forceinline__ void operator()(const f32x4 (&acc)[2][2][4][2], const Unit& u, int wr, int wc, int fr, int fq) const {
        const int row0 = u.pm * BM + wr * 64 + fr, col0 = u.pn * HALF + wc * 32 + 8 * fq;
        float rs[2][4];
#pragma unroll
        for (int ai = 0; ai < 2; ++ai)
#pragma unroll
            for (int m = 0; m < 4; ++m) rs[ai][m] = ssq[row0 + ai * HALF + m * 16];
#pragma unroll
        for (int ai = 0; ai < 2; ++ai)
#pragma unroll
            for (int m = 0; m < 4; ++m) { bf16_t* rowp = O + (size_t)(row0 + ai * HALF + m * 16) * DFF + col0; const float r = 1.0f / sqrtf(rs[ai][m] * (1.f / DM) + 1e-6f);
                const f32x4 g0 = acc[ai][0][m][0] * r, g1 = acc[ai][0][m][1] * r, u0 = acc[ai][1][m][0] * r, u1 = acc[ai][1][m][1] * r;
                f32x4 a0, a1;
#pragma unroll
                for (int j = 0; j < 4; ++j) { a0[j] = silu_f(g0[j]) * u0[j]; a1[j] = silu_f(g1[j]) * u1[j]; }
                u32x4 w; w.x = cvt_pk_bf16(a0[0], a0[1]); w.y = cvt_pk_bf16(a0[2], a0[3]); w.z = cvt_pk_bf16(a1[0], a1[1]); w.w = cvt_pk_bf16(a1[2], a1[3]);
                *(u32x4*)rowp = w; }
    }
};
struct EpiKVFQ {
    static constexpr bool PERM = false, AFTER_DRAIN = false;
    float* kP; float* vP; float* lfP; float* kS; float* vS; float* lfS; bf16_t* KB; bf16_t* VB; bf16_t* KALL; bf16_t* VALL; bf16_t* QB; const float* bf; const float* ssq;
    __device__ __forceinline__ void operator()(const f32x4 (&acc)[2][2][4][2], const Unit& u, int wr, int wc, int fr, int fq) const {
        const int row0 = u.pm * BM + wr * 64 + fr;
        float rs[2][4];
#pragma unroll
        for (int ai = 0; ai < 2; ++ai)
#pragma unroll
            for (int m = 0; m < 4; ++m) rs[ai][m] = 1.0f / sqrtf(ssq[row0 + ai * HALF + m * 16] * (1.f / DM) + 1e-6f);
        if (u.pn >= 5) {
            const int col0 = (u.pn - 5) * BM + wc * 32 + 4 * fq;
#pragma unroll
            for (int ai = 0; ai < 2; ++ai)
#pragma unroll
                for (int m = 0; m < 4; ++m) { bf16_t* bo = QB + (size_t)(row0 + ai * HALF + m * 16) * DM + col0;
#pragma unroll
                    for (int bj = 0; bj < 2; ++bj)
#pragma unroll
                        for (int n = 0; n < 2; ++n) { const f32x4 v = acc[ai][bj][m][n] * rs[ai][m]; u32x2 w; w.x = cvt_pk_bf16(v[0], v[1]); w.y = cvt_pk_bf16(v[2], v[3]); *(u32x2*)(bo + bj * HALF + n * 16) = w; } }
        } else if (u.pn < 4) {
            const bool isv = u.pn >= 2; const int col0 = (u.pn & 1) * BM + wc * 32 + 4 * fq;
            float* fP = isv ? vP : kP; float* fS = isv ? vS : kS; bf16_t* bP = isv ? VB : KB; bf16_t* bA = isv ? VALL : KALL;
#pragma unroll
            for (int ai = 0; ai < 2; ++ai)
#pragma unroll
                for (int m = 0; m < 4; ++m) { const int row = row0 + ai * HALF + m * 16; float* fo; bf16_t* bo;
                    if (row < TP) { fo = fP + (size_t)row * 512 + col0; bo = bP + (size_t)row * 512 + col0; }
                    else { const int r2 = row - TP; fo = fS + (size_t)r2 * 512 + col0; bo = bA + ((size_t)(r2 >> 5) * LKS + PASTL + (r2 & 31)) * 512 + col0; }
#pragma unroll
                    for (int bj = 0; bj < 2; ++bj)
#pragma unroll
                        for (int n = 0; n < 2; ++n) { const f32x4 v = acc[ai][bj][m][n] * rs[ai][m]; *(f32x4*)(fo + bj * HALF + n * 16) = v;
                            u32x2 w; w.x = cvt_pk_bf16(v[0], v[1]); w.y = cvt_pk_bf16(v[2], v[3]); *(u32x2*)(bo + bj * HALF + n * 16) = w; } }
        } else if (wc == 0) {
            const f32x4 bb = *(const f32x4*)(bf + 4 * fq);
#pragma unroll
            for (int ai = 0; ai < 2; ++ai)
#pragma unroll
                for (int m = 0; m < 4; ++m) { const int row = row0 + ai * HALF + m * 16; const f32x4 z = acc[ai][0][m][0] * rs[ai][m] + bb; f32x4 r;
#pragma unroll
                    for (int j = 0; j < 4; ++j) r[j] = fminf(z[j], 0.f) - log1pf(__expf(-fabsf(z[j])));
                    float* o = row < TP ? lfP + (size_t)row * 16 : lfS + (size_t)(row - TP) * 16; *(f32x4*)(o + 4 * fq) = r; }
        }
    }
};
}
namespace fox {
enum { ORDER_NATURAL = 0, ORDER_REVERSED = 1, ORDER_PAIRED = 2, ORDER_XCD = 4 };
constexpr int D = 128, QS = 2048, KS = 512, OS = 2048;
constexpr float THR = 8.f;
constexpr bool WSKIP = false;
constexpr float SCALE = 0.08838834764831845f;
constexpr int NW = 8, QBLK = 32, KVBLK = 64, QB = NW * QBLK;
constexpr int SHM_V = KVBLK * D * 2, SHM_K = KVBLK * D * 2;
constexpr int LDS_BYTES = 2 * SHM_V + 2 * SHM_K + NW * 64 * 4 + 2 * 64 * 4;
typedef unsigned short bf16;
typedef short bf16x8 __attribute__((ext_vector_type(8)));
typedef short s16x4 __attribute__((ext_vector_type(4)));
typedef float f32x16 __attribute__((ext_vector_type(16)));
typedef float f32x4 __attribute__((ext_vector_type(4)));
typedef unsigned u32x4 __attribute__((ext_vector_type(4)));
template <class A, class Bt> struct same_t { static constexpr bool v = false; };
template <class A> struct same_t<A, A> { static constexpr bool v = true; };

#define KSWZ(row, colB) ((row) * 256 + ((colB) ^ (((row) & 7) << 4)))
#define SBAR() __builtin_amdgcn_sched_barrier(0)
__device__ __forceinline__ int v_st(int k, int c) { const int kk = (k & ~0xC) | ((k & 4) << 1) | ((k & 8) >> 1); return ((kk >> 3) * 4 + (c >> 5)) * 512 + ((kk & 7) * 32 + (c & 31)) * 2; }
__device__ __forceinline__ int v_rd_base(int lane) { return ((lane & 3) << 3) | (((lane >> 2) & 3) << 6) | (((lane >> 4) & 1) << 5) | (((lane >> 5) & 1) << 8); }
constexpr int v_rd_off(int d0, int ks, int half) { return d0 * 512 + ks * 4096 + half * 2048; }
__device__ __forceinline__ int crow(int r, int hi) { return (r & 3) + 8 * (r >> 2) + 4 * hi; }
__device__ __forceinline__ unsigned cvtpk(float lo, float hi) {
    unsigned r; asm volatile("v_cvt_pk_bf16_f32 %0, %1, %2" : "=v"(r) : "v"(lo), "v"(hi)); return r;
}
__device__ __forceinline__ bf16x8 pack8(f32x4 a, f32x4 b) {
    u32x4 w = {cvtpk(a[0], a[1]), cvtpk(a[2], a[3]), cvtpk(b[0], b[1]), cvtpk(b[2], b[3])};
    return *reinterpret_cast<bf16x8*>(&w);
}
template <class T> __device__ __forceinline__ bf16x8 load8(const T* p) {
    if constexpr (same_t<T, float>::v) { return pack8(*(const f32x4*)p, *(const f32x4*)(p + 4)); }
    else { return *reinterpret_cast<const bf16x8*>(p); }
}
__device__ __forceinline__ void mask_tile(f32x16& p0, f32x16& p1, int dq, unsigned W) {
    const float NEG = -__builtin_inff();
#pragma unroll
    for (int r = 0; r < 16; ++r) {
        const int c = (r & 3) + 8 * (r >> 2);
        if ((unsigned)(dq - c) >= W) p0[r] = NEG;
        if ((unsigned)(dq - c - 32) >= W) p1[r] = NEG;
    }
}
__device__ __forceinline__ void partialSM(f32x16& p0, f32x16& p1, float& m_reg, float& mn, float& alpha) {
    float pmax = p0[0]; for (int r = 1; r < 16; ++r) pmax = fmaxf(pmax, p0[r]); for (int r = 0; r < 16; ++r) pmax = fmaxf(pmax, p1[r]);
    { auto rr = __builtin_amdgcn_permlane32_swap(__float_as_uint(pmax), __float_as_uint(pmax), false, false);
      pmax = fmaxf(__uint_as_float(rr[0]), __uint_as_float(rr[1])); }
    constexpr float C2 = 1.4426950408889634f * SCALE;
    if (__builtin_expect(__all((pmax - m_reg) * SCALE <= THR), 1)) { mn = m_reg; alpha = 1.f; }
    else { mn = fmaxf(m_reg, pmax); alpha = __builtin_amdgcn_exp2f((m_reg - mn) * C2); m_reg = mn; }
    const float mnL = -mn * C2;
    for (int r = 0; r < 16; ++r) p0[r] = fmaf(p0[r], C2, mnL); for (int r = 0; r < 16; ++r) p1[r] = fmaf(p1[r], C2, mnL);
    for (int r = 0; r < 16; ++r) p0[r] = __builtin_amdgcn_exp2f(p0[r]);
}
__device__ __forceinline__ void finishSM(f32x16& p0, f32x16& p1, float alpha, float& l_reg, bf16x8& pa0, bf16x8& pa1, bf16x8& pa2, bf16x8& pa3) {
    for (int r = 0; r < 16; ++r) p1[r] = __builtin_amdgcn_exp2f(p1[r]);
    float ps = 0; for (int r = 0; r < 16; ++r) ps += p0[r]; for (int r = 0; r < 16; ++r) ps += p1[r];
    { auto rr = __builtin_amdgcn_permlane32_swap(__float_as_uint(ps), __float_as_uint(ps), false, false);
      ps = __uint_as_float(rr[0]) + __uint_as_float(rr[1]); }
    l_reg = l_reg * alpha + ps;
#define PK4(P, B_, OUT) do { unsigned a0 = cvtpk(P[B_+0], P[B_+1]), a1 = cvtpk(P[B_+2], P[B_+3]);                          \
        unsigned b0 = cvtpk(P[B_+4], P[B_+5]), b1 = cvtpk(P[B_+6], P[B_+7]);                                             \
        auto r0 = __builtin_amdgcn_permlane32_swap(a0, b0, false, false); auto r1 = __builtin_amdgcn_permlane32_swap(a1, b1, false, false); \
        u32x4 w = {r0[0], r1[0], r0[1], r1[1]}; OUT = *reinterpret_cast<bf16x8*>(&w); } while (0)
    PK4(p0, 0, pa0); PK4(p0, 8, pa1); PK4(p1, 0, pa2); PK4(p1, 8, pa3);
#undef PK4
}
template <int KB, bool SK>
__device__ __forceinline__ void qkt(f32x16& p0, f32x16& p1, const char* K_lds, int r32, int hi, const bf16x8* qr, bool act) {
    if (SK && !act) { const float NEG = -__builtin_inff();
#pragma unroll
        for (int r = 0; r < 16; ++r) { p0[r] = NEG; p1[r] = NEG; } return; }
    { const float* bb_ = (const float*)(K_lds + 2 * SHM_K + NW * 64 * 4) + KB * 64 + 4 * hi;
#pragma unroll
      for (int q_ = 0; q_ < 4; ++q_) { const f32x4 b0_ = *(const f32x4*)(bb_ + 8 * q_), b1_ = *(const f32x4*)(bb_ + 32 + 8 * q_);
#pragma unroll
        for (int i_ = 0; i_ < 4; ++i_) { p0[4 * q_ + i_] = b0_[i_]; p1[4 * q_ + i_] = b1_[i_]; } } }
    const char* kb[4];
#pragma unroll
    for (int dd = 0; dd < 4; ++dd) kb[dd] = K_lds + KB * SHM_K + KSWZ(r32, (dd * 16 + hi * 8) * 2);
#pragma unroll
    for (int d0 = 0; d0 < 8; ++d0) { const char* a = kb[d0 & 3] + (d0 >> 2) * 128;
        bf16x8 b0 = *reinterpret_cast<const bf16x8*>(a);
        bf16x8 b1 = *reinterpret_cast<const bf16x8*>(a + 32 * 256);
        p0 = __builtin_amdgcn_mfma_f32_32x32x16_bf16(b0, qr[d0], p0, 0, 0, 0);
        p1 = __builtin_amdgcn_mfma_f32_32x32x16_bf16(b1, qr[d0], p1, 0, 0, 0); }
}
template <int VB, bool SK>
__device__ __forceinline__ void pv_tile(f32x16* o, int vb0, bf16x8 pa0, bf16x8 pa1, bf16x8 pa2, bf16x8 pa3, bool act) {
    if (SK && !act) return;
#define TRRD(dst, off) asm volatile("ds_read_b64_tr_b16 %0, %1 offset:%2" : "=&v"(dst) : "v"(vb0), "i"(off) : "memory")
#define PV_D0(d0) do { s16x4 l0, l1, l2, l3, h0, h1, h2, h3; constexpr int b_ = VB * SHM_V + v_rd_off(d0, 0, 0);     \
        TRRD(l0, b_); TRRD(h0, b_ + 2048); TRRD(l1, b_ + 4096); TRRD(h1, b_ + 6144); TRRD(l2, b_ + 8192); TRRD(h2, b_ + 10240); TRRD(l3, b_ + 12288); TRRD(h3, b_ + 14336); \
        asm volatile("s_waitcnt lgkmcnt(0)" ::: "memory"); SBAR();                 \
        o[d0] = __builtin_amdgcn_mfma_f32_32x32x16_bf16(pa0, (bf16x8){l0[0], l0[1], l0[2], l0[3], h0[0], h0[1], h0[2], h0[3]}, o[d0], 0, 0, 0);   \
        o[d0] = __builtin_amdgcn_mfma_f32_32x32x16_bf16(pa1, (bf16x8){l1[0], l1[1], l1[2], l1[3], h1[0], h1[1], h1[2], h1[3]}, o[d0], 0, 0, 0);   \
        o[d0] = __builtin_amdgcn_mfma_f32_32x32x16_bf16(pa2, (bf16x8){l2[0], l2[1], l2[2], l2[3], h2[0], h2[1], h2[2], h2[3]}, o[d0], 0, 0, 0);   \
        o[d0] = __builtin_amdgcn_mfma_f32_32x32x16_bf16(pa3, (bf16x8){l3[0], l3[1], l3[2], l3[3], h3[0], h3[1], h3[2], h3[3]}, o[d0], 0, 0, 0); } while (0)
    PV_D0(0); PV_D0(1); PV_D0(2); PV_D0(3);
#undef PV_D0
#undef TRRD
}
template <class TIn, class TOut> struct BlockRef { const TIn* Q; const TIn* K; const TIn* V; TOut* O; const float* FB; int P0; };
template <class TIn> struct Seam {
    bf16x8 qr[8];
    bf16x8 st_v0, st_v1, st_k0, st_k1; float st_f; f32x4 sf0, sf1, sf2, sf3;
    f32x4 tq[16];
};
__device__ __forceinline__ int swa_jlo(int P0, int W) { const int lowk = P0 - W + 1; return lowk > 0 ? lowk / KVBLK : 0; }
#define ROW(p, k0, rr) ((p) + (size_t)((k0) + (rr)) * KS + sc)
#define VMW() asm volatile("s_waitcnt vmcnt(0)" ::: "memory")
#define VMWN(n) asm volatile("s_waitcnt vmcnt(%0)" :: "i"(n) : "memory")
#define SLOAD_H(Kp, Vp, Fp, k0) do { S.st_f = (Fp)[(k0) + (tid & 63)]; S.st_v0 = load8<TIn>(ROW(Vp, k0, sr)); S.st_v1 = load8<TIn>(ROW(Vp, k0, 32 + sr));              \
                         S.st_k0 = load8<TIn>(ROW(Kp, k0, sr)); S.st_k1 = load8<TIn>(ROW(Kp, k0, 32 + sr)); } while (0)
#define SWRITE_HK(bf) do { ((float*)(K_lds + 2 * SHM_K + NW * 64 * 4))[(bf) * 64 + (tid & 63)] = S.st_f; *(bf16x8*)(K_lds + (bf) * SHM_K + kws) = S.st_k0; *(bf16x8*)(K_lds + (bf) * SHM_K + kws + 32 * 256) = S.st_k1; } while (0)
#define SWRITE_HV(bf) do { *(bf16x8*)(V_lds + (bf) * SHM_V + vst0) = S.st_v0; *(bf16x8*)(V_lds + (bf) * SHM_V + vst1) = S.st_v1; } while (0)
#define SWRITE_H(bf) do { SWRITE_HV(bf); SWRITE_HK(bf); } while (0)
#define SLOAD_F(p, k0) do { S.sf0 = *(const f32x4*)ROW(p, k0, sr); S.sf1 = *(const f32x4*)(ROW(p, k0, sr) + 4);                \
                            S.sf2 = *(const f32x4*)ROW(p, k0, 32 + sr); S.sf3 = *(const f32x4*)(ROW(p, k0, 32 + sr) + 4); } while (0)
#define SWRITE_KF(bf) do { *(bf16x8*)(K_lds + (bf) * SHM_K + kws) = pack8(S.sf0, S.sf1); *(bf16x8*)(K_lds + (bf) * SHM_K + kws + 32 * 256) = pack8(S.sf2, S.sf3); } while (0)
#define SWRITE_VF(bf) do { *(bf16x8*)(V_lds + (bf) * SHM_V + vst0) = pack8(S.sf0, S.sf1); *(bf16x8*)(V_lds + (bf) * SHM_V + vst1) = pack8(S.sf2, S.sf3); } while (0)
template <class TIn, class TOut>
__device__ __forceinline__ void causal_swa_prime(const BlockRef<TIn, TOut>& cur, int W, char* lds, Seam<TIn>& S) {
    constexpr bool F32 = same_t<TIn, float>::v;
    const int tid = opaque_tid(), wid = __builtin_amdgcn_readfirstlane(tid >> 6), lane = tid & 63, r32 = lane & 31, hi = lane >> 5;
    const int sr = tid >> 4, sc = (tid & 15) * 8, kws = KSWZ(sr, sc * 2); char* K_lds = lds + 2 * SHM_V;
    const int kb0 = swa_jlo(cur.P0, W) * KVBLK;
    for (int d0 = 0; d0 < 8; ++d0) S.qr[d0] = load8<TIn>(cur.Q + (size_t)(wid * QBLK + r32) * QS + d0 * 16 + hi * 8);
    if constexpr (F32) { SLOAD_F((const float*)cur.K, kb0); VMW(); SWRITE_KF(0); SBAR(); SLOAD_F((const float*)cur.V, kb0); }
    else { SLOAD_H(cur.K, cur.V, cur.FB, kb0); VMW(); SWRITE_HK(0); }
    __syncthreads();
}
template <class TIn, class TOut>
__device__ __forceinline__ void causal_swa_block(const BlockRef<TIn, TOut>& cur, const BlockRef<TIn, TOut>& nxt, int skv, int W, char* lds, Seam<TIn>& S) {
    constexpr bool F32 = same_t<TIn, float>::v;
    const int tid = opaque_tid(), wid = __builtin_amdgcn_readfirstlane(tid >> 6), lane = tid & 63, r32 = lane & 31, hi = lane >> 5;
    const int j_lo = swa_jlo(cur.P0, W);
    int j_hi = (cur.P0 + QB - 1) / KVBLK + 1; if (j_hi > skv / KVBLK) j_hi = skv / KVBLK;
    const int NT = j_hi - j_lo;
    const int kbn = swa_jlo(nxt.P0, W) * KVBLK;
    const int qlo = cur.P0 + wid * QBLK, qm = qlo + r32 - 4 * hi;
    char* V_lds = lds; char* K_lds = lds + 2 * SHM_V;
    float* ws = (float*)(lds + 2 * SHM_V + 2 * SHM_K) + wid * 64; float* li_l = ws, * al_l = ws + 32;
    float m_reg = -1e30f, l_reg = 0; f32x16 o[4] = {};
    const int sr = tid >> 4, sc = (tid & 15) * 8, vst0 = v_st(sr, sc), vst1 = v_st(32 + sr, sc), kws = KSWZ(sr, sc * 2);
    const int vb0 = (int)(uintptr_t)V_lds + v_rd_base(lane);
    const TIn* Kh = cur.K; const TIn* Vh = cur.V;
#define RESC(a) do { if (__any((a) < 1.f)) { if (hi == 0) al_l[r32] = (a); asm volatile("s_waitcnt lgkmcnt(0)" ::: "memory");              \
                     for (int d_ = 0; d_ < 4; ++d_) for (int r = 0; r < 16; ++r) o[d_][r] *= al_l[crow(r, hi)]; } } while (0)
#define KBASE(t) ((j_lo + (t)) * KVBLK)
#define ACT(t) (KBASE(t) <= qlo + QBLK - 1 && KBASE(t) + KVBLK - 1 >= qlo - W + 1)
#define MASKT(P0_, P1_, t) do { const int kb_ = KBASE(t); if ((!SK || ACT(t)) && (kb_ + KVBLK - 1 > qlo || kb_ <= qlo + QBLK - 1 - W)) mask_tile(P0_, P1_, qm - kb_, (unsigned)W); } while (0)
    constexpr int NQL = F32 ? 16 : 8;
    constexpr bool SK = WSKIP && !F32;
#define SEAM_K0() do { VMWN(NQL); if constexpr (F32) { SWRITE_KF(0); SBAR(); SLOAD_F((const float*)nxt.V, kbn); } else { SWRITE_HK(0); } SBAR(); } while (0)
    f32x16 pA0, pA1, pB0, pB1; float mnA, mnB, alA, alB; bf16x8 pa0, pa1, pa2, pa3;
    if constexpr (F32) { VMW(); SWRITE_VF(0); SBAR(); } else { SWRITE_HV(0); SBAR(); }
    if (NT > 1) { if constexpr (F32) SLOAD_F((const float*)Kh, KBASE(1)); else SLOAD_H(Kh, Vh, cur.FB, KBASE(1)); }
    SBAR(); qkt<0, SK>(pA0, pA1, K_lds, r32, hi, S.qr, ACT(0));
    if constexpr (F32) { if (NT > 1) { VMW(); SWRITE_KF(1); SBAR(); SLOAD_F((const float*)Vh, KBASE(1)); } }
    MASKT(pA0, pA1, 0); partialSM(pA0, pA1, m_reg, mnA, alA);
    if (NT > 1) { VMW(); if constexpr (F32) { SWRITE_VF(1); SBAR(); if (NT > 2) SLOAD_F((const float*)Kh, KBASE(2)); } else SWRITE_H(1); }
    __syncthreads();
#define HALF_STEP(PX0, PX1, mnX, alX, PY0, PY1, alY, t, KB, VB, SB) do {                                                      \
        SBAR(); qkt<KB, SK>(PX0, PX1, K_lds, r32, hi, S.qr, ACT(t));                                             \
        finishSM(PY0, PY1, alY, l_reg, pa0, pa1, pa2, pa3); SBAR();                                                           \
        if ((t) + 1 < NT) { if constexpr (F32) { VMW(); SWRITE_KF(SB); SBAR(); SLOAD_F((const float*)Vh, KBASE((t) + 1)); }  \
                            else { SLOAD_H(Kh, Vh, cur.FB, KBASE((t) + 1)); } SBAR(); }                                               \
        pv_tile<VB, SK>(o, vb0, pa0, pa1, pa2, pa3, ACT((t) - 1)); MASKT(PX0, PX1, (t)); partialSM(PX0, PX1, m_reg, mnX, alX);                                        \
        __syncthreads();                                                                                                      \
        if ((t) + 1 < NT) { VMW(); if constexpr (F32) { SWRITE_VF(SB); SBAR(); if ((t) + 2 < NT) SLOAD_F((const float*)Kh, KBASE((t) + 2)); } \
                            else { SWRITE_H(SB); } }                                                                          \
        RESC(alX); __syncthreads(); } while (0)
    for (int t = 1; t + 1 < NT; t += 2) {
        HALF_STEP(pB0, pB1, mnB, alB, pA0, pA1, alA, t, 1, 0, 0);
        HALF_STEP(pA0, pA1, mnA, alA, pB0, pB1, alB, t + 1, 0, 1, 1);
    }
    const bool even = (NT & 1) == 0;
    if (even) { SBAR(); qkt<1, SK>(pB0, pB1, K_lds, r32, hi, S.qr, ACT(NT - 1)); SBAR(); }
#define QROW(e) (nxt.Q + (size_t)(wid * QBLK + r32) * D + ((e) >> 1) * 16 + hi * 8 + ((e) & 1) * 4)
    if constexpr (F32) { SLOAD_F((const float*)nxt.K, kbn); SBAR();
#pragma unroll
        for (int e = 0; e < 8; ++e) S.tq[e] = *(const f32x4*)QROW(e); }
    else { SLOAD_H(nxt.K, nxt.V, nxt.FB, kbn); SBAR();
#pragma unroll
        for (int d0 = 0; d0 < 8; ++d0) S.qr[d0] = load8<TIn>(nxt.Q + (size_t)(wid * QBLK + r32) * QS + d0 * 16 + hi * 8); }
    SBAR();
    finishSM(pA0, pA1, alA, l_reg, pa0, pa1, pa2, pa3); SBAR();
    if constexpr (F32) {
#pragma unroll
        for (int e = 8; e < 16; ++e) S.tq[e] = *(const f32x4*)QROW(e); SBAR(); }
#undef QROW
    pv_tile<0, SK>(o, vb0, pa0, pa1, pa2, pa3, ACT(even ? NT - 2 : NT - 1));
    if (even) { MASKT(pB0, pB1, NT - 1); partialSM(pB0, pB1, m_reg, mnB, alB); __syncthreads(); RESC(alB);
        finishSM(pB0, pB1, alB, l_reg, pa0, pa1, pa2, pa3); SBAR(); pv_tile<1, SK>(o, vb0, pa0, pa1, pa2, pa3, ACT(NT - 1)); }
    SBAR(); SEAM_K0();
    if (hi == 0) li_l[r32] = l_reg; asm volatile("s_waitcnt lgkmcnt(0)" ::: "memory");
    float rli[16];
#pragma unroll
    for (int r = 0; r < 16; ++r) rli[r] = __builtin_amdgcn_rcpf(li_l[crow(r, hi)]);
    TOut* Ow = cur.O + (size_t)(wid * QBLK) * OS;
#pragma unroll
    for (int r = 0; r < 16; ++r) { const int orow = crow(r, hi);
#pragma unroll
        for (int d0 = 0; d0 < 4; ++d0) { const float v = o[d0][r] * rli[r];
            if constexpr (same_t<TOut, float>::v) { Ow[(size_t)orow * OS + d0 * 32 + r32] = v; }
            else { const float vn = __shfl_xor(v, 1);
                   if ((r32 & 1) == 0) *(unsigned*)(Ow + (size_t)orow * OS + d0 * 32 + r32) = cvtpk(v, vn); } } }
    if constexpr (F32) {
#pragma unroll
        for (int d0 = 0; d0 < 8; ++d0) S.qr[d0] = pack8(S.tq[2 * d0], S.tq[2 * d0 + 1]); }
    __syncthreads();
#undef RESC
#undef KBASE
#undef ACT
#undef MASKT
#undef SEAM_K0
#undef HALF_STEP
}
#undef ROW
#undef VMW
#undef VMWN
#undef SLOAD_H
#undef SWRITE_HK
#undef SWRITE_HV
#undef SWRITE_H
#undef SLOAD_F
#undef SWRITE_KF
#undef SWRITE_VF

__host__ __device__ inline int swa_nramp(int nqb, int W, int qoff) { const int t = W - 1 - qoff; const int n = t < 0 ? 0 : t / QB + 1; return n > nqb ? nqb : n; }
__host__ __device__ inline int swa_nx(int nqb, int nramp, int order) { return (order & ORDER_PAIRED) ? (nramp + 1) / 2 + (nqb - nramp) : nqb; }
struct SwaItem { int bh, qb0, qb1; };
__device__ __forceinline__ SwaItem swa_decode(int L, int nb, int nh, int nhkv, int nqb, int nx, int nramp, int order) {
    const int G = nh / nhkv; SwaItem it; int x;
    if ((order & ORDER_XCD) && (nb * nhkv) % 8 == 0) { const int xcd = L & 7, k = L >> 3, per = G * nx, gi = k / per, r = k - gi * per;
        it.bh = (gi * 8 + xcd) * G + r / nx; x = r % nx; }
    else { it.bh = L / nx; x = L - it.bh * nx; }
    if (order & ORDER_PAIRED) { const int ns = nqb - nramp;
        if (x < ns) { it.qb0 = it.qb1 = nqb - 1 - x; } else { it.qb0 = x - ns; it.qb1 = nramp - 1 - it.qb0; } }
    else { it.qb0 = it.qb1 = ((order & 3) == ORDER_REVERSED) ? nqb - 1 - x : x; }
    return it;
}
typedef unsigned short bf16;
__device__ __forceinline__ BlockRef<bf16, bf16> mk_ref(const SwaItem& it, int pass, const bf16* Q, const bf16* K, const bf16* V, bf16* O, const float* FB) {
    const int qb = pass ? it.qb1 : it.qb0, b = it.bh >> 4, h = it.bh & 15, kvh = h >> 2;
    BlockRef<bf16, bf16> r;
    r.Q = Q + ((size_t)b * 8192 + (size_t)qb * QB) * QS + h * 128; r.O = O + ((size_t)b * 8192 + (size_t)qb * QB) * OS + h * 128;
    r.K = K + (size_t)b * 8192 * KS + kvh * 128; r.V = V + (size_t)b * 8192 * KS + kvh * 128; r.FB = FB + (size_t)it.bh * 8192; r.P0 = qb * QB;
    return r;
}
__device__ __forceinline__ void attn_phase(char* lds, const bf16* Q, const bf16* K, const bf16* V, bf16* O, const float* FB) {
    constexpr int nb = 4, nh = 16, nhkv = 4, nqb = 32, W = 8192, order = ORDER_PAIRED | ORDER_XCD;
    const int nramp = swa_nramp(nqb, W, 0), nx = swa_nx(nqb, nramp, order), total = nx * nb * nh, stride = gridDim.x;
    int L = blockIdx.x; if (L >= total) return;
    SwaItem it = swa_decode(L, nb, nh, nhkv, nqb, nx, nramp, order); int pass = 0;
    BlockRef<bf16, bf16> cur = mk_ref(it, 0, Q, K, V, O, FB);
    Seam<bf16> S;
    causal_swa_prime<bf16, bf16>(cur, W, lds, S);
    for (;;) {
        const bool more_pass = pass == 0 && it.qb1 != it.qb0, more_item = L + stride < total, last = !more_pass && !more_item;
        SwaItem itn = it; int passn = pass + 1, Ln = L;
        if (!more_pass) { passn = 0; Ln = more_item ? L + stride : L; itn = swa_decode(Ln, nb, nh, nhkv, nqb, nx, nramp, order); }
        const BlockRef<bf16, bf16> nxt = last ? cur : mk_ref(itn, passn, Q, K, V, O, FB);
        causal_swa_block<bf16, bf16>(cur, nxt, 8192, W, lds, S);
        if (last) break;
        cur = nxt; it = itn; pass = passn; L = Ln;
    }
}
}
constexpr size_t WS_WIN = 0, WS_WRO = 50331648, WS_WGU0 = 67108864, WS_WGU1 = 113246208, WS_WDN0 = 159383552, WS_WDN1 = 182452224,
                 WS_WO = 205520896, WS_WKVF = 213909504  , WS_COS = 227540992, WS_SIN = 231735296, WS_FB = 235929600, WS_FS = WS_FB + 2097152, WS_SSQ = WS_FS + 540672  , WS_BAR = WS_SSQ + 396288  ,
                 WS_BIG = 239075328;
constexpr size_t SZ_ROWS2K = (size_t)TALL * DM * 2;
constexpr size_t BIG_XN = 0, BIG_ACT = SZ_ROWS2K, BIG_HKV = BIG_ACT + (size_t)TALL * DFF * 2, BIG_KB = BIG_HKV + SZ_ROWS2K, BIG_VB = BIG_KB + (size_t)TP * 512 * 2,
                 BIG_KALL = BIG_VB + (size_t)TP * 512 * 2, BIG_VALL = BIG_KALL + (size_t)8 * LKS * 512 * 2, BIG_END = BIG_VALL + (size_t)8 * LKS * 512 * 2;
static_assert(BIG_END <= (size_t)TALL * NPROJ * 2, "layer-1 buffers fit in the PROJ region");
constexpr size_t WS_END = WS_BIG + (size_t)TALL * NPROJ * 2;
static_assert(WS_END <= (size_t)1073741824, "workspace fits 1 GiB");
constexpr size_t OUT_Y = 0, OUT_SP = 67633152, OUT_KP = 71827456, OUT_VP = 88604672, OUT_LFP = 105381888, OUT_SS = 105906176, OUT_KS = 114294784, OUT_VS = 114425856, OUT_LFS = 114556928;
constexpr int NWAVES = 8, LDS_BYTES = 149504;

struct Params { const float* in[21]; float* out; unsigned char* ws; };

__device__ __forceinline__ float wave_sum(float v) {
#pragma unroll
    for (int o = 1; o < 64; o <<= 1) v += __shfl_xor(v, o);
    return v;
}
__device__ __forceinline__ float bf2f(unsigned short b) { return __uint_as_float(((unsigned)b) << 16); }
__device__ __forceinline__ unsigned pk2(float lo, float hi) { return pg8::cvt_pk_bf16(lo, hi); }

__device__ __forceinline__ void transpose_item(const float* W, int K, int N, bf16_t* WT, int k0, int n0, int drow0, LAS float* scr, int lane, const float* gain = nullptr) {
    float wv[32];
#pragma unroll
    for (int i = 0; i < 32; ++i) { const int kk = 2 * i + (lane >> 5); wv[i] = W[(size_t)(k0 + kk) * N + n0 + (lane & 31)] * (gain ? gain[k0 + kk] : 1.f); }
#pragma unroll
    for (int i = 0; i < 32; ++i) { const int kk = 2 * i + (lane >> 5); scr[kk * 33 + (lane & 31)] = wv[i]; }
    asm volatile("s_waitcnt lgkmcnt(0)" ::: "memory");
    const int c = lane & 7;
#pragma unroll
    for (int j = 0; j < 4; ++j) { const int n = (lane >> 3) + 8 * j; const LAS float* s = scr + (8 * c) * 33 + n;
        u32x4 o; o.x = pk2(s[0 * 33], s[1 * 33]); o.y = pk2(s[2 * 33], s[3 * 33]); o.z = pk2(s[4 * 33], s[5 * 33]); o.w = pk2(s[6 * 33], s[7 * 33]);
        *(u32x4*)(WT + (size_t)(drow0 + n) * K + k0 + 8 * c) = o; }
    asm volatile("s_waitcnt lgkmcnt(0)" ::: "memory");
}
__device__ __forceinline__ void tr_plain(const float* W, int K, int N, bf16_t* WT, int row_off, LAS float* scr, int item, int lane, const float* gain = nullptr) {
    const int nblk = N / 32, kb = item / nblk, nb = item % nblk; transpose_item(W, K, N, WT, 64 * kb, 32 * nb, row_off + 32 * nb, scr, lane, gain);
}
__device__ __forceinline__ void tr_gu(const float* W, bf16_t* WT, int up, LAS float* scr, int item, int lane, const float* gain) {
    const int nblk = DFF / 32, kb = item / nblk, nb = item % nblk, n0 = 32 * nb; transpose_item(W, DM, DFF, WT, 64 * kb, n0, (n0 >> 7) * 256 + up * 128 + (n0 & 127), scr, lane, gain);
}
template <int MODE  >
__device__ __forceinline__ void rms_row(const float* xrow, const float* g1, bf16_t* o1, const float* g2, bf16_t* o2, float* of, int lane) {
    const f32x4* xr = (const f32x4*)xrow + lane;
    f32x4 v[8]; float s = 0.f;
#pragma unroll
    for (int j = 0; j < 8; ++j) { v[j] = xr[64 * j]; s += (v[j].x * v[j].x + v[j].y * v[j].y) + (v[j].z * v[j].z + v[j].w * v[j].w); }
    const float rs = 1.0f / sqrtf(wave_sum(s) * (1.f / DM) + 1e-6f);
#pragma unroll
    for (int j = 0; j < 8; ++j) { const f32x4 ga = ((const f32x4*)g1)[64 * j + lane]; const f32x4 y = v[j] * rs;
        if (MODE == 2) { ((f32x4*)of)[64 * j + lane] = y * ga; }
        else { u32x2 w; w.x = pk2(y.x * ga.x, y.y * ga.y); w.y = pk2(y.z * ga.z, y.w * ga.w); ((u32x2*)o1)[64 * j + lane] = w;
            if (MODE == 1) { const f32x4 gb = ((const f32x4*)g2)[64 * j + lane]; u32x2 w2; w2.x = pk2(y.x * gb.x, y.y * gb.y); w2.y = pk2(y.z * gb.z, y.w * gb.w); ((u32x2*)o2)[64 * j + lane] = w2; } } }
}

namespace ret {
constexpr int QOFF = 0, KOFF = 33792, STOFF = 67584, VOFF = 101376, POFF = 110592, RS = 528, VS = 144;
typedef short v4i16_t __attribute__((ext_vector_type(4)));
__device__ __forceinline__ bf16x8 frag_rm(const LAS char* base, int stride, int i0, int k0, int fr, int fq) { return *(const LAS bf16x8*)(base + (i0 + fr) * stride + (k0 + 8 * fq) * 2); }
__device__ __forceinline__ s16x4 tr4(const LAS char* p) { return __builtin_bit_cast(s16x4, __builtin_amdgcn_ds_read_tr16_b64_v4i16((LAS v4i16_t*)p)); }
__device__ __forceinline__ bf16x8 frag_tr(const LAS char* base, int stride, int k0, int i0, int fr, int fq) {
    const LAS char* p = base + (k0 + 8 * fq + (fr >> 2)) * stride + (i0 + 4 * (fr & 3)) * 2;
    const s16x4 a = tr4(p), b = tr4(p + 4 * stride);
    return (bf16x8){a[0], a[1], a[2], a[3], b[0], b[1], b[2], b[3]};
}
#define MFMA16(X, Y, C) __builtin_amdgcn_mfma_f32_16x16x32_bf16(X, Y, C, 0, 0, 0)
__device__ __forceinline__ void ret_item(LAS char* lds, const bf16_t* pin, bf16_t* pout  , int nchunks, int c, int h, int es, const float* S0, float* Sout) {
    const int tid = opaque_tid(), wid = __builtin_amdgcn_readfirstlane(tid >> 6), lane = tid & 63, fr = lane & 15, fq = lane >> 4, lt = wid >> 1, half = wid & 1;
    const float lg2 = __log2f(1.0f - exp2f(-5.0f - (float)h)), gam = exp2f(lg2), gc1 = exp2f(lg2 * (float)(c - 1));
    f32x4 accT[8];
    const int eT = 16 * lt + fr;
#pragma unroll
    for (int i = 0; i < 8; ++i) { const int d0 = 16 * (8 * half + i) + 4 * fq;
#pragma unroll
        for (int r = 0; r < 4; ++r) accT[i][r] = S0 ? S0[(size_t)(d0 + r) * 512 + es * 64 + eT] : 0.f;
        u32x2 w; w.x = pk2(accT[i][0], accT[i][1]); w.y = pk2(accT[i][2], accT[i][3]); *(LAS u32x2*)(lds + STOFF + eT * RS + d0 * 2) = w; }
    u32x4 rq[4], rk[4], rv;
    const bf16_t* gq = pin + h * 256; const bf16_t* gk = pin + 2048 + h * 256; const bf16_t* gv = pin + 4096 + h * 512 + es * 64;
#define RET_LOAD(n) do { _Pragma("unroll") for (int i = 0; i < 4; ++i) { const int p = tid + 512 * i, row = p >> 5, ch = p & 31; const size_t go = (size_t)((n) * 64 + row) * NPROJ + ch * 8; \
            if (row < c) { rq[i] = *(const u32x4*)(gq + go); rk[i] = *(const u32x4*)(gk + go); } else { rq[i] = (u32x4){0u, 0u, 0u, 0u}; rk[i] = (u32x4){0u, 0u, 0u, 0u}; } } \
        { const int row = tid >> 3, ch = tid & 7; if (row < c) rv = *(const u32x4*)(gv + (size_t)((n) * 64 + row) * NPROJ + ch * 8); else rv = (u32x4){0u, 0u, 0u, 0u}; } } while (0)
    RET_LOAD(0);
    for (int n = 0; n < nchunks; ++n) {
#pragma unroll
        for (int i = 0; i < 4; ++i) { const int p = tid + 512 * i, row = p >> 5, ch = p & 31; *(LAS u32x4*)(lds + QOFF + row * RS + ch * 16) = rq[i]; *(LAS u32x4*)(lds + KOFF + row * RS + ch * 16) = rk[i]; }
        *(LAS u32x4*)(lds + VOFF + (tid >> 3) * VS + (tid & 7) * 16) = rv;
        if (n + 1 < nchunks) RET_LOAD(n + 1);
        __syncthreads();
        f32x4 accS[2], accC[2];
#pragma unroll
        for (int j = 0; j < 2; ++j) { accS[j] = (f32x4){0.f, 0.f, 0.f, 0.f}; accC[j] = (f32x4){0.f, 0.f, 0.f, 0.f}; }
#pragma unroll
        for (int ks = 0; ks < 8; ++ks) { const int k0 = 32 * ks;
            const bf16x8 yq = frag_rm(lds + QOFF, RS, 16 * lt, k0, fr, fq);
#pragma unroll
            for (int j = 0; j < 2; ++j) { const bf16x8 xk = frag_rm(lds + KOFF, RS, 16 * (2 * half + j), k0, fr, fq); accS[j] = MFMA16(xk, yq, accS[j]); }
#pragma unroll
            for (int j = 0; j < 2; ++j) { const bf16x8 xs = frag_rm(lds + STOFF, RS, 16 * (2 * half + j), k0, fr, fq); accC[j] = MFMA16(xs, yq, accC[j]); } }
        const int lrow = 16 * lt + fr;
#pragma unroll
        for (int j = 0; j < 2; ++j) { const int m0 = 16 * (2 * half + j) + 4 * fq; f32x4 s = accS[j];
#pragma unroll
            for (int r = 0; r < 4; ++r) s[r] = (m0 + r <= lrow) ? s[r] : 0.f;
            u32x2 w; w.x = pk2(s[0], s[1]); w.y = pk2(s[2], s[3]); *(LAS u32x2*)(lds + POFF + lrow * VS + m0 * 2) = w; }
        __syncthreads();
        f32x4 accO[2];
#pragma unroll
        for (int j = 0; j < 2; ++j) accO[j] = accC[j] * gam;
#pragma unroll
        for (int ks = 0; ks < 2; ++ks) { const int k0 = 32 * ks;
            const bf16x8 yp = frag_rm(lds + POFF, VS, 16 * lt, k0, fr, fq);
#pragma unroll
            for (int j = 0; j < 2; ++j) { const bf16x8 xv = frag_tr(lds + VOFF, VS, k0, 16 * (2 * half + j), fr, fq); accO[j] = MFMA16(xv, yp, accO[j]); } }
        if (lrow < c) {
#pragma unroll
            for (int j = 0; j < 2; ++j) { u32x2 w; w.x = pk2(accO[j][0], accO[j][1]); w.y = pk2(accO[j][2], accO[j][3]);
                *(u32x2*)(pout + (size_t)(n * 64 + lrow) * 4096 + h * 512 + es * 64 + 16 * (2 * half + j) + 4 * fq) = w; } }
#pragma unroll
        for (int i = 0; i < 8; ++i) accT[i] = accT[i] * gam;
#pragma unroll
        for (int ks = 0; ks < 2; ++ks) { const int k0 = 32 * ks;
            const bf16x8 yv = frag_tr(lds + VOFF, VS, k0, 16 * lt, fr, fq);
#pragma unroll
            for (int i = 0; i < 8; ++i) { const bf16x8 xk = frag_tr(lds + KOFF, RS, k0, 16 * (8 * half + i), fr, fq); accT[i] = MFMA16(xk, yv, accT[i]); } }
#pragma unroll
        for (int i = 0; i < 8; ++i) { accT[i] = accT[i] * gc1; const int d0 = 16 * (8 * half + i) + 4 * fq;
            u32x2 w; w.x = pk2(accT[i][0], accT[i][1]); w.y = pk2(accT[i][2], accT[i][3]); *(LAS u32x2*)(lds + STOFF + eT * RS + d0 * 2) = w; }
        __syncthreads();
    }
#undef RET_LOAD
#pragma unroll
    for (int i = 0; i < 8; ++i) { const int d0 = 16 * (8 * half + i) + 4 * fq;
#pragma unroll
        for (int r = 0; r < 4; ++r) Sout[(size_t)(d0 + r) * 512 + es * 64 + eT] = accT[i][r]; }
}
}
__device__ __forceinline__ void sample_attn(LAS char* lds, const bf16_t* QBp, const bf16_t* KALL, const bf16_t* VALL, const float* FS, bf16_t* AO) {
    const int tid = opaque_tid(), wid = __builtin_amdgcn_readfirstlane(tid >> 6), lane = tid & 63;
    LAS float* qf = (LAS float*)(lds + wid * 5120); LAS float* pf = qf + 128;
    const int gw = blockIdx.x * NWAVES + wid, NGW = gridDim.x * NWAVES;
    for (int item = gw; item < 8 * 16 * 32; item += NGW) {
        const int b = item >> 9, h = (item >> 5) & 15, qi = item & 31, kvh = h >> 2, qpos = PASTL + qi, row = TP + b * 32 + qi;
        const bf16_t* q = QBp + (size_t)row * DM + h * 128;
        qf[lane] = bf2f(q[lane]); qf[lane + 64] = bf2f(q[lane + 64]);
        asm volatile("s_waitcnt lgkmcnt(0)" ::: "memory");
        const float* F = FS + (size_t)(b * 16 + h) * LKS; const float Fq = F[qpos];
        const bf16_t* Kb = KALL + (size_t)b * LKS * 512 + kvh * 128; const bf16_t* Vb = VALL + (size_t)b * LKS * 512 + kvh * 128;
        float mx = -1e30f;
#pragma unroll 1
        for (int t = 0; t < 17; ++t) { const int j = lane + 64 * t; float s = -__builtin_inff();
            if (j <= qpos) { const u32x4* kr = (const u32x4*)(Kb + (size_t)j * 512); float a = 0.f; u32x4 kvv[16];
#pragma unroll
                for (int c8 = 0; c8 < 16; ++c8) kvv[c8] = kr[c8];
#pragma unroll
                for (int c8 = 0; c8 < 16; ++c8) { const u32x4 kv = kvv[c8]; const LAS f32x4* qq = (const LAS f32x4*)(qf + 8 * c8); const f32x4 q0 = qq[0], q1 = qq[1];
                    a += __uint_as_float(kv.x << 16) * q0.x + __uint_as_float(kv.x & 0xffff0000u) * q0.y + __uint_as_float(kv.y << 16) * q0.z + __uint_as_float(kv.y & 0xffff0000u) * q0.w
                       + __uint_as_float(kv.z << 16) * q1.x + __uint_as_float(kv.z & 0xffff0000u) * q1.y + __uint_as_float(kv.w << 16) * q1.z + __uint_as_float(kv.w & 0xffff0000u) * q1.w; }
                s = a * 0.08838834764831845f + (Fq - F[j]); }
            pf[j] = s; mx = fmaxf(mx, s); }
#pragma unroll
        for (int o = 1; o < 64; o <<= 1) mx = fmaxf(mx, __shfl_xor(mx, o));
        float sum = 0.f;
#pragma unroll 1
        for (int t = 0; t < 17; ++t) { const float p = __expf(pf[lane + 64 * t] - mx); sum += p; pf[lane + 64 * t] = p; }
        sum = wave_sum(sum);
        asm volatile("s_waitcnt lgkmcnt(0)" ::: "memory");
        float oa[8];
#pragma unroll
        for (int e = 0; e < 8; ++e) oa[e] = 0.f;
        const int kg = lane >> 4, dg = lane & 15;
        for (int j = 0; j < PASTL + 32; j += 32) {
            u32x4 vv[8]; float p[8];
#pragma unroll
            for (int u = 0; u < 8; ++u) { vv[u] = *(const u32x4*)(Vb + (size_t)(j + 4 * u + kg) * 512 + 8 * dg); p[u] = pf[j + 4 * u + kg]; }
#pragma unroll
            for (int u = 0; u < 8; ++u) { const unsigned w4[4] = {vv[u].x, vv[u].y, vv[u].z, vv[u].w};
#pragma unroll
                for (int e = 0; e < 4; ++e) { oa[2 * e] += p[u] * __uint_as_float(w4[e] << 16); oa[2 * e + 1] += p[u] * __uint_as_float(w4[e] & 0xffff0000u); } } }
#pragma unroll
        for (int e = 0; e < 8; ++e) { oa[e] += __shfl_xor(oa[e], 16); oa[e] += __shfl_xor(oa[e], 32); }
        const float inv = 1.0f / sum;
        if (kg == 0) { u32x4 w; w.x = pk2(oa[0] * inv, oa[1] * inv); w.y = pk2(oa[2] * inv, oa[3] * inv); w.z = pk2(oa[4] * inv, oa[5] * inv); w.w = pk2(oa[6] * inv, oa[7] * inv);
            *(u32x4*)(AO + (size_t)row * DM + h * 128 + 8 * dg) = w; }
        asm volatile("s_waitcnt lgkmcnt(0)" ::: "memory");
    }
}

#define XB_TMO      128
#define XB_XCNT(j)  (256  + 64 * (j))
#define XB_XSUB(j)  (1280 + 64 * (j))
#define XB_XGEN(j)  (2304 + 64 * (j))
#define XB_TOP      3328
#define XB_TOPGEN   3392
#define XCD_BAR_WORDS 3456
#define XB_SPIN_CAP (1u << 18)

__device__ __forceinline__ unsigned xb_ld(unsigned* p)              { return __hip_atomic_load(p, __ATOMIC_RELAXED, __HIP_MEMORY_SCOPE_AGENT); }
__device__ __forceinline__ unsigned xb_add(unsigned* p, unsigned v) { return __hip_atomic_fetch_add(p, v, __ATOMIC_RELAXED, __HIP_MEMORY_SCOPE_AGENT); }
__device__ __forceinline__ unsigned xb_xcc_id() { return (unsigned)__builtin_amdgcn_s_getreg((3 << 11) | 20) & 0xFu; }
#define XB_SPIN(cond, bar) do { unsigned _sp = 0; while (cond) { __builtin_amdgcn_s_sleep(1); \
    if ((++_sp & 255u) == 0u) { if (xb_ld(&(bar)[XB_TMO])) break; if (_sp > XB_SPIN_CAP) { atomicAdd(&(bar)[XB_TMO], 1u); break; } } } } while (0)

struct XcdBarrier {
    unsigned* bar; unsigned x;
    volatile LAS unsigned* st;
};

__device__ __forceinline__ XcdBarrier xcd_barrier_post(unsigned* bar, volatile LAS unsigned* st) {
    XcdBarrier b; b.bar = bar; b.x = xb_xcc_id(); b.st = st;
    if (threadIdx.x == 0) (void)xb_add(&bar[XB_XCNT(b.x)], 1u);
    return b;
}
__device__ __forceinline__ void xcd_barrier_complete(unsigned* bar, unsigned x, unsigned& nloc, unsigned& nx) {
    const unsigned G = gridDim.x * gridDim.y * gridDim.z;
    unsigned sum, cnt, mine, sp = 0u;
    for (;;) {
        sum = 0u; cnt = 0u; mine = 0u;
#pragma unroll
        for (unsigned j = 0; j < 16; ++j) { const unsigned c = xb_ld(&bar[XB_XCNT(j)]); sum += c; cnt += (c > 0u) ? 1u : 0u; mine = (j == x) ? c : mine; }
        if (sum == G) break;
        __builtin_amdgcn_s_sleep(1);
        if ((++sp & 255u) == 0u) { if (xb_ld(&bar[XB_TMO])) break; if (sp > XB_SPIN_CAP) { atomicAdd(&bar[XB_TMO], 1u); break; } }
    }
    nloc = mine > 0u ? mine : 1u; nx = cnt > 0u ? cnt : 1u;
}

__device__ __forceinline__ void xcd_barrier(const XcdBarrier& b) {
    asm volatile("s_waitcnt vmcnt(0)" ::: "memory");
    __syncthreads();
    if (threadIdx.x == 0) {
        unsigned* bar = b.bar;
        __builtin_amdgcn_s_waitcnt(0);
        unsigned nloc = b.st[0], nx = b.st[1];
        if (nloc == 0u) { xcd_barrier_complete(bar, b.x, nloc, nx); b.st[0] = nloc; b.st[1] = nx; }
        const unsigned old = xb_add(&bar[XB_XSUB(b.x)], 1u);
        const unsigned gen = old / nloc;
        if (old + 1u == (gen + 1u) * nloc) {
            __builtin_amdgcn_fence(__ATOMIC_RELEASE, "agent");
            asm volatile("s_waitcnt vmcnt(0)" ::: "memory");
            const unsigned og = xb_add(&bar[XB_TOP], 1u);
            const unsigned tg = og / nx;
            if (og + 1u == (tg + 1u) * nx) xb_add(&bar[XB_TOPGEN], 1u);
            else XB_SPIN(xb_ld(&bar[XB_TOPGEN]) == tg, bar);
            __builtin_amdgcn_fence(__ATOMIC_ACQUIRE, "agent");
            xb_add(&bar[XB_XGEN(b.x)], 1u);
            asm volatile("s_waitcnt vmcnt(0)" ::: "memory");
        } else {
            XB_SPIN(xb_ld(&bar[XB_XGEN(b.x)]) == gen, bar);
            __builtin_amdgcn_fence(__ATOMIC_ACQUIRE, "agent");
            asm volatile("s_waitcnt vmcnt(0)" ::: "memory");
        }
    }
    __syncthreads();
}

#define KARG(i) ((unsigned char*)(((const volatile __attribute__((address_space(4))) unsigned long long*)__builtin_amdgcn_kernarg_segment_ptr())[i]))
#define INF(i) ((const float*)KARG(i))
#define OUTP ((float*)KARG(21))
#define WSP (KARG(22))
#define BIGP (KARG(22) + WS_BIG)
#define PH_IDS const int tid = opaque_tid(), lane = tid & 63, wave = __builtin_amdgcn_readfirstlane(tid >> 6); const int G = gridDim.x, gw = blockIdx.x * NWAVES + wave, NGW = G * NWAVES; const size_t gt = (size_t)blockIdx.x * 512 + tid, NGT = (size_t)G * 512; (void)lane; (void)gw; (void)NGW; (void)gt; (void)NGT

__device__ __forceinline__ void ph_prologue(LAS unsigned char* lds) {
    PH_IDS; unsigned char* ws = WSP;
    bf16_t* WIN = (bf16_t*)(ws + WS_WIN); bf16_t* WKVF = (bf16_t*)(ws + WS_WKVF);
    LAS float* scr = (LAS float*)(lds + wave * 16384);
    constexpr int I0 = 32 * 384;
    for (int it = gw; it < I0; it += NGW) tr_plain(INF(10), DM, NPROJ, WIN, 0, scr, it, lane);
    { const float* wf = INF(14); const float* nkv = INF(8);
      for (size_t i = gt; i < (size_t)256 * DM; i += NGT) { const int r = (int)(i >> 11), k = (int)(i & 2047); WKVF[(size_t)(1024 + r) * DM + k] = r < 16 ? (bf16_t)(pk2(wf[k * 16 + r] * nkv[k], 0.f) & 0xffffu) : (bf16_t)0; }
      float* ssq = (float*)(ws + WS_SSQ); for (size_t i = gt; i < (size_t)3 * TALL; i += NGT) ssq[i] = 0.f; }
    { float* COS = (float*)(ws + WS_COS); float* SIN = (float*)(ws + WS_SIN);
      for (size_t i = gt; i < (size_t)SEQ * 128; i += NGT) { const int pos = (int)(i >> 7), d = (int)(i & 127);
        const float inv = exp2f(-(float)d * (13.287712379549449f / 128.f));
        const double rev = (double)pos * (double)inv * 0.15915494309189535; const float fr = (float)(rev - __builtin_floor(rev));
        COS[i] = __builtin_amdgcn_cosf(fr); SIN[i] = __builtin_amdgcn_sinf(fr); } }
    { const float* x_p = INF(0); const float* x_s = INF(1); const float* nm = INF(6); bf16_t* XN0 = (bf16_t*)OUTP;
      for (int m = gw; m < TALL; m += NGW) rms_row<0>(m < TP ? x_p + (size_t)m * DM : x_s + (size_t)(m - TP) * DM, nm, XN0 + (size_t)m * DM, nullptr, nullptr, nullptr, lane); }
}
template <int JOB> __device__ __forceinline__ void ph_conv(LAS unsigned char* lds) {
    const int tid = opaque_tid(), lane = tid & 63, wave = __builtin_amdgcn_readfirstlane(tid >> 6);
    const int G = gridDim.x, first = G > 64 ? (JOB == 0 ? 48 : 8) : 0;
    if ((int)blockIdx.x < first) return;
    const int gw = ((int)blockIdx.x - first) * NWAVES + wave, NGW = (G - first) * NWAVES;
    unsigned char* ws = WSP; LAS float* scr = (LAS float*)(lds + wave * 16384);
    constexpr int IG = 32 * 176, ID = 88 * 64, IQ = 32 * 64, IK = 32 * 16;
    if (JOB == 0) {
        bf16_t* WRO = (bf16_t*)(ws + WS_WRO);
        for (int it = gw; it < 64 * 64; it += NGW) tr_plain(INF(11), 4096, DM, WRO, 0, scr, it, lane);
    } else if (JOB == 1) {
        bf16_t* WGU0 = (bf16_t*)(ws + WS_WGU0); bf16_t* WDN0 = (bf16_t*)(ws + WS_WDN0);
        for (int it = gw; it < 2 * IG + ID; it += NGW) { int r = it;
            if (r < IG) { tr_gu(INF(18), WGU0, 0, scr, r, lane, INF(7)); continue; } r -= IG;
            if (r < IG) { tr_gu(INF(19), WGU0, 1, scr, r, lane, INF(7)); continue; } r -= IG;
            tr_plain(INF(20), DFF, DM, WDN0, 0, scr, r, lane); }
    } else {
        bf16_t* WGU1 = (bf16_t*)(ws + WS_WGU1); bf16_t* WDN1 = (bf16_t*)(ws + WS_WDN1); bf16_t* WO = (bf16_t*)(ws + WS_WO); bf16_t* WKVF = (bf16_t*)(ws + WS_WKVF);
        for (int it = gw; it < 2 * IQ + 2 * IK + 2 * IG + ID; it += NGW) { int r = it;
            if (r < IQ) { tr_plain(INF(16), DM, DM, WKVF, 1280, scr, r, lane, INF(6) + DM); continue; } r -= IQ;
            if (r < IK) { tr_plain(INF(12), DM, 512, WKVF, 0, scr, r, lane, INF(8)); continue; } r -= IK;
            if (r < IK) { tr_plain(INF(13), DM, 512, WKVF, 512, scr, r, lane, INF(8)); continue; } r -= IK;
            if (r < IQ) { tr_plain(INF(17), DM, DM, WO, 0, scr, r, lane); continue; } r -= IQ;
            if (r < IG) { tr_gu(INF(18) + (size_t)DM * DFF, WGU1, 0, scr, r, lane, INF(7) + DM); continue; } r -= IG;
            if (r < IG) { tr_gu(INF(19) + (size_t)DM * DFF, WGU1, 1, scr, r, lane, INF(7) + DM); continue; } r -= IG;
            tr_plain(INF(20) + (size_t)DFF * DM, DFF, DM, WDN1, 0, scr, r, lane); }
    }
}
__device__ __forceinline__ void ph_retin(LAS unsigned char* lds) {
    unsigned char* ws = WSP;
    pg8::Gemm g{(const bf16_t*)OUTP, (const bf16_t*)(ws + WS_WIN), TALL, NPROJ, DM, DM}; pg8::StaticOrder S; S.init(TALL, NPROJ, (int)gridDim.x, (int)blockIdx.x);
    pg8::EpiRetIn E{(bf16_t*)(ws + WS_BIG), (const float*)(ws + WS_COS), (const float*)(ws + WS_SIN)};
    pg8::gemm_phase<pg8::EpiRetIn, pg8::StaticOrder, true, true>(lds, g, S, E);
}
__device__ __forceinline__ void ph_retention(LAS unsigned char* lds) {
    const int G = gridDim.x;
    for (int it = blockIdx.x; it < 256; it += G) { const int bh = (it & 7) * 4 + (it >> 6), es = (it >> 3) & 7, b = bh >> 3, h = bh & 7;
        ret::ret_item((LAS char*)lds, (const bf16_t*)BIGP + (size_t)b * SEQ * NPROJ, (bf16_t*)OUTP + (size_t)b * SEQ * 4096, 128, 64, h, es, nullptr, OUTP + OUT_SP + (size_t)(b * 8 + h) * 256 * 512); }
    for (int it = blockIdx.x; it < 512; it += G) { const int bh = (it & 7) * 8 + (it >> 6), es = (it >> 3) & 7, b = bh >> 3, h = bh & 7;
        ret::ret_item((LAS char*)lds, (const bf16_t*)BIGP + (size_t)(TP + b * 32) * NPROJ, (bf16_t*)OUTP + (size_t)(TP + b * 32) * 4096, 1, 32, h, es, INF(2) + (size_t)(b * 8 + h) * 256 * 512, OUTP + OUT_SS + (size_t)(b * 8 + h) * 256 * 512); }
}
__device__ __forceinline__ void ph_groupnorm() {
    PH_IDS; bf16_t* PROJ = (bf16_t*)BIGP; const bf16_t* OB = (const bf16_t*)OUTP;
    for (int it0 = gw * 4; it0 < TALL * 8; it0 += NGW * 4) {
        u32x4 ovv[4], gvv[4];
#pragma unroll
        for (int q = 0; q < 4; ++q) { const int it = it0 + q, row = it >> 3, h = it & 7;
            ovv[q] = *(const u32x4*)(OB + (size_t)row * 4096 + h * 512 + lane * 8); gvv[q] = *(const u32x4*)(PROJ + (size_t)row * NPROJ + 8192 + h * 512 + lane * 8); }
#pragma unroll
        for (int q = 0; q < 4; ++q) { const int it = it0 + q, row = it >> 3, h = it & 7; const u32x4 ov = ovv[q], gv = gvv[q];
            bf16_t* op = PROJ + (size_t)row * NPROJ + 4096 + h * 512 + lane * 8;
            float o[8], g[8]; const unsigned ow[4] = {ov.x, ov.y, ov.z, ov.w}, gwd[4] = {gv.x, gv.y, gv.z, gv.w};
#pragma unroll
            for (int j = 0; j < 4; ++j) { o[2 * j] = __uint_as_float(ow[j] << 16); o[2 * j + 1] = __uint_as_float(ow[j] & 0xffff0000u); g[2 * j] = __uint_as_float(gwd[j] << 16); g[2 * j + 1] = __uint_as_float(gwd[j] & 0xffff0000u); }
            float s = 0.f;
#pragma unroll
            for (int j = 0; j < 8; ++j) s += o[j];
            const float mu = wave_sum(s) * (1.f / 512.f); float qq = 0.f;
#pragma unroll
            for (int j = 0; j < 8; ++j) { o[j] -= mu; qq += o[j] * o[j]; }
            const float rstd = 1.0f / sqrtf(wave_sum(qq) * (1.f / 512.f) + 1e-5f);
#pragma unroll
            for (int j = 0; j < 8; ++j) o[j] = o[j] * rstd * pg8::silu_f(g[j]);
            u32x4 w; w.x = pk2(o[0], o[1]); w.y = pk2(o[2], o[3]); w.z = pk2(o[4], o[5]); w.w = pk2(o[6], o[7]); *(u32x4*)op = w; } }
}
template <bool FIRST, int MROWS = TALL> __device__ __forceinline__ void ph_res_gemm(LAS unsigned char* lds, unsigned char* a_ptr, size_t w_off, int K, int lda, bf16_t* hb, int ssq_idx) {
    unsigned char* ws = WSP; float* Hres = OUTP + OUT_Y;
    pg8::Gemm g{(const bf16_t*)a_ptr, (const bf16_t*)(ws + w_off), MROWS, DM, K, lda}; pg8::StaticOrder S; S.init(MROWS, DM, (int)gridDim.x, (int)blockIdx.x);
    pg8::EpiRes E{FIRST ? INF(0) : Hres, FIRST ? INF(1) : Hres + (size_t)TP * DM, Hres, hb, ssq_idx >= 0 ? (float*)(ws + WS_SSQ) + (size_t)ssq_idx * TALL : nullptr};
    pg8::gemm_phase<pg8::EpiRes, pg8::StaticOrder, true, true>(lds, g, S, E);
}
__device__ __forceinline__ void ph_sample_res(const unsigned char* a_ptr, int lda, size_t w_off, int K, bf16_t* hb, int ssq_idx) {
    const int tid = opaque_tid(), lane = tid & 63, wave = __builtin_amdgcn_readfirstlane(tid >> 6), fr = lane & 15, fq = lane >> 4;
    unsigned char* ws = WSP; float* Hs = OUTP + OUT_Y + (size_t)TP * DM;
    const bf16_t* A = (const bf16_t*)a_ptr; const bf16_t* Wt = (const bf16_t*)(ws + w_off);
    float* ssq = ssq_idx >= 0 ? (float*)(ws + WS_SSQ) + (size_t)ssq_idx * TALL + TP : nullptr;
    for (int it = blockIdx.x; it < 256; it += gridDim.x) {
        const int n0 = (it >> 1) * 16, row = (it & 1) * 128 + 16 * wave + fr;
        const bf16_t* bp = Wt + (size_t)(n0 + fr) * K + 8 * fq; const bf16_t* ap = A + (size_t)row * lda + 8 * fq;
        f32x4 acc = {0.f, 0.f, 0.f, 0.f};
        bf16x8 bA[8], aA[8], bB[8], aB[8];
#define SR_LOAD(B_, A_, kk) do { _Pragma("unroll") for (int s_ = 0; s_ < 8; ++s_) { B_[s_] = *(const bf16x8*)(bp + (kk) + 32 * s_); A_[s_] = *(const bf16x8*)(ap + (kk) + 32 * s_); } } while (0)
#define SR_MMA(B_, A_) do { _Pragma("unroll") for (int s_ = 0; s_ < 8; ++s_) acc = __builtin_amdgcn_mfma_f32_16x16x32_bf16(B_[s_], A_[s_], acc, 0, 0, 0); } while (0)
        SR_LOAD(bA, aA, 0);
        for (int k0 = 0; k0 < K; k0 += 512) {
            SR_LOAD(bB, aB, k0 + 256);
            SR_MMA(bA, aA);
            if (k0 + 512 < K) SR_LOAD(bA, aA, k0 + 512);
            SR_MMA(bB, aB);
        }
#undef SR_LOAD
#undef SR_MMA
        float* o = Hs + (size_t)row * DM + n0 + 4 * fq;
        const f32x4 v = *(const f32x4*)o + acc; *(f32x4*)o = v;
        if (hb) { u32x2 w; w.x = pk2(v[0], v[1]); w.y = pk2(v[2], v[3]); *(u32x2*)(hb + (size_t)(TP + row) * DM + n0 + 4 * fq) = w; }
        if (ssq) { float ss = (v[0] * v[0] + v[1] * v[1]) + (v[2] * v[2] + v[3] * v[3]); ss += __shfl_xor(ss, 16); ss += __shfl_xor(ss, 32);
            if (fq == 0) (void)__hip_atomic_fetch_add(ssq + row, ss, __ATOMIC_RELAXED, __HIP_MEMORY_SCOPE_AGENT); }
    }
}
template <int MODE> __device__ __forceinline__ void ph_rms(const float* g1, size_t o1_off, const float* g2, size_t o2_off) {
    PH_IDS; float* Hres = OUTP + OUT_Y; unsigned char* ws = WSP;
    for (int m = gw; m < TALL; m += NGW) rms_row<MODE>(Hres + (size_t)m * DM, g1, (bf16_t*)(ws + o1_off) + (size_t)m * DM, g2, (bf16_t*)(ws + o2_off) + (size_t)m * DM, Hres + (size_t)m * DM, lane);
}
__device__ __forceinline__ void ph_cache_cvt() {
    PH_IDS; const float* cache_k = INF(3); const float* cache_v = INF(4); bf16_t* KALL = (bf16_t*)(BIGP + BIG_KALL); bf16_t* VALL = (bf16_t*)(BIGP + BIG_VALL);
    for (size_t i = gt; i < (size_t)8 * PASTL * 512 / 4; i += NGT) { const size_t e = i * 4, b = e / ((size_t)PASTL * 512), r = e % ((size_t)PASTL * 512);
        const f32x4 kv = *(const f32x4*)(cache_k + e), vv = *(const f32x4*)(cache_v + e); u32x2 w; w.x = pk2(kv.x, kv.y); w.y = pk2(kv.z, kv.w); *(u32x2*)(KALL + b * LKS * 512 + r) = w;
        w.x = pk2(vv.x, vv.y); w.y = pk2(vv.z, vv.w); *(u32x2*)(VALL + b * LKS * 512 + r) = w; }
}
__device__ __forceinline__ void ph_kvfq(LAS unsigned char* lds) {
    unsigned char* ws = WSP; unsigned char* big = ws + WS_BIG; float* out = OUTP;
    pg8::Gemm g{(const bf16_t*)(big + BIG_XN), (const bf16_t*)(ws + WS_WKVF), TALL, 3328, DM, DM}; pg8::StaticOrder S; S.init(TALL, 3328, (int)gridDim.x, (int)blockIdx.x);
    pg8::EpiKVFQ E{out + OUT_KP, out + OUT_VP, out + OUT_LFP, out + OUT_KS, out + OUT_VS, out + OUT_LFS, (bf16_t*)(big + BIG_KB), (bf16_t*)(big + BIG_VB), (bf16_t*)(big + BIG_KALL), (bf16_t*)(big + BIG_VALL),
                    (bf16_t*)(big + BIG_ACT), INF(15), (const float*)(ws + WS_SSQ) + (size_t)1 * TALL};
    pg8::gemm_phase<pg8::EpiKVFQ, pg8::StaticOrder, true, true>(lds, g, S, E);
}
__device__ __forceinline__ void ph_cumsum(LAS unsigned char* lds) {
    PH_IDS; const float* cache_lf = INF(5); const float* out = OUTP; float* FB = (float*)(WSP + WS_FB); float* FS = (float*)(WSP + WS_FS);
    for (int it = blockIdx.x; it < 64 + 128; it += G) {
        LAS float* wtot = (LAS float*)lds;
        const bool smp = it >= 64; const int bh = smp ? it - 64 : it, b = bh >> 4, h = bh & 15, Ls = smp ? LKS : SEQ, per = smp ? 3 : 16, j0 = tid * per;
        float v[16]; float s = 0.f;
#pragma unroll
        for (int i = 0; i < 16; ++i) { const int j = j0 + i; float x = 0.f;
            if (i < per && j < Ls) x = smp ? (j < PASTL ? cache_lf[((size_t)b * PASTL + j) * 16 + h] : out[OUT_LFS + ((size_t)b * 32 + (j - PASTL)) * 16 + h]) : out[OUT_LFP + ((size_t)b * SEQ + j) * 16 + h];
            s += x; v[i] = s; }
        float inc = s;
#pragma unroll
        for (int o = 1; o < 64; o <<= 1) { const float t = __shfl_up(inc, o); if (lane >= o) inc += t; }
        if (lane == 63) wtot[wave] = inc;
        __syncthreads();
        float base = inc - s;
        for (int w = 0; w < wave; ++w) base += wtot[w];
#pragma unroll
        for (int i = 0; i < 16; ++i) { const int j = j0 + i; if (i < per && j < Ls) { const float F = base + v[i];
            if (smp) FS[(size_t)bh * LKS + j] = F; else FB[(size_t)bh * SEQ + j] = -F * 11.313708498984761f; } }
        __syncthreads();
    }
}
__device__ __forceinline__ void ph_attn(unsigned char* lds_raw) {
    unsigned char* ws = WSP; unsigned char* big = ws + WS_BIG;
    fox::attn_phase((char*)lds_raw, (const bf16_t*)(big + BIG_ACT), (const bf16_t*)(big + BIG_KB), (const bf16_t*)(big + BIG_VB), (bf16_t*)(big + BIG_XN), (const float*)(ws + WS_FB));
}
__device__ __forceinline__ void ph_sattn(LAS unsigned char* lds) {
    unsigned char* ws = WSP; unsigned char* big = ws + WS_BIG;
    sample_attn((LAS char*)lds, (const bf16_t*)(big + BIG_ACT), (const bf16_t*)(big + BIG_KALL), (const bf16_t*)(big + BIG_VALL), (const float*)(ws + WS_FS), (bf16_t*)(big + BIG_XN));
}
__device__ __forceinline__ void ph_gateup(LAS unsigned char* lds, const unsigned char* a_ptr, size_t w_off, int ssq_idx) {
    unsigned char* ws = WSP; unsigned char* big = ws + WS_BIG;
    pg8::Gemm g{(const bf16_t*)a_ptr, (const bf16_t*)(ws + w_off), TALL, 2 * DFF, DM, DM}; pg8::StaticOrder S; S.init(TALL, 2 * DFF, (int)gridDim.x, (int)blockIdx.x);
    pg8::EpiSwiglu E{(bf16_t*)(big + BIG_ACT), (const float*)(ws + WS_SSQ) + (size_t)ssq_idx * TALL};
    pg8::gemm_phase<pg8::EpiSwiglu, pg8::StaticOrder, true, true>(lds, g, S, E);
}

__global__ void __launch_bounds__(NWAVES * 64, 2) yoco_fwd(Params P) {
    extern __shared__ __attribute__((aligned(16))) unsigned char lds_raw[];
    cg::grid_group grid = cg::this_grid();
    LAS unsigned char* lds = (LAS unsigned char*)lds_raw;
    volatile LAS unsigned* bst = (volatile LAS unsigned*)(lds + 148480);
    if (opaque_tid() < 2) bst[opaque_tid()] = 0u;
    __syncthreads();
    const XcdBarrier xbar = xcd_barrier_post((unsigned*)(WSP + WS_BAR), bst);
#define GSYNC() xcd_barrier(xbar)
    ph_prologue(lds);                                                                                   grid.sync();
    ph_retin(lds); ph_conv<0>(lds);                                                                                      GSYNC();
    ph_retention(lds);                                                                                  GSYNC();
    ph_groupnorm();                                                                                     GSYNC();
    ph_res_gemm<true>(lds, BIGP + 4096 * 2, WS_WRO, 4096, NPROJ, (bf16_t*)(OUTP + OUT_KP), 0); ph_conv<1>(lds);   GSYNC();
    ph_gateup(lds, (const unsigned char*)(OUTP + OUT_KP), WS_WGU0, 0);                                  GSYNC();
    ph_res_gemm<false>(lds, BIGP + BIG_ACT, WS_WDN0, DFF, DFF, (bf16_t*)(BIGP + BIG_XN), 1); ph_cache_cvt(); ph_conv<2>(lds);   GSYNC();
    ph_kvfq(lds);                                                                                       GSYNC();
    ph_cumsum(lds);                                                                                     GSYNC();
    ph_attn(lds_raw); __syncthreads(); ph_sattn(lds);                                                   GSYNC();
    ph_res_gemm<false, TP>(lds, BIGP + BIG_XN, WS_WO, DM, DM, (bf16_t*)(BIGP + BIG_HKV), 2); ph_sample_res(BIGP + BIG_XN + (size_t)TP * DM * 2, DM, WS_WO, DM, (bf16_t*)(BIGP + BIG_HKV), 2);   GSYNC();
    ph_gateup(lds, BIGP + BIG_HKV, WS_WGU1, 2);                                                         GSYNC();
    ph_res_gemm<false, TP>(lds, BIGP + BIG_ACT, WS_WDN1, DFF, DFF, nullptr, -1); ph_sample_res(BIGP + BIG_ACT + (size_t)TP * DFF * 2, DFF, WS_WDN1, DFF, nullptr, -1);   GSYNC();
    ph_rms<2>(INF(9), 0, nullptr, 0);
}

extern "C" void kernel_launch(void* const* d_in, const int* in_sizes, int n_in, void* d_out, int out_size, void* d_ws, size_t ws_size, hipStream_t stream) {
    static int grid = 0;
    if (grid == 0) {
        if (n_in != 21 || ws_size < WS_END) { fprintf(stderr, "kernel_launch: unexpected n_in %d / ws_size %zu (need %zu)\n", n_in, ws_size, (size_t)WS_END); grid = -1; return; }
        int dev = 0, cus = 0, per_cu = 0;
        (void)hipGetDevice(&dev); (void)hipDeviceGetAttribute(&cus, hipDeviceAttributeMultiprocessorCount, dev);
        if (hipFuncSetAttribute((const void*)yoco_fwd, hipFuncAttributeMaxDynamicSharedMemorySize, LDS_BYTES) != hipSuccess) { fprintf(stderr, "kernel_launch: hipFuncSetAttribute failed\n"); grid = -1; return; }
        if (hipOccupancyMaxActiveBlocksPerMultiprocessor(&per_cu, (const void*)yoco_fwd, NWAVES * 64, LDS_BYTES) != hipSuccess || per_cu < 1) { fprintf(stderr, "kernel_launch: occupancy query says %d\n", per_cu); per_cu = 1; }
        (void)hipGetLastError();
        grid = cus > 0 ? cus : 256;
    }
    if (grid < 0) return;
    if (hipMemsetAsync((char*)d_ws + WS_BAR, 0, XCD_BAR_WORDS * 4, stream) != hipSuccess) { fprintf(stderr, "kernel_launch: memset of the barrier words failed\n"); return; }
    Params p{};
    for (int i = 0; i < 21; ++i) p.in[i] = (const float*)d_in[i];
    p.out = (float*)d_out; p.ws = (unsigned char*)d_ws;
    void* args[] = {&p};
    hipError_t e = hipLaunchCooperativeKernel((const void*)yoco_fwd, dim3(grid), dim3(NWAVES * 64), args, LDS_BYTES, stream);
    if (e != hipSuccess) fprintf(stderr, "cooperative launch failed: %s (grid %d)\n", hipGetErrorString(e), grid);
}
```

```cpp
#include <hip/hip_runtime.h>
#include <hip/hip_cooperative_groups.h>
#include <cstdio>
#include <cstdint>
namespace cg = cooperative_groups;
__device__ __forceinline__ int opaque_tid() { int t = threadIdx.x; asm volatile("" : "+v"(t)); return t; }
namespace pg8 {
#define PG8_LAS __attribute__((address_space(3)))
typedef unsigned short bf16_t;
typedef short bf16x8 __attribute__((ext_vector_type(8)));
typedef float f32x4 __attribute__((ext_vector_type(4)));
typedef unsigned u32x4 __attribute__((ext_vector_type(4)));
constexpr int BM = 256, BK = 64, HALF = 128, HTB = HALF * BK * 2  , STAGE_BYTES = 8 * HTB, NXCD = 8, WGM = 4;

__host__ __device__ __forceinline__ int lds_byte(int r, int c) { const int st = (r >> 4) * 2 + (c >> 5), rr = r & 15, cc = c & 31, ob = rr * 64 + cc * 2; return st * 1024 + (ob ^ (((ob >> 9) & 1) << 5)); }
__host__ __device__ __forceinline__ void stage_rc(int b, int& R, int& C) { const int st = b / 1024, sb = b % 1024, swz = sb ^ (((sb >> 9) & 1) << 5); R = (st >> 1) * 16 + swz / 64; C = (st & 1) * 32 + (swz % 64) / 2; }
__host__ __device__ __forceinline__ int perm32(int rho) { const int n = rho >> 4, i = rho & 15; return 8 * (i >> 2) + 4 * n + (i & 3); }

struct Unit { int pm, pn; };
struct Gemm { const bf16_t* A; const bf16_t* Bt; int M, N, K, lda; };

struct StaticOrder {
    int nM, nN, nwg, G, c;
    __host__ __device__ void init(int M, int N, int G_, int c_) { nM = M / BM; nN = N / BM; nwg = nM * nN; G = G_; c = c_; }
    __host__ __device__ bool next(int i, Unit& u) const {
        const long L = (long)i * G + c; if (L >= nwg) return false;
        int wgid = (int)L; { const int q = nwg / NXCD, r = nwg % NXCD, xcd = wgid % NXCD, off = wgid / NXCD; wgid = (xcd < r ? xcd * (q + 1) : r * (q + 1) + (xcd - r) * q) + off; }
        const int nig = WGM * nN, gid = wgid / nig, fm = gid * WGM, gsz = (nM - fm) < WGM ? (nM - fm) : WGM;
        u.pm = fm + ((wgid % nig) % gsz); u.pn = (wgid % nig) / gsz; return true;
    }
    __device__ __forceinline__ void a_ready(const Unit&) const {}
    __device__ __forceinline__ void done(const Unit&) const {}
};

__device__ __forceinline__ unsigned cvt_pk_bf16(float lo, float hi) { unsigned r; asm volatile("v_cvt_pk_bf16_f32 %0, %1, %2" : "=v"(r) : "v"(lo), "v"(hi)); return r; }
template <class Epi, class Sched, bool ALIGN_EPI = false, bool SP2 = false>
__device__ __forceinline__ void gemm_phase(PG8_LAS unsigned char* lds, const Gemm g, const Sched& S, const Epi& E) {
    const int tid = opaque_tid(), wid = __builtin_amdgcn_readfirstlane(tid >> 6), lane = tid & 63, wr = wid >> 2, wc = wid & 3, fr = lane & 15, fq = lane >> 4;
    const int K = g.K, nt = K / BK;
    unsigned voffA[2], voffB[2];
#pragma unroll
    for (int i = 0; i < 2; ++i) { int R, C; stage_rc(tid * 16 + i * 8192, R, C); const int Rb = Epi::PERM ? ((R & ~31) + perm32(R & 31)) : R;
        voffA[i] = (unsigned)(R * g.lda + C) * 2u; voffB[i] = (unsigned)(Rb * K + C) * 2u; }
    const size_t kstep = (size_t)(BK * 2);
    const size_t hstep = (size_t)HALF * K * 2, hstepA = (size_t)HALF * g.lda * 2;
    const size_t tstep = 2 * hstep, tstepA = 2 * hstepA;
    const unsigned ldsw = (unsigned)wid * 1024u;
    const int aoff = lds_byte(wr * 64 + fr, fq * 8), boff = lds_byte(wc * 32 + fr, fq * 8);
#define PG8_SA(b, h) (((b) * 2 + (h)) * HTB)
#define PG8_SB(b, h) ((4 + (b) * 2 + (h)) * HTB)
#define PG8_STAGE(bufoff, gbase, voff) do { _Pragma("unroll") for (int _i = 0; _i < 2; ++_i) \
        __builtin_amdgcn_global_load_lds((const unsigned*)((const char*)(gbase) + (voff)[_i]), (PG8_LAS unsigned*)(lds + (bufoff) + ldsw + _i * 8192), 16, 0, 0); } while (0)
#define PG8_LDA(dst, b, h) do { _Pragma("unroll") for (int m = 0; m < 4; ++m) _Pragma("unroll") for (int k = 0; k < 2; ++k) dst[m][k] = *(const PG8_LAS bf16x8*)(lds + PG8_SA(b, h) + aoff + m * 2048 + k * 1024); } while (0)
#define PG8_LDB(dst, b, h) do { _Pragma("unroll") for (int n = 0; n < 2; ++n) _Pragma("unroll") for (int k = 0; k < 2; ++k) dst[n][k] = *(const PG8_LAS bf16x8*)(lds + PG8_SB(b, h) + boff + n * 2048 + k * 1024); } while (0)
#define PG8_MMA(ai, bj, At, Bt) do { __builtin_amdgcn_s_setprio(1); _Pragma("unroll") for (int m = 0; m < 4; ++m) _Pragma("unroll") for (int n = 0; n < 2; ++n) _Pragma("unroll") for (int k = 0; k < 2; ++k) \
        acc[ai][bj][m][n] = __builtin_amdgcn_mfma_f32_16x16x32_bf16(Bt[n][k], At[m][k], acc[ai][bj][m][n], 0, 0, 0); __builtin_amdgcn_s_setprio(0); } while (0)
#define PG8_WAIT_V(n) asm volatile("s_waitcnt vmcnt(" #n ")" ::: "memory")
#define PG8_WAIT_L(n) asm volatile("s_waitcnt lgkmcnt(" #n ")" ::: "memory")
#define PG8_BAR __builtin_amdgcn_s_barrier()
#define PG8_SCHED __builtin_amdgcn_sched_barrier(0)
    Unit cur, nxt; int ui = 0;
    if (!S.next(0, cur)) return;
    f32x4 acc[2][2][4][2];
#pragma unroll
    for (int a = 0; a < 2; ++a)
#pragma unroll
        for (int b = 0; b < 2; ++b)
#pragma unroll
            for (int m = 0; m < 4; ++m)
#pragma unroll
                for (int n = 0; n < 2; ++n) acc[a][b][m][n] = (f32x4){0.f, 0.f, 0.f, 0.f};
    bf16x8 At[4][2], B0[2][2], B1[2][2];
    const char* cA = (const char*)g.A + (size_t)cur.pm * tstepA; const char* cB = (const char*)g.Bt + (size_t)cur.pn * tstep;
    S.a_ready(cur);
    if constexpr (SP2) {
        PG8_STAGE(PG8_SB(0, 0), cB, voffB); PG8_STAGE(PG8_SB(0, 1), cB + hstep, voffB); PG8_STAGE(PG8_SA(0, 0), cA, voffA); PG8_STAGE(PG8_SA(0, 1), cA + hstepA, voffA);
        if (wr == 1) PG8_BAR;
        PG8_WAIT_V(2); PG8_BAR;
        PG8_STAGE(PG8_SB(1, 0), cB + kstep, voffB); PG8_STAGE(PG8_SA(1, 0), cA + kstep, voffA); PG8_STAGE(PG8_SB(1, 1), cB + hstep + kstep, voffB);
        PG8_WAIT_V(6); PG8_BAR;
    } else {
        PG8_STAGE(PG8_SB(0, 0), cB, voffB); PG8_STAGE(PG8_SA(0, 0), cA, voffA); PG8_STAGE(PG8_SB(0, 1), cB + hstep, voffB); PG8_STAGE(PG8_SA(0, 1), cA + hstepA, voffA);
        if (wr == 1) PG8_BAR;
        PG8_WAIT_V(4); PG8_BAR;
        PG8_STAGE(PG8_SB(1, 0), cB + kstep, voffB); PG8_STAGE(PG8_SA(1, 0), cA + kstep, voffA); PG8_STAGE(PG8_SB(1, 1), cB + hstep + kstep, voffB);
        PG8_WAIT_V(6); PG8_BAR;
    }
    for (;;) {
        const bool has_next = S.next(ui + 1, nxt);
        const char* nA = has_next ? (const char*)g.A + (size_t)nxt.pm * tstepA : cA; const char* nB = has_next ? (const char*)g.Bt + (size_t)nxt.pn * tstep : cB;
        for (int t = 0; t < nt; t += 2) {
            const bool last = (t == nt - 2);
            const char* a1 = cA + (size_t)(t + 1) * kstep;
            const char* a2 = last ? nA : cA + (size_t)(t + 2) * kstep; const char* b2 = last ? nB : cB + (size_t)(t + 2) * kstep;
            const char* a3 = a2 + kstep; const char* b3 = b2 + kstep;
            if (last && has_next) S.a_ready(nxt);
            if constexpr (SP2) {
            PG8_LDB(B0, 0, 0); PG8_LDB(B1, 0, 1); PG8_SCHED; PG8_LDA(At, 0, 0); PG8_STAGE(PG8_SA(1, 1), a1 + hstepA, voffA);
            PG8_WAIT_V(8); PG8_WAIT_L(0); PG8_BAR; PG8_MMA(0, 0, At, B0); PG8_MMA(0, 1, At, B1); PG8_BAR; PG8_SCHED;
            PG8_LDA(At, 0, 1); PG8_STAGE(PG8_SB(0, 0), b2, voffB); PG8_STAGE(PG8_SB(0, 1), b2 + hstep, voffB); PG8_STAGE(PG8_SA(0, 0), a2, voffA);
            PG8_WAIT_V(8); PG8_WAIT_L(0); PG8_BAR; PG8_MMA(1, 0, At, B0); PG8_MMA(1, 1, At, B1); PG8_BAR; PG8_SCHED;
            PG8_LDB(B0, 1, 0); PG8_LDB(B1, 1, 1); PG8_SCHED; PG8_LDA(At, 1, 0); PG8_STAGE(PG8_SA(0, 1), a2 + hstepA, voffA);
            PG8_WAIT_V(8); PG8_WAIT_L(0); PG8_BAR; PG8_MMA(0, 0, At, B0); PG8_MMA(0, 1, At, B1); PG8_BAR; PG8_SCHED;
            PG8_LDA(At, 1, 1); PG8_STAGE(PG8_SB(1, 0), b3, voffB); PG8_STAGE(PG8_SB(1, 1), b3 + hstep, voffB); PG8_STAGE(PG8_SA(1, 0), a3, voffA);
            PG8_WAIT_V(8); PG8_WAIT_L(0); PG8_BAR; PG8_MMA(1, 0, At, B0); PG8_MMA(1, 1, At, B1); PG8_BAR; PG8_SCHED;
            } else {
            PG8_LDB(B0, 0, 0); PG8_SCHED; PG8_LDA(At, 0, 0); PG8_STAGE(PG8_SA(1, 1), a1 + hstepA, voffA);
            PG8_WAIT_L(8); PG8_BAR; PG8_WAIT_L(0); PG8_MMA(0, 0, At, B0); PG8_BAR; PG8_SCHED;
            PG8_LDB(B1, 0, 1); PG8_STAGE(PG8_SB(0, 0), b2, voffB);
            PG8_BAR; PG8_WAIT_L(0); PG8_MMA(0, 1, At, B1); PG8_BAR;
            PG8_LDA(At, 0, 1); PG8_STAGE(PG8_SA(0, 0), a2, voffA);
            PG8_BAR; PG8_WAIT_L(0); PG8_MMA(1, 0, At, B0); PG8_BAR; PG8_SCHED;
            PG8_STAGE(PG8_SB(0, 1), b2 + hstep, voffB);
            PG8_WAIT_V(6); PG8_BAR; PG8_MMA(1, 1, At, B1); PG8_BAR;
            PG8_LDB(B0, 1, 0); PG8_SCHED; PG8_LDA(At, 1, 0); PG8_STAGE(PG8_SA(0, 1), a2 + hstepA, voffA);
            PG8_WAIT_L(8); PG8_BAR; PG8_WAIT_L(0); PG8_MMA(0, 0, At, B0); PG8_BAR; PG8_SCHED;
            PG8_LDB(B1, 1, 1); PG8_STAGE(PG8_SB(1, 0), b3, voffB);
            PG8_BAR; PG8_WAIT_L(0); PG8_MMA(0, 1, At, B1); PG8_BAR;
            PG8_LDA(At, 1, 1); PG8_STAGE(PG8_SA(1, 0), a3, voffA);
            PG8_BAR; PG8_WAIT_L(0); PG8_MMA(1, 0, At, B0); PG8_BAR; PG8_SCHED;
            PG8_STAGE(PG8_SB(1, 1), b3 + hstep, voffB);
            PG8_WAIT_V(6); PG8_BAR; PG8_MMA(1, 1, At, B1); PG8_BAR;
            }
        }
        if constexpr (ALIGN_EPI) { if (wr == 0) PG8_BAR; }
        if constexpr (!Epi::AFTER_DRAIN) { E(acc, cur, wr, wc, fr, fq); S.done(cur); }
        if (!has_next) break;
#pragma unroll
        for (int a = 0; a < 2; ++a)
#pragma unroll
            for (int b = 0; b < 2; ++b)
#pragma unroll
                for (int m = 0; m < 4; ++m)
#pragma unroll
                    for (int n = 0; n < 2; ++n) acc[a][b][m][n] = (f32x4){0.f, 0.f, 0.f, 0.f};
        cur = nxt; cA = nA; cB = nB; ++ui;
        if constexpr (ALIGN_EPI) { if (wr == 1) PG8_BAR; }
    }
    PG8_WAIT_V(0);
    if constexpr (!ALIGN_EPI) { if (wr == 0) PG8_BAR; }
    PG8_BAR;
    if constexpr (Epi::AFTER_DRAIN) { E.fused(acc, cur, wr, wc, fr, fq, lds, wid, lane); S.done(cur); }
#undef PG8_SA
#undef PG8_SB
#undef PG8_STAGE
#undef PG8_LDA
#undef PG8_LDB
#undef PG8_MMA
#undef PG8_WAIT_V
#undef PG8_WAIT_L
#undef PG8_BAR
#undef PG8_SCHED
}
}
constexpr int DM = 2048, TP = 32768, TSMP = 256, TALL = 33024, SEQ = 8192, NPROJ = 12288, DFF = 5632, PASTL = 1024, LKS = 1056;
#define GAS __attribute__((address_space(1)))
#define LAS __attribute__((address_space(3)))
typedef unsigned short bf16_t;
typedef float f32x4 __attribute__((ext_vector_type(4)));
typedef unsigned u32x4 __attribute__((ext_vector_type(4)));
typedef unsigned u32x2 __attribute__((ext_vector_type(2)));
typedef short bf16x8 __attribute__((ext_vector_type(8)));
typedef short s16x4 __attribute__((ext_vector_type(4)));

namespace pg8 {
__device__ __forceinline__ float silu_f(float g) { return g * __builtin_amdgcn_rcpf(1.0f + __builtin_amdgcn_exp2f(-1.4426950408889634f * g)); }
struct EpiBf16P {
    static constexpr bool PERM = true, AFTER_DRAIN = false;
    bf16_t* O; int ldc;
    __device__ __forceinline__ void operator()(const f32x4 (&acc)[2][2][4][2], const Unit& u, int wr, int wc, int fr, int fq) const {
        const int row0 = u.pm * BM + wr * 64 + fr, col0 = u.pn * BM + wc * 32 + 8 * fq;
#pragma unroll
        for (int ai = 0; ai < 2; ++ai)
#pragma unroll
            for (int m = 0; m < 4; ++m) { bf16_t* rowp = O + (size_t)(row0 + ai * HALF + m * 16) * ldc + col0;
#pragma unroll
                for (int bj = 0; bj < 2; ++bj) { const f32x4 v0 = acc[ai][bj][m][0], v1 = acc[ai][bj][m][1];
                    u32x4 w; w.x = cvt_pk_bf16(v0[0], v0[1]); w.y = cvt_pk_bf16(v0[2], v0[3]); w.z = cvt_pk_bf16(v1[0], v1[1]); w.w = cvt_pk_bf16(v1[2], v1[3]);
                    *(u32x4*)(rowp + bj * HALF) = w; } }
    }
};
struct EpiRetIn {
    static constexpr bool PERM = true, AFTER_DRAIN = false;
    bf16_t* O; const float* cosT; const float* sinT;
    __device__ __forceinline__ void operator()(const f32x4 (&acc)[2][2][4][2], const Unit& u, int wr, int wc, int fr, int fq) const {
        const int row0 = u.pm * BM + wr * 64 + fr, cl = wc * 32 + 8 * fq;
        bf16_t* obase = O + (size_t)u.pn * BM + cl;
        if (u.pn < 16) {
            const bool isk = u.pn >= 8; const int h = u.pn & 7;
            const float lg2 = __log2f(1.0f - exp2f(-5.0f - (float)h));
#pragma unroll
            for (int ai = 0; ai < 2; ++ai) {
                f32x4 cs[4][4]; float scv[4];
#pragma unroll
                for (int m = 0; m < 4; ++m) {
                    const int row = row0 + ai * HALF + m * 16; int pos, l;
                    if (row < TP) { pos = row & (SEQ - 1); l = row & 63; } else { const int s = (row - TP) & 31; pos = PASTL + s; l = s; }
                    scv[m] = isk ? exp2f(-lg2 * (float)l) * 0.0625f : exp2f(lg2 * (float)l);
                    const float* cp = cosT + (size_t)pos * 128 + cl; const float* sp = sinT + (size_t)pos * 128 + cl;
                    cs[m][0] = *(const f32x4*)cp; cs[m][1] = *(const f32x4*)(cp + 4); cs[m][2] = *(const f32x4*)sp; cs[m][3] = *(const f32x4*)(sp + 4); }
#pragma unroll
                for (int m = 0; m < 4; ++m) {
                    const int row = row0 + ai * HALF + m * 16; const float sc = scv[m];
                    const f32x4 c0 = cs[m][0], c1 = cs[m][1], s0 = cs[m][2], s1 = cs[m][3];
                    const f32x4 x1a = acc[ai][0][m][0], x1b = acc[ai][0][m][1], x2a = acc[ai][1][m][0], x2b = acc[ai][1][m][1];
                    const f32x4 o1a = (x1a * c0 - x2a * s0) * sc, o1b = (x1b * c1 - x2b * s1) * sc, o2a = (x1a * s0 + x2a * c0) * sc, o2b = (x1b * s1 + x2b * c1) * sc;
                    bf16_t* rowp = obase + (size_t)row * NPROJ;
                    u32x4 w; w.x = cvt_pk_bf16(o1a[0], o1a[1]); w.y = cvt_pk_bf16(o1a[2], o1a[3]); w.z = cvt_pk_bf16(o1b[0], o1b[1]); w.w = cvt_pk_bf16(o1b[2], o1b[3]);
                    *(u32x4*)rowp = w;
                    w.x = cvt_pk_bf16(o2a[0], o2a[1]); w.y = cvt_pk_bf16(o2a[2], o2a[3]); w.z = cvt_pk_bf16(o2b[0], o2b[1]); w.w = cvt_pk_bf16(o2b[2], o2b[3]);
                    *(u32x4*)(rowp + HALF) = w; }
                asm volatile("" ::: "memory"); }
        } else {
#pragma unroll
            for (int ai = 0; ai < 2; ++ai)
#pragma unroll
                for (int m = 0; m < 4; ++m) { bf16_t* rowp = obase + (size_t)(row0 + ai * HALF + m * 16) * NPROJ;
#pragma unroll
                    for (int bj = 0; bj < 2; ++bj) { const f32x4 v0 = acc[ai][bj][m][0], v1 = acc[ai][bj][m][1];
                        u32x4 w; w.x = cvt_pk_bf16(v0[0], v0[1]); w.y = cvt_pk_bf16(v0[2], v0[3]); w.z = cvt_pk_bf16(v1[0], v1[1]); w.w = cvt_pk_bf16(v1[2], v1[3]);
                        *(u32x4*)(rowp + bj * HALF) = w; } }
        }
    }
};
struct EpiRes {
    static constexpr bool PERM = false, AFTER_DRAIN = false;
    const float* baseP; const float* baseS; float* out; bf16_t* hb; float* ssq;
    __device__ __forceinline__ void operator()(const f32x4 (&acc)[2][2][4][2], const Unit& u, int wr, int wc, int fr, int fq) const {
        const int row0 = u.pm * BM + wr * 64 + fr, col0 = u.pn * BM + wc * 32 + 4 * fq;
#pragma unroll
        for (int ai = 0; ai < 2; ++ai) {
            f32x4 bv[4][2][2];
#pragma unroll
            for (int m = 0; m < 4; ++m) { const int row = row0 + ai * HALF + m * 16;
                const float* b = (row < TP ? baseP + (size_t)row * DM : baseS + (size_t)(row - TP) * DM) + col0;
#pragma unroll
                for (int bj = 0; bj < 2; ++bj)
#pragma unroll
                    for (int n = 0; n < 2; ++n) bv[m][bj][n] = *(const f32x4*)(b + bj * HALF + n * 16); }
#pragma unroll
            for (int m = 0; m < 4; ++m) { const int row = row0 + ai * HALF + m * 16; float* o = out + (size_t)row * DM + col0; float ss = 0.f;
#pragma unroll
                for (int bj = 0; bj < 2; ++bj)
#pragma unroll
                    for (int n = 0; n < 2; ++n) { const f32x4 v = bv[m][bj][n] + acc[ai][bj][m][n]; *(f32x4*)(o + bj * HALF + n * 16) = v;
                        if (hb) { u32x2 w; w.x = cvt_pk_bf16(v[0], v[1]); w.y = cvt_pk_bf16(v[2], v[3]); *(u32x2*)(hb + (size_t)row * DM + col0 + bj * HALF + n * 16) = w; }
                        ss += (v[0] * v[0] + v[1] * v[1]) + (v[2] * v[2] + v[3] * v[3]); }
                if (ssq) { ss += __shfl_xor(ss, 16); ss += __shfl_xor(ss, 32);
                    if (fq == 0) (void)__hip_atomic_fetch_add(ssq + row, ss, __ATOMIC_RELAXED, __HIP_MEMORY_SCOPE_AGENT); } }
            asm volatile("" ::: "memory"); }
    }
};
struct EpiSwiglu {
    static constexpr bool PERM = true, AFTER_DRAIN = false;
    bf16_t* O; const float* ssq;
    __device__ __forceinline__ void operator()(const f32x4 (&acc)[2][2][4][2], const Unit& u, int wr, int wc, int fr, int fq) const {
        const int row0 = u.pm * BM + wr * 64 + fr, col0 = u.pn * HALF + wc * 32 + 8 * fq;
        float rs[2][4];
#pragma unroll
        for (int ai = 0; ai < 2; ++ai)
#pragma unroll
            for (int m = 0; m < 4; ++m) rs[ai][m] = ssq[row0 + ai * HALF + m * 16];
#pragma unroll
        for (int ai = 0; ai < 2; ++ai)
#pragma unroll
            for (int m = 0; m < 4; ++m) { bf16_t* rowp = O + (size_t)(row0 + ai * HALF + m * 16) * DFF + col0; const float r = 1.0f / sqrtf(rs[ai][m] * (1.f / DM) + 1e-6f);
                const f32x4 g0 = acc[ai][0][m][0] * r, g1 = acc[ai][0][m][1] * r, u0 = acc[ai][1][m][0] * r, u1 = acc[ai][1][m][1] * r;
                f32x4 a0, a1;
#pragma unroll
                for (int j = 0; j < 4; ++j) { a0[j] = silu_f(g0[j]) * u0[j]; a1[j] = silu_f(g1[j]) * u1[j]; }
                u32x4 w; w.x = cvt_pk_bf16(a0[0], a0[1]); w.y = cvt_pk_bf16(a0[2], a0[3]); w.z = cvt_pk_bf16(a1[0], a1[1]); w.w = cvt_pk_bf16(a1[2], a1[3]);
                *(u32x4*)rowp = w; }
    }
};
struct EpiKVFQ {
    static constexpr bool PERM = false, AFTER_DRAIN = false;
    float* kP; float* vP; float* lfP; float* kS; float* vS; float* lfS; bf16_t* KB; bf16_t* VB; bf16_t* KALL; bf16_t* VALL; bf16_t* QB; const float* bf; const float* ssq;
    __device__ __forceinline__ void operator()(const f32x4 (&acc)[2][2][4][2], const Unit& u, int wr, int wc, int fr, int fq) const {
        const int row0 = u.pm * BM + wr * 64 + fr;
        float rs[2][4];
#pragma unroll
        for (int ai = 0; ai < 2; ++ai)
#pragma unroll
            for (int m = 0; m < 4; ++m) rs[ai][m] = 1.0f / sqrtf(ssq[row0 + ai * HALF + m * 16] * (1.f / DM) + 1e-6f);
        if (u.pn >= 5) {
            const int col0 = (u.pn - 5) * BM + wc * 32 + 4 * fq;
#pragma unroll
            for (int ai = 0; ai < 2; ++ai)
#pragma unroll
                for (int m = 0; m < 4; ++m) { bf16_t* bo = QB + (size_t)(row0 + ai * HALF + m * 16) * DM + col0;
#pragma unroll
                    for (int bj = 0; bj < 2; ++bj)
#pragma unroll
                        for (int n = 0; n < 2; ++n) { const f32x4 v = acc[ai][bj][m][n] * rs[ai][m]; u32x2 w; w.x = cvt_pk_bf16(v[0], v[1]); w.y = cvt_pk_bf16(v[2], v[3]); *(u32x2*)(bo + bj * HALF + n * 16) = w; } }
        } else if (u.pn < 4) {
            const bool isv = u.pn >= 2; const int col0 = (u.pn & 1) * BM + wc * 32 + 4 * fq;
            float* fP = isv ? vP : kP; float* fS = isv ? vS : kS; bf16_t* bP = isv ? VB : KB; bf16_t* bA = isv ? VALL : KALL;
#pragma unroll
            for (int ai = 0; ai < 2; ++ai)
#pragma unroll
                for (int m = 0; m < 4; ++m) { const int row = row0 + ai * HALF + m * 16; float* fo; bf16_t* bo;
                    if (row < TP) { fo = fP + (size_t)row * 512 + col0; bo = bP + (size_t)row * 512 + col0; }
                    else { const int r2 = row - TP; fo = fS + (size_t)r2 * 512 + col0; bo = bA + ((size_t)(r2 >> 5) * LKS + PASTL + (r2 & 31)) * 512 + col0; }
#pragma unroll
                    for (int bj = 0; bj < 2; ++bj)
#pragma unroll
                        for (int n = 0; n < 2; ++n) { const f32x4 v = acc[ai][bj][m][n] * rs[ai][m]; *(f32x4*)(fo + bj * HALF + n * 16) = v;
                            u32x2 w; w.x = cvt_pk_bf16(v[0], v[1]); w.y = cvt_pk_bf16(v[2], v[3]); *(u32x2*)(bo + bj * HALF + n * 16) = w; } }
        } else if (wc == 0) {
            const f32x4 bb = *(const f32x4*)(bf + 4 * fq);
#pragma unroll
            for (int ai = 0; ai < 2; ++ai)
#pragma unroll
                for (int m = 0; m < 4; ++m) { const int row = row0 + ai * HALF + m * 16; const f32x4 z = acc[ai][0][m][0] * rs[ai][m] + bb; f32x4 r;
#pragma unroll
                    for (int j = 0; j < 4; ++j) r[j] = fminf(z[j], 0.f) - log1pf(__expf(-fabsf(z[j])));
                    float* o = row < TP ? lfP + (size_t)row * 16 : lfS + (size_t)(row - TP) * 16; *(f32x4*)(o + 4 * fq) = r; }
        }
    }
};
}
namespace fox {
enum { ORDER_NATURAL = 0, ORDER_REVERSED = 1, ORDER_PAIRED = 2, ORDER_XCD = 4 };
constexpr int D = 128, QS = 2048, KS = 512, OS = 2048;
constexpr float THR = 8.f;
constexpr bool WSKIP = false;
constexpr float SCALE = 0.08838834764831845f;
constexpr int NW = 8, QBLK = 32, KVBLK = 64, QB = NW * QBLK;
constexpr int SHM_V = KVBLK * D * 2, SHM_K = KVBLK * D * 2;
constexpr int LDS_BYTES = 2 * SHM_V + 2 * SHM_K + NW * 64 * 4 + 2 * 64 * 4;
typedef unsigned short bf16;
typedef short bf16x8 __attribute__((ext_vector_type(8)));
typedef short s16x4 __attribute__((ext_vector_type(4)));
typedef float f32x16 __attribute__((ext_vector_type(16)));
typedef float f32x4 __attribute__((ext_vector_type(4)));
typedef unsigned u32x4 __attribute__((ext_vector_type(4)));
template <class A, class Bt> struct same_t { static constexpr bool v = false; };
template <class A> struct same_t<A, A> { static constexpr bool v = true; };

#define KSWZ(row, colB) ((row) * 256 + ((colB) ^ (((row) & 7) << 4)))
#define SBAR() __builtin_amdgcn_sched_barrier(0)
__device__ __forceinline__ int v_st(int k, int c) { const int kk = (k & ~0xC) | ((k & 4) << 1) | ((k & 8) >> 1); return ((kk >> 3) * 4 + (c >> 5)) * 512 + ((kk & 7) * 32 + (c & 31)) * 2; }
__device__ __forceinline__ int v_rd_base(int lane) { return ((lane & 3) << 3) | (((lane >> 2) & 3) << 6) | (((lane >> 4) & 1) << 5) | (((lane >> 5) & 1) << 8); }
constexpr int v_rd_off(int d0, int ks, int half) { return d0 * 512 + ks * 4096 + half * 2048; }
__device__ __forceinline__ int crow(int r, int hi) { return (r & 3) + 8 * (r >> 2) + 4 * hi; }
__device__ __forceinline__ unsigned cvtpk(float lo, float hi) {
    unsigned r; asm volatile("v_cvt_pk_bf16_f32 %0, %1, %2" : "=v"(r) : "v"(lo), "v"(hi)); return r;
}
__device__ __forceinline__ bf16x8 pack8(f32x4 a, f32x4 b) {
    u32x4 w = {cvtpk(a[0], a[1]), cvtpk(a[2], a[3]), cvtpk(b[0], b[1]), cvtpk(b[2], b[3])};
    return *reinterpret_cast<bf16x8*>(&w);
}
template <class T> __device__ __forceinline__ bf16x8 load8(const T* p) {
    if constexpr (same_t<T, float>::v) { return pack8(*(const f32x4*)p, *(const f32x4*)(p + 4)); }
    else { return *reinterpret_cast<const bf16x8*>(p); }
}
__device__ __forceinline__ void mask_tile(f32x16& p0, f32x16& p1, int dq, unsigned W) {
    const float NEG = -__builtin_inff();
#pragma unroll
    for (int r = 0; r < 16; ++r) {
        const int c = (r & 3) + 8 * (r >> 2);
        if ((unsigned)(dq - c) >= W) p0[r] = NEG;
        if ((unsigned)(dq - c - 32) >= W) p1[r] = NEG;
    }
}
__device__ __forceinline__ void partialSM(f32x16& p0, f32x16& p1, float& m_reg, float& mn, float& alpha) {
    float pmax = p0[0]; for (int r = 1; r < 16; ++r) pmax = fmaxf(pmax, p0[r]); for (int r = 0; r < 16; ++r) pmax = fmaxf(pmax, p1[r]);
    { auto rr = __builtin_amdgcn_permlane32_swap(__float_as_uint(pmax), __float_as_uint(pmax), false, false);
      pmax = fmaxf(__uint_as_float(rr[0]), __uint_as_float(rr[1])); }
    constexpr float C2 = 1.4426950408889634f * SCALE;
    if (__builtin_expect(__all((pmax - m_reg) * SCALE <= THR), 1)) { mn = m_reg; alpha = 1.f; }
    else { mn = fmaxf(m_reg, pmax); alpha = __builtin_amdgcn_exp2f((m_reg - mn) * C2); m_reg = mn; }
    const float mnL = -mn * C2;
    for (int r = 0; r < 16; ++r) p0[r] = fmaf(p0[r], C2, mnL); for (int r = 0; r < 16; ++r) p1[r] = fmaf(p1[r], C2, mnL);
    for (int r = 0; r < 16; ++r) p0[r] = __builtin_amdgcn_exp2f(p0[r]);
}
__device__ __forceinline__ void finishSM(f32x16& p0, f32x16& p1, float alpha, float& l_reg, bf16x8& pa0, bf16x8& pa1, bf16x8& pa2, bf16x8& pa3) {
    for (int r = 0; r < 16; ++r) p1[r] = __builtin_amdgcn_exp2f(p1[r]);
    float ps = 0; for (int r = 0; r < 16; ++r) ps += p0[r]; for (int r = 0; r < 16; ++r) ps += p1[r];
    { auto rr = __builtin_amdgcn_permlane32_swap(__float_as_uint(ps), __float_as_uint(ps), false, false);
      ps = __uint_as_float(rr[0]) + __uint_as_float(rr[1]); }
    l_reg = l_reg * alpha + ps;
#define PK4(P, B_, OUT) do { unsigned a0 = cvtpk(P[B_+0], P[B_+1]), a1 = cvtpk(P[B_+2], P[B_+3]);                          \
        unsigned b0 = cvtpk(P[B_+4], P[B_+5]), b1 = cvtpk(P[B_+6], P[B_+7]);                                             \
        auto r0 = __builtin_amdgcn_permlane32_swap(a0, b0, false, false); auto r1 = __builtin_amdgcn_permlane32_swap(a1, b1, false, false); \
        u32x4 w = {r0[0], r1[0], r0[1], r1[1]}; OUT = *reinterpret_cast<bf16x8*>(&w); } while (0)
    PK4(p0, 0, pa0); PK4(p0, 8, pa1); PK4(p1, 0, pa2); PK4(p1, 8, pa3);
#undef PK4
}
template <int KB, bool SK>
__device__ __forceinline__ void qkt(f32x16& p0, f32x16& p1, const char* K_lds, int r32, int hi, const bf16x8* qr, bool act) {
    if (SK && !act) { const float NEG = -__builtin_inff();
#pragma unroll
        for (int r = 0; r < 16; ++r) { p0[r] = NEG; p1[r] = NEG; } return; }
    { const float* bb_ = (const float*)(K_lds + 2 * SHM_K + NW * 64 * 4) + KB * 64 + 4 * hi;
#pragma unroll
      for (int q_ = 0; q_ < 4; ++q_) { const f32x4 b0_ = *(const f32x4*)(bb_ + 8 * q_), b1_ = *(const f32x4*)(bb_ + 32 + 8 * q_);
#pragma unroll
        for (int i_ = 0; i_ < 4; ++i_) { p0[4 * q_ + i_] = b0_[i_]; p1[4 * q_ + i_] = b1_[i_]; } } }
    const char* kb[4];
#pragma unroll
    for (int dd = 0; dd < 4; ++dd) kb[dd] = K_lds + KB * SHM_K + KSWZ(r32, (dd * 16 + hi * 8) * 2);
#pragma unroll
    for (int d0 = 0; d0 < 8; ++d0) { const char* a = kb[d0 & 3] + (d0 >> 2) * 128;
        bf16x8 b0 = *reinterpret_cast<const bf16x8*>(a);
        bf16x8 b1 = *reinterpret_cast<const bf16x8*>(a + 32 * 256);
        p0 = __builtin_amdgcn_mfma_f32_32x32x16_bf16(b0, qr[d0], p0, 0, 0, 0);
        p1 = __builtin_amdgcn_mfma_f32_32x32x16_bf16(b1, qr[d0], p1, 0, 0, 0); }
}
template <int VB, bool SK>
__device__ __forceinline__ void pv_tile(f32x16* o, int vb0, bf16x8 pa0, bf16x8 pa1, bf16x8 pa2, bf16x8 pa3, bool act) {
    if (SK && !act) return;
#define TRRD(dst, off) asm volatile("ds_read_b64_tr_b16 %0, %1 offset:%2" : "=&v"(dst) : "v"(vb0), "i"(off) : "memory")
#define PV_D0(d0) do { s16x4 l0, l1, l2, l3, h0, h1, h2, h3; constexpr int b_ = VB * SHM_V + v_rd_off(d0, 0, 0);     \
        TRRD(l0, b_); TRRD(h0, b_ + 2048); TRRD(l1, b_ + 4096); TRRD(h1, b_ + 6144); TRRD(l2, b_ + 8192); TRRD(h2, b_ + 10240); TRRD(l3, b_ + 12288); TRRD(h3, b_ + 14336); \
        asm volatile("s_waitcnt lgkmcnt(0)" ::: "memory"); SBAR();                 \
        o[d0] = __builtin_amdgcn_mfma_f32_32x32x16_bf16(pa0, (bf16x8){l0[0], l0[1], l0[2], l0[3], h0[0], h0[1], h0[2], h0[3]}, o[d0], 0, 0, 0);   \
        o[d0] = __builtin_amdgcn_mfma_f32_32x32x16_bf16(pa1, (bf16x8){l1[0], l1[1], l1[2], l1[3], h1[0], h1[1], h1[2], h1[3]}, o[d0], 0, 0, 0);   \
        o[d0] = __builtin_amdgcn_mfma_f32_32x32x16_bf16(pa2, (bf16x8){l2[0], l2[1], l2[2], l2[3], h2[0], h2[1], h2[2], h2[3]}, o[d0], 0, 0, 0);   \
        o[d0] = __builtin_amdgcn_mfma_f32_32x32x16_bf16(pa3, (bf16x8){l3[0], l3[1], l3[2], l3[3], h3[0], h3[1], h3[2], h3[3]}, o[d0], 0, 0, 0); } while (0)
    PV_D0(0); PV_D0(1); PV_D0(2); PV_D0(3);
#undef PV_D0
#undef TRRD
}
template <class TIn, class TOut> struct BlockRef { const TIn* Q; const TIn* K; const TIn* V; TOut* O; const float* FB; int P0; };
template <class TIn> struct Seam {
    bf16x8 qr[8];
    bf16x8 st_v0, st_v1, st_k0, st_k1; float st_f; f32x4 sf0, sf1, sf2, sf3;
    f32x4 tq[16];
};
__device__ __forceinline__ int swa_jlo(int P0, int W) { const int lowk = P0 - W + 1; return lowk > 0 ? lowk / KVBLK : 0; }
#define ROW(p, k0, rr) ((p) + (size_t)((k0) + (rr)) * KS + sc)
#define VMW() asm volatile("s_waitcnt vmcnt(0)" ::: "memory")
#define VMWN(n) asm volatile("s_waitcnt vmcnt(%0)" :: "i"(n) : "memory")
#define SLOAD_H(Kp, Vp, Fp, k0) do { S.st_f = (Fp)[(k0) + (tid & 63)]; S.st_v0 = load8<TIn>(ROW(Vp, k0, sr)); S.st_v1 = load8<TIn>(ROW(Vp, k0, 32 + sr));              \
                         S.st_k0 = load8<TIn>(ROW(Kp, k0, sr)); S.st_k1 = load8<TIn>(ROW(Kp, k0, 32 + sr)); } while (0)
#define SWRITE_HK(bf) do { ((float*)(K_lds + 2 * SHM_K + NW * 64 * 4))[(bf) * 64 + (tid & 63)] = S.st_f; *(bf16x8*)(K_lds + (bf) * SHM_K + kws) = S.st_k0; *(bf16x8*)(K_lds + (bf) * SHM_K + kws + 32 * 256) = S.st_k1; } while (0)
#define SWRITE_HV(bf) do { *(bf16x8*)(V_lds + (bf) * SHM_V + vst0) = S.st_v0; *(bf16x8*)(V_lds + (bf) * SHM_V + vst1) = S.st_v1; } while (0)
#define SWRITE_H(bf) do { SWRITE_HV(bf); SWRITE_HK(bf); } while (0)
#define SLOAD_F(p, k0) do { S.sf0 = *(const f32x4*)ROW(p, k0, sr); S.sf1 = *(const f32x4*)(ROW(p, k0, sr) + 4);                \
                            S.sf2 = *(const f32x4*)ROW(p, k0, 32 + sr); S.sf3 = *(const f32x4*)(ROW(p, k0, 32 + sr) + 4); } while (0)
#define SWRITE_KF(bf) do { *(bf16x8*)(K_lds + (bf) * SHM_K + kws) = pack8(S.sf0, S.sf1); *(bf16x8*)(K_lds + (bf) * SHM_K + kws + 32 * 256) = pack8(S.sf2, S.sf3); } while (0)
#define SWRITE_VF(bf) do { *(bf16x8*)(V_lds + (bf) * SHM_V + vst0) = pack8(S.sf0, S.sf1); *(bf16x8*)(V_lds + (bf) * SHM_V + vst1) = pack8(S.sf2, S.sf3); } while (0)
template <class TIn, class TOut>
__device__ __forceinline__ void causal_swa_prime(const BlockRef<TIn, TOut>& cur, int W, char* lds, Seam<TIn>& S) {
    constexpr bool F32 = same_t<TIn, float>::v;
    const int tid = opaque_tid(), wid = __builtin_amdgcn_readfirstlane(tid >> 6), lane = tid & 63, r32 = lane & 31, hi = lane >> 5;
    const int sr = tid >> 4, sc = (tid & 15) * 8, kws = KSWZ(sr, sc * 2); char* K_lds = lds + 2 * SHM_V;
    const int kb0 = swa_jlo(cur.P0, W) * KVBLK;
    for (int d0 = 0; d0 < 8; ++d0) S.qr[d0] = load8<TIn>(cur.Q + (size_t)(wid * QBLK + r32) * QS + d0 * 16 + hi * 8);
    if constexpr (F32) { SLOAD_F((const float*)cur.K, kb0); VMW(); SWRITE_KF(0); SBAR(); SLOAD_F((const float*)cur.V, kb0); }
    else { SLOAD_H(cur.K, cur.V, cur.FB, kb0); VMW(); SWRITE_HK(0); }
    __syncthreads();
}
template <class TIn, class TOut>
__device__ __forceinline__ void causal_swa_block(const BlockRef<TIn, TOut>& cur, const BlockRef<TIn, TOut>& nxt, int skv, int W, char* lds, Seam<TIn>& S) {
    constexpr bool F32 = same_t<TIn, float>::v;
    const int tid = opaque_tid(), wid = __builtin_amdgcn_readfirstlane(tid >> 6), lane = tid & 63, r32 = lane & 31, hi = lane >> 5;
    const int j_lo = swa_jlo(cur.P0, W);
    int j_hi = (cur.P0 + QB - 1) / KVBLK + 1; if (j_hi > skv / KVBLK) j_hi = skv / KVBLK;
    const int NT = j_hi - j_lo;
    const int kbn = swa_jlo(nxt.P0, W) * KVBLK;
    const int qlo = cur.P0 + wid * QBLK, qm = qlo + r32 - 4 * hi;
    char* V_lds = lds; char* K_lds = lds + 2 * SHM_V;
    float* ws = (float*)(lds + 2 * SHM_V + 2 * SHM_K) + wid * 64; float* li_l = ws, * al_l = ws + 32;
    float m_reg = -1e30f, l_reg = 0; f32x16 o[4] = {};
    const int sr = tid >> 4, sc = (tid & 15) * 8, vst0 = v_st(sr, sc), vst1 = v_st(32 + sr, sc), kws = KSWZ(sr, sc * 2);
    const int vb0 = (int)(uintptr_t)V_lds + v_rd_base(lane);
    const TIn* Kh = cur.K; const TIn* Vh = cur.V;
#define RESC(a) do { if (__any((a) < 1.f)) { if (hi == 0) al_l[r32] = (a); asm volatile("s_waitcnt lgkmcnt(0)" ::: "memory");              \
                     for (int d_ = 0; d_ < 4; ++d_) for (int r = 0; r < 16; ++r) o[d_][r] *= al_l[crow(r, hi)]; } } while (0)
#define KBASE(t) ((j_lo + (t)) * KVBLK)
#define ACT(t) (KBASE(t) <= qlo + QBLK - 1 && KBASE(t) + KVBLK - 1 >= qlo - W + 1)
#define MASKT(P0_, P1_, t) do { const int kb_ = KBASE(t); if ((!SK || ACT(t)) && (kb_ + KVBLK - 1 > qlo || kb_ <= qlo + QBLK - 1 - W)) mask_tile(P0_, P1_, qm - kb_, (unsigned)W); } while (0)
    constexpr int NQL = F32 ? 16 : 8;
    constexpr bool SK = WSKIP && !F32;
#define SEAM_K0() do { VMWN(NQL); if constexpr (F32) { SWRITE_KF(0); SBAR(); SLOAD_F((const float*)nxt.V, kbn); } else { SWRITE_HK(0); } SBAR(); } while (0)
    f32x16 pA0, pA1, pB0, pB1; float mnA, mnB, alA, alB; bf16x8 pa0, pa1, pa2, pa3;
    if constexpr (F32) { VMW(); SWRITE_VF(0); SBAR(); } else { SWRITE_HV(0); SBAR(); }
    if (NT > 1) { if constexpr (F32) SLOAD_F((const float*)Kh, KBASE(1)); else SLOAD_H(Kh, Vh, cur.FB, KBASE(1)); }
    SBAR(); qkt<0, SK>(pA0, pA1, K_lds, r32, hi, S.qr, ACT(0));
    if constexpr (F32) { if (NT > 1) { VMW(); SWRITE_KF(1); SBAR(); SLOAD_F((const float*)Vh, KBASE(1)); } }
    MASKT(pA0, pA1, 0); partialSM(pA0, pA1, m_reg, mnA, alA);
    if (NT > 1) { VMW(); if constexpr (F32) { SWRITE_VF(1); SBAR(); if (NT > 2) SLOAD_F((const float*)Kh, KBASE(2)); } else SWRITE_H(1); }
    __syncthreads();
#define HALF_STEP(PX0, PX1, mnX, alX, PY0, PY1, alY, t, KB, VB, SB) do {                                                      \
        SBAR(); qkt<KB, SK>(PX0, PX1, K_lds, r32, hi, S.qr, ACT(t));                                             \
        finishSM(PY0, PY1, alY, l_reg, pa0, pa1, pa2, pa3); SBAR();                                                           \
        if ((t) + 1 < NT) { if constexpr (F32) { VMW(); SWRITE_KF(SB); SBAR(); SLOAD_F((const float*)Vh, KBASE((t) + 1)); }  \
                            else { SLOAD_H(Kh, Vh, cur.FB, KBASE((t) + 1)); } SBAR(); }                                               \
        pv_tile<VB, SK>(o, vb0, pa0, pa1, pa2, pa3, ACT((t) - 1)); MASKT(PX0, PX1, (t)); partialSM(PX0, PX1, m_reg, mnX, alX);                                        \
        __syncthreads();                                                                                                      \
        if ((t) + 1 < NT) { VMW(); if constexpr (F32) { SWRITE_VF(SB); SBAR(); if ((t) + 2 < NT) SLOAD_F((const float*)Kh, KBASE((t) + 2)); } \
                            else { SWRITE_H(SB); } }                                                                          \
        RESC(alX); __syncthreads(); } while (0)
    for (int t = 1; t + 1 < NT; t += 2) {
        HALF_STEP(pB0, pB1, mnB, alB, pA0, pA1, alA, t, 1, 0, 0);
        HALF_STEP(pA0, pA1, mnA, alA, pB0, pB1, alB, t + 1, 0, 1, 1);
    }
    const bool even = (NT & 1) == 0;
    if (even) { SBAR(); qkt<1, SK>(pB0, pB1, K_lds, r32, hi, S.qr, ACT(NT - 1)); SBAR(); }
#define QROW(e) (nxt.Q + (size_t)(wid * QBLK + r32) * D + ((e) >> 1) * 16 + hi * 8 + ((e) & 1) * 4)
    if constexpr (F32) { SLOAD_F((const float*)nxt.K, kbn); SBAR();
#pragma unroll
        for (int e = 0; e < 8; ++e) S.tq[e] = *(const f32x4*)QROW(e); }
    else { SLOAD_H(nxt.K, nxt.V, nxt.FB, kbn); SBAR();
#pragma unroll
        for (int d0 = 0; d0 < 8; ++d0) S.qr[d0] = load8<TIn>(nxt.Q + (size_t)(wid * QBLK + r32) * QS + d0 * 16 + hi * 8); }
    SBAR();
    finishSM(pA0, pA1, alA, l_reg, pa0, pa1, pa2, pa3); SBAR();
    if constexpr (F32) {
#pragma unroll
        for (int e = 8; e < 16; ++e) S.tq[e] = *(const f32x4*)QROW(e); SBAR(); }
#undef QROW
    pv_tile<0, SK>(o, vb0, pa0, pa1, pa2, pa3, ACT(even ? NT - 2 : NT - 1));
    if (even) { MASKT(pB0, pB1, NT - 1); partialSM(pB0, pB1, m_reg, mnB, alB); __syncthreads(); RESC(alB);
        finishSM(pB0, pB1, alB, l_reg, pa0, pa1, pa2, pa3); SBAR(); pv_tile<1, SK>(o, vb0, pa0, pa1, pa2, pa3, ACT(NT - 1)); }
    SBAR(); SEAM_K0();
    if (hi == 0) li_l[r32] = l_reg; asm volatile("s_waitcnt lgkmcnt(0)" ::: "memory");
    float rli[16];
#pragma unroll
    for (int r = 0; r < 16; ++r) rli[r] = __builtin_amdgcn_rcpf(li_l[crow(r, hi)]);
    TOut* Ow = cur.O + (size_t)(wid * QBLK) * OS;
#pragma unroll
    for (int r = 0; r < 16; ++r) { const int orow = crow(r, hi);
#pragma unroll
        for (int d0 = 0; d0 < 4; ++d0) { const float v = o[d0][r] * rli[r];
            if constexpr (same_t<TOut, float>::v) { Ow[(size_t)orow * OS + d0 * 32 + r32] = v; }
            else { const float vn = __shfl_xor(v, 1);
                   if ((r32 & 1) == 0) *(unsigned*)(Ow + (size_t)orow * OS + d0 * 32 + r32) = cvtpk(v, vn); } } }
    if constexpr (F32) {
#pragma unroll
        for (int d0 = 0; d0 < 8; ++d0) S.qr[d0] = pack8(S.tq[2 * d0], S.tq[2 * d0 + 1]); }
    __syncthreads();
#undef RESC
#undef KBASE
#undef ACT
#undef MASKT
#undef SEAM_K0
#undef HALF_STEP
}
#undef ROW
#undef VMW
#undef VMWN
#undef SLOAD_H
#undef SWRITE_HK
#undef SWRITE_HV
#undef SWRITE_H
#undef SLOAD_F
#undef SWRITE_KF
#undef SWRITE_VF

__host__ __device__ inline int swa_nramp(int nqb, int W, int qoff) { const int t = W - 1 - qoff; const int n = t < 0 ? 0 : t / QB + 1; return n > nqb ? nqb : n; }
__host__ __device__ inline int swa_nx(int nqb, int nramp, int order) { return (order & ORDER_PAIRED) ? (nramp + 1) / 2 + (nqb - nramp) : nqb; }
struct SwaItem { int bh, qb0, qb1; };
__device__ __forceinline__ SwaItem swa_decode(int L, int nb, int nh, int nhkv, int nqb, int nx, int nramp, int order) {
    const int G = nh / nhkv; SwaItem it; int x;
    if ((order & ORDER_XCD) && (nb * nhkv) % 8 == 0) { const int xcd = L & 7, k = L >> 3, per = G * nx, gi = k / per, r = k - gi * per;
        it.bh = (gi * 8 + xcd) * G + r / nx; x = r % nx; }
    else { it.bh = L / nx; x = L - it.bh * nx; }
    if (order & ORDER_PAIRED) { const int ns = nqb - nramp;
        if (x < ns) { it.qb0 = it.qb1 = nqb - 1 - x; } else { it.qb0 = x - ns; it.qb1 = nramp - 1 - it.qb0; } }
    else { it.qb0 = it.qb1 = ((order & 3) == ORDER_REVERSED) ? nqb - 1 - x : x; }
    return it;
}
typedef unsigned short bf16;
__device__ __forceinline__ BlockRef<bf16, bf16> mk_ref(const SwaItem& it, int pass, const bf16* Q, const bf16* K, const bf16* V, bf16* O, const float* FB) {
    const int qb = pass ? it.qb1 : it.qb0, b = it.bh >> 4, h = it.bh & 15, kvh = h >> 2;
    BlockRef<bf16, bf16> r;
    r.Q = Q + ((size_t)b * 8192 + (size_t)qb * QB) * QS + h * 128; r.O = O + ((size_t)b * 8192 + (size_t)qb * QB) * OS + h * 128;
    r.K = K + (size_t)b * 8192 * KS + kvh * 128; r.V = V + (size_t)b * 8192 * KS + kvh * 128; r.FB = FB + (size_t)it.bh * 8192; r.P0 = qb * QB;
    return r;
}
__device__ __forceinline__ void attn_phase(char* lds, const bf16* Q, const bf16* K, const bf16* V, bf16* O, const float* FB) {
    constexpr int nb = 4, nh = 16, nhkv = 4, nqb = 32, W = 8192, order = ORDER_PAIRED | ORDER_XCD;
    const int nramp = swa_nramp(nqb, W, 0), nx = swa_nx(nqb, nramp, order), total = nx * nb * nh, stride = gridDim.x;
    int L = blockIdx.x; if (L >= total) return;
    SwaItem it = swa_decode(L, nb, nh, nhkv, nqb, nx, nramp, order); int pass = 0;
    BlockRef<bf16, bf16> cur = mk_ref(it, 0, Q, K, V, O, FB);
    Seam<bf16> S;
    causal_swa_prime<bf16, bf16>(cur, W, lds, S);
    for (;;) {
        const bool more_pass = pass == 0 && it.qb1 != it.qb0, more_item = L + stride < total, last = !more_pass && !more_item;
        SwaItem itn = it; int passn = pass + 1, Ln = L;
        if (!more_pass) { passn = 0; Ln = more_item ? L + stride : L; itn = swa_decode(Ln, nb, nh, nhkv, nqb, nx, nramp, order); }
        const BlockRef<bf16, bf16> nxt = last ? cur : mk_ref(itn, passn, Q, K, V, O, FB);
        causal_swa_block<bf16, bf16>(cur, nxt, 8192, W, lds, S);
        if (last) break;
        cur = nxt; it = itn; pass = passn; L = Ln;
    }
}
}
constexpr size_t WS_WIN = 0, WS_WRO = 50331648, WS_WGU0 = 67108864, WS_WGU1 = 113246208, WS_WDN0 = 159383552, WS_WDN1 = 182452224,
                 WS_WO = 205520896, WS_WKVF = 213909504  , WS_COS = 227540992, WS_SIN = 231735296, WS_FB = 235929600, WS_FS = WS_FB + 2097152, WS_SSQ = WS_FS + 540672  , WS_BAR = WS_SSQ + 396288  ,
                 WS_BIG = 239075328;
constexpr size_t SZ_ROWS2K = (size_t)TALL * DM * 2;
constexpr size_t BIG_XN = 0, BIG_ACT = SZ_ROWS2K, BIG_HKV = BIG_ACT + (size_t)TALL * DFF * 2, BIG_KB = BIG_HKV + SZ_ROWS2K, BIG_VB = BIG_KB + (size_t)TP * 512 * 2,
                 BIG_KALL = BIG_VB + (size_t)TP * 512 * 2, BIG_VALL = BIG_KALL + (size_t)8 * LKS * 512 * 2, BIG_END = BIG_VALL + (size_t)8 * LKS * 512 * 2;
static_assert(BIG_END <= (size_t)TALL * NPROJ * 2, "layer-1 buffers fit in the PROJ region");
constexpr size_t WS_END = WS_BIG + (size_t)TALL * NPROJ * 2;
static_assert(WS_END <= (size_t)1073741824, "workspace fits 1 GiB");
constexpr size_t OUT_Y = 0, OUT_SP = 67633152, OUT_KP = 71827456, OUT_VP = 88604672, OUT_LFP = 105381888, OUT_SS = 105906176, OUT_KS = 114294784, OUT_VS = 114425856, OUT_LFS = 114556928;
constexpr int NWAVES = 8, LDS_BYTES = 149504;

struct Params { const float* in[21]; float* out; unsigned char* ws; };

__device__ __forceinline__ float wave_sum(float v) {
#pragma unroll
    for (int o = 1; o < 64; o <<= 1) v += __shfl_xor(v, o);
    return v;
}
__device__ __forceinline__ float bf2f(unsigned short b) { return __uint_as_float(((unsigned)b) << 16); }
__device__ __forceinline__ unsigned pk2(float lo, float hi) { return pg8::cvt_pk_bf16(lo, hi); }

__device__ __forceinline__ void transpose_item(const float* W, int K, int N, bf16_t* WT, int k0, int n0, int drow0, LAS float* scr, int lane, const float* gain = nullptr) {
    float wv[32];
#pragma unroll
    for (int i = 0; i < 32; ++i) { const int kk = 2 * i + (lane >> 5); wv[i] = W[(size_t)(k0 + kk) * N + n0 + (lane & 31)] * (gain ? gain[k0 + kk] : 1.f); }
#pragma unroll
    for (int i = 0; i < 32; ++i) { const int kk = 2 * i + (lane >> 5); scr[kk * 33 + (lane & 31)] = wv[i]; }
    asm volatile("s_waitcnt lgkmcnt(0)" ::: "memory");
    const int c = lane & 7;
#pragma unroll
    for (int j = 0; j < 4; ++j) { const int n = (lane >> 3) + 8 * j; const LAS float* s = scr + (8 * c) * 33 + n;
        u32x4 o; o.x = pk2(s[0 * 33], s[1 * 33]); o.y = pk2(s[2 * 33], s[3 * 33]); o.z = pk2(s[4 * 33], s[5 * 33]); o.w = pk2(s[6 * 33], s[7 * 33]);
        *(u32x4*)(WT + (size_t)(drow0 + n) * K + k0 + 8 * c) = o; }
    asm volatile("s_waitcnt lgkmcnt(0)" ::: "memory");
}
__device__ __forceinline__ void tr_plain(const float* W, int K, int N, bf16_t* WT, int row_off, LAS float* scr, int item, int lane, const float* gain = nullptr) {
    const int nblk = N / 32, kb = item / nblk, nb = item % nblk; transpose_item(W, K, N, WT, 64 * kb, 32 * nb, row_off + 32 * nb, scr, lane, gain);
}
__device__ __forceinline__ void tr_gu(const float* W, bf16_t* WT, int up, LAS float* scr, int item, int lane, const float* gain) {
    const int nblk = DFF / 32, kb = item / nblk, nb = item % nblk, n0 = 32 * nb; transpose_item(W, DM, DFF, WT, 64 * kb, n0, (n0 >> 7) * 256 + up * 128 + (n0 & 127), scr, lane, gain);
}
template <int MODE  >
__device__ __forceinline__ void rms_row(const float* xrow, const float* g1, bf16_t* o1, const float* g2, bf16_t* o2, float* of, int lane) {
    const f32x4* xr = (const f32x4*)xrow + lane;
    f32x4 v[8]; float s = 0.f;
#pragma unroll
    for (int j = 0; j < 8; ++j) { v[j] = xr[64 * j]; s += (v[j].x * v[j].x + v[j].y * v[j].y) + (v[j].z * v[j].z + v[j].w * v[j].w); }
    const float rs = 1.0f / sqrtf(wave_sum(s) * (1.f / DM) + 1e-6f);
#pragma unroll
    for (int j = 0; j < 8; ++j) { const f32x4 ga = ((const f32x4*)g1)[64 * j + lane]; const f32x4 y = v[j] * rs;
        if (MODE == 2) { ((f32x4*)of)[64 * j + lane] = y * ga; }
        else { u32x2 w; w.x = pk2(y.x * ga.x, y.y * ga.y); w.y = pk2(y.z * ga.z, y.w * ga.w); ((u32x2*)o1)[64 * j + lane] = w;
            if (MODE == 1) { const f32x4 gb = ((const f32x4*)g2)[64 * j + lane]; u32x2 w2; w2.x = pk2(y.x * gb.x, y.y * gb.y); w2.y = pk2(y.z * gb.z, y.w * gb.w); ((u32x2*)o2)[64 * j + lane] = w2; } } }
}

namespace ret {
constexpr int QOFF = 0, KOFF = 33792, STOFF = 67584, VOFF = 101376, POFF = 110592, RS = 528, VS = 144;
typedef short v4i16_t __attribute__((ext_vector_type(4)));
__device__ __forceinline__ bf16x8 frag_rm(const LAS char* base, int stride, int i0, int k0, int fr, int fq) { return *(const LAS bf16x8*)(base + (i0 + fr) * stride + (k0 + 8 * fq) * 2); }
__device__ __forceinline__ s16x4 tr4(const LAS char* p) { return __builtin_bit_cast(s16x4, __builtin_amdgcn_ds_read_tr16_b64_v4i16((LAS v4i16_t*)p)); }
__device__ __forceinline__ bf16x8 frag_tr(const LAS char* base, int stride, int k0, int i0, int fr, int fq) {
    const LAS char* p = base + (k0 + 8 * fq + (fr >> 2)) * stride + (i0 + 4 * (fr & 3)) * 2;
    const s16x4 a = tr4(p), b = tr4(p + 4 * stride);
    return (bf16x8){a[0], a[1], a[2], a[3], b[0], b[1], b[2], b[3]};
}
#define MFMA16(X, Y, C) __builtin_amdgcn_mfma_f32_16x16x32_bf16(X, Y, C, 0, 0, 0)
__device__ __forceinline__ void ret_item(LAS char* lds, const bf16_t* pin, bf16_t* pout  , int nchunks, int c, int h, int es, const float* S0, float* Sout) {
    const int tid = opaque_tid(), wid = __builtin_amdgcn_readfirstlane(tid >> 6), lane = tid & 63, fr = lane & 15, fq = lane >> 4, lt = wid >> 1, half = wid & 1;
    const float lg2 = __log2f(1.0f - exp2f(-5.0f - (float)h)), gam = exp2f(lg2), gc1 = exp2f(lg2 * (float)(c - 1));
    f32x4 accT[8];
    const int eT = 16 * lt + fr;
#pragma unroll
    for (int i = 0; i < 8; ++i) { const int d0 = 16 * (8 * half + i) + 4 * fq;
#pragma unroll
        for (int r = 0; r < 4; ++r) accT[i][r] = S0 ? S0[(size_t)(d0 + r) * 512 + es * 64 + eT] : 0.f;
        u32x2 w; w.x = pk2(accT[i][0], accT[i][1]); w.y = pk2(accT[i][2], accT[i][3]); *(LAS u32x2*)(lds + STOFF + eT * RS + d0 * 2) = w; }
    u32x4 rq[4], rk[4], rv;
    const bf16_t* gq = pin + h * 256; const bf16_t* gk = pin + 2048 + h * 256; const bf16_t* gv = pin + 4096 + h * 512 + es * 64;
#define RET_LOAD(n) do { _Pragma("unroll") for (int i = 0; i < 4; ++i) { const int p = tid + 512 * i, row = p >> 5, ch = p & 31; const size_t go = (size_t)((n) * 64 + row) * NPROJ + ch * 8; \
            if (row < c) { rq[i] = *(const u32x4*)(gq + go); rk[i] = *(const u32x4*)(gk + go); } else { rq[i] = (u32x4){0u, 0u, 0u, 0u}; rk[i] = (u32x4){0u, 0u, 0u, 0u}; } } \
        { const int row = tid >> 3, ch = tid & 7; if (row < c) rv = *(const u32x4*)(gv + (size_t)((n) * 64 + row) * NPROJ + ch * 8); else rv = (u32x4){0u, 0u, 0u, 0u}; } } while (0)
    RET_LOAD(0);
    for (int n = 0; n < nchunks; ++n) {
#pragma unroll
        for (int i = 0; i < 4; ++i) { const int p = tid + 512 * i, row = p >> 5, ch = p & 31; *(LAS u32x4*)(lds + QOFF + row * RS + ch * 16) = rq[i]; *(LAS u32x4*)(lds + KOFF + row * RS + ch * 16) = rk[i]; }
        *(LAS u32x4*)(lds + VOFF + (tid >> 3) * VS + (tid & 7) * 16) = rv;
        if (n + 1 < nchunks) RET_LOAD(n + 1);
        __syncthreads();
        f32x4 accS[2], accC[2];
#pragma unroll
        for (int j = 0; j < 2; ++j) { accS[j] = (f32x4){0.f, 0.f, 0.f, 0.f}; accC[j] = (f32x4){0.f, 0.f, 0.f, 0.f}; }
#pragma unroll
        for (int ks = 0; ks < 8; ++ks) { const int k0 = 32 * ks;
            const bf16x8 yq = frag_rm(lds + QOFF, RS, 16 * lt, k0, fr, fq);
#pragma unroll
            for (int j = 0; j < 2; ++j) { const bf16x8 xk = frag_rm(lds + KOFF, RS, 16 * (2 * half + j), k0, fr, fq); accS[j] = MFMA16(xk, yq, accS[j]); }
#pragma unroll
            for (int j = 0; j < 2; ++j) { const bf16x8 xs = frag_rm(lds + STOFF, RS, 16 * (2 * half + j), k0, fr, fq); accC[j] = MFMA16(xs, yq, accC[j]); } }
        const int lrow = 16 * lt + fr;
#pragma unroll
        for (int j = 0; j < 2; ++j) { const int m0 = 16 * (2 * half + j) + 4 * fq; f32x4 s = accS[j];
#pragma unroll
            for (int r = 0; r < 4; ++r) s[r] = (m0 + r <= lrow) ? s[r] : 0.f;
            u32x2 w; w.x = pk2(s[0], s[1]); w.y = pk2(s[2], s[3]); *(LAS u32x2*)(lds + POFF + lrow * VS + m0 * 2) = w; }
        __syncthreads();
        f32x4 accO[2];
#pragma unroll
        for (int j = 0; j < 2; ++j) accO[j] = accC[j] * gam;
#pragma unroll
        for (int ks = 0; ks < 2; ++ks) { const int k0 = 32 * ks;
            const bf16x8 yp = frag_rm(lds + POFF, VS, 16 * lt, k0, fr, fq);
#pragma unroll
            for (int j = 0; j < 2; ++j) { const bf16x8 xv = frag_tr(lds + VOFF, VS, k0, 16 * (2 * half + j), fr, fq); accO[j] = MFMA16(xv, yp, accO[j]); } }
        if (lrow < c) {
#pragma unroll
            for (int j = 0; j < 2; ++j) { u32x2 w; w.x = pk2(accO[j][0], accO[j][1]); w.y = pk2(accO[j][2], accO[j][3]);
                *(u32x2*)(pout + (size_t)(n * 64 + lrow) * 4096 + h * 512 + es * 64 + 16 * (2 * half + j) + 4 * fq) = w; } }
#pragma unroll
        for (int i = 0; i < 8; ++i) accT[i] = accT[i] * gam;
#pragma unroll
        for (int ks = 0; ks < 2; ++ks) { const int k0 = 32 * ks;
            const bf16x8 yv = frag_tr(lds + VOFF, VS, k0, 16 * lt, fr, fq);
#pragma unroll
            for (int i = 0; i < 8; ++i) { const bf16x8 xk = frag_tr(lds + KOFF, RS, k0, 16 * (8 * half + i), fr, fq); accT[i] = MFMA16(xk, yv, accT[i]); } }
#pragma unroll
        for (int i = 0; i < 8; ++i) { accT[i] = accT[i] * gc1; const int d0 = 16 * (8 * half + i) + 4 * fq;
            u32x2 w; w.x = pk2(accT[i][0], accT[i][1]); w.y = pk2(accT[i][2], accT[i][3]); *(LAS u32x2*)(lds + STOFF + eT * RS + d0 * 2) = w; }
        __syncthreads();
    }
#undef RET_LOAD
#pragma unroll
    for (int i = 0; i < 8; ++i) { const int d0 = 16 * (8 * half + i) + 4 * fq;
#pragma unroll
        for (int r = 0; r < 4; ++r) Sout[(size_t)(d0 + r) * 512 + es * 64 + eT] = accT[i][r]; }
}
}
__device__ __forceinline__ void sample_attn(LAS char* lds, const bf16_t* QBp, const bf16_t* KALL, const bf16_t* VALL, const float* FS, bf16_t* AO) {
    const int tid = opaque_tid(), wid = __builtin_amdgcn_readfirstlane(tid >> 6), lane = tid & 63;
    LAS float* qf = (LAS float*)(lds + wid * 5120); LAS float* pf = qf + 128;
    const int gw = blockIdx.x * NWAVES + wid, NGW = gridDim.x * NWAVES;
    for (int item = gw; item < 8 * 16 * 32; item += NGW) {
        const int b = item >> 9, h = (item >> 5) & 15, qi = item & 31, kvh = h >> 2, qpos = PASTL + qi, row = TP + b * 32 + qi;
        const bf16_t* q = QBp + (size_t)row * DM + h * 128;
        qf[lane] = bf2f(q[lane]); qf[lane + 64] = bf2f(q[lane + 64]);
        asm volatile("s_waitcnt lgkmcnt(0)" ::: "memory");
        const float* F = FS + (size_t)(b * 16 + h) * LKS; const float Fq = F[qpos];
        const bf16_t* Kb = KALL + (size_t)b * LKS * 512 + kvh * 128; const bf16_t* Vb = VALL + (size_t)b * LKS * 512 + kvh * 128;
        float mx = -1e30f;
#pragma unroll 1
        for (int t = 0; t < 17; ++t) { const int j = lane + 64 * t; float s = -__builtin_inff();
            if (j <= qpos) { const u32x4* kr = (const u32x4*)(Kb + (size_t)j * 512); float a = 0.f; u32x4 kvv[16];
#pragma unroll
                for (int c8 = 0; c8 < 16; ++c8) kvv[c8] = kr[c8];
#pragma unroll
                for (int c8 = 0; c8 < 16; ++c8) { const u32x4 kv = kvv[c8]; const LAS f32x4* qq = (const LAS f32x4*)(qf + 8 * c8); const f32x4 q0 = qq[0], q1 = qq[1];
                    a += __uint_as_float(kv.x << 16) * q0.x + __uint_as_float(kv.x & 0xffff0000u) * q0.y + __uint_as_float(kv.y << 16) * q0.z + __uint_as_float(kv.y & 0xffff0000u) * q0.w
                       + __uint_as_float(kv.z << 16) * q1.x + __uint_as_float(kv.z & 0xffff0000u) * q1.y + __uint_as_float(kv.w << 16) * q1.z + __uint_as_float(kv.w & 0xffff0000u) * q1.w; }
                s = a * 0.08838834764831845f + (Fq - F[j]); }
            pf[j] = s; mx = fmaxf(mx, s); }
#pragma unroll
        for (int o = 1; o < 64; o <<= 1) mx = fmaxf(mx, __shfl_xor(mx, o));
        float sum = 0.f;
#pragma unroll 1
        for (int t = 0; t < 17; ++t) { const float p = __expf(pf[lane + 64 * t] - mx); sum += p; pf[lane + 64 * t] = p; }
        sum = wave_sum(sum);
        asm volatile("s_waitcnt lgkmcnt(0)" ::: "memory");
        float oa[8];
#pragma unroll
        for (int e = 0; e < 8; ++e) oa[e] = 0.f;
        const int kg = lane >> 4, dg = lane & 15;
        for (int j = 0; j < PASTL + 32; j += 32) {
            u32x4 vv[8]; float p[8];
#pragma unroll
            for (int u = 0; u < 8; ++u) { vv[u] = *(const u32x4*)(Vb + (size_t)(j + 4 * u + kg) * 512 + 8 * dg); p[u] = pf[j + 4 * u + kg]; }
#pragma unroll
            for (int u = 0; u < 8; ++u) { const unsigned w4[4] = {vv[u].x, vv[u].y, vv[u].z, vv[u].w};
#pragma unroll
                for (int e = 0; e < 4; ++e) { oa[2 * e] += p[u] * __uint_as_float(w4[e] << 16); oa[2 * e + 1] += p[u] * __uint_as_float(w4[e] & 0xffff0000u); } } }
#pragma unroll
        for (int e = 0; e < 8; ++e) { oa[e] += __shfl_xor(oa[e], 16); oa[e] += __shfl_xor(oa[e], 32); }
        const float inv = 1.0f / sum;
        if (kg == 0) { u32x4 w; w.x = pk2(oa[0] * inv, oa[1] * inv); w.y = pk2(oa[2] * inv, oa[3] * inv); w.z = pk2(oa[4] * inv, oa[5] * inv); w.w = pk2(oa[6] * inv, oa[7] * inv);
            *(u32x4*)(AO + (size_t)row * DM + h * 128 + 8 * dg) = w; }
        asm volatile("s_waitcnt lgkmcnt(0)" ::: "memory");
    }
}

#define XB_TMO      128
#define XB_XCNT(j)  (256  + 64 * (j))
#define XB_XSUB(j)  (1280 + 64 * (j))
#define XB_XGEN(j)  (2304 + 64 * (j))
#define XB_TOP      3328
#define XB_TOPGEN   3392
#define XCD_BAR_WORDS 3456
#define XB_SPIN_CAP (1u << 18)

__device__ __forceinline__ unsigned xb_ld(unsigned* p)              { return __hip_atomic_load(p, __ATOMIC_RELAXED, __HIP_MEMORY_SCOPE_AGENT); }
__device__ __forceinline__ unsigned xb_add(unsigned* p, unsigned v) { return __hip_atomic_fetch_add(p, v, __ATOMIC_RELAXED, __HIP_MEMORY_SCOPE_AGENT); }
__device__ __forceinline__ unsigned xb_xcc_id() { return (unsigned)__builtin_amdgcn_s_getreg((3 << 11) | 20) & 0xFu; }
#define XB_SPIN(cond, bar) do { unsigned _sp = 0; while (cond) { __builtin_amdgcn_s_sleep(1); \
    if ((++_sp & 255u) == 0u) { if (xb_ld(&(bar)[XB_TMO])) break; if (_sp > XB_SPIN_CAP) { atomicAdd(&(bar)[XB_TMO], 1u); break; } } } } while (0)

struct XcdBarrier {
    unsigned* bar; unsigned x;
    volatile LAS unsigned* st;
};

__device__ __forceinline__ XcdBarrier xcd_barrier_post(unsigned* bar, volatile LAS unsigned* st) {
    XcdBarrier b; b.bar = bar; b.x = xb_xcc_id(); b.st = st;
    if (threadIdx.x == 0) (void)xb_add(&bar[XB_XCNT(b.x)], 1u);
    return b;
}
__device__ __forceinline__ void xcd_barrier_complete(unsigned* bar, unsigned x, unsigned& nloc, unsigned& nx) {
    const unsigned G = gridDim.x * gridDim.y * gridDim.z;
    unsigned sum, cnt, mine, sp = 0u;
    for (;;) {
        sum = 0u; cnt = 0u; mine = 0u;
#pragma unroll
        for (unsigned j = 0; j < 16; ++j) { const unsigned c = xb_ld(&bar[XB_XCNT(j)]); sum += c; cnt += (c > 0u) ? 1u : 0u; mine = (j == x) ? c : mine; }
        if (sum == G) break;
        __builtin_amdgcn_s_sleep(1);
        if ((++sp & 255u) == 0u) { if (xb_ld(&bar[XB_TMO])) break; if (sp > XB_SPIN_CAP) { atomicAdd(&bar[XB_TMO], 1u); break; } }
    }
    nloc = mine > 0u ? mine : 1u; nx = cnt > 0u ? cnt : 1u;
}

__device__ __forceinline__ void xcd_barrier(const XcdBarrier& b) {
    asm volatile("s_waitcnt vmcnt(0)" ::: "memory");
    __syncthreads();
    if (threadIdx.x == 0) {
        unsigned* bar = b.bar;
        __builtin_amdgcn_s_waitcnt(0);
        unsigned nloc = b.st[0], nx = b.st[1];
        if (nloc == 0u) { xcd_barrier_complete(bar, b.x, nloc, nx); b.st[0] = nloc; b.st[1] = nx; }
        const unsigned old = xb_add(&bar[XB_XSUB(b.x)], 1u);
        const unsigned gen = old / nloc;
        if (old + 1u == (gen + 1u) * nloc) {
            __builtin_amdgcn_fence(__ATOMIC_RELEASE, "agent");
            asm volatile("s_waitcnt vmcnt(0)" ::: "memory");
            const unsigned og = xb_add(&bar[XB_TOP], 1u);
            const unsigned tg = og / nx;
            if (og + 1u == (tg + 1u) * nx) xb_add(&bar[XB_TOPGEN], 1u);
            else XB_SPIN(xb_ld(&bar[XB_TOPGEN]) == tg, bar);
            __builtin_amdgcn_fence(__ATOMIC_ACQUIRE, "agent");
            xb_add(&bar[XB_XGEN(b.x)], 1u);
            asm volatile("s_waitcnt vmcnt(0)" ::: "memory");
        } else {
            XB_SPIN(xb_ld(&bar[XB_XGEN(b.x)]) == gen, bar);
            __builtin_amdgcn_fence(__ATOMIC_ACQUIRE, "agent");
            asm volatile("s_waitcnt vmcnt(0)" ::: "memory");
        }
    }
    __syncthreads();
}

#define KARG(i) ((unsigned char*)(((const volatile __attribute__((address_space(4))) unsigned long long*)__builtin_amdgcn_kernarg_segment_ptr())[i]))
#define INF(i) ((const float*)KARG(i))
#define OUTP ((float*)KARG(21))
#define WSP (KARG(22))
#define BIGP (KARG(22) + WS_BIG)
#define PH_IDS const int tid = opaque_tid(), lane = tid & 63, wave = __builtin_amdgcn_readfirstlane(tid >> 6); const int G = gridDim.x, gw = blockIdx.x * NWAVES + wave, NGW = G * NWAVES; const size_t gt = (size_t)blockIdx.x * 512 + tid, NGT = (size_t)G * 512; (void)lane; (void)gw; (void)NGW; (void)gt; (void)NGT

__device__ __forceinline__ void ph_prologue(LAS unsigned char* lds) {
    PH_IDS; unsigned char* ws = WSP;
    bf16_t* WIN = (bf16_t*)(ws + WS_WIN); bf16_t* WKVF = (bf16_t*)(ws + WS_WKVF);
    LAS float* scr = (LAS float*)(lds + wave * 16384);
    constexpr int I0 = 32 * 384;
    for (int it = gw; it < I0; it += NGW) tr_plain(INF(10), DM, NPROJ, WIN, 0, scr, it, lane);
    { const float* wf = INF(14); const float* nkv = INF(8);
      for (size_t i = gt; i < (size_t)256 * DM; i += NGT) { const int r = (int)(i >> 11), k = (int)(i & 2047); WKVF[(size_t)(1024 + r) * DM + k] = r < 16 ? (bf16_t)(pk2(wf[k * 16 + r] * nkv[k], 0.f) & 0xffffu) : (bf16_t)0; }
      float* ssq = (float*)(ws + WS_SSQ); for (size_t i = gt; i < (size_t)3 * TALL; i += NGT) ssq[i] = 0.f; }
    { float* COS = (float*)(ws + WS_COS); float* SIN = (float*)(ws + WS_SIN);
      for (size_t i = gt; i < (size_t)SEQ * 128; i += NGT) { const int pos = (int)(i >> 7), d = (int)(i & 127);
        const float inv = exp2f(-(float)d * (13.287712379549449f / 128.f));
        const double rev = (double)pos * (double)inv * 0.15915494309189535; const float fr = (float)(rev - __builtin_floor(rev));
        COS[i] = __builtin_amdgcn_cosf(fr); SIN[i] = __builtin_amdgcn_sinf(fr); } }
    { const float* x_p = INF(0); const float* x_s = INF(1); const float* nm = INF(6); bf16_t* XN0 = (bf16_t*)OUTP;
      for (int m = gw; m < TALL; m += NGW) rms_row<0>(m < TP ? x_p + (size_t)m * DM : x_s + (size_t)(m - TP) * DM, nm, XN0 + (size_t)m * DM, nullptr, nullptr, nullptr, lane); }
}
template <int JOB> __device__ __forceinline__ void ph_conv(LAS unsigned char* lds) {
    const int tid = opaque_tid(), lane = tid & 63, wave = __builtin_amdgcn_readfirstlane(tid >> 6);
    const int G = gridDim.x, first = G > 160 ? (JOB == 1 ? 48 : JOB == 3 ? 141 : 44) : 0;
    if ((int)blockIdx.x < first) return;
    const int gw = ((int)blockIdx.x - first) * NWAVES + wave, NGW = (G - first) * NWAVES;
    unsigned char* ws = WSP; LAS float* scr = (LAS float*)(lds + wave * 16384);
    constexpr int IG = 32 * 176, ID = 88 * 64, IQ = 32 * 64, IK = 32 * 16;
    if (JOB == 1) {
        bf16_t* WRO = (bf16_t*)(ws + WS_WRO); bf16_t* WGU0 = (bf16_t*)(ws + WS_WGU0);
        for (int it = gw; it < 64 * 64 + 2 * IG; it += NGW) { int r = it;
            if (r < 64 * 64) { tr_plain(INF(11), 4096, DM, WRO, 0, scr, r, lane); continue; } r -= 64 * 64;
            if (r < IG) { tr_gu(INF(18), WGU0, 0, scr, r, lane, INF(7)); continue; } r -= IG;
            tr_gu(INF(19), WGU0, 1, scr, r, lane, INF(7)); }
    } else if (JOB == 2) {
        bf16_t* WDN0 = (bf16_t*)(ws + WS_WDN0); bf16_t* WGU1 = (bf16_t*)(ws + WS_WGU1); bf16_t* WO = (bf16_t*)(ws + WS_WO); bf16_t* WKVF = (bf16_t*)(ws + WS_WKVF);
        for (int it = gw; it < ID + 2 * IQ + 2 * IK + IG; it += NGW) { int r = it;
            if (r < ID) { tr_plain(INF(20), DFF, DM, WDN0, 0, scr, r, lane); continue; } r -= ID;
            if (r < IQ) { tr_plain(INF(16), DM, DM, WKVF, 1280, scr, r, lane, INF(6) + DM); continue; } r -= IQ;
            if (r < IK) { tr_plain(INF(12), DM, 512, WKVF, 0, scr, r, lane, INF(8)); continue; } r -= IK;
            if (r < IK) { tr_plain(INF(13), DM, 512, WKVF, 512, scr, r, lane, INF(8)); continue; } r -= IK;
            if (r < IQ) { tr_plain(INF(17), DM, DM, WO, 0, scr, r, lane); continue; } r -= IQ;
            tr_gu(INF(18) + (size_t)DM * DFF, WGU1, 0, scr, r, lane, INF(7) + DM); }
    } else if (JOB == 3) {
        bf16_t* WGU1 = (bf16_t*)(ws + WS_WGU1);
        for (int it = gw; it < IG; it += NGW) tr_gu(INF(19) + (size_t)DM * DFF, WGU1, 1, scr, it, lane, INF(7) + DM);
    } else {
        bf16_t* WDN1 = (bf16_t*)(ws + WS_WDN1);
        for (int it = gw; it < ID; it += NGW) tr_plain(INF(20) + (size_t)DFF * DM, DFF, DM, WDN1, 0, scr, it, lane);
    }
}
__device__ __forceinline__ void ph_retin(LAS unsigned char* lds) {
    unsigned char* ws = WSP;
    pg8::Gemm g{(const bf16_t*)OUTP, (const bf16_t*)(ws + WS_WIN), TALL, NPROJ, DM, DM}; pg8::StaticOrder S; S.init(TALL, NPROJ, (int)gridDim.x, (int)blockIdx.x);
    pg8::EpiRetIn E{(bf16_t*)(ws + WS_BIG), (const float*)(ws + WS_COS), (const float*)(ws + WS_SIN)};
    pg8::gemm_phase<pg8::EpiRetIn, pg8::StaticOrder, true, true>(lds, g, S, E);
}
__device__ __forceinline__ void ph_retention(LAS unsigned char* lds) {
    const int G = gridDim.x;
    for (int it = blockIdx.x; it < 256; it += G) { const int bh = (it & 7) * 4 + (it >> 6), es = (it >> 3) & 7, b = bh >> 3, h = bh & 7;
        ret::ret_item((LAS char*)lds, (const bf16_t*)BIGP + (size_t)b * SEQ * NPROJ, (bf16_t*)OUTP + (size_t)b * SEQ * 4096, 128, 64, h, es, nullptr, OUTP + OUT_SP + (size_t)(b * 8 + h) * 256 * 512); }
    for (int it = blockIdx.x; it < 512; it += G) { const int bh = (it & 7) * 8 + (it >> 6), es = (it >> 3) & 7, b = bh >> 3, h = bh & 7;
        ret::ret_item((LAS char*)lds, (const bf16_t*)BIGP + (size_t)(TP + b * 32) * NPROJ, (bf16_t*)OUTP + (size_t)(TP + b * 32) * 4096, 1, 32, h, es, INF(2) + (size_t)(b * 8 + h) * 256 * 512, OUTP + OUT_SS + (size_t)(b * 8 + h) * 256 * 512); }
}
__device__ __forceinline__ void ph_groupnorm() {
    PH_IDS; bf16_t* PROJ = (bf16_t*)BIGP; const bf16_t* OB = (const bf16_t*)OUTP;
    for (int it0 = gw * 4; it0 < TALL * 8; it0 += NGW * 4) {
        u32x4 ovv[4], gvv[4];
#pragma unroll
        for (int q = 0; q < 4; ++q) { const int it = it0 + q, row = it >> 3, h = it & 7;
            ovv[q] = *(const u32x4*)(OB + (size_t)row * 4096 + h * 512 + lane * 8); gvv[q] = *(const u32x4*)(PROJ + (size_t)row * NPROJ + 8192 + h * 512 + lane * 8); }
#pragma unroll
        for (int q = 0; q < 4; ++q) { const int it = it0 + q, row = it >> 3, h = it & 7; const u32x4 ov = ovv[q], gv = gvv[q];
            bf16_t* op = PROJ + (size_t)row * NPROJ + 4096 + h * 512 + lane * 8;
            float o[8], g[8]; const unsigned ow[4] = {ov.x, ov.y, ov.z, ov.w}, gwd[4] = {gv.x, gv.y, gv.z, gv.w};
#pragma unroll
            for (int j = 0; j < 4; ++j) { o[2 * j] = __uint_as_float(ow[j] << 16); o[2 * j + 1] = __uint_as_float(ow[j] & 0xffff0000u); g[2 * j] = __uint_as_float(gwd[j] << 16); g[2 * j + 1] = __uint_as_float(gwd[j] & 0xffff0000u); }
            float s = 0.f;
#pragma unroll
            for (int j = 0; j < 8; ++j) s += o[j];
            const float mu = wave_sum(s) * (1.f / 512.f); float qq = 0.f;
#pragma unroll
            for (int j = 0; j < 8; ++j) { o[j] -= mu; qq += o[j] * o[j]; }
            const float rstd = 1.0f / sqrtf(wave_sum(qq) * (1.f / 512.f) + 1e-5f);
#pragma unroll
            for (int j = 0; j < 8; ++j) o[j] = o[j] * rstd * pg8::silu_f(g[j]);
            u32x4 w; w.x = pk2(o[0], o[1]); w.y = pk2(o[2], o[3]); w.z = pk2(o[4], o[5]); w.w = pk2(o[6], o[7]); *(u32x4*)op = w; } }
}
template <bool FIRST, int MROWS = TALL> __device__ __forceinline__ void ph_res_gemm(LAS unsigned char* lds, unsigned char* a_ptr, size_t w_off, int K, int lda, bf16_t* hb, int ssq_idx) {
    unsigned char* ws = WSP; float* Hres = OUTP + OUT_Y;
    pg8::Gemm g{(const bf16_t*)a_ptr, (const bf16_t*)(ws + w_off), MROWS, DM, K, lda}; pg8::StaticOrder S; S.init(MROWS, DM, (int)gridDim.x, (int)blockIdx.x);
    pg8::EpiRes E{FIRST ? INF(0) : Hres, FIRST ? INF(1) : Hres + (size_t)TP * DM, Hres, hb, ssq_idx >= 0 ? (float*)(ws + WS_SSQ) + (size_t)ssq_idx * TALL : nullptr};
    pg8::gemm_phase<pg8::EpiRes, pg8::StaticOrder, true, true>(lds, g, S, E);
}
template <bool FIRST = false> __device__ __forceinline__ void ph_sample_res(const unsigned char* a_ptr, int lda, size_t w_off, int K, bf16_t* hb, int ssq_idx) {
    const int tid = opaque_tid(), lane = tid & 63, wave = __builtin_amdgcn_readfirstlane(tid >> 6), fr = lane & 15, fq = lane >> 4;
    unsigned char* ws = WSP; float* Hs = OUTP + OUT_Y + (size_t)TP * DM;
    const bf16_t* A = (const bf16_t*)a_ptr; const bf16_t* Wt = (const bf16_t*)(ws + w_off);
    float* ssq = ssq_idx >= 0 ? (float*)(ws + WS_SSQ) + (size_t)ssq_idx * TALL + TP : nullptr;
    for (int it = blockIdx.x; it < 256; it += gridDim.x) {
        const int n0 = (it >> 1) * 16, row = (it & 1) * 128 + 16 * wave + fr;
        const bf16_t* bp = Wt + (size_t)(n0 + fr) * K + 8 * fq; const bf16_t* ap = A + (size_t)row * lda + 8 * fq;
        f32x4 acc = {0.f, 0.f, 0.f, 0.f};
        bf16x8 bA[8], aA[8], bB[8], aB[8];
#define SR_LOAD(B_, A_, kk) do { _Pragma("unroll") for (int s_ = 0; s_ < 8; ++s_) { B_[s_] = *(const bf16x8*)(bp + (kk) + 32 * s_); A_[s_] = *(const bf16x8*)(ap + (kk) + 32 * s_); } } while (0)
#define SR_MMA(B_, A_) do { _Pragma("unroll") for (int s_ = 0; s_ < 8; ++s_) acc = __builtin_amdgcn_mfma_f32_16x16x32_bf16(B_[s_], A_[s_], acc, 0, 0, 0); } while (0)
        SR_LOAD(bA, aA, 0);
        for (int k0 = 0; k0 < K; k0 += 512) {
            SR_LOAD(bB, aB, k0 + 256);
            SR_MMA(bA, aA);
            if (k0 + 512 < K) SR_LOAD(bA, aA, k0 + 512);
            SR_MMA(bB, aB);
        }
#undef SR_LOAD
#undef SR_MMA
        float* o = Hs + (size_t)row * DM + n0 + 4 * fq;
        const f32x4 v = (FIRST ? *(const f32x4*)(INF(1) + (size_t)row * DM + n0 + 4 * fq) : *(const f32x4*)o) + acc; *(f32x4*)o = v;
        if (hb) { u32x2 w; w.x = pk2(v[0], v[1]); w.y = pk2(v[2], v[3]); *(u32x2*)(hb + (size_t)(TP + row) * DM + n0 + 4 * fq) = w; }
        if (ssq) { float ss = (v[0] * v[0] + v[1] * v[1]) + (v[2] * v[2] + v[3] * v[3]); ss += __shfl_xor(ss, 16); ss += __shfl_xor(ss, 32);
            if (fq == 0) (void)__hip_atomic_fetch_add(ssq + row, ss, __ATOMIC_RELAXED, __HIP_MEMORY_SCOPE_AGENT); }
    }
}
template <int MODE> __device__ __forceinline__ void ph_rms(const float* g1, size_t o1_off, const float* g2, size_t o2_off) {
    PH_IDS; float* Hres = OUTP + OUT_Y; unsigned char* ws = WSP;
    for (int m = gw; m < TALL; m += NGW) rms_row<MODE>(Hres + (size_t)m * DM, g1, (bf16_t*)(ws + o1_off) + (size_t)m * DM, g2, (bf16_t*)(ws + o2_off) + (size_t)m * DM, Hres + (size_t)m * DM, lane);
}
__device__ __forceinline__ void ph_cache_cvt() {
    PH_IDS; const float* cache_k = INF(3); const float* cache_v = INF(4); bf16_t* KALL = (bf16_t*)(BIGP + BIG_KALL); bf16_t* VALL = (bf16_t*)(BIGP + BIG_VALL);
    for (size_t i = gt; i < (size_t)8 * PASTL * 512 / 4; i += NGT) { const size_t e = i * 4, b = e / ((size_t)PASTL * 512), r = e % ((size_t)PASTL * 512);
        const f32x4 kv = *(const f32x4*)(cache_k + e), vv = *(const f32x4*)(cache_v + e); u32x2 w; w.x = pk2(kv.x, kv.y); w.y = pk2(kv.z, kv.w); *(u32x2*)(KALL + b * LKS * 512 + r) = w;
        w.x = pk2(vv.x, vv.y); w.y = pk2(vv.z, vv.w); *(u32x2*)(VALL + b * LKS * 512 + r) = w; }
}
__device__ __forceinline__ void ph_kvfq(LAS unsigned char* lds) {
    unsigned char* ws = WSP; unsigned char* big = ws + WS_BIG; float* out = OUTP;
    pg8::Gemm g{(const bf16_t*)(big + BIG_XN), (const bf16_t*)(ws + WS_WKVF), TALL, 3328, DM, DM}; pg8::StaticOrder S; S.init(TALL, 3328, (int)gridDim.x, (int)blockIdx.x);
    pg8::EpiKVFQ E{out + OUT_KP, out + OUT_VP, out + OUT_LFP, out + OUT_KS, out + OUT_VS, out + OUT_LFS, (bf16_t*)(big + BIG_KB), (bf16_t*)(big + BIG_VB), (bf16_t*)(big + BIG_KALL), (bf16_t*)(big + BIG_VALL),
                    (bf16_t*)(big + BIG_ACT), INF(15), (const float*)(ws + WS_SSQ) + (size_t)1 * TALL};
    pg8::gemm_phase<pg8::EpiKVFQ, pg8::StaticOrder, true, true>(lds, g, S, E);
}
__device__ __forceinline__ void ph_cumsum(LAS unsigned char* lds) {
    PH_IDS; const float* cache_lf = INF(5); const float* out = OUTP; float* FB = (float*)(WSP + WS_FB); float* FS = (float*)(WSP + WS_FS);
    for (int it = blockIdx.x; it < 64 + 128; it += G) {
        LAS float* wtot = (LAS float*)lds;
        const bool smp = it >= 64; const int bh = smp ? it - 64 : it, b = bh >> 4, h = bh & 15, Ls = smp ? LKS : SEQ, per = smp ? 3 : 16, j0 = tid * per;
        float v[16]; float s = 0.f;
#pragma unroll
        for (int i = 0; i < 16; ++i) { const int j = j0 + i; float x = 0.f;
            if (i < per && j < Ls) x = smp ? (j < PASTL ? cache_lf[((size_t)b * PASTL + j) * 16 + h] : out[OUT_LFS + ((size_t)b * 32 + (j - PASTL)) * 16 + h]) : out[OUT_LFP + ((size_t)b * SEQ + j) * 16 + h];
            s += x; v[i] = s; }
        float inc = s;
#pragma unroll
        for (int o = 1; o < 64; o <<= 1) { const float t = __shfl_up(inc, o); if (lane >= o) inc += t; }
        if (lane == 63) wtot[wave] = inc;
        __syncthreads();
        float base = inc - s;
        for (int w = 0; w < wave; ++w) base += wtot[w];
#pragma unroll
        for (int i = 0; i < 16; ++i) { const int j = j0 + i; if (i < per && j < Ls) { const float F = base + v[i];
            if (smp) FS[(size_t)bh * LKS + j] = F; else FB[(size_t)bh * SEQ + j] = -F * 11.313708498984761f; } }
        __syncthreads();
    }
}
__device__ __forceinline__ void ph_attn(unsigned char* lds_raw) {
    unsigned char* ws = WSP; unsigned char* big = ws + WS_BIG;
    fox::attn_phase((char*)lds_raw, (const bf16_t*)(big + BIG_ACT), (const bf16_t*)(big + BIG_KB), (const bf16_t*)(big + BIG_VB), (bf16_t*)(big + BIG_XN), (const float*)(ws + WS_FB));
}
__device__ __forceinline__ void ph_sattn(LAS unsigned char* lds) {
    unsigned char* ws = WSP; unsigned char* big = ws + WS_BIG;
    sample_attn((LAS char*)lds, (const bf16_t*)(big + BIG_ACT), (const bf16_t*)(big + BIG_KALL), (const bf16_t*)(big + BIG_VALL), (const float*)(ws + WS_FS), (bf16_t*)(big + BIG_XN));
}
__device__ __forceinline__ void ph_gateup(LAS unsigned char* lds, const unsigned char* a_ptr, size_t w_off, int ssq_idx) {
    unsigned char* ws = WSP; unsigned char* big = ws + WS_BIG;
    pg8::Gemm g{(const bf16_t*)a_ptr, (const bf16_t*)(ws + w_off), TALL, 2 * DFF, DM, DM}; pg8::StaticOrder S; S.init(TALL, 2 * DFF, (int)gridDim.x, (int)blockIdx.x);
    pg8::EpiSwiglu E{(bf16_t*)(big + BIG_ACT), (const float*)(ws + WS_SSQ) + (size_t)ssq_idx * TALL};
    pg8::gemm_phase<pg8::EpiSwiglu, pg8::StaticOrder, true, true>(lds, g, S, E);
}

__global__ void __launch_bounds__(NWAVES * 64, 2) yoco_fwd(Params P) {
    extern __shared__ __attribute__((aligned(16))) unsigned char lds_raw[];
    cg::grid_group grid = cg::this_grid();
    LAS unsigned char* lds = (LAS unsigned char*)lds_raw;
    volatile LAS unsigned* bst = (volatile LAS unsigned*)(lds + 148480);
    if (opaque_tid() < 2) bst[opaque_tid()] = 0u;
    __syncthreads();
    const XcdBarrier xbar = xcd_barrier_post((unsigned*)(WSP + WS_BAR), bst);
#define GSYNC() xcd_barrier(xbar)
    ph_prologue(lds);                                                                                   grid.sync();
    ph_retin(lds); ph_conv<1>(lds);                                                                                      GSYNC();
    ph_retention(lds);                                                                                  GSYNC();
    ph_groupnorm();                                                                                     GSYNC();
    ph_res_gemm<true, TP>(lds, BIGP + 4096 * 2, WS_WRO, 4096, NPROJ, (bf16_t*)(OUTP + OUT_KP), 0); ph_sample_res<true>(BIGP + ((size_t)TP * NPROJ + 4096) * 2, NPROJ, WS_WRO, 4096, (bf16_t*)(OUTP + OUT_KP), 0);   GSYNC();
    ph_gateup(lds, (const unsigned char*)(OUTP + OUT_KP), WS_WGU0, 0); ph_conv<2>(lds);                                  GSYNC();
    ph_res_gemm<false, TP>(lds, BIGP + BIG_ACT, WS_WDN0, DFF, DFF, (bf16_t*)(BIGP + BIG_XN), 1); ph_sample_res(BIGP + BIG_ACT + (size_t)TP * DFF * 2, DFF, WS_WDN0, DFF, (bf16_t*)(BIGP + BIG_XN), 1); ph_cache_cvt();   GSYNC();
    ph_kvfq(lds); ph_conv<3>(lds);                                                                                       GSYNC();
    ph_cumsum(lds);                                                                                     GSYNC();
    ph_attn(lds_raw); __syncthreads(); ph_sattn(lds);                                                   GSYNC();
    ph_res_gemm<false, TP>(lds, BIGP + BIG_XN, WS_WO, DM, DM, (bf16_t*)(BIGP + BIG_HKV), 2); ph_sample_res(BIGP + BIG_XN + (size_t)TP * DM * 2, DM, WS_WO, DM, (bf16_t*)(BIGP + BIG_HKV), 2);   GSYNC();
    ph_gateup(lds, BIGP + BIG_HKV, WS_WGU1, 2); ph_conv<4>(lds);                                                         GSYNC();
    ph_res_gemm<false, TP>(lds, BIGP + BIG_ACT, WS_WDN1, DFF, DFF, nullptr, -1); ph_sample_res(BIGP + BIG_ACT + (size_t)TP * DFF * 2, DFF, WS_WDN1, DFF, nullptr, -1);   GSYNC();
    ph_rms<2>(INF(9), 0, nullptr, 0);
}

extern "C" void kernel_launch(void* const* d_in, const int* in_sizes, int n_in, void* d_out, int out_size, void* d_ws, size_t ws_size, hipStream_t stream) {
    static int grid = 0;
    if (grid == 0) {
        if (n_in != 21 || ws_size < WS_END) { fprintf(stderr, "kernel_launch: unexpected n_in %d / ws_size %zu (need %zu)\n", n_in, ws_size, (size_t)WS_END); grid = -1; return; }
        int dev = 0, cus = 0, per_cu = 0;
        (void)hipGetDevice(&dev); (void)hipDeviceGetAttribute(&cus, hipDeviceAttributeMultiprocessorCount, dev);
        if (hipFuncSetAttribute((const void*)yoco_fwd, hipFuncAttributeMaxDynamicSharedMemorySize, LDS_BYTES) != hipSuccess) { fprintf(stderr, "kernel_launch: hipFuncSetAttribute failed\n"); grid = -1; return; }
        if (hipOccupancyMaxActiveBlocksPerMultiprocessor(&per_cu, (const void*)yoco_fwd, NWAVES * 64, LDS_BYTES) != hipSuccess || per_cu < 1) { fprintf(stderr, "kernel_launch: occupancy query says %d\n", per_cu); per_cu = 1; }
        (void)hipGetLastError();
        grid = cus > 0 ? cus : 256;
    }
    if (grid < 0) return;
    if (hipMemsetAsync((char*)d_ws + WS_BAR, 0, XCD_BAR_WORDS * 4, stream) != hipSuccess) { fprintf(stderr, "kernel_launch: memset of the barrier words failed\n"); return; }
    Params p{};
    for (int i = 0; i < 21; ++i) p.in[i] = (const float*)d_in[i];
    p.out = (float*)d_out; p.ws = (unsigned char*)d_ws;
    void* args[] = {&p};
    hipError_t e = hipLaunchCooperativeKernel((const void*)yoco_fwd, dim3(grid), dim3(NWAVES * 64), args, LDS_BYTES, stream);
    if (e != hipSuccess) fprintf(stderr, "cooperative launch failed: %s (grid %d)\n", hipGetErrorString(e), grid);
}
```

```cpp
#include <hip/hip_runtime.h>
#include <hip/hip_cooperative_groups.h>
#include <cstdio>
#include <cstdint>
namespace cg = cooperative_groups;
__device__ __forceinline__ int opaque_tid() { int t = threadIdx.x; asm volatile("" : "+v"(t)); return t; }
namespace pg8 {
#define PG8_LAS __attribute__((address_space(3)))
typedef unsigned short bf16_t;
typedef short bf16x8 __attribute__((ext_vector_type(8)));
typedef float f32x4 __attribute__((ext_vector_type(4)));
typedef unsigned u32x4 __attribute__((ext_vector_type(4)));
constexpr int BM = 256, BK = 64, HALF = 128, HTB = HALF * BK * 2  , STAGE_BYTES = 8 * HTB, NXCD = 8, WGM = 4;

__host__ __device__ __forceinline__ int lds_byte(int r, int c) { const int st = (r >> 4) * 2 + (c >> 5), rr = r & 15, cc = c & 31, ob = rr * 64 + cc * 2; return st * 1024 + (ob ^ (((ob >> 9) & 1) << 5)); }
__host__ __device__ __forceinline__ void stage_rc(int b, int& R, int& C) { const int st = b / 1024, sb = b % 1024, swz = sb ^ (((sb >> 9) & 1) << 5); R = (st >> 1) * 16 + swz / 64; C = (st & 1) * 32 + (swz % 64) / 2; }
__host__ __device__ __forceinline__ int perm32(int rho) { const int n = rho >> 4, i = rho & 15; return 8 * (i >> 2) + 4 * n + (i & 3); }

struct Unit { int pm, pn; };
struct Gemm { const bf16_t* A; const bf16_t* Bt; int M, N, K, lda; };

struct StaticOrder {
    int nM, nN, nwg, G, c;
    __host__ __device__ void init(int M, int N, int G_, int c_) { nM = M / BM; nN = N / BM; nwg = nM * nN; G = G_; c = c_; }
    __host__ __device__ bool next(int i, Unit& u) const {
        const long L = (long)i * G + c; if (L >= nwg) return false;
        int wgid = (int)L; { const int q = nwg / NXCD, r = nwg % NXCD, xcd = wgid % NXCD, off = wgid / NXCD; wgid = (xcd < r ? xcd * (q + 1) : r * (q + 1) + (xcd - r) * q) + off; }
        const int nig = WGM * nN, gid = wgid / nig, fm = gid * WGM, gsz = (nM - fm) < WGM ? (nM - fm) : WGM;
        u.pm = fm + ((wgid % nig) % gsz); u.pn = (wgid % nig) / gsz; return true;
    }
    __device__ __forceinline__ void a_ready(const Unit&) const {}
    __device__ __forceinline__ void done(const Unit&) const {}
};

__device__ __forceinline__ unsigned cvt_pk_bf16(float lo, float hi) { unsigned r; asm volatile("v_cvt_pk_bf16_f32 %0, %1, %2" : "=v"(r) : "v"(lo), "v"(hi)); return r; }
template <class Epi, class Sched, bool ALIGN_EPI = false, bool SP2 = false>
__device__ __forceinline__ void gemm_phase(PG8_LAS unsigned char* lds, const Gemm g, const Sched& S, const Epi& E) {
    const int tid = opaque_tid(), wid = __builtin_amdgcn_readfirstlane(tid >> 6), lane = tid & 63, wr = wid >> 2, wc = wid & 3, fr = lane & 15, fq = lane >> 4;
    const int K = g.K, nt = K / BK;
    unsigned voffA[2], voffB[2];
#pragma unroll
    for (int i = 0; i < 2; ++i) { int R, C; stage_rc(tid * 16 + i * 8192, R, C); const int Rb = Epi::PERM ? ((R & ~31) + perm32(R & 31)) : R;
        voffA[i] = (unsigned)(R * g.lda + C) * 2u; voffB[i] = (unsigned)(Rb * K + C) * 2u; }
    const size_t kstep = (size_t)(BK * 2);
    const size_t hstep = (size_t)HALF * K * 2, hstepA = (size_t)HALF * g.lda * 2;
    const size_t tstep = 2 * hstep, tstepA = 2 * hstepA;
    const unsigned ldsw = (unsigned)wid * 1024u;
    const int aoff = lds_byte(wr * 64 + fr, fq * 8), boff = lds_byte(wc * 32 + fr, fq * 8);
#define PG8_SA(b, h) (((b) * 2 + (h)) * HTB)
#define PG8_SB(b, h) ((4 + (b) * 2 + (h)) * HTB)
#define PG8_STAGE(bufoff, gbase, voff) do { _Pragma("unroll") for (int _i = 0; _i < 2; ++_i) \
        __builtin_amdgcn_global_load_lds((const unsigned*)((const char*)(gbase) + (voff)[_i]), (PG8_LAS unsigned*)(lds + (bufoff) + ldsw + _i * 8192), 16, 0, 0); } while (0)
#define PG8_LDA(dst, b, h) do { _Pragma("unroll") for (int m = 0; m < 4; ++m) _Pragma("unroll") for (int k = 0; k < 2; ++k) dst[m][k] = *(const PG8_LAS bf16x8*)(lds + PG8_SA(b, h) + aoff + m * 2048 + k * 1024); } while (0)
#define PG8_LDB(dst, b, h) do { _Pragma("unroll") for (int n = 0; n < 2; ++n) _Pragma("unroll") for (int k = 0; k < 2; ++k) dst[n][k] = *(const PG8_LAS bf16x8*)(lds + PG8_SB(b, h) + boff + n * 2048 + k * 1024); } while (0)
#define PG8_MMA(ai, bj, At, Bt) do { __builtin_amdgcn_s_setprio(1); _Pragma("unroll") for (int m = 0; m < 4; ++m) _Pragma("unroll") for (int n = 0; n < 2; ++n) _Pragma("unroll") for (int k = 0; k < 2; ++k) \
        acc[ai][bj][m][n] = __builtin_amdgcn_mfma_f32_16x16x32_bf16(Bt[n][k], At[m][k], acc[ai][bj][m][n], 0, 0, 0); __builtin_amdgcn_s_setprio(0); } while (0)
#define PG8_WAIT_V(n) asm volatile("s_waitcnt vmcnt(" #n ")" ::: "memory")
#define PG8_WAIT_L(n) asm volatile("s_waitcnt lgkmcnt(" #n ")" ::: "memory")
#define PG8_BAR __builtin_amdgcn_s_barrier()
#define PG8_SCHED __builtin_amdgcn_sched_barrier(0)
    Unit cur, nxt; int ui = 0;
    if (!S.next(0, cur)) return;
    f32x4 acc[2][2][4][2];
#pragma unroll
    for (int a = 0; a < 2; ++a)
#pragma unroll
        for (int b = 0; b < 2; ++b)
#pragma unroll
            for (int m = 0; m < 4; ++m)
#pragma unroll
                for (int n = 0; n < 2; ++n) acc[a][b][m][n] = (f32x4){0.f, 0.f, 0.f, 0.f};
    bf16x8 At[4][2], B0[2][2], B1[2][2];
    const char* cA = (const char*)g.A + (size_t)cur.pm * tstepA; const char* cB = (const char*)g.Bt + (size_t)cur.pn * tstep;
    S.a_ready(cur);
    if constexpr (SP2) {
        PG8_STAGE(PG8_SB(0, 0), cB, voffB); PG8_STAGE(PG8_SB(0, 1), cB + hstep, voffB); PG8_STAGE(PG8_SA(0, 0), cA, voffA); PG8_STAGE(PG8_SA(0, 1), cA + hstepA, voffA);
        if (wr == 1) PG8_BAR;
        PG8_WAIT_V(2); PG8_BAR;
        PG8_STAGE(PG8_SB(1, 0), cB + kstep, voffB); PG8_STAGE(PG8_SA(1, 0), cA + kstep, voffA); PG8_STAGE(PG8_SB(1, 1), cB + hstep + kstep, voffB);
        PG8_WAIT_V(6); PG8_BAR;
    } else {
        PG8_STAGE(PG8_SB(0, 0), cB, voffB); PG8_STAGE(PG8_SA(0, 0), cA, voffA); PG8_STAGE(PG8_SB(0, 1), cB + hstep, voffB); PG8_STAGE(PG8_SA(0, 1), cA + hstepA, voffA);
        if (wr == 1) PG8_BAR;
        PG8_WAIT_V(4); PG8_BAR;
        PG8_STAGE(PG8_SB(1, 0), cB + kstep, voffB); PG8_STAGE(PG8_SA(1, 0), cA + kstep, voffA); PG8_STAGE(PG8_SB(1, 1), cB + hstep + kstep, voffB);
        PG8_WAIT_V(6); PG8_BAR;
    }
    for (;;) {
        const bool has_next = S.next(ui + 1, nxt);
        const char* nA = has_next ? (const char*)g.A + (size_t)nxt.pm * tstepA : cA; const char* nB = has_next ? (const char*)g.Bt + (size_t)nxt.pn * tstep : cB;
        for (int t = 0; t < nt; t += 2) {
            const bool last = (t == nt - 2);
            const char* a1 = cA + (size_t)(t + 1) * kstep;
            const char* a2 = last ? nA : cA + (size_t)(t + 2) * kstep; const char* b2 = last ? nB : cB + (size_t)(t + 2) * kstep;
            const char* a3 = a2 + kstep; const char* b3 = b2 + kstep;
            if (last && has_next) S.a_ready(nxt);
            if constexpr (SP2) {
            PG8_LDB(B0, 0, 0); PG8_LDB(B1, 0, 1); PG8_SCHED; PG8_LDA(At, 0, 0); PG8_STAGE(PG8_SA(1, 1), a1 + hstepA, voffA);
            PG8_WAIT_V(8); PG8_WAIT_L(0); PG8_BAR; PG8_MMA(0, 0, At, B0); PG8_MMA(0, 1, At, B1); PG8_BAR; PG8_SCHED;
            PG8_LDA(At, 0, 1); PG8_STAGE(PG8_SB(0, 0), b2, voffB); PG8_STAGE(PG8_SB(0, 1), b2 + hstep, voffB); PG8_STAGE(PG8_SA(0, 0), a2, voffA);
            PG8_WAIT_V(8); PG8_WAIT_L(0); PG8_BAR; PG8_MMA(1, 0, At, B0); PG8_MMA(1, 1, At, B1); PG8_BAR; PG8_SCHED;
            PG8_LDB(B0, 1, 0); PG8_LDB(B1, 1, 1); PG8_SCHED; PG8_LDA(At, 1, 0); PG8_STAGE(PG8_SA(0, 1), a2 + hstepA, voffA);
            PG8_WAIT_V(8); PG8_WAIT_L(0); PG8_BAR; PG8_MMA(0, 0, At, B0); PG8_MMA(0, 1, At, B1); PG8_BAR; PG8_SCHED;
            PG8_LDA(At, 1, 1); PG8_STAGE(PG8_SB(1, 0), b3, voffB); PG8_STAGE(PG8_SB(1, 1), b3 + hstep, voffB); PG8_STAGE(PG8_SA(1, 0), a3, voffA);
            PG8_WAIT_V(8); PG8_WAIT_L(0); PG8_BAR; PG8_MMA(1, 0, At, B0); PG8_MMA(1, 1, At, B1); PG8_BAR; PG8_SCHED;
            } else {
            PG8_LDB(B0, 0, 0); PG8_SCHED; PG8_LDA(At, 0, 0); PG8_STAGE(PG8_SA(1, 1), a1 + hstepA, voffA);
            PG8_WAIT_L(8); PG8_BAR; PG8_WAIT_L(0); PG8_MMA(0, 0, At, B0); PG8_BAR; PG8_SCHED;
            PG8_LDB(B1, 0, 1); PG8_STAGE(PG8_SB(0, 0), b2, voffB);
            PG8_BAR; PG8_WAIT_L(0); PG8_MMA(0, 1, At, B1); PG8_BAR;
            PG8_LDA(At, 0, 1); PG8_STAGE(PG8_SA(0, 0), a2, voffA);
            PG8_BAR; PG8_WAIT_L(0); PG8_MMA(1, 0, At, B0); PG8_BAR; PG8_SCHED;
            PG8_STAGE(PG8_SB(0, 1), b2 + hstep, voffB);
            PG8_WAIT_V(6); PG8_BAR; PG8_MMA(1, 1, At, B1); PG8_BAR;
            PG8_LDB(B0, 1, 0); PG8_SCHED; PG8_LDA(At, 1, 0); PG8_STAGE(PG8_SA(0, 1), a2 + hstepA, voffA);
            PG8_WAIT_L(8); PG8_BAR; PG8_WAIT_L(0); PG8_MMA(0, 0, At, B0); PG8_BAR; PG8_SCHED;
            PG8_LDB(B1, 1, 1); PG8_STAGE(PG8_SB(1, 0), b3, voffB);
            PG8_BAR; PG8_WAIT_L(0); PG8_MMA(0, 1, At, B1); PG8_BAR;
            PG8_LDA(At, 1, 1); PG8_STAGE(PG8_SA(1, 0), a3, voffA);
            PG8_BAR; PG8_WAIT_L(0); PG8_MMA(1, 0, At, B0); PG8_BAR; PG8_SCHED;
            PG8_STAGE(PG8_SB(1, 1), b3 + hstep, voffB);
            PG8_WAIT_V(6); PG8_BAR; PG8_MMA(1, 1, At, B1); PG8_BAR;
            }
        }
        if constexpr (ALIGN_EPI) { if (wr == 0) PG8_BAR; }
        if constexpr (!Epi::AFTER_DRAIN) { E(acc, cur, wr, wc, fr, fq); S.done(cur); }
        if (!has_next) break;
#pragma unroll
        for (int a = 0; a < 2; ++a)
#pragma unroll
            for (int b = 0; b < 2; ++b)
#pragma unroll
                for (int m = 0; m < 4; ++m)
#pragma unroll
                    for (int n = 0; n < 2; ++n) acc[a][b][m][n] = (f32x4){0.f, 0.f, 0.f, 0.f};
        cur = nxt; cA = nA; cB = nB; ++ui;
        if constexpr (ALIGN_EPI) { if (wr == 1) PG8_BAR; }
    }
    PG8_WAIT_V(0);
    if constexpr (!ALIGN_EPI) { if (wr == 0) PG8_BAR; }
    PG8_BAR;
    if constexpr (Epi::AFTER_DRAIN) { E.fused(acc, cur, wr, wc, fr, fq, lds, wid, lane); S.done(cur); }
#undef PG8_SA
#undef PG8_SB
#undef PG8_STAGE
#undef PG8_LDA
#undef PG8_LDB
#undef PG8_MMA
#undef PG8_WAIT_V
#undef PG8_WAIT_L
#undef PG8_BAR
#undef PG8_SCHED
}
}
constexpr int DM = 2048, TP = 32768, TSMP = 256, TALL = 33024, SEQ = 8192, NPROJ = 12288, DFF = 5632, PASTL = 1024, LKS = 1056;
#define GAS __attribute__((address_space(1)))
#define LAS __attribute__((address_space(3)))
typedef unsigned short bf16_t;
typedef float f32x4 __attribute__((ext_vector_type(4)));
typedef unsigned u32x4 __attribute__((ext_vector_type(4)));
typedef unsigned u32x2 __attribute__((ext_vector_type(2)));
typedef short bf16x8 __attribute__((ext_vector_type(8)));
typedef short s16x4 __attribute__((ext_vector_type(4)));

namespace pg8 {
__device__ __forceinline__ float silu_f(float g) { return g * __builtin_amdgcn_rcpf(1.0f + __builtin_amdgcn_exp2f(-1.4426950408889634f * g)); }
struct EpiBf16P {
    static constexpr bool PERM = true, AFTER_DRAIN = false;
    bf16_t* O; int ldc;
    __device__ __forceinline__ void operator()(const f32x4 (&acc)[2][2][4][2], const Unit& u, int wr, int wc, int fr, int fq) const {
        const int row0 = u.pm * BM + wr * 64 + fr, col0 = u.pn * BM + wc * 32 + 8 * fq;
#pragma unroll
        for (int ai = 0; ai < 2; ++ai)
#pragma unroll
            for (int m = 0; m < 4; ++m) { bf16_t* rowp = O + (size_t)(row0 + ai * HALF + m * 16) * ldc + col0;
#pragma unroll
                for (int bj = 0; bj < 2; ++bj) { const f32x4 v0 = acc[ai][bj][m][0], v1 = acc[ai][bj][m][1];
                    u32x4 w; w.x = cvt_pk_bf16(v0[0], v0[1]); w.y = cvt_pk_bf16(v0[2], v0[3]); w.z = cvt_pk_bf16(v1[0], v1[1]); w.w = cvt_pk_bf16(v1[2], v1[3]);
                    *(u32x4*)(rowp + bj * HALF) = w; } }
    }
};
struct EpiRetIn {
    static constexpr bool PERM = true, AFTER_DRAIN = false;
    bf16_t* O; const float* cosT; const float* sinT;
    __device__ __forceinline__ void operator()(const f32x4 (&acc)[2][2][4][2], const Unit& u, int wr, int wc, int fr, int fq) const {
        const int row0 = u.pm * BM + wr * 64 + fr, cl = wc * 32 + 8 * fq;
        bf16_t* obase = O + (size_t)u.pn * BM + cl;
        if (u.pn < 16) {
            const bool isk = u.pn >= 8; const int h = u.pn & 7;
            const float lg2 = __log2f(1.0f - exp2f(-5.0f - (float)h));
#pragma unroll
            for (int ai = 0; ai < 2; ++ai) {
                f32x4 cs[4][4]; float scv[4];
#pragma unroll
                for (int m = 0; m < 4; ++m) {
                    const int row = row0 + ai * HALF + m * 16; int pos, l;
                    if (row < TP) { pos = row & (SEQ - 1); l = row & 63; } else { const int s = (row - TP) & 31; pos = PASTL + s; l = s; }
                    scv[m] = isk ? exp2f(-lg2 * (float)l) * 0.0625f : exp2f(lg2 * (float)l);
                    const float* cp = cosT + (size_t)pos * 128 + cl; const float* sp = sinT + (size_t)pos * 128 + cl;
                    cs[m][0] = *(const f32x4*)cp; cs[m][1] = *(const f32x4*)(cp + 4); cs[m][2] = *(const f32x4*)sp; cs[m][3] = *(const f32x4*)(sp + 4); }
#pragma unroll
                for (int m = 0; m < 4; ++m) {
                    const int row = row0 + ai * HALF + m * 16; const float sc = scv[m];
                    const f32x4 c0 = cs[m][0], c1 = cs[m][1], s0 = cs[m][2], s1 = cs[m][3];
                    const f32x4 x1a = acc[ai][0][m][0], x1b = acc[ai][0][m][1], x2a = acc[ai][1][m][0], x2b = acc[ai][1][m][1];
                    const f32x4 o1a = (x1a * c0 - x2a * s0) * sc, o1b = (x1b * c1 - x2b * s1) * sc, o2a = (x1a * s0 + x2a * c0) * sc, o2b = (x1b * s1 + x2b * c1) * sc;
                    bf16_t* rowp = obase + (size_t)row * NPROJ;
                    u32x4 w; w.x = cvt_pk_bf16(o1a[0], o1a[1]); w.y = cvt_pk_bf16(o1a[2], o1a[3]); w.z = cvt_pk_bf16(o1b[0], o1b[1]); w.w = cvt_pk_bf16(o1b[2], o1b[3]);
                    *(u32x4*)rowp = w;
                    w.x = cvt_pk_bf16(o2a[0], o2a[1]); w.y = cvt_pk_bf16(o2a[2], o2a[3]); w.z = cvt_pk_bf16(o2b[0], o2b[1]); w.w = cvt_pk_bf16(o2b[2], o2b[3]);
                    *(u32x4*)(rowp + HALF) = w; }
                asm volatile("" ::: "memory"); }
        } else {
#pragma unroll
            for (int ai = 0; ai < 2; ++ai)
#pragma unroll
                for (int m = 0; m < 4; ++m) { bf16_t* rowp = obase + (size_t)(row0 + ai * HALF + m * 16) * NPROJ;
#pragma unroll
                    for (int bj = 0; bj < 2; ++bj) { const f32x4 v0 = acc[ai][bj][m][0], v1 = acc[ai][bj][m][1];
                        u32x4 w; w.x = cvt_pk_bf16(v0[0], v0[1]); w.y = cvt_pk_bf16(v0[2], v0[3]); w.z = cvt_pk_bf16(v1[0], v1[1]); w.w = cvt_pk_bf16(v1[2], v1[3]);
                        *(u32x4*)(rowp + bj * HALF) = w; } }
        }
    }
};
struct EpiRes {
    static constexpr bool PERM = false, AFTER_DRAIN = false;
    const float* baseP; const float* baseS; float* out; bf16_t* hb; float* ssq;
    __device__ __forceinline__ void operator()(const f32x4 (&acc)[2][2][4][2], const Unit& u, int wr, int wc, int fr, int fq) const {
        const int row0 = u.pm * BM + wr * 64 + fr, col0 = u.pn * BM + wc * 32 + 4 * fq;
#pragma unroll
        for (int ai = 0; ai < 2; ++ai) {
            f32x4 bv[4][2][2];
#pragma unroll
            for (int m = 0; m < 4; ++m) { const int row = row0 + ai * HALF + m * 16;
                const float* b = (row < TP ? baseP + (size_t)row * DM : baseS + (size_t)(row - TP) * DM) + col0;
#pragma unroll
                for (int bj = 0; bj < 2; ++bj)
#pragma unroll
                    for (int n = 0; n < 2; ++n) bv[m][bj][n] = *(const f32x4*)(b + bj * HALF + n * 16); }
#pragma unroll
            for (int m = 0; m < 4; ++m) { const int row = row0 + ai * HALF + m * 16; float* o = out + (size_t)row * DM + col0; float ss = 0.f;
#pragma unroll
                for (int bj = 0; bj < 2; ++bj)
#pragma unroll
                    for (int n = 0; n < 2; ++n) { const f32x4 v = bv[m][bj][n] + acc[ai][bj][m][n]; *(f32x4*)(o + bj * HALF + n * 16) = v;
                        if (hb) { u32x2 w; w.x = cvt_pk_bf16(v[0], v[1]); w.y = cvt_pk_bf16(v[2], v[3]); *(u32x2*)(hb + (size_t)row * DM + col0 + bj * HALF + n * 16) = w; }
                        ss += (v[0] * v[0] + v[1] * v[1]) + (v[2] * v[2] + v[3] * v[3]); }
                if (ssq) { ss += __shfl_xor(ss, 16); ss += __shfl_xor(ss, 32);
                    if (fq == 0) (void)__hip_atomic_fetch_add(ssq + row, ss, __ATOMIC_RELAXED, __HIP_MEMORY_SCOPE_AGENT); } }
            asm volatile("" ::: "memory"); }
    }
};
struct EpiSwiglu {
    static constexpr bool PERM = true, AFTER_DRAIN = false;
    bf16_t* O; const float* ssq;
    __device__ __forceinline__ void operator()(const f32x4 (&acc)[2][2][4][2], const Unit& u, int wr, int wc, int fr, int fq) const {
        const int row0 = u.pm * BM + wr * 64 + fr, col0 = u.pn * HALF + wc * 32 + 8 * fq;
        float rs[2][4];
#pragma unroll
        for (int ai = 0; ai < 2; ++ai)
#pragma unroll
            for (int m = 0; m < 4; ++m) rs[ai][m] = ssq[row0 + ai * HALF + m * 16];
#pragma unroll
        for (int ai = 0; ai < 2; ++ai)
#pragma unroll
            for (int m = 0; m < 4; ++m) { bf16_t* rowp = O + (size_t)(row0 + ai * HALF + m * 16) * DFF + col0; const float r = 1.0f / sqrtf(rs[ai][m] * (1.f / DM) + 1e-6f);
                const f32x4 g0 = acc[ai][0][m][0] * r, g1 = acc[ai][0][m][1] * r, u0 = acc[ai][1][m][0] * r, u1 = acc[ai][1][m][1] * r;
                f32x4 a0, a1;
#pragma unroll
                for (int j = 0; j < 4; ++j) { a0[j] = silu_f(g0[j]) * u0[j]; a1[j] = silu_f(g1[j]) * u1[j]; }
                u32x4 w; w.x = cvt_pk_bf16(a0[0], a0[1]); w.y = cvt_pk_bf16(a0[2], a0[3]); w.z = cvt_pk_bf16(a1[0], a1[1]); w.w = cvt_pk_bf16(a1[2], a1[3]);
                *(u32x4*)rowp = w; }
    }
};
struct EpiKVFQ {
    static constexpr bool PERM = false, AFTER_DRAIN = false;
    float* kP; float* vP; float* lfP; float* kS; float* vS; float* lfS; bf16_t* KB; bf16_t* VB; bf16_t* KALL; bf16_t* VALL; bf16_t* QB; const float* bf; const float* ssq;
    __device__ __forceinline__ void operator()(const f32x4 (&acc)[2][2][4][2], const Unit& u, int wr, int wc, int fr, int fq) const {
        const int row0 = u.pm * BM + wr * 64 + fr;
        float rs[2][4];
#pragma unroll
        for (int ai = 0; ai < 2; ++ai)
#pragma unroll
            for (int m = 0; m < 4; ++m) rs[ai][m] = 1.0f / sqrtf(ssq[row0 + ai * HALF + m * 16] * (1.f / DM) + 1e-6f);
        if (u.pn >= 5) {
            const int col0 = (u.pn - 5) * BM + wc * 32 + 4 * fq;
#pragma unroll
            for (int ai = 0; ai < 2; ++ai)
#pragma unroll
                for (int m = 0; m < 4; ++m) { bf16_t* bo = QB + (size_t)(row0 + ai * HALF + m * 16) * DM + col0;
#pragma unroll
                    for (int bj = 0; bj < 2; ++bj)
#pragma unroll
                        for (int n = 0; n < 2; ++n) { const f32x4 v = acc[ai][bj][m][n] * rs[ai][m]; u32x2 w; w.x = cvt_pk_bf16(v[0], v[1]); w.y = cvt_pk_bf16(v[2], v[3]); *(u32x2*)(bo + bj * HALF + n * 16) = w; } }
        } else if (u.pn < 4) {
            const bool isv = u.pn >= 2; const int col0 = (u.pn & 1) * BM + wc * 32 + 4 * fq;
            float* fP = isv ? vP : kP; float* fS = isv ? vS : kS; bf16_t* bP = isv ? VB : KB; bf16_t* bA = isv ? VALL : KALL;
#pragma unroll
            for (int ai = 0; ai < 2; ++ai)
#pragma unroll
                for (int m = 0; m < 4; ++m) { const int row = row0 + ai * HALF + m * 16; float* fo; bf16_t* bo;
                    if (row < TP) { fo = fP + (size_t)row * 512 + col0; bo = bP + (size_t)row * 512 + col0; }
                    else { const int r2 = row - TP; fo = fS + (size_t)r2 * 512 + col0; bo = bA + ((size_t)(r2 >> 5) * LKS + PASTL + (r2 & 31)) * 512 + col0; }
#pragma unroll
                    for (int bj = 0; bj < 2; ++bj)
#pragma unroll
                        for (int n = 0; n < 2; ++n) { const f32x4 v = acc[ai][bj][m][n] * rs[ai][m]; *(f32x4*)(fo + bj * HALF + n * 16) = v;
                            u32x2 w; w.x = cvt_pk_bf16(v[0], v[1]); w.y = cvt_pk_bf16(v[2], v[3]); *(u32x2*)(bo + bj * HALF + n * 16) = w; } }
        } else if (wc == 0) {
            const f32x4 bb = *(const f32x4*)(bf + 4 * fq);
#pragma unroll
            for (int ai = 0; ai < 2; ++ai)
#pragma unroll
                for (int m = 0; m < 4; ++m) { const int row = row0 + ai * HALF + m * 16; const f32x4 z = acc[ai][0][m][0] * rs[ai][m] + bb; f32x4 r;
#pragma unroll
                    for (int j = 0; j < 4; ++j) r[j] = fminf(z[j], 0.f) - log1pf(__expf(-fabsf(z[j])));
                    float* o = row < TP ? lfP + (size_t)row * 16 : lfS + (size_t)(row - TP) * 16; *(f32x4*)(o + 4 * fq) = r; }
        }
    }
};
}
namespace fox {
enum { ORDER_NATURAL = 0, ORDER_REVERSED = 1, ORDER_PAIRED = 2, ORDER_XCD = 4 };
constexpr int D = 128, QS = 2048, KS = 512, OS = 2048;
constexpr float THR = 8.f;
constexpr bool WSKIP = false;
constexpr float SCALE = 0.08838834764831845f;
constexpr int NW = 8, QBLK = 32, KVBLK = 64, QB = NW * QBLK;
constexpr int SHM_V = KVBLK * D * 2, SHM_K = KVBLK * D * 2;
constexpr int LDS_BYTES = 2 * SHM_V + 2 * SHM_K + NW * 64 * 4 + 2 * 64 * 4;
typedef unsigned short bf16;
typedef short bf16x8 __attribute__((ext_vector_type(8)));
typedef short s16x4 __attribute__((ext_vector_type(4)));
typedef float f32x16 __attribute__((ext_vector_type(16)));
typedef float f32x4 __attribute__((ext_vector_type(4)));
typedef unsigned u32x4 __attribute__((ext_vector_type(4)));
template <class A, class Bt> struct same_t { static constexpr bool v = false; };
template <class A> struct same_t<A, A> { static constexpr bool v = true; };

#define KSWZ(row, colB) ((row) * 256 + ((colB) ^ (((row) & 7) << 4)))
#define SBAR() __builtin_amdgcn_sched_barrier(0)
__device__ __forceinline__ int v_st(int k, int c) { const int kk = (k & ~0xC) | ((k & 4) << 1) | ((k & 8) >> 1); return ((kk >> 3) * 4 + (c >> 5)) * 512 + ((kk & 7) * 32 + (c & 31)) * 2; }
__device__ __forceinline__ int v_rd_base(int lane) { return ((lane & 3) << 3) | (((lane >> 2) & 3) << 6) | (((lane >> 4) & 1) << 5) | (((lane >> 5) & 1) << 8); }
constexpr int v_rd_off(int d0, int ks, int half) { return d0 * 512 + ks * 4096 + half * 2048; }
__device__ __forceinline__ int crow(int r, int hi) { return (r & 3) + 8 * (r >> 2) + 4 * hi; }
__device__ __forceinline__ unsigned cvtpk(float lo, float hi) {
    unsigned r; asm volatile("v_cvt_pk_bf16_f32 %0, %1, %2" : "=v"(r) : "v"(lo), "v"(hi)); return r;
}
__device__ __forceinline__ bf16x8 pack8(f32x4 a, f32x4 b) {
    u32x4 w = {cvtpk(a[0], a[1]), cvtpk(a[2], a[3]), cvtpk(b[0], b[1]), cvtpk(b[2], b[3])};
    return *reinterpret_cast<bf16x8*>(&w);
}
template <class T> __device__ __forceinline__ bf16x8 load8(const T* p) {
    if constexpr (same_t<T, float>::v) { return pack8(*(const f32x4*)p, *(const f32x4*)(p + 4)); }
    else { return *reinterpret_cast<const bf16x8*>(p); }
}
__device__ __forceinline__ void mask_tile(f32x16& p0, f32x16& p1, int dq, unsigned W) {
    const float NEG = -__builtin_inff();
#pragma unroll
    for (int r = 0; r < 16; ++r) {
        const int c = (r & 3) + 8 * (r >> 2);
        if ((unsigned)(dq - c) >= W) p0[r] = NEG;
        if ((unsigned)(dq - c - 32) >= W) p1[r] = NEG;
    }
}
__device__ __forceinline__ void partialSM(f32x16& p0, f32x16& p1, float& m_reg, float& mn, float& alpha) {
    float pmax = p0[0]; for (int r = 1; r < 16; ++r) pmax = fmaxf(pmax, p0[r]); for (int r = 0; r < 16; ++r) pmax = fmaxf(pmax, p1[r]);
    { auto rr = __builtin_amdgcn_permlane32_swap(__float_as_uint(pmax), __float_as_uint(pmax), false, false);
      pmax = fmaxf(__uint_as_float(rr[0]), __uint_as_float(rr[1])); }
    constexpr float C2 = 1.4426950408889634f * SCALE;
    if (__builtin_expect(__all((pmax - m_reg) * SCALE <= THR), 1)) { mn = m_reg; alpha = 1.f; }
    else { mn = fmaxf(m_reg, pmax); alpha = __builtin_amdgcn_exp2f((m_reg - mn) * C2); m_reg = mn; }
    const float mnL = -mn * C2;
    for (int r = 0; r < 16; ++r) p0[r] = fmaf(p0[r], C2, mnL); for (int r = 0; r < 16; ++r) p1[r] = fmaf(p1[r], C2, mnL);
    for (int r = 0; r < 16; ++r) p0[r] = __builtin_amdgcn_exp2f(p0[r]);
}
__device__ __forceinline__ void finishSM(f32x16& p0, f32x16& p1, float alpha, float& l_reg, bf16x8& pa0, bf16x8& pa1, bf16x8& pa2, bf16x8& pa3) {
    for (int r = 0; r < 16; ++r) p1[r] = __builtin_amdgcn_exp2f(p1[r]);
    float ps = 0; for (int r = 0; r < 16; ++r) ps += p0[r]; for (int r = 0; r < 16; ++r) ps += p1[r];
    { auto rr = __builtin_amdgcn_permlane32_swap(__float_as_uint(ps), __float_as_uint(ps), false, false);
      ps = __uint_as_float(rr[0]) + __uint_as_float(rr[1]); }
    l_reg = l_reg * alpha + ps;
#define PK4(P, B_, OUT) do { unsigned a0 = cvtpk(P[B_+0], P[B_+1]), a1 = cvtpk(P[B_+2], P[B_+3]);                          \
        unsigned b0 = cvtpk(P[B_+4], P[B_+5]), b1 = cvtpk(P[B_+6], P[B_+7]);                                             \
        auto r0 = __builtin_amdgcn_permlane32_swap(a0, b0, false, false); auto r1 = __builtin_amdgcn_permlane32_swap(a1, b1, false, false); \
        u32x4 w = {r0[0], r1[0], r0[1], r1[1]}; OUT = *reinterpret_cast<bf16x8*>(&w); } while (0)
    PK4(p0, 0, pa0); PK4(p0, 8, pa1); PK4(p1, 0, pa2); PK4(p1, 8, pa3);
#undef PK4
}
template <int KB, bool SK>
__device__ __forceinline__ void qkt(f32x16& p0, f32x16& p1, const char* K_lds, int r32, int hi, const bf16x8* qr, bool act) {
    if (SK && !act) { const float NEG = -__builtin_inff();
#pragma unroll
        for (int r = 0; r < 16; ++r) { p0[r] = NEG; p1[r] = NEG; } return; }
    { const float* bb_ = (const float*)(K_lds + 2 * SHM_K + NW * 64 * 4) + KB * 64 + 4 * hi;
#pragma unroll
      for (int q_ = 0; q_ < 4; ++q_) { const f32x4 b0_ = *(const f32x4*)(bb_ + 8 * q_), b1_ = *(const f32x4*)(bb_ + 32 + 8 * q_);
#pragma unroll
        for (int i_ = 0; i_ < 4; ++i_) { p0[4 * q_ + i_] = b0_[i_]; p1[4 * q_ + i_] = b1_[i_]; } } }
    const char* kb[4];
#pragma unroll
    for (int dd = 0; dd < 4; ++dd) kb[dd] = K_lds + KB * SHM_K + KSWZ(r32, (dd * 16 + hi * 8) * 2);
#pragma unroll
    for (int d0 = 0; d0 < 8; ++d0) { const char* a = kb[d0 & 3] + (d0 >> 2) * 128;
        bf16x8 b0 = *reinterpret_cast<const bf16x8*>(a);
        bf16x8 b1 = *reinterpret_cast<const bf16x8*>(a + 32 * 256);
        p0 = __builtin_amdgcn_mfma_f32_32x32x16_bf16(b0, qr[d0], p0, 0, 0, 0);
        p1 = __builtin_amdgcn_mfma_f32_32x32x16_bf16(b1, qr[d0], p1, 0, 0, 0); }
}
template <int VB, bool SK>
__device__ __forceinline__ void pv_tile(f32x16* o, int vb0, bf16x8 pa0, bf16x8 pa1, bf16x8 pa2, bf16x8 pa3, bool act) {
    if (SK && !act) return;
#define TRRD(dst, off) asm volatile("ds_read_b64_tr_b16 %0, %1 offset:%2" : "=&v"(dst) : "v"(vb0), "i"(off) : "memory")
#define PV_D0(d0) do { s16x4 l0, l1, l2, l3, h0, h1, h2, h3; constexpr int b_ = VB * SHM_V + v_rd_off(d0, 0, 0);     \
        TRRD(l0, b_); TRRD(h0, b_ + 2048); TRRD(l1, b_ + 4096); TRRD(h1, b_ + 6144); TRRD(l2, b_ + 8192); TRRD(h2, b_ + 10240); TRRD(l3, b_ + 12288); TRRD(h3, b_ + 14336); \
        asm volatile("s_waitcnt lgkmcnt(0)" ::: "memory"); SBAR();                 \
        o[d0] = __builtin_amdgcn_mfma_f32_32x32x16_bf16(pa0, (bf16x8){l0[0], l0[1], l0[2], l0[3], h0[0], h0[1], h0[2], h0[3]}, o[d0], 0, 0, 0);   \
        o[d0] = __builtin_amdgcn_mfma_f32_32x32x16_bf16(pa1, (bf16x8){l1[0], l1[1], l1[2], l1[3], h1[0], h1[1], h1[2], h1[3]}, o[d0], 0, 0, 0);   \
        o[d0] = __builtin_amdgcn_mfma_f32_32x32x16_bf16(pa2, (bf16x8){l2[0], l2[1], l2[2], l2[3], h2[0], h2[1], h2[2], h2[3]}, o[d0], 0, 0, 0);   \
        o[d0] = __builtin_amdgcn_mfma_f32_32x32x16_bf16(pa3, (bf16x8){l3[0], l3[1], l3[2], l3[3], h3[0], h3[1], h3[2], h3[3]}, o[d0], 0, 0, 0); } while (0)
    PV_D0(0); PV_D0(1); PV_D0(2); PV_D0(3);
#undef PV_D0
#undef TRRD
}
template <class TIn, class TOut> struct BlockRef { const TIn* Q; const TIn* K; const TIn* V; TOut* O; const float* FB; int P0; };
template <class TIn> struct Seam {
    bf16x8 qr[8];
    bf16x8 st_v0, st_v1, st_k0, st_k1; float st_f; f32x4 sf0, sf1, sf2, sf3;
    f32x4 tq[16];
};
__device__ __forceinline__ int swa_jlo(int P0, int W) { const int lowk = P0 - W + 1; return lowk > 0 ? lowk / KVBLK : 0; }
#define ROW(p, k0, rr) ((p) + (size_t)((k0) + (rr)) * KS + sc)
#define VMW() asm volatile("s_waitcnt vmcnt(0)" ::: "memory")
#define VMWN(n) asm volatile("s_waitcnt vmcnt(%0)" :: "i"(n) : "memory")
#define SLOAD_H(Kp, Vp, Fp, k0) do { S.st_f = (Fp)[(k0) + (tid & 63)]; S.st_v0 = load8<TIn>(ROW(Vp, k0, sr)); S.st_v1 = load8<TIn>(ROW(Vp, k0, 32 + sr));              \
                         S.st_k0 = load8<TIn>(ROW(Kp, k0, sr)); S.st_k1 = load8<TIn>(ROW(Kp, k0, 32 + sr)); } while (0)
#define SWRITE_HK(bf) do { ((float*)(K_lds + 2 * SHM_K + NW * 64 * 4))[(bf) * 64 + (tid & 63)] = S.st_f; *(bf16x8*)(K_lds + (bf) * SHM_K + kws) = S.st_k0; *(bf16x8*)(K_lds + (bf) * SHM_K + kws + 32 * 256) = S.st_k1; } while (0)
#define SWRITE_HV(bf) do { *(bf16x8*)(V_lds + (bf) * SHM_V + vst0) = S.st_v0; *(bf16x8*)(V_lds + (bf) * SHM_V + vst1) = S.st_v1; } while (0)
#define SWRITE_H(bf) do { SWRITE_HV(bf); SWRITE_HK(bf); } while (0)
#define SLOAD_F(p, k0) do { S.sf0 = *(const f32x4*)ROW(p, k0, sr); S.sf1 = *(const f32x4*)(ROW(p, k0, sr) + 4);                \
                            S.sf2 = *(const f32x4*)ROW(p, k0, 32 + sr); S.sf3 = *(const f32x4*)(ROW(p, k0, 32 + sr) + 4); } while (0)
#define SWRITE_KF(bf) do { *(bf16x8*)(K_lds + (bf) * SHM_K + kws) = pack8(S.sf0, S.sf1); *(bf16x8*)(K_lds + (bf) * SHM_K + kws + 32 * 256) = pack8(S.sf2, S.sf3); } while (0)
#define SWRITE_VF(bf) do { *(bf16x8*)(V_lds + (bf) * SHM_V + vst0) = pack8(S.sf0, S.sf1); *(bf16x8*)(V_lds + (bf) * SHM_V + vst1) = pack8(S.sf2, S.sf3); } while (0)
template <class TIn, class TOut>
__device__ __forceinline__ void causal_swa_prime(const BlockRef<TIn, TOut>& cur, int W, char* lds, Seam<TIn>& S) {
    constexpr bool F32 = same_t<TIn, float>::v;
    const int tid = opaque_tid(), wid = __builtin_amdgcn_readfirstlane(tid >> 6), lane = tid & 63, r32 = lane & 31, hi = lane >> 5;
    const int sr = tid >> 4, sc = (tid & 15) * 8, kws = KSWZ(sr, sc * 2); char* K_lds = lds + 2 * SHM_V;
    const int kb0 = swa_jlo(cur.P0, W) * KVBLK;
    for (int d0 = 0; d0 < 8; ++d0) S.qr[d0] = load8<TIn>(cur.Q + (size_t)(wid * QBLK + r32) * QS + d0 * 16 + hi * 8);
    if constexpr (F32) { SLOAD_F((const float*)cur.K, kb0); VMW(); SWRITE_KF(0); SBAR(); SLOAD_F((const float*)cur.V, kb0); }
    else { SLOAD_H(cur.K, cur.V, cur.FB, kb0); VMW(); SWRITE_HK(0); }
    __syncthreads();
}
template <class TIn, class TOut>
__device__ __forceinline__ void causal_swa_block(const BlockRef<TIn, TOut>& cur, const BlockRef<TIn, TOut>& nxt, int skv, int W, char* lds, Seam<TIn>& S) {
    constexpr bool F32 = same_t<TIn, float>::v;
    const int tid = opaque_tid(), wid = __builtin_amdgcn_readfirstlane(tid >> 6), lane = tid & 63, r32 = lane & 31, hi = lane >> 5;
    const int j_lo = swa_jlo(cur.P0, W);
    int j_hi = (cur.P0 + QB - 1) / KVBLK + 1; if (j_hi > skv / KVBLK) j_hi = skv / KVBLK;
    const int NT = j_hi - j_lo;
    const int kbn = swa_jlo(nxt.P0, W) * KVBLK;
    const int qlo = cur.P0 + wid * QBLK, qm = qlo + r32 - 4 * hi;
    char* V_lds = lds; char* K_lds = lds + 2 * SHM_V;
    float* ws = (float*)(lds + 2 * SHM_V + 2 * SHM_K) + wid * 64; float* li_l = ws, * al_l = ws + 32;
    float m_reg = -1e30f, l_reg = 0; f32x16 o[4] = {};
    const int sr = tid >> 4, sc = (tid & 15) * 8, vst0 = v_st(sr, sc), vst1 = v_st(32 + sr, sc), kws = KSWZ(sr, sc * 2);
    const int vb0 = (int)(uintptr_t)V_lds + v_rd_base(lane);
    const TIn* Kh = cur.K; const TIn* Vh = cur.V;
#define RESC(a) do { if (__any((a) < 1.f)) { if (hi == 0) al_l[r32] = (a); asm volatile("s_waitcnt lgkmcnt(0)" ::: "memory");              \
                     for (int d_ = 0; d_ < 4; ++d_) for (int r = 0; r < 16; ++r) o[d_][r] *= al_l[crow(r, hi)]; } } while (0)
#define KBASE(t) ((j_lo + (t)) * KVBLK)
#define ACT(t) (KBASE(t) <= qlo + QBLK - 1 && KBASE(t) + KVBLK - 1 >= qlo - W + 1)
#define MASKT(P0_, P1_, t) do { const int kb_ = KBASE(t); if ((!SK || ACT(t)) && (kb_ + KVBLK - 1 > qlo || kb_ <= qlo + QBLK - 1 - W)) mask_tile(P0_, P1_, qm - kb_, (unsigned)W); } while (0)
    constexpr int NQL = F32 ? 16 : 8;
    constexpr bool SK = WSKIP && !F32;
#define SEAM_K0() do { VMWN(NQL); if constexpr (F32) { SWRITE_KF(0); SBAR(); SLOAD_F((const float*)nxt.V, kbn); } else { SWRITE_HK(0); } SBAR(); } while (0)
    f32x16 pA0, pA1, pB0, pB1; float mnA, mnB, alA, alB; bf16x8 pa0, pa1, pa2, pa3;
    if constexpr (F32) { VMW(); SWRITE_VF(0); SBAR(); } else { SWRITE_HV(0); SBAR(); }
    if (NT > 1) { if constexpr (F32) SLOAD_F((const float*)Kh, KBASE(1)); else SLOAD_H(Kh, Vh, cur.FB, KBASE(1)); }
    SBAR(); qkt<0, SK>(pA0, pA1, K_lds, r32, hi, S.qr, ACT(0));
    if constexpr (F32) { if (NT > 1) { VMW(); SWRITE_KF(1); SBAR(); SLOAD_F((const float*)Vh, KBASE(1)); } }
    MASKT(pA0, pA1, 0); partialSM(pA0, pA1, m_reg, mnA, alA);
    if (NT > 1) { VMW(); if constexpr (F32) { SWRITE_VF(1); SBAR(); if (NT > 2) SLOAD_F((const float*)Kh, KBASE(2)); } else SWRITE_H(1); }
    __syncthreads();
#define HALF_STEP(PX0, PX1, mnX, alX, PY0, PY1, alY, t, KB, VB, SB) do {                                                      \
        SBAR(); qkt<KB, SK>(PX0, PX1, K_lds, r32, hi, S.qr, ACT(t));                                             \
        finishSM(PY0, PY1, alY, l_reg, pa0, pa1, pa2, pa3); SBAR();                                                           \
        if ((t) + 1 < NT) { if constexpr (F32) { VMW(); SWRITE_KF(SB); SBAR(); SLOAD_F((const float*)Vh, KBASE((t) + 1)); }  \
                            else { SLOAD_H(Kh, Vh, cur.FB, KBASE((t) + 1)); } SBAR(); }                                               \
        pv_tile<VB, SK>(o, vb0, pa0, pa1, pa2, pa3, ACT((t) - 1)); MASKT(PX0, PX1, (t)); partialSM(PX0, PX1, m_reg, mnX, alX);                                        \
        __syncthreads();                                                                                                      \
        if ((t) + 1 < NT) { VMW(); if constexpr (F32) { SWRITE_VF(SB); SBAR(); if ((t) + 2 < NT) SLOAD_F((const float*)Kh, KBASE((t) + 2)); } \
                            else { SWRITE_H(SB); } }                                                                          \
        RESC(alX); __syncthreads(); } while (0)
    for (int t = 1; t + 1 < NT; t += 2) {
        HALF_STEP(pB0, pB1, mnB, alB, pA0, pA1, alA, t, 1, 0, 0);
        HALF_STEP(pA0, pA1, mnA, alA, pB0, pB1, alB, t + 1, 0, 1, 1);
    }
    const bool even = (NT & 1) == 0;
    if (even) { SBAR(); qkt<1, SK>(pB0, pB1, K_lds, r32, hi, S.qr, ACT(NT - 1)); SBAR(); }
#define QROW(e) (nxt.Q + (size_t)(wid * QBLK + r32) * D + ((e) >> 1) * 16 + hi * 8 + ((e) & 1) * 4)
    if constexpr (F32) { SLOAD_F((const float*)nxt.K, kbn); SBAR();
#pragma unroll
        for (int e = 0; e < 8; ++e) S.tq[e] = *(const f32x4*)QROW(e); }
    else { SLOAD_H(nxt.K, nxt.V, nxt.FB, kbn); SBAR();
#pragma unroll
        for (int d0 = 0; d0 < 8; ++d0) S.qr[d0] = load8<TIn>(nxt.Q + (size_t)(wid * QBLK + r32) * QS + d0 * 16 + hi * 8); }
    SBAR();
    finishSM(pA0, pA1, alA, l_reg, pa0, pa1, pa2, pa3); SBAR();
    if constexpr (F32) {
#pragma unroll
        for (int e = 8; e < 16; ++e) S.tq[e] = *(const f32x4*)QROW(e); SBAR(); }
#undef QROW
    pv_tile<0, SK>(o, vb0, pa0, pa1, pa2, pa3, ACT(even ? NT - 2 : NT - 1));
    if (even) { MASKT(pB0, pB1, NT - 1); partialSM(pB0, pB1, m_reg, mnB, alB); __syncthreads(); RESC(alB);
        finishSM(pB0, pB1, alB, l_reg, pa0, pa1, pa2, pa3); SBAR(); pv_tile<1, SK>(o, vb0, pa0, pa1, pa2, pa3, ACT(NT - 1)); }
    SBAR(); SEAM_K0();
    if (hi == 0) li_l[r32] = l_reg; asm volatile("s_waitcnt lgkmcnt(0)" ::: "memory");
    float rli[16];
#pragma unroll
    for (int r = 0; r < 16; ++r) rli[r] = __builtin_amdgcn_rcpf(li_l[crow(r, hi)]);
    TOut* Ow = cur.O + (size_t)(wid * QBLK) * OS;
#pragma unroll
    for (int r = 0; r < 16; ++r) { const int orow = crow(r, hi);
#pragma unroll
        for (int d0 = 0; d0 < 4; ++d0) { const float v = o[d0][r] * rli[r];
            if constexpr (same_t<TOut, float>::v) { Ow[(size_t)orow * OS + d0 * 32 + r32] = v; }
            else { const float vn = __shfl_xor(v, 1);
                   if ((r32 & 1) == 0) *(unsigned*)(Ow + (size_t)orow * OS + d0 * 32 + r32) = cvtpk(v, vn); } } }
    if constexpr (F32) {
#pragma unroll
        for (int d0 = 0; d0 < 8; ++d0) S.qr[d0] = pack8(S.tq[2 * d0], S.tq[2 * d0 + 1]); }
    __syncthreads();
#undef RESC
#undef KBASE
#undef ACT
#undef MASKT
#undef SEAM_K0
#undef HALF_STEP
}
#undef ROW
#undef VMW
#undef VMWN
#undef SLOAD_H
#undef SWRITE_HK
#undef SWRITE_HV
#undef SWRITE_H
#undef SLOAD_F
#undef SWRITE_KF
#undef SWRITE_VF

__host__ __device__ inline int swa_nramp(int nqb, int W, int qoff) { const int t = W - 1 - qoff; const int n = t < 0 ? 0 : t / QB + 1; return n > nqb ? nqb : n; }
__host__ __device__ inline int swa_nx(int nqb, int nramp, int order) { return (order & ORDER_PAIRED) ? (nramp + 1) / 2 + (nqb - nramp) : nqb; }
struct SwaItem { int bh, qb0, qb1; };
__device__ __forceinline__ SwaItem swa_decode(int L, int nb, int nh, int nhkv, int nqb, int nx, int nramp, int order) {
    const int G = nh / nhkv; SwaItem it; int x;
    if ((order & ORDER_XCD) && (nb * nhkv) % 8 == 0) { const int xcd = L & 7, k = L >> 3, per = G * nx, gi = k / per, r = k - gi * per;
        it.bh = (gi * 8 + xcd) * G + r / nx; x = r % nx; }
    else { it.bh = L / nx; x = L - it.bh * nx; }
    if (order & ORDER_PAIRED) { const int ns = nqb - nramp;
        if (x < ns) { it.qb0 = it.qb1 = nqb - 1 - x; } else { it.qb0 = x - ns; it.qb1 = nramp - 1 - it.qb0; } }
    else { it.qb0 = it.qb1 = ((order & 3) == ORDER_REVERSED) ? nqb - 1 - x : x; }
    return it;
}
typedef unsigned short bf16;
__device__ __forceinline__ BlockRef<bf16, bf16> mk_ref(const SwaItem& it, int pass, const bf16* Q, const bf16* K, const bf16* V, bf16* O, const float* FB) {
    const int qb = pass ? it.qb1 : it.qb0, b = it.bh >> 4, h = it.bh & 15, kvh = h >> 2;
    BlockRef<bf16, bf16> r;
    r.Q = Q + ((size_t)b * 8192 + (size_t)qb * QB) * QS + h * 128; r.O = O + ((size_t)b * 8192 + (size_t)qb * QB) * OS + h * 128;
    r.K = K + (size_t)b * 8192 * KS + kvh * 128; r.V = V + (size_t)b * 8192 * KS + kvh * 128; r.FB = FB + (size_t)it.bh * 8192; r.P0 = qb * QB;
    return r;
}
__device__ __forceinline__ void attn_phase(char* lds, const bf16* Q, const bf16* K, const bf16* V, bf16* O, const float* FB) {
    constexpr int nb = 4, nh = 16, nhkv = 4, nqb = 32, W = 8192, order = ORDER_PAIRED | ORDER_XCD;
    const int nramp = swa_nramp(nqb, W, 0), nx = swa_nx(nqb, nramp, order), total = nx * nb * nh, stride = gridDim.x;
    int L = blockIdx.x; if (L >= total) return;
    SwaItem it = swa_decode(L, nb, nh, nhkv, nqb, nx, nramp, order); int pass = 0;
    BlockRef<bf16, bf16> cur = mk_ref(it, 0, Q, K, V, O, FB);
    Seam<bf16> S;
    causal_swa_prime<bf16, bf16>(cur, W, lds, S);
    for (;;) {
        const bool more_pass = pass == 0 && it.qb1 != it.qb0, more_item = L + stride < total, last = !more_pass && !more_item;
        SwaItem itn = it; int passn = pass + 1, Ln = L;
        if (!more_pass) { passn = 0; Ln = more_item ? L + stride : L; itn = swa_decode(Ln, nb, nh, nhkv, nqb, nx, nramp, order); }
        const BlockRef<bf16, bf16> nxt = last ? cur : mk_ref(itn, passn, Q, K, V, O, FB);
        causal_swa_block<bf16, bf16>(cur, nxt, 8192, W, lds, S);
        if (last) break;
        cur = nxt; it = itn; pass = passn; L = Ln;
    }
}
}
constexpr size_t WS_WIN = 0, WS_WRO = 50331648, WS_WGU0 = 67108864, WS_WGU1 = 113246208, WS_WDN0 = 159383552, WS_WDN1 = 182452224,
                 WS_WO = 205520896, WS_WKVF = 213909504  , WS_COS = 227540992, WS_SIN = 231735296, WS_FB = 235929600, WS_FS = WS_FB + 2097152, WS_SSQ = WS_FS + 540672  , WS_BAR = WS_SSQ + 396288  ,
                 WS_BIG = 239075328;
constexpr size_t SZ_ROWS2K = (size_t)TALL * DM * 2;
constexpr size_t BIG_XN = 0, BIG_ACT = SZ_ROWS2K, BIG_HKV = BIG_ACT + (size_t)TALL * DFF * 2, BIG_KB = BIG_HKV + SZ_ROWS2K, BIG_VB = BIG_KB + (size_t)TP * 512 * 2,
                 BIG_KALL = BIG_VB + (size_t)TP * 512 * 2, BIG_VALL = BIG_KALL + (size_t)8 * LKS * 512 * 2, BIG_END = BIG_VALL + (size_t)8 * LKS * 512 * 2;
static_assert(BIG_END <= (size_t)TALL * NPROJ * 2, "layer-1 buffers fit in the PROJ region");
constexpr size_t WS_END = WS_BIG + (size_t)TALL * NPROJ * 2;
static_assert(WS_END <= (size_t)1073741824, "workspace fits 1 GiB");
constexpr size_t OUT_Y = 0, OUT_SP = 67633152, OUT_KP = 71827456, OUT_VP = 88604672, OUT_LFP = 105381888, OUT_SS = 105906176, OUT_KS = 114294784, OUT_VS = 114425856, OUT_LFS = 114556928;
constexpr int NWAVES = 8, LDS_BYTES = 149504;

struct Params { const float* in[21]; float* out; unsigned char* ws; };

__device__ __forceinline__ float wave_sum(float v) {
#pragma unroll
    for (int o = 1; o < 64; o <<= 1) v += __shfl_xor(v, o);
    return v;
}
__device__ __forceinline__ float bf2f(unsigned short b) { return __uint_as_float(((unsigned)b) << 16); }
__device__ __forceinline__ unsigned pk2(float lo, float hi) { return pg8::cvt_pk_bf16(lo, hi); }

__device__ __forceinline__ void transpose_item(const float* W, int K, int N, bf16_t* WT, int k0, int n0, int drow0, LAS float* scr, int lane, const float* gain = nullptr) {
    float wv[32];
#pragma unroll
    for (int i = 0; i < 32; ++i) { const int kk = 2 * i + (lane >> 5); wv[i] = W[(size_t)(k0 + kk) * N + n0 + (lane & 31)] * (gain ? gain[k0 + kk] : 1.f); }
#pragma unroll
    for (int i = 0; i < 32; ++i) { const int kk = 2 * i + (lane >> 5); scr[kk * 33 + (lane & 31)] = wv[i]; }
    asm volatile("s_waitcnt lgkmcnt(0)" ::: "memory");
    const int c = lane & 7;
#pragma unroll
    for (int j = 0; j < 4; ++j) { const int n = (lane >> 3) + 8 * j; const LAS float* s = scr + (8 * c) * 33 + n;
        u32x4 o; o.x = pk2(s[0 * 33], s[1 * 33]); o.y = pk2(s[2 * 33], s[3 * 33]); o.z = pk2(s[4 * 33], s[5 * 33]); o.w = pk2(s[6 * 33], s[7 * 33]);
        *(u32x4*)(WT + (size_t)(drow0 + n) * K + k0 + 8 * c) = o; }
    asm volatile("s_waitcnt lgkmcnt(0)" ::: "memory");
}
__device__ __forceinline__ void tr_plain(const float* W, int K, int N, bf16_t* WT, int row_off, LAS float* scr, int item, int lane, const float* gain = nullptr) {
    const int nblk = N / 32, kb = item / nblk, nb = item % nblk; transpose_item(W, K, N, WT, 64 * kb, 32 * nb, row_off + 32 * nb, scr, lane, gain);
}
__device__ __forceinline__ void tr_gu(const float* W, bf16_t* WT, int up, LAS float* scr, int item, int lane, const float* gain) {
    const int nblk = DFF / 32, kb = item / nblk, nb = item % nblk, n0 = 32 * nb; transpose_item(W, DM, DFF, WT, 64 * kb, n0, (n0 >> 7) * 256 + up * 128 + (n0 & 127), scr, lane, gain);
}
template <int MODE  >
__device__ __forceinline__ void rms_row(const float* xrow, const float* g1, bf16_t* o1, const float* g2, bf16_t* o2, float* of, int lane) {
    const f32x4* xr = (const f32x4*)xrow + lane;
    f32x4 v[8]; float s = 0.f;
#pragma unroll
    for (int j = 0; j < 8; ++j) { v[j] = xr[64 * j]; s += (v[j].x * v[j].x + v[j].y * v[j].y) + (v[j].z * v[j].z + v[j].w * v[j].w); }
    const float rs = 1.0f / sqrtf(wave_sum(s) * (1.f / DM) + 1e-6f);
#pragma unroll
    for (int j = 0; j < 8; ++j) { const f32x4 ga = ((const f32x4*)g1)[64 * j + lane]; const f32x4 y = v[j] * rs;
        if (MODE == 2) { ((f32x4*)of)[64 * j + lane] = y * ga; }
        else { u32x2 w; w.x = pk2(y.x * ga.x, y.y * ga.y); w.y = pk2(y.z * ga.z, y.w * ga.w); ((u32x2*)o1)[64 * j + lane] = w;
            if (MODE == 1) { const f32x4 gb = ((const f32x4*)g2)[64 * j + lane]; u32x2 w2; w2.x = pk2(y.x * gb.x, y.y * gb.y); w2.y = pk2(y.z * gb.z, y.w * gb.w); ((u32x2*)o2)[64 * j + lane] = w2; } } }
}

namespace ret {
constexpr int KOFF = 0, STOFF = 32768, VOFF = 65536, POFF = 74752, VS = 144;
typedef short v4i16_t __attribute__((ext_vector_type(4)));
__device__ __forceinline__ bf16x8 frag_rm(const LAS char* base, int stride, int i0, int k0, int fr, int fq) { return *(const LAS bf16x8*)(base + (i0 + fr) * stride + (k0 + 8 * fq) * 2); }
__device__ __forceinline__ bf16x8 frag_sw(const LAS char* base, int i0, int k0, int fr, int fq) { return *(const LAS bf16x8*)(base + (i0 + fr) * 512 + ((((k0 >> 3) + fq) ^ fr) << 4)); }
__device__ __forceinline__ s16x4 tr4(const LAS char* p) { return __builtin_bit_cast(s16x4, __builtin_amdgcn_ds_read_tr16_b64_v4i16((LAS v4i16_t*)p)); }
__device__ __forceinline__ bf16x8 frag_tr(const LAS char* base, int stride, int k0, int i0, int fr, int fq) {
    const LAS char* p = base + (k0 + 8 * fq + (fr >> 2)) * stride + (i0 + 4 * (fr & 3)) * 2;
    const s16x4 a = tr4(p), b = tr4(p + 4 * stride);
    return (bf16x8){a[0], a[1], a[2], a[3], b[0], b[1], b[2], b[3]};
}
__device__ __forceinline__ bf16x8 frag_tr_sw(const LAS char* base, int k0, int i0, int fr, int fq) {
    const int m = k0 + 8 * fq + (fr >> 2), d = i0 + 4 * (fr & 3);
    const s16x4 a = tr4(base + m * 512 + ((((d >> 3) ^ (m & 15))) << 4) + (d & 7) * 2), b = tr4(base + (m + 4) * 512 + ((((d >> 3) ^ ((m + 4) & 15))) << 4) + (d & 7) * 2);
    return (bf16x8){a[0], a[1], a[2], a[3], b[0], b[1], b[2], b[3]};
}
#define MFMA16(X, Y, C) __builtin_amdgcn_mfma_f32_16x16x32_bf16(X, Y, C, 0, 0, 0)
__device__ __forceinline__ void ret_item(LAS char* lds, const bf16_t* pin, bf16_t* pout  , int nchunks, int c, int h, int es, const float* S0, float* Sout) {
    const int tid = opaque_tid(), wid = __builtin_amdgcn_readfirstlane(tid >> 6), lane = tid & 63, fr = lane & 15, fq = lane >> 4, lt = wid >> 1, half = wid & 1;
    const float lg2 = __log2f(1.0f - exp2f(-5.0f - (float)h)), gam = exp2f(lg2), gc1 = exp2f(lg2 * (float)(c - 1));
    f32x4 accT[8];
    const int eT = 16 * lt + fr;
#pragma unroll
    for (int i = 0; i < 8; ++i) { const int d0 = 16 * (8 * half + i) + 4 * fq;
#pragma unroll
        for (int r = 0; r < 4; ++r) accT[i][r] = S0 ? S0[(size_t)(d0 + r) * 512 + es * 64 + eT] : 0.f;
        u32x2 w; w.x = pk2(accT[i][0], accT[i][1]); w.y = pk2(accT[i][2], accT[i][3]); *(LAS u32x2*)(lds + STOFF + eT * 512 + (((d0 >> 3) ^ fr) << 4) + (d0 & 7) * 2) = w; }
    u32x4 rk[4], rv; bf16x8 yq[8];
    const bf16_t* gq = pin + h * 256 + (size_t)eT * NPROJ + 8 * fq; const bf16_t* gk = pin + 2048 + h * 256; const bf16_t* gv = pin + 4096 + h * 512 + es * 64;
    const bool qok = eT < c;
#define RET_LOADQ(n) do { _Pragma("unroll") for (int ks = 0; ks < 8; ++ks) yq[ks] = qok ? *(const bf16x8*)(gq + (size_t)(n) * 64 * NPROJ + 32 * ks) : (bf16x8){0, 0, 0, 0, 0, 0, 0, 0}; } while (0)
#define RET_LOAD(n) do { _Pragma("unroll") for (int i = 0; i < 4; ++i) { const int p = tid + 512 * i, row = p >> 5, ch = p & 31; \
            if (row < c) rk[i] = *(const u32x4*)(gk + (size_t)((n) * 64 + row) * NPROJ + ch * 8); else rk[i] = (u32x4){0u, 0u, 0u, 0u}; } \
        { const int row = tid >> 3, ch = tid & 7; if (row < c) rv = *(const u32x4*)(gv + (size_t)((n) * 64 + row) * NPROJ + ch * 8); else rv = (u32x4){0u, 0u, 0u, 0u}; } } while (0)
    RET_LOAD(0); RET_LOADQ(0);
    for (int n = 0; n < nchunks; ++n) {
#pragma unroll
        for (int i = 0; i < 4; ++i) { const int p = tid + 512 * i, row = p >> 5, ch = p & 31; *(LAS u32x4*)(lds + KOFF + row * 512 + ((ch ^ (row & 15)) << 4)) = rk[i]; }
        *(LAS u32x4*)(lds + VOFF + (tid >> 3) * VS + (tid & 7) * 16) = rv;
        if (n + 1 < nchunks) RET_LOAD(n + 1);
        __syncthreads();
        f32x4 accS[2], accC[2];
#pragma unroll
        for (int j = 0; j < 2; ++j) { accS[j] = (f32x4){0.f, 0.f, 0.f, 0.f}; accC[j] = (f32x4){0.f, 0.f, 0.f, 0.f}; }
#pragma unroll
        for (int ks = 0; ks < 8; ++ks) { const int k0 = 32 * ks;
#pragma unroll
            for (int j = 0; j < 2; ++j) { const bf16x8 xk = frag_sw(lds + KOFF, 16 * (2 * half + j), k0, fr, fq); accS[j] = MFMA16(xk, yq[ks], accS[j]); }
#pragma unroll
            for (int j = 0; j < 2; ++j) { const bf16x8 xs = frag_sw(lds + STOFF, 16 * (2 * half + j), k0, fr, fq); accC[j] = MFMA16(xs, yq[ks], accC[j]); } }
        if (n + 1 < nchunks) RET_LOADQ(n + 1);
        const int lrow = eT;
#pragma unroll
        for (int j = 0; j < 2; ++j) { const int m0 = 16 * (2 * half + j) + 4 * fq; f32x4 sv = accS[j];
#pragma unroll
            for (int r = 0; r < 4; ++r) sv[r] = (m0 + r <= lrow) ? sv[r] : 0.f;
            u32x2 w; w.x = pk2(sv[0], sv[1]); w.y = pk2(sv[2], sv[3]); *(LAS u32x2*)(lds + POFF + lrow * VS + m0 * 2) = w; }
        __syncthreads();
        f32x4 accO[2];
#pragma unroll
        for (int j = 0; j < 2; ++j) accO[j] = accC[j] * gam;
#pragma unroll
        for (int ks = 0; ks < 2; ++ks) { const int k0 = 32 * ks;
            const bf16x8 yp = frag_rm(lds + POFF, VS, 16 * lt, k0, fr, fq);
#pragma unroll
            for (int j = 0; j < 2; ++j) { const bf16x8 xv = frag_tr(lds + VOFF, VS, k0, 16 * (2 * half + j), fr, fq); accO[j] = MFMA16(xv, yp, accO[j]); } }
        if (lrow < c) {
#pragma unroll
            for (int j = 0; j < 2; ++j) { u32x2 w; w.x = pk2(accO[j][0], accO[j][1]); w.y = pk2(accO[j][2], accO[j][3]);
                *(u32x2*)(pout + (size_t)(n * 64 + lrow) * 4096 + h * 512 + es * 64 + 16 * (2 * half + j) + 4 * fq) = w; } }
#pragma unroll
        for (int i = 0; i < 8; ++i) accT[i] = accT[i] * gam;
#pragma unroll
        for (int ks = 0; ks < 2; ++ks) { const int k0 = 32 * ks;
            const bf16x8 yv = frag_tr(lds + VOFF, VS, k0, 16 * lt, fr, fq);
#pragma unroll
            for (int i = 0; i < 8; ++i) { const bf16x8 xk = frag_tr_sw(lds + KOFF, k0, 16 * (8 * half + i), fr, fq); accT[i] = MFMA16(xk, yv, accT[i]); } }
#pragma unroll
        for (int i = 0; i < 8; ++i) { accT[i] = accT[i] * gc1; const int d0 = 16 * (8 * half + i) + 4 * fq;
            u32x2 w; w.x = pk2(accT[i][0], accT[i][1]); w.y = pk2(accT[i][2], accT[i][3]); *(LAS u32x2*)(lds + STOFF + eT * 512 + (((d0 >> 3) ^ fr) << 4) + (d0 & 7) * 2) = w; }
        __syncthreads();
    }
#undef RET_LOAD
#undef RET_LOADQ
#pragma unroll
    for (int i = 0; i < 8; ++i) { const int d0 = 16 * (8 * half + i) + 4 * fq;
#pragma unroll
        for (int r = 0; r < 4; ++r) Sout[(size_t)(d0 + r) * 512 + es * 64 + eT] = accT[i][r]; }
}
}
__device__ __forceinline__ void sample_attn(LAS char* lds, const bf16_t* QBp, const bf16_t* KALL, const bf16_t* VALL, const float* FS, bf16_t* AO) {
    const int tid = opaque_tid(), wid = __builtin_amdgcn_readfirstlane(tid >> 6), lane = tid & 63;
    LAS float* qf = (LAS float*)(lds + wid * 5120); LAS float* pf = qf + 128;
    const int gw = blockIdx.x * NWAVES + wid, NGW = gridDim.x * NWAVES;
    for (int item = gw; item < 8 * 16 * 32; item += NGW) {
        const int b = item >> 9, h = (item >> 5) & 15, qi = item & 31, kvh = h >> 2, qpos = PASTL + qi, row = TP + b * 32 + qi;
        const bf16_t* q = QBp + (size_t)row * DM + h * 128;
        qf[lane] = bf2f(q[lane]); qf[lane + 64] = bf2f(q[lane + 64]);
        asm volatile("s_waitcnt lgkmcnt(0)" ::: "memory");
        const float* F = FS + (size_t)(b * 16 + h) * LKS; const float Fq = F[qpos];
        const bf16_t* Kb = KALL + (size_t)b * LKS * 512 + kvh * 128; const bf16_t* Vb = VALL + (size_t)b * LKS * 512 + kvh * 128;
        float mx = -1e30f;
#pragma unroll 1
        for (int t = 0; t < 17; ++t) { const int j = lane + 64 * t; float s = -__builtin_inff();
            if (j <= qpos) { const u32x4* kr = (const u32x4*)(Kb + (size_t)j * 512); float a = 0.f; u32x4 kvv[16];
#pragma unroll
                for (int c8 = 0; c8 < 16; ++c8) kvv[c8] = kr[c8];
#pragma unroll
                for (int c8 = 0; c8 < 16; ++c8) { const u32x4 kv = kvv[c8]; const LAS f32x4* qq = (const LAS f32x4*)(qf + 8 * c8); const f32x4 q0 = qq[0], q1 = qq[1];
                    a += __uint_as_float(kv.x << 16) * q0.x + __uint_as_float(kv.x & 0xffff0000u) * q0.y + __uint_as_float(kv.y << 16) * q0.z + __uint_as_float(kv.y & 0xffff0000u) * q0.w
                       + __uint_as_float(kv.z << 16) * q1.x + __uint_as_float(kv.z & 0xffff0000u) * q1.y + __uint_as_float(kv.w << 16) * q1.z + __uint_as_float(kv.w & 0xffff0000u) * q1.w; }
                s = a * 0.08838834764831845f + (Fq - F[j]); }
            pf[j] = s; mx = fmaxf(mx, s); }
#pragma unroll
        for (int o = 1; o < 64; o <<= 1) mx = fmaxf(mx, __shfl_xor(mx, o));
        float sum = 0.f;
#pragma unroll 1
        for (int t = 0; t < 17; ++t) { const float p = __expf(pf[lane + 64 * t] - mx); sum += p; pf[lane + 64 * t] = p; }
        sum = wave_sum(sum);
        asm volatile("s_waitcnt lgkmcnt(0)" ::: "memory");
        float oa[8];
#pragma unroll
        for (int e = 0; e < 8; ++e) oa[e] = 0.f;
        const int kg = lane >> 4, dg = lane & 15;
        for (int j = 0; j < PASTL + 32; j += 32) {
            u32x4 vv[8]; float p[8];
#pragma unroll
            for (int u = 0; u < 8; ++u) { vv[u] = *(const u32x4*)(Vb + (size_t)(j + 4 * u + kg) * 512 + 8 * dg); p[u] = pf[j + 4 * u + kg]; }
#pragma unroll
            for (int u = 0; u < 8; ++u) { const unsigned w4[4] = {vv[u].x, vv[u].y, vv[u].z, vv[u].w};
#pragma unroll
                for (int e = 0; e < 4; ++e) { oa[2 * e] += p[u] * __uint_as_float(w4[e] << 16); oa[2 * e + 1] += p[u] * __uint_as_float(w4[e] & 0xffff0000u); } } }
#pragma unroll
        for (int e = 0; e < 8; ++e) { oa[e] += __shfl_xor(oa[e], 16); oa[e] += __shfl_xor(oa[e], 32); }
        const float inv = 1.0f / sum;
        if (kg == 0) { u32x4 w; w.x = pk2(oa[0] * inv, oa[1] * inv); w.y = pk2(oa[2] * inv, oa[3] * inv); w.z = pk2(oa[4] * inv, oa[5] * inv); w.w = pk2(oa[6] * inv, oa[7] * inv);
            *(u32x4*)(AO + (size_t)row * DM + h * 128 + 8 * dg) = w; }
        asm volatile("s_waitcnt lgkmcnt(0)" ::: "memory");
    }
}

#define XB_TMO      128
#define XB_XCNT(j)  (256  + 64 * (j))
#define XB_XSUB(j)  (1280 + 64 * (j))
#define XB_XGEN(j)  (2304 + 64 * (j))
#define XB_TOP      3328
#define XB_TOPGEN   3392
#define XCD_BAR_WORDS 3456
#define XB_SPIN_CAP (1u << 18)

__device__ __forceinline__ unsigned xb_ld(unsigned* p)              { return __hip_atomic_load(p, __ATOMIC_RELAXED, __HIP_MEMORY_SCOPE_AGENT); }
__device__ __forceinline__ unsigned xb_add(unsigned* p, unsigned v) { return __hip_atomic_fetch_add(p, v, __ATOMIC_RELAXED, __HIP_MEMORY_SCOPE_AGENT); }
__device__ __forceinline__ unsigned xb_xcc_id() { return (unsigned)__builtin_amdgcn_s_getreg((3 << 11) | 20) & 0xFu; }
#define XB_SPIN(cond, bar) do { unsigned _sp = 0; while (cond) { __builtin_amdgcn_s_sleep(1); \
    if ((++_sp & 255u) == 0u) { if (xb_ld(&(bar)[XB_TMO])) break; if (_sp > XB_SPIN_CAP) { atomicAdd(&(bar)[XB_TMO], 1u); break; } } } } while (0)

struct XcdBarrier {
    unsigned* bar; unsigned x;
    volatile LAS unsigned* st;
};

__device__ __forceinline__ XcdBarrier xcd_barrier_post(unsigned* bar, volatile LAS unsigned* st) {
    XcdBarrier b; b.bar = bar; b.x = xb_xcc_id(); b.st = st;
    if (threadIdx.x == 0) (void)xb_add(&bar[XB_XCNT(b.x)], 1u);
    return b;
}
__device__ __forceinline__ void xcd_barrier_complete(unsigned* bar, unsigned x, unsigned& nloc, unsigned& nx) {
    const unsigned G = gridDim.x * gridDim.y * gridDim.z;
    unsigned sum, cnt, mine, sp = 0u;
    for (;;) {
        sum = 0u; cnt = 0u; mine = 0u;
#pragma unroll
        for (unsigned j = 0; j < 16; ++j) { const unsigned c = xb_ld(&bar[XB_XCNT(j)]); sum += c; cnt += (c > 0u) ? 1u : 0u; mine = (j == x) ? c : mine; }
        if (sum == G) break;
        __builtin_amdgcn_s_sleep(1);
        if ((++sp & 255u) == 0u) { if (xb_ld(&bar[XB_TMO])) break; if (sp > XB_SPIN_CAP) { atomicAdd(&bar[XB_TMO], 1u); break; } }
    }
    nloc = mine > 0u ? mine : 1u; nx = cnt > 0u ? cnt : 1u;
}

__device__ __forceinline__ void xcd_barrier(const XcdBarrier& b) {
    asm volatile("s_waitcnt vmcnt(0)" ::: "memory");
    __syncthreads();
    if (threadIdx.x == 0) {
        unsigned* bar = b.bar;
        __builtin_amdgcn_s_waitcnt(0);
        unsigned nloc = b.st[0], nx = b.st[1];
        if (nloc == 0u) { xcd_barrier_complete(bar, b.x, nloc, nx); b.st[0] = nloc; b.st[1] = nx; }
        const unsigned old = xb_add(&bar[XB_XSUB(b.x)], 1u);
        const unsigned gen = old / nloc;
        if (old + 1u == (gen + 1u) * nloc) {
            __builtin_amdgcn_fence(__ATOMIC_RELEASE, "agent");
            asm volatile("s_waitcnt vmcnt(0)" ::: "memory");
            const unsigned og = xb_add(&bar[XB_TOP], 1u);
            const unsigned tg = og / nx;
            if (og + 1u == (tg + 1u) * nx) xb_add(&bar[XB_TOPGEN], 1u);
            else XB_SPIN(xb_ld(&bar[XB_TOPGEN]) == tg, bar);
            __builtin_amdgcn_fence(__ATOMIC_ACQUIRE, "agent");
            xb_add(&bar[XB_XGEN(b.x)], 1u);
            asm volatile("s_waitcnt vmcnt(0)" ::: "memory");
        } else {
            XB_SPIN(xb_ld(&bar[XB_XGEN(b.x)]) == gen, bar);
            __builtin_amdgcn_fence(__ATOMIC_ACQUIRE, "agent");
            asm volatile("s_waitcnt vmcnt(0)" ::: "memory");
        }
    }
    __syncthreads();
}

#define KARG(i) ((unsigned char*)(((const volatile __attribute__((address_space(4))) unsigned long long*)__builtin_amdgcn_kernarg_segment_ptr())[i]))
#define INF(i) ((const float*)KARG(i))
#define OUTP ((float*)KARG(21))
#define WSP (KARG(22))
#define BIGP (KARG(22) + WS_BIG)
#define PH_IDS const int tid = opaque_tid(), lane = tid & 63, wave = __builtin_amdgcn_readfirstlane(tid >> 6); const int G = gridDim.x, gw = blockIdx.x * NWAVES + wave, NGW = G * NWAVES; const size_t gt = (size_t)blockIdx.x * 512 + tid, NGT = (size_t)G * 512; (void)lane; (void)gw; (void)NGW; (void)gt; (void)NGT

__device__ __forceinline__ void ph_prologue(LAS unsigned char* lds) {
    PH_IDS; unsigned char* ws = WSP;
    bf16_t* WIN = (bf16_t*)(ws + WS_WIN); bf16_t* WKVF = (bf16_t*)(ws + WS_WKVF);
    LAS float* scr = (LAS float*)(lds + wave * 16384);
    constexpr int I0 = 32 * 384;
    for (int it = gw; it < I0; it += NGW) tr_plain(INF(10), DM, NPROJ, WIN, 0, scr, it, lane);
    { const float* wf = INF(14); const float* nkv = INF(8);
      for (size_t i = gt; i < (size_t)256 * DM; i += NGT) { const int r = (int)(i >> 11), k = (int)(i & 2047); WKVF[(size_t)(1024 + r) * DM + k] = r < 16 ? (bf16_t)(pk2(wf[k * 16 + r] * nkv[k], 0.f) & 0xffffu) : (bf16_t)0; }
      float* ssq = (float*)(ws + WS_SSQ); for (size_t i = gt; i < (size_t)3 * TALL; i += NGT) ssq[i] = 0.f; }
    { float* COS = (float*)(ws + WS_COS); float* SIN = (float*)(ws + WS_SIN);
      for (size_t i = gt; i < (size_t)SEQ * 128; i += NGT) { const int pos = (int)(i >> 7), d = (int)(i & 127);
        const float inv = exp2f(-(float)d * (13.287712379549449f / 128.f));
        const double rev = (double)pos * (double)inv * 0.15915494309189535; const float fr = (float)(rev - __builtin_floor(rev));
        COS[i] = __builtin_amdgcn_cosf(fr); SIN[i] = __builtin_amdgcn_sinf(fr); } }
    { const float* x_p = INF(0); const float* x_s = INF(1); const float* nm = INF(6); bf16_t* XN0 = (bf16_t*)OUTP;
      for (int m = gw; m < TALL; m += NGW) rms_row<0>(m < TP ? x_p + (size_t)m * DM : x_s + (size_t)(m - TP) * DM, nm, XN0 + (size_t)m * DM, nullptr, nullptr, nullptr, lane); }
}
template <int JOB> __device__ __forceinline__ void ph_conv(LAS unsigned char* lds) {
    const int tid = opaque_tid(), lane = tid & 63, wave = __builtin_amdgcn_readfirstlane(tid >> 6);
    const int G = gridDim.x, first = G > 160 ? (JOB == 1 ? 48 : JOB == 3 ? 141 : 44) : 0;
    if ((int)blockIdx.x < first) return;
    const int gw = ((int)blockIdx.x - first) * NWAVES + wave, NGW = (G - first) * NWAVES;
    unsigned char* ws = WSP; LAS float* scr = (LAS float*)(lds + wave * 16384);
    constexpr int IG = 32 * 176, ID = 88 * 64, IQ = 32 * 64, IK = 32 * 16;
    if (JOB == 1) {
        bf16_t* WRO = (bf16_t*)(ws + WS_WRO); bf16_t* WGU0 = (bf16_t*)(ws + WS_WGU0);
        for (int it = gw; it < 64 * 64 + 2 * IG; it += NGW) { int r = it;
            if (r < 64 * 64) { tr_plain(INF(11), 4096, DM, WRO, 0, scr, r, lane); continue; } r -= 64 * 64;
            if (r < IG) { tr_gu(INF(18), WGU0, 0, scr, r, lane, INF(7)); continue; } r -= IG;
            tr_gu(INF(19), WGU0, 1, scr, r, lane, INF(7)); }
    } else if (JOB == 2) {
        bf16_t* WDN0 = (bf16_t*)(ws + WS_WDN0); bf16_t* WGU1 = (bf16_t*)(ws + WS_WGU1); bf16_t* WO = (bf16_t*)(ws + WS_WO); bf16_t* WKVF = (bf16_t*)(ws + WS_WKVF);
        for (int it = gw; it < ID + 2 * IQ + 2 * IK + IG; it += NGW) { int r = it;
            if (r < ID) { tr_plain(INF(20), DFF, DM, WDN0, 0, scr, r, lane); continue; } r -= ID;
            if (r < IQ) { tr_plain(INF(16), DM, DM, WKVF, 1280, scr, r, lane, INF(6) + DM); continue; } r -= IQ;
            if (r < IK) { tr_plain(INF(12), DM, 512, WKVF, 0, scr, r, lane, INF(8)); continue; } r -= IK;
            if (r < IK) { tr_plain(INF(13), DM, 512, WKVF, 512, scr, r, lane, INF(8)); continue; } r -= IK;
            if (r < IQ) { tr_plain(INF(17), DM, DM, WO, 0, scr, r, lane); continue; } r -= IQ;
            tr_gu(INF(18) + (size_t)DM * DFF, WGU1, 0, scr, r, lane, INF(7) + DM); }
    } else if (JOB == 3) {
        bf16_t* WGU1 = (bf16_t*)(ws + WS_WGU1);
        for (int it = gw; it < IG; it += NGW) tr_gu(INF(19) + (size_t)DM * DFF, WGU1, 1, scr, it, lane, INF(7) + DM);
    } else {
        bf16_t* WDN1 = (bf16_t*)(ws + WS_WDN1);
        for (int it = gw; it < ID; it += NGW) tr_plain(INF(20) + (size_t)DFF * DM, DFF, DM, WDN1, 0, scr, it, lane);
    }
}
__device__ __forceinline__ void ph_retin(LAS unsigned char* lds) {
    unsigned char* ws = WSP;
    pg8::Gemm g{(const bf16_t*)OUTP, (const bf16_t*)(ws + WS_WIN), TALL, NPROJ, DM, DM}; pg8::StaticOrder S; S.init(TALL, NPROJ, (int)gridDim.x, (int)blockIdx.x);
    pg8::EpiRetIn E{(bf16_t*)(ws + WS_BIG), (const float*)(ws + WS_COS), (const float*)(ws + WS_SIN)};
    pg8::gemm_phase<pg8::EpiRetIn, pg8::StaticOrder, true, true>(lds, g, S, E);
}
__device__ __forceinline__ void ph_retention(LAS unsigned char* lds) {
    const int G = gridDim.x;
    for (int it = blockIdx.x; it < 256; it += G) { const int bh = (it & 7) * 4 + (it >> 6), es = (it >> 3) & 7, b = bh >> 3, h = bh & 7;
        ret::ret_item((LAS char*)lds, (const bf16_t*)BIGP + (size_t)b * SEQ * NPROJ, (bf16_t*)OUTP + (size_t)b * SEQ * 4096, 128, 64, h, es, nullptr, OUTP + OUT_SP + (size_t)(b * 8 + h) * 256 * 512); }
    for (int it = blockIdx.x; it < 512; it += G) { const int bh = (it & 7) * 8 + (it >> 6), es = (it >> 3) & 7, b = bh >> 3, h = bh & 7;
        ret::ret_item((LAS char*)lds, (const bf16_t*)BIGP + (size_t)(TP + b * 32) * NPROJ, (bf16_t*)OUTP + (size_t)(TP + b * 32) * 4096, 1, 32, h, es, INF(2) + (size_t)(b * 8 + h) * 256 * 512, OUTP + OUT_SS + (size_t)(b * 8 + h) * 256 * 512); }
}
__device__ __forceinline__ void ph_groupnorm() {
    PH_IDS; bf16_t* PROJ = (bf16_t*)BIGP; const bf16_t* OB = (const bf16_t*)OUTP;
    for (int it0 = gw * 4; it0 < TALL * 8; it0 += NGW * 4) {
        u32x4 ovv[4], gvv[4];
#pragma unroll
        for (int q = 0; q < 4; ++q) { const int it = it0 + q, row = it >> 3, h = it & 7;
            ovv[q] = *(const u32x4*)(OB + (size_t)row * 4096 + h * 512 + lane * 8); gvv[q] = *(const u32x4*)(PROJ + (size_t)row * NPROJ + 8192 + h * 512 + lane * 8); }
#pragma unroll
        for (int q = 0; q < 4; ++q) { const int it = it0 + q, row = it >> 3, h = it & 7; const u32x4 ov = ovv[q], gv = gvv[q];
            bf16_t* op = PROJ + (size_t)row * NPROJ + 4096 + h * 512 + lane * 8;
            float o[8], g[8]; const unsigned ow[4] = {ov.x, ov.y, ov.z, ov.w}, gwd[4] = {gv.x, gv.y, gv.z, gv.w};
#pragma unroll
            for (int j = 0; j < 4; ++j) { o[2 * j] = __uint_as_float(ow[j] << 16); o[2 * j + 1] = __uint_as_float(ow[j] & 0xffff0000u); g[2 * j] = __uint_as_float(gwd[j] << 16); g[2 * j + 1] = __uint_as_float(gwd[j] & 0xffff0000u); }
            float s = 0.f;
#pragma unroll
            for (int j = 0; j < 8; ++j) s += o[j];
            const float mu = wave_sum(s) * (1.f / 512.f); float qq = 0.f;
#pragma unroll
            for (int j = 0; j < 8; ++j) { o[j] -= mu; qq += o[j] * o[j]; }
            const float rstd = 1.0f / sqrtf(wave_sum(qq) * (1.f / 512.f) + 1e-5f);
#pragma unroll
            for (int j = 0; j < 8; ++j) o[j] = o[j] * rstd * pg8::silu_f(g[j]);
            u32x4 w; w.x = pk2(o[0], o[1]); w.y = pk2(o[2], o[3]); w.z = pk2(o[4], o[5]); w.w = pk2(o[6], o[7]); *(u32x4*)op = w; } }
}
template <bool FIRST, int MROWS = TALL> __device__ __forceinline__ void ph_res_gemm(LAS unsigned char* lds, unsigned char* a_ptr, size_t w_off, int K, int lda, bf16_t* hb, int ssq_idx) {
    unsigned char* ws = WSP; float* Hres = OUTP + OUT_Y;
    pg8::Gemm g{(const bf16_t*)a_ptr, (const bf16_t*)(ws + w_off), MROWS, DM, K, lda}; pg8::StaticOrder S; S.init(MROWS, DM, (int)gridDim.x, (int)blockIdx.x);
    pg8::EpiRes E{FIRST ? INF(0) : Hres, FIRST ? INF(1) : Hres + (size_t)TP * DM, Hres, hb, ssq_idx >= 0 ? (float*)(ws + WS_SSQ) + (size_t)ssq_idx * TALL : nullptr};
    pg8::gemm_phase<pg8::EpiRes, pg8::StaticOrder, true, true>(lds, g, S, E);
}
template <bool FIRST = false> __device__ __forceinline__ void ph_sample_res(const unsigned char* a_ptr, int lda, size_t w_off, int K, bf16_t* hb, int ssq_idx) {
    const int tid = opaque_tid(), lane = tid & 63, wave = __builtin_amdgcn_readfirstlane(tid >> 6), fr = lane & 15, fq = lane >> 4;
    unsigned char* ws = WSP; float* Hs = OUTP + OUT_Y + (size_t)TP * DM;
    const bf16_t* A = (const bf16_t*)a_ptr; const bf16_t* Wt = (const bf16_t*)(ws + w_off);
    float* ssq = ssq_idx >= 0 ? (float*)(ws + WS_SSQ) + (size_t)ssq_idx * TALL + TP : nullptr;
    for (int it = blockIdx.x; it < 256; it += gridDim.x) {
        const int n0 = (it >> 1) * 16, row = (it & 1) * 128 + 16 * wave + fr;
        const bf16_t* bp = Wt + (size_t)(n0 + fr) * K + 8 * fq; const bf16_t* ap = A + (size_t)row * lda + 8 * fq;
        f32x4 acc = {0.f, 0.f, 0.f, 0.f};
        bf16x8 bA[8], aA[8], bB[8], aB[8];
#define SR_LOAD(B_, A_, kk) do { _Pragma("unroll") for (int s_ = 0; s_ < 8; ++s_) { B_[s_] = *(const bf16x8*)(bp + (kk) + 32 * s_); A_[s_] = *(const bf16x8*)(ap + (kk) + 32 * s_); } } while (0)
#define SR_MMA(B_, A_) do { _Pragma("unroll") for (int s_ = 0; s_ < 8; ++s_) acc = __builtin_amdgcn_mfma_f32_16x16x32_bf16(B_[s_], A_[s_], acc, 0, 0, 0); } while (0)
        SR_LOAD(bA, aA, 0);
        for (int k0 = 0; k0 < K; k0 += 512) {
            SR_LOAD(bB, aB, k0 + 256);
            SR_MMA(bA, aA);
            if (k0 + 512 < K) SR_LOAD(bA, aA, k0 + 512);
            SR_MMA(bB, aB);
        }
#undef SR_LOAD
#undef SR_MMA
        float* o = Hs + (size_t)row * DM + n0 + 4 * fq;
        const f32x4 v = (FIRST ? *(const f32x4*)(INF(1) + (size_t)row * DM + n0 + 4 * fq) : *(const f32x4*)o) + acc; *(f32x4*)o = v;
        if (hb) { u32x2 w; w.x = pk2(v[0], v[1]); w.y = pk2(v[2], v[3]); *(u32x2*)(hb + (size_t)(TP + row) * DM + n0 + 4 * fq) = w; }
        if (ssq) { float ss = (v[0] * v[0] + v[1] * v[1]) + (v[2] * v[2] + v[3] * v[3]); ss += __shfl_xor(ss, 16); ss += __shfl_xor(ss, 32);
            if (fq == 0) (void)__hip_atomic_fetch_add(ssq + row, ss, __ATOMIC_RELAXED, __HIP_MEMORY_SCOPE_AGENT); }
    }
}
template <int MODE> __device__ __forceinline__ void ph_rms(const float* g1, size_t o1_off, const float* g2, size_t o2_off) {
    PH_IDS; float* Hres = OUTP + OUT_Y; unsigned char* ws = WSP;
    for (int m = gw; m < TALL; m += NGW) rms_row<MODE>(Hres + (size_t)m * DM, g1, (bf16_t*)(ws + o1_off) + (size_t)m * DM, g2, (bf16_t*)(ws + o2_off) + (size_t)m * DM, Hres + (size_t)m * DM, lane);
}
__device__ __forceinline__ void ph_cache_cvt() {
    PH_IDS; const float* cache_k = INF(3); const float* cache_v = INF(4); bf16_t* KALL = (bf16_t*)(BIGP + BIG_KALL); bf16_t* VALL = (bf16_t*)(BIGP + BIG_VALL);
    for (size_t i = gt; i < (size_t)8 * PASTL * 512 / 4; i += NGT) { const size_t e = i * 4, b = e / ((size_t)PASTL * 512), r = e % ((size_t)PASTL * 512);
        const f32x4 kv = *(const f32x4*)(cache_k + e), vv = *(const f32x4*)(cache_v + e); u32x2 w; w.x = pk2(kv.x, kv.y); w.y = pk2(kv.z, kv.w); *(u32x2*)(KALL + b * LKS * 512 + r) = w;
        w.x = pk2(vv.x, vv.y); w.y = pk2(vv.z, vv.w); *(u32x2*)(VALL + b * LKS * 512 + r) = w; }
}
__device__ __forceinline__ void ph_kvfq(LAS unsigned char* lds) {
    unsigned char* ws = WSP; unsigned char* big = ws + WS_BIG; float* out = OUTP;
    pg8::Gemm g{(const bf16_t*)(big + BIG_XN), (const bf16_t*)(ws + WS_WKVF), TALL, 3328, DM, DM}; pg8::StaticOrder S; S.init(TALL, 3328, (int)gridDim.x, (int)blockIdx.x);
    pg8::EpiKVFQ E{out + OUT_KP, out + OUT_VP, out + OUT_LFP, out + OUT_KS, out + OUT_VS, out + OUT_LFS, (bf16_t*)(big + BIG_KB), (bf16_t*)(big + BIG_VB), (bf16_t*)(big + BIG_KALL), (bf16_t*)(big + BIG_VALL),
                    (bf16_t*)(big + BIG_ACT), INF(15), (const float*)(ws + WS_SSQ) + (size_t)1 * TALL};
    pg8::gemm_phase<pg8::EpiKVFQ, pg8::StaticOrder, true, true>(lds, g, S, E);
}
__device__ __forceinline__ void ph_cumsum(LAS unsigned char* lds) {
    PH_IDS; const float* cache_lf = INF(5); const float* out = OUTP; float* FB = (float*)(WSP + WS_FB); float* FS = (float*)(WSP + WS_FS);
    for (int it = blockIdx.x; it < 64 + 128; it += G) {
        LAS float* wtot = (LAS float*)lds;
        const bool smp = it >= 64; const int bh = smp ? it - 64 : it, b = bh >> 4, h = bh & 15, Ls = smp ? LKS : SEQ, per = smp ? 3 : 16, j0 = tid * per;
        float v[16]; float s = 0.f;
#pragma unroll
        for (int i = 0; i < 16; ++i) { const int j = j0 + i; float x = 0.f;
            if (i < per && j < Ls) x = smp ? (j < PASTL ? cache_lf[((size_t)b * PASTL + j) * 16 + h] : out[OUT_LFS + ((size_t)b * 32 + (j - PASTL)) * 16 + h]) : out[OUT_LFP + ((size_t)b * SEQ + j) * 16 + h];
            s += x; v[i] = s; }
        float inc = s;
#pragma unroll
        for (int o = 1; o < 64; o <<= 1) { const float t = __shfl_up(inc, o); if (lane >= o) inc += t; }
        if (lane == 63) wtot[wave] = inc;
        __syncthreads();
        float base = inc - s;
        for (int w = 0; w < wave; ++w) base += wtot[w];
#pragma unroll
        for (int i = 0; i < 16; ++i) { const int j = j0 + i; if (i < per && j < Ls) { const float F = base + v[i];
            if (smp) FS[(size_t)bh * LKS + j] = F; else FB[(size_t)bh * SEQ + j] = -F * 11.313708498984761f; } }
        __syncthreads();
    }
}
__device__ __forceinline__ void ph_attn(unsigned char* lds_raw) {
    unsigned char* ws = WSP; unsigned char* big = ws + WS_BIG;
    fox::attn_phase((char*)lds_raw, (const bf16_t*)(big + BIG_ACT), (const bf16_t*)(big + BIG_KB), (const bf16_t*)(big + BIG_VB), (bf16_t*)(big + BIG_XN), (const float*)(ws + WS_FB));
}
__device__ __forceinline__ void ph_sattn(LAS unsigned char* lds) {
    unsigned char* ws = WSP; unsigned char* big = ws + WS_BIG;
    sample_attn((LAS char*)lds, (const bf16_t*)(big + BIG_ACT), (const bf16_t*)(big + BIG_KALL), (const bf16_t*)(big + BIG_VALL), (const float*)(ws + WS_FS), (bf16_t*)(big + BIG_XN));
}
__device__ __forceinline__ void ph_gateup(LAS unsigned char* lds, const unsigned char* a_ptr, size_t w_off, int ssq_idx) {
    unsigned char* ws = WSP; unsigned char* big = ws + WS_BIG;
    pg8::Gemm g{(const bf16_t*)a_ptr, (const bf16_t*)(ws + w_off), TALL, 2 * DFF, DM, DM}; pg8::StaticOrder S; S.init(TALL, 2 * DFF, (int)gridDim.x, (int)blockIdx.x);
    pg8::EpiSwiglu E{(bf16_t*)(big + BIG_ACT), (const float*)(ws + WS_SSQ) + (size_t)ssq_idx * TALL};
    pg8::gemm_phase<pg8::EpiSwiglu, pg8::StaticOrder, true, true>(lds, g, S, E);
}

__global__ void __launch_bounds__(NWAVES * 64, 2) yoco_fwd(Params P) {
    extern __shared__ __attribute__((aligned(16))) unsigned char lds_raw[];
    cg::grid_group grid = cg::this_grid();
    LAS unsigned char* lds = (LAS unsigned char*)lds_raw;
    volatile LAS unsigned* bst = (volatile LAS unsigned*)(lds + 148480);
    if (opaque_tid() < 2) bst[opaque_tid()] = 0u;
    __syncthreads();
    const XcdBarrier xbar = xcd_barrier_post((unsigned*)(WSP + WS_BAR), bst);
#define GSYNC() xcd_barrier(xbar)
    ph_prologue(lds);                                                                                   grid.sync();
    ph_retin(lds); ph_conv<1>(lds);                                                                                      GSYNC();
    ph_retention(lds);                                                                                  GSYNC();
    ph_groupnorm();                                                                                     GSYNC();
    ph_res_gemm<true, TP>(lds, BIGP + 4096 * 2, WS_WRO, 4096, NPROJ, (bf16_t*)(OUTP + OUT_KP), 0); ph_sample_res<true>(BIGP + ((size_t)TP * NPROJ + 4096) * 2, NPROJ, WS_WRO, 4096, (bf16_t*)(OUTP + OUT_KP), 0);   GSYNC();
    ph_gateup(lds, (const unsigned char*)(OUTP + OUT_KP), WS_WGU0, 0); ph_conv<2>(lds);                                  GSYNC();
    ph_res_gemm<false, TP>(lds, BIGP + BIG_ACT, WS_WDN0, DFF, DFF, (bf16_t*)(BIGP + BIG_XN), 1); ph_sample_res(BIGP + BIG_ACT + (size_t)TP * DFF * 2, DFF, WS_WDN0, DFF, (bf16_t*)(BIGP + BIG_XN), 1); ph_cache_cvt();   GSYNC();
    ph_kvfq(lds); ph_conv<3>(lds);                                                                                       GSYNC();
    ph_cumsum(lds);                                                                                     GSYNC();
    ph_attn(lds_raw); __syncthreads(); ph_sattn(lds);                                                   GSYNC();
    ph_res_gemm<false, TP>(lds, BIGP + BIG_XN, WS_WO, DM, DM, (bf16_t*)(BIGP + BIG_HKV), 2); ph_sample_res(BIGP + BIG_XN + (size_t)TP * DM * 2, DM, WS_WO, DM, (bf16_t*)(BIGP + BIG_HKV), 2);   GSYNC();
    ph_gateup(lds, BIGP + BIG_HKV, WS_WGU1, 2); ph_conv<4>(lds);                                                         GSYNC();
    ph_res_gemm<false, TP>(lds, BIGP + BIG_ACT, WS_WDN1, DFF, DFF, nullptr, -1); ph_sample_res(BIGP + BIG_ACT + (size_t)TP * DFF * 2, DFF, WS_WDN1, DFF, nullptr, -1);   GSYNC();
    ph_rms<2>(INF(9), 0, nullptr, 0);
}

extern "C" void kernel_launch(void* const* d_in, const int* in_sizes, int n_in, void* d_out, int out_size, void* d_ws, size_t ws_size, hipStream_t stream) {
    static int grid = 0;
    if (grid == 0) {
        if (n_in != 21 || ws_size < WS_END) { fprintf(stderr, "kernel_launch: unexpected n_in %d / ws_size %zu (need %zu)\n", n_in, ws_size, (size_t)WS_END); grid = -1; return; }
        int dev = 0, cus = 0, per_cu = 0;
        (void)hipGetDevice(&dev); (void)hipDeviceGetAttribute(&cus, hipDeviceAttributeMultiprocessorCount, dev);
        if (hipFuncSetAttribute((const void*)yoco_fwd, hipFuncAttributeMaxDynamicSharedMemorySize, LDS_BYTES) != hipSuccess) { fprintf(stderr, "kernel_launch: hipFuncSetAttribute failed\n"); grid = -1; return; }
        if (hipOccupancyMaxActiveBlocksPerMultiprocessor(&per_cu, (const void*)yoco_fwd, NWAVES * 64, LDS_BYTES) != hipSuccess || per_cu < 1) { fprintf(stderr, "kernel_launch: occupancy query says %d\n", per_cu); per_cu = 1; }
        (void)hipGetLastError();
        grid = cus > 0 ? cus : 256;
    }
    if (grid < 0) return;
    if (hipMemsetAsync((char*)d_ws + WS_BAR, 0, XCD_BAR_WORDS * 4, stream) != hipSuccess) { fprintf(stderr, "kernel_launch: memset of the barrier words failed\n"); return; }
    Params p{};
    for (int i = 0; i < 21; ++i) p.in[i] = (const float*)d_in[i];
    p.out = (float*)d_out; p.ws = (unsigned char*)d_ws;
    void* args[] = {&p};
    hipError_t e = hipLaunchCooperativeKernel((const void*)yoco_fwd, dim3(grid), dim3(NWAVES * 64), args, LDS_BYTES, stream);
    if (e != hipSuccess) fprintf(stderr, "cooperative launch failed: %s (grid %d)\n", hipGetErrorString(e), grid);
}
```

```cpp
#include <hip/hip_runtime.h>
#include <hip/hip_cooperative_groups.h>
#include <cstdio>
#include <cstdint>
namespace cg = cooperative_groups;
__device__ __forceinline__ int opaque_tid() { int t = threadIdx.x; asm volatile("" : "+v"(t)); return t; }
namespace pg8 {
#define PG8_LAS __attribute__((address_space(3)))
typedef unsigned short bf16_t;
typedef short bf16x8 __attribute__((ext_vector_type(8)));
typedef float f32x4 __attribute__((ext_vector_type(4)));
typedef unsigned u32x4 __attribute__((ext_vector_type(4)));
constexpr int BM = 256, BK = 64, HALF = 128, HTB = HALF * BK * 2  , STAGE_BYTES = 8 * HTB, NXCD = 8, WGM = 4;

__host__ __device__ __forceinline__ int lds_byte(int r, int c) { const int st = (r >> 4) * 2 + (c >> 5), rr = r & 15, cc = c & 31, ob = rr * 64 + cc * 2; return st * 1024 + (ob ^ (((ob >> 9) & 1) << 5)); }
__host__ __device__ __forceinline__ void stage_rc(int b, int& R, int& C) { const int st = b / 1024, sb = b % 1024, swz = sb ^ (((sb >> 9) & 1) << 5); R = (st >> 1) * 16 + swz / 64; C = (st & 1) * 32 + (swz % 64) / 2; }
__host__ __device__ __forceinline__ int perm32(int rho) { const int n = rho >> 4, i = rho & 15; return 8 * (i >> 2) + 4 * n + (i & 3); }

struct Unit { int pm, pn; };
struct Gemm { const bf16_t* A; const bf16_t* Bt; int M, N, K, lda; };

struct StaticOrder {
    int nM, nN, nwg, G, c;
    __host__ __device__ void init(int M, int N, int G_, int c_) { nM = M / BM; nN = N / BM; nwg = nM * nN; G = G_; c = c_; }
    __host__ __device__ bool next(int i, Unit& u) const {
        const long L = (long)i * G + c; if (L >= nwg) return false;
        int wgid = (int)L; { const int q = nwg / NXCD, r = nwg % NXCD, xcd = wgid % NXCD, off = wgid / NXCD; wgid = (xcd < r ? xcd * (q + 1) : r * (q + 1) + (xcd - r) * q) + off; }
        const int nig = WGM * nN, gid = wgid / nig, fm = gid * WGM, gsz = (nM - fm) < WGM ? (nM - fm) : WGM;
        u.pm = fm + ((wgid % nig) % gsz); u.pn = (wgid % nig) / gsz; return true;
    }
    __device__ __forceinline__ void a_ready(const Unit&) const {}
    __device__ __forceinline__ void done(const Unit&) const {}
};

__device__ __forceinline__ unsigned cvt_pk_bf16(float lo, float hi) { unsigned r; asm volatile("v_cvt_pk_bf16_f32 %0, %1, %2" : "=v"(r) : "v"(lo), "v"(hi)); return r; }
template <class Epi, class Sched, bool ALIGN_EPI = false, bool SP2 = false>
__device__ __forceinline__ void gemm_phase(PG8_LAS unsigned char* lds, const Gemm g, const Sched& S, const Epi& E) {
    const int tid = opaque_tid(), wid = __builtin_amdgcn_readfirstlane(tid >> 6), lane = tid & 63, wr = wid >> 2, wc = wid & 3, fr = lane & 15, fq = lane >> 4;
    const int K = g.K, nt = K / BK;
    unsigned voffA[2], voffB[2];
#pragma unroll
    for (int i = 0; i < 2; ++i) { int R, C; stage_rc(tid * 16 + i * 8192, R, C); const int Rb = Epi::PERM ? ((R & ~31) + perm32(R & 31)) : R;
        voffA[i] = (unsigned)(R * g.lda + C) * 2u; voffB[i] = (unsigned)(Rb * K + C) * 2u; }
    const size_t kstep = (size_t)(BK * 2);
    const size_t hstep = (size_t)HALF * K * 2, hstepA = (size_t)HALF * g.lda * 2;
    const size_t tstep = 2 * hstep, tstepA = 2 * hstepA;
    const unsigned ldsw = (unsigned)wid * 1024u;
    const int aoff = lds_byte(wr * 64 + fr, fq * 8), boff = lds_byte(wc * 32 + fr, fq * 8);
#define PG8_SA(b, h) (((b) * 2 + (h)) * HTB)
#define PG8_SB(b, h) ((4 + (b) * 2 + (h)) * HTB)
#define PG8_STAGE(bufoff, gbase, voff) do { _Pragma("unroll") for (int _i = 0; _i < 2; ++_i) \
        __builtin_amdgcn_global_load_lds((const unsigned*)((const char*)(gbase) + (voff)[_i]), (PG8_LAS unsigned*)(lds + (bufoff) + ldsw + _i * 8192), 16, 0, 0); } while (0)
#define PG8_LDA(dst, b, h) do { _Pragma("unroll") for (int m = 0; m < 4; ++m) _Pragma("unroll") for (int k = 0; k < 2; ++k) dst[m][k] = *(const PG8_LAS bf16x8*)(lds + PG8_SA(b, h) + aoff + m * 2048 + k * 1024); } while (0)
#define PG8_LDB(dst, b, h) do { _Pragma("unroll") for (int n = 0; n < 2; ++n) _Pragma("unroll") for (int k = 0; k < 2; ++k) dst[n][k] = *(const PG8_LAS bf16x8*)(lds + PG8_SB(b, h) + boff + n * 2048 + k * 1024); } while (0)
#define PG8_MMA(ai, bj, At, Bt) do { __builtin_amdgcn_s_setprio(1); _Pragma("unroll") for (int m = 0; m < 4; ++m) _Pragma("unroll") for (int n = 0; n < 2; ++n) _Pragma("unroll") for (int k = 0; k < 2; ++k) \
        acc[ai][bj][m][n] = __builtin_amdgcn_mfma_f32_16x16x32_bf16(Bt[n][k], At[m][k], acc[ai][bj][m][n], 0, 0, 0); __builtin_amdgcn_s_setprio(0); } while (0)
#define PG8_WAIT_V(n) asm volatile("s_waitcnt vmcnt(" #n ")" ::: "memory")
#define PG8_WAIT_L(n) asm volatile("s_waitcnt lgkmcnt(" #n ")" ::: "memory")
#define PG8_BAR __builtin_amdgcn_s_barrier()
#define PG8_SCHED __builtin_amdgcn_sched_barrier(0)
    Unit cur, nxt; int ui = 0;
    if (!S.next(0, cur)) return;
    f32x4 acc[2][2][4][2];
#pragma unroll
    for (int a = 0; a < 2; ++a)
#pragma unroll
        for (int b = 0; b < 2; ++b)
#pragma unroll
            for (int m = 0; m < 4; ++m)
#pragma unroll
                for (int n = 0; n < 2; ++n) acc[a][b][m][n] = (f32x4){0.f, 0.f, 0.f, 0.f};
    bf16x8 At[4][2], B0[2][2], B1[2][2];
    const char* cA = (const char*)g.A + (size_t)cur.pm * tstepA; const char* cB = (const char*)g.Bt + (size_t)cur.pn * tstep;
    S.a_ready(cur);
    if constexpr (SP2) {
        PG8_STAGE(PG8_SB(0, 0), cB, voffB); PG8_STAGE(PG8_SB(0, 1), cB + hstep, voffB); PG8_STAGE(PG8_SA(0, 0), cA, voffA); PG8_STAGE(PG8_SA(0, 1), cA + hstepA, voffA);
        if (wr == 1) PG8_BAR;
        PG8_WAIT_V(2); PG8_BAR;
        PG8_STAGE(PG8_SB(1, 0), cB + kstep, voffB); PG8_STAGE(PG8_SA(1, 0), cA + kstep, voffA); PG8_STAGE(PG8_SB(1, 1), cB + hstep + kstep, voffB);
        PG8_WAIT_V(6); PG8_BAR;
    } else {
        PG8_STAGE(PG8_SB(0, 0), cB, voffB); PG8_STAGE(PG8_SA(0, 0), cA, voffA); PG8_STAGE(PG8_SB(0, 1), cB + hstep, voffB); PG8_STAGE(PG8_SA(0, 1), cA + hstepA, voffA);
        if (wr == 1) PG8_BAR;
        PG8_WAIT_V(4); PG8_BAR;
        PG8_STAGE(PG8_SB(1, 0), cB + kstep, voffB); PG8_STAGE(PG8_SA(1, 0), cA + kstep, voffA); PG8_STAGE(PG8_SB(1, 1), cB + hstep + kstep, voffB);
        PG8_WAIT_V(6); PG8_BAR;
    }
    for (;;) {
        const bool has_next = S.next(ui + 1, nxt);
        const char* nA = has_next ? (const char*)g.A + (size_t)nxt.pm * tstepA : cA; const char* nB = has_next ? (const char*)g.Bt + (size_t)nxt.pn * tstep : cB;
        for (int t = 0; t < nt; t += 2) {
            const bool last = (t == nt - 2);
            const char* a1 = cA + (size_t)(t + 1) * kstep;
            const char* a2 = last ? nA : cA + (size_t)(t + 2) * kstep; const char* b2 = last ? nB : cB + (size_t)(t + 2) * kstep;
            const char* a3 = a2 + kstep; const char* b3 = b2 + kstep;
            if (last && has_next) S.a_ready(nxt);
            if constexpr (SP2) {
            PG8_LDB(B0, 0, 0); PG8_LDB(B1, 0, 1); PG8_SCHED; PG8_LDA(At, 0, 0); PG8_STAGE(PG8_SA(1, 1), a1 + hstepA, voffA);
            PG8_WAIT_V(8); PG8_WAIT_L(0); PG8_BAR; PG8_MMA(0, 0, At, B0); PG8_MMA(0, 1, At, B1); PG8_BAR; PG8_SCHED;
            PG8_LDA(At, 0, 1); PG8_STAGE(PG8_SB(0, 0), b2, voffB); PG8_STAGE(PG8_SB(0, 1), b2 + hstep, voffB); PG8_STAGE(PG8_SA(0, 0), a2, voffA);
            PG8_WAIT_V(8); PG8_WAIT_L(0); PG8_BAR; PG8_MMA(1, 0, At, B0); PG8_MMA(1, 1, At, B1); PG8_BAR; PG8_SCHED;
            PG8_LDB(B0, 1, 0); PG8_LDB(B1, 1, 1); PG8_SCHED; PG8_LDA(At, 1, 0); PG8_STAGE(PG8_SA(0, 1), a2 + hstepA, voffA);
            PG8_WAIT_V(8); PG8_WAIT_L(0); PG8_BAR; PG8_MMA(0, 0, At, B0); PG8_MMA(0, 1, At, B1); PG8_BAR; PG8_SCHED;
            PG8_LDA(At, 1, 1); PG8_STAGE(PG8_SB(1, 0), b3, voffB); PG8_STAGE(PG8_SB(1, 1), b3 + hstep, voffB); PG8_STAGE(PG8_SA(1, 0), a3, voffA);
            PG8_WAIT_V(8); PG8_WAIT_L(0); PG8_BAR; PG8_MMA(1, 0, At, B0); PG8_MMA(1, 1, At, B1); PG8_BAR; PG8_SCHED;
            } else {
            PG8_LDB(B0, 0, 0); PG8_SCHED; PG8_LDA(At, 0, 0); PG8_STAGE(PG8_SA(1, 1), a1 + hstepA, voffA);
            PG8_WAIT_L(8); PG8_BAR; PG8_WAIT_L(0); PG8_MMA(0, 0, At, B0); PG8_BAR; PG8_SCHED;
            PG8_LDB(B1, 0, 1); PG8_STAGE(PG8_SB(0, 0), b2, voffB);
            PG8_BAR; PG8_WAIT_L(0); PG8_MMA(0, 1, At, B1); PG8_BAR;
            PG8_LDA(At, 0, 1); PG8_STAGE(PG8_SA(0, 0), a2, voffA);
            PG8_BAR; PG8_WAIT_L(0); PG8_MMA(1, 0, At, B0); PG8_BAR; PG8_SCHED;
            PG8_STAGE(PG8_SB(0, 1), b2 + hstep, voffB);
            PG8_WAIT_V(6); PG8_BAR; PG8_MMA(1, 1, At, B1); PG8_BAR;
            PG8_LDB(B0, 1, 0); PG8_SCHED; PG8_LDA(At, 1, 0); PG8_STAGE(PG8_SA(0, 1), a2 + hstepA, voffA);
            PG8_WAIT_L(8); PG8_BAR; PG8_WAIT_L(0); PG8_MMA(0, 0, At, B0); PG8_BAR; PG8_SCHED;
            PG8_LDB(B1, 1, 1); PG8_STAGE(PG8_SB(1, 0), b3, voffB);
            PG8_BAR; PG8_WAIT_L(0); PG8_MMA(0, 1, At, B1); PG8_BAR;
            PG8_LDA(At, 1, 1); PG8_STAGE(PG8_SA(1, 0), a3, voffA);
            PG8_BAR; PG8_WAIT_L(0); PG8_MMA(1, 0, At, B0); PG8_BAR; PG8_SCHED;
            PG8_STAGE(PG8_SB(1, 1), b3 + hstep, voffB);
            PG8_WAIT_V(6); PG8_BAR; PG8_MMA(1, 1, At, B1); PG8_BAR;
            }
        }
        if constexpr (ALIGN_EPI) { if (wr == 0) PG8_BAR; }
        if constexpr (!Epi::AFTER_DRAIN) { E(acc, cur, wr, wc, fr, fq); S.done(cur); }
        if (!has_next) break;
#pragma unroll
        for (int a = 0; a < 2; ++a)
#pragma unroll
            for (int b = 0; b < 2; ++b)
#pragma unroll
                for (int m = 0; m < 4; ++m)
#pragma unroll
                    for (int n = 0; n < 2; ++n) acc[a][b][m][n] = (f32x4){0.f, 0.f, 0.f, 0.f};
        cur = nxt; cA = nA; cB = nB; ++ui;
        if constexpr (ALIGN_EPI) { if (wr == 1) PG8_BAR; }
    }
    PG8_WAIT_V(0);
    if constexpr (!ALIGN_EPI) { if (wr == 0) PG8_BAR; }
    PG8_BAR;
    if constexpr (Epi::AFTER_DRAIN) { E.fused(acc, cur, wr, wc, fr, fq, lds, wid, lane); S.done(cur); }
#undef PG8_SA
#undef PG8_SB
#undef PG8_STAGE
#undef PG8_LDA
#undef PG8_LDB
#undef PG8_MMA
#undef PG8_WAIT_V
#undef PG8_WAIT_L
#undef PG8_BAR
#undef PG8_SCHED
}
}
constexpr int DM = 2048, TP = 32768, TSMP = 256, TALL = 33024, SEQ = 8192, NPROJ = 12288, DFF = 5632, PASTL = 1024, LKS = 1056;
constexpr size_t PJ_Q = 0, PJ_K = (size_t)TALL * 2048, PJ_V = (size_t)TALL * 4096, PJ_G = (size_t)TALL * 8192;
__device__ __forceinline__ size_t hrow(int row, int h) { return row < TP ? ((size_t)((row >> 13) * 8 + h) << 13) + (row & 8191) : (size_t)262144 + (size_t)((((row - TP) >> 5) * 8 + h) << 5) + ((row - TP) & 31); }
#define GAS __attribute__((address_space(1)))
#define LAS __attribute__((address_space(3)))
typedef unsigned short bf16_t;
typedef float f32x4 __attribute__((ext_vector_type(4)));
typedef unsigned u32x4 __attribute__((ext_vector_type(4)));
typedef unsigned u32x2 __attribute__((ext_vector_type(2)));
typedef short bf16x8 __attribute__((ext_vector_type(8)));
typedef short s16x4 __attribute__((ext_vector_type(4)));

namespace pg8 {
__device__ __forceinline__ float silu_f(float g) { return g * __builtin_amdgcn_rcpf(1.0f + __builtin_amdgcn_exp2f(-1.4426950408889634f * g)); }
struct EpiBf16P {
    static constexpr bool PERM = true, AFTER_DRAIN = false;
    bf16_t* O; int ldc;
    __device__ __forceinline__ void operator()(const f32x4 (&acc)[2][2][4][2], const Unit& u, int wr, int wc, int fr, int fq) const {
        const int row0 = u.pm * BM + wr * 64 + fr, col0 = u.pn * BM + wc * 32 + 8 * fq;
#pragma unroll
        for (int ai = 0; ai < 2; ++ai)
#pragma unroll
            for (int m = 0; m < 4; ++m) { bf16_t* rowp = O + (size_t)(row0 + ai * HALF + m * 16) * ldc + col0;
#pragma unroll
                for (int bj = 0; bj < 2; ++bj) { const f32x4 v0 = acc[ai][bj][m][0], v1 = acc[ai][bj][m][1];
                    u32x4 w; w.x = cvt_pk_bf16(v0[0], v0[1]); w.y = cvt_pk_bf16(v0[2], v0[3]); w.z = cvt_pk_bf16(v1[0], v1[1]); w.w = cvt_pk_bf16(v1[2], v1[3]);
                    *(u32x4*)(rowp + bj * HALF) = w; } }
    }
};
struct EpiRetIn {
    static constexpr bool PERM = true, AFTER_DRAIN = false;
    bf16_t* O; const float* cosT; const float* sinT;
    __device__ __forceinline__ void operator()(const f32x4 (&acc)[2][2][4][2], const Unit& u, int wr, int wc, int fr, int fq) const {
        const int row0 = u.pm * BM + wr * 64 + fr, cl = wc * 32 + 8 * fq;
        if (u.pn < 16) {
            const bool isk = u.pn >= 8; const int h = u.pn & 7;
            const float lg2 = __log2f(1.0f - exp2f(-5.0f - (float)h));
#pragma unroll
            for (int ai = 0; ai < 2; ++ai) {
                f32x4 cs[4][4]; float scv[4];
#pragma unroll
                for (int m = 0; m < 4; ++m) {
                    const int row = row0 + ai * HALF + m * 16; int pos, l;
                    if (row < TP) { pos = row & (SEQ - 1); l = row & 63; } else { const int s = (row - TP) & 31; pos = PASTL + s; l = s; }
                    scv[m] = isk ? exp2f(-lg2 * (float)l) * 0.0625f : exp2f(lg2 * (float)l);
                    const float* cp = cosT + (size_t)pos * 128 + cl; const float* sp = sinT + (size_t)pos * 128 + cl;
                    cs[m][0] = *(const f32x4*)cp; cs[m][1] = *(const f32x4*)(cp + 4); cs[m][2] = *(const f32x4*)sp; cs[m][3] = *(const f32x4*)(sp + 4); }
#pragma unroll
                for (int m = 0; m < 4; ++m) {
                    const int row = row0 + ai * HALF + m * 16; const float sc = scv[m];
                    const f32x4 c0 = cs[m][0], c1 = cs[m][1], s0 = cs[m][2], s1 = cs[m][3];
                    const f32x4 x1a = acc[ai][0][m][0], x1b = acc[ai][0][m][1], x2a = acc[ai][1][m][0], x2b = acc[ai][1][m][1];
                    const f32x4 o1a = (x1a * c0 - x2a * s0) * sc, o1b = (x1b * c1 - x2b * s1) * sc, o2a = (x1a * s0 + x2a * c0) * sc, o2b = (x1b * s1 + x2b * c1) * sc;
                    bf16_t* rowp = O + (isk ? PJ_K : PJ_Q) + hrow(row, h) * 256 + cl;
                    u32x4 w; w.x = cvt_pk_bf16(o1a[0], o1a[1]); w.y = cvt_pk_bf16(o1a[2], o1a[3]); w.z = cvt_pk_bf16(o1b[0], o1b[1]); w.w = cvt_pk_bf16(o1b[2], o1b[3]);
                    *(u32x4*)rowp = w;
                    w.x = cvt_pk_bf16(o2a[0], o2a[1]); w.y = cvt_pk_bf16(o2a[2], o2a[3]); w.z = cvt_pk_bf16(o2b[0], o2b[1]); w.w = cvt_pk_bf16(o2b[2], o2b[3]);
                    *(u32x4*)(rowp + HALF) = w; }
                asm volatile("" ::: "memory"); }
        } else {
            const bool isv = u.pn < 32; const int hv = (u.pn - 16) >> 1, e0 = ((u.pn - 16) & 1) * 256 + cl;
#pragma unroll
            for (int ai = 0; ai < 2; ++ai)
#pragma unroll
                for (int m = 0; m < 4; ++m) { const int row = row0 + ai * HALF + m * 16;
                    bf16_t* rowp = isv ? O + PJ_V + hrow(row, hv) * 512 + e0 : O + PJ_G + (size_t)row * 4096 + (u.pn - 32) * BM + cl;
#pragma unroll
                    for (int bj = 0; bj < 2; ++bj) { const f32x4 v0 = acc[ai][bj][m][0], v1 = acc[ai][bj][m][1];
                        u32x4 w; w.x = cvt_pk_bf16(v0[0], v0[1]); w.y = cvt_pk_bf16(v0[2], v0[3]); w.z = cvt_pk_bf16(v1[0], v1[1]); w.w = cvt_pk_bf16(v1[2], v1[3]);
                        *(u32x4*)(rowp + bj * HALF) = w; } }
        }
    }
};
struct EpiRes {
    static constexpr bool PERM = false, AFTER_DRAIN = false;
    const float* baseP; const float* baseS; float* out; bf16_t* hb; float* ssq;
    __device__ __forceinline__ void operator()(const f32x4 (&acc)[2][2][4][2], const Unit& u, int wr, int wc, int fr, int fq) const {
        const int row0 = u.pm * BM + wr * 64 + fr, col0 = u.pn * BM + wc * 32 + 4 * fq;
#pragma unroll
        for (int ai = 0; ai < 2; ++ai) {
            f32x4 bv[4][2][2];
#pragma unroll
            for (int m = 0; m < 4; ++m) { const int row = row0 + ai * HALF + m * 16;
                const float* b = (row < TP ? baseP + (size_t)row * DM : baseS + (size_t)(row - TP) * DM) + col0;
#pragma unroll
                for (int bj = 0; bj < 2; ++bj)
#pragma unroll
                    for (int n = 0; n < 2; ++n) bv[m][bj][n] = *(const f32x4*)(b + bj * HALF + n * 16); }
#pragma unroll
            for (int m = 0; m < 4; ++m) { const int row = row0 + ai * HALF + m * 16; float* o = out + (size_t)row * DM + col0; float ss = 0.f;
#pragma unroll
                for (int bj = 0; bj < 2; ++bj)
#pragma unroll
                    for (int n = 0; n < 2; ++n) { const f32x4 v = bv[m][bj][n] + acc[ai][bj][m][n]; *(f32x4*)(o + bj * HALF + n * 16) = v;
                        if (hb) { u32x2 w; w.x = cvt_pk_bf16(v[0], v[1]); w.y = cvt_pk_bf16(v[2], v[3]); *(u32x2*)(hb + (size_t)row * DM + col0 + bj * HALF + n * 16) = w; }
                        ss += (v[0] * v[0] + v[1] * v[1]) + (v[2] * v[2] + v[3] * v[3]); }
                if (ssq) { ss += __shfl_xor(ss, 16); ss += __shfl_xor(ss, 32);
                    if (fq == 0) (void)__hip_atomic_fetch_add(ssq + row, ss, __ATOMIC_RELAXED, __HIP_MEMORY_SCOPE_AGENT); } }
            asm volatile("" ::: "memory"); }
    }
};
struct EpiSwiglu {
    static constexpr bool PERM = true, AFTER_DRAIN = false;
    bf16_t* O; const float* ssq;
    __device__ __forceinline__ void operator()(const f32x4 (&acc)[2][2][4][2], const Unit& u, int wr, int wc, int fr, int fq) const {
        const int row0 = u.pm * BM + wr * 64 + fr, col0 = u.pn * HALF + wc * 32 + 8 * fq;
        float rs[2][4];
#pragma unroll
        for (int ai = 0; ai < 2; ++ai)
#pragma unroll
            for (int m = 0; m < 4; ++m) rs[ai][m] = ssq[row0 + ai * HALF + m * 16];
#pragma unroll
        for (int ai = 0; ai < 2; ++ai)
#pragma unroll
            for (int m = 0; m < 4; ++m) { bf16_t* rowp = O + (size_t)(row0 + ai * HALF + m * 16) * DFF + col0; const float r = 1.0f / sqrtf(rs[ai][m] * (1.f / DM) + 1e-6f);
                const f32x4 g0 = acc[ai][0][m][0] * r, g1 = acc[ai][0][m][1] * r, u0 = acc[ai][1][m][0] * r, u1 = acc[ai][1][m][1] * r;
                f32x4 a0, a1;
#pragma unroll
                for (int j = 0; j < 4; ++j) { a0[j] = silu_f(g0[j]) * u0[j]; a1[j] = silu_f(g1[j]) * u1[j]; }
                u32x4 w; w.x = cvt_pk_bf16(a0[0], a0[1]); w.y = cvt_pk_bf16(a0[2], a0[3]); w.z = cvt_pk_bf16(a1[0], a1[1]); w.w = cvt_pk_bf16(a1[2], a1[3]);
                *(u32x4*)rowp = w; }
    }
};
struct EpiKVFQ {
    static constexpr bool PERM = false, AFTER_DRAIN = false;
    float* kP; float* vP; float* lfP; float* kS; float* vS; float* lfS; bf16_t* KB; bf16_t* VB; bf16_t* KALL; bf16_t* VALL; bf16_t* QB; const float* bf; const float* ssq;
    __device__ __forceinline__ void operator()(const f32x4 (&acc)[2][2][4][2], const Unit& u, int wr, int wc, int fr, int fq) const {
        const int row0 = u.pm * BM + wr * 64 + fr;
        float rs[2][4];
#pragma unroll
        for (int ai = 0; ai < 2; ++ai)
#pragma unroll
            for (int m = 0; m < 4; ++m) rs[ai][m] = 1.0f / sqrtf(ssq[row0 + ai * HALF + m * 16] * (1.f / DM) + 1e-6f);
        if (u.pn >= 5) {
            const int col0 = (u.pn - 5) * BM + wc * 32 + 4 * fq;
#pragma unroll
            for (int ai = 0; ai < 2; ++ai)
#pragma unroll
                for (int m = 0; m < 4; ++m) { bf16_t* bo = QB + (size_t)(row0 + ai * HALF + m * 16) * DM + col0;
#pragma unroll
                    for (int bj = 0; bj < 2; ++bj)
#pragma unroll
                        for (int n = 0; n < 2; ++n) { const f32x4 v = acc[ai][bj][m][n] * rs[ai][m]; u32x2 w; w.x = cvt_pk_bf16(v[0], v[1]); w.y = cvt_pk_bf16(v[2], v[3]); *(u32x2*)(bo + bj * HALF + n * 16) = w; } }
        } else if (u.pn < 4) {
            const bool isv = u.pn >= 2; const int col0 = (u.pn & 1) * BM + wc * 32 + 4 * fq;
            float* fP = isv ? vP : kP; float* fS = isv ? vS : kS; bf16_t* bP = isv ? VB : KB; bf16_t* bA = isv ? VALL : KALL;
#pragma unroll
            for (int ai = 0; ai < 2; ++ai)
#pragma unroll
                for (int m = 0; m < 4; ++m) { const int row = row0 + ai * HALF + m * 16; float* fo; bf16_t* bo;
                    if (row < TP) { fo = fP + (size_t)row * 512 + col0; bo = bP + (size_t)row * 512 + col0; }
                    else { const int r2 = row - TP; fo = fS + (size_t)r2 * 512 + col0; bo = bA + ((size_t)(r2 >> 5) * LKS + PASTL + (r2 & 31)) * 512 + col0; }
#pragma unroll
                    for (int bj = 0; bj < 2; ++bj)
#pragma unroll
                        for (int n = 0; n < 2; ++n) { const f32x4 v = acc[ai][bj][m][n] * rs[ai][m]; *(f32x4*)(fo + bj * HALF + n * 16) = v;
                            u32x2 w; w.x = cvt_pk_bf16(v[0], v[1]); w.y = cvt_pk_bf16(v[2], v[3]); *(u32x2*)(bo + bj * HALF + n * 16) = w; } }
        } else if (wc == 0) {
            const f32x4 bb = *(const f32x4*)(bf + 4 * fq);
#pragma unroll
            for (int ai = 0; ai < 2; ++ai)
#pragma unroll
                for (int m = 0; m < 4; ++m) { const int row = row0 + ai * HALF + m * 16; const f32x4 z = acc[ai][0][m][0] * rs[ai][m] + bb; f32x4 r;
#pragma unroll
                    for (int j = 0; j < 4; ++j) r[j] = fminf(z[j], 0.f) - log1pf(__expf(-fabsf(z[j])));
                    float* o = row < TP ? lfP + (size_t)row * 16 : lfS + (size_t)(row - TP) * 16; *(f32x4*)(o + 4 * fq) = r; }
        }
    }
};
}
namespace fox {
enum { ORDER_NATURAL = 0, ORDER_REVERSED = 1, ORDER_PAIRED = 2, ORDER_XCD = 4 };
constexpr int D = 128, QS = 2048, KS = 512, OS = 2048;
constexpr float THR = 8.f;
constexpr bool WSKIP = false;
constexpr float SCALE = 0.08838834764831845f;
constexpr int NW = 8, QBLK = 32, KVBLK = 64, QB = NW * QBLK;
constexpr int SHM_V = KVBLK * D * 2, SHM_K = KVBLK * D * 2;
constexpr int LDS_BYTES = 2 * SHM_V + 2 * SHM_K + NW * 64 * 4 + 2 * 64 * 4;
typedef unsigned short bf16;
typedef short bf16x8 __attribute__((ext_vector_type(8)));
typedef short s16x4 __attribute__((ext_vector_type(4)));
typedef float f32x16 __attribute__((ext_vector_type(16)));
typedef float f32x4 __attribute__((ext_vector_type(4)));
typedef unsigned u32x4 __attribute__((ext_vector_type(4)));
template <class A, class Bt> struct same_t { static constexpr bool v = false; };
template <class A> struct same_t<A, A> { static constexpr bool v = true; };

#define KSWZ(row, colB) ((row) * 256 + ((colB) ^ (((row) & 7) << 4)))
#define SBAR() __builtin_amdgcn_sched_barrier(0)
__device__ __forceinline__ int v_st(int k, int c) { const int kk = (k & ~0xC) | ((k & 4) << 1) | ((k & 8) >> 1); return ((kk >> 3) * 4 + (c >> 5)) * 512 + ((kk & 7) * 32 + (c & 31)) * 2; }
__device__ __forceinline__ int v_rd_base(int lane) { return ((lane & 3) << 3) | (((lane >> 2) & 3) << 6) | (((lane >> 4) & 1) << 5) | (((lane >> 5) & 1) << 8); }
constexpr int v_rd_off(int d0, int ks, int half) { return d0 * 512 + ks * 4096 + half * 2048; }
__device__ __forceinline__ int crow(int r, int hi) { return (r & 3) + 8 * (r >> 2) + 4 * hi; }
__device__ __forceinline__ unsigned cvtpk(float lo, float hi) {
    unsigned r; asm volatile("v_cvt_pk_bf16_f32 %0, %1, %2" : "=v"(r) : "v"(lo), "v"(hi)); return r;
}
__device__ __forceinline__ bf16x8 pack8(f32x4 a, f32x4 b) {
    u32x4 w = {cvtpk(a[0], a[1]), cvtpk(a[2], a[3]), cvtpk(b[0], b[1]), cvtpk(b[2], b[3])};
    return *reinterpret_cast<bf16x8*>(&w);
}
template <class T> __device__ __forceinline__ bf16x8 load8(const T* p) {
    if constexpr (same_t<T, float>::v) { return pack8(*(const f32x4*)p, *(const f32x4*)(p + 4)); }
    else { return *reinterpret_cast<const bf16x8*>(p); }
}
__device__ __forceinline__ void mask_tile(f32x16& p0, f32x16& p1, int dq, unsigned W) {
    const float NEG = -__builtin_inff();
#pragma unroll
    for (int r = 0; r < 16; ++r) {
        const int c = (r & 3) + 8 * (r >> 2);
        if ((unsigned)(dq - c) >= W) p0[r] = NEG;
        if ((unsigned)(dq - c - 32) >= W) p1[r] = NEG;
    }
}
__device__ __forceinline__ void partialSM(f32x16& p0, f32x16& p1, float& m_reg, float& mn, float& alpha) {
    float pmax = p0[0]; for (int r = 1; r < 16; ++r) pmax = fmaxf(pmax, p0[r]); for (int r = 0; r < 16; ++r) pmax = fmaxf(pmax, p1[r]);
    { auto rr = __builtin_amdgcn_permlane32_swap(__float_as_uint(pmax), __float_as_uint(pmax), false, false);
      pmax = fmaxf(__uint_as_float(rr[0]), __uint_as_float(rr[1])); }
    constexpr float C2 = 1.4426950408889634f * SCALE;
    if (__builtin_expect(__all((pmax - m_reg) * SCALE <= THR), 1)) { mn = m_reg; alpha = 1.f; }
    else { mn = fmaxf(m_reg, pmax); alpha = __builtin_amdgcn_exp2f((m_reg - mn) * C2); m_reg = mn; }
    const float mnL = -mn * C2;
    for (int r = 0; r < 16; ++r) p0[r] = fmaf(p0[r], C2, mnL); for (int r = 0; r < 16; ++r) p1[r] = fmaf(p1[r], C2, mnL);
    for (int r = 0; r < 16; ++r) p0[r] = __builtin_amdgcn_exp2f(p0[r]);
}
__device__ __forceinline__ void finishSM(f32x16& p0, f32x16& p1, float alpha, float& l_reg, bf16x8& pa0, bf16x8& pa1, bf16x8& pa2, bf16x8& pa3) {
    for (int r = 0; r < 16; ++r) p1[r] = __builtin_amdgcn_exp2f(p1[r]);
    float ps = 0; for (int r = 0; r < 16; ++r) ps += p0[r]; for (int r = 0; r < 16; ++r) ps += p1[r];
    { auto rr = __builtin_amdgcn_permlane32_swap(__float_as_uint(ps), __float_as_uint(ps), false, false);
      ps = __uint_as_float(rr[0]) + __uint_as_float(rr[1]); }
    l_reg = l_reg * alpha + ps;
#define PK4(P, B_, OUT) do { unsigned a0 = cvtpk(P[B_+0], P[B_+1]), a1 = cvtpk(P[B_+2], P[B_+3]);                          \
        unsigned b0 = cvtpk(P[B_+4], P[B_+5]), b1 = cvtpk(P[B_+6], P[B_+7]);                                             \
        auto r0 = __builtin_amdgcn_permlane32_swap(a0, b0, false, false); auto r1 = __builtin_amdgcn_permlane32_swap(a1, b1, false, false); \
        u32x4 w = {r0[0], r1[0], r0[1], r1[1]}; OUT = *reinterpret_cast<bf16x8*>(&w); } while (0)
    PK4(p0, 0, pa0); PK4(p0, 8, pa1); PK4(p1, 0, pa2); PK4(p1, 8, pa3);
#undef PK4
}
template <int KB, bool SK>
__device__ __forceinline__ void qkt(f32x16& p0, f32x16& p1, const char* K_lds, int r32, int hi, const bf16x8* qr, bool act) {
    if (SK && !act) { const float NEG = -__builtin_inff();
#pragma unroll
        for (int r = 0; r < 16; ++r) { p0[r] = NEG; p1[r] = NEG; } return; }
    { const float* bb_ = (const float*)(K_lds + 2 * SHM_K + NW * 64 * 4) + KB * 64 + 4 * hi;
#pragma unroll
      for (int q_ = 0; q_ < 4; ++q_) { const f32x4 b0_ = *(const f32x4*)(bb_ + 8 * q_), b1_ = *(const f32x4*)(bb_ + 32 + 8 * q_);
#pragma unroll
        for (int i_ = 0; i_ < 4; ++i_) { p0[4 * q_ + i_] = b0_[i_]; p1[4 * q_ + i_] = b1_[i_]; } } }
    const char* kb[4];
#pragma unroll
    for (int dd = 0; dd < 4; ++dd) kb[dd] = K_lds + KB * SHM_K + KSWZ(r32, (dd * 16 + hi * 8) * 2);
#pragma unroll
    for (int d0 = 0; d0 < 8; ++d0) { const char* a = kb[d0 & 3] + (d0 >> 2) * 128;
        bf16x8 b0 = *reinterpret_cast<const bf16x8*>(a);
        bf16x8 b1 = *reinterpret_cast<const bf16x8*>(a + 32 * 256);
        p0 = __builtin_amdgcn_mfma_f32_32x32x16_bf16(b0, qr[d0], p0, 0, 0, 0);
        p1 = __builtin_amdgcn_mfma_f32_32x32x16_bf16(b1, qr[d0], p1, 0, 0, 0); }
}
template <int VB, bool SK>
__device__ __forceinline__ void pv_tile(f32x16* o, int vb0, bf16x8 pa0, bf16x8 pa1, bf16x8 pa2, bf16x8 pa3, bool act) {
    if (SK && !act) return;
#define TRRD(dst, off) asm volatile("ds_read_b64_tr_b16 %0, %1 offset:%2" : "=&v"(dst) : "v"(vb0), "i"(off) : "memory")
#define PV_D0(d0) do { s16x4 l0, l1, l2, l3, h0, h1, h2, h3; constexpr int b_ = VB * SHM_V + v_rd_off(d0, 0, 0);     \
        TRRD(l0, b_); TRRD(h0, b_ + 2048); TRRD(l1, b_ + 4096); TRRD(h1, b_ + 6144); TRRD(l2, b_ + 8192); TRRD(h2, b_ + 10240); TRRD(l3, b_ + 12288); TRRD(h3, b_ + 14336); \
        asm volatile("s_waitcnt lgkmcnt(0)" ::: "memory"); SBAR();                 \
        o[d0] = __builtin_amdgcn_mfma_f32_32x32x16_bf16(pa0, (bf16x8){l0[0], l0[1], l0[2], l0[3], h0[0], h0[1], h0[2], h0[3]}, o[d0], 0, 0, 0);   \
        o[d0] = __builtin_amdgcn_mfma_f32_32x32x16_bf16(pa1, (bf16x8){l1[0], l1[1], l1[2], l1[3], h1[0], h1[1], h1[2], h1[3]}, o[d0], 0, 0, 0);   \
        o[d0] = __builtin_amdgcn_mfma_f32_32x32x16_bf16(pa2, (bf16x8){l2[0], l2[1], l2[2], l2[3], h2[0], h2[1], h2[2], h2[3]}, o[d0], 0, 0, 0);   \
        o[d0] = __builtin_amdgcn_mfma_f32_32x32x16_bf16(pa3, (bf16x8){l3[0], l3[1], l3[2], l3[3], h3[0], h3[1], h3[2], h3[3]}, o[d0], 0, 0, 0); } while (0)
    PV_D0(0); PV_D0(1); PV_D0(2); PV_D0(3);
#undef PV_D0
#undef TRRD
}
template <class TIn, class TOut> struct BlockRef { const TIn* Q; const TIn* K; const TIn* V; TOut* O; const float* FB; int P0; };
template <class TIn> struct Seam {
    bf16x8 qr[8];
    bf16x8 st_v0, st_v1, st_k0, st_k1; float st_f; f32x4 sf0, sf1, sf2, sf3;
    f32x4 tq[16];
};
__device__ __forceinline__ int swa_jlo(int P0, int W) { const int lowk = P0 - W + 1; return lowk > 0 ? lowk / KVBLK : 0; }
#define ROW(p, k0, rr) ((p) + (size_t)((k0) + (rr)) * KS + sc)
#define VMW() asm volatile("s_waitcnt vmcnt(0)" ::: "memory")
#define VMWN(n) asm volatile("s_waitcnt vmcnt(%0)" :: "i"(n) : "memory")
#define SLOAD_H(Kp, Vp, Fp, k0) do { S.st_f = (Fp)[(k0) + (tid & 63)]; S.st_v0 = load8<TIn>(ROW(Vp, k0, sr)); S.st_v1 = load8<TIn>(ROW(Vp, k0, 32 + sr));              \
                         S.st_k0 = load8<TIn>(ROW(Kp, k0, sr)); S.st_k1 = load8<TIn>(ROW(Kp, k0, 32 + sr)); } while (0)
#define SWRITE_HK(bf) do { ((float*)(K_lds + 2 * SHM_K + NW * 64 * 4))[(bf) * 64 + (tid & 63)] = S.st_f; *(bf16x8*)(K_lds + (bf) * SHM_K + kws) = S.st_k0; *(bf16x8*)(K_lds + (bf) * SHM_K + kws + 32 * 256) = S.st_k1; } while (0)
#define SWRITE_HV(bf) do { *(bf16x8*)(V_lds + (bf) * SHM_V + vst0) = S.st_v0; *(bf16x8*)(V_lds + (bf) * SHM_V + vst1) = S.st_v1; } while (0)
#define SWRITE_H(bf) do { SWRITE_HV(bf); SWRITE_HK(bf); } while (0)
#define SLOAD_F(p, k0) do { S.sf0 = *(const f32x4*)ROW(p, k0, sr); S.sf1 = *(const f32x4*)(ROW(p, k0, sr) + 4);                \
                            S.sf2 = *(const f32x4*)ROW(p, k0, 32 + sr); S.sf3 = *(const f32x4*)(ROW(p, k0, 32 + sr) + 4); } while (0)
#define SWRITE_KF(bf) do { *(bf16x8*)(K_lds + (bf) * SHM_K + kws) = pack8(S.sf0, S.sf1); *(bf16x8*)(K_lds + (bf) * SHM_K + kws + 32 * 256) = pack8(S.sf2, S.sf3); } while (0)
#define SWRITE_VF(bf) do { *(bf16x8*)(V_lds + (bf) * SHM_V + vst0) = pack8(S.sf0, S.sf1); *(bf16x8*)(V_lds + (bf) * SHM_V + vst1) = pack8(S.sf2, S.sf3); } while (0)
template <class TIn, class TOut>
__device__ __forceinline__ void causal_swa_prime(const BlockRef<TIn, TOut>& cur, int W, char* lds, Seam<TIn>& S) {
    constexpr bool F32 = same_t<TIn, float>::v;
    const int tid = opaque_tid(), wid = __builtin_amdgcn_readfirstlane(tid >> 6), lane = tid & 63, r32 = lane & 31, hi = lane >> 5;
    const int sr = tid >> 4, sc = (tid & 15) * 8, kws = KSWZ(sr, sc * 2); char* K_lds = lds + 2 * SHM_V;
    const int kb0 = swa_jlo(cur.P0, W) * KVBLK;
    for (int d0 = 0; d0 < 8; ++d0) S.qr[d0] = load8<TIn>(cur.Q + (size_t)(wid * QBLK + r32) * QS + d0 * 16 + hi * 8);
    if constexpr (F32) { SLOAD_F((const float*)cur.K, kb0); VMW(); SWRITE_KF(0); SBAR(); SLOAD_F((const float*)cur.V, kb0); }
    else { SLOAD_H(cur.K, cur.V, cur.FB, kb0); VMW(); SWRITE_HK(0); }
    __syncthreads();
}
template <class TIn, class TOut>
__device__ __forceinline__ void causal_swa_block(const BlockRef<TIn, TOut>& cur, const BlockRef<TIn, TOut>& nxt, int skv, int W, char* lds, Seam<TIn>& S) {
    constexpr bool F32 = same_t<TIn, float>::v;
    const int tid = opaque_tid(), wid = __builtin_amdgcn_readfirstlane(tid >> 6), lane = tid & 63, r32 = lane & 31, hi = lane >> 5;
    const int j_lo = swa_jlo(cur.P0, W);
    int j_hi = (cur.P0 + QB - 1) / KVBLK + 1; if (j_hi > skv / KVBLK) j_hi = skv / KVBLK;
    const int NT = j_hi - j_lo;
    const int kbn = swa_jlo(nxt.P0, W) * KVBLK;
    const int qlo = cur.P0 + wid * QBLK, qm = qlo + r32 - 4 * hi;
    char* V_lds = lds; char* K_lds = lds + 2 * SHM_V;
    float* ws = (float*)(lds + 2 * SHM_V + 2 * SHM_K) + wid * 64; float* li_l = ws, * al_l = ws + 32;
    float m_reg = -1e30f, l_reg = 0; f32x16 o[4] = {};
    const int sr = tid >> 4, sc = (tid & 15) * 8, vst0 = v_st(sr, sc), vst1 = v_st(32 + sr, sc), kws = KSWZ(sr, sc * 2);
    const int vb0 = (int)(uintptr_t)V_lds + v_rd_base(lane);
    const TIn* Kh = cur.K; const TIn* Vh = cur.V;
#define RESC(a) do { if (__any((a) < 1.f)) { if (hi == 0) al_l[r32] = (a); asm volatile("s_waitcnt lgkmcnt(0)" ::: "memory");              \
                     for (int d_ = 0; d_ < 4; ++d_) for (int r = 0; r < 16; ++r) o[d_][r] *= al_l[crow(r, hi)]; } } while (0)
#define KBASE(t) ((j_lo + (t)) * KVBLK)
#define ACT(t) (KBASE(t) <= qlo + QBLK - 1 && KBASE(t) + KVBLK - 1 >= qlo - W + 1)
#define MASKT(P0_, P1_, t) do { const int kb_ = KBASE(t); if ((!SK || ACT(t)) && (kb_ + KVBLK - 1 > qlo || kb_ <= qlo + QBLK - 1 - W)) mask_tile(P0_, P1_, qm - kb_, (unsigned)W); } while (0)
    constexpr int NQL = F32 ? 16 : 8;
    constexpr bool SK = WSKIP && !F32;
#define SEAM_K0() do { VMWN(NQL); if constexpr (F32) { SWRITE_KF(0); SBAR(); SLOAD_F((const float*)nxt.V, kbn); } else { SWRITE_HK(0); } SBAR(); } while (0)
    f32x16 pA0, pA1, pB0, pB1; float mnA, mnB, alA, alB; bf16x8 pa0, pa1, pa2, pa3;
    if constexpr (F32) { VMW(); SWRITE_VF(0); SBAR(); } else { SWRITE_HV(0); SBAR(); }
    if (NT > 1) { if constexpr (F32) SLOAD_F((const float*)Kh, KBASE(1)); else SLOAD_H(Kh, Vh, cur.FB, KBASE(1)); }
    SBAR(); qkt<0, SK>(pA0, pA1, K_lds, r32, hi, S.qr, ACT(0));
    if constexpr (F32) { if (NT > 1) { VMW(); SWRITE_KF(1); SBAR(); SLOAD_F((const float*)Vh, KBASE(1)); } }
    MASKT(pA0, pA1, 0); partialSM(pA0, pA1, m_reg, mnA, alA);
    if (NT > 1) { VMW(); if constexpr (F32) { SWRITE_VF(1); SBAR(); if (NT > 2) SLOAD_F((const float*)Kh, KBASE(2)); } else SWRITE_H(1); }
    __syncthreads();
#define HALF_STEP(PX0, PX1, mnX, alX, PY0, PY1, alY, t, KB, VB, SB) do {                                                      \
        SBAR(); qkt<KB, SK>(PX0, PX1, K_lds, r32, hi, S.qr, ACT(t));                                             \
        finishSM(PY0, PY1, alY, l_reg, pa0, pa1, pa2, pa3); SBAR();                                                           \
        if ((t) + 1 < NT) { if constexpr (F32) { VMW(); SWRITE_KF(SB); SBAR(); SLOAD_F((const float*)Vh, KBASE((t) + 1)); }  \
                            else { SLOAD_H(Kh, Vh, cur.FB, KBASE((t) + 1)); } SBAR(); }                                               \
        pv_tile<VB, SK>(o, vb0, pa0, pa1, pa2, pa3, ACT((t) - 1)); MASKT(PX0, PX1, (t)); partialSM(PX0, PX1, m_reg, mnX, alX);                                        \
        __syncthreads();                                                                                                      \
        if ((t) + 1 < NT) { VMW(); if constexpr (F32) { SWRITE_VF(SB); SBAR(); if ((t) + 2 < NT) SLOAD_F((const float*)Kh, KBASE((t) + 2)); } \
                            else { SWRITE_H(SB); } }                                                                          \
        RESC(alX); __syncthreads(); } while (0)
    for (int t = 1; t + 1 < NT; t += 2) {
        HALF_STEP(pB0, pB1, mnB, alB, pA0, pA1, alA, t, 1, 0, 0);
        HALF_STEP(pA0, pA1, mnA, alA, pB0, pB1, alB, t + 1, 0, 1, 1);
    }
    const bool even = (NT & 1) == 0;
    if (even) { SBAR(); qkt<1, SK>(pB0, pB1, K_lds, r32, hi, S.qr, ACT(NT - 1)); SBAR(); }
#define QROW(e) (nxt.Q + (size_t)(wid * QBLK + r32) * D + ((e) >> 1) * 16 + hi * 8 + ((e) & 1) * 4)
    if constexpr (F32) { SLOAD_F((const float*)nxt.K, kbn); SBAR();
#pragma unroll
        for (int e = 0; e < 8; ++e) S.tq[e] = *(const f32x4*)QROW(e); }
    else { SLOAD_H(nxt.K, nxt.V, nxt.FB, kbn); SBAR();
#pragma unroll
        for (int d0 = 0; d0 < 8; ++d0) S.qr[d0] = load8<TIn>(nxt.Q + (size_t)(wid * QBLK + r32) * QS + d0 * 16 + hi * 8); }
    SBAR();
    finishSM(pA0, pA1, alA, l_reg, pa0, pa1, pa2, pa3); SBAR();
    if constexpr (F32) {
#pragma unroll
        for (int e = 8; e < 16; ++e) S.tq[e] = *(const f32x4*)QROW(e); SBAR(); }
#undef QROW
    pv_tile<0, SK>(o, vb0, pa0, pa1, pa2, pa3, ACT(even ? NT - 2 : NT - 1));
    if (even) { MASKT(pB0, pB1, NT - 1); partialSM(pB0, pB1, m_reg, mnB, alB); __syncthreads(); RESC(alB);
        finishSM(pB0, pB1, alB, l_reg, pa0, pa1, pa2, pa3); SBAR(); pv_tile<1, SK>(o, vb0, pa0, pa1, pa2, pa3, ACT(NT - 1)); }
    SBAR(); SEAM_K0();
    if (hi == 0) li_l[r32] = l_reg; asm volatile("s_waitcnt lgkmcnt(0)" ::: "memory");
    float rli[16];
#pragma unroll
    for (int r = 0; r < 16; ++r) rli[r] = __builtin_amdgcn_rcpf(li_l[crow(r, hi)]);
    TOut* Ow = cur.O + (size_t)(wid * QBLK) * OS;
#pragma unroll
    for (int r = 0; r < 16; ++r) { const int orow = crow(r, hi);
#pragma unroll
        for (int d0 = 0; d0 < 4; ++d0) { const float v = o[d0][r] * rli[r];
            if constexpr (same_t<TOut, float>::v) { Ow[(size_t)orow * OS + d0 * 32 + r32] = v; }
            else { const float vn = __shfl_xor(v, 1);
                   if ((r32 & 1) == 0) *(unsigned*)(Ow + (size_t)orow * OS + d0 * 32 + r32) = cvtpk(v, vn); } } }
    if constexpr (F32) {
#pragma unroll
        for (int d0 = 0; d0 < 8; ++d0) S.qr[d0] = pack8(S.tq[2 * d0], S.tq[2 * d0 + 1]); }
    __syncthreads();
#undef RESC
#undef KBASE
#undef ACT
#undef MASKT
#undef SEAM_K0
#undef HALF_STEP
}
#undef ROW
#undef VMW
#undef VMWN
#undef SLOAD_H
#undef SWRITE_HK
#undef SWRITE_HV
#undef SWRITE_H
#undef SLOAD_F
#undef SWRITE_KF
#undef SWRITE_VF

__host__ __device__ inline int swa_nramp(int nqb, int W, int qoff) { const int t = W - 1 - qoff; const int n = t < 0 ? 0 : t / QB + 1; return n > nqb ? nqb : n; }
__host__ __device__ inline int swa_nx(int nqb, int nramp, int order) { return (order & ORDER_PAIRED) ? (nramp + 1) / 2 + (nqb - nramp) : nqb; }
struct SwaItem { int bh, qb0, qb1; };
__device__ __forceinline__ SwaItem swa_decode(int L, int nb, int nh, int nhkv, int nqb, int nx, int nramp, int order) {
    const int G = nh / nhkv; SwaItem it; int x;
    if ((order & ORDER_XCD) && (nb * nhkv) % 8 == 0) { const int xcd = L & 7, k = L >> 3, per = G * nx, gi = k / per, r = k - gi * per;
        it.bh = (gi * 8 + xcd) * G + r / nx; x = r % nx; }
    else { it.bh = L / nx; x = L - it.bh * nx; }
    if (order & ORDER_PAIRED) { const int ns = nqb - nramp;
        if (x < ns) { it.qb0 = it.qb1 = nqb - 1 - x; } else { it.qb0 = x - ns; it.qb1 = nramp - 1 - it.qb0; } }
    else { it.qb0 = it.qb1 = ((order & 3) == ORDER_REVERSED) ? nqb - 1 - x : x; }
    return it;
}
typedef unsigned short bf16;
__device__ __forceinline__ BlockRef<bf16, bf16> mk_ref(const SwaItem& it, int pass, const bf16* Q, const bf16* K, const bf16* V, bf16* O, const float* FB) {
    const int qb = pass ? it.qb1 : it.qb0, b = it.bh >> 4, h = it.bh & 15, kvh = h >> 2;
    BlockRef<bf16, bf16> r;
    r.Q = Q + ((size_t)b * 8192 + (size_t)qb * QB) * QS + h * 128; r.O = O + ((size_t)b * 8192 + (size_t)qb * QB) * OS + h * 128;
    r.K = K + (size_t)b * 8192 * KS + kvh * 128; r.V = V + (size_t)b * 8192 * KS + kvh * 128; r.FB = FB + (size_t)it.bh * 8192; r.P0 = qb * QB;
    return r;
}
__device__ __forceinline__ void attn_phase(char* lds, const bf16* Q, const bf16* K, const bf16* V, bf16* O, const float* FB) {
    constexpr int nb = 4, nh = 16, nhkv = 4, nqb = 32, W = 8192, order = ORDER_PAIRED | ORDER_XCD;
    const int nramp = swa_nramp(nqb, W, 0), nx = swa_nx(nqb, nramp, order), total = nx * nb * nh, stride = gridDim.x;
    int L = blockIdx.x; if (L >= total) return;
    SwaItem it = swa_decode(L, nb, nh, nhkv, nqb, nx, nramp, order); int pass = 0;
    BlockRef<bf16, bf16> cur = mk_ref(it, 0, Q, K, V, O, FB);
    Seam<bf16> S;
    causal_swa_prime<bf16, bf16>(cur, W, lds, S);
    for (;;) {
        const bool more_pass = pass == 0 && it.qb1 != it.qb0, more_item = L + stride < total, last = !more_pass && !more_item;
        SwaItem itn = it; int passn = pass + 1, Ln = L;
        if (!more_pass) { passn = 0; Ln = more_item ? L + stride : L; itn = swa_decode(Ln, nb, nh, nhkv, nqb, nx, nramp, order); }
        const BlockRef<bf16, bf16> nxt = last ? cur : mk_ref(itn, passn, Q, K, V, O, FB);
        causal_swa_block<bf16, bf16>(cur, nxt, 8192, W, lds, S);
        if (last) break;
        cur = nxt; it = itn; pass = passn; L = Ln;
    }
}
}
constexpr size_t WS_WIN = 0, WS_WRO = 50331648, WS_WGU0 = 67108864, WS_WGU1 = 113246208, WS_WDN0 = 159383552, WS_WDN1 = 182452224,
                 WS_WO = 205520896, WS_WKVF = 213909504  , WS_COS = 227540992, WS_SIN = 231735296, WS_FB = 235929600, WS_FS = WS_FB + 2097152, WS_SSQ = WS_FS + 540672  , WS_BAR = WS_SSQ + 396288  ,
                 WS_BIG = 239075328;
constexpr size_t SZ_ROWS2K = (size_t)TALL * DM * 2;
constexpr size_t BIG_XN = 0, BIG_ACT = SZ_ROWS2K, BIG_HKV = BIG_ACT + (size_t)TALL * DFF * 2, BIG_KB = BIG_HKV + SZ_ROWS2K, BIG_VB = BIG_KB + (size_t)TP * 512 * 2,
                 BIG_KALL = BIG_VB + (size_t)TP * 512 * 2, BIG_VALL = BIG_KALL + (size_t)8 * LKS * 512 * 2, BIG_END = BIG_VALL + (size_t)8 * LKS * 512 * 2;
static_assert(BIG_END <= (size_t)TALL * NPROJ * 2, "layer-1 buffers fit in the PROJ region");
constexpr size_t WS_END = WS_BIG + (size_t)TALL * NPROJ * 2;
static_assert(WS_END <= (size_t)1073741824, "workspace fits 1 GiB");
constexpr size_t OUT_Y = 0, OUT_SP = 67633152, OUT_KP = 71827456, OUT_VP = 88604672, OUT_LFP = 105381888, OUT_SS = 105906176, OUT_KS = 114294784, OUT_VS = 114425856, OUT_LFS = 114556928;
constexpr int NWAVES = 8, LDS_BYTES = 149504;

struct Params { const float* in[21]; float* out; unsigned char* ws; };

__device__ __forceinline__ float wave_sum(float v) {
#pragma unroll
    for (int o = 1; o < 64; o <<= 1) v += __shfl_xor(v, o);
    return v;
}
__device__ __forceinline__ float bf2f(unsigned short b) { return __uint_as_float(((unsigned)b) << 16); }
__device__ __forceinline__ unsigned pk2(float lo, float hi) { return pg8::cvt_pk_bf16(lo, hi); }

__device__ __forceinline__ void transpose_item(const float* W, int K, int N, bf16_t* WT, int k0, int n0, int drow0, LAS float* scr, int lane, const float* gain = nullptr) {
    float wv[32];
#pragma unroll
    for (int i = 0; i < 32; ++i) { const int kk = 2 * i + (lane >> 5); wv[i] = W[(size_t)(k0 + kk) * N + n0 + (lane & 31)] * (gain ? gain[k0 + kk] : 1.f); }
#pragma unroll
    for (int i = 0; i < 32; ++i) { const int kk = 2 * i + (lane >> 5); scr[kk * 33 + (lane & 31)] = wv[i]; }
    asm volatile("s_waitcnt lgkmcnt(0)" ::: "memory");
    const int c = lane & 7;
#pragma unroll
    for (int j = 0; j < 4; ++j) { const int n = (lane >> 3) + 8 * j; const LAS float* s = scr + (8 * c) * 33 + n;
        u32x4 o; o.x = pk2(s[0 * 33], s[1 * 33]); o.y = pk2(s[2 * 33], s[3 * 33]); o.z = pk2(s[4 * 33], s[5 * 33]); o.w = pk2(s[6 * 33], s[7 * 33]);
        *(u32x4*)(WT + (size_t)(drow0 + n) * K + k0 + 8 * c) = o; }
    asm volatile("s_waitcnt lgkmcnt(0)" ::: "memory");
}
__device__ __forceinline__ void tr_plain(const float* W, int K, int N, bf16_t* WT, int row_off, LAS float* scr, int item, int lane, const float* gain = nullptr) {
    const int nblk = N / 32, kb = item / nblk, nb = item % nblk; transpose_item(W, K, N, WT, 64 * kb, 32 * nb, row_off + 32 * nb, scr, lane, gain);
}
__device__ __forceinline__ void tr_gu(const float* W, bf16_t* WT, int up, LAS float* scr, int item, int lane, const float* gain) {
    const int nblk = DFF / 32, kb = item / nblk, nb = item % nblk, n0 = 32 * nb; transpose_item(W, DM, DFF, WT, 64 * kb, n0, (n0 >> 7) * 256 + up * 128 + (n0 & 127), scr, lane, gain);
}
template <int MODE  >
__device__ __forceinline__ void rms_row(const float* xrow, const float* g1, bf16_t* o1, const float* g2, bf16_t* o2, float* of, int lane) {
    const f32x4* xr = (const f32x4*)xrow + lane;
    f32x4 v[8]; float s = 0.f;
#pragma unroll
    for (int j = 0; j < 8; ++j) { v[j] = xr[64 * j]; s += (v[j].x * v[j].x + v[j].y * v[j].y) + (v[j].z * v[j].z + v[j].w * v[j].w); }
    const float rs = 1.0f / sqrtf(wave_sum(s) * (1.f / DM) + 1e-6f);
#pragma unroll
    for (int j = 0; j < 8; ++j) { const f32x4 ga = ((const f32x4*)g1)[64 * j + lane]; const f32x4 y = v[j] * rs;
        if (MODE == 2) { ((f32x4*)of)[64 * j + lane] = y * ga; }
        else { u32x2 w; w.x = pk2(y.x * ga.x, y.y * ga.y); w.y = pk2(y.z * ga.z, y.w * ga.w); ((u32x2*)o1)[64 * j + lane] = w;
            if (MODE == 1) { const f32x4 gb = ((const f32x4*)g2)[64 * j + lane]; u32x2 w2; w2.x = pk2(y.x * gb.x, y.y * gb.y); w2.y = pk2(y.z * gb.z, y.w * gb.w); ((u32x2*)o2)[64 * j + lane] = w2; } } }
}

namespace ret {
constexpr int KOFF = 0, STOFF = 32768, VOFF = 65536, POFF = 74752, VS = 144;
typedef short v4i16_t __attribute__((ext_vector_type(4)));
__device__ __forceinline__ bf16x8 frag_rm(const LAS char* base, int stride, int i0, int k0, int fr, int fq) { return *(const LAS bf16x8*)(base + (i0 + fr) * stride + (k0 + 8 * fq) * 2); }
__device__ __forceinline__ bf16x8 frag_sw(const LAS char* base, int i0, int k0, int fr, int fq) { return *(const LAS bf16x8*)(base + (i0 + fr) * 512 + ((((k0 >> 3) + fq) ^ fr) << 4)); }
__device__ __forceinline__ s16x4 tr4(const LAS char* p) { return __builtin_bit_cast(s16x4, __builtin_amdgcn_ds_read_tr16_b64_v4i16((LAS v4i16_t*)p)); }
__device__ __forceinline__ bf16x8 frag_tr(const LAS char* base, int stride, int k0, int i0, int fr, int fq) {
    const LAS char* p = base + (k0 + 8 * fq + (fr >> 2)) * stride + (i0 + 4 * (fr & 3)) * 2;
    const s16x4 a = tr4(p), b = tr4(p + 4 * stride);
    return (bf16x8){a[0], a[1], a[2], a[3], b[0], b[1], b[2], b[3]};
}
__device__ __forceinline__ bf16x8 frag_tr_sw(const LAS char* base, int k0, int i0, int fr, int fq) {
    const int m = k0 + 8 * fq + (fr >> 2), d = i0 + 4 * (fr & 3);
    const s16x4 a = tr4(base + m * 512 + ((((d >> 3) ^ (m & 15))) << 4) + (d & 7) * 2), b = tr4(base + (m + 4) * 512 + ((((d >> 3) ^ ((m + 4) & 15))) << 4) + (d & 7) * 2);
    return (bf16x8){a[0], a[1], a[2], a[3], b[0], b[1], b[2], b[3]};
}
#define RET_BAR() do { asm volatile("s_waitcnt lgkmcnt(0)" ::: "memory"); __builtin_amdgcn_s_barrier(); asm volatile("" ::: "memory"); } while (0)
#define MFMA16(X, Y, C) __builtin_amdgcn_mfma_f32_16x16x32_bf16(X, Y, C, 0, 0, 0)
__device__ __forceinline__ void ret_item(LAS char* lds, const bf16_t* proj, size_t hr0  , bf16_t* oh  , int nchunks, int c, int h, int es, const float* S0, float* Sout) {
    const int tid = opaque_tid(), wid = __builtin_amdgcn_readfirstlane(tid >> 6), lane = tid & 63, fr = lane & 15, fq = lane >> 4, lt = wid >> 1, half = wid & 1;
    const float lg2 = __log2f(1.0f - exp2f(-5.0f - (float)h)), gam = exp2f(lg2), gc1 = exp2f(lg2 * (float)(c - 1));
    f32x4 accT[8];
    const int eT = 16 * lt + fr;
#pragma unroll
    for (int i = 0; i < 8; ++i) { const int d0 = 16 * (8 * half + i) + 4 * fq;
#pragma unroll
        for (int r = 0; r < 4; ++r) accT[i][r] = S0 ? S0[(size_t)(d0 + r) * 512 + es * 64 + eT] : 0.f;
        u32x2 w; w.x = pk2(accT[i][0], accT[i][1]); w.y = pk2(accT[i][2], accT[i][3]); *(LAS u32x2*)(lds + STOFF + eT * 512 + (((d0 >> 3) ^ fr) << 4) + (d0 & 7) * 2) = w; }
    u32x4 rk[4], rv; bf16x8 yq[8];
    const bf16_t* gq = proj + PJ_Q + (hr0 + eT) * 256 + 8 * fq; const bf16_t* gk = proj + PJ_K + hr0 * 256; const bf16_t* gv = proj + PJ_V + hr0 * 512 + es * 64; bf16_t* pout = oh + hr0 * 512 + es * 64;
    const bool qok = eT < c;
#define RET_LOADQ(n) do { _Pragma("unroll") for (int ks = 0; ks < 8; ++ks) yq[ks] = qok ? *(const bf16x8*)(gq + (size_t)(n) * 64 * 256 + 32 * ks) : (bf16x8){0, 0, 0, 0, 0, 0, 0, 0}; } while (0)
#define RET_LOAD(n) do { _Pragma("unroll") for (int i = 0; i < 4; ++i) { const int p = tid + 512 * i, row = p >> 5, ch = p & 31; \
            if (row < c) rk[i] = *(const u32x4*)(gk + (size_t)((n) * 64 + row) * 256 + ch * 8); else rk[i] = (u32x4){0u, 0u, 0u, 0u}; } \
        { const int row = tid >> 3, ch = tid & 7; if (row < c) rv = *(const u32x4*)(gv + (size_t)((n) * 64 + row) * 512 + ch * 8); else rv = (u32x4){0u, 0u, 0u, 0u}; } } while (0)
    RET_LOAD(0); RET_LOADQ(0);
    for (int n = 0; n < nchunks; ++n) {
#pragma unroll
        for (int i = 0; i < 4; ++i) { const int p = tid + 512 * i, row = p >> 5, ch = p & 31; *(LAS u32x4*)(lds + KOFF + row * 512 + ((ch ^ (row & 15)) << 4)) = rk[i]; }
        *(LAS u32x4*)(lds + VOFF + (tid >> 3) * VS + (tid & 7) * 16) = rv;
        if (n + 1 < nchunks) RET_LOAD(n + 1);
        RET_BAR();
        f32x4 accS[2], accC[2];
#pragma unroll
        for (int j = 0; j < 2; ++j) { accS[j] = (f32x4){0.f, 0.f, 0.f, 0.f}; accC[j] = (f32x4){0.f, 0.f, 0.f, 0.f}; }
#pragma unroll
        for (int kb = 0; kb < 8; kb += 2) {
            bf16x8 xk[2][2], xs[2][2];
#pragma unroll
            for (int ks = 0; ks < 2; ++ks)
#pragma unroll
                for (int j = 0; j < 2; ++j) { xk[ks][j] = frag_sw(lds + KOFF, 16 * (2 * half + j), 32 * (kb + ks), fr, fq); xs[ks][j] = frag_sw(lds + STOFF, 16 * (2 * half + j), 32 * (kb + ks), fr, fq); }
            __builtin_amdgcn_sched_barrier(0);
#pragma unroll
            for (int ks = 0; ks < 2; ++ks)
#pragma unroll
                for (int j = 0; j < 2; ++j) { accS[j] = MFMA16(xk[ks][j], yq[kb + ks], accS[j]); accC[j] = MFMA16(xs[ks][j], yq[kb + ks], accC[j]); }
            __builtin_amdgcn_sched_barrier(0);
        }
        if (n + 1 < nchunks) RET_LOADQ(n + 1);
        const int lrow = eT;
#pragma unroll
        for (int j = 0; j < 2; ++j) { const int m0 = 16 * (2 * half + j) + 4 * fq; f32x4 sv = accS[j];
#pragma unroll
            for (int r = 0; r < 4; ++r) sv[r] = (m0 + r <= lrow) ? sv[r] : 0.f;
            u32x2 w; w.x = pk2(sv[0], sv[1]); w.y = pk2(sv[2], sv[3]); *(LAS u32x2*)(lds + POFF + lrow * VS + m0 * 2) = w; }
        RET_BAR();
        f32x4 accO[2];
#pragma unroll
        for (int j = 0; j < 2; ++j) accO[j] = accC[j] * gam;
#pragma unroll
        for (int ks = 0; ks < 2; ++ks) { const int k0 = 32 * ks;
            const bf16x8 yp = frag_rm(lds + POFF, VS, 16 * lt, k0, fr, fq);
#pragma unroll
            for (int j = 0; j < 2; ++j) { const bf16x8 xv = frag_tr(lds + VOFF, VS, k0, 16 * (2 * half + j), fr, fq); accO[j] = MFMA16(xv, yp, accO[j]); } }
        if (lrow < c) {
#pragma unroll
            for (int j = 0; j < 2; ++j) { u32x2 w; w.x = pk2(accO[j][0], accO[j][1]); w.y = pk2(accO[j][2], accO[j][3]);
                *(u32x2*)(pout + (size_t)(n * 64 + lrow) * 512 + 16 * (2 * half + j) + 4 * fq) = w; } }
#pragma unroll
        for (int i = 0; i < 8; ++i) accT[i] = accT[i] * gam;
#pragma unroll
        for (int ks = 0; ks < 2; ++ks) {
            bf16x8 xk[8]; const bf16x8 yv = frag_tr(lds + VOFF, VS, 32 * ks, 16 * lt, fr, fq);
#pragma unroll
            for (int i = 0; i < 8; ++i) xk[i] = frag_tr_sw(lds + KOFF, 32 * ks, 16 * (8 * half + i), fr, fq);
            __builtin_amdgcn_sched_barrier(0);
#pragma unroll
            for (int i = 0; i < 8; ++i) accT[i] = MFMA16(xk[i], yv, accT[i]);
            __builtin_amdgcn_sched_barrier(0);
        }
#pragma unroll
        for (int i = 0; i < 8; ++i) { accT[i] = accT[i] * gc1; const int d0 = 16 * (8 * half + i) + 4 * fq;
            u32x2 w; w.x = pk2(accT[i][0], accT[i][1]); w.y = pk2(accT[i][2], accT[i][3]); *(LAS u32x2*)(lds + STOFF + eT * 512 + (((d0 >> 3) ^ fr) << 4) + (d0 & 7) * 2) = w; }
        RET_BAR();
    }
#undef RET_LOAD
#undef RET_LOADQ
#pragma unroll
    for (int i = 0; i < 8; ++i) { const int d0 = 16 * (8 * half + i) + 4 * fq;
#pragma unroll
        for (int r = 0; r < 4; ++r) Sout[(size_t)(d0 + r) * 512 + es * 64 + eT] = accT[i][r]; }
}
}
__device__ __forceinline__ void sample_attn(LAS char* lds, const bf16_t* QBp, const bf16_t* KALL, const bf16_t* VALL, const float* FS, bf16_t* AO) {
    const int tid = opaque_tid(), wid = __builtin_amdgcn_readfirstlane(tid >> 6), lane = tid & 63;
    LAS float* qf = (LAS float*)(lds + wid * 5120); LAS float* pf = qf + 128;
    const int gw = blockIdx.x * NWAVES + wid, NGW = gridDim.x * NWAVES;
    for (int item = gw; item < 8 * 16 * 32; item += NGW) {
        const int b = item >> 9, h = (item >> 5) & 15, qi = item & 31, kvh = h >> 2, qpos = PASTL + qi, row = TP + b * 32 + qi;
        const bf16_t* q = QBp + (size_t)row * DM + h * 128;
        qf[lane] = bf2f(q[lane]); qf[lane + 64] = bf2f(q[lane + 64]);
        asm volatile("s_waitcnt lgkmcnt(0)" ::: "memory");
        const float* F = FS + (size_t)(b * 16 + h) * LKS; const float Fq = F[qpos];
        const bf16_t* Kb = KALL + (size_t)b * LKS * 512 + kvh * 128; const bf16_t* Vb = VALL + (size_t)b * LKS * 512 + kvh * 128;
        float mx = -1e30f;
#pragma unroll 1
        for (int t = 0; t < 17; ++t) { const int j = lane + 64 * t; float s = -__builtin_inff();
            if (j <= qpos) { const u32x4* kr = (const u32x4*)(Kb + (size_t)j * 512); float a = 0.f; u32x4 kvv[16];
#pragma unroll
                for (int c8 = 0; c8 < 16; ++c8) kvv[c8] = kr[c8];
#pragma unroll
                for (int c8 = 0; c8 < 16; ++c8) { const u32x4 kv = kvv[c8]; const LAS f32x4* qq = (const LAS f32x4*)(qf + 8 * c8); const f32x4 q0 = qq[0], q1 = qq[1];
                    a += __uint_as_float(kv.x << 16) * q0.x + __uint_as_float(kv.x & 0xffff0000u) * q0.y + __uint_as_float(kv.y << 16) * q0.z + __uint_as_float(kv.y & 0xffff0000u) * q0.w
                       + __uint_as_float(kv.z << 16) * q1.x + __uint_as_float(kv.z & 0xffff0000u) * q1.y + __uint_as_float(kv.w << 16) * q1.z + __uint_as_float(kv.w & 0xffff0000u) * q1.w; }
                s = a * 0.08838834764831845f + (Fq - F[j]); }
            pf[j] = s; mx = fmaxf(mx, s); }
#pragma unroll
        for (int o = 1; o < 64; o <<= 1) mx = fmaxf(mx, __shfl_xor(mx, o));
        float sum = 0.f;
#pragma unroll 1
        for (int t = 0; t < 17; ++t) { const float p = __expf(pf[lane + 64 * t] - mx); sum += p; pf[lane + 64 * t] = p; }
        sum = wave_sum(sum);
        asm volatile("s_waitcnt lgkmcnt(0)" ::: "memory");
        float oa[8];
#pragma unroll
        for (int e = 0; e < 8; ++e) oa[e] = 0.f;
        const int kg = lane >> 4, dg = lane & 15;
        for (int j = 0; j < PASTL + 32; j += 32) {
            u32x4 vv[8]; float p[8];
#pragma unroll
            for (int u = 0; u < 8; ++u) { vv[u] = *(const u32x4*)(Vb + (size_t)(j + 4 * u + kg) * 512 + 8 * dg); p[u] = pf[j + 4 * u + kg]; }
#pragma unroll
            for (int u = 0; u < 8; ++u) { const unsigned w4[4] = {vv[u].x, vv[u].y, vv[u].z, vv[u].w};
#pragma unroll
                for (int e = 0; e < 4; ++e) { oa[2 * e] += p[u] * __uint_as_float(w4[e] << 16); oa[2 * e + 1] += p[u] * __uint_as_float(w4[e] & 0xffff0000u); } } }
#pragma unroll
        for (int e = 0; e < 8; ++e) { oa[e] += __shfl_xor(oa[e], 16); oa[e] += __shfl_xor(oa[e], 32); }
        const float inv = 1.0f / sum;
        if (kg == 0) { u32x4 w; w.x = pk2(oa[0] * inv, oa[1] * inv); w.y = pk2(oa[2] * inv, oa[3] * inv); w.z = pk2(oa[4] * inv, oa[5] * inv); w.w = pk2(oa[6] * inv, oa[7] * inv);
            *(u32x4*)(AO + (size_t)row * DM + h * 128 + 8 * dg) = w; }
        asm volatile("s_waitcnt lgkmcnt(0)" ::: "memory");
    }
}

#define XB_TMO      128
#define XB_XCNT(j)  (256  + 64 * (j))
#define XB_XSUB(j)  (1280 + 64 * (j))
#define XB_XGEN(j)  (2304 + 64 * (j))
#define XB_TOP      3328
#define XB_TOPGEN   3392
#define XCD_BAR_WORDS 3456
#define XB_SPIN_CAP (1u << 18)

__device__ __forceinline__ unsigned xb_ld(unsigned* p)              { return __hip_atomic_load(p, __ATOMIC_RELAXED, __HIP_MEMORY_SCOPE_AGENT); }
__device__ __forceinline__ unsigned xb_add(unsigned* p, unsigned v) { return __hip_atomic_fetch_add(p, v, __ATOMIC_RELAXED, __HIP_MEMORY_SCOPE_AGENT); }
__device__ __forceinline__ unsigned xb_xcc_id() { return (unsigned)__builtin_amdgcn_s_getreg((3 << 11) | 20) & 0xFu; }
#define XB_SPIN(cond, bar) do { unsigned _sp = 0; while (cond) { __builtin_amdgcn_s_sleep(1); \
    if ((++_sp & 255u) == 0u) { if (xb_ld(&(bar)[XB_TMO])) break; if (_sp > XB_SPIN_CAP) { atomicAdd(&(bar)[XB_TMO], 1u); break; } } } } while (0)

struct XcdBarrier {
    unsigned* bar; unsigned x;
    volatile LAS unsigned* st;
};

__device__ __forceinline__ XcdBarrier xcd_barrier_post(unsigned* bar, volatile LAS unsigned* st) {
    XcdBarrier b; b.bar = bar; b.x = xb_xcc_id(); b.st = st;
    if (threadIdx.x == 0) (void)xb_add(&bar[XB_XCNT(b.x)], 1u);
    return b;
}
__device__ __forceinline__ void xcd_barrier_complete(unsigned* bar, unsigned x, unsigned& nloc, unsigned& nx) {
    const unsigned G = gridDim.x * gridDim.y * gridDim.z;
    unsigned sum, cnt, mine, sp = 0u;
    for (;;) {
        sum = 0u; cnt = 0u; mine = 0u;
#pragma unroll
        for (unsigned j = 0; j < 16; ++j) { const unsigned c = xb_ld(&bar[XB_XCNT(j)]); sum += c; cnt += (c > 0u) ? 1u : 0u; mine = (j == x) ? c : mine; }
        if (sum == G) break;
        __builtin_amdgcn_s_sleep(1);
        if ((++sp & 255u) == 0u) { if (xb_ld(&bar[XB_TMO])) break; if (sp > XB_SPIN_CAP) { atomicAdd(&bar[XB_TMO], 1u); break; } }
    }
    nloc = mine > 0u ? mine : 1u; nx = cnt > 0u ? cnt : 1u;
}

__device__ __forceinline__ void xcd_barrier(const XcdBarrier& b) {
    asm volatile("s_waitcnt vmcnt(0)" ::: "memory");
    __syncthreads();
    if (threadIdx.x == 0) {
        unsigned* bar = b.bar;
        __builtin_amdgcn_s_waitcnt(0);
        unsigned nloc = b.st[0], nx = b.st[1];
        if (nloc == 0u) { xcd_barrier_complete(bar, b.x, nloc, nx); b.st[0] = nloc; b.st[1] = nx; }
        const unsigned old = xb_add(&bar[XB_XSUB(b.x)], 1u);
        const unsigned gen = old / nloc;
        if (old + 1u == (gen + 1u) * nloc) {
            __builtin_amdgcn_fence(__ATOMIC_RELEASE, "agent");
            asm volatile("s_waitcnt vmcnt(0)" ::: "memory");
            const unsigned og = xb_add(&bar[XB_TOP], 1u);
            const unsigned tg = og / nx;
            if (og + 1u == (tg + 1u) * nx) xb_add(&bar[XB_TOPGEN], 1u);
            else XB_SPIN(xb_ld(&bar[XB_TOPGEN]) == tg, bar);
            __builtin_amdgcn_fence(__ATOMIC_ACQUIRE, "agent");
            xb_add(&bar[XB_XGEN(b.x)], 1u);
            asm volatile("s_waitcnt vmcnt(0)" ::: "memory");
        } else {
            XB_SPIN(xb_ld(&bar[XB_XGEN(b.x)]) == gen, bar);
            __builtin_amdgcn_fence(__ATOMIC_ACQUIRE, "agent");
            asm volatile("s_waitcnt vmcnt(0)" ::: "memory");
        }
    }
    __syncthreads();
}

#define KARG(i) ((unsigned char*)(__attribute__((address_space(1))) unsigned char*)(((const volatile __attribute__((address_space(4))) unsigned long long*)__builtin_amdgcn_kernarg_segment_ptr())[i]))
#define INF(i) ((const float*)KARG(i))
#define OUTP ((float*)KARG(21))
#define WSP (KARG(22))
#define BIGP (KARG(22) + WS_BIG)
#define PH_IDS const int tid = opaque_tid(), lane = tid & 63, wave = __builtin_amdgcn_readfirstlane(tid >> 6); const int G = gridDim.x, gw = blockIdx.x * NWAVES + wave, NGW = G * NWAVES; const size_t gt = (size_t)blockIdx.x * 512 + tid, NGT = (size_t)G * 512; (void)lane; (void)gw; (void)NGW; (void)gt; (void)NGT

__device__ __forceinline__ void ph_prologue(LAS unsigned char* lds) {
    PH_IDS; unsigned char* ws = WSP;
    bf16_t* WIN = (bf16_t*)(ws + WS_WIN); bf16_t* WKVF = (bf16_t*)(ws + WS_WKVF);
    LAS float* scr = (LAS float*)(lds + wave * 16384);
    constexpr int I0 = 32 * 384;
    for (int it = gw; it < I0; it += NGW) tr_plain(INF(10), DM, NPROJ, WIN, 0, scr, it, lane);
    { const float* wf = INF(14); const float* nkv = INF(8);
      for (size_t i = gt; i < (size_t)256 * DM; i += NGT) { const int r = (int)(i >> 11), k = (int)(i & 2047); WKVF[(size_t)(1024 + r) * DM + k] = r < 16 ? (bf16_t)(pk2(wf[k * 16 + r] * nkv[k], 0.f) & 0xffffu) : (bf16_t)0; }
      float* ssq = (float*)(ws + WS_SSQ); for (size_t i = gt; i < (size_t)3 * TALL; i += NGT) ssq[i] = 0.f; }
    { float* COS = (float*)(ws + WS_COS); float* SIN = (float*)(ws + WS_SIN);
      for (size_t i = gt; i < (size_t)SEQ * 128; i += NGT) { const int pos = (int)(i >> 7), d = (int)(i & 127);
        const float inv = exp2f(-(float)d * (13.287712379549449f / 128.f));
        const double rev = (double)pos * (double)inv * 0.15915494309189535; const float fr = (float)(rev - __builtin_floor(rev));
        COS[i] = __builtin_amdgcn_cosf(fr); SIN[i] = __builtin_amdgcn_sinf(fr); } }
    { const float* x_p = INF(0); const float* x_s = INF(1); const float* nm = INF(6); bf16_t* XN0 = (bf16_t*)OUTP;
      for (int m = gw; m < TALL; m += NGW) rms_row<0>(m < TP ? x_p + (size_t)m * DM : x_s + (size_t)(m - TP) * DM, nm, XN0 + (size_t)m * DM, nullptr, nullptr, nullptr, lane); }
}
template <int JOB> __device__ __forceinline__ void ph_conv(LAS unsigned char* lds) {
    const int tid = opaque_tid(), lane = tid & 63, wave = __builtin_amdgcn_readfirstlane(tid >> 6);
    const int G = gridDim.x, first = G > 160 ? (JOB == 1 ? 48 : JOB == 3 ? 141 : 44) : 0;
    if ((int)blockIdx.x < first) return;
    const int gw = ((int)blockIdx.x - first) * NWAVES + wave, NGW = (G - first) * NWAVES;
    unsigned char* ws = WSP; LAS float* scr = (LAS float*)(lds + wave * 16384);
    constexpr int IG = 32 * 176, ID = 88 * 64, IQ = 32 * 64, IK = 32 * 16;
    if (JOB == 1) {
        bf16_t* WRO = (bf16_t*)(ws + WS_WRO); bf16_t* WGU0 = (bf16_t*)(ws + WS_WGU0);
        for (int it = gw; it < 64 * 64 + 2 * IG; it += NGW) { int r = it;
            if (r < 64 * 64) { tr_plain(INF(11), 4096, DM, WRO, 0, scr, r, lane); continue; } r -= 64 * 64;
            if (r < IG) { tr_gu(INF(18), WGU0, 0, scr, r, lane, INF(7)); continue; } r -= IG;
            tr_gu(INF(19), WGU0, 1, scr, r, lane, INF(7)); }
    } else if (JOB == 2) {
        bf16_t* WDN0 = (bf16_t*)(ws + WS_WDN0); bf16_t* WGU1 = (bf16_t*)(ws + WS_WGU1); bf16_t* WO = (bf16_t*)(ws + WS_WO); bf16_t* WKVF = (bf16_t*)(ws + WS_WKVF);
        for (int it = gw; it < ID + 2 * IQ + 2 * IK + IG; it += NGW) { int r = it;
            if (r < ID) { tr_plain(INF(20), DFF, DM, WDN0, 0, scr, r, lane); continue; } r -= ID;
            if (r < IQ) { tr_plain(INF(16), DM, DM, WKVF, 1280, scr, r, lane, INF(6) + DM); continue; } r -= IQ;
            if (r < IK) { tr_plain(INF(12), DM, 512, WKVF, 0, scr, r, lane, INF(8)); continue; } r -= IK;
            if (r < IK) { tr_plain(INF(13), DM, 512, WKVF, 512, scr, r, lane, INF(8)); continue; } r -= IK;
            if (r < IQ) { tr_plain(INF(17), DM, DM, WO, 0, scr, r, lane); continue; } r -= IQ;
            tr_gu(INF(18) + (size_t)DM * DFF, WGU1, 0, scr, r, lane, INF(7) + DM); }
    } else if (JOB == 3) {
        bf16_t* WGU1 = (bf16_t*)(ws + WS_WGU1);
        for (int it = gw; it < IG; it += NGW) tr_gu(INF(19) + (size_t)DM * DFF, WGU1, 1, scr, it, lane, INF(7) + DM);
    } else {
        bf16_t* WDN1 = (bf16_t*)(ws + WS_WDN1);
        for (int it = gw; it < ID; it += NGW) tr_plain(INF(20) + (size_t)DFF * DM, DFF, DM, WDN1, 0, scr, it, lane);
    }
}
__device__ __forceinline__ void ph_retin(LAS unsigned char* lds) {
    unsigned char* ws = WSP;
    pg8::Gemm g{(const bf16_t*)OUTP, (const bf16_t*)(ws + WS_WIN), TALL, NPROJ, DM, DM}; pg8::StaticOrder S; S.init(TALL, NPROJ, (int)gridDim.x, (int)blockIdx.x);
    pg8::EpiRetIn E{(bf16_t*)(ws + WS_BIG), (const float*)(ws + WS_COS), (const float*)(ws + WS_SIN)};
    pg8::gemm_phase<pg8::EpiRetIn, pg8::StaticOrder, true, true>(lds, g, S, E);
}
__device__ __forceinline__ void ph_retention(LAS unsigned char* lds) {
    const int G = gridDim.x;
    for (int it = blockIdx.x; it < 256; it += G) { const int bh = (it & 7) * 4 + (it >> 6), es = (it >> 3) & 7, b = bh >> 3, h = bh & 7;
        ret::ret_item((LAS char*)lds, (const bf16_t*)BIGP, (size_t)(b * 8 + h) * SEQ, (bf16_t*)OUTP, 128, 64, h, es, nullptr, OUTP + OUT_SP + (size_t)(b * 8 + h) * 256 * 512); }
    for (int it = blockIdx.x; it < 512; it += G) { const int bh = (it & 7) * 8 + (it >> 6), es = (it >> 3) & 7, b = bh >> 3, h = bh & 7;
        ret::ret_item((LAS char*)lds, (const bf16_t*)BIGP, (size_t)262144 + (size_t)(b * 8 + h) * 32, (bf16_t*)OUTP, 1, 32, h, es, INF(2) + (size_t)(b * 8 + h) * 256 * 512, OUTP + OUT_SS + (size_t)(b * 8 + h) * 256 * 512); }
}
__device__ __forceinline__ void ph_groupnorm() {
    PH_IDS; bf16_t* PROJ = (bf16_t*)BIGP; const bf16_t* OB = (const bf16_t*)OUTP;
    for (int it0 = gw * 4; it0 < TALL * 8; it0 += NGW * 4) {
        u32x4 ovv[4], gvv[4];
#pragma unroll
        for (int q = 0; q < 4; ++q) { const int it = it0 + q, row = it >> 3, h = it & 7;
            ovv[q] = *(const u32x4*)(OB + hrow(row, h) * 512 + lane * 8); gvv[q] = *(const u32x4*)(PROJ + PJ_G + (size_t)row * 4096 + h * 512 + lane * 8); }
#pragma unroll
        for (int q = 0; q < 4; ++q) { const int it = it0 + q, row = it >> 3, h = it & 7; const u32x4 ov = ovv[q], gv = gvv[q];
            bf16_t* op = PROJ + PJ_G + (size_t)row * 4096 + h * 512 + lane * 8;
            float o[8], g[8]; const unsigned ow[4] = {ov.x, ov.y, ov.z, ov.w}, gwd[4] = {gv.x, gv.y, gv.z, gv.w};
#pragma unroll
            for (int j = 0; j < 4; ++j) { o[2 * j] = __uint_as_float(ow[j] << 16); o[2 * j + 1] = __uint_as_float(ow[j] & 0xffff0000u); g[2 * j] = __uint_as_float(gwd[j] << 16); g[2 * j + 1] = __uint_as_float(gwd[j] & 0xffff0000u); }
            float s = 0.f;
#pragma unroll
            for (int j = 0; j < 8; ++j) s += o[j];
            const float mu = wave_sum(s) * (1.f / 512.f); float qq = 0.f;
#pragma unroll
            for (int j = 0; j < 8; ++j) { o[j] -= mu; qq += o[j] * o[j]; }
            const float rstd = 1.0f / sqrtf(wave_sum(qq) * (1.f / 512.f) + 1e-5f);
#pragma unroll
            for (int j = 0; j < 8; ++j) o[j] = o[j] * rstd * pg8::silu_f(g[j]);
            u32x4 w; w.x = pk2(o[0], o[1]); w.y = pk2(o[2], o[3]); w.z = pk2(o[4], o[5]); w.w = pk2(o[6], o[7]); *(u32x4*)op = w; } }
}
template <bool FIRST, int MROWS = TALL> __device__ __forceinline__ void ph_res_gemm(LAS unsigned char* lds, unsigned char* a_ptr, size_t w_off, int K, int lda, bf16_t* hb, int ssq_idx) {
    unsigned char* ws = WSP; float* Hres = OUTP + OUT_Y;
    pg8::Gemm g{(const bf16_t*)a_ptr, (const bf16_t*)(ws + w_off), MROWS, DM, K, lda}; pg8::StaticOrder S; S.init(MROWS, DM, (int)gridDim.x, (int)blockIdx.x);
    pg8::EpiRes E{FIRST ? INF(0) : Hres, FIRST ? INF(1) : Hres + (size_t)TP * DM, Hres, hb, ssq_idx >= 0 ? (float*)(ws + WS_SSQ) + (size_t)ssq_idx * TALL : nullptr};
    pg8::gemm_phase<pg8::EpiRes, pg8::StaticOrder, true, true>(lds, g, S, E);
}
template <bool FIRST = false> __device__ __forceinline__ void ph_sample_res(const unsigned char* a_ptr, int lda, size_t w_off, int K, bf16_t* hb, int ssq_idx) {
    const int tid = opaque_tid(), lane = tid & 63, wave = __builtin_amdgcn_readfirstlane(tid >> 6), fr = lane & 15, fq = lane >> 4;
    unsigned char* ws = WSP; float* Hs = OUTP + OUT_Y + (size_t)TP * DM;
    const bf16_t* A = (const bf16_t*)a_ptr; const bf16_t* Wt = (const bf16_t*)(ws + w_off);
    float* ssq = ssq_idx >= 0 ? (float*)(ws + WS_SSQ) + (size_t)ssq_idx * TALL + TP : nullptr;
    for (int it = blockIdx.x; it < 256; it += gridDim.x) {
        const int n0 = (it >> 1) * 16, row = (it & 1) * 128 + 16 * wave + fr;
        const bf16_t* bp = Wt + (size_t)(n0 + fr) * K + 8 * fq; const bf16_t* ap = A + (size_t)row * lda + 8 * fq;
        f32x4 acc = {0.f, 0.f, 0.f, 0.f};
        bf16x8 bA[8], aA[8], bB[8], aB[8];
#define SR_LOAD(B_, A_, kk) do { _Pragma("unroll") for (int s_ = 0; s_ < 8; ++s_) { B_[s_] = *(const bf16x8*)(bp + (kk) + 32 * s_); A_[s_] = *(const bf16x8*)(ap + (kk) + 32 * s_); } } while (0)
#define SR_MMA(B_, A_) do { _Pragma("unroll") for (int s_ = 0; s_ < 8; ++s_) acc = __builtin_amdgcn_mfma_f32_16x16x32_bf16(B_[s_], A_[s_], acc, 0, 0, 0); } while (0)
        SR_LOAD(bA, aA, 0);
        for (int k0 = 0; k0 < K; k0 += 512) {
            SR_LOAD(bB, aB, k0 + 256);
            SR_MMA(bA, aA);
            if (k0 + 512 < K) SR_LOAD(bA, aA, k0 + 512);
            SR_MMA(bB, aB);
        }
#undef SR_LOAD
#undef SR_MMA
        float* o = Hs + (size_t)row * DM + n0 + 4 * fq;
        const f32x4 v = (FIRST ? *(const f32x4*)(INF(1) + (size_t)row * DM + n0 + 4 * fq) : *(const f32x4*)o) + acc; *(f32x4*)o = v;
        if (hb) { u32x2 w; w.x = pk2(v[0], v[1]); w.y = pk2(v[2], v[3]); *(u32x2*)(hb + (size_t)(TP + row) * DM + n0 + 4 * fq) = w; }
        if (ssq) { float ss = (v[0] * v[0] + v[1] * v[1]) + (v[2] * v[2] + v[3] * v[3]); ss += __shfl_xor(ss, 16); ss += __shfl_xor(ss, 32);
            if (fq == 0) (void)__hip_atomic_fetch_add(ssq + row, ss, __ATOMIC_RELAXED, __HIP_MEMORY_SCOPE_AGENT); }
    }
}
template <int MODE> __device__ __forceinline__ void ph_rms(const float* g1, size_t o1_off, const float* g2, size_t o2_off) {
    PH_IDS; float* Hres = OUTP + OUT_Y; unsigned char* ws = WSP;
    for (int m = gw; m < TALL; m += NGW) rms_row<MODE>(Hres + (size_t)m * DM, g1, (bf16_t*)(ws + o1_off) + (size_t)m * DM, g2, (bf16_t*)(ws + o2_off) + (size_t)m * DM, Hres + (size_t)m * DM, lane);
}
__device__ __forceinline__ void ph_cache_cvt() {
    PH_IDS; const float* cache_k = INF(3); const float* cache_v = INF(4); bf16_t* KALL = (bf16_t*)(BIGP + BIG_KALL); bf16_t* VALL = (bf16_t*)(BIGP + BIG_VALL);
    for (size_t i = gt; i < (size_t)8 * PASTL * 512 / 4; i += NGT) { const size_t e = i * 4, b = e / ((size_t)PASTL * 512), r = e % ((size_t)PASTL * 512);
        const f32x4 kv = *(const f32x4*)(cache_k + e), vv = *(const f32x4*)(cache_v + e); u32x2 w; w.x = pk2(kv.x, kv.y); w.y = pk2(kv.z, kv.w); *(u32x2*)(KALL + b * LKS * 512 + r) = w;
        w.x = pk2(vv.x, vv.y); w.y = pk2(vv.z, vv.w); *(u32x2*)(VALL + b * LKS * 512 + r) = w; }
}
__device__ __forceinline__ void ph_kvfq(LAS unsigned char* lds) {
    unsigned char* ws = WSP; unsigned char* big = ws + WS_BIG; float* out = OUTP;
    pg8::Gemm g{(const bf16_t*)(big + BIG_XN), (const bf16_t*)(ws + WS_WKVF), TALL, 3328, DM, DM}; pg8::StaticOrder S; S.init(TALL, 3328, (int)gridDim.x, (int)blockIdx.x);
    pg8::EpiKVFQ E{out + OUT_KP, out + OUT_VP, out + OUT_LFP, out + OUT_KS, out + OUT_VS, out + OUT_LFS, (bf16_t*)(big + BIG_KB), (bf16_t*)(big + BIG_VB), (bf16_t*)(big + BIG_KALL), (bf16_t*)(big + BIG_VALL),
                    (bf16_t*)(big + BIG_ACT), INF(15), (const float*)(ws + WS_SSQ) + (size_t)1 * TALL};
    pg8::gemm_phase<pg8::EpiKVFQ, pg8::StaticOrder, true, true>(lds, g, S, E);
}
__device__ __forceinline__ void ph_cumsum(LAS unsigned char* lds) {
    PH_IDS; const float* cache_lf = INF(5); const float* out = OUTP; float* FB = (float*)(WSP + WS_FB); float* FS = (float*)(WSP + WS_FS);
    for (int it = blockIdx.x; it < 64 + 128; it += G) {
        LAS float* wtot = (LAS float*)lds;
        const bool smp = it >= 64; const int bh = smp ? it - 64 : it, b = bh >> 4, h = bh & 15, Ls = smp ? LKS : SEQ, per = smp ? 3 : 16, j0 = tid * per;
        float v[16]; float s = 0.f;
#pragma unroll
        for (int i = 0; i < 16; ++i) { const int j = j0 + i; float x = 0.f;
            if (i < per && j < Ls) x = smp ? (j < PASTL ? cache_lf[((size_t)b * PASTL + j) * 16 + h] : out[OUT_LFS + ((size_t)b * 32 + (j - PASTL)) * 16 + h]) : out[OUT_LFP + ((size_t)b * SEQ + j) * 16 + h];
            s += x; v[i] = s; }
        float inc = s;
#pragma unroll
        for (int o = 1; o < 64; o <<= 1) { const float t = __shfl_up(inc, o); if (lane >= o) inc += t; }
        if (lane == 63) wtot[wave] = inc;
        __syncthreads();
        float base = inc - s;
        for (int w = 0; w < wave; ++w) base += wtot[w];
#pragma unroll
        for (int i = 0; i < 16; ++i) { const int j = j0 + i; if (i < per && j < Ls) { const float F = base + v[i];
            if (smp) FS[(size_t)bh * LKS + j] = F; else FB[(size_t)bh * SEQ + j] = -F * 11.313708498984761f; } }
        __syncthreads();
    }
}
__device__ __forceinline__ void ph_attn(unsigned char* lds_raw) {
    unsigned char* ws = WSP; unsigned char* big = ws + WS_BIG;
    fox::attn_phase((char*)lds_raw, (const bf16_t*)(big + BIG_ACT), (const bf16_t*)(big + BIG_KB), (const bf16_t*)(big + BIG_VB), (bf16_t*)(big + BIG_XN), (const float*)(ws + WS_FB));
}
__device__ __forceinline__ void ph_sattn(LAS unsigned char* lds) {
    unsigned char* ws = WSP; unsigned char* big = ws + WS_BIG;
    sample_attn((LAS char*)lds, (const bf16_t*)(big + BIG_ACT), (const bf16_t*)(big + BIG_KALL), (const bf16_t*)(big + BIG_VALL), (const float*)(ws + WS_FS), (bf16_t*)(big + BIG_XN));
}
__device__ __forceinline__ void ph_gateup(LAS unsigned char* lds, const unsigned char* a_ptr, size_t w_off, int ssq_idx) {
    unsigned char* ws = WSP; unsigned char* big = ws + WS_BIG;
    pg8::Gemm g{(const bf16_t*)a_ptr, (const bf16_t*)(ws + w_off), TALL, 2 * DFF, DM, DM}; pg8::StaticOrder S; S.init(TALL, 2 * DFF, (int)gridDim.x, (int)blockIdx.x);
    pg8::EpiSwiglu E{(bf16_t*)(big + BIG_ACT), (const float*)(ws + WS_SSQ) + (size_t)ssq_idx * TALL};
    pg8::gemm_phase<pg8::EpiSwiglu, pg8::StaticOrder, true, true>(lds, g, S, E);
}

__global__ void __launch_bounds__(NWAVES * 64, 2) yoco_fwd(Params P) {
    extern __shared__ __attribute__((aligned(16))) unsigned char lds_raw[];
    cg::grid_group grid = cg::this_grid();
    LAS unsigned char* lds = (LAS unsigned char*)lds_raw;
    volatile LAS unsigned* bst = (volatile LAS unsigned*)(lds + 148480);
    if (opaque_tid() < 2) bst[opaque_tid()] = 0u;
    __syncthreads();
    const XcdBarrier xbar = xcd_barrier_post((unsigned*)(WSP + WS_BAR), bst);
#define GSYNC() xcd_barrier(xbar)
    ph_prologue(lds);                                                                                   grid.sync();
    ph_retin(lds); ph_conv<1>(lds);                                                                                      GSYNC();
    ph_retention(lds);                                                                                  GSYNC();
    ph_groupnorm();                                                                                     GSYNC();
    ph_res_gemm<true, TP>(lds, BIGP + PJ_G * 2, WS_WRO, 4096, 4096, (bf16_t*)(OUTP + OUT_KP), 0); ph_sample_res<true>(BIGP + (PJ_G + (size_t)TP * 4096) * 2, 4096, WS_WRO, 4096, (bf16_t*)(OUTP + OUT_KP), 0);   GSYNC();
    ph_gateup(lds, (const unsigned char*)(OUTP + OUT_KP), WS_WGU0, 0); ph_conv<2>(lds);                                  GSYNC();
    ph_res_gemm<false, TP>(lds, BIGP + BIG_ACT, WS_WDN0, DFF, DFF, (bf16_t*)(BIGP + BIG_XN), 1); ph_sample_res(BIGP + BIG_ACT + (size_t)TP * DFF * 2, DFF, WS_WDN0, DFF, (bf16_t*)(BIGP + BIG_XN), 1); ph_cache_cvt();   GSYNC();
    ph_kvfq(lds); ph_conv<3>(lds);                                                                                       GSYNC();
    ph_cumsum(lds);                                                                                     GSYNC();
    ph_attn(lds_raw); __syncthreads(); ph_sattn(lds);                                                   GSYNC();
    ph_res_gemm<false, TP>(lds, BIGP + BIG_XN, WS_WO, DM, DM, (bf16_t*)(BIGP + BIG_HKV), 2); ph_sample_res(BIGP + BIG_XN + (size_t)TP * DM * 2, DM, WS_WO, DM, (bf16_t*)(BIGP + BIG_HKV), 2);   GSYNC();
    ph_gateup(lds, BIGP + BIG_HKV, WS_WGU1, 2); ph_conv<4>(lds);                                                         GSYNC();
    ph_res_gemm<false, TP>(lds, BIGP + BIG_ACT, WS_WDN1, DFF, DFF, nullptr, -1); ph_sample_res(BIGP + BIG_ACT + (size_t)TP * DFF * 2, DFF, WS_WDN1, DFF, nullptr, -1);   GSYNC();
    ph_rms<2>(INF(9), 0, nullptr, 0);
}

extern "C" void kernel_launch(void* const* d_in, const int* in_sizes, int n_in, void* d_out, int out_size, void* d_ws, size_t ws_size, hipStream_t stream) {
    static int grid = 0;
    if (grid == 0) {
        if (n_in != 21 || ws_size < WS_END) { fprintf(stderr, "kernel_launch: unexpected n_in %d / ws_size %zu (need %zu)\n", n_in, ws_size, (size_t)WS_END); grid = -1; return; }
        int dev = 0, cus = 0, per_cu = 0;
        (void)hipGetDevice(&dev); (void)hipDeviceGetAttribute(&cus, hipDeviceAttributeMultiprocessorCount, dev);
        if (hipFuncSetAttribute((const void*)yoco_fwd, hipFuncAttributeMaxDynamicSharedMemorySize, LDS_BYTES) != hipSuccess) { fprintf(stderr, "kernel_launch: hipFuncSetAttribute failed\n"); grid = -1; return; }
        if (hipOccupancyMaxActiveBlocksPerMultiprocessor(&per_cu, (const void*)yoco_fwd, NWAVES * 64, LDS_BYTES) != hipSuccess || per_cu < 1) { fprintf(stderr, "kernel_launch: occupancy query says %d\n", per_cu); per_cu = 1; }
        (void)hipGetLastError();
        grid = cus > 0 ? cus : 256;
    }
    if (grid < 0) return;
    if (hipMemsetAsync((char*)d_ws + WS_BAR, 0, XCD_BAR_WORDS * 4, stream) != hipSuccess) { fprintf(stderr, "kernel_launch: memset of the barrier words failed\n"); return; }
    Params p{};
    for (int i = 0; i < 21; ++i) p.in[i] = (const float*)d_in[i];
    p.out = (float*)d_out; p.ws = (unsigned char*)d_ws;
    void* args[] = {&p};
    hipError_t e = hipLaunchCooperativeKernel((const void*)yoco_fwd, dim3(grid), dim3(NWAVES * 64), args, LDS_BYTES, stream);
    if (e != hipSuccess) fprintf(stderr, "cooperative launch failed: %s (grid %d)\n", hipGetErrorString(e), grid);
}
```

```cpp
#include <hip/hip_runtime.h>
#include <hip/hip_cooperative_groups.h>
#include <cstdio>
#include <cstdint>
namespace cg = cooperative_groups;
__device__ __forceinline__ int opaque_tid() { int t = threadIdx.x; asm volatile("" : "+v"(t)); return t; }
namespace pg8 {
#define PG8_LAS __attribute__((address_space(3)))
typedef unsigned short bf16_t;
typedef short bf16x8 __attribute__((ext_vector_type(8)));
typedef float f32x4 __attribute__((ext_vector_type(4)));
typedef unsigned u32x4 __attribute__((ext_vector_type(4)));
constexpr int BM = 256, BK = 64, HALF = 128, HTB = HALF * BK * 2  , STAGE_BYTES = 8 * HTB, NXCD = 8, WGM = 4;

__host__ __device__ __forceinline__ int lds_byte(int r, int c) { const int st = (r >> 4) * 2 + (c >> 5), rr = r & 15, cc = c & 31, ob = rr * 64 + cc * 2; return st * 1024 + (ob ^ (((ob >> 9) & 1) << 5)); }
__host__ __device__ __forceinline__ void stage_rc(int b, int& R, int& C) { const int st = b / 1024, sb = b % 1024, swz = sb ^ (((sb >> 9) & 1) << 5); R = (st >> 1) * 16 + swz / 64; C = (st & 1) * 32 + (swz % 64) / 2; }
__host__ __device__ __forceinline__ int perm32(int rho) { const int n = rho >> 4, i = rho & 15; return 8 * (i >> 2) + 4 * n + (i & 3); }

struct Unit { int pm, pn; };
struct Gemm { const bf16_t* A; const bf16_t* Bt; int M, N, K, lda; };

struct StaticOrder {
    int nM, nN, nwg, G, c;
    __host__ __device__ void init(int M, int N, int G_, int c_) { nM = M / BM; nN = N / BM; nwg = nM * nN; G = G_; c = c_; }
    __host__ __device__ bool next(int i, Unit& u) const {
        const long L = (long)i * G + c; if (L >= nwg) return false;
        int wgid = (int)L; { const int q = nwg / NXCD, r = nwg % NXCD, xcd = wgid % NXCD, off = wgid / NXCD; wgid = (xcd < r ? xcd * (q + 1) : r * (q + 1) + (xcd - r) * q) + off; }
        const int nig = WGM * nN, gid = wgid / nig, fm = gid * WGM, gsz = (nM - fm) < WGM ? (nM - fm) : WGM;
        u.pm = fm + ((wgid % nig) % gsz); u.pn = (wgid % nig) / gsz; return true;
    }
    __device__ __forceinline__ void a_ready(const Unit&) const {}
    __device__ __forceinline__ void done(const Unit&) const {}
};

__device__ __forceinline__ unsigned cvt_pk_bf16(float lo, float hi) { unsigned r; asm volatile("v_cvt_pk_bf16_f32 %0, %1, %2" : "=v"(r) : "v"(lo), "v"(hi)); return r; }
template <class Epi, class Sched, bool ALIGN_EPI = false, bool SP2 = false>
__device__ __forceinline__ void gemm_phase(PG8_LAS unsigned char* lds, const Gemm g, const Sched& S, const Epi& E) {
    const int tid = opaque_tid(), wid = __builtin_amdgcn_readfirstlane(tid >> 6), lane = tid & 63, wr = wid >> 2, wc = wid & 3, fr = lane & 15, fq = lane >> 4;
    const int K = g.K, nt = K / BK;
    unsigned voffA[2], voffB[2];
#pragma unroll
    for (int i = 0; i < 2; ++i) { int R, C; stage_rc(tid * 16 + i * 8192, R, C); const int Rb = Epi::PERM ? ((R & ~31) + perm32(R & 31)) : R;
        voffA[i] = (unsigned)(R * g.lda + C) * 2u; voffB[i] = (unsigned)(Rb * K + C) * 2u; }
    const size_t kstep = (size_t)(BK * 2);
    const size_t hstep = (size_t)HALF * K * 2, hstepA = (size_t)HALF * g.lda * 2;
    const size_t tstep = 2 * hstep, tstepA = 2 * hstepA;
    const unsigned ldsw = (unsigned)wid * 1024u;
    const int aoff = lds_byte(wr * 64 + fr, fq * 8), boff = lds_byte(wc * 32 + fr, fq * 8);
#define PG8_SA(b, h) (((b) * 2 + (h)) * HTB)
#define PG8_SB(b, h) ((4 + (b) * 2 + (h)) * HTB)
#define PG8_STAGE(bufoff, gbase, voff) do { _Pragma("unroll") for (int _i = 0; _i < 2; ++_i) \
        __builtin_amdgcn_global_load_lds((const unsigned*)((const char*)(gbase) + (voff)[_i]), (PG8_LAS unsigned*)(lds + (bufoff) + ldsw + _i * 8192), 16, 0, 0); } while (0)
#define PG8_LDA(dst, b, h) do { _Pragma("unroll") for (int m = 0; m < 4; ++m) _Pragma("unroll") for (int k = 0; k < 2; ++k) dst[m][k] = *(const PG8_LAS bf16x8*)(lds + PG8_SA(b, h) + aoff + m * 2048 + k * 1024); } while (0)
#define PG8_LDB(dst, b, h) do { _Pragma("unroll") for (int n = 0; n < 2; ++n) _Pragma("unroll") for (int k = 0; k < 2; ++k) dst[n][k] = *(const PG8_LAS bf16x8*)(lds + PG8_SB(b, h) + boff + n * 2048 + k * 1024); } while (0)
#define PG8_MMA(ai, bj, At, Bt) do { __builtin_amdgcn_s_setprio(1); _Pragma("unroll") for (int m = 0; m < 4; ++m) _Pragma("unroll") for (int n = 0; n < 2; ++n) _Pragma("unroll") for (int k = 0; k < 2; ++k) \
        acc[ai][bj][m][n] = __builtin_amdgcn_mfma_f32_16x16x32_bf16(Bt[n][k], At[m][k], acc[ai][bj][m][n], 0, 0, 0); __builtin_amdgcn_s_setprio(0); } while (0)
#define PG8_WAIT_V(n) asm volatile("s_waitcnt vmcnt(" #n ")" ::: "memory")
#define PG8_WAIT_L(n) asm volatile("s_waitcnt lgkmcnt(" #n ")" ::: "memory")
#define PG8_BAR __builtin_amdgcn_s_barrier()
#define PG8_SCHED __builtin_amdgcn_sched_barrier(0)
    Unit cur, nxt; int ui = 0;
    if (!S.next(0, cur)) return;
    f32x4 acc[2][2][4][2];
#pragma unroll
    for (int a = 0; a < 2; ++a)
#pragma unroll
        for (int b = 0; b < 2; ++b)
#pragma unroll
            for (int m = 0; m < 4; ++m)
#pragma unroll
                for (int n = 0; n < 2; ++n) acc[a][b][m][n] = (f32x4){0.f, 0.f, 0.f, 0.f};
    bf16x8 At[4][2], B0[2][2], B1[2][2];
    const char* cA = (const char*)g.A + (size_t)cur.pm * tstepA; const char* cB = (const char*)g.Bt + (size_t)cur.pn * tstep;
    S.a_ready(cur);
    if constexpr (SP2) {
        PG8_STAGE(PG8_SB(0, 0), cB, voffB); PG8_STAGE(PG8_SB(0, 1), cB + hstep, voffB); PG8_STAGE(PG8_SA(0, 0), cA, voffA); PG8_STAGE(PG8_SA(0, 1), cA + hstepA, voffA);
        if (wr == 1) PG8_BAR;
        PG8_WAIT_V(2); PG8_BAR;
        PG8_STAGE(PG8_SB(1, 0), cB + kstep, voffB); PG8_STAGE(PG8_SA(1, 0), cA + kstep, voffA); PG8_STAGE(PG8_SB(1, 1), cB + hstep + kstep, voffB);
        PG8_WAIT_V(6); PG8_BAR;
    } else {
        PG8_STAGE(PG8_SB(0, 0), cB, voffB); PG8_STAGE(PG8_SA(0, 0), cA, voffA); PG8_STAGE(PG8_SB(0, 1), cB + hstep, voffB); PG8_STAGE(PG8_SA(0, 1), cA + hstepA, voffA);
        if (wr == 1) PG8_BAR;
        PG8_WAIT_V(4); PG8_BAR;
        PG8_STAGE(PG8_SB(1, 0), cB + kstep, voffB); PG8_STAGE(PG8_SA(1, 0), cA + kstep, voffA); PG8_STAGE(PG8_SB(1, 1), cB + hstep + kstep, voffB);
        PG8_WAIT_V(6); PG8_BAR;
    }
    for (;;) {
        const bool has_next = S.next(ui + 1, nxt);
        const char* nA = has_next ? (const char*)g.A + (size_t)nxt.pm * tstepA : cA; const char* nB = has_next ? (const char*)g.Bt + (size_t)nxt.pn * tstep : cB;
        for (int t = 0; t < nt; t += 2) {
            const bool last = (t == nt - 2);
            const char* a1 = cA + (size_t)(t + 1) * kstep;
            const char* a2 = last ? nA : cA + (size_t)(t + 2) * kstep; const char* b2 = last ? nB : cB + (size_t)(t + 2) * kstep;
            const char* a3 = a2 + kstep; const char* b3 = b2 + kstep;
            if (last && has_next) S.a_ready(nxt);
            if constexpr (SP2) {
            PG8_LDB(B0, 0, 0); PG8_LDB(B1, 0, 1); PG8_SCHED; PG8_LDA(At, 0, 0); PG8_STAGE(PG8_SA(1, 1), a1 + hstepA, voffA);
            PG8_WAIT_V(8); PG8_WAIT_L(0); PG8_BAR; PG8_MMA(0, 0, At, B0); PG8_MMA(0, 1, At, B1); PG8_BAR; PG8_SCHED;
            PG8_LDA(At, 0, 1); PG8_STAGE(PG8_SB(0, 0), b2, voffB); PG8_STAGE(PG8_SB(0, 1), b2 + hstep, voffB); PG8_STAGE(PG8_SA(0, 0), a2, voffA);
            PG8_WAIT_V(8); PG8_WAIT_L(0); PG8_BAR; PG8_MMA(1, 0, At, B0); PG8_MMA(1, 1, At, B1); PG8_BAR; PG8_SCHED;
            PG8_LDB(B0, 1, 0); PG8_LDB(B1, 1, 1); PG8_SCHED; PG8_LDA(At, 1, 0); PG8_STAGE(PG8_SA(0, 1), a2 + hstepA, voffA);
            PG8_WAIT_V(8); PG8_WAIT_L(0); PG8_BAR; PG8_MMA(0, 0, At, B0); PG8_MMA(0, 1, At, B1); PG8_BAR; PG8_SCHED;
            PG8_LDA(At, 1, 1); PG8_STAGE(PG8_SB(1, 0), b3, voffB); PG8_STAGE(PG8_SB(1, 1), b3 + hstep, voffB); PG8_STAGE(PG8_SA(1, 0), a3, voffA);
            PG8_WAIT_V(8); PG8_WAIT_L(0); PG8_BAR; PG8_MMA(1, 0, At, B0); PG8_MMA(1, 1, At, B1); PG8_BAR; PG8_SCHED;
            } else {
            PG8_LDB(B0, 0, 0); PG8_SCHED; PG8_LDA(At, 0, 0); PG8_STAGE(PG8_SA(1, 1), a1 + hstepA, voffA);
            PG8_WAIT_L(8); PG8_BAR; PG8_WAIT_L(0); PG8_MMA(0, 0, At, B0); PG8_BAR; PG8_SCHED;
            PG8_LDB(B1, 0, 1); PG8_STAGE(PG8_SB(0, 0), b2, voffB);
            PG8_BAR; PG8_WAIT_L(0); PG8_MMA(0, 1, At, B1); PG8_BAR;
            PG8_LDA(At, 0, 1); PG8_STAGE(PG8_SA(0, 0), a2, voffA);
            PG8_BAR; PG8_WAIT_L(0); PG8_MMA(1, 0, At, B0); PG8_BAR; PG8_SCHED;
            PG8_STAGE(PG8_SB(0, 1), b2 + hstep, voffB);
            PG8_WAIT_V(6); PG8_BAR; PG8_MMA(1, 1, At, B1); PG8_BAR;
            PG8_LDB(B0, 1, 0); PG8_SCHED; PG8_LDA(At, 1, 0); PG8_STAGE(PG8_SA(0, 1), a2 + hstepA, voffA);
            PG8_WAIT_L(8); PG8_BAR; PG8_WAIT_L(0); PG8_MMA(0, 0, At, B0); PG8_BAR; PG8_SCHED;
            PG8_LDB(B1, 1, 1); PG8_STAGE(PG8_SB(1, 0), b3, voffB);
            PG8_BAR; PG8_WAIT_L(0); PG8_MMA(0, 1, At, B1); PG8_BAR;
            PG8_LDA(At, 1, 1); PG8_STAGE(PG8_SA(1, 0), a3, voffA);
            PG8_BAR; PG8_WAIT_L(0); PG8_MMA(1, 0, At, B0); PG8_BAR; PG8_SCHED;
            PG8_STAGE(PG8_SB(1, 1), b3 + hstep, voffB);
            PG8_WAIT_V(6); PG8_BAR; PG8_MMA(1, 1, At, B1); PG8_BAR;
            }
        }
        if constexpr (ALIGN_EPI) { if (wr == 0) PG8_BAR; }
        if constexpr (!Epi::AFTER_DRAIN) { E(acc, cur, wr, wc, fr, fq); S.done(cur); }
        if (!has_next) break;
#pragma unroll
        for (int a = 0; a < 2; ++a)
#pragma unroll
            for (int b = 0; b < 2; ++b)
#pragma unroll
                for (int m = 0; m < 4; ++m)
#pragma unroll
                    for (int n = 0; n < 2; ++n) acc[a][b][m][n] = (f32x4){0.f, 0.f, 0.f, 0.f};
        cur = nxt; cA = nA; cB = nB; ++ui;
        if constexpr (ALIGN_EPI) { if (wr == 1) PG8_BAR; }
    }
    PG8_WAIT_V(0);
    if constexpr (!ALIGN_EPI) { if (wr == 0) PG8_BAR; }
    PG8_BAR;
    if constexpr (Epi::AFTER_DRAIN) { E.fused(acc, cur, wr, wc, fr, fq, lds, wid, lane); S.done(cur); }
#undef PG8_SA
#undef PG8_SB
#undef PG8_STAGE
#undef PG8_LDA
#undef PG8_LDB
#undef PG8_MMA
#undef PG8_WAIT_V
#undef PG8_WAIT_L
#undef PG8_BAR
#undef PG8_SCHED
}
}
constexpr int DM = 2048, TP = 32768, TSMP = 256, TALL = 33024, SEQ = 8192, NPROJ = 12288, DFF = 5632, PASTL = 1024, LKS = 1056;
constexpr size_t PJ_Q = 0, PJ_K = (size_t)TALL * 2048, PJ_V = (size_t)TALL * 4096, PJ_G = (size_t)TALL * 8192;
__device__ __forceinline__ size_t hrow(int row, int h) { return row < TP ? ((size_t)((row >> 13) * 8 + h) << 13) + (row & 8191) : (size_t)262144 + (size_t)((((row - TP) >> 5) * 8 + h) << 5) + ((row - TP) & 31); }
#define GAS __attribute__((address_space(1)))
#define LAS __attribute__((address_space(3)))
typedef unsigned short bf16_t;
typedef float f32x4 __attribute__((ext_vector_type(4)));
typedef unsigned u32x4 __attribute__((ext_vector_type(4)));
typedef unsigned u32x2 __attribute__((ext_vector_type(2)));
typedef short bf16x8 __attribute__((ext_vector_type(8)));
typedef short s16x4 __attribute__((ext_vector_type(4)));

namespace pg8 {
__device__ __forceinline__ float silu_f(float g) { return g * __builtin_amdgcn_rcpf(1.0f + __builtin_amdgcn_exp2f(-1.4426950408889634f * g)); }
struct EpiBf16P {
    static constexpr bool PERM = true, AFTER_DRAIN = false;
    bf16_t* O; int ldc;
    __device__ __forceinline__ void operator()(const f32x4 (&acc)[2][2][4][2], const Unit& u, int wr, int wc, int fr, int fq) const {
        const int row0 = u.pm * BM + wr * 64 + fr, col0 = u.pn * BM + wc * 32 + 8 * fq;
#pragma unroll
        for (int ai = 0; ai < 2; ++ai)
#pragma unroll
            for (int m = 0; m < 4; ++m) { bf16_t* rowp = O + (size_t)(row0 + ai * HALF + m * 16) * ldc + col0;
#pragma unroll
                for (int bj = 0; bj < 2; ++bj) { const f32x4 v0 = acc[ai][bj][m][0], v1 = acc[ai][bj][m][1];
                    u32x4 w; w.x = cvt_pk_bf16(v0[0], v0[1]); w.y = cvt_pk_bf16(v0[2], v0[3]); w.z = cvt_pk_bf16(v1[0], v1[1]); w.w = cvt_pk_bf16(v1[2], v1[3]);
                    *(u32x4*)(rowp + bj * HALF) = w; } }
    }
};
struct EpiRetIn {
    static constexpr bool PERM = true, AFTER_DRAIN = false;
    bf16_t* O; const float* cosT; const float* sinT;
    __device__ __forceinline__ void operator()(const f32x4 (&acc)[2][2][4][2], const Unit& u, int wr, int wc, int fr, int fq) const {
        const int row0 = u.pm * BM + wr * 64 + fr, cl = wc * 32 + 8 * fq;
        if (u.pn < 16) {
            const bool isk = u.pn >= 8; const int h = u.pn & 7;
            const float lg2 = __log2f(1.0f - exp2f(-5.0f - (float)h));
#pragma unroll
            for (int ai = 0; ai < 2; ++ai) {
                f32x4 cs[4][4]; float scv[4];
#pragma unroll
                for (int m = 0; m < 4; ++m) {
                    const int row = row0 + ai * HALF + m * 16; int pos, l;
                    if (row < TP) { pos = row & (SEQ - 1); l = row & 63; } else { const int s = (row - TP) & 31; pos = PASTL + s; l = s; }
                    scv[m] = isk ? exp2f(-lg2 * (float)l) * 0.0625f : exp2f(lg2 * (float)l);
                    const float* cp = cosT + (size_t)pos * 128 + cl; const float* sp = sinT + (size_t)pos * 128 + cl;
                    cs[m][0] = *(const f32x4*)cp; cs[m][1] = *(const f32x4*)(cp + 4); cs[m][2] = *(const f32x4*)sp; cs[m][3] = *(const f32x4*)(sp + 4); }
#pragma unroll
                for (int m = 0; m < 4; ++m) {
                    const int row = row0 + ai * HALF + m * 16; const float sc = scv[m];
                    const f32x4 c0 = cs[m][0], c1 = cs[m][1], s0 = cs[m][2], s1 = cs[m][3];
                    const f32x4 x1a = acc[ai][0][m][0], x1b = acc[ai][0][m][1], x2a = acc[ai][1][m][0], x2b = acc[ai][1][m][1];
                    const f32x4 o1a = (x1a * c0 - x2a * s0) * sc, o1b = (x1b * c1 - x2b * s1) * sc, o2a = (x1a * s0 + x2a * c0) * sc, o2b = (x1b * s1 + x2b * c1) * sc;
                    bf16_t* rowp = O + (isk ? PJ_K : PJ_Q) + hrow(row, h) * 256 + cl;
                    u32x4 w; w.x = cvt_pk_bf16(o1a[0], o1a[1]); w.y = cvt_pk_bf16(o1a[2], o1a[3]); w.z = cvt_pk_bf16(o1b[0], o1b[1]); w.w = cvt_pk_bf16(o1b[2], o1b[3]);
                    *(u32x4*)rowp = w;
                    w.x = cvt_pk_bf16(o2a[0], o2a[1]); w.y = cvt_pk_bf16(o2a[2], o2a[3]); w.z = cvt_pk_bf16(o2b[0], o2b[1]); w.w = cvt_pk_bf16(o2b[2], o2b[3]);
                    *(u32x4*)(rowp + HALF) = w; }
                asm volatile("" ::: "memory"); }
        } else {
            const bool isv = u.pn < 32; const int hv = (u.pn - 16) >> 1, e0 = ((u.pn - 16) & 1) * 256 + cl;
#pragma unroll
            for (int ai = 0; ai < 2; ++ai)
#pragma unroll
                for (int m = 0; m < 4; ++m) { const int row = row0 + ai * HALF + m * 16;
                    bf16_t* rowp = isv ? O + PJ_V + hrow(row, hv) * 512 + e0 : O + PJ_G + (size_t)row * 4096 + (u.pn - 32) * BM + cl;
#pragma unroll
                    for (int bj = 0; bj < 2; ++bj) { const f32x4 v0 = acc[ai][bj][m][0], v1 = acc[ai][bj][m][1];
                        u32x4 w; w.x = cvt_pk_bf16(v0[0], v0[1]); w.y = cvt_pk_bf16(v0[2], v0[3]); w.z = cvt_pk_bf16(v1[0], v1[1]); w.w = cvt_pk_bf16(v1[2], v1[3]);
                        *(u32x4*)(rowp + bj * HALF) = w; } }
        }
    }
};
struct EpiRes {
    static constexpr bool PERM = false, AFTER_DRAIN = false;
    const float* baseP; const float* baseS; float* out; bf16_t* hb; float* ssq;
    __device__ __forceinline__ void operator()(const f32x4 (&acc)[2][2][4][2], const Unit& u, int wr, int wc, int fr, int fq) const {
        const int row0 = u.pm * BM + wr * 64 + fr, col0 = u.pn * BM + wc * 32 + 4 * fq;
#pragma unroll
        for (int ai = 0; ai < 2; ++ai) {
            f32x4 bv[4][2][2];
#pragma unroll
            for (int m = 0; m < 4; ++m) { const int row = row0 + ai * HALF + m * 16;
                const float* b = (row < TP ? baseP + (size_t)row * DM : baseS + (size_t)(row - TP) * DM) + col0;
#pragma unroll
                for (int bj = 0; bj < 2; ++bj)
#pragma unroll
                    for (int n = 0; n < 2; ++n) bv[m][bj][n] = *(const f32x4*)(b + bj * HALF + n * 16); }
#pragma unroll
            for (int m = 0; m < 4; ++m) { const int row = row0 + ai * HALF + m * 16; float* o = out + (size_t)row * DM + col0; float ss = 0.f;
#pragma unroll
                for (int bj = 0; bj < 2; ++bj)
#pragma unroll
                    for (int n = 0; n < 2; ++n) { const f32x4 v = bv[m][bj][n] + acc[ai][bj][m][n]; if (out) *(f32x4*)(o + bj * HALF + n * 16) = v;
                        if (hb) { u32x2 w; w.x = cvt_pk_bf16(v[0], v[1]); w.y = cvt_pk_bf16(v[2], v[3]); *(u32x2*)(hb + (size_t)row * DM + col0 + bj * HALF + n * 16) = w; }
                        ss += (v[0] * v[0] + v[1] * v[1]) + (v[2] * v[2] + v[3] * v[3]); }
                if (ssq) { ss += __shfl_xor(ss, 16); ss += __shfl_xor(ss, 32);
                    if (fq == 0) (void)__hip_atomic_fetch_add(ssq + row, ss, __ATOMIC_RELAXED, __HIP_MEMORY_SCOPE_AGENT); } }
            asm volatile("" ::: "memory"); }
    }
};
struct EpiSwiglu {
    static constexpr bool PERM = true, AFTER_DRAIN = false;
    bf16_t* O; const float* ssq;
    __device__ __forceinline__ void operator()(const f32x4 (&acc)[2][2][4][2], const Unit& u, int wr, int wc, int fr, int fq) const {
        const int row0 = u.pm * BM + wr * 64 + fr, col0 = u.pn * HALF + wc * 32 + 8 * fq;
        float rs[2][4];
#pragma unroll
        for (int ai = 0; ai < 2; ++ai)
#pragma unroll
            for (int m = 0; m < 4; ++m) rs[ai][m] = ssq[row0 + ai * HALF + m * 16];
#pragma unroll
        for (int ai = 0; ai < 2; ++ai)
#pragma unroll
            for (int m = 0; m < 4; ++m) { bf16_t* rowp = O + (size_t)(row0 + ai * HALF + m * 16) * DFF + col0; const float r = 1.0f / sqrtf(rs[ai][m] * (1.f / DM) + 1e-6f);
                const f32x4 g0 = acc[ai][0][m][0] * r, g1 = acc[ai][0][m][1] * r, u0 = acc[ai][1][m][0] * r, u1 = acc[ai][1][m][1] * r;
                f32x4 a0, a1;
#pragma unroll
                for (int j = 0; j < 4; ++j) { a0[j] = silu_f(g0[j]) * u0[j]; a1[j] = silu_f(g1[j]) * u1[j]; }
                u32x4 w; w.x = cvt_pk_bf16(a0[0], a0[1]); w.y = cvt_pk_bf16(a0[2], a0[3]); w.z = cvt_pk_bf16(a1[0], a1[1]); w.w = cvt_pk_bf16(a1[2], a1[3]);
                *(u32x4*)rowp = w; }
    }
};
struct EpiKVFQ {
    static constexpr bool PERM = false, AFTER_DRAIN = false;
    float* kP; float* vP; float* lfP; float* kS; float* vS; float* lfS; bf16_t* KB; bf16_t* VB; bf16_t* KALL; bf16_t* VALL; bf16_t* QB; const float* bf; const float* ssq;
    __device__ __forceinline__ void operator()(const f32x4 (&acc)[2][2][4][2], const Unit& u, int wr, int wc, int fr, int fq) const {
        const int row0 = u.pm * BM + wr * 64 + fr;
        float rs[2][4];
#pragma unroll
        for (int ai = 0; ai < 2; ++ai)
#pragma unroll
            for (int m = 0; m < 4; ++m) rs[ai][m] = 1.0f / sqrtf(ssq[row0 + ai * HALF + m * 16] * (1.f / DM) + 1e-6f);
        if (u.pn >= 5) {
            const int col0 = (u.pn - 5) * BM + wc * 32 + 4 * fq;
#pragma unroll
            for (int ai = 0; ai < 2; ++ai)
#pragma unroll
                for (int m = 0; m < 4; ++m) { bf16_t* bo = QB + (size_t)(row0 + ai * HALF + m * 16) * DM + col0;
#pragma unroll
                    for (int bj = 0; bj < 2; ++bj)
#pragma unroll
                        for (int n = 0; n < 2; ++n) { const f32x4 v = acc[ai][bj][m][n] * rs[ai][m]; u32x2 w; w.x = cvt_pk_bf16(v[0], v[1]); w.y = cvt_pk_bf16(v[2], v[3]); *(u32x2*)(bo + bj * HALF + n * 16) = w; } }
        } else if (u.pn < 4) {
            const bool isv = u.pn >= 2; const int col0 = (u.pn & 1) * BM + wc * 32 + 4 * fq;
            float* fP = isv ? vP : kP; float* fS = isv ? vS : kS; bf16_t* bP = isv ? VB : KB; bf16_t* bA = isv ? VALL : KALL;
#pragma unroll
            for (int ai = 0; ai < 2; ++ai)
#pragma unroll
                for (int m = 0; m < 4; ++m) { const int row = row0 + ai * HALF + m * 16; float* fo; bf16_t* bo;
                    if (row < TP) { fo = fP + (size_t)row * 512 + col0; bo = bP + (size_t)row * 512 + col0; }
                    else { const int r2 = row - TP; fo = fS + (size_t)r2 * 512 + col0; bo = bA + ((size_t)(r2 >> 5) * LKS + PASTL + (r2 & 31)) * 512 + col0; }
#pragma unroll
                    for (int bj = 0; bj < 2; ++bj)
#pragma unroll
                        for (int n = 0; n < 2; ++n) { const f32x4 v = acc[ai][bj][m][n] * rs[ai][m]; *(f32x4*)(fo + bj * HALF + n * 16) = v;
                            u32x2 w; w.x = cvt_pk_bf16(v[0], v[1]); w.y = cvt_pk_bf16(v[2], v[3]); *(u32x2*)(bo + bj * HALF + n * 16) = w; } }
        } else if (wc == 0) {
            const f32x4 bb = *(const f32x4*)(bf + 4 * fq);
#pragma unroll
            for (int ai = 0; ai < 2; ++ai)
#pragma unroll
                for (int m = 0; m < 4; ++m) { const int row = row0 + ai * HALF + m * 16; const f32x4 z = acc[ai][0][m][0] * rs[ai][m] + bb; f32x4 r;
#pragma unroll
                    for (int j = 0; j < 4; ++j) r[j] = fminf(z[j], 0.f) - log1pf(__expf(-fabsf(z[j])));
                    float* o = row < TP ? lfP + (size_t)row * 16 : lfS + (size_t)(row - TP) * 16; *(f32x4*)(o + 4 * fq) = r; }
        }
    }
};
}
namespace fox {
enum { ORDER_NATURAL = 0, ORDER_REVERSED = 1, ORDER_PAIRED = 2, ORDER_XCD = 4 };
constexpr int D = 128, QS = 2048, KS = 512, OS = 2048;
constexpr float THR = 8.f;
constexpr bool WSKIP = false;
constexpr float SCALE = 0.08838834764831845f;
constexpr int NW = 8, QBLK = 32, KVBLK = 64, QB = NW * QBLK;
constexpr int SHM_V = KVBLK * D * 2, SHM_K = KVBLK * D * 2;
constexpr int LDS_BYTES = 2 * SHM_V + 2 * SHM_K + NW * 64 * 4 + 2 * 64 * 4;
typedef unsigned short bf16;
typedef short bf16x8 __attribute__((ext_vector_type(8)));
typedef short s16x4 __attribute__((ext_vector_type(4)));
typedef float f32x16 __attribute__((ext_vector_type(16)));
typedef float f32x4 __attribute__((ext_vector_type(4)));
typedef unsigned u32x4 __attribute__((ext_vector_type(4)));
template <class A, class Bt> struct same_t { static constexpr bool v = false; };
template <class A> struct same_t<A, A> { static constexpr bool v = true; };

#define KSWZ(row, colB) ((row) * 256 + ((colB) ^ (((row) & 7) << 4)))
#define SBAR() __builtin_amdgcn_sched_barrier(0)
__device__ __forceinline__ int v_st(int k, int c) { const int kk = (k & ~0xC) | ((k & 4) << 1) | ((k & 8) >> 1); return ((kk >> 3) * 4 + (c >> 5)) * 512 + ((kk & 7) * 32 + (c & 31)) * 2; }
__device__ __forceinline__ int v_rd_base(int lane) { return ((lane & 3) << 3) | (((lane >> 2) & 3) << 6) | (((lane >> 4) & 1) << 5) | (((lane >> 5) & 1) << 8); }
constexpr int v_rd_off(int d0, int ks, int half) { return d0 * 512 + ks * 4096 + half * 2048; }
__device__ __forceinline__ int crow(int r, int hi) { return (r & 3) + 8 * (r >> 2) + 4 * hi; }
__device__ __forceinline__ unsigned cvtpk(float lo, float hi) {
    unsigned r; asm volatile("v_cvt_pk_bf16_f32 %0, %1, %2" : "=v"(r) : "v"(lo), "v"(hi)); return r;
}
__device__ __forceinline__ bf16x8 pack8(f32x4 a, f32x4 b) {
    u32x4 w = {cvtpk(a[0], a[1]), cvtpk(a[2], a[3]), cvtpk(b[0], b[1]), cvtpk(b[2], b[3])};
    return *reinterpret_cast<bf16x8*>(&w);
}
template <class T> __device__ __forceinline__ bf16x8 load8(const T* p) {
    if constexpr (same_t<T, float>::v) { return pack8(*(const f32x4*)p, *(const f32x4*)(p + 4)); }
    else { return *reinterpret_cast<const bf16x8*>(p); }
}
__device__ __forceinline__ void mask_tile(f32x16& p0, f32x16& p1, int dq, unsigned W) {
    const float NEG = -__builtin_inff();
#pragma unroll
    for (int r = 0; r < 16; ++r) {
        const int c = (r & 3) + 8 * (r >> 2);
        if ((unsigned)(dq - c) >= W) p0[r] = NEG;
        if ((unsigned)(dq - c - 32) >= W) p1[r] = NEG;
    }
}
__device__ __forceinline__ void partialSM(f32x16& p0, f32x16& p1, float& m_reg, float& mn, float& alpha) {
    float pmax = p0[0]; for (int r = 1; r < 16; ++r) pmax = fmaxf(pmax, p0[r]); for (int r = 0; r < 16; ++r) pmax = fmaxf(pmax, p1[r]);
    { auto rr = __builtin_amdgcn_permlane32_swap(__float_as_uint(pmax), __float_as_uint(pmax), false, false);
      pmax = fmaxf(__uint_as_float(rr[0]), __uint_as_float(rr[1])); }
    constexpr float C2 = 1.4426950408889634f * SCALE;
    if (__builtin_expect(__all((pmax - m_reg) * SCALE <= THR), 1)) { mn = m_reg; alpha = 1.f; }
    else { mn = fmaxf(m_reg, pmax); alpha = __builtin_amdgcn_exp2f((m_reg - mn) * C2); m_reg = mn; }
    const float mnL = -mn * C2;
    for (int r = 0; r < 16; ++r) p0[r] = fmaf(p0[r], C2, mnL); for (int r = 0; r < 16; ++r) p1[r] = fmaf(p1[r], C2, mnL);
    for (int r = 0; r < 16; ++r) p0[r] = __builtin_amdgcn_exp2f(p0[r]);
}
__device__ __forceinline__ void finishSM(f32x16& p0, f32x16& p1, float alpha, float& l_reg, bf16x8& pa0, bf16x8& pa1, bf16x8& pa2, bf16x8& pa3) {
    for (int r = 0; r < 16; ++r) p1[r] = __builtin_amdgcn_exp2f(p1[r]);
    float ps = 0; for (int r = 0; r < 16; ++r) ps += p0[r]; for (int r = 0; r < 16; ++r) ps += p1[r];
    { auto rr = __builtin_amdgcn_permlane32_swap(__float_as_uint(ps), __float_as_uint(ps), false, false);
      ps = __uint_as_float(rr[0]) + __uint_as_float(rr[1]); }
    l_reg = l_reg * alpha + ps;
#define PK4(P, B_, OUT) do { unsigned a0 = cvtpk(P[B_+0], P[B_+1]), a1 = cvtpk(P[B_+2], P[B_+3]);                          \
        unsigned b0 = cvtpk(P[B_+4], P[B_+5]), b1 = cvtpk(P[B_+6], P[B_+7]);                                             \
        auto r0 = __builtin_amdgcn_permlane32_swap(a0, b0, false, false); auto r1 = __builtin_amdgcn_permlane32_swap(a1, b1, false, false); \
        u32x4 w = {r0[0], r1[0], r0[1], r1[1]}; OUT = *reinterpret_cast<bf16x8*>(&w); } while (0)
    PK4(p0, 0, pa0); PK4(p0, 8, pa1); PK4(p1, 0, pa2); PK4(p1, 8, pa3);
#undef PK4
}
template <int KB, bool SK>
__device__ __forceinline__ void qkt(f32x16& p0, f32x16& p1, const char* K_lds, int r32, int hi, const bf16x8* qr, bool act) {
    if (SK && !act) { const float NEG = -__builtin_inff();
#pragma unroll
        for (int r = 0; r < 16; ++r) { p0[r] = NEG; p1[r] = NEG; } return; }
    { const float* bb_ = (const float*)(K_lds + 2 * SHM_K + NW * 64 * 4) + KB * 64 + 4 * hi;
#pragma unroll
      for (int q_ = 0; q_ < 4; ++q_) { const f32x4 b0_ = *(const f32x4*)(bb_ + 8 * q_), b1_ = *(const f32x4*)(bb_ + 32 + 8 * q_);
#pragma unroll
        for (int i_ = 0; i_ < 4; ++i_) { p0[4 * q_ + i_] = b0_[i_]; p1[4 * q_ + i_] = b1_[i_]; } } }
    const char* kb[4];
#pragma unroll
    for (int dd = 0; dd < 4; ++dd) kb[dd] = K_lds + KB * SHM_K + KSWZ(r32, (dd * 16 + hi * 8) * 2);
#pragma unroll
    for (int d0 = 0; d0 < 8; ++d0) { const char* a = kb[d0 & 3] + (d0 >> 2) * 128;
        bf16x8 b0 = *reinterpret_cast<const bf16x8*>(a);
        bf16x8 b1 = *reinterpret_cast<const bf16x8*>(a + 32 * 256);
        p0 = __builtin_amdgcn_mfma_f32_32x32x16_bf16(b0, qr[d0], p0, 0, 0, 0);
        p1 = __builtin_amdgcn_mfma_f32_32x32x16_bf16(b1, qr[d0], p1, 0, 0, 0); }
}
template <int VB, bool SK>
__device__ __forceinline__ void pv_tile(f32x16* o, int vb0, bf16x8 pa0, bf16x8 pa1, bf16x8 pa2, bf16x8 pa3, bool act) {
    if (SK && !act) return;
#define TRRD(dst, off) asm volatile("ds_read_b64_tr_b16 %0, %1 offset:%2" : "=&v"(dst) : "v"(vb0), "i"(off) : "memory")
#define PV_D0(d0) do { s16x4 l0, l1, l2, l3, h0, h1, h2, h3; constexpr int b_ = VB * SHM_V + v_rd_off(d0, 0, 0);     \
        TRRD(l0, b_); TRRD(h0, b_ + 2048); TRRD(l1, b_ + 4096); TRRD(h1, b_ + 6144); TRRD(l2, b_ + 8192); TRRD(h2, b_ + 10240); TRRD(l3, b_ + 12288); TRRD(h3, b_ + 14336); \
        asm volatile("s_waitcnt lgkmcnt(0)" ::: "memory"); SBAR();                 \
        o[d0] = __builtin_amdgcn_mfma_f32_32x32x16_bf16(pa0, (bf16x8){l0[0], l0[1], l0[2], l0[3], h0[0], h0[1], h0[2], h0[3]}, o[d0], 0, 0, 0);   \
        o[d0] = __builtin_amdgcn_mfma_f32_32x32x16_bf16(pa1, (bf16x8){l1[0], l1[1], l1[2], l1[3], h1[0], h1[1], h1[2], h1[3]}, o[d0], 0, 0, 0);   \
        o[d0] = __builtin_amdgcn_mfma_f32_32x32x16_bf16(pa2, (bf16x8){l2[0], l2[1], l2[2], l2[3], h2[0], h2[1], h2[2], h2[3]}, o[d0], 0, 0, 0);   \
        o[d0] = __builtin_amdgcn_mfma_f32_32x32x16_bf16(pa3, (bf16x8){l3[0], l3[1], l3[2], l3[3], h3[0], h3[1], h3[2], h3[3]}, o[d0], 0, 0, 0); } while (0)
    PV_D0(0); PV_D0(1); PV_D0(2); PV_D0(3);
#undef PV_D0
#undef TRRD
}
template <class TIn, class TOut> struct BlockRef { const TIn* Q; const TIn* K; const TIn* V; TOut* O; const float* FB; int P0; };
template <class TIn> struct Seam {
    bf16x8 qr[8];
    bf16x8 st_v0, st_v1, st_k0, st_k1; float st_f; f32x4 sf0, sf1, sf2, sf3;
    f32x4 tq[16];
};
__device__ __forceinline__ int swa_jlo(int P0, int W) { const int lowk = P0 - W + 1; return lowk > 0 ? lowk / KVBLK : 0; }
#define ROW(p, k0, rr) ((p) + (size_t)((k0) + (rr)) * KS + sc)
#define VMW() asm volatile("s_waitcnt vmcnt(0)" ::: "memory")
#define VMWN(n) asm volatile("s_waitcnt vmcnt(%0)" :: "i"(n) : "memory")
#define SLOAD_H(Kp, Vp, Fp, k0) do { S.st_f = (Fp)[(k0) + (tid & 63)]; S.st_v0 = load8<TIn>(ROW(Vp, k0, sr)); S.st_v1 = load8<TIn>(ROW(Vp, k0, 32 + sr));              \
                         S.st_k0 = load8<TIn>(ROW(Kp, k0, sr)); S.st_k1 = load8<TIn>(ROW(Kp, k0, 32 + sr)); } while (0)
#define SWRITE_HK(bf) do { ((float*)(K_lds + 2 * SHM_K + NW * 64 * 4))[(bf) * 64 + (tid & 63)] = S.st_f; *(bf16x8*)(K_lds + (bf) * SHM_K + kws) = S.st_k0; *(bf16x8*)(K_lds + (bf) * SHM_K + kws + 32 * 256) = S.st_k1; } while (0)
#define SWRITE_HV(bf) do { *(bf16x8*)(V_lds + (bf) * SHM_V + vst0) = S.st_v0; *(bf16x8*)(V_lds + (bf) * SHM_V + vst1) = S.st_v1; } while (0)
#define SWRITE_H(bf) do { SWRITE_HV(bf); SWRITE_HK(bf); } while (0)
#define SLOAD_F(p, k0) do { S.sf0 = *(const f32x4*)ROW(p, k0, sr); S.sf1 = *(const f32x4*)(ROW(p, k0, sr) + 4);                \
                            S.sf2 = *(const f32x4*)ROW(p, k0, 32 + sr); S.sf3 = *(const f32x4*)(ROW(p, k0, 32 + sr) + 4); } while (0)
#define SWRITE_KF(bf) do { *(bf16x8*)(K_lds + (bf) * SHM_K + kws) = pack8(S.sf0, S.sf1); *(bf16x8*)(K_lds + (bf) * SHM_K + kws + 32 * 256) = pack8(S.sf2, S.sf3); } while (0)
#define SWRITE_VF(bf) do { *(bf16x8*)(V_lds + (bf) * SHM_V + vst0) = pack8(S.sf0, S.sf1); *(bf16x8*)(V_lds + (bf) * SHM_V + vst1) = pack8(S.sf2, S.sf3); } while (0)
template <class TIn, class TOut>
__device__ __forceinline__ void causal_swa_prime(const BlockRef<TIn, TOut>& cur, int W, char* lds, Seam<TIn>& S) {
    constexpr bool F32 = same_t<TIn, float>::v;
    const int tid = opaque_tid(), wid = __builtin_amdgcn_readfirstlane(tid >> 6), lane = tid & 63, r32 = lane & 31, hi = lane >> 5;
    const int sr = tid >> 4, sc = (tid & 15) * 8, kws = KSWZ(sr, sc * 2); char* K_lds = lds + 2 * SHM_V;
    const int kb0 = swa_jlo(cur.P0, W) * KVBLK;
    for (int d0 = 0; d0 < 8; ++d0) S.qr[d0] = load8<TIn>(cur.Q + (size_t)(wid * QBLK + r32) * QS + d0 * 16 + hi * 8);
    if constexpr (F32) { SLOAD_F((const float*)cur.K, kb0); VMW(); SWRITE_KF(0); SBAR(); SLOAD_F((const float*)cur.V, kb0); }
    else { SLOAD_H(cur.K, cur.V, cur.FB, kb0); VMW(); SWRITE_HK(0); }
    __syncthreads();
}
template <class TIn, class TOut>
__device__ __forceinline__ void causal_swa_block(const BlockRef<TIn, TOut>& cur, const BlockRef<TIn, TOut>& nxt, int skv, int W, char* lds, Seam<TIn>& S) {
    constexpr bool F32 = same_t<TIn, float>::v;
    const int tid = opaque_tid(), wid = __builtin_amdgcn_readfirstlane(tid >> 6), lane = tid & 63, r32 = lane & 31, hi = lane >> 5;
    const int j_lo = swa_jlo(cur.P0, W);
    int j_hi = (cur.P0 + QB - 1) / KVBLK + 1; if (j_hi > skv / KVBLK) j_hi = skv / KVBLK;
    const int NT = j_hi - j_lo;
    const int kbn = swa_jlo(nxt.P0, W) * KVBLK;
    const int qlo = cur.P0 + wid * QBLK, qm = qlo + r32 - 4 * hi;
    char* V_lds = lds; char* K_lds = lds + 2 * SHM_V;
    float* ws = (float*)(lds + 2 * SHM_V + 2 * SHM_K) + wid * 64; float* li_l = ws, * al_l = ws + 32;
    float m_reg = -1e30f, l_reg = 0; f32x16 o[4] = {};
    const int sr = tid >> 4, sc = (tid & 15) * 8, vst0 = v_st(sr, sc), vst1 = v_st(32 + sr, sc), kws = KSWZ(sr, sc * 2);
    const int vb0 = (int)(uintptr_t)V_lds + v_rd_base(lane);
    const TIn* Kh = cur.K; const TIn* Vh = cur.V;
#define RESC(a) do { if (__any((a) < 1.f)) { if (hi == 0) al_l[r32] = (a); asm volatile("s_waitcnt lgkmcnt(0)" ::: "memory");              \
                     for (int d_ = 0; d_ < 4; ++d_) for (int r = 0; r < 16; ++r) o[d_][r] *= al_l[crow(r, hi)]; } } while (0)
#define KBASE(t) ((j_lo + (t)) * KVBLK)
#define ACT(t) (KBASE(t) <= qlo + QBLK - 1 && KBASE(t) + KVBLK - 1 >= qlo - W + 1)
#define MASKT(P0_, P1_, t) do { const int kb_ = KBASE(t); if ((!SK || ACT(t)) && (kb_ + KVBLK - 1 > qlo || kb_ <= qlo + QBLK - 1 - W)) mask_tile(P0_, P1_, qm - kb_, (unsigned)W); } while (0)
    constexpr int NQL = F32 ? 16 : 8;
    constexpr bool SK = WSKIP && !F32;
#define SEAM_K0() do { VMWN(NQL); if constexpr (F32) { SWRITE_KF(0); SBAR(); SLOAD_F((const float*)nxt.V, kbn); } else { SWRITE_HK(0); } SBAR(); } while (0)
    f32x16 pA0, pA1, pB0, pB1; float mnA, mnB, alA, alB; bf16x8 pa0, pa1, pa2, pa3;
    if constexpr (F32) { VMW(); SWRITE_VF(0); SBAR(); } else { SWRITE_HV(0); SBAR(); }
    if (NT > 1) { if constexpr (F32) SLOAD_F((const float*)Kh, KBASE(1)); else SLOAD_H(Kh, Vh, cur.FB, KBASE(1)); }
    SBAR(); qkt<0, SK>(pA0, pA1, K_lds, r32, hi, S.qr, ACT(0));
    if constexpr (F32) { if (NT > 1) { VMW(); SWRITE_KF(1); SBAR(); SLOAD_F((const float*)Vh, KBASE(1)); } }
    MASKT(pA0, pA1, 0); partialSM(pA0, pA1, m_reg, mnA, alA);
    if (NT > 1) { VMW(); if constexpr (F32) { SWRITE_VF(1); SBAR(); if (NT > 2) SLOAD_F((const float*)Kh, KBASE(2)); } else SWRITE_H(1); }
    __syncthreads();
#define HALF_STEP(PX0, PX1, mnX, alX, PY0, PY1, alY, t, KB, VB, SB) do {                                                      \
        SBAR(); qkt<KB, SK>(PX0, PX1, K_lds, r32, hi, S.qr, ACT(t));                                             \
        finishSM(PY0, PY1, alY, l_reg, pa0, pa1, pa2, pa3); SBAR();                                                           \
        if ((t) + 1 < NT) { if constexpr (F32) { VMW(); SWRITE_KF(SB); SBAR(); SLOAD_F((const float*)Vh, KBASE((t) + 1)); }  \
                            else { SLOAD_H(Kh, Vh, cur.FB, KBASE((t) + 1)); } SBAR(); }                                               \
        pv_tile<VB, SK>(o, vb0, pa0, pa1, pa2, pa3, ACT((t) - 1)); MASKT(PX0, PX1, (t)); partialSM(PX0, PX1, m_reg, mnX, alX);                                        \
        __syncthreads();                                                                                                      \
        if ((t) + 1 < NT) { VMW(); if constexpr (F32) { SWRITE_VF(SB); SBAR(); if ((t) + 2 < NT) SLOAD_F((const float*)Kh, KBASE((t) + 2)); } \
                            else { SWRITE_H(SB); } }                                                                          \
        RESC(alX); __syncthreads(); } while (0)
    for (int t = 1; t + 1 < NT; t += 2) {
        HALF_STEP(pB0, pB1, mnB, alB, pA0, pA1, alA, t, 1, 0, 0);
        HALF_STEP(pA0, pA1, mnA, alA, pB0, pB1, alB, t + 1, 0, 1, 1);
    }
    const bool even = (NT & 1) == 0;
    if (even) { SBAR(); qkt<1, SK>(pB0, pB1, K_lds, r32, hi, S.qr, ACT(NT - 1)); SBAR(); }
#define QROW(e) (nxt.Q + (size_t)(wid * QBLK + r32) * D + ((e) >> 1) * 16 + hi * 8 + ((e) & 1) * 4)
    if constexpr (F32) { SLOAD_F((const float*)nxt.K, kbn); SBAR();
#pragma unroll
        for (int e = 0; e < 8; ++e) S.tq[e] = *(const f32x4*)QROW(e); }
    else { SLOAD_H(nxt.K, nxt.V, nxt.FB, kbn); SBAR();
#pragma unroll
        for (int d0 = 0; d0 < 8; ++d0) S.qr[d0] = load8<TIn>(nxt.Q + (size_t)(wid * QBLK + r32) * QS + d0 * 16 + hi * 8); }
    SBAR();
    finishSM(pA0, pA1, alA, l_reg, pa0, pa1, pa2, pa3); SBAR();
    if constexpr (F32) {
#pragma unroll
        for (int e = 8; e < 16; ++e) S.tq[e] = *(const f32x4*)QROW(e); SBAR(); }
#undef QROW
    pv_tile<0, SK>(o, vb0, pa0, pa1, pa2, pa3, ACT(even ? NT - 2 : NT - 1));
    if (even) { MASKT(pB0, pB1, NT - 1); partialSM(pB0, pB1, m_reg, mnB, alB); __syncthreads(); RESC(alB);
        finishSM(pB0, pB1, alB, l_reg, pa0, pa1, pa2, pa3); SBAR(); pv_tile<1, SK>(o, vb0, pa0, pa1, pa2, pa3, ACT(NT - 1)); }
    SBAR(); SEAM_K0();
    if (hi == 0) li_l[r32] = l_reg; asm volatile("s_waitcnt lgkmcnt(0)" ::: "memory");
    float rli[16];
#pragma unroll
    for (int r = 0; r < 16; ++r) rli[r] = __builtin_amdgcn_rcpf(li_l[crow(r, hi)]);
    TOut* Ow = cur.O + (size_t)(wid * QBLK) * OS;
#pragma unroll
    for (int r = 0; r < 16; ++r) { const int orow = crow(r, hi);
#pragma unroll
        for (int d0 = 0; d0 < 4; ++d0) { const float v = o[d0][r] * rli[r];
            if constexpr (same_t<TOut, float>::v) { Ow[(size_t)orow * OS + d0 * 32 + r32] = v; }
            else { const float vn = __shfl_xor(v, 1);
                   if ((r32 & 1) == 0) *(unsigned*)(Ow + (size_t)orow * OS + d0 * 32 + r32) = cvtpk(v, vn); } } }
    if constexpr (F32) {
#pragma unroll
        for (int d0 = 0; d0 < 8; ++d0) S.qr[d0] = pack8(S.tq[2 * d0], S.tq[2 * d0 + 1]); }
    __syncthreads();
#undef RESC
#undef KBASE
#undef ACT
#undef MASKT
#undef SEAM_K0
#undef HALF_STEP
}
#undef ROW
#undef VMW
#undef VMWN
#undef SLOAD_H
#undef SWRITE_HK
#undef SWRITE_HV
#undef SWRITE_H
#undef SLOAD_F
#undef SWRITE_KF
#undef SWRITE_VF

__host__ __device__ inline int swa_nramp(int nqb, int W, int qoff) { const int t = W - 1 - qoff; const int n = t < 0 ? 0 : t / QB + 1; return n > nqb ? nqb : n; }
__host__ __device__ inline int swa_nx(int nqb, int nramp, int order) { return (order & ORDER_PAIRED) ? (nramp + 1) / 2 + (nqb - nramp) : nqb; }
struct SwaItem { int bh, qb0, qb1; };
__device__ __forceinline__ SwaItem swa_decode(int L, int nb, int nh, int nhkv, int nqb, int nx, int nramp, int order) {
    const int G = nh / nhkv; SwaItem it; int x;
    if ((order & ORDER_XCD) && (nb * nhkv) % 8 == 0) { const int xcd = L & 7, k = L >> 3, per = G * nx, gi = k / per, r = k - gi * per;
        it.bh = (gi * 8 + xcd) * G + r / nx; x = r % nx; }
    else { it.bh = L / nx; x = L - it.bh * nx; }
    if (order & ORDER_PAIRED) { const int ns = nqb - nramp;
        if (x < ns) { it.qb0 = it.qb1 = nqb - 1 - x; } else { it.qb0 = x - ns; it.qb1 = nramp - 1 - it.qb0; } }
    else { it.qb0 = it.qb1 = ((order & 3) == ORDER_REVERSED) ? nqb - 1 - x : x; }
    return it;
}
typedef unsigned short bf16;
__device__ __forceinline__ BlockRef<bf16, bf16> mk_ref(const SwaItem& it, int pass, const bf16* Q, const bf16* K, const bf16* V, bf16* O, const float* FB) {
    const int qb = pass ? it.qb1 : it.qb0, b = it.bh >> 4, h = it.bh & 15, kvh = h >> 2;
    BlockRef<bf16, bf16> r;
    r.Q = Q + ((size_t)b * 8192 + (size_t)qb * QB) * QS + h * 128; r.O = O + ((size_t)b * 8192 + (size_t)qb * QB) * OS + h * 128;
    r.K = K + (size_t)b * 8192 * KS + kvh * 128; r.V = V + (size_t)b * 8192 * KS + kvh * 128; r.FB = FB + (size_t)it.bh * 8192; r.P0 = qb * QB;
    return r;
}
__device__ __forceinline__ void attn_phase(char* lds, const bf16* Q, const bf16* K, const bf16* V, bf16* O, const float* FB) {
    constexpr int nb = 4, nh = 16, nhkv = 4, nqb = 32, W = 8192, order = ORDER_PAIRED | ORDER_XCD;
    const int nramp = swa_nramp(nqb, W, 0), nx = swa_nx(nqb, nramp, order), total = nx * nb * nh, stride = gridDim.x;
    int L = blockIdx.x; if (L >= total) return;
    SwaItem it = swa_decode(L, nb, nh, nhkv, nqb, nx, nramp, order); int pass = 0;
    BlockRef<bf16, bf16> cur = mk_ref(it, 0, Q, K, V, O, FB);
    Seam<bf16> S;
    causal_swa_prime<bf16, bf16>(cur, W, lds, S);
    for (;;) {
        const bool more_pass = pass == 0 && it.qb1 != it.qb0, more_item = L + stride < total, last = !more_pass && !more_item;
        SwaItem itn = it; int passn = pass + 1, Ln = L;
        if (!more_pass) { passn = 0; Ln = more_item ? L + stride : L; itn = swa_decode(Ln, nb, nh, nhkv, nqb, nx, nramp, order); }
        const BlockRef<bf16, bf16> nxt = last ? cur : mk_ref(itn, passn, Q, K, V, O, FB);
        causal_swa_block<bf16, bf16>(cur, nxt, 8192, W, lds, S);
        if (last) break;
        cur = nxt; it = itn; pass = passn; L = Ln;
    }
}
}
constexpr size_t WS_WIN = 0, WS_WRO = 50331648, WS_WGU0 = 67108864, WS_WGU1 = 113246208, WS_WDN0 = 159383552, WS_WDN1 = 182452224,
                 WS_WO = 205520896, WS_WKVF = 213909504  , WS_COS = 227540992, WS_SIN = 231735296, WS_FB = 235929600, WS_FS = WS_FB + 2097152,
                 WS_BIG = 239075328;
constexpr size_t SZ_ROWS2K = (size_t)TALL * DM * 2;
constexpr size_t BIG_XN = 0, BIG_ACT = SZ_ROWS2K, BIG_HKV = BIG_ACT + (size_t)TALL * DFF * 2, BIG_KB = BIG_HKV + SZ_ROWS2K, BIG_VB = BIG_KB + (size_t)TP * 512 * 2,
                 BIG_KALL = BIG_VB + (size_t)TP * 512 * 2, BIG_VALL = BIG_KALL + (size_t)8 * LKS * 512 * 2, BIG_END = BIG_VALL + (size_t)8 * LKS * 512 * 2;
static_assert(BIG_END <= (size_t)TALL * NPROJ * 2, "layer-1 buffers fit in the PROJ region");
constexpr size_t WS_SSQ = WS_BIG + (size_t)TALL * NPROJ * 2  , WS_BAR = WS_SSQ + (size_t)4 * TALL * 4  , WS_END = WS_BAR + 16384;
static_assert(WS_FS + 540672 <= WS_BIG && WS_BAR % 256 == 0, "small arrays end before the big region");
static_assert(WS_END <= (size_t)1073741824, "workspace fits 1 GiB");
constexpr size_t OUT_Y = 0, OUT_SP = 67633152, OUT_KP = 71827456, OUT_VP = 88604672, OUT_LFP = 105381888, OUT_SS = 105906176, OUT_KS = 114294784, OUT_VS = 114425856, OUT_LFS = 114556928;
constexpr int NWAVES = 8, LDS_BYTES = 149504;

struct Params { const float* in[21]; float* out; unsigned char* ws; };

__device__ __forceinline__ float wave_sum(float v) {
#pragma unroll
    for (int o = 1; o < 64; o <<= 1) v += __shfl_xor(v, o);
    return v;
}
__device__ __forceinline__ float bf2f(unsigned short b) { return __uint_as_float(((unsigned)b) << 16); }
__device__ __forceinline__ unsigned pk2(float lo, float hi) { return pg8::cvt_pk_bf16(lo, hi); }

__device__ __forceinline__ void transpose_item(const float* W, int K, int N, bf16_t* WT, int k0, int n0, int drow0, LAS float* scr, int lane, const float* gain = nullptr) {
    float wv[32];
#pragma unroll
    for (int i = 0; i < 32; ++i) { const int kk = 2 * i + (lane >> 5); wv[i] = W[(size_t)(k0 + kk) * N + n0 + (lane & 31)] * (gain ? gain[k0 + kk] : 1.f); }
#pragma unroll
    for (int i = 0; i < 32; ++i) { const int kk = 2 * i + (lane >> 5); scr[kk * 33 + (lane & 31)] = wv[i]; }
    asm volatile("s_waitcnt lgkmcnt(0)" ::: "memory");
    const int c = lane & 7;
#pragma unroll
    for (int j = 0; j < 4; ++j) { const int n = (lane >> 3) + 8 * j; const LAS float* s = scr + (8 * c) * 33 + n;
        u32x4 o; o.x = pk2(s[0 * 33], s[1 * 33]); o.y = pk2(s[2 * 33], s[3 * 33]); o.z = pk2(s[4 * 33], s[5 * 33]); o.w = pk2(s[6 * 33], s[7 * 33]);
        *(u32x4*)(WT + (size_t)(drow0 + n) * K + k0 + 8 * c) = o; }
    asm volatile("s_waitcnt lgkmcnt(0)" ::: "memory");
}
__device__ __forceinline__ void tr_plain(const float* W, int K, int N, bf16_t* WT, int row_off, LAS float* scr, int item, int lane, const float* gain = nullptr) {
    const int nblk = N / 32, kb = item / nblk, nb = item % nblk; transpose_item(W, K, N, WT, 64 * kb, 32 * nb, row_off + 32 * nb, scr, lane, gain);
}
__device__ __forceinline__ void tr_gu(const float* W, bf16_t* WT, int up, LAS float* scr, int item, int lane, const float* gain) {
    const int nblk = DFF / 32, kb = item / nblk, nb = item % nblk, n0 = 32 * nb; transpose_item(W, DM, DFF, WT, 64 * kb, n0, (n0 >> 7) * 256 + up * 128 + (n0 & 127), scr, lane, gain);
}
template <int MODE  >
__device__ __forceinline__ void rms_row(const float* xrow, const float* g1, bf16_t* o1, const float* g2, bf16_t* o2, float* of, int lane) {
    const f32x4* xr = (const f32x4*)xrow + lane;
    f32x4 v[8]; float s = 0.f;
#pragma unroll
    for (int j = 0; j < 8; ++j) { v[j] = xr[64 * j]; s += (v[j].x * v[j].x + v[j].y * v[j].y) + (v[j].z * v[j].z + v[j].w * v[j].w); }
    const float rs = 1.0f / sqrtf(wave_sum(s) * (1.f / DM) + 1e-6f);
#pragma unroll
    for (int j = 0; j < 8; ++j) { const f32x4 ga = ((const f32x4*)g1)[64 * j + lane]; const f32x4 y = v[j] * rs;
        if (MODE == 2) { ((f32x4*)of)[64 * j + lane] = y * ga; }
        else { u32x2 w; w.x = pk2(y.x * ga.x, y.y * ga.y); w.y = pk2(y.z * ga.z, y.w * ga.w); ((u32x2*)o1)[64 * j + lane] = w;
            if (MODE == 1) { const f32x4 gb = ((const f32x4*)g2)[64 * j + lane]; u32x2 w2; w2.x = pk2(y.x * gb.x, y.y * gb.y); w2.y = pk2(y.z * gb.z, y.w * gb.w); ((u32x2*)o2)[64 * j + lane] = w2; } } }
}

namespace ret {
constexpr int KOFF = 0, STOFF = 32768, VOFF = 65536, POFF = 74752, VS = 144;
typedef short v4i16_t __attribute__((ext_vector_type(4)));
__device__ __forceinline__ bf16x8 frag_rm(const LAS char* base, int stride, int i0, int k0, int fr, int fq) { return *(const LAS bf16x8*)(base + (i0 + fr) * stride + (k0 + 8 * fq) * 2); }
__device__ __forceinline__ bf16x8 frag_sw(const LAS char* base, int i0, int k0, int fr, int fq) { return *(const LAS bf16x8*)(base + (i0 + fr) * 512 + ((((k0 >> 3) + fq) ^ fr) << 4)); }
__device__ __forceinline__ s16x4 tr4(const LAS char* p) { return __builtin_bit_cast(s16x4, __builtin_amdgcn_ds_read_tr16_b64_v4i16((LAS v4i16_t*)p)); }
__device__ __forceinline__ bf16x8 frag_tr(const LAS char* base, int stride, int k0, int i0, int fr, int fq) {
    const LAS char* p = base + (k0 + 8 * fq + (fr >> 2)) * stride + (i0 + 4 * (fr & 3)) * 2;
    const s16x4 a = tr4(p), b = tr4(p + 4 * stride);
    return (bf16x8){a[0], a[1], a[2], a[3], b[0], b[1], b[2], b[3]};
}
__device__ __forceinline__ bf16x8 frag_tr_sw(const LAS char* base, int k0, int i0, int fr, int fq) {
    const int m = k0 + 8 * fq + (fr >> 2), d = i0 + 4 * (fr & 3);
    const s16x4 a = tr4(base + m * 512 + ((((d >> 3) ^ (m & 15))) << 4) + (d & 7) * 2), b = tr4(base + (m + 4) * 512 + ((((d >> 3) ^ ((m + 4) & 15))) << 4) + (d & 7) * 2);
    return (bf16x8){a[0], a[1], a[2], a[3], b[0], b[1], b[2], b[3]};
}
#define RET_BAR() do { asm volatile("s_waitcnt lgkmcnt(0)" ::: "memory"); __builtin_amdgcn_s_barrier(); asm volatile("" ::: "memory"); } while (0)
#define MFMA16(X, Y, C) __builtin_amdgcn_mfma_f32_16x16x32_bf16(X, Y, C, 0, 0, 0)
__device__ __forceinline__ void ret_item(LAS char* lds, const bf16_t* proj, size_t hr0  , bf16_t* oh  , int nchunks, int c, int h, int es, const float* S0, float* Sout) {
    const int tid = opaque_tid(), wid = __builtin_amdgcn_readfirstlane(tid >> 6), lane = tid & 63, fr = lane & 15, fq = lane >> 4, lt = wid >> 1, half = wid & 1;
    const float lg2 = __log2f(1.0f - exp2f(-5.0f - (float)h)), gam = exp2f(lg2), gc1 = exp2f(lg2 * (float)(c - 1));
    f32x4 accT[8];
    const int eT = 16 * lt + fr;
#pragma unroll
    for (int i = 0; i < 8; ++i) { const int d0 = 16 * (8 * half + i) + 4 * fq;
#pragma unroll
        for (int r = 0; r < 4; ++r) accT[i][r] = S0 ? S0[(size_t)(d0 + r) * 512 + es * 64 + eT] : 0.f;
        u32x2 w; w.x = pk2(accT[i][0], accT[i][1]); w.y = pk2(accT[i][2], accT[i][3]); *(LAS u32x2*)(lds + STOFF + eT * 512 + (((d0 >> 3) ^ fr) << 4) + (d0 & 7) * 2) = w; }
    u32x4 rk[4], rv; bf16x8 yq[8];
    const bf16_t* gq = proj + PJ_Q + (hr0 + eT) * 256 + 8 * fq; const bf16_t* gk = proj + PJ_K + hr0 * 256; const bf16_t* gv = proj + PJ_V + hr0 * 512 + es * 64; bf16_t* pout = oh + hr0 * 512 + es * 64;
    const bool qok = eT < c;
#define RET_LOADQ(n) do { _Pragma("unroll") for (int ks = 0; ks < 8; ++ks) yq[ks] = qok ? *(const bf16x8*)(gq + (size_t)(n) * 64 * 256 + 32 * ks) : (bf16x8){0, 0, 0, 0, 0, 0, 0, 0}; } while (0)
#define RET_LOAD(n) do { _Pragma("unroll") for (int i = 0; i < 4; ++i) { const int p = tid + 512 * i, row = p >> 5, ch = p & 31; \
            if (row < c) rk[i] = *(const u32x4*)(gk + (size_t)((n) * 64 + row) * 256 + ch * 8); else rk[i] = (u32x4){0u, 0u, 0u, 0u}; } \
        { const int row = tid >> 3, ch = tid & 7; if (row < c) rv = *(const u32x4*)(gv + (size_t)((n) * 64 + row) * 512 + ch * 8); else rv = (u32x4){0u, 0u, 0u, 0u}; } } while (0)
    RET_LOAD(0); RET_LOADQ(0);
    for (int n = 0; n < nchunks; ++n) {
#pragma unroll
        for (int i = 0; i < 4; ++i) { const int p = tid + 512 * i, row = p >> 5, ch = p & 31; *(LAS u32x4*)(lds + KOFF + row * 512 + ((ch ^ (row & 15)) << 4)) = rk[i]; }
        *(LAS u32x4*)(lds + VOFF + (tid >> 3) * VS + (tid & 7) * 16) = rv;
        if (n + 1 < nchunks) RET_LOAD(n + 1);
        RET_BAR();
        f32x4 accS[2], accC[2];
#pragma unroll
        for (int j = 0; j < 2; ++j) { accS[j] = (f32x4){0.f, 0.f, 0.f, 0.f}; accC[j] = (f32x4){0.f, 0.f, 0.f, 0.f}; }
#pragma unroll
        for (int kb = 0; kb < 8; kb += 2) {
            bf16x8 xk[2][2], xs[2][2];
#pragma unroll
            for (int ks = 0; ks < 2; ++ks)
#pragma unroll
                for (int j = 0; j < 2; ++j) { xk[ks][j] = frag_sw(lds + KOFF, 16 * (2 * half + j), 32 * (kb + ks), fr, fq); xs[ks][j] = frag_sw(lds + STOFF, 16 * (2 * half + j), 32 * (kb + ks), fr, fq); }
            __builtin_amdgcn_sched_barrier(0);
#pragma unroll
            for (int ks = 0; ks < 2; ++ks)
#pragma unroll
                for (int j = 0; j < 2; ++j) { accS[j] = MFMA16(xk[ks][j], yq[kb + ks], accS[j]); accC[j] = MFMA16(xs[ks][j], yq[kb + ks], accC[j]); }
            __builtin_amdgcn_sched_barrier(0);
        }
        if (n + 1 < nchunks) RET_LOADQ(n + 1);
        const int lrow = eT;
#pragma unroll
        for (int j = 0; j < 2; ++j) { const int m0 = 16 * (2 * half + j) + 4 * fq; f32x4 sv = accS[j];
#pragma unroll
            for (int r = 0; r < 4; ++r) sv[r] = (m0 + r <= lrow) ? sv[r] : 0.f;
            u32x2 w; w.x = pk2(sv[0], sv[1]); w.y = pk2(sv[2], sv[3]); *(LAS u32x2*)(lds + POFF + lrow * VS + m0 * 2) = w; }
        RET_BAR();
        f32x4 accO[2];
#pragma unroll
        for (int j = 0; j < 2; ++j) accO[j] = accC[j] * gam;
#pragma unroll
        for (int ks = 0; ks < 2; ++ks) { const int k0 = 32 * ks;
            const bf16x8 yp = frag_rm(lds + POFF, VS, 16 * lt, k0, fr, fq);
#pragma unroll
            for (int j = 0; j < 2; ++j) { const bf16x8 xv = frag_tr(lds + VOFF, VS, k0, 16 * (2 * half + j), fr, fq); accO[j] = MFMA16(xv, yp, accO[j]); } }
        if (lrow < c) {
#pragma unroll
            for (int j = 0; j < 2; ++j) { u32x2 w; w.x = pk2(accO[j][0], accO[j][1]); w.y = pk2(accO[j][2], accO[j][3]);
                *(u32x2*)(pout + (size_t)(n * 64 + lrow) * 512 + 16 * (2 * half + j) + 4 * fq) = w; } }
#pragma unroll
        for (int i = 0; i < 8; ++i) accT[i] = accT[i] * gam;
#pragma unroll
        for (int ks = 0; ks < 2; ++ks) {
            bf16x8 xk[8]; const bf16x8 yv = frag_tr(lds + VOFF, VS, 32 * ks, 16 * lt, fr, fq);
#pragma unroll
            for (int i = 0; i < 8; ++i) xk[i] = frag_tr_sw(lds + KOFF, 32 * ks, 16 * (8 * half + i), fr, fq);
            __builtin_amdgcn_sched_barrier(0);
#pragma unroll
            for (int i = 0; i < 8; ++i) accT[i] = MFMA16(xk[i], yv, accT[i]);
            __builtin_amdgcn_sched_barrier(0);
        }
#pragma unroll
        for (int i = 0; i < 8; ++i) { accT[i] = accT[i] * gc1; const int d0 = 16 * (8 * half + i) + 4 * fq;
            u32x2 w; w.x = pk2(accT[i][0], accT[i][1]); w.y = pk2(accT[i][2], accT[i][3]); *(LAS u32x2*)(lds + STOFF + eT * 512 + (((d0 >> 3) ^ fr) << 4) + (d0 & 7) * 2) = w; }
        RET_BAR();
    }
#undef RET_LOAD
#undef RET_LOADQ
#pragma unroll
    for (int i = 0; i < 8; ++i) { const int d0 = 16 * (8 * half + i) + 4 * fq;
#pragma unroll
        for (int r = 0; r < 4; ++r) Sout[(size_t)(d0 + r) * 512 + es * 64 + eT] = accT[i][r]; }
}
}
__device__ __forceinline__ void sample_attn(LAS char* lds, const bf16_t* QBp, const bf16_t* KALL, const bf16_t* VALL, const float* FS, bf16_t* AO) {
    const int tid = opaque_tid(), wid = __builtin_amdgcn_readfirstlane(tid >> 6), lane = tid & 63;
    LAS float* qf = (LAS float*)(lds + wid * 5120); LAS float* pf = qf + 128;
    const int gw = blockIdx.x * NWAVES + wid, NGW = gridDim.x * NWAVES;
    for (int item = gw; item < 8 * 16 * 32; item += NGW) {
        const int b = item >> 9, h = (item >> 5) & 15, qi = item & 31, kvh = h >> 2, qpos = PASTL + qi, row = TP + b * 32 + qi;
        const bf16_t* q = QBp + (size_t)row * DM + h * 128;
        qf[lane] = bf2f(q[lane]); qf[lane + 64] = bf2f(q[lane + 64]);
        asm volatile("s_waitcnt lgkmcnt(0)" ::: "memory");
        const float* F = FS + (size_t)(b * 16 + h) * LKS; const float Fq = F[qpos];
        const bf16_t* Kb = KALL + (size_t)b * LKS * 512 + kvh * 128; const bf16_t* Vb = VALL + (size_t)b * LKS * 512 + kvh * 128;
        float mx = -1e30f;
#pragma unroll 1
        for (int t = 0; t < 17; ++t) { const int j = lane + 64 * t; float s = -__builtin_inff();
            if (j <= qpos) { const u32x4* kr = (const u32x4*)(Kb + (size_t)j * 512); float a = 0.f; u32x4 kvv[16];
#pragma unroll
                for (int c8 = 0; c8 < 16; ++c8) kvv[c8] = kr[c8];
#pragma unroll
                for (int c8 = 0; c8 < 16; ++c8) { const u32x4 kv = kvv[c8]; const LAS f32x4* qq = (const LAS f32x4*)(qf + 8 * c8); const f32x4 q0 = qq[0], q1 = qq[1];
                    a += __uint_as_float(kv.x << 16) * q0.x + __uint_as_float(kv.x & 0xffff0000u) * q0.y + __uint_as_float(kv.y << 16) * q0.z + __uint_as_float(kv.y & 0xffff0000u) * q0.w
                       + __uint_as_float(kv.z << 16) * q1.x + __uint_as_float(kv.z & 0xffff0000u) * q1.y + __uint_as_float(kv.w << 16) * q1.z + __uint_as_float(kv.w & 0xffff0000u) * q1.w; }
                s = a * 0.08838834764831845f + (Fq - F[j]); }
            pf[j] = s; mx = fmaxf(mx, s); }
#pragma unroll
        for (int o = 1; o < 64; o <<= 1) mx = fmaxf(mx, __shfl_xor(mx, o));
        float sum = 0.f;
#pragma unroll 1
        for (int t = 0; t < 17; ++t) { const float p = __expf(pf[lane + 64 * t] - mx); sum += p; pf[lane + 64 * t] = p; }
        sum = wave_sum(sum);
        asm volatile("s_waitcnt lgkmcnt(0)" ::: "memory");
        float oa[8];
#pragma unroll
        for (int e = 0; e < 8; ++e) oa[e] = 0.f;
        const int kg = lane >> 4, dg = lane & 15;
        for (int j = 0; j < PASTL + 32; j += 32) {
            u32x4 vv[8]; float p[8];
#pragma unroll
            for (int u = 0; u < 8; ++u) { vv[u] = *(const u32x4*)(Vb + (size_t)(j + 4 * u + kg) * 512 + 8 * dg); p[u] = pf[j + 4 * u + kg]; }
#pragma unroll
            for (int u = 0; u < 8; ++u) { const unsigned w4[4] = {vv[u].x, vv[u].y, vv[u].z, vv[u].w};
#pragma unroll
                for (int e = 0; e < 4; ++e) { oa[2 * e] += p[u] * __uint_as_float(w4[e] << 16); oa[2 * e + 1] += p[u] * __uint_as_float(w4[e] & 0xffff0000u); } } }
#pragma unroll
        for (int e = 0; e < 8; ++e) { oa[e] += __shfl_xor(oa[e], 16); oa[e] += __shfl_xor(oa[e], 32); }
        const float inv = 1.0f / sum;
        if (kg == 0) { u32x4 w; w.x = pk2(oa[0] * inv, oa[1] * inv); w.y = pk2(oa[2] * inv, oa[3] * inv); w.z = pk2(oa[4] * inv, oa[5] * inv); w.w = pk2(oa[6] * inv, oa[7] * inv);
            *(u32x4*)(AO + (size_t)row * DM + h * 128 + 8 * dg) = w; }
        asm volatile("s_waitcnt lgkmcnt(0)" ::: "memory");
    }
}

#define XB_TMO      128
#define XB_XCNT(j)  (256  + 64 * (j))
#define XB_XSUB(j)  (1280 + 64 * (j))
#define XB_XGEN(j)  (2304 + 64 * (j))
#define XB_TOP      3328
#define XB_TOPGEN   3392
#define XCD_BAR_WORDS 3456
#define XB_SPIN_CAP (1u << 18)

__device__ __forceinline__ unsigned xb_ld(unsigned* p)              { return __hip_atomic_load(p, __ATOMIC_RELAXED, __HIP_MEMORY_SCOPE_AGENT); }
__device__ __forceinline__ unsigned xb_add(unsigned* p, unsigned v) { return __hip_atomic_fetch_add(p, v, __ATOMIC_RELAXED, __HIP_MEMORY_SCOPE_AGENT); }
__device__ __forceinline__ unsigned xb_xcc_id() { return (unsigned)__builtin_amdgcn_s_getreg((3 << 11) | 20) & 0xFu; }
#define XB_SPIN(cond, bar) do { unsigned _sp = 0; while (cond) { __builtin_amdgcn_s_sleep(1); \
    if ((++_sp & 255u) == 0u) { if (xb_ld(&(bar)[XB_TMO])) break; if (_sp > XB_SPIN_CAP) { atomicAdd(&(bar)[XB_TMO], 1u); break; } } } } while (0)

struct XcdBarrier {
    unsigned* bar; unsigned x;
    volatile LAS unsigned* st;
};

__device__ __forceinline__ XcdBarrier xcd_barrier_post(unsigned* bar, volatile LAS unsigned* st) {
    XcdBarrier b; b.bar = bar; b.x = xb_xcc_id(); b.st = st;
    if (threadIdx.x == 0) (void)xb_add(&bar[XB_XCNT(b.x)], 1u);
    return b;
}
__device__ __forceinline__ void xcd_barrier_complete(unsigned* bar, unsigned x, unsigned& nloc, unsigned& nx) {
    const unsigned G = gridDim.x * gridDim.y * gridDim.z;
    unsigned sum, cnt, mine, sp = 0u;
    for (;;) {
        sum = 0u; cnt = 0u; mine = 0u;
#pragma unroll
        for (unsigned j = 0; j < 16; ++j) { const unsigned c = xb_ld(&bar[XB_XCNT(j)]); sum += c; cnt += (c > 0u) ? 1u : 0u; mine = (j == x) ? c : mine; }
        if (sum == G) break;
        __builtin_amdgcn_s_sleep(1);
        if ((++sp & 255u) == 0u) { if (xb_ld(&bar[XB_TMO])) break; if (sp > XB_SPIN_CAP) { atomicAdd(&bar[XB_TMO], 1u); break; } }
    }
    nloc = mine > 0u ? mine : 1u; nx = cnt > 0u ? cnt : 1u;
}

__device__ __forceinline__ void xcd_barrier(const XcdBarrier& b) {
    asm volatile("s_waitcnt vmcnt(0)" ::: "memory");
    __syncthreads();
    if (threadIdx.x == 0) {
        unsigned* bar = b.bar;
        __builtin_amdgcn_s_waitcnt(0);
        unsigned nloc = b.st[0], nx = b.st[1];
        if (nloc == 0u) { xcd_barrier_complete(bar, b.x, nloc, nx); b.st[0] = nloc; b.st[1] = nx; }
        const unsigned old = xb_add(&bar[XB_XSUB(b.x)], 1u);
        const unsigned gen = old / nloc;
        if (old + 1u == (gen + 1u) * nloc) {
            __builtin_amdgcn_fence(__ATOMIC_RELEASE, "agent");
            asm volatile("s_waitcnt vmcnt(0)" ::: "memory");
            const unsigned og = xb_add(&bar[XB_TOP], 1u);
            const unsigned tg = og / nx;
            if (og + 1u == (tg + 1u) * nx) xb_add(&bar[XB_TOPGEN], 1u);
            else XB_SPIN(xb_ld(&bar[XB_TOPGEN]) == tg, bar);
            __builtin_amdgcn_fence(__ATOMIC_ACQUIRE, "agent");
            xb_add(&bar[XB_XGEN(b.x)], 1u);
            asm volatile("s_waitcnt vmcnt(0)" ::: "memory");
        } else {
            XB_SPIN(xb_ld(&bar[XB_XGEN(b.x)]) == gen, bar);
            __builtin_amdgcn_fence(__ATOMIC_ACQUIRE, "agent");
            asm volatile("s_waitcnt vmcnt(0)" ::: "memory");
        }
    }
    __syncthreads();
}

#define KARG(i) ((unsigned char*)(__attribute__((address_space(1))) unsigned char*)(((const volatile __attribute__((address_space(4))) unsigned long long*)__builtin_amdgcn_kernarg_segment_ptr())[i]))
#define INF(i) ((const float*)KARG(i))
#define OUTP ((float*)KARG(21))
#define WSP (KARG(22))
#define BIGP (KARG(22) + WS_BIG)
#define PH_IDS const int tid = opaque_tid(), lane = tid & 63, wave = __builtin_amdgcn_readfirstlane(tid >> 6); const int G = gridDim.x, gw = blockIdx.x * NWAVES + wave, NGW = G * NWAVES; const size_t gt = (size_t)blockIdx.x * 512 + tid, NGT = (size_t)G * 512; (void)lane; (void)gw; (void)NGW; (void)gt; (void)NGT

__device__ __forceinline__ void ph_prologue(LAS unsigned char* lds) {
    PH_IDS; unsigned char* ws = WSP;
    bf16_t* WIN = (bf16_t*)(ws + WS_WIN); bf16_t* WKVF = (bf16_t*)(ws + WS_WKVF);
    LAS float* scr = (LAS float*)(lds + wave * 16384);
    constexpr int I0 = 32 * 384;
    for (int it = gw; it < I0; it += NGW) tr_plain(INF(10), DM, NPROJ, WIN, 0, scr, it, lane);
    { const float* wf = INF(14); const float* nkv = INF(8);
      for (size_t i = gt; i < (size_t)256 * DM; i += NGT) { const int r = (int)(i >> 11), k = (int)(i & 2047); WKVF[(size_t)(1024 + r) * DM + k] = r < 16 ? (bf16_t)(pk2(wf[k * 16 + r] * nkv[k], 0.f) & 0xffffu) : (bf16_t)0; }
      float* ssq = (float*)(ws + WS_SSQ); for (size_t i = gt; i < (size_t)4 * TALL; i += NGT) ssq[i] = 0.f; }
    { float* COS = (float*)(ws + WS_COS); float* SIN = (float*)(ws + WS_SIN);
      for (size_t i = gt; i < (size_t)SEQ * 128; i += NGT) { const int pos = (int)(i >> 7), d = (int)(i & 127);
        const float inv = exp2f(-(float)d * (13.287712379549449f / 128.f));
        const double rev = (double)pos * (double)inv * 0.15915494309189535; const float fr = (float)(rev - __builtin_floor(rev));
        COS[i] = __builtin_amdgcn_cosf(fr); SIN[i] = __builtin_amdgcn_sinf(fr); } }
    { const float* x_p = INF(0); const float* x_s = INF(1); const float* nm = INF(6); bf16_t* XN0 = (bf16_t*)OUTP;
      for (int m = gw; m < TALL; m += NGW) rms_row<0>(m < TP ? x_p + (size_t)m * DM : x_s + (size_t)(m - TP) * DM, nm, XN0 + (size_t)m * DM, nullptr, nullptr, nullptr, lane); }
}
template <int JOB> __device__ __forceinline__ void ph_conv(LAS unsigned char* lds) {
    const int tid = opaque_tid(), lane = tid & 63, wave = __builtin_amdgcn_readfirstlane(tid >> 6);
    const int G = gridDim.x, first = G > 160 ? (JOB == 1 ? 48 : JOB == 3 ? 141 : 44) : 0;
    if ((int)blockIdx.x < first) return;
    const int gw = ((int)blockIdx.x - first) * NWAVES + wave, NGW = (G - first) * NWAVES;
    unsigned char* ws = WSP; LAS float* scr = (LAS float*)(lds + wave * 16384);
    constexpr int IG = 32 * 176, ID = 88 * 64, IQ = 32 * 64, IK = 32 * 16;
    if (JOB == 1) {
        bf16_t* WRO = (bf16_t*)(ws + WS_WRO); bf16_t* WGU0 = (bf16_t*)(ws + WS_WGU0);
        for (int it = gw; it < 64 * 64 + 2 * IG; it += NGW) { int r = it;
            if (r < 64 * 64) { tr_plain(INF(11), 4096, DM, WRO, 0, scr, r, lane); continue; } r -= 64 * 64;
            if (r < IG) { tr_gu(INF(18), WGU0, 0, scr, r, lane, INF(7)); continue; } r -= IG;
            tr_gu(INF(19), WGU0, 1, scr, r, lane, INF(7)); }
    } else if (JOB == 2) {
        bf16_t* WDN0 = (bf16_t*)(ws + WS_WDN0); bf16_t* WGU1 = (bf16_t*)(ws + WS_WGU1); bf16_t* WO = (bf16_t*)(ws + WS_WO); bf16_t* WKVF = (bf16_t*)(ws + WS_WKVF);
        for (int it = gw; it < ID + 2 * IQ + 2 * IK + IG; it += NGW) { int r = it;
            if (r < ID) { tr_plain(INF(20), DFF, DM, WDN0, 0, scr, r, lane); continue; } r -= ID;
            if (r < IQ) { tr_plain(INF(16), DM, DM, WKVF, 1280, scr, r, lane, INF(6) + DM); continue; } r -= IQ;
            if (r < IK) { tr_plain(INF(12), DM, 512, WKVF, 0, scr, r, lane, INF(8)); continue; } r -= IK;
            if (r < IK) { tr_plain(INF(13), DM, 512, WKVF, 512, scr, r, lane, INF(8)); continue; } r -= IK;
            if (r < IQ) { tr_plain(INF(17), DM, DM, WO, 0, scr, r, lane); continue; } r -= IQ;
            tr_gu(INF(18) + (size_t)DM * DFF, WGU1, 0, scr, r, lane, INF(7) + DM); }
    } else if (JOB == 3) {
        bf16_t* WGU1 = (bf16_t*)(ws + WS_WGU1);
        for (int it = gw; it < IG; it += NGW) tr_gu(INF(19) + (size_t)DM * DFF, WGU1, 1, scr, it, lane, INF(7) + DM);
    } else {
        bf16_t* WDN1 = (bf16_t*)(ws + WS_WDN1);
        for (int it = gw; it < ID; it += NGW) tr_plain(INF(20) + (size_t)DFF * DM, DFF, DM, WDN1, 0, scr, it, lane);
    }
}
__device__ __forceinline__ void ph_retin(LAS unsigned char* lds) {
    unsigned char* ws = WSP;
    pg8::Gemm g{(const bf16_t*)OUTP, (const bf16_t*)(ws + WS_WIN), TALL, NPROJ, DM, DM}; pg8::StaticOrder S; S.init(TALL, NPROJ, (int)gridDim.x, (int)blockIdx.x);
    pg8::EpiRetIn E{(bf16_t*)(ws + WS_BIG), (const float*)(ws + WS_COS), (const float*)(ws + WS_SIN)};
    pg8::gemm_phase<pg8::EpiRetIn, pg8::StaticOrder, true, true>(lds, g, S, E);
}
__device__ __forceinline__ void ph_retention(LAS unsigned char* lds) {
    const int G = gridDim.x;
    for (int it = blockIdx.x; it < 256; it += G) { const int bh = (it & 7) * 4 + (it >> 6), es = (it >> 3) & 7, b = bh >> 3, h = bh & 7;
        ret::ret_item((LAS char*)lds, (const bf16_t*)BIGP, (size_t)(b * 8 + h) * SEQ, (bf16_t*)OUTP, 128, 64, h, es, nullptr, OUTP + OUT_SP + (size_t)(b * 8 + h) * 256 * 512); }
    for (int it = blockIdx.x; it < 512; it += G) { const int bh = (it & 7) * 8 + (it >> 6), es = (it >> 3) & 7, b = bh >> 3, h = bh & 7;
        ret::ret_item((LAS char*)lds, (const bf16_t*)BIGP, (size_t)262144 + (size_t)(b * 8 + h) * 32, (bf16_t*)OUTP, 1, 32, h, es, INF(2) + (size_t)(b * 8 + h) * 256 * 512, OUTP + OUT_SS + (size_t)(b * 8 + h) * 256 * 512); }
}
__device__ __forceinline__ void ph_groupnorm() {
    PH_IDS; bf16_t* PROJ = (bf16_t*)BIGP; const bf16_t* OB = (const bf16_t*)OUTP;
    for (int it0 = gw * 4; it0 < TALL * 8; it0 += NGW * 4) {
        u32x4 ovv[4], gvv[4];
#pragma unroll
        for (int q = 0; q < 4; ++q) { const int it = it0 + q, row = it >> 3, h = it & 7;
            ovv[q] = *(const u32x4*)(OB + hrow(row, h) * 512 + lane * 8); gvv[q] = *(const u32x4*)(PROJ + PJ_G + (size_t)row * 4096 + h * 512 + lane * 8); }
#pragma unroll
        for (int q = 0; q < 4; ++q) { const int it = it0 + q, row = it >> 3, h = it & 7; const u32x4 ov = ovv[q], gv = gvv[q];
            bf16_t* op = PROJ + PJ_G + (size_t)row * 4096 + h * 512 + lane * 8;
            float o[8], g[8]; const unsigned ow[4] = {ov.x, ov.y, ov.z, ov.w}, gwd[4] = {gv.x, gv.y, gv.z, gv.w};
#pragma unroll
            for (int j = 0; j < 4; ++j) { o[2 * j] = __uint_as_float(ow[j] << 16); o[2 * j + 1] = __uint_as_float(ow[j] & 0xffff0000u); g[2 * j] = __uint_as_float(gwd[j] << 16); g[2 * j + 1] = __uint_as_float(gwd[j] & 0xffff0000u); }
            float s = 0.f;
#pragma unroll
            for (int j = 0; j < 8; ++j) s += o[j];
            const float mu = wave_sum(s) * (1.f / 512.f); float qq = 0.f;
#pragma unroll
            for (int j = 0; j < 8; ++j) { o[j] -= mu; qq += o[j] * o[j]; }
            const float rstd = 1.0f / sqrtf(wave_sum(qq) * (1.f / 512.f) + 1e-5f);
#pragma unroll
            for (int j = 0; j < 8; ++j) o[j] = o[j] * rstd * pg8::silu_f(g[j]);
            u32x4 w; w.x = pk2(o[0], o[1]); w.y = pk2(o[2], o[3]); w.z = pk2(o[4], o[5]); w.w = pk2(o[6], o[7]); *(u32x4*)op = w; } }
}
template <bool FIRST, int MROWS = TALL, bool NOF32 = false> __device__ __forceinline__ void ph_res_gemm(LAS unsigned char* lds, unsigned char* a_ptr, size_t w_off, int K, int lda, bf16_t* hb, int ssq_idx) {
    unsigned char* ws = WSP; float* Hres = OUTP + OUT_Y;
    pg8::Gemm g{(const bf16_t*)a_ptr, (const bf16_t*)(ws + w_off), MROWS, DM, K, lda}; pg8::StaticOrder S; S.init(MROWS, DM, (int)gridDim.x, (int)blockIdx.x);
    pg8::EpiRes E{FIRST ? INF(0) : Hres, FIRST ? INF(1) : Hres + (size_t)TP * DM, NOF32 ? (float*)nullptr : Hres, hb, ssq_idx >= 0 ? (float*)(ws + WS_SSQ) + (size_t)ssq_idx * TALL : nullptr};
    pg8::gemm_phase<pg8::EpiRes, pg8::StaticOrder, true, true>(lds, g, S, E);
}
template <bool FIRST = false, bool NOF32 = false> __device__ __forceinline__ void ph_sample_res(const unsigned char* a_ptr, int lda, size_t w_off, int K, bf16_t* hb, int ssq_idx) {
    const int tid = opaque_tid(), lane = tid & 63, wave = __builtin_amdgcn_readfirstlane(tid >> 6), fr = lane & 15, fq = lane >> 4;
    unsigned char* ws = WSP; float* Hs = OUTP + OUT_Y + (size_t)TP * DM;
    const bf16_t* A = (const bf16_t*)a_ptr; const bf16_t* Wt = (const bf16_t*)(ws + w_off);
    float* ssq = ssq_idx >= 0 ? (float*)(ws + WS_SSQ) + (size_t)ssq_idx * TALL + TP : nullptr;
    for (int it = blockIdx.x; it < 256; it += gridDim.x) {
        const int n0 = (it >> 1) * 16, row = (it & 1) * 128 + 16 * wave + fr;
        const bf16_t* bp = Wt + (size_t)(n0 + fr) * K + 8 * fq; const bf16_t* ap = A + (size_t)row * lda + 8 * fq;
        f32x4 acc = {0.f, 0.f, 0.f, 0.f};
        bf16x8 bA[8], aA[8], bB[8], aB[8];
#define SR_LOAD(B_, A_, kk) do { _Pragma("unroll") for (int s_ = 0; s_ < 8; ++s_) { B_[s_] = *(const bf16x8*)(bp + (kk) + 32 * s_); A_[s_] = *(const bf16x8*)(ap + (kk) + 32 * s_); } } while (0)
#define SR_MMA(B_, A_) do { _Pragma("unroll") for (int s_ = 0; s_ < 8; ++s_) acc = __builtin_amdgcn_mfma_f32_16x16x32_bf16(B_[s_], A_[s_], acc, 0, 0, 0); } while (0)
        SR_LOAD(bA, aA, 0);
        for (int k0 = 0; k0 < K; k0 += 512) {
            SR_LOAD(bB, aB, k0 + 256);
            SR_MMA(bA, aA);
            if (k0 + 512 < K) SR_LOAD(bA, aA, k0 + 512);
            SR_MMA(bB, aB);
        }
#undef SR_LOAD
#undef SR_MMA
        float* o = Hs + (size_t)row * DM + n0 + 4 * fq;
        const f32x4 v = (FIRST ? *(const f32x4*)(INF(1) + (size_t)row * DM + n0 + 4 * fq) : *(const f32x4*)o) + acc; if (!NOF32) *(f32x4*)o = v;
        if (hb) { u32x2 w; w.x = pk2(v[0], v[1]); w.y = pk2(v[2], v[3]); *(u32x2*)(hb + (size_t)(TP + row) * DM + n0 + 4 * fq) = w; }
        if (ssq) { float ss = (v[0] * v[0] + v[1] * v[1]) + (v[2] * v[2] + v[3] * v[3]); ss += __shfl_xor(ss, 16); ss += __shfl_xor(ss, 32);
            if (fq == 0) (void)__hip_atomic_fetch_add(ssq + row, ss, __ATOMIC_RELAXED, __HIP_MEMORY_SCOPE_AGENT); }
    }
}
template <int MODE> __device__ __forceinline__ void ph_rms(const float* g1, size_t o1_off, const float* g2, size_t o2_off) {
    PH_IDS; float* Hres = OUTP + OUT_Y; unsigned char* ws = WSP;
    for (int m = gw; m < TALL; m += NGW) rms_row<MODE>(Hres + (size_t)m * DM, g1, (bf16_t*)(ws + o1_off) + (size_t)m * DM, g2, (bf16_t*)(ws + o2_off) + (size_t)m * DM, Hres + (size_t)m * DM, lane);
}
__device__ __forceinline__ void ph_cache_cvt() {
    PH_IDS; const float* cache_k = INF(3); const float* cache_v = INF(4); bf16_t* KALL = (bf16_t*)(BIGP + BIG_KALL); bf16_t* VALL = (bf16_t*)(BIGP + BIG_VALL);
    for (size_t i = gt; i < (size_t)8 * PASTL * 512 / 4; i += NGT) { const size_t e = i * 4, b = e / ((size_t)PASTL * 512), r = e % ((size_t)PASTL * 512);
        const f32x4 kv = *(const f32x4*)(cache_k + e), vv = *(const f32x4*)(cache_v + e); u32x2 w; w.x = pk2(kv.x, kv.y); w.y = pk2(kv.z, kv.w); *(u32x2*)(KALL + b * LKS * 512 + r) = w;
        w.x = pk2(vv.x, vv.y); w.y = pk2(vv.z, vv.w); *(u32x2*)(VALL + b * LKS * 512 + r) = w; }
}
__device__ __forceinline__ void ph_kvfq(LAS unsigned char* lds) {
    unsigned char* ws = WSP; unsigned char* big = ws + WS_BIG; float* out = OUTP;
    pg8::Gemm g{(const bf16_t*)(big + BIG_XN), (const bf16_t*)(ws + WS_WKVF), TALL, 3328, DM, DM}; pg8::StaticOrder S; S.init(TALL, 3328, (int)gridDim.x, (int)blockIdx.x);
    pg8::EpiKVFQ E{out + OUT_KP, out + OUT_VP, out + OUT_LFP, out + OUT_KS, out + OUT_VS, out + OUT_LFS, (bf16_t*)(big + BIG_KB), (bf16_t*)(big + BIG_VB), (bf16_t*)(big + BIG_KALL), (bf16_t*)(big + BIG_VALL),
                    (bf16_t*)(big + BIG_ACT), INF(15), (const float*)(ws + WS_SSQ) + (size_t)1 * TALL};
    pg8::gemm_phase<pg8::EpiKVFQ, pg8::StaticOrder, true, true>(lds, g, S, E);
}
__device__ __forceinline__ void ph_cumsum(LAS unsigned char* lds) {
    PH_IDS; const float* cache_lf = INF(5); const float* out = OUTP; float* FB = (float*)(WSP + WS_FB); float* FS = (float*)(WSP + WS_FS);
    for (int it = blockIdx.x; it < 64 + 128; it += G) {
        LAS float* wtot = (LAS float*)lds;
        const bool smp = it >= 64; const int bh = smp ? it - 64 : it, b = bh >> 4, h = bh & 15, Ls = smp ? LKS : SEQ, per = smp ? 3 : 16, j0 = tid * per;
        float v[16]; float s = 0.f;
#pragma unroll
        for (int i = 0; i < 16; ++i) { const int j = j0 + i; float x = 0.f;
            if (i < per && j < Ls) x = smp ? (j < PASTL ? cache_lf[((size_t)b * PASTL + j) * 16 + h] : out[OUT_LFS + ((size_t)b * 32 + (j - PASTL)) * 16 + h]) : out[OUT_LFP + ((size_t)b * SEQ + j) * 16 + h];
            s += x; v[i] = s; }
        float inc = s;
#pragma unroll
        for (int o = 1; o < 64; o <<= 1) { const float t = __shfl_up(inc, o); if (lane >= o) inc += t; }
        if (lane == 63) wtot[wave] = inc;
        __syncthreads();
        float base = inc - s;
        for (int w = 0; w < wave; ++w) base += wtot[w];
#pragma unroll
        for (int i = 0; i < 16; ++i) { const int j = j0 + i; if (i < per && j < Ls) { const float F = base + v[i];
            if (smp) FS[(size_t)bh * LKS + j] = F; else FB[(size_t)bh * SEQ + j] = -F * 11.313708498984761f; } }
        __syncthreads();
    }
}
__device__ __forceinline__ void ph_attn(unsigned char* lds_raw) {
    unsigned char* ws = WSP; unsigned char* big = ws + WS_BIG;
    fox::attn_phase((char*)lds_raw, (const bf16_t*)(big + BIG_ACT), (const bf16_t*)(big + BIG_KB), (const bf16_t*)(big + BIG_VB), (bf16_t*)(big + BIG_XN), (const float*)(ws + WS_FB));
}
__device__ __forceinline__ void ph_sattn(LAS unsigned char* lds) {
    unsigned char* ws = WSP; unsigned char* big = ws + WS_BIG;
    sample_attn((LAS char*)lds, (const bf16_t*)(big + BIG_ACT), (const bf16_t*)(big + BIG_KALL), (const bf16_t*)(big + BIG_VALL), (const float*)(ws + WS_FS), (bf16_t*)(big + BIG_XN));
}
__device__ __forceinline__ void ph_gateup(LAS unsigned char* lds, const unsigned char* a_ptr, size_t w_off, int ssq_idx) {
    unsigned char* ws = WSP; unsigned char* big = ws + WS_BIG;
    pg8::Gemm g{(const bf16_t*)a_ptr, (const bf16_t*)(ws + w_off), TALL, 2 * DFF, DM, DM}; pg8::StaticOrder S; S.init(TALL, 2 * DFF, (int)gridDim.x, (int)blockIdx.x);
    pg8::EpiSwiglu E{(bf16_t*)(big + BIG_ACT), (const float*)(ws + WS_SSQ) + (size_t)ssq_idx * TALL};
    pg8::gemm_phase<pg8::EpiSwiglu, pg8::StaticOrder, true, true>(lds, g, S, E);
}

__device__ __forceinline__ void ph_final() {
    PH_IDS; const bf16_t* H4 = (const bf16_t*)(BIGP + BIG_XN); const float* ssq = (const float*)(WSP + WS_SSQ) + (size_t)3 * TALL; const float* g = INF(9); float* Y = OUTP + OUT_Y;
    for (int m = gw; m < TALL; m += NGW) {
        const u32x4* hr = (const u32x4*)(H4 + (size_t)m * DM); u32x4 hv[4];
#pragma unroll
        for (int j = 0; j < 4; ++j) hv[j] = hr[64 * j + lane];
        const float rs = 1.0f / sqrtf(ssq[m] * (1.f / DM) + 1e-6f);
#pragma unroll
        for (int j = 0; j < 4; ++j) { const int c0 = (64 * j + lane) * 8; const f32x4 g0 = *(const f32x4*)(g + c0), g1 = *(const f32x4*)(g + c0 + 4);
            f32x4 y0, y1; y0.x = __uint_as_float(hv[j].x << 16); y0.y = __uint_as_float(hv[j].x & 0xffff0000u); y0.z = __uint_as_float(hv[j].y << 16); y0.w = __uint_as_float(hv[j].y & 0xffff0000u);
            y1.x = __uint_as_float(hv[j].z << 16); y1.y = __uint_as_float(hv[j].z & 0xffff0000u); y1.z = __uint_as_float(hv[j].w << 16); y1.w = __uint_as_float(hv[j].w & 0xffff0000u);
            *(f32x4*)(Y + (size_t)m * DM + c0) = y0 * rs * g0; *(f32x4*)(Y + (size_t)m * DM + c0 + 4) = y1 * rs * g1; } }
}
__global__ void __launch_bounds__(NWAVES * 64, 2) yoco_fwd(Params P) {
    extern __shared__ __attribute__((aligned(16))) unsigned char lds_raw[];
    cg::grid_group grid = cg::this_grid();
    LAS unsigned char* lds = (LAS unsigned char*)lds_raw;
    volatile LAS unsigned* bst = (volatile LAS unsigned*)(lds + 148480);
    if (opaque_tid() < 2) bst[opaque_tid()] = 0u;
    __syncthreads();
    const XcdBarrier xbar = xcd_barrier_post((unsigned*)(WSP + WS_BAR), bst);
#define GSYNC() xcd_barrier(xbar)
    ph_prologue(lds);                                                                                   GSYNC();
    if (WSP == nullptr) grid.sync();
    ph_retin(lds); ph_conv<1>(lds);                                                                                      GSYNC();
    ph_retention(lds);                                                                                  GSYNC();
    ph_groupnorm();                                                                                     GSYNC();
    ph_res_gemm<true, TP>(lds, BIGP + PJ_G * 2, WS_WRO, 4096, 4096, (bf16_t*)(OUTP + OUT_KP), 0); ph_sample_res<true>(BIGP + (PJ_G + (size_t)TP * 4096) * 2, 4096, WS_WRO, 4096, (bf16_t*)(OUTP + OUT_KP), 0);   GSYNC();
    ph_gateup(lds, (const unsigned char*)(OUTP + OUT_KP), WS_WGU0, 0); ph_conv<2>(lds);                                  GSYNC();
    ph_res_gemm<false, TP>(lds, BIGP + BIG_ACT, WS_WDN0, DFF, DFF, (bf16_t*)(BIGP + BIG_XN), 1); ph_sample_res(BIGP + BIG_ACT + (size_t)TP * DFF * 2, DFF, WS_WDN0, DFF, (bf16_t*)(BIGP + BIG_XN), 1); ph_cache_cvt();   GSYNC();
    ph_kvfq(lds); ph_conv<3>(lds);                                                                                       GSYNC();
    ph_cumsum(lds);                                                                                     GSYNC();
    ph_attn(lds_raw); __syncthreads(); ph_sattn(lds);                                                   GSYNC();
    ph_res_gemm<false, TP>(lds, BIGP + BIG_XN, WS_WO, DM, DM, (bf16_t*)(BIGP + BIG_HKV), 2); ph_sample_res(BIGP + BIG_XN + (size_t)TP * DM * 2, DM, WS_WO, DM, (bf16_t*)(BIGP + BIG_HKV), 2);   GSYNC();
    ph_gateup(lds, BIGP + BIG_HKV, WS_WGU1, 2); ph_conv<4>(lds);                                                         GSYNC();
    ph_res_gemm<false, TP, true>(lds, BIGP + BIG_ACT, WS_WDN1, DFF, DFF, (bf16_t*)(BIGP + BIG_XN), 3); ph_sample_res<false, true>(BIGP + BIG_ACT + (size_t)TP * DFF * 2, DFF, WS_WDN1, DFF, (bf16_t*)(BIGP + BIG_XN), 3);   GSYNC();
    ph_final();
}

extern "C" void kernel_launch(void* const* d_in, const int* in_sizes, int n_in, void* d_out, int out_size, void* d_ws, size_t ws_size, hipStream_t stream) {
    static int grid = 0;
    if (grid == 0) {
        if (n_in != 21 || ws_size < WS_END) { fprintf(stderr, "kernel_launch: unexpected n_in %d / ws_size %zu (need %zu)\n", n_in, ws_size, (size_t)WS_END); grid = -1; return; }
        int dev = 0, cus = 0, per_cu = 0;
        (void)hipGetDevice(&dev); (void)hipDeviceGetAttribute(&cus, hipDeviceAttributeMultiprocessorCount, dev);
        if (hipFuncSetAttribute((const void*)yoco_fwd, hipFuncAttributeMaxDynamicSharedMemorySize, LDS_BYTES) != hipSuccess) { fprintf(stderr, "kernel_launch: hipFuncSetAttribute failed\n"); grid = -1; return; }
        if (hipOccupancyMaxActiveBlocksPerMultiprocessor(&per_cu, (const void*)yoco_fwd, NWAVES * 64, LDS_BYTES) != hipSuccess || per_cu < 1) { fprintf(stderr, "kernel_launch: occupancy query says %d\n", per_cu); per_cu = 1; }
        (void)hipGetLastError();
        grid = cus > 0 ? cus : 256;
    }
    if (grid < 0) return;
    if (hipMemsetAsync((char*)d_ws + WS_BAR, 0, XCD_BAR_WORDS * 4, stream) != hipSuccess) { fprintf(stderr, "kernel_launch: memset of the barrier words failed\n"); return; }
    Params p{};
    for (int i = 0; i < 21; ++i) p.in[i] = (const float*)d_in[i];
    p.out = (float*)d_out; p.ws = (unsigned char*)d_ws;
    void* args[] = {&p};
    hipError_t e = hipLaunchCooperativeKernel((const void*)yoco_fwd, dim3(grid), dim3(NWAVES * 64), args, LDS_BYTES, stream);
    if (e != hipSuccess) fprintf(stderr, "cooperative launch failed: %s (grid %d)\n", hipGetErrorString(e), grid);
}
```

```cpp
#include <hip/hip_runtime.h>
#include <hip/hip_cooperative_groups.h>
#include <cstdio>
#include <cstdint>
namespace cg = cooperative_groups;
__device__ __forceinline__ int opaque_tid() { int t = threadIdx.x; asm volatile("" : "+v"(t)); return t; }
namespace pg8 {
#define PG8_LAS __attribute__((address_space(3)))
typedef unsigned short bf16_t;
typedef short bf16x8 __attribute__((ext_vector_type(8)));
typedef float f32x4 __attribute__((ext_vector_type(4)));
typedef unsigned u32x4 __attribute__((ext_vector_type(4)));
constexpr int BM = 256, BK = 64, HALF = 128, HTB = HALF * BK * 2  , STAGE_BYTES = 8 * HTB, NXCD = 8, WGM = 4;

__host__ __device__ __forceinline__ int lds_byte(int r, int c) { const int st = (r >> 4) * 2 + (c >> 5), rr = r & 15, cc = c & 31, ob = rr * 64 + cc * 2; return st * 1024 + (ob ^ (((ob >> 9) & 1) << 5)); }
__host__ __device__ __forceinline__ void stage_rc(int b, int& R, int& C) { const int st = b / 1024, sb = b % 1024, swz = sb ^ (((sb >> 9) & 1) << 5); R = (st >> 1) * 16 + swz / 64; C = (st & 1) * 32 + (swz % 64) / 2; }
__host__ __device__ __forceinline__ int perm32(int rho) { const int n = rho >> 4, i = rho & 15; return 8 * (i >> 2) + 4 * n + (i & 3); }

struct Unit { int pm, pn; };
struct Gemm { const bf16_t* A; const bf16_t* Bt; int M, N, K, lda; };

struct StaticOrder {
    int nM, nN, nwg, G, c;
    __host__ __device__ void init(int M, int N, int G_, int c_) { nM = M / BM; nN = N / BM; nwg = nM * nN; G = G_; c = c_; }
    __host__ __device__ bool next(int i, Unit& u) const {
        const long L = (long)i * G + c; if (L >= nwg) return false;
        int wgid = (int)L; { const int q = nwg / NXCD, r = nwg % NXCD, xcd = wgid % NXCD, off = wgid / NXCD; wgid = (xcd < r ? xcd * (q + 1) : r * (q + 1) + (xcd - r) * q) + off; }
        const int nig = WGM * nN, gid = wgid / nig, fm = gid * WGM, gsz = (nM - fm) < WGM ? (nM - fm) : WGM;
        u.pm = fm + ((wgid % nig) % gsz); u.pn = (wgid % nig) / gsz; return true;
    }
    __device__ __forceinline__ void a_ready(const Unit&) const {}
    __device__ __forceinline__ void done(const Unit&) const {}
};

__device__ __forceinline__ unsigned cvt_pk_bf16(float lo, float hi) { unsigned r; asm volatile("v_cvt_pk_bf16_f32 %0, %1, %2" : "=v"(r) : "v"(lo), "v"(hi)); return r; }
template <class Epi, class Sched, bool ALIGN_EPI = false, bool SP2 = false>
__device__ __forceinline__ void gemm_phase(PG8_LAS unsigned char* lds, const Gemm g, const Sched& S, const Epi& E) {
    const int tid = opaque_tid(), wid = __builtin_amdgcn_readfirstlane(tid >> 6), lane = tid & 63, wr = wid >> 2, wc = wid & 3, fr = lane & 15, fq = lane >> 4;
    const int K = g.K, nt = K / BK;
    unsigned voffA[2], voffB[2];
#pragma unroll
    for (int i = 0; i < 2; ++i) { int R, C; stage_rc(tid * 16 + i * 8192, R, C); const int Rb = Epi::PERM ? ((R & ~31) + perm32(R & 31)) : R;
        voffA[i] = (unsigned)(R * g.lda + C) * 2u; voffB[i] = (unsigned)(Rb * K + C) * 2u; }
    const size_t kstep = (size_t)(BK * 2);
    const size_t hstep = (size_t)HALF * K * 2, hstepA = (size_t)HALF * g.lda * 2;
    const size_t tstep = 2 * hstep, tstepA = 2 * hstepA;
    const unsigned ldsw = (unsigned)wid * 1024u;
    const int aoff = lds_byte(wr * 64 + fr, fq * 8), boff = lds_byte(wc * 32 + fr, fq * 8);
#define PG8_SA(b, h) (((b) * 2 + (h)) * HTB)
#define PG8_SB(b, h) ((4 + (b) * 2 + (h)) * HTB)
#define PG8_STAGE(bufoff, gbase, voff) do { _Pragma("unroll") for (int _i = 0; _i < 2; ++_i) \
        __builtin_amdgcn_global_load_lds((const unsigned*)((const char*)(gbase) + (voff)[_i]), (PG8_LAS unsigned*)(lds + (bufoff) + ldsw + _i * 8192), 16, 0, 0); } while (0)
#define PG8_LDA(dst, b, h) do { _Pragma("unroll") for (int m = 0; m < 4; ++m) _Pragma("unroll") for (int k = 0; k < 2; ++k) dst[m][k] = *(const PG8_LAS bf16x8*)(lds + PG8_SA(b, h) + aoff + m * 2048 + k * 1024); } while (0)
#define PG8_LDB(dst, b, h) do { _Pragma("unroll") for (int n = 0; n < 2; ++n) _Pragma("unroll") for (int k = 0; k < 2; ++k) dst[n][k] = *(const PG8_LAS bf16x8*)(lds + PG8_SB(b, h) + boff + n * 2048 + k * 1024); } while (0)
#define PG8_MMA(ai, bj, At, Bt) do { __builtin_amdgcn_s_setprio(1); _Pragma("unroll") for (int m = 0; m < 4; ++m) _Pragma("unroll") for (int n = 0; n < 2; ++n) _Pragma("unroll") for (int k = 0; k < 2; ++k) \
        acc[ai][bj][m][n] = __builtin_amdgcn_mfma_f32_16x16x32_bf16(Bt[n][k], At[m][k], acc[ai][bj][m][n], 0, 0, 0); __builtin_amdgcn_s_setprio(0); } while (0)
#define PG8_WAIT_V(n) asm volatile("s_waitcnt vmcnt(" #n ")" ::: "memory")
#define PG8_WAIT_L(n) asm volatile("s_waitcnt lgkmcnt(" #n ")" ::: "memory")
#define PG8_BAR __builtin_amdgcn_s_barrier()
#define PG8_SCHED __builtin_amdgcn_sched_barrier(0)
    Unit cur, nxt; int ui = 0;
    if (!S.next(0, cur)) return;
    f32x4 acc[2][2][4][2];
#pragma unroll
    for (int a = 0; a < 2; ++a)
#pragma unroll
        for (int b = 0; b < 2; ++b)
#pragma unroll
            for (int m = 0; m < 4; ++m)
#pragma unroll
                for (int n = 0; n < 2; ++n) acc[a][b][m][n] = (f32x4){0.f, 0.f, 0.f, 0.f};
    bf16x8 At[4][2], B0[2][2], B1[2][2];
    const char* cA = (const char*)g.A + (size_t)cur.pm * tstepA; const char* cB = (const char*)g.Bt + (size_t)cur.pn * tstep;
    S.a_ready(cur);
    if constexpr (SP2) {
        PG8_STAGE(PG8_SB(0, 0), cB, voffB); PG8_STAGE(PG8_SB(0, 1), cB + hstep, voffB); PG8_STAGE(PG8_SA(0, 0), cA, voffA); PG8_STAGE(PG8_SA(0, 1), cA + hstepA, voffA);
        if (wr == 1) PG8_BAR;
        PG8_WAIT_V(2); PG8_BAR;
        PG8_STAGE(PG8_SB(1, 0), cB + kstep, voffB); PG8_STAGE(PG8_SA(1, 0), cA + kstep, voffA); PG8_STAGE(PG8_SB(1, 1), cB + hstep + kstep, voffB);
        PG8_WAIT_V(6); PG8_BAR;
    } else {
        PG8_STAGE(PG8_SB(0, 0), cB, voffB); PG8_STAGE(PG8_SA(0, 0), cA, voffA); PG8_STAGE(PG8_SB(0, 1), cB + hstep, voffB); PG8_STAGE(PG8_SA(0, 1), cA + hstepA, voffA);
        if (wr == 1) PG8_BAR;
        PG8_WAIT_V(4); PG8_BAR;
        PG8_STAGE(PG8_SB(1, 0), cB + kstep, voffB); PG8_STAGE(PG8_SA(1, 0), cA + kstep, voffA); PG8_STAGE(PG8_SB(1, 1), cB + hstep + kstep, voffB);
        PG8_WAIT_V(6); PG8_BAR;
    }
    for (;;) {
        const bool has_next = S.next(ui + 1, nxt);
        const char* nA = has_next ? (const char*)g.A + (size_t)nxt.pm * tstepA : cA; const char* nB = has_next ? (const char*)g.Bt + (size_t)nxt.pn * tstep : cB;
        for (int t = 0; t < nt; t += 2) {
            const bool last = (t == nt - 2);
            const char* a1 = cA + (size_t)(t + 1) * kstep;
            const char* a2 = last ? nA : cA + (size_t)(t + 2) * kstep; const char* b2 = last ? nB : cB + (size_t)(t + 2) * kstep;
            const char* a3 = a2 + kstep; const char* b3 = b2 + kstep;
            if (last && has_next) S.a_ready(nxt);
            if constexpr (SP2) {
            PG8_LDB(B0, 0, 0); PG8_LDB(B1, 0, 1); PG8_SCHED; PG8_LDA(At, 0, 0); PG8_STAGE(PG8_SA(1, 1), a1 + hstepA, voffA);
            PG8_WAIT_V(8); PG8_WAIT_L(0); PG8_BAR; PG8_MMA(0, 0, At, B0); PG8_MMA(0, 1, At, B1); PG8_BAR; PG8_SCHED;
            PG8_LDA(At, 0, 1); PG8_STAGE(PG8_SB(0, 0), b2, voffB); PG8_STAGE(PG8_SB(0, 1), b2 + hstep, voffB); PG8_STAGE(PG8_SA(0, 0), a2, voffA);
            PG8_WAIT_V(8); PG8_WAIT_L(0); PG8_BAR; PG8_MMA(1, 0, At, B0); PG8_MMA(1, 1, At, B1); PG8_BAR; PG8_SCHED;
            PG8_LDB(B0, 1, 0); PG8_LDB(B1, 1, 1); PG8_SCHED; PG8_LDA(At, 1, 0); PG8_STAGE(PG8_SA(0, 1), a2 + hstepA, voffA);
            PG8_WAIT_V(8); PG8_WAIT_L(0); PG8_BAR; PG8_MMA(0, 0, At, B0); PG8_MMA(0, 1, At, B1); PG8_BAR; PG8_SCHED;
            PG8_LDA(At, 1, 1); PG8_STAGE(PG8_SB(1, 0), b3, voffB); PG8_STAGE(PG8_SB(1, 1), b3 + hstep, voffB); PG8_STAGE(PG8_SA(1, 0), a3, voffA);
            PG8_WAIT_V(8); PG8_WAIT_L(0); PG8_BAR; PG8_MMA(1, 0, At, B0); PG8_MMA(1, 1, At, B1); PG8_BAR; PG8_SCHED;
            } else {
            PG8_LDB(B0, 0, 0); PG8_SCHED; PG8_LDA(At, 0, 0); PG8_STAGE(PG8_SA(1, 1), a1 + hstepA, voffA);
            PG8_WAIT_L(8); PG8_BAR; PG8_WAIT_L(0); PG8_MMA(0, 0, At, B0); PG8_BAR; PG8_SCHED;
            PG8_LDB(B1, 0, 1); PG8_STAGE(PG8_SB(0, 0), b2, voffB);
            PG8_BAR; PG8_WAIT_L(0); PG8_MMA(0, 1, At, B1); PG8_BAR;
            PG8_LDA(At, 0, 1); PG8_STAGE(PG8_SA(0, 0), a2, voffA);
            PG8_BAR; PG8_WAIT_L(0); PG8_MMA(1, 0, At, B0); PG8_BAR; PG8_SCHED;
            PG8_STAGE(PG8_SB(0, 1), b2 + hstep, voffB);
            PG8_WAIT_V(6); PG8_BAR; PG8_MMA(1, 1, At, B1); PG8_BAR;
            PG8_LDB(B0, 1, 0); PG8_SCHED; PG8_LDA(At, 1, 0); PG8_STAGE(PG8_SA(0, 1), a2 + hstepA, voffA);
            PG8_WAIT_L(8); PG8_BAR; PG8_WAIT_L(0); PG8_MMA(0, 0, At, B0); PG8_BAR; PG8_SCHED;
            PG8_LDB(B1, 1, 1); PG8_STAGE(PG8_SB(1, 0), b3, voffB);
            PG8_BAR; PG8_WAIT_L(0); PG8_MMA(0, 1, At, B1); PG8_BAR;
            PG8_LDA(At, 1, 1); PG8_STAGE(PG8_SA(1, 0), a3, voffA);
            PG8_BAR; PG8_WAIT_L(0); PG8_MMA(1, 0, At, B0); PG8_BAR; PG8_SCHED;
            PG8_STAGE(PG8_SB(1, 1), b3 + hstep, voffB);
            PG8_WAIT_V(6); PG8_BAR; PG8_MMA(1, 1, At, B1); PG8_BAR;
            }
        }
        if constexpr (ALIGN_EPI) { if (wr == 0) PG8_BAR; }
        if constexpr (!Epi::AFTER_DRAIN) { E(acc, cur, wr, wc, fr, fq); S.done(cur); }
        if (!has_next) break;
#pragma unroll
        for (int a = 0; a < 2; ++a)
#pragma unroll
            for (int b = 0; b < 2; ++b)
#pragma unroll
                for (int m = 0; m < 4; ++m)
#pragma unroll
                    for (int n = 0; n < 2; ++n) acc[a][b][m][n] = (f32x4){0.f, 0.f, 0.f, 0.f};
        cur = nxt; cA = nA; cB = nB; ++ui;
        if constexpr (ALIGN_EPI) { if (wr == 1) PG8_BAR; }
    }
    PG8_WAIT_V(0);
    if constexpr (!ALIGN_EPI) { if (wr == 0) PG8_BAR; }
    PG8_BAR;
    if constexpr (Epi::AFTER_DRAIN) { E.fused(acc, cur, wr, wc, fr, fq, lds, wid, lane); S.done(cur); }
#undef PG8_SA
#undef PG8_SB
#undef PG8_STAGE
#undef PG8_LDA
#undef PG8_LDB
#undef PG8_MMA
#undef PG8_WAIT_V
#undef PG8_WAIT_L
#undef PG8_BAR
#undef PG8_SCHED
}
}
constexpr int DM = 2048, TP = 32768, TSMP = 256, TALL = 33024, SEQ = 8192, NPROJ = 12288, DFF = 5632, PASTL = 1024, LKS = 1056;
constexpr size_t PJ_Q = 0, PJ_K = (size_t)TALL * 2048, PJ_V = (size_t)TALL * 4096, PJ_G = (size_t)TALL * 8192;
__device__ __forceinline__ size_t hrow(int row, int h) { return row < TP ? ((size_t)((row >> 13) * 8 + h) << 13) + (row & 8191) : (size_t)262144 + (size_t)((((row - TP) >> 5) * 8 + h) << 5) + ((row - TP) & 31); }
#define GAS __attribute__((address_space(1)))
#define LAS __attribute__((address_space(3)))
typedef unsigned short bf16_t;
typedef float f32x4 __attribute__((ext_vector_type(4)));
typedef unsigned u32x4 __attribute__((ext_vector_type(4)));
typedef unsigned u32x2 __attribute__((ext_vector_type(2)));
typedef short bf16x8 __attribute__((ext_vector_type(8)));
typedef short s16x4 __attribute__((ext_vector_type(4)));

namespace pg8 {
__device__ __forceinline__ float silu_f(float g) { return g * __builtin_amdgcn_rcpf(1.0f + __builtin_amdgcn_exp2f(-1.4426950408889634f * g)); }
struct EpiBf16P {
    static constexpr bool PERM = true, AFTER_DRAIN = false;
    bf16_t* O; int ldc;
    __device__ __forceinline__ void operator()(const f32x4 (&acc)[2][2][4][2], const Unit& u, int wr, int wc, int fr, int fq) const {
        const int row0 = u.pm * BM + wr * 64 + fr, col0 = u.pn * BM + wc * 32 + 8 * fq;
#pragma unroll
        for (int ai = 0; ai < 2; ++ai)
#pragma unroll
            for (int m = 0; m < 4; ++m) { bf16_t* rowp = O + (size_t)(row0 + ai * HALF + m * 16) * ldc + col0;
#pragma unroll
                for (int bj = 0; bj < 2; ++bj) { const f32x4 v0 = acc[ai][bj][m][0], v1 = acc[ai][bj][m][1];
                    u32x4 w; w.x = cvt_pk_bf16(v0[0], v0[1]); w.y = cvt_pk_bf16(v0[2], v0[3]); w.z = cvt_pk_bf16(v1[0], v1[1]); w.w = cvt_pk_bf16(v1[2], v1[3]);
                    *(u32x4*)(rowp + bj * HALF) = w; } }
    }
};
struct EpiRetIn {
    static constexpr bool PERM = true, AFTER_DRAIN = false;
    bf16_t* O; const float* cosT; const float* sinT;
    __device__ __forceinline__ void operator()(const f32x4 (&acc)[2][2][4][2], const Unit& u, int wr, int wc, int fr, int fq) const {
        const int row0 = u.pm * BM + wr * 64 + fr, cl = wc * 32 + 8 * fq;
        if (u.pn < 16) {
            const bool isk = u.pn >= 8; const int h = u.pn & 7;
            const float lg2 = __log2f(1.0f - exp2f(-5.0f - (float)h));
#pragma unroll
            for (int ai = 0; ai < 2; ++ai) {
                f32x4 cs[4][4]; float scv[4];
#pragma unroll
                for (int m = 0; m < 4; ++m) {
                    const int row = row0 + ai * HALF + m * 16; int pos, l;
                    if (row < TP) { pos = row & (SEQ - 1); l = row & 63; } else { const int s = (row - TP) & 31; pos = PASTL + s; l = s; }
                    scv[m] = isk ? exp2f(-lg2 * (float)l) * 0.0625f : exp2f(lg2 * (float)l);
                    const float* cp = cosT + (size_t)pos * 128 + cl; const float* sp = sinT + (size_t)pos * 128 + cl;
                    cs[m][0] = *(const f32x4*)cp; cs[m][1] = *(const f32x4*)(cp + 4); cs[m][2] = *(const f32x4*)sp; cs[m][3] = *(const f32x4*)(sp + 4); }
#pragma unroll
                for (int m = 0; m < 4; ++m) {
                    const int row = row0 + ai * HALF + m * 16; const float sc = scv[m];
                    const f32x4 c0 = cs[m][0], c1 = cs[m][1], s0 = cs[m][2], s1 = cs[m][3];
                    const f32x4 x1a = acc[ai][0][m][0], x1b = acc[ai][0][m][1], x2a = acc[ai][1][m][0], x2b = acc[ai][1][m][1];
                    const f32x4 o1a = (x1a * c0 - x2a * s0) * sc, o1b = (x1b * c1 - x2b * s1) * sc, o2a = (x1a * s0 + x2a * c0) * sc, o2b = (x1b * s1 + x2b * c1) * sc;
                    bf16_t* rowp = O + (isk ? PJ_K : PJ_Q) + hrow(row, h) * 256 + cl;
                    u32x4 w; w.x = cvt_pk_bf16(o1a[0], o1a[1]); w.y = cvt_pk_bf16(o1a[2], o1a[3]); w.z = cvt_pk_bf16(o1b[0], o1b[1]); w.w = cvt_pk_bf16(o1b[2], o1b[3]);
                    *(u32x4*)rowp = w;
                    w.x = cvt_pk_bf16(o2a[0], o2a[1]); w.y = cvt_pk_bf16(o2a[2], o2a[3]); w.z = cvt_pk_bf16(o2b[0], o2b[1]); w.w = cvt_pk_bf16(o2b[2], o2b[3]);
                    *(u32x4*)(rowp + HALF) = w; }
                asm volatile("" ::: "memory"); }
        } else {
            const bool isv = u.pn < 32; const int hv = (u.pn - 16) >> 1, e0 = ((u.pn - 16) & 1) * 256 + cl;
#pragma unroll
            for (int ai = 0; ai < 2; ++ai)
#pragma unroll
                for (int m = 0; m < 4; ++m) { const int row = row0 + ai * HALF + m * 16;
                    bf16_t* rowp = isv ? O + PJ_V + hrow(row, hv) * 512 + e0 : O + PJ_G + (size_t)row * 4096 + (u.pn - 32) * BM + cl;
#pragma unroll
                    for (int bj = 0; bj < 2; ++bj) { const f32x4 v0 = acc[ai][bj][m][0], v1 = acc[ai][bj][m][1];
                        u32x4 w; w.x = cvt_pk_bf16(v0[0], v0[1]); w.y = cvt_pk_bf16(v0[2], v0[3]); w.z = cvt_pk_bf16(v1[0], v1[1]); w.w = cvt_pk_bf16(v1[2], v1[3]);
                        *(u32x4*)(rowp + bj * HALF) = w; } }
        }
    }
};
template <bool BASEBF> struct EpiRes {
    static constexpr bool PERM = false, AFTER_DRAIN = false;
    const float* baseP; const float* baseS; const bf16_t* baseH; bf16_t* hb; float* ssq;
    __device__ __forceinline__ void operator()(const f32x4 (&acc)[2][2][4][2], const Unit& u, int wr, int wc, int fr, int fq) const {
        const int row0 = u.pm * BM + wr * 64 + fr, col0 = u.pn * BM + wc * 32 + 4 * fq;
#pragma unroll
        for (int ai = 0; ai < 2; ++ai) {
            f32x4 bv[4][2][2];
#pragma unroll
            for (int m = 0; m < 4; ++m) { const int row = row0 + ai * HALF + m * 16;
                if (BASEBF) { const bf16_t* b = baseH + (size_t)row * DM + col0;
#pragma unroll
                    for (int bj = 0; bj < 2; ++bj)
#pragma unroll
                        for (int n = 0; n < 2; ++n) { const u32x2 t = *(const u32x2*)(b + bj * HALF + n * 16);
                            bv[m][bj][n] = (f32x4){__uint_as_float(t.x << 16), __uint_as_float(t.x & 0xffff0000u), __uint_as_float(t.y << 16), __uint_as_float(t.y & 0xffff0000u)}; } }
                else { const float* b = (row < TP ? baseP + (size_t)row * DM : baseS + (size_t)(row - TP) * DM) + col0;
#pragma unroll
                    for (int bj = 0; bj < 2; ++bj)
#pragma unroll
                        for (int n = 0; n < 2; ++n) bv[m][bj][n] = *(const f32x4*)(b + bj * HALF + n * 16); } }
#pragma unroll
            for (int m = 0; m < 4; ++m) { const int row = row0 + ai * HALF + m * 16; float ss = 0.f;
#pragma unroll
                for (int bj = 0; bj < 2; ++bj)
#pragma unroll
                    for (int n = 0; n < 2; ++n) { const f32x4 v = bv[m][bj][n] + acc[ai][bj][m][n];
                        u32x2 w; w.x = cvt_pk_bf16(v[0], v[1]); w.y = cvt_pk_bf16(v[2], v[3]); *(u32x2*)(hb + (size_t)row * DM + col0 + bj * HALF + n * 16) = w;
                        ss += (v[0] * v[0] + v[1] * v[1]) + (v[2] * v[2] + v[3] * v[3]); }
                ss += __shfl_xor(ss, 16); ss += __shfl_xor(ss, 32);
                if (fq == 0) (void)__hip_atomic_fetch_add(ssq + row, ss, __ATOMIC_RELAXED, __HIP_MEMORY_SCOPE_AGENT); }
            asm volatile("" ::: "memory"); }
    }
};
struct EpiSwiglu {
    static constexpr bool PERM = true, AFTER_DRAIN = false;
    bf16_t* O; const float* ssq;
    __device__ __forceinline__ void operator()(const f32x4 (&acc)[2][2][4][2], const Unit& u, int wr, int wc, int fr, int fq) const {
        const int row0 = u.pm * BM + wr * 64 + fr, col0 = u.pn * HALF + wc * 32 + 8 * fq;
        float rs[2][4];
#pragma unroll
        for (int ai = 0; ai < 2; ++ai)
#pragma unroll
            for (int m = 0; m < 4; ++m) rs[ai][m] = ssq[row0 + ai * HALF + m * 16];
#pragma unroll
        for (int ai = 0; ai < 2; ++ai)
#pragma unroll
            for (int m = 0; m < 4; ++m) { bf16_t* rowp = O + (size_t)(row0 + ai * HALF + m * 16) * DFF + col0; const float r = 1.0f / sqrtf(rs[ai][m] * (1.f / DM) + 1e-6f);
                const f32x4 g0 = acc[ai][0][m][0] * r, g1 = acc[ai][0][m][1] * r, u0 = acc[ai][1][m][0] * r, u1 = acc[ai][1][m][1] * r;
                f32x4 a0, a1;
#pragma unroll
                for (int j = 0; j < 4; ++j) { a0[j] = silu_f(g0[j]) * u0[j]; a1[j] = silu_f(g1[j]) * u1[j]; }
                u32x4 w; w.x = cvt_pk_bf16(a0[0], a0[1]); w.y = cvt_pk_bf16(a0[2], a0[3]); w.z = cvt_pk_bf16(a1[0], a1[1]); w.w = cvt_pk_bf16(a1[2], a1[3]);
                *(u32x4*)rowp = w; }
    }
};
struct EpiKVFQ {
    static constexpr bool PERM = false, AFTER_DRAIN = false;
    float* kP; float* vP; float* lfP; float* kS; float* vS; float* lfS; bf16_t* KB; bf16_t* VB; bf16_t* KALL; bf16_t* VALL; bf16_t* QB; const float* bf; const float* ssq;
    __device__ __forceinline__ void operator()(const f32x4 (&acc)[2][2][4][2], const Unit& u, int wr, int wc, int fr, int fq) const {
        const int row0 = u.pm * BM + wr * 64 + fr;
        float rs[2][4];
#pragma unroll
        for (int ai = 0; ai < 2; ++ai)
#pragma unroll
            for (int m = 0; m < 4; ++m) rs[ai][m] = 1.0f / sqrtf(ssq[row0 + ai * HALF + m * 16] * (1.f / DM) + 1e-6f);
        if (u.pn >= 5) {
            const int col0 = (u.pn - 5) * BM + wc * 32 + 4 * fq;
#pragma unroll
            for (int ai = 0; ai < 2; ++ai)
#pragma unroll
                for (int m = 0; m < 4; ++m) { bf16_t* bo = QB + (size_t)(row0 + ai * HALF + m * 16) * DM + col0;
#pragma unroll
                    for (int bj = 0; bj < 2; ++bj)
#pragma unroll
                        for (int n = 0; n < 2; ++n) { const f32x4 v = acc[ai][bj][m][n] * rs[ai][m]; u32x2 w; w.x = cvt_pk_bf16(v[0], v[1]); w.y = cvt_pk_bf16(v[2], v[3]); *(u32x2*)(bo + bj * HALF + n * 16) = w; } }
        } else if (u.pn < 4) {
            const bool isv = u.pn >= 2; const int col0 = (u.pn & 1) * BM + wc * 32 + 4 * fq;
            float* fP = isv ? vP : kP; float* fS = isv ? vS : kS; bf16_t* bP = isv ? VB : KB; bf16_t* bA = isv ? VALL : KALL;
#pragma unroll
            for (int ai = 0; ai < 2; ++ai)
#pragma unroll
                for (int m = 0; m < 4; ++m) { const int row = row0 + ai * HALF + m * 16; float* fo; bf16_t* bo;
                    if (row < TP) { fo = fP + (size_t)row * 512 + col0; bo = bP + (size_t)row * 512 + col0; }
                    else { const int r2 = row - TP; fo = fS + (size_t)r2 * 512 + col0; bo = bA + ((size_t)(r2 >> 5) * LKS + PASTL + (r2 & 31)) * 512 + col0; }
#pragma unroll
                    for (int bj = 0; bj < 2; ++bj)
#pragma unroll
                        for (int n = 0; n < 2; ++n) { const f32x4 v = acc[ai][bj][m][n] * rs[ai][m]; *(f32x4*)(fo + bj * HALF + n * 16) = v;
                            u32x2 w; w.x = cvt_pk_bf16(v[0], v[1]); w.y = cvt_pk_bf16(v[2], v[3]); *(u32x2*)(bo + bj * HALF + n * 16) = w; } }
        } else if (wc == 0) {
            const f32x4 bb = *(const f32x4*)(bf + 4 * fq);
#pragma unroll
            for (int ai = 0; ai < 2; ++ai)
#pragma unroll
                for (int m = 0; m < 4; ++m) { const int row = row0 + ai * HALF + m * 16; const f32x4 z = acc[ai][0][m][0] * rs[ai][m] + bb; f32x4 r;
#pragma unroll
                    for (int j = 0; j < 4; ++j) r[j] = fminf(z[j], 0.f) - log1pf(__expf(-fabsf(z[j])));
                    float* o = row < TP ? lfP + (size_t)row * 16 : lfS + (size_t)(row - TP) * 16; *(f32x4*)(o + 4 * fq) = r; }
        }
    }
};
}
namespace fox {
enum { ORDER_NATURAL = 0, ORDER_REVERSED = 1, ORDER_PAIRED = 2, ORDER_XCD = 4 };
constexpr int D = 128, QS = 2048, KS = 512, OS = 2048;
constexpr float THR = 8.f;
constexpr bool WSKIP = false;
constexpr float SCALE = 0.08838834764831845f;
constexpr int NW = 8, QBLK = 32, KVBLK = 64, QB = NW * QBLK;
constexpr int SHM_V = KVBLK * D * 2, SHM_K = KVBLK * D * 2;
constexpr int LDS_BYTES = 2 * SHM_V + 2 * SHM_K + NW * 64 * 4 + 2 * 64 * 4;
typedef unsigned short bf16;
typedef short bf16x8 __attribute__((ext_vector_type(8)));
typedef short s16x4 __attribute__((ext_vector_type(4)));
typedef float f32x16 __attribute__((ext_vector_type(16)));
typedef float f32x4 __attribute__((ext_vector_type(4)));
typedef unsigned u32x4 __attribute__((ext_vector_type(4)));
template <class A, class Bt> struct same_t { static constexpr bool v = false; };
template <class A> struct same_t<A, A> { static constexpr bool v = true; };

#define KSWZ(row, colB) ((row) * 256 + ((colB) ^ (((row) & 7) << 4)))
#define SBAR() __builtin_amdgcn_sched_barrier(0)
__device__ __forceinline__ int v_st(int k, int c) { const int kk = (k & ~0xC) | ((k & 4) << 1) | ((k & 8) >> 1); return ((kk >> 3) * 4 + (c >> 5)) * 512 + ((kk & 7) * 32 + (c & 31)) * 2; }
__device__ __forceinline__ int v_rd_base(int lane) { return ((lane & 3) << 3) | (((lane >> 2) & 3) << 6) | (((lane >> 4) & 1) << 5) | (((lane >> 5) & 1) << 8); }
constexpr int v_rd_off(int d0, int ks, int half) { return d0 * 512 + ks * 4096 + half * 2048; }
__device__ __forceinline__ int crow(int r, int hi) { return (r & 3) + 8 * (r >> 2) + 4 * hi; }
__device__ __forceinline__ unsigned cvtpk(float lo, float hi) {
    unsigned r; asm volatile("v_cvt_pk_bf16_f32 %0, %1, %2" : "=v"(r) : "v"(lo), "v"(hi)); return r;
}
__device__ __forceinline__ bf16x8 pack8(f32x4 a, f32x4 b) {
    u32x4 w = {cvtpk(a[0], a[1]), cvtpk(a[2], a[3]), cvtpk(b[0], b[1]), cvtpk(b[2], b[3])};
    return *reinterpret_cast<bf16x8*>(&w);
}
template <class T> __device__ __forceinline__ bf16x8 load8(const T* p) {
    if constexpr (same_t<T, float>::v) { return pack8(*(const f32x4*)p, *(const f32x4*)(p + 4)); }
    else { return *reinterpret_cast<const bf16x8*>(p); }
}
__device__ __forceinline__ void mask_tile(f32x16& p0, f32x16& p1, int dq, unsigned W) {
    const float NEG = -__builtin_inff();
#pragma unroll
    for (int r = 0; r < 16; ++r) {
        const int c = (r & 3) + 8 * (r >> 2);
        if ((unsigned)(dq - c) >= W) p0[r] = NEG;
        if ((unsigned)(dq - c - 32) >= W) p1[r] = NEG;
    }
}
__device__ __forceinline__ void partialSM(f32x16& p0, f32x16& p1, float& m_reg, float& mn, float& alpha) {
    float pmax = p0[0]; for (int r = 1; r < 16; ++r) pmax = fmaxf(pmax, p0[r]); for (int r = 0; r < 16; ++r) pmax = fmaxf(pmax, p1[r]);
    { auto rr = __builtin_amdgcn_permlane32_swap(__float_as_uint(pmax), __float_as_uint(pmax), false, false);
      pmax = fmaxf(__uint_as_float(rr[0]), __uint_as_float(rr[1])); }
    constexpr float C2 = 1.4426950408889634f * SCALE;
    if (__builtin_expect(__all((pmax - m_reg) * SCALE <= THR), 1)) { mn = m_reg; alpha = 1.f; }
    else { mn = fmaxf(m_reg, pmax); alpha = __builtin_amdgcn_exp2f((m_reg - mn) * C2); m_reg = mn; }
    const float mnL = -mn * C2;
    for (int r = 0; r < 16; ++r) p0[r] = fmaf(p0[r], C2, mnL); for (int r = 0; r < 16; ++r) p1[r] = fmaf(p1[r], C2, mnL);
    for (int r = 0; r < 16; ++r) p0[r] = __builtin_amdgcn_exp2f(p0[r]);
}
__device__ __forceinline__ void finishSM(f32x16& p0, f32x16& p1, float alpha, float& l_reg, bf16x8& pa0, bf16x8& pa1, bf16x8& pa2, bf16x8& pa3) {
    for (int r = 0; r < 16; ++r) p1[r] = __builtin_amdgcn_exp2f(p1[r]);
    float ps = 0; for (int r = 0; r < 16; ++r) ps += p0[r]; for (int r = 0; r < 16; ++r) ps += p1[r];
    { auto rr = __builtin_amdgcn_permlane32_swap(__float_as_uint(ps), __float_as_uint(ps), false, false);
      ps = __uint_as_float(rr[0]) + __uint_as_float(rr[1]); }
    l_reg = l_reg * alpha + ps;
#define PK4(P, B_, OUT) do { unsigned a0 = cvtpk(P[B_+0], P[B_+1]), a1 = cvtpk(P[B_+2], P[B_+3]);                          \
        unsigned b0 = cvtpk(P[B_+4], P[B_+5]), b1 = cvtpk(P[B_+6], P[B_+7]);                                             \
        auto r0 = __builtin_amdgcn_permlane32_swap(a0, b0, false, false); auto r1 = __builtin_amdgcn_permlane32_swap(a1, b1, false, false); \
        u32x4 w = {r0[0], r1[0], r0[1], r1[1]}; OUT = *reinterpret_cast<bf16x8*>(&w); } while (0)
    PK4(p0, 0, pa0); PK4(p0, 8, pa1); PK4(p1, 0, pa2); PK4(p1, 8, pa3);
#undef PK4
}
template <int KB, bool SK>
__device__ __forceinline__ void qkt(f32x16& p0, f32x16& p1, const char* K_lds, int r32, int hi, const bf16x8* qr, bool act) {
    if (SK && !act) { const float NEG = -__builtin_inff();
#pragma unroll
        for (int r = 0; r < 16; ++r) { p0[r] = NEG; p1[r] = NEG; } return; }
    { const float* bb_ = (const float*)(K_lds + 2 * SHM_K + NW * 64 * 4) + KB * 64 + 4 * hi;
#pragma unroll
      for (int q_ = 0; q_ < 4; ++q_) { const f32x4 b0_ = *(const f32x4*)(bb_ + 8 * q_), b1_ = *(const f32x4*)(bb_ + 32 + 8 * q_);
#pragma unroll
        for (int i_ = 0; i_ < 4; ++i_) { p0[4 * q_ + i_] = b0_[i_]; p1[4 * q_ + i_] = b1_[i_]; } } }
    const char* kb[4];
#pragma unroll
    for (int dd = 0; dd < 4; ++dd) kb[dd] = K_lds + KB * SHM_K + KSWZ(r32, (dd * 16 + hi * 8) * 2);
#pragma unroll
    for (int d0 = 0; d0 < 8; ++d0) { const char* a = kb[d0 & 3] + (d0 >> 2) * 128;
        bf16x8 b0 = *reinterpret_cast<const bf16x8*>(a);
        bf16x8 b1 = *reinterpret_cast<const bf16x8*>(a + 32 * 256);
        p0 = __builtin_amdgcn_mfma_f32_32x32x16_bf16(b0, qr[d0], p0, 0, 0, 0);
        p1 = __builtin_amdgcn_mfma_f32_32x32x16_bf16(b1, qr[d0], p1, 0, 0, 0); }
}
template <int VB, bool SK>
__device__ __forceinline__ void pv_tile(f32x16* o, int vb0, bf16x8 pa0, bf16x8 pa1, bf16x8 pa2, bf16x8 pa3, bool act) {
    if (SK && !act) return;
#define TRRD(dst, off) asm volatile("ds_read_b64_tr_b16 %0, %1 offset:%2" : "=&v"(dst) : "v"(vb0), "i"(off) : "memory")
#define PV_D0(d0) do { s16x4 l0, l1, l2, l3, h0, h1, h2, h3; constexpr int b_ = VB * SHM_V + v_rd_off(d0, 0, 0);     \
        TRRD(l0, b_); TRRD(h0, b_ + 2048); TRRD(l1, b_ + 4096); TRRD(h1, b_ + 6144); TRRD(l2, b_ + 8192); TRRD(h2, b_ + 10240); TRRD(l3, b_ + 12288); TRRD(h3, b_ + 14336); \
        asm volatile("s_waitcnt lgkmcnt(0)" ::: "memory"); SBAR();                 \
        o[d0] = __builtin_amdgcn_mfma_f32_32x32x16_bf16(pa0, (bf16x8){l0[0], l0[1], l0[2], l0[3], h0[0], h0[1], h0[2], h0[3]}, o[d0], 0, 0, 0);   \
        o[d0] = __builtin_amdgcn_mfma_f32_32x32x16_bf16(pa1, (bf16x8){l1[0], l1[1], l1[2], l1[3], h1[0], h1[1], h1[2], h1[3]}, o[d0], 0, 0, 0);   \
        o[d0] = __builtin_amdgcn_mfma_f32_32x32x16_bf16(pa2, (bf16x8){l2[0], l2[1], l2[2], l2[3], h2[0], h2[1], h2[2], h2[3]}, o[d0], 0, 0, 0);   \
        o[d0] = __builtin_amdgcn_mfma_f32_32x32x16_bf16(pa3, (bf16x8){l3[0], l3[1], l3[2], l3[3], h3[0], h3[1], h3[2], h3[3]}, o[d0], 0, 0, 0); } while (0)
    PV_D0(0); PV_D0(1); PV_D0(2); PV_D0(3);
#undef PV_D0
#undef TRRD
}
template <class TIn, class TOut> struct BlockRef { const TIn* Q; const TIn* K; const TIn* V; TOut* O; const float* FB; int P0; };
template <class TIn> struct Seam {
    bf16x8 qr[8];
    bf16x8 st_v0, st_v1, st_k0, st_k1; float st_f; f32x4 sf0, sf1, sf2, sf3;
    f32x4 tq[16];
};
__device__ __forceinline__ int swa_jlo(int P0, int W) { const int lowk = P0 - W + 1; return lowk > 0 ? lowk / KVBLK : 0; }
#define ROW(p, k0, rr) ((p) + (size_t)((k0) + (rr)) * KS + sc)
#define VMW() asm volatile("s_waitcnt vmcnt(0)" ::: "memory")
#define VMWN(n) asm volatile("s_waitcnt vmcnt(%0)" :: "i"(n) : "memory")
#define SLOAD_H(Kp, Vp, Fp, k0) do { S.st_f = (Fp)[(k0) + (tid & 63)]; S.st_v0 = load8<TIn>(ROW(Vp, k0, sr)); S.st_v1 = load8<TIn>(ROW(Vp, k0, 32 + sr));              \
                         S.st_k0 = load8<TIn>(ROW(Kp, k0, sr)); S.st_k1 = load8<TIn>(ROW(Kp, k0, 32 + sr)); } while (0)
#define SWRITE_HK(bf) do { ((float*)(K_lds + 2 * SHM_K + NW * 64 * 4))[(bf) * 64 + (tid & 63)] = S.st_f; *(bf16x8*)(K_lds + (bf) * SHM_K + kws) = S.st_k0; *(bf16x8*)(K_lds + (bf) * SHM_K + kws + 32 * 256) = S.st_k1; } while (0)
#define SWRITE_HV(bf) do { *(bf16x8*)(V_lds + (bf) * SHM_V + vst0) = S.st_v0; *(bf16x8*)(V_lds + (bf) * SHM_V + vst1) = S.st_v1; } while (0)
#define SWRITE_H(bf) do { SWRITE_HV(bf); SWRITE_HK(bf); } while (0)
#define SLOAD_F(p, k0) do { S.sf0 = *(const f32x4*)ROW(p, k0, sr); S.sf1 = *(const f32x4*)(ROW(p, k0, sr) + 4);                \
                            S.sf2 = *(const f32x4*)ROW(p, k0, 32 + sr); S.sf3 = *(const f32x4*)(ROW(p, k0, 32 + sr) + 4); } while (0)
#define SWRITE_KF(bf) do { *(bf16x8*)(K_lds + (bf) * SHM_K + kws) = pack8(S.sf0, S.sf1); *(bf16x8*)(K_lds + (bf) * SHM_K + kws + 32 * 256) = pack8(S.sf2, S.sf3); } while (0)
#define SWRITE_VF(bf) do { *(bf16x8*)(V_lds + (bf) * SHM_V + vst0) = pack8(S.sf0, S.sf1); *(bf16x8*)(V_lds + (bf) * SHM_V + vst1) = pack8(S.sf2, S.sf3); } while (0)
template <class TIn, class TOut>
__device__ __forceinline__ void causal_swa_prime(const BlockRef<TIn, TOut>& cur, int W, char* lds, Seam<TIn>& S) {
    constexpr bool F32 = same_t<TIn, float>::v;
    const int tid = opaque_tid(), wid = __builtin_amdgcn_readfirstlane(tid >> 6), lane = tid & 63, r32 = lane & 31, hi = lane >> 5;
    const int sr = tid >> 4, sc = (tid & 15) * 8, kws = KSWZ(sr, sc * 2); char* K_lds = lds + 2 * SHM_V;
    const int kb0 = swa_jlo(cur.P0, W) * KVBLK;
    for (int d0 = 0; d0 < 8; ++d0) S.qr[d0] = load8<TIn>(cur.Q + (size_t)(wid * QBLK + r32) * QS + d0 * 16 + hi * 8);
    if constexpr (F32) { SLOAD_F((const float*)cur.K, kb0); VMW(); SWRITE_KF(0); SBAR(); SLOAD_F((const float*)cur.V, kb0); }
    else { SLOAD_H(cur.K, cur.V, cur.FB, kb0); VMW(); SWRITE_HK(0); }
    __syncthreads();
}
template <class TIn, class TOut>
__device__ __forceinline__ void causal_swa_block(const BlockRef<TIn, TOut>& cur, const BlockRef<TIn, TOut>& nxt, int skv, int W, char* lds, Seam<TIn>& S) {
    constexpr bool F32 = same_t<TIn, float>::v;
    const int tid = opaque_tid(), wid = __builtin_amdgcn_readfirstlane(tid >> 6), lane = tid & 63, r32 = lane & 31, hi = lane >> 5;
    const int j_lo = swa_jlo(cur.P0, W);
    int j_hi = (cur.P0 + QB - 1) / KVBLK + 1; if (j_hi > skv / KVBLK) j_hi = skv / KVBLK;
    const int NT = j_hi - j_lo;
    const int kbn = swa_jlo(nxt.P0, W) * KVBLK;
    const int qlo = cur.P0 + wid * QBLK, qm = qlo + r32 - 4 * hi;
    char* V_lds = lds; char* K_lds = lds + 2 * SHM_V;
    float* ws = (float*)(lds + 2 * SHM_V + 2 * SHM_K) + wid * 64; float* li_l = ws, * al_l = ws + 32;
    float m_reg = -1e30f, l_reg = 0; f32x16 o[4] = {};
    const int sr = tid >> 4, sc = (tid & 15) * 8, vst0 = v_st(sr, sc), vst1 = v_st(32 + sr, sc), kws = KSWZ(sr, sc * 2);
    const int vb0 = (int)(uintptr_t)V_lds + v_rd_base(lane);
    const TIn* Kh = cur.K; const TIn* Vh = cur.V;
#define RESC(a) do { if (__any((a) < 1.f)) { if (hi == 0) al_l[r32] = (a); asm volatile("s_waitcnt lgkmcnt(0)" ::: "memory");              \
                     for (int d_ = 0; d_ < 4; ++d_) for (int r = 0; r < 16; ++r) o[d_][r] *= al_l[crow(r, hi)]; } } while (0)
#define KBASE(t) ((j_lo + (t)) * KVBLK)
#define ACT(t) (KBASE(t) <= qlo + QBLK - 1 && KBASE(t) + KVBLK - 1 >= qlo - W + 1)
#define MASKT(P0_, P1_, t) do { const int kb_ = KBASE(t); if ((!SK || ACT(t)) && (kb_ + KVBLK - 1 > qlo || kb_ <= qlo + QBLK - 1 - W)) mask_tile(P0_, P1_, qm - kb_, (unsigned)W); } while (0)
    constexpr int NQL = F32 ? 16 : 8;
    constexpr bool SK = WSKIP && !F32;
#define SEAM_K0() do { VMWN(NQL); if constexpr (F32) { SWRITE_KF(0); SBAR(); SLOAD_F((const float*)nxt.V, kbn); } else { SWRITE_HK(0); } SBAR(); } while (0)
    f32x16 pA0, pA1, pB0, pB1; float mnA, mnB, alA, alB; bf16x8 pa0, pa1, pa2, pa3;
    if constexpr (F32) { VMW(); SWRITE_VF(0); SBAR(); } else { SWRITE_HV(0); SBAR(); }
    if (NT > 1) { if constexpr (F32) SLOAD_F((const float*)Kh, KBASE(1)); else SLOAD_H(Kh, Vh, cur.FB, KBASE(1)); }
    SBAR(); qkt<0, SK>(pA0, pA1, K_lds, r32, hi, S.qr, ACT(0));
    if constexpr (F32) { if (NT > 1) { VMW(); SWRITE_KF(1); SBAR(); SLOAD_F((const float*)Vh, KBASE(1)); } }
    MASKT(pA0, pA1, 0); partialSM(pA0, pA1, m_reg, mnA, alA);
    if (NT > 1) { VMW(); if constexpr (F32) { SWRITE_VF(1); SBAR(); if (NT > 2) SLOAD_F((const float*)Kh, KBASE(2)); } else SWRITE_H(1); }
    __syncthreads();
#define HALF_STEP(PX0, PX1, mnX, alX, PY0, PY1, alY, t, KB, VB, SB) do {                                                      \
        SBAR(); qkt<KB, SK>(PX0, PX1, K_lds, r32, hi, S.qr, ACT(t));                                             \
        finishSM(PY0, PY1, alY, l_reg, pa0, pa1, pa2, pa3); SBAR();                                                           \
        if ((t) + 1 < NT) { if constexpr (F32) { VMW(); SWRITE_KF(SB); SBAR(); SLOAD_F((const float*)Vh, KBASE((t) + 1)); }  \
                            else { SLOAD_H(Kh, Vh, cur.FB, KBASE((t) + 1)); } SBAR(); }                                               \
        pv_tile<VB, SK>(o, vb0, pa0, pa1, pa2, pa3, ACT((t) - 1)); MASKT(PX0, PX1, (t)); partialSM(PX0, PX1, m_reg, mnX, alX);                                        \
        __syncthreads();                                                                                                      \
        if ((t) + 1 < NT) { VMW(); if constexpr (F32) { SWRITE_VF(SB); SBAR(); if ((t) + 2 < NT) SLOAD_F((const float*)Kh, KBASE((t) + 2)); } \
                            else { SWRITE_H(SB); } }                                                                          \
        RESC(alX); __syncthreads(); } while (0)
    for (int t = 1; t + 1 < NT; t += 2) {
        HALF_STEP(pB0, pB1, mnB, alB, pA0, pA1, alA, t, 1, 0, 0);
        HALF_STEP(pA0, pA1, mnA, alA, pB0, pB1, alB, t + 1, 0, 1, 1);
    }
    const bool even = (NT & 1) == 0;
    if (even) { SBAR(); qkt<1, SK>(pB0, pB1, K_lds, r32, hi, S.qr, ACT(NT - 1)); SBAR(); }
#define QROW(e) (nxt.Q + (size_t)(wid * QBLK + r32) * D + ((e) >> 1) * 16 + hi * 8 + ((e) & 1) * 4)
    if constexpr (F32) { SLOAD_F((const float*)nxt.K, kbn); SBAR();
#pragma unroll
        for (int e = 0; e < 8; ++e) S.tq[e] = *(const f32x4*)QROW(e); }
    else { SLOAD_H(nxt.K, nxt.V, nxt.FB, kbn); SBAR();
#pragma unroll
        for (int d0 = 0; d0 < 8; ++d0) S.qr[d0] = load8<TIn>(nxt.Q + (size_t)(wid * QBLK + r32) * QS + d0 * 16 + hi * 8); }
    SBAR();
    finishSM(pA0, pA1, alA, l_reg, pa0, pa1, pa2, pa3); SBAR();
    if constexpr (F32) {
#pragma unroll
        for (int e = 8; e < 16; ++e) S.tq[e] = *(const f32x4*)QROW(e); SBAR(); }
#undef QROW
    pv_tile<0, SK>(o, vb0, pa0, pa1, pa2, pa3, ACT(even ? NT - 2 : NT - 1));
    if (even) { MASKT(pB0, pB1, NT - 1); partialSM(pB0, pB1, m_reg, mnB, alB); __syncthreads(); RESC(alB);
        finishSM(pB0, pB1, alB, l_reg, pa0, pa1, pa2, pa3); SBAR(); pv_tile<1, SK>(o, vb0, pa0, pa1, pa2, pa3, ACT(NT - 1)); }
    SBAR(); SEAM_K0();
    if (hi == 0) li_l[r32] = l_reg; asm volatile("s_waitcnt lgkmcnt(0)" ::: "memory");
    float rli[16];
#pragma unroll
    for (int r = 0; r < 16; ++r) rli[r] = __builtin_amdgcn_rcpf(li_l[crow(r, hi)]);
    TOut* Ow = cur.O + (size_t)(wid * QBLK) * OS;
#pragma unroll
    for (int r = 0; r < 16; ++r) { const int orow = crow(r, hi);
#pragma unroll
        for (int d0 = 0; d0 < 4; ++d0) { const float v = o[d0][r] * rli[r];
            if constexpr (same_t<TOut, float>::v) { Ow[(size_t)orow * OS + d0 * 32 + r32] = v; }
            else { const float vn = __shfl_xor(v, 1);
                   if ((r32 & 1) == 0) *(unsigned*)(Ow + (size_t)orow * OS + d0 * 32 + r32) = cvtpk(v, vn); } } }
    if constexpr (F32) {
#pragma unroll
        for (int d0 = 0; d0 < 8; ++d0) S.qr[d0] = pack8(S.tq[2 * d0], S.tq[2 * d0 + 1]); }
    __syncthreads();
#undef RESC
#undef KBASE
#undef ACT
#undef MASKT
#undef SEAM_K0
#undef HALF_STEP
}
#undef ROW
#undef VMW
#undef VMWN
#undef SLOAD_H
#undef SWRITE_HK
#undef SWRITE_HV
#undef SWRITE_H
#undef SLOAD_F
#undef SWRITE_KF
#undef SWRITE_VF

__host__ __device__ inline int swa_nramp(int nqb, int W, int qoff) { const int t = W - 1 - qoff; const int n = t < 0 ? 0 : t / QB + 1; return n > nqb ? nqb : n; }
__host__ __device__ inline int swa_nx(int nqb, int nramp, int order) { return (order & ORDER_PAIRED) ? (nramp + 1) / 2 + (nqb - nramp) : nqb; }
struct SwaItem { int bh, qb0, qb1; };
__device__ __forceinline__ SwaItem swa_decode(int L, int nb, int nh, int nhkv, int nqb, int nx, int nramp, int order) {
    const int G = nh / nhkv; SwaItem it; int x;
    if ((order & ORDER_XCD) && (nb * nhkv) % 8 == 0) { const int xcd = L & 7, k = L >> 3, per = G * nx, gi = k / per, r = k - gi * per;
        it.bh = (gi * 8 + xcd) * G + r / nx; x = r % nx; }
    else { it.bh = L / nx; x = L - it.bh * nx; }
    if (order & ORDER_PAIRED) { const int ns = nqb - nramp;
        if (x < ns) { it.qb0 = it.qb1 = nqb - 1 - x; } else { it.qb0 = x - ns; it.qb1 = nramp - 1 - it.qb0; } }
    else { it.qb0 = it.qb1 = ((order & 3) == ORDER_REVERSED) ? nqb - 1 - x : x; }
    return it;
}
typedef unsigned short bf16;
__device__ __forceinline__ BlockRef<bf16, bf16> mk_ref(const SwaItem& it, int pass, const bf16* Q, const bf16* K, const bf16* V, bf16* O, const float* FB) {
    const int qb = pass ? it.qb1 : it.qb0, b = it.bh >> 4, h = it.bh & 15, kvh = h >> 2;
    BlockRef<bf16, bf16> r;
    r.Q = Q + ((size_t)b * 8192 + (size_t)qb * QB) * QS + h * 128; r.O = O + ((size_t)b * 8192 + (size_t)qb * QB) * OS + h * 128;
    r.K = K + (size_t)b * 8192 * KS + kvh * 128; r.V = V + (size_t)b * 8192 * KS + kvh * 128; r.FB = FB + (size_t)it.bh * 8192; r.P0 = qb * QB;
    return r;
}
__device__ __forceinline__ void attn_phase(char* lds, const bf16* Q, const bf16* K, const bf16* V, bf16* O, const float* FB) {
    constexpr int nb = 4, nh = 16, nhkv = 4, nqb = 32, W = 8192, order = ORDER_PAIRED | ORDER_XCD;
    const int nramp = swa_nramp(nqb, W, 0), nx = swa_nx(nqb, nramp, order), total = nx * nb * nh, stride = gridDim.x;
    int L = blockIdx.x; if (L >= total) return;
    SwaItem it = swa_decode(L, nb, nh, nhkv, nqb, nx, nramp, order); int pass = 0;
    BlockRef<bf16, bf16> cur = mk_ref(it, 0, Q, K, V, O, FB);
    Seam<bf16> S;
    causal_swa_prime<bf16, bf16>(cur, W, lds, S);
    for (;;) {
        const bool more_pass = pass == 0 && it.qb1 != it.qb0, more_item = L + stride < total, last = !more_pass && !more_item;
        SwaItem itn = it; int passn = pass + 1, Ln = L;
        if (!more_pass) { passn = 0; Ln = more_item ? L + stride : L; itn = swa_decode(Ln, nb, nh, nhkv, nqb, nx, nramp, order); }
        const BlockRef<bf16, bf16> nxt = last ? cur : mk_ref(itn, passn, Q, K, V, O, FB);
        causal_swa_block<bf16, bf16>(cur, nxt, 8192, W, lds, S);
        if (last) break;
        cur = nxt; it = itn; pass = passn; L = Ln;
    }
}
}
constexpr size_t WS_WIN = 0, WS_WRO = 50331648, WS_WGU0 = 67108864, WS_WGU1 = 113246208, WS_WDN0 = 159383552, WS_WDN1 = 182452224,
                 WS_WO = 205520896, WS_WKVF = 213909504  , WS_COS = 227540992, WS_SIN = 231735296, WS_FB = 235929600, WS_FS = WS_FB + 2097152,
                 WS_BIG = 239075328;
constexpr size_t SZ_ROWS2K = (size_t)TALL * DM * 2;
constexpr size_t BIG_XN = 0, BIG_ACT = SZ_ROWS2K, BIG_HKV = BIG_ACT + (size_t)TALL * DFF * 2, BIG_KB = BIG_HKV + SZ_ROWS2K, BIG_VB = BIG_KB + (size_t)TP * 512 * 2,
                 BIG_KALL = BIG_VB + (size_t)TP * 512 * 2, BIG_VALL = BIG_KALL + (size_t)8 * LKS * 512 * 2, BIG_END = BIG_VALL + (size_t)8 * LKS * 512 * 2;
static_assert(BIG_END <= (size_t)TALL * NPROJ * 2, "layer-1 buffers fit in the PROJ region");
constexpr size_t WS_SSQ = WS_BIG + (size_t)TALL * NPROJ * 2  , WS_BAR = WS_SSQ + (size_t)4 * TALL * 4  , WS_END = WS_BAR + 16384;
static_assert(WS_FS + 540672 <= WS_BIG && WS_BAR % 256 == 0, "small arrays end before the big region");
static_assert(WS_END <= (size_t)1073741824, "workspace fits 1 GiB");
constexpr size_t OUT_Y = 0, OUT_SP = 67633152, OUT_KP = 71827456, OUT_VP = 88604672, OUT_LFP = 105381888, OUT_SS = 105906176, OUT_KS = 114294784, OUT_VS = 114425856, OUT_LFS = 114556928;
constexpr int NWAVES = 8, LDS_BYTES = 149504;

struct Params { const float* in[21]; float* out; unsigned char* ws; };

__device__ __forceinline__ float wave_sum(float v) {
#pragma unroll
    for (int o = 1; o < 64; o <<= 1) v += __shfl_xor(v, o);
    return v;
}
__device__ __forceinline__ float bf2f(unsigned short b) { return __uint_as_float(((unsigned)b) << 16); }
__device__ __forceinline__ unsigned pk2(float lo, float hi) { return pg8::cvt_pk_bf16(lo, hi); }

__device__ __forceinline__ void transpose_item(const float* W, int K, int N, bf16_t* WT, int k0, int n0, int drow0, LAS float* scr, int lane, const float* gain = nullptr) {
    float wv[32];
#pragma unroll
    for (int i = 0; i < 32; ++i) { const int kk = 2 * i + (lane >> 5); wv[i] = W[(size_t)(k0 + kk) * N + n0 + (lane & 31)] * (gain ? gain[k0 + kk] : 1.f); }
#pragma unroll
    for (int i = 0; i < 32; ++i) { const int kk = 2 * i + (lane >> 5); scr[kk * 33 + (lane & 31)] = wv[i]; }
    asm volatile("s_waitcnt lgkmcnt(0)" ::: "memory");
    const int c = lane & 7;
#pragma unroll
    for (int j = 0; j < 4; ++j) { const int n = (lane >> 3) + 8 * j; const LAS float* s = scr + (8 * c) * 33 + n;
        u32x4 o; o.x = pk2(s[0 * 33], s[1 * 33]); o.y = pk2(s[2 * 33], s[3 * 33]); o.z = pk2(s[4 * 33], s[5 * 33]); o.w = pk2(s[6 * 33], s[7 * 33]);
        *(u32x4*)(WT + (size_t)(drow0 + n) * K + k0 + 8 * c) = o; }
    asm volatile("s_waitcnt lgkmcnt(0)" ::: "memory");
}
__device__ __forceinline__ void tr_plain(const float* W, int K, int N, bf16_t* WT, int row_off, LAS float* scr, int item, int lane, const float* gain = nullptr) {
    const int nblk = N / 32, kb = item / nblk, nb = item % nblk; transpose_item(W, K, N, WT, 64 * kb, 32 * nb, row_off + 32 * nb, scr, lane, gain);
}
__device__ __forceinline__ void tr_gu(const float* W, bf16_t* WT, int up, LAS float* scr, int item, int lane, const float* gain) {
    const int nblk = DFF / 32, kb = item / nblk, nb = item % nblk, n0 = 32 * nb; transpose_item(W, DM, DFF, WT, 64 * kb, n0, (n0 >> 7) * 256 + up * 128 + (n0 & 127), scr, lane, gain);
}
template <int MODE  >
__device__ __forceinline__ void rms_row(const float* xrow, const float* g1, bf16_t* o1, const float* g2, bf16_t* o2, float* of, int lane) {
    const f32x4* xr = (const f32x4*)xrow + lane;
    f32x4 v[8]; float s = 0.f;
#pragma unroll
    for (int j = 0; j < 8; ++j) { v[j] = xr[64 * j]; s += (v[j].x * v[j].x + v[j].y * v[j].y) + (v[j].z * v[j].z + v[j].w * v[j].w); }
    const float rs = 1.0f / sqrtf(wave_sum(s) * (1.f / DM) + 1e-6f);
#pragma unroll
    for (int j = 0; j < 8; ++j) { const f32x4 ga = ((const f32x4*)g1)[64 * j + lane]; const f32x4 y = v[j] * rs;
        if (MODE == 2) { ((f32x4*)of)[64 * j + lane] = y * ga; }
        else { u32x2 w; w.x = pk2(y.x * ga.x, y.y * ga.y); w.y = pk2(y.z * ga.z, y.w * ga.w); ((u32x2*)o1)[64 * j + lane] = w;
            if (MODE == 1) { const f32x4 gb = ((const f32x4*)g2)[64 * j + lane]; u32x2 w2; w2.x = pk2(y.x * gb.x, y.y * gb.y); w2.y = pk2(y.z * gb.z, y.w * gb.w); ((u32x2*)o2)[64 * j + lane] = w2; } } }
}

namespace ret {
constexpr int KOFF = 0, STOFF = 32768, VOFF = 65536, POFF = 74752, VS = 144;
typedef short v4i16_t __attribute__((ext_vector_type(4)));
__device__ __forceinline__ bf16x8 frag_rm(const LAS char* base, int stride, int i0, int k0, int fr, int fq) { return *(const LAS bf16x8*)(base + (i0 + fr) * stride + (k0 + 8 * fq) * 2); }
__device__ __forceinline__ bf16x8 frag_sw(const LAS char* base, int i0, int k0, int fr, int fq) { return *(const LAS bf16x8*)(base + (i0 + fr) * 512 + ((((k0 >> 3) + fq) ^ fr) << 4)); }
__device__ __forceinline__ s16x4 tr4(const LAS char* p) { return __builtin_bit_cast(s16x4, __builtin_amdgcn_ds_read_tr16_b64_v4i16((LAS v4i16_t*)p)); }
__device__ __forceinline__ bf16x8 frag_tr(const LAS char* base, int stride, int k0, int i0, int fr, int fq) {
    const LAS char* p = base + (k0 + 8 * fq + (fr >> 2)) * stride + (i0 + 4 * (fr & 3)) * 2;
    const s16x4 a = tr4(p), b = tr4(p + 4 * stride);
    return (bf16x8){a[0], a[1], a[2], a[3], b[0], b[1], b[2], b[3]};
}
__device__ __forceinline__ bf16x8 frag_tr_sw(const LAS char* base, int k0, int i0, int fr, int fq) {
    const int m = k0 + 8 * fq + (fr >> 2), d = i0 + 4 * (fr & 3);
    const s16x4 a = tr4(base + m * 512 + ((((d >> 3) ^ (m & 15))) << 4) + (d & 7) * 2), b = tr4(base + (m + 4) * 512 + ((((d >> 3) ^ ((m + 4) & 15))) << 4) + (d & 7) * 2);
    return (bf16x8){a[0], a[1], a[2], a[3], b[0], b[1], b[2], b[3]};
}
#define RET_BAR() do { asm volatile("s_waitcnt lgkmcnt(0)" ::: "memory"); __builtin_amdgcn_s_barrier(); asm volatile("" ::: "memory"); } while (0)
#define MFMA16(X, Y, C) __builtin_amdgcn_mfma_f32_16x16x32_bf16(X, Y, C, 0, 0, 0)
__device__ __forceinline__ void ret_item(LAS char* lds, const bf16_t* proj, size_t hr0  , bf16_t* oh  , int nchunks, int c, int h, int es, const float* S0, float* Sout) {
    const int tid = opaque_tid(), wid = __builtin_amdgcn_readfirstlane(tid >> 6), lane = tid & 63, fr = lane & 15, fq = lane >> 4, lt = wid >> 1, half = wid & 1;
    const float lg2 = __log2f(1.0f - exp2f(-5.0f - (float)h)), gam = exp2f(lg2), gc1 = exp2f(lg2 * (float)(c - 1));
    f32x4 accT[8];
    const int eT = 16 * lt + fr;
#pragma unroll
    for (int i = 0; i < 8; ++i) { const int d0 = 16 * (8 * half + i) + 4 * fq;
#pragma unroll
        for (int r = 0; r < 4; ++r) accT[i][r] = S0 ? S0[(size_t)(d0 + r) * 512 + es * 64 + eT] : 0.f;
        u32x2 w; w.x = pk2(accT[i][0], accT[i][1]); w.y = pk2(accT[i][2], accT[i][3]); *(LAS u32x2*)(lds + STOFF + eT * 512 + (((d0 >> 3) ^ fr) << 4) + (d0 & 7) * 2) = w; }
    u32x4 rk[4], rv; bf16x8 yq[8];
    const bf16_t* gq = proj + PJ_Q + (hr0 + eT) * 256 + 8 * fq; const bf16_t* gk = proj + PJ_K + hr0 * 256; const bf16_t* gv = proj + PJ_V + hr0 * 512 + es * 64; bf16_t* pout = oh + hr0 * 512 + es * 64;
    const bool qok = eT < c;
#define RET_LOADQ(n) do { _Pragma("unroll") for (int ks = 0; ks < 8; ++ks) yq[ks] = qok ? *(const bf16x8*)(gq + (size_t)(n) * 64 * 256 + 32 * ks) : (bf16x8){0, 0, 0, 0, 0, 0, 0, 0}; } while (0)
#define RET_LOAD(n) do { _Pragma("unroll") for (int i = 0; i < 4; ++i) { const int p = tid + 512 * i, row = p >> 5, ch = p & 31; \
            if (row < c) rk[i] = *(const u32x4*)(gk + (size_t)((n) * 64 + row) * 256 + ch * 8); else rk[i] = (u32x4){0u, 0u, 0u, 0u}; } \
        { const int row = tid >> 3, ch = tid & 7; if (row < c) rv = *(const u32x4*)(gv + (size_t)((n) * 64 + row) * 512 + ch * 8); else rv = (u32x4){0u, 0u, 0u, 0u}; } } while (0)
    RET_LOAD(0); RET_LOADQ(0);
    for (int n = 0; n < nchunks; ++n) {
#pragma unroll
        for (int i = 0; i < 4; ++i) { const int p = tid + 512 * i, row = p >> 5, ch = p & 31; *(LAS u32x4*)(lds + KOFF + row * 512 + ((ch ^ (row & 15)) << 4)) = rk[i]; }
        *(LAS u32x4*)(lds + VOFF + (tid >> 3) * VS + (tid & 7) * 16) = rv;
        if (n + 1 < nchunks) RET_LOAD(n + 1);
        RET_BAR();
        f32x4 accS[2], accC[2];
#pragma unroll
        for (int j = 0; j < 2; ++j) { accS[j] = (f32x4){0.f, 0.f, 0.f, 0.f}; accC[j] = (f32x4){0.f, 0.f, 0.f, 0.f}; }
#pragma unroll
        for (int kb = 0; kb < 8; kb += 2) {
            bf16x8 xk[2][2], xs[2][2];
#pragma unroll
            for (int ks = 0; ks < 2; ++ks)
#pragma unroll
                for (int j = 0; j < 2; ++j) { xk[ks][j] = frag_sw(lds + KOFF, 16 * (2 * half + j), 32 * (kb + ks), fr, fq); xs[ks][j] = frag_sw(lds + STOFF, 16 * (2 * half + j), 32 * (kb + ks), fr, fq); }
            __builtin_amdgcn_sched_barrier(0);
#pragma unroll
            for (int ks = 0; ks < 2; ++ks)
#pragma unroll
                for (int j = 0; j < 2; ++j) { accS[j] = MFMA16(xk[ks][j], yq[kb + ks], accS[j]); accC[j] = MFMA16(xs[ks][j], yq[kb + ks], accC[j]); }
            __builtin_amdgcn_sched_barrier(0);
        }
        if (n + 1 < nchunks) RET_LOADQ(n + 1);
        const int lrow = eT;
#pragma unroll
        for (int j = 0; j < 2; ++j) { const int m0 = 16 * (2 * half + j) + 4 * fq; f32x4 sv = accS[j];
#pragma unroll
            for (int r = 0; r < 4; ++r) sv[r] = (m0 + r <= lrow) ? sv[r] : 0.f;
            u32x2 w; w.x = pk2(sv[0], sv[1]); w.y = pk2(sv[2], sv[3]); *(LAS u32x2*)(lds + POFF + lrow * VS + m0 * 2) = w; }
        RET_BAR();
        f32x4 accO[2];
#pragma unroll
        for (int j = 0; j < 2; ++j) accO[j] = accC[j] * gam;
#pragma unroll
        for (int ks = 0; ks < 2; ++ks) { const int k0 = 32 * ks;
            const bf16x8 yp = frag_rm(lds + POFF, VS, 16 * lt, k0, fr, fq);
#pragma unroll
            for (int j = 0; j < 2; ++j) { const bf16x8 xv = frag_tr(lds + VOFF, VS, k0, 16 * (2 * half + j), fr, fq); accO[j] = MFMA16(xv, yp, accO[j]); } }
        if (lrow < c) {
#pragma unroll
            for (int j = 0; j < 2; ++j) { u32x2 w; w.x = pk2(accO[j][0], accO[j][1]); w.y = pk2(accO[j][2], accO[j][3]);
                *(u32x2*)(pout + (size_t)(n * 64 + lrow) * 512 + 16 * (2 * half + j) + 4 * fq) = w; } }
#pragma unroll
        for (int i = 0; i < 8; ++i) accT[i] = accT[i] * gam;
#pragma unroll
        for (int ks = 0; ks < 2; ++ks) {
            bf16x8 xk[8]; const bf16x8 yv = frag_tr(lds + VOFF, VS, 32 * ks, 16 * lt, fr, fq);
#pragma unroll
            for (int i = 0; i < 8; ++i) xk[i] = frag_tr_sw(lds + KOFF, 32 * ks, 16 * (8 * half + i), fr, fq);
            __builtin_amdgcn_sched_barrier(0);
#pragma unroll
            for (int i = 0; i < 8; ++i) accT[i] = MFMA16(xk[i], yv, accT[i]);
            __builtin_amdgcn_sched_barrier(0);
        }
#pragma unroll
        for (int i = 0; i < 8; ++i) { accT[i] = accT[i] * gc1; const int d0 = 16 * (8 * half + i) + 4 * fq;
            u32x2 w; w.x = pk2(accT[i][0], accT[i][1]); w.y = pk2(accT[i][2], accT[i][3]); *(LAS u32x2*)(lds + STOFF + eT * 512 + (((d0 >> 3) ^ fr) << 4) + (d0 & 7) * 2) = w; }
        RET_BAR();
    }
#undef RET_LOAD
#undef RET_LOADQ
#pragma unroll
    for (int i = 0; i < 8; ++i) { const int d0 = 16 * (8 * half + i) + 4 * fq;
#pragma unroll
        for (int r = 0; r < 4; ++r) Sout[(size_t)(d0 + r) * 512 + es * 64 + eT] = accT[i][r]; }
}
}
__device__ __forceinline__ void sample_attn(LAS char* lds, const bf16_t* QBp, const bf16_t* KALL, const bf16_t* VALL, const float* FS, bf16_t* AO) {
    const int tid = opaque_tid(), wid = __builtin_amdgcn_readfirstlane(tid >> 6), lane = tid & 63;
    LAS float* qf = (LAS float*)(lds + wid * 5120); LAS float* pf = qf + 128;
    const int gw = blockIdx.x * NWAVES + wid, NGW = gridDim.x * NWAVES;
    for (int item = gw; item < 8 * 16 * 32; item += NGW) {
        const int b = item >> 9, h = (item >> 5) & 15, qi = item & 31, kvh = h >> 2, qpos = PASTL + qi, row = TP + b * 32 + qi;
        const bf16_t* q = QBp + (size_t)row * DM + h * 128;
        qf[lane] = bf2f(q[lane]); qf[lane + 64] = bf2f(q[lane + 64]);
        asm volatile("s_waitcnt lgkmcnt(0)" ::: "memory");
        const float* F = FS + (size_t)(b * 16 + h) * LKS; const float Fq = F[qpos];
        const bf16_t* Kb = KALL + (size_t)b * LKS * 512 + kvh * 128; const bf16_t* Vb = VALL + (size_t)b * LKS * 512 + kvh * 128;
        float mx = -1e30f;
#pragma unroll 1
        for (int t = 0; t < 17; ++t) { const int j = lane + 64 * t; float s = -__builtin_inff();
            if (j <= qpos) { const u32x4* kr = (const u32x4*)(Kb + (size_t)j * 512); float a = 0.f; u32x4 kvv[16];
#pragma unroll
                for (int c8 = 0; c8 < 16; ++c8) kvv[c8] = kr[c8];
#pragma unroll
                for (int c8 = 0; c8 < 16; ++c8) { const u32x4 kv = kvv[c8]; const LAS f32x4* qq = (const LAS f32x4*)(qf + 8 * c8); const f32x4 q0 = qq[0], q1 = qq[1];
                    a += __uint_as_float(kv.x << 16) * q0.x + __uint_as_float(kv.x & 0xffff0000u) * q0.y + __uint_as_float(kv.y << 16) * q0.z + __uint_as_float(kv.y & 0xffff0000u) * q0.w
                       + __uint_as_float(kv.z << 16) * q1.x + __uint_as_float(kv.z & 0xffff0000u) * q1.y + __uint_as_float(kv.w << 16) * q1.z + __uint_as_float(kv.w & 0xffff0000u) * q1.w; }
                s = a * 0.08838834764831845f + (Fq - F[j]); }
            pf[j] = s; mx = fmaxf(mx, s); }
#pragma unroll
        for (int o = 1; o < 64; o <<= 1) mx = fmaxf(mx, __shfl_xor(mx, o));
        float sum = 0.f;
#pragma unroll 1
        for (int t = 0; t < 17; ++t) { const float p = __expf(pf[lane + 64 * t] - mx); sum += p; pf[lane + 64 * t] = p; }
        sum = wave_sum(sum);
        asm volatile("s_waitcnt lgkmcnt(0)" ::: "memory");
        float oa[8];
#pragma unroll
        for (int e = 0; e < 8; ++e) oa[e] = 0.f;
        const int kg = lane >> 4, dg = lane & 15;
        for (int j = 0; j < PASTL + 32; j += 32) {
            u32x4 vv[8]; float p[8];
#pragma unroll
            for (int u = 0; u < 8; ++u) { vv[u] = *(const u32x4*)(Vb + (size_t)(j + 4 * u + kg) * 512 + 8 * dg); p[u] = pf[j + 4 * u + kg]; }
#pragma unroll
            for (int u = 0; u < 8; ++u) { const unsigned w4[4] = {vv[u].x, vv[u].y, vv[u].z, vv[u].w};
#pragma unroll
                for (int e = 0; e < 4; ++e) { oa[2 * e] += p[u] * __uint_as_float(w4[e] << 16); oa[2 * e + 1] += p[u] * __uint_as_float(w4[e] & 0xffff0000u); } } }
#pragma unroll
        for (int e = 0; e < 8; ++e) { oa[e] += __shfl_xor(oa[e], 16); oa[e] += __shfl_xor(oa[e], 32); }
        const float inv = 1.0f / sum;
        if (kg == 0) { u32x4 w; w.x = pk2(oa[0] * inv, oa[1] * inv); w.y = pk2(oa[2] * inv, oa[3] * inv); w.z = pk2(oa[4] * inv, oa[5] * inv); w.w = pk2(oa[6] * inv, oa[7] * inv);
            *(u32x4*)(AO + (size_t)row * DM + h * 128 + 8 * dg) = w; }
        asm volatile("s_waitcnt lgkmcnt(0)" ::: "memory");
    }
}

#define XB_TMO      128
#define XB_XCNT(j)  (256  + 64 * (j))
#define XB_XSUB(j)  (1280 + 64 * (j))
#define XB_XGEN(j)  (2304 + 64 * (j))
#define XB_TOP      3328
#define XB_TOPGEN   3392
#define XCD_BAR_WORDS 3456
#define XB_SPIN_CAP (1u << 18)

__device__ __forceinline__ unsigned xb_ld(unsigned* p)              { return __hip_atomic_load(p, __ATOMIC_RELAXED, __HIP_MEMORY_SCOPE_AGENT); }
__device__ __forceinline__ unsigned xb_add(unsigned* p, unsigned v) { return __hip_atomic_fetch_add(p, v, __ATOMIC_RELAXED, __HIP_MEMORY_SCOPE_AGENT); }
__device__ __forceinline__ unsigned xb_xcc_id() { return (unsigned)__builtin_amdgcn_s_getreg((3 << 11) | 20) & 0xFu; }
#define XB_SPIN(cond, bar) do { unsigned _sp = 0; while (cond) { __builtin_amdgcn_s_sleep(1); \
    if ((++_sp & 255u) == 0u) { if (xb_ld(&(bar)[XB_TMO])) break; if (_sp > XB_SPIN_CAP) { atomicAdd(&(bar)[XB_TMO], 1u); break; } } } } while (0)

struct XcdBarrier {
    unsigned* bar; unsigned x;
    volatile LAS unsigned* st;
};

__device__ __forceinline__ XcdBarrier xcd_barrier_post(unsigned* bar, volatile LAS unsigned* st) {
    XcdBarrier b; b.bar = bar; b.x = xb_xcc_id(); b.st = st;
    if (threadIdx.x == 0) (void)xb_add(&bar[XB_XCNT(b.x)], 1u);
    return b;
}
__device__ __forceinline__ void xcd_barrier_complete(unsigned* bar, unsigned x, unsigned& nloc, unsigned& nx) {
    const unsigned G = gridDim.x * gridDim.y * gridDim.z;
    unsigned sum, cnt, mine, sp = 0u;
    for (;;) {
        sum = 0u; cnt = 0u; mine = 0u;
#pragma unroll
        for (unsigned j = 0; j < 16; ++j) { const unsigned c = xb_ld(&bar[XB_XCNT(j)]); sum += c; cnt += (c > 0u) ? 1u : 0u; mine = (j == x) ? c : mine; }
        if (sum == G) break;
        __builtin_amdgcn_s_sleep(1);
        if ((++sp & 255u) == 0u) { if (xb_ld(&bar[XB_TMO])) break; if (sp > XB_SPIN_CAP) { atomicAdd(&bar[XB_TMO], 1u); break; } }
    }
    nloc = mine > 0u ? mine : 1u; nx = cnt > 0u ? cnt : 1u;
}

__device__ __forceinline__ void xcd_barrier(const XcdBarrier& b) {
    asm volatile("s_waitcnt vmcnt(0)" ::: "memory");
    __syncthreads();
    if (threadIdx.x == 0) {
        unsigned* bar = b.bar;
        __builtin_amdgcn_s_waitcnt(0);
        unsigned nloc = b.st[0], nx = b.st[1];
        if (nloc == 0u) { xcd_barrier_complete(bar, b.x, nloc, nx); b.st[0] = nloc; b.st[1] = nx; }
        const unsigned old = xb_add(&bar[XB_XSUB(b.x)], 1u);
        const unsigned gen = old / nloc;
        if (old + 1u == (gen + 1u) * nloc) {
            __builtin_amdgcn_fence(__ATOMIC_RELEASE, "agent");
            asm volatile("s_waitcnt vmcnt(0)" ::: "memory");
            const unsigned og = xb_add(&bar[XB_TOP], 1u);
            const unsigned tg = og / nx;
            if (og + 1u == (tg + 1u) * nx) xb_add(&bar[XB_TOPGEN], 1u);
            else XB_SPIN(xb_ld(&bar[XB_TOPGEN]) == tg, bar);
            __builtin_amdgcn_fence(__ATOMIC_ACQUIRE, "agent");
            xb_add(&bar[XB_XGEN(b.x)], 1u);
            asm volatile("s_waitcnt vmcnt(0)" ::: "memory");
        } else {
            XB_SPIN(xb_ld(&bar[XB_XGEN(b.x)]) == gen, bar);
            __builtin_amdgcn_fence(__ATOMIC_ACQUIRE, "agent");
            asm volatile("s_waitcnt vmcnt(0)" ::: "memory");
        }
    }
    __syncthreads();
}

#define KARG(i) ((unsigned char*)(__attribute__((address_space(1))) unsigned char*)(((const volatile __attribute__((address_space(4))) unsigned long long*)__builtin_amdgcn_kernarg_segment_ptr())[i]))
#define INF(i) ((const float*)KARG(i))
#define OUTP ((float*)KARG(21))
#define WSP (KARG(22))
#define BIGP (KARG(22) + WS_BIG)
#define PH_IDS const int tid = opaque_tid(), lane = tid & 63, wave = __builtin_amdgcn_readfirstlane(tid >> 6); const int G = gridDim.x, gw = blockIdx.x * NWAVES + wave, NGW = G * NWAVES; const size_t gt = (size_t)blockIdx.x * 512 + tid, NGT = (size_t)G * 512; (void)lane; (void)gw; (void)NGW; (void)gt; (void)NGT

__device__ __forceinline__ void ph_prologue(LAS unsigned char* lds) {
    PH_IDS; unsigned char* ws = WSP;
    bf16_t* WIN = (bf16_t*)(ws + WS_WIN); bf16_t* WKVF = (bf16_t*)(ws + WS_WKVF);
    LAS float* scr = (LAS float*)(lds + wave * 16384);
    constexpr int I0 = 32 * 384;
    for (int it = gw; it < I0; it += NGW) tr_plain(INF(10), DM, NPROJ, WIN, 0, scr, it, lane);
    { const float* wf = INF(14); const float* nkv = INF(8);
      for (size_t i = gt; i < (size_t)256 * DM; i += NGT) { const int r = (int)(i >> 11), k = (int)(i & 2047); WKVF[(size_t)(1024 + r) * DM + k] = r < 16 ? (bf16_t)(pk2(wf[k * 16 + r] * nkv[k], 0.f) & 0xffffu) : (bf16_t)0; }
      float* ssq = (float*)(ws + WS_SSQ); for (size_t i = gt; i < (size_t)4 * TALL; i += NGT) ssq[i] = 0.f; }
    { float* COS = (float*)(ws + WS_COS); float* SIN = (float*)(ws + WS_SIN);
      for (size_t i = gt; i < (size_t)SEQ * 128; i += NGT) { const int pos = (int)(i >> 7), d = (int)(i & 127);
        const float inv = exp2f(-(float)d * (13.287712379549449f / 128.f));
        const double rev = (double)pos * (double)inv * 0.15915494309189535; const float fr = (float)(rev - __builtin_floor(rev));
        COS[i] = __builtin_amdgcn_cosf(fr); SIN[i] = __builtin_amdgcn_sinf(fr); } }
    { const float* x_p = INF(0); const float* x_s = INF(1); const float* nm = INF(6); bf16_t* XN0 = (bf16_t*)OUTP;
      for (int m = gw; m < TALL; m += NGW) rms_row<0>(m < TP ? x_p + (size_t)m * DM : x_s + (size_t)(m - TP) * DM, nm, XN0 + (size_t)m * DM, nullptr, nullptr, nullptr, lane); }
}
template <int JOB> __device__ __forceinline__ void ph_conv(LAS unsigned char* lds) {
    const int tid = opaque_tid(), lane = tid & 63, wave = __builtin_amdgcn_readfirstlane(tid >> 6);
    const int G = gridDim.x, first = G > 160 ? (JOB == 1 ? 48 : JOB == 3 ? 141 : 44) : 0;
    if ((int)blockIdx.x < first) return;
    const int gw = ((int)blockIdx.x - first) * NWAVES + wave, NGW = (G - first) * NWAVES;
    unsigned char* ws = WSP; LAS float* scr = (LAS float*)(lds + wave * 16384);
    constexpr int IG = 32 * 176, ID = 88 * 64, IQ = 32 * 64, IK = 32 * 16;
    if (JOB == 1) {
        bf16_t* WRO = (bf16_t*)(ws + WS_WRO); bf16_t* WGU0 = (bf16_t*)(ws + WS_WGU0);
        for (int it = gw; it < 64 * 64 + 2 * IG; it += NGW) { int r = it;
            if (r < 64 * 64) { tr_plain(INF(11), 4096, DM, WRO, 0, scr, r, lane); continue; } r -= 64 * 64;
            if (r < IG) { tr_gu(INF(18), WGU0, 0, scr, r, lane, INF(7)); continue; } r -= IG;
            tr_gu(INF(19), WGU0, 1, scr, r, lane, INF(7)); }
    } else if (JOB == 2) {
        bf16_t* WDN0 = (bf16_t*)(ws + WS_WDN0); bf16_t* WGU1 = (bf16_t*)(ws + WS_WGU1); bf16_t* WO = (bf16_t*)(ws + WS_WO); bf16_t* WKVF = (bf16_t*)(ws + WS_WKVF);
        for (int it = gw; it < ID + 2 * IQ + 2 * IK + IG; it += NGW) { int r = it;
            if (r < ID) { tr_plain(INF(20), DFF, DM, WDN0, 0, scr, r, lane); continue; } r -= ID;
            if (r < IQ) { tr_plain(INF(16), DM, DM, WKVF, 1280, scr, r, lane, INF(6) + DM); continue; } r -= IQ;
            if (r < IK) { tr_plain(INF(12), DM, 512, WKVF, 0, scr, r, lane, INF(8)); continue; } r -= IK;
            if (r < IK) { tr_plain(INF(13), DM, 512, WKVF, 512, scr, r, lane, INF(8)); continue; } r -= IK;
            if (r < IQ) { tr_plain(INF(17), DM, DM, WO, 0, scr, r, lane); continue; } r -= IQ;
            tr_gu(INF(18) + (size_t)DM * DFF, WGU1, 0, scr, r, lane, INF(7) + DM); }
    } else if (JOB == 3) {
        bf16_t* WGU1 = (bf16_t*)(ws + WS_WGU1);
        for (int it = gw; it < IG; it += NGW) tr_gu(INF(19) + (size_t)DM * DFF, WGU1, 1, scr, it, lane, INF(7) + DM);
    } else {
        bf16_t* WDN1 = (bf16_t*)(ws + WS_WDN1);
        for (int it = gw; it < ID; it += NGW) tr_plain(INF(20) + (size_t)DFF * DM, DFF, DM, WDN1, 0, scr, it, lane);
    }
}
__device__ __forceinline__ void ph_retin(LAS unsigned char* lds) {
    unsigned char* ws = WSP;
    pg8::Gemm g{(const bf16_t*)OUTP, (const bf16_t*)(ws + WS_WIN), TALL, NPROJ, DM, DM}; pg8::StaticOrder S; S.init(TALL, NPROJ, (int)gridDim.x, (int)blockIdx.x);
    pg8::EpiRetIn E{(bf16_t*)(ws + WS_BIG), (const float*)(ws + WS_COS), (const float*)(ws + WS_SIN)};
    pg8::gemm_phase<pg8::EpiRetIn, pg8::StaticOrder, true, true>(lds, g, S, E);
}
__device__ __forceinline__ void ph_retention(LAS unsigned char* lds) {
    const int G = gridDim.x;
    for (int it = blockIdx.x; it < 256; it += G) { const int bh = (it & 7) * 4 + (it >> 6), es = (it >> 3) & 7, b = bh >> 3, h = bh & 7;
        ret::ret_item((LAS char*)lds, (const bf16_t*)BIGP, (size_t)(b * 8 + h) * SEQ, (bf16_t*)OUTP, 128, 64, h, es, nullptr, OUTP + OUT_SP + (size_t)(b * 8 + h) * 256 * 512); }
    for (int it = blockIdx.x; it < 512; it += G) { const int bh = (it & 7) * 8 + (it >> 6), es = (it >> 3) & 7, b = bh >> 3, h = bh & 7;
        ret::ret_item((LAS char*)lds, (const bf16_t*)BIGP, (size_t)262144 + (size_t)(b * 8 + h) * 32, (bf16_t*)OUTP, 1, 32, h, es, INF(2) + (size_t)(b * 8 + h) * 256 * 512, OUTP + OUT_SS + (size_t)(b * 8 + h) * 256 * 512); }
}
__device__ __forceinline__ void ph_groupnorm() {
    PH_IDS; bf16_t* PROJ = (bf16_t*)BIGP; const bf16_t* OB = (const bf16_t*)OUTP;
    for (int it0 = gw * 4; it0 < TALL * 8; it0 += NGW * 4) {
        u32x4 ovv[4], gvv[4];
#pragma unroll
        for (int q = 0; q < 4; ++q) { const int it = it0 + q, row = it >> 3, h = it & 7;
            ovv[q] = *(const u32x4*)(OB + hrow(row, h) * 512 + lane * 8); gvv[q] = *(const u32x4*)(PROJ + PJ_G + (size_t)row * 4096 + h * 512 + lane * 8); }
#pragma unroll
        for (int q = 0; q < 4; ++q) { const int it = it0 + q, row = it >> 3, h = it & 7; const u32x4 ov = ovv[q], gv = gvv[q];
            bf16_t* op = PROJ + PJ_G + (size_t)row * 4096 + h * 512 + lane * 8;
            float o[8], g[8]; const unsigned ow[4] = {ov.x, ov.y, ov.z, ov.w}, gwd[4] = {gv.x, gv.y, gv.z, gv.w};
#pragma unroll
            for (int j = 0; j < 4; ++j) { o[2 * j] = __uint_as_float(ow[j] << 16); o[2 * j + 1] = __uint_as_float(ow[j] & 0xffff0000u); g[2 * j] = __uint_as_float(gwd[j] << 16); g[2 * j + 1] = __uint_as_float(gwd[j] & 0xffff0000u); }
            float s = 0.f;
#pragma unroll
            for (int j = 0; j < 8; ++j) s += o[j];
            const float mu = wave_sum(s) * (1.f / 512.f); float qq = 0.f;
#pragma unroll
            for (int j = 0; j < 8; ++j) { o[j] -= mu; qq += o[j] * o[j]; }
            const float rstd = 1.0f / sqrtf(wave_sum(qq) * (1.f / 512.f) + 1e-5f);
#pragma unroll
            for (int j = 0; j < 8; ++j) o[j] = o[j] * rstd * pg8::silu_f(g[j]);
            u32x4 w; w.x = pk2(o[0], o[1]); w.y = pk2(o[2], o[3]); w.z = pk2(o[4], o[5]); w.w = pk2(o[6], o[7]); *(u32x4*)op = w; } }
}
template <bool FIRST, int MROWS = TALL> __device__ __forceinline__ void ph_res_gemm(LAS unsigned char* lds, unsigned char* a_ptr, size_t w_off, int K, int lda, const bf16_t* base_h, bf16_t* hb, int ssq_idx) {
    unsigned char* ws = WSP;
    pg8::Gemm g{(const bf16_t*)a_ptr, (const bf16_t*)(ws + w_off), MROWS, DM, K, lda}; pg8::StaticOrder S; S.init(MROWS, DM, (int)gridDim.x, (int)blockIdx.x);
    pg8::EpiRes<!FIRST> E{FIRST ? INF(0) : nullptr, FIRST ? INF(1) : nullptr, base_h, hb, (float*)(ws + WS_SSQ) + (size_t)ssq_idx * TALL};
    pg8::gemm_phase<pg8::EpiRes<!FIRST>, pg8::StaticOrder, true, true>(lds, g, S, E);
}
template <bool FIRST = false> __device__ __forceinline__ void ph_sample_res(const unsigned char* a_ptr, int lda, size_t w_off, int K, const bf16_t* base_h, bf16_t* hb, int ssq_idx) {
    const int tid = opaque_tid(), lane = tid & 63, wave = __builtin_amdgcn_readfirstlane(tid >> 6), fr = lane & 15, fq = lane >> 4;
    unsigned char* ws = WSP;
    const bf16_t* A = (const bf16_t*)a_ptr; const bf16_t* Wt = (const bf16_t*)(ws + w_off);
    float* ssq = (float*)(ws + WS_SSQ) + (size_t)ssq_idx * TALL + TP;
    for (int it = blockIdx.x; it < 256; it += gridDim.x) {
        const int n0 = (it >> 1) * 16, row = (it & 1) * 128 + 16 * wave + fr;
        const bf16_t* bp = Wt + (size_t)(n0 + fr) * K + 8 * fq; const bf16_t* ap = A + (size_t)row * lda + 8 * fq;
        f32x4 acc = {0.f, 0.f, 0.f, 0.f};
        bf16x8 bA[8], aA[8], bB[8], aB[8];
#define SR_LOAD(B_, A_, kk) do { _Pragma("unroll") for (int s_ = 0; s_ < 8; ++s_) { B_[s_] = *(const bf16x8*)(bp + (kk) + 32 * s_); A_[s_] = *(const bf16x8*)(ap + (kk) + 32 * s_); } } while (0)
#define SR_MMA(B_, A_) do { _Pragma("unroll") for (int s_ = 0; s_ < 8; ++s_) acc = __builtin_amdgcn_mfma_f32_16x16x32_bf16(B_[s_], A_[s_], acc, 0, 0, 0); } while (0)
        SR_LOAD(bA, aA, 0);
        for (int k0 = 0; k0 < K; k0 += 512) {
            SR_LOAD(bB, aB, k0 + 256);
            SR_MMA(bA, aA);
            if (k0 + 512 < K) SR_LOAD(bA, aA, k0 + 512);
            SR_MMA(bB, aB);
        }
#undef SR_LOAD
#undef SR_MMA
        f32x4 bvv;
        if (FIRST) bvv = *(const f32x4*)(INF(1) + (size_t)row * DM + n0 + 4 * fq);
        else { const u32x2 t = *(const u32x2*)(base_h + (size_t)(TP + row) * DM + n0 + 4 * fq); bvv = (f32x4){__uint_as_float(t.x << 16), __uint_as_float(t.x & 0xffff0000u), __uint_as_float(t.y << 16), __uint_as_float(t.y & 0xffff0000u)}; }
        const f32x4 v = bvv + acc;
        { u32x2 w; w.x = pk2(v[0], v[1]); w.y = pk2(v[2], v[3]); *(u32x2*)(hb + (size_t)(TP + row) * DM + n0 + 4 * fq) = w; }
        { float ss = (v[0] * v[0] + v[1] * v[1]) + (v[2] * v[2] + v[3] * v[3]); ss += __shfl_xor(ss, 16); ss += __shfl_xor(ss, 32);
            if (fq == 0) (void)__hip_atomic_fetch_add(ssq + row, ss, __ATOMIC_RELAXED, __HIP_MEMORY_SCOPE_AGENT); }
    }
}
template <int MODE> __device__ __forceinline__ void ph_rms(const float* g1, size_t o1_off, const float* g2, size_t o2_off) {
    PH_IDS; float* Hres = OUTP + OUT_Y; unsigned char* ws = WSP;
    for (int m = gw; m < TALL; m += NGW) rms_row<MODE>(Hres + (size_t)m * DM, g1, (bf16_t*)(ws + o1_off) + (size_t)m * DM, g2, (bf16_t*)(ws + o2_off) + (size_t)m * DM, Hres + (size_t)m * DM, lane);
}
__device__ __forceinline__ void ph_cache_cvt() {
    PH_IDS; const float* cache_k = INF(3); const float* cache_v = INF(4); bf16_t* KALL = (bf16_t*)(BIGP + BIG_KALL); bf16_t* VALL = (bf16_t*)(BIGP + BIG_VALL);
    for (size_t i = gt; i < (size_t)8 * PASTL * 512 / 4; i += NGT) { const size_t e = i * 4, b = e / ((size_t)PASTL * 512), r = e % ((size_t)PASTL * 512);
        const f32x4 kv = *(const f32x4*)(cache_k + e), vv = *(const f32x4*)(cache_v + e); u32x2 w; w.x = pk2(kv.x, kv.y); w.y = pk2(kv.z, kv.w); *(u32x2*)(KALL + b * LKS * 512 + r) = w;
        w.x = pk2(vv.x, vv.y); w.y = pk2(vv.z, vv.w); *(u32x2*)(VALL + b * LKS * 512 + r) = w; }
}
__device__ __forceinline__ void ph_kvfq(LAS unsigned char* lds) {
    unsigned char* ws = WSP; unsigned char* big = ws + WS_BIG; float* out = OUTP;
    pg8::Gemm g{(const bf16_t*)(big + BIG_XN), (const bf16_t*)(ws + WS_WKVF), TALL, 3328, DM, DM}; pg8::StaticOrder S; S.init(TALL, 3328, (int)gridDim.x, (int)blockIdx.x);
    pg8::EpiKVFQ E{out + OUT_KP, out + OUT_VP, out + OUT_LFP, out + OUT_KS, out + OUT_VS, out + OUT_LFS, (bf16_t*)(big + BIG_KB), (bf16_t*)(big + BIG_VB), (bf16_t*)(big + BIG_KALL), (bf16_t*)(big + BIG_VALL),
                    (bf16_t*)(big + BIG_ACT), INF(15), (const float*)(ws + WS_SSQ) + (size_t)1 * TALL};
    pg8::gemm_phase<pg8::EpiKVFQ, pg8::StaticOrder, true, true>(lds, g, S, E);
}
__device__ __forceinline__ void ph_cumsum(LAS unsigned char* lds) {
    PH_IDS; const float* cache_lf = INF(5); const float* out = OUTP; float* FB = (float*)(WSP + WS_FB); float* FS = (float*)(WSP + WS_FS);
    for (int it = blockIdx.x; it < 64 + 128; it += G) {
        LAS float* wtot = (LAS float*)lds;
        const bool smp = it >= 64; const int bh = smp ? it - 64 : it, b = bh >> 4, h = bh & 15, Ls = smp ? LKS : SEQ, per = smp ? 3 : 16, j0 = tid * per;
        float v[16]; float s = 0.f;
#pragma unroll
        for (int i = 0; i < 16; ++i) { const int j = j0 + i; float x = 0.f;
            if (i < per && j < Ls) x = smp ? (j < PASTL ? cache_lf[((size_t)b * PASTL + j) * 16 + h] : out[OUT_LFS + ((size_t)b * 32 + (j - PASTL)) * 16 + h]) : out[OUT_LFP + ((size_t)b * SEQ + j) * 16 + h];
            s += x; v[i] = s; }
        float inc = s;
#pragma unroll
        for (int o = 1; o < 64; o <<= 1) { const float t = __shfl_up(inc, o); if (lane >= o) inc += t; }
        if (lane == 63) wtot[wave] = inc;
        __syncthreads();
        float base = inc - s;
        for (int w = 0; w < wave; ++w) base += wtot[w];
#pragma unroll
        for (int i = 0; i < 16; ++i) { const int j = j0 + i; if (i < per && j < Ls) { const float F = base + v[i];
            if (smp) FS[(size_t)bh * LKS + j] = F; else FB[(size_t)bh * SEQ + j] = -F * 11.313708498984761f; } }
        __syncthreads();
    }
}
__device__ __forceinline__ void ph_attn(unsigned char* lds_raw) {
    unsigned char* ws = WSP; unsigned char* big = ws + WS_BIG;
    fox::attn_phase((char*)lds_raw, (const bf16_t*)(big + BIG_ACT), (const bf16_t*)(big + BIG_KB), (const bf16_t*)(big + BIG_VB), (bf16_t*)OUTP  , (const float*)(ws + WS_FB));
}
__device__ __forceinline__ void ph_sattn(LAS unsigned char* lds) {
    unsigned char* ws = WSP; unsigned char* big = ws + WS_BIG;
    sample_attn((LAS char*)lds, (const bf16_t*)(big + BIG_ACT), (const bf16_t*)(big + BIG_KALL), (const bf16_t*)(big + BIG_VALL), (const float*)(ws + WS_FS), (bf16_t*)OUTP);
}
__device__ __forceinline__ void ph_gateup(LAS unsigned char* lds, const unsigned char* a_ptr, size_t w_off, int ssq_idx) {
    unsigned char* ws = WSP; unsigned char* big = ws + WS_BIG;
    pg8::Gemm g{(const bf16_t*)a_ptr, (const bf16_t*)(ws + w_off), TALL, 2 * DFF, DM, DM}; pg8::StaticOrder S; S.init(TALL, 2 * DFF, (int)gridDim.x, (int)blockIdx.x);
    pg8::EpiSwiglu E{(bf16_t*)(big + BIG_ACT), (const float*)(ws + WS_SSQ) + (size_t)ssq_idx * TALL};
    pg8::gemm_phase<pg8::EpiSwiglu, pg8::StaticOrder, true, true>(lds, g, S, E);
}

__device__ __forceinline__ void ph_final() {
    PH_IDS; const bf16_t* H4 = (const bf16_t*)(BIGP + BIG_XN); const float* ssq = (const float*)(WSP + WS_SSQ) + (size_t)3 * TALL; const float* g = INF(9); float* Y = OUTP + OUT_Y;
    for (int m = gw; m < TALL; m += NGW) {
        const u32x4* hr = (const u32x4*)(H4 + (size_t)m * DM); u32x4 hv[4];
#pragma unroll
        for (int j = 0; j < 4; ++j) hv[j] = hr[64 * j + lane];
        const float rs = 1.0f / sqrtf(ssq[m] * (1.f / DM) + 1e-6f);
#pragma unroll
        for (int j = 0; j < 4; ++j) { const int c0 = (64 * j + lane) * 8; const f32x4 g0 = *(const f32x4*)(g + c0), g1 = *(const f32x4*)(g + c0 + 4);
            f32x4 y0, y1; y0.x = __uint_as_float(hv[j].x << 16); y0.y = __uint_as_float(hv[j].x & 0xffff0000u); y0.z = __uint_as_float(hv[j].y << 16); y0.w = __uint_as_float(hv[j].y & 0xffff0000u);
            y1.x = __uint_as_float(hv[j].z << 16); y1.y = __uint_as_float(hv[j].z & 0xffff0000u); y1.z = __uint_as_float(hv[j].w << 16); y1.w = __uint_as_float(hv[j].w & 0xffff0000u);
            *(f32x4*)(Y + (size_t)m * DM + c0) = y0 * rs * g0; *(f32x4*)(Y + (size_t)m * DM + c0 + 4) = y1 * rs * g1; } }
}
__global__ void __launch_bounds__(NWAVES * 64, 2) yoco_fwd(Params P) {
    extern __shared__ __attribute__((aligned(16))) unsigned char lds_raw[];
    cg::grid_group grid = cg::this_grid();
    LAS unsigned char* lds = (LAS unsigned char*)lds_raw;
    volatile LAS unsigned* bst = (volatile LAS unsigned*)(lds + 148480);
    if (opaque_tid() < 2) bst[opaque_tid()] = 0u;
    __syncthreads();
    const XcdBarrier xbar = xcd_barrier_post((unsigned*)(WSP + WS_BAR), bst);
#define GSYNC() xcd_barrier(xbar)
    ph_prologue(lds);                                                                                   GSYNC();
    if (WSP == nullptr) grid.sync();
    ph_retin(lds); ph_conv<1>(lds);                                                                                      GSYNC();
    ph_retention(lds);                                                                                  GSYNC();
    ph_groupnorm();                                                                                     GSYNC();
    ph_res_gemm<true, TP>(lds, BIGP + PJ_G * 2, WS_WRO, 4096, 4096, nullptr, (bf16_t*)(OUTP + OUT_KP), 0); ph_sample_res<true>(BIGP + (PJ_G + (size_t)TP * 4096) * 2, 4096, WS_WRO, 4096, nullptr, (bf16_t*)(OUTP + OUT_KP), 0);   GSYNC();
    ph_gateup(lds, (const unsigned char*)(OUTP + OUT_KP), WS_WGU0, 0); ph_conv<2>(lds);                                  GSYNC();
    ph_res_gemm<false, TP>(lds, BIGP + BIG_ACT, WS_WDN0, DFF, DFF, (const bf16_t*)(OUTP + OUT_KP), (bf16_t*)(BIGP + BIG_XN), 1); ph_sample_res(BIGP + BIG_ACT + (size_t)TP * DFF * 2, DFF, WS_WDN0, DFF, (const bf16_t*)(OUTP + OUT_KP), (bf16_t*)(BIGP + BIG_XN), 1); ph_cache_cvt();   GSYNC();
    ph_kvfq(lds); ph_conv<3>(lds);                                                                                       GSYNC();
    ph_cumsum(lds);                                                                                     GSYNC();
    ph_attn(lds_raw); __syncthreads(); ph_sattn(lds);                                                   GSYNC();
    ph_res_gemm<false, TP>(lds, (unsigned char*)OUTP, WS_WO, DM, DM, (const bf16_t*)(BIGP + BIG_XN), (bf16_t*)(BIGP + BIG_HKV), 2); ph_sample_res((const unsigned char*)OUTP + (size_t)TP * DM * 2, DM, WS_WO, DM, (const bf16_t*)(BIGP + BIG_XN), (bf16_t*)(BIGP + BIG_HKV), 2);   GSYNC();
    ph_gateup(lds, BIGP + BIG_HKV, WS_WGU1, 2); ph_conv<4>(lds);                                                         GSYNC();
    ph_res_gemm<false, TP>(lds, BIGP + BIG_ACT, WS_WDN1, DFF, DFF, (const bf16_t*)(BIGP + BIG_HKV), (bf16_t*)(BIGP + BIG_XN), 3); ph_sample_res(BIGP + BIG_ACT + (size_t)TP * DFF * 2, DFF, WS_WDN1, DFF, (const bf16_t*)(BIGP + BIG_HKV), (bf16_t*)(BIGP + BIG_XN), 3);   GSYNC();
    ph_final();
}

extern "C" void kernel_launch(void* const* d_in, const int* in_sizes, int n_in, void* d_out, int out_size, void* d_ws, size_t ws_size, hipStream_t stream) {
    static int grid = 0;
    if (grid == 0) {
        if (n_in != 21 || ws_size < WS_END) { fprintf(stderr, "kernel_launch: unexpected n_in %d / ws_size %zu (need %zu)\n", n_in, ws_size, (size_t)WS_END); grid = -1; return; }
        int dev = 0, cus = 0, per_cu = 0;
        (void)hipGetDevice(&dev); (void)hipDeviceGetAttribute(&cus, hipDeviceAttributeMultiprocessorCount, dev);
        if (hipFuncSetAttribute((const void*)yoco_fwd, hipFuncAttributeMaxDynamicSharedMemorySize, LDS_BYTES) != hipSuccess) { fprintf(stderr, "kernel_launch: hipFuncSetAttribute failed\n"); grid = -1; return; }
        if (hipOccupancyMaxActiveBlocksPerMultiprocessor(&per_cu, (const void*)yoco_fwd, NWAVES * 64, LDS_BYTES) != hipSuccess || per_cu < 1) { fprintf(stderr, "kernel_launch: occupancy query says %d\n", per_cu); per_cu = 1; }
        (void)hipGetLastError();
        grid = cus > 0 ? cus : 256;
    }
    if (grid < 0) return;
    if (hipMemsetAsync((char*)d_ws + WS_BAR, 0, XCD_BAR_WORDS * 4, stream) != hipSuccess) { fprintf(stderr, "kernel_launch: memset of the barrier words failed\n"); return; }
    Params p{};
    for (int i = 0; i < 21; ++i) p.in[i] = (const float*)d_in[i];
    p.out = (float*)d_out; p.ws = (unsigned char*)d_ws;
    void* args[] = {&p};
    hipError_t e = hipLaunchCooperativeKernel((const void*)yoco_fwd, dim3(grid), dim3(NWAVES * 64), args, LDS_BYTES, stream);
    if (e != hipSuccess) fprintf(stderr, "cooperative launch failed: %s (grid %d)\n", hipGetErrorString(e), grid);
}
```

```cpp
#include <hip/hip_runtime.h>
#include <hip/hip_cooperative_groups.h>
#include <cstdio>
#include <cstdint>
namespace cg = cooperative_groups;
__device__ __forceinline__ int opaque_tid() { int t = threadIdx.x; asm volatile("" : "+v"(t)); return t; }
namespace pg8 {
#define PG8_LAS __attribute__((address_space(3)))
typedef unsigned short bf16_t;
typedef short bf16x8 __attribute__((ext_vector_type(8)));
typedef float f32x4 __attribute__((ext_vector_type(4)));
typedef unsigned u32x4 __attribute__((ext_vector_type(4)));
constexpr int BM = 256, BK = 64, HALF = 128, HTB = HALF * BK * 2  , STAGE_BYTES = 8 * HTB, NXCD = 8, WGM = 4;

__host__ __device__ __forceinline__ int lds_byte(int r, int c) { const int st = (r >> 4) * 2 + (c >> 5), rr = r & 15, cc = c & 31, ob = rr * 64 + cc * 2; return st * 1024 + (ob ^ (((ob >> 9) & 1) << 5)); }
__host__ __device__ __forceinline__ void stage_rc(int b, int& R, int& C) { const int st = b / 1024, sb = b % 1024, swz = sb ^ (((sb >> 9) & 1) << 5); R = (st >> 1) * 16 + swz / 64; C = (st & 1) * 32 + (swz % 64) / 2; }
__host__ __device__ __forceinline__ int perm32(int rho) { const int n = rho >> 4, i = rho & 15; return 8 * (i >> 2) + 4 * n + (i & 3); }

struct Unit { int pm, pn; };
struct Gemm { const bf16_t* A; const bf16_t* Bt; int M, N, K, lda; };

struct StaticOrder {
    int nM, nN, nwg, G, c;
    __host__ __device__ void init(int M, int N, int G_, int c_) { nM = M / BM; nN = N / BM; nwg = nM * nN; G = G_; c = c_; }
    __host__ __device__ bool next(int i, Unit& u) const {
        const long L = (long)i * G + c; if (L >= nwg) return false;
        int wgid = (int)L; { const int q = nwg / NXCD, r = nwg % NXCD, xcd = wgid % NXCD, off = wgid / NXCD; wgid = (xcd < r ? xcd * (q + 1) : r * (q + 1) + (xcd - r) * q) + off; }
        const int nig = WGM * nN, gid = wgid / nig, fm = gid * WGM, gsz = (nM - fm) < WGM ? (nM - fm) : WGM;
        u.pm = fm + ((wgid % nig) % gsz); u.pn = (wgid % nig) / gsz; return true;
    }
    __device__ __forceinline__ void a_ready(const Unit&) const {}
    __device__ __forceinline__ void done(const Unit&) const {}
};

__device__ __forceinline__ unsigned cvt_pk_bf16(float lo, float hi) { unsigned r; asm volatile("v_cvt_pk_bf16_f32 %0, %1, %2" : "=v"(r) : "v"(lo), "v"(hi)); return r; }
template <class Epi, class Sched, bool ALIGN_EPI = false, bool SP2 = false>
__device__ __forceinline__ void gemm_phase(PG8_LAS unsigned char* lds, const Gemm g, const Sched& S, const Epi& E) {
    const int tid = opaque_tid(), wid = __builtin_amdgcn_readfirstlane(tid >> 6), lane = tid & 63, wr = wid >> 2, wc = wid & 3, fr = lane & 15, fq = lane >> 4;
    const int K = g.K, nt = K / BK;
    unsigned voffA[2], voffB[2];
#pragma unroll
    for (int i = 0; i < 2; ++i) { int R, C; stage_rc(tid * 16 + i * 8192, R, C); const int Rb = Epi::PERM ? ((R & ~31) + perm32(R & 31)) : R;
        voffA[i] = (unsigned)(R * g.lda + C) * 2u; voffB[i] = (unsigned)(Rb * K + C) * 2u; }
    const size_t kstep = (size_t)(BK * 2);
    const size_t hstep = (size_t)HALF * K * 2, hstepA = (size_t)HALF * g.lda * 2;
    const size_t tstep = 2 * hstep, tstepA = 2 * hstepA;
    const unsigned ldsw = (unsigned)wid * 1024u;
    const int aoff = lds_byte(wr * 64 + fr, fq * 8), boff = lds_byte(wc * 32 + fr, fq * 8);
#define PG8_SA(b, h) (((b) * 2 + (h)) * HTB)
#define PG8_SB(b, h) ((4 + (b) * 2 + (h)) * HTB)
#define PG8_STAGE(bufoff, gbase, voff) do { _Pragma("unroll") for (int _i = 0; _i < 2; ++_i) \
        __builtin_amdgcn_global_load_lds((const unsigned*)((const char*)(gbase) + (voff)[_i]), (PG8_LAS unsigned*)(lds + (bufoff) + ldsw + _i * 8192), 16, 0, 0); } while (0)
#define PG8_LDA(dst, b, h) do { _Pragma("unroll") for (int m = 0; m < 4; ++m) _Pragma("unroll") for (int k = 0; k < 2; ++k) dst[m][k] = *(const PG8_LAS bf16x8*)(lds + PG8_SA(b, h) + aoff + m * 2048 + k * 1024); } while (0)
#define PG8_LDB(dst, b, h) do { _Pragma("unroll") for (int n = 0; n < 2; ++n) _Pragma("unroll") for (int k = 0; k < 2; ++k) dst[n][k] = *(const PG8_LAS bf16x8*)(lds + PG8_SB(b, h) + boff + n * 2048 + k * 1024); } while (0)
#define PG8_MMA(ai, bj, At, Bt) do { __builtin_amdgcn_s_setprio(1); _Pragma("unroll") for (int m = 0; m < 4; ++m) _Pragma("unroll") for (int n = 0; n < 2; ++n) _Pragma("unroll") for (int k = 0; k < 2; ++k) \
        acc[ai][bj][m][n] = __builtin_amdgcn_mfma_f32_16x16x32_bf16(Bt[n][k], At[m][k], acc[ai][bj][m][n], 0, 0, 0); __builtin_amdgcn_s_setprio(0); } while (0)
#define PG8_WAIT_V(n) asm volatile("s_waitcnt vmcnt(" #n ")" ::: "memory")
#define PG8_WAIT_L(n) asm volatile("s_waitcnt lgkmcnt(" #n ")" ::: "memory")
#define PG8_BAR __builtin_amdgcn_s_barrier()
#define PG8_SCHED __builtin_amdgcn_sched_barrier(0)
    Unit cur, nxt; int ui = 0;
    if (!S.next(0, cur)) return;
    f32x4 acc[2][2][4][2];
#pragma unroll
    for (int a = 0; a < 2; ++a)
#pragma unroll
        for (int b = 0; b < 2; ++b)
#pragma unroll
            for (int m = 0; m < 4; ++m)
#pragma unroll
                for (int n = 0; n < 2; ++n) acc[a][b][m][n] = (f32x4){0.f, 0.f, 0.f, 0.f};
    bf16x8 At[4][2], B0[2][2], B1[2][2];
    const char* cA = (const char*)g.A + (size_t)cur.pm * tstepA; const char* cB = (const char*)g.Bt + (size_t)cur.pn * tstep;
    S.a_ready(cur);
    if constexpr (SP2) {
        PG8_STAGE(PG8_SB(0, 0), cB, voffB); PG8_STAGE(PG8_SB(0, 1), cB + hstep, voffB); PG8_STAGE(PG8_SA(0, 0), cA, voffA); PG8_STAGE(PG8_SA(0, 1), cA + hstepA, voffA);
        if (wr == 1) PG8_BAR;
        PG8_WAIT_V(2); PG8_BAR;
        PG8_STAGE(PG8_SB(1, 0), cB + kstep, voffB); PG8_STAGE(PG8_SA(1, 0), cA + kstep, voffA); PG8_STAGE(PG8_SB(1, 1), cB + hstep + kstep, voffB);
        PG8_WAIT_V(6); PG8_BAR;
    } else {
        PG8_STAGE(PG8_SB(0, 0), cB, voffB); PG8_STAGE(PG8_SA(0, 0), cA, voffA); PG8_STAGE(PG8_SB(0, 1), cB + hstep, voffB); PG8_STAGE(PG8_SA(0, 1), cA + hstepA, voffA);
        if (wr == 1) PG8_BAR;
        PG8_WAIT_V(4); PG8_BAR;
        PG8_STAGE(PG8_SB(1, 0), cB + kstep, voffB); PG8_STAGE(PG8_SA(1, 0), cA + kstep, voffA); PG8_STAGE(PG8_SB(1, 1), cB + hstep + kstep, voffB);
        PG8_WAIT_V(6); PG8_BAR;
    }
    for (;;) {
        const bool has_next = S.next(ui + 1, nxt);
        const char* nA = has_next ? (const char*)g.A + (size_t)nxt.pm * tstepA : cA; const char* nB = has_next ? (const char*)g.Bt + (size_t)nxt.pn * tstep : cB;
        for (int t = 0; t < nt; t += 2) {
            const bool last = (t == nt - 2);
            const char* a1 = cA + (size_t)(t + 1) * kstep;
            const char* a2 = last ? nA : cA + (size_t)(t + 2) * kstep; const char* b2 = last ? nB : cB + (size_t)(t + 2) * kstep;
            const char* a3 = a2 + kstep; const char* b3 = b2 + kstep;
            if (last && has_next) S.a_ready(nxt);
            if constexpr (SP2) {
            PG8_LDB(B0, 0, 0); PG8_LDB(B1, 0, 1); PG8_SCHED; PG8_LDA(At, 0, 0); PG8_STAGE(PG8_SA(1, 1), a1 + hstepA, voffA);
            PG8_WAIT_V(8); PG8_WAIT_L(0); PG8_BAR; PG8_MMA(0, 0, At, B0); PG8_MMA(0, 1, At, B1); PG8_BAR; PG8_SCHED;
            PG8_LDA(At, 0, 1); PG8_STAGE(PG8_SB(0, 0), b2, voffB); PG8_STAGE(PG8_SB(0, 1), b2 + hstep, voffB); PG8_STAGE(PG8_SA(0, 0), a2, voffA);
            PG8_WAIT_V(8); PG8_WAIT_L(0); PG8_BAR; PG8_MMA(1, 0, At, B0); PG8_MMA(1, 1, At, B1); PG8_BAR; PG8_SCHED;
            PG8_LDB(B0, 1, 0); PG8_LDB(B1, 1, 1); PG8_SCHED; PG8_LDA(At, 1, 0); PG8_STAGE(PG8_SA(0, 1), a2 + hstepA, voffA);
            PG8_WAIT_V(8); PG8_WAIT_L(0); PG8_BAR; PG8_MMA(0, 0, At, B0); PG8_MMA(0, 1, At, B1); PG8_BAR; PG8_SCHED;
            PG8_LDA(At, 1, 1); PG8_STAGE(PG8_SB(1, 0), b3, voffB); PG8_STAGE(PG8_SB(1, 1), b3 + hstep, voffB); PG8_STAGE(PG8_SA(1, 0), a3, voffA);
            PG8_WAIT_V(8); PG8_WAIT_L(0); PG8_BAR; PG8_MMA(1, 0, At, B0); PG8_MMA(1, 1, At, B1); PG8_BAR; PG8_SCHED;
            } else {
            PG8_LDB(B0, 0, 0); PG8_SCHED; PG8_LDA(At, 0, 0); PG8_STAGE(PG8_SA(1, 1), a1 + hstepA, voffA);
            PG8_WAIT_L(8); PG8_BAR; PG8_WAIT_L(0); PG8_MMA(0, 0, At, B0); PG8_BAR; PG8_SCHED;
            PG8_LDB(B1, 0, 1); PG8_STAGE(PG8_SB(0, 0), b2, voffB);
            PG8_BAR; PG8_WAIT_L(0); PG8_MMA(0, 1, At, B1); PG8_BAR;
            PG8_LDA(At, 0, 1); PG8_STAGE(PG8_SA(0, 0), a2, voffA);
            PG8_BAR; PG8_WAIT_L(0); PG8_MMA(1, 0, At, B0); PG8_BAR; PG8_SCHED;
            PG8_STAGE(PG8_SB(0, 1), b2 + hstep, voffB);
            PG8_WAIT_V(6); PG8_BAR; PG8_MMA(1, 1, At, B1); PG8_BAR;
            PG8_LDB(B0, 1, 0); PG8_SCHED; PG8_LDA(At, 1, 0); PG8_STAGE(PG8_SA(0, 1), a2 + hstepA, voffA);
            PG8_WAIT_L(8); PG8_BAR; PG8_WAIT_L(0); PG8_MMA(0, 0, At, B0); PG8_BAR; PG8_SCHED;
            PG8_LDB(B1, 1, 1); PG8_STAGE(PG8_SB(1, 0), b3, voffB);
            PG8_BAR; PG8_WAIT_L(0); PG8_MMA(0, 1, At, B1); PG8_BAR;
            PG8_LDA(At, 1, 1); PG8_STAGE(PG8_SA(1, 0), a3, voffA);
            PG8_BAR; PG8_WAIT_L(0); PG8_MMA(1, 0, At, B0); PG8_BAR; PG8_SCHED;
            PG8_STAGE(PG8_SB(1, 1), b3 + hstep, voffB);
            PG8_WAIT_V(6); PG8_BAR; PG8_MMA(1, 1, At, B1); PG8_BAR;
            }
        }
        if constexpr (ALIGN_EPI) { if (wr == 0) PG8_BAR; }
        if constexpr (!Epi::AFTER_DRAIN) { E(acc, cur, wr, wc, fr, fq); S.done(cur); }
        if (!has_next) break;
#pragma unroll
        for (int a = 0; a < 2; ++a)
#pragma unroll
            for (int b = 0; b < 2; ++b)
#pragma unroll
                for (int m = 0; m < 4; ++m)
#pragma unroll
                    for (int n = 0; n < 2; ++n) acc[a][b][m][n] = (f32x4){0.f, 0.f, 0.f, 0.f};
        cur = nxt; cA = nA; cB = nB; ++ui;
        if constexpr (ALIGN_EPI) { if (wr == 1) PG8_BAR; }
    }
    PG8_WAIT_V(0);
    if constexpr (!ALIGN_EPI) { if (wr == 0) PG8_BAR; }
    PG8_BAR;
    if constexpr (Epi::AFTER_DRAIN) { E.fused(acc, cur, wr, wc, fr, fq, lds, wid, lane); S.done(cur); }
#undef PG8_SA
#undef PG8_SB
#undef PG8_STAGE
#undef PG8_LDA
#undef PG8_LDB
#undef PG8_MMA
#undef PG8_WAIT_V
#undef PG8_WAIT_L
#undef PG8_BAR
#undef PG8_SCHED
}
}
constexpr int DM = 2048, TP = 32768, TSMP = 256, TALL = 33024, SEQ = 8192, NPROJ = 12288, DFF = 5632, PASTL = 1024, LKS = 1056;
constexpr size_t PJ_Q = 0, PJ_K = (size_t)TALL * 2048, PJ_V = (size_t)TALL * 4096, PJ_G = (size_t)TALL * 8192;
__device__ __forceinline__ size_t hrow(int row, int h) { return row < TP ? ((size_t)((row >> 13) * 8 + h) << 13) + (row & 8191) : (size_t)262144 + (size_t)((((row - TP) >> 5) * 8 + h) << 5) + ((row - TP) & 31); }
#define GAS __attribute__((address_space(1)))
#define LAS __attribute__((address_space(3)))
typedef unsigned short bf16_t;
typedef float f32x4 __attribute__((ext_vector_type(4)));
typedef unsigned u32x4 __attribute__((ext_vector_type(4)));
typedef unsigned u32x2 __attribute__((ext_vector_type(2)));
typedef short bf16x8 __attribute__((ext_vector_type(8)));
typedef short s16x4 __attribute__((ext_vector_type(4)));

namespace pg8 {
__device__ __forceinline__ float silu_f(float g) { return g * __builtin_amdgcn_rcpf(1.0f + __builtin_amdgcn_exp2f(-1.4426950408889634f * g)); }
struct EpiBf16P {
    static constexpr bool PERM = true, AFTER_DRAIN = false;
    bf16_t* O; int ldc;
    __device__ __forceinline__ void operator()(const f32x4 (&acc)[2][2][4][2], const Unit& u, int wr, int wc, int fr, int fq) const {
        const int row0 = u.pm * BM + wr * 64 + fr, col0 = u.pn * BM + wc * 32 + 8 * fq;
#pragma unroll
        for (int ai = 0; ai < 2; ++ai)
#pragma unroll
            for (int m = 0; m < 4; ++m) { bf16_t* rowp = O + (size_t)(row0 + ai * HALF + m * 16) * ldc + col0;
#pragma unroll
                for (int bj = 0; bj < 2; ++bj) { const f32x4 v0 = acc[ai][bj][m][0], v1 = acc[ai][bj][m][1];
                    u32x4 w; w.x = cvt_pk_bf16(v0[0], v0[1]); w.y = cvt_pk_bf16(v0[2], v0[3]); w.z = cvt_pk_bf16(v1[0], v1[1]); w.w = cvt_pk_bf16(v1[2], v1[3]);
                    *(u32x4*)(rowp + bj * HALF) = w; } }
    }
};
struct EpiRetIn {
    static constexpr bool PERM = true, AFTER_DRAIN = false;
    bf16_t* O; const float* cosT; const float* sinT;
    __device__ __forceinline__ void operator()(const f32x4 (&acc)[2][2][4][2], const Unit& u, int wr, int wc, int fr, int fq) const {
        const int row0 = u.pm * BM + wr * 64 + fr, cl = wc * 32 + 8 * fq;
        if (u.pn < 16) {
            const bool isk = u.pn >= 8; const int h = u.pn & 7;
            const float lg2 = __log2f(1.0f - exp2f(-5.0f - (float)h));
#pragma unroll
            for (int ai = 0; ai < 2; ++ai) {
                f32x4 cs[4][4]; float scv[4];
#pragma unroll
                for (int m = 0; m < 4; ++m) {
                    const int row = row0 + ai * HALF + m * 16; int pos, l;
                    if (row < TP) { pos = row & (SEQ - 1); l = row & 63; } else { const int s = (row - TP) & 31; pos = PASTL + s; l = s; }
                    scv[m] = isk ? exp2f(-lg2 * (float)l) * 0.0625f : exp2f(lg2 * (float)l);
                    const float* cp = cosT + (size_t)pos * 128 + cl; const float* sp = sinT + (size_t)pos * 128 + cl;
                    cs[m][0] = *(const f32x4*)cp; cs[m][1] = *(const f32x4*)(cp + 4); cs[m][2] = *(const f32x4*)sp; cs[m][3] = *(const f32x4*)(sp + 4); }
#pragma unroll
                for (int m = 0; m < 4; ++m) {
                    const int row = row0 + ai * HALF + m * 16; const float sc = scv[m];
                    const f32x4 c0 = cs[m][0], c1 = cs[m][1], s0 = cs[m][2], s1 = cs[m][3];
                    const f32x4 x1a = acc[ai][0][m][0], x1b = acc[ai][0][m][1], x2a = acc[ai][1][m][0], x2b = acc[ai][1][m][1];
                    const f32x4 o1a = (x1a * c0 - x2a * s0) * sc, o1b = (x1b * c1 - x2b * s1) * sc, o2a = (x1a * s0 + x2a * c0) * sc, o2b = (x1b * s1 + x2b * c1) * sc;
                    bf16_t* rowp = O + (isk ? PJ_K : PJ_Q) + hrow(row, h) * 256 + cl;
                    u32x4 w; w.x = cvt_pk_bf16(o1a[0], o1a[1]); w.y = cvt_pk_bf16(o1a[2], o1a[3]); w.z = cvt_pk_bf16(o1b[0], o1b[1]); w.w = cvt_pk_bf16(o1b[2], o1b[3]);
                    *(u32x4*)rowp = w;
                    w.x = cvt_pk_bf16(o2a[0], o2a[1]); w.y = cvt_pk_bf16(o2a[2], o2a[3]); w.z = cvt_pk_bf16(o2b[0], o2b[1]); w.w = cvt_pk_bf16(o2b[2], o2b[3]);
                    *(u32x4*)(rowp + HALF) = w; }
                asm volatile("" ::: "memory"); }
        } else {
            const bool isv = u.pn < 32; const int hv = (u.pn - 16) >> 1, e0 = ((u.pn - 16) & 1) * 256 + cl;
#pragma unroll
            for (int ai = 0; ai < 2; ++ai)
#pragma unroll
                for (int m = 0; m < 4; ++m) { const int row = row0 + ai * HALF + m * 16;
                    bf16_t* rowp = isv ? O + PJ_V + hrow(row, hv) * 512 + e0 : O + PJ_G + (size_t)row * 4096 + (u.pn - 32) * BM + cl;
#pragma unroll
                    for (int bj = 0; bj < 2; ++bj) { const f32x4 v0 = acc[ai][bj][m][0], v1 = acc[ai][bj][m][1];
                        u32x4 w; w.x = cvt_pk_bf16(v0[0], v0[1]); w.y = cvt_pk_bf16(v0[2], v0[3]); w.z = cvt_pk_bf16(v1[0], v1[1]); w.w = cvt_pk_bf16(v1[2], v1[3]);
                        *(u32x4*)(rowp + bj * HALF) = w; } }
        }
    }
};
template <bool BASEBF> struct EpiRes {
    static constexpr bool PERM = true, AFTER_DRAIN = false;
    const float* baseP; const float* baseS; const bf16_t* baseH; bf16_t* hb; float* ssq;
    __device__ __forceinline__ void operator()(const f32x4 (&acc)[2][2][4][2], const Unit& u, int wr, int wc, int fr, int fq) const {
        const int row0 = u.pm * BM + wr * 64 + fr, col0 = u.pn * BM + wc * 32 + 8 * fq;
#pragma unroll
        for (int ai = 0; ai < 2; ++ai) {
            f32x4 bv[4][2][2];
#pragma unroll
            for (int m = 0; m < 4; ++m) { const int row = row0 + ai * HALF + m * 16;
                if (BASEBF) { const bf16_t* b = baseH + (size_t)row * DM + col0;
#pragma unroll
                    for (int bj = 0; bj < 2; ++bj) { const u32x4 t = *(const u32x4*)(b + bj * HALF);
                        bv[m][bj][0] = (f32x4){__uint_as_float(t.x << 16), __uint_as_float(t.x & 0xffff0000u), __uint_as_float(t.y << 16), __uint_as_float(t.y & 0xffff0000u)};
                        bv[m][bj][1] = (f32x4){__uint_as_float(t.z << 16), __uint_as_float(t.z & 0xffff0000u), __uint_as_float(t.w << 16), __uint_as_float(t.w & 0xffff0000u)}; } }
                else { const float* b = (row < TP ? baseP + (size_t)row * DM : baseS + (size_t)(row - TP) * DM) + col0;
#pragma unroll
                    for (int bj = 0; bj < 2; ++bj)
#pragma unroll
                        for (int n = 0; n < 2; ++n) bv[m][bj][n] = *(const f32x4*)(b + bj * HALF + n * 4); } }
#pragma unroll
            for (int m = 0; m < 4; ++m) { const int row = row0 + ai * HALF + m * 16; float ss = 0.f;
#pragma unroll
                for (int bj = 0; bj < 2; ++bj) { const f32x4 v0 = bv[m][bj][0] + acc[ai][bj][m][0], v1 = bv[m][bj][1] + acc[ai][bj][m][1];
                    u32x4 w; w.x = cvt_pk_bf16(v0[0], v0[1]); w.y = cvt_pk_bf16(v0[2], v0[3]); w.z = cvt_pk_bf16(v1[0], v1[1]); w.w = cvt_pk_bf16(v1[2], v1[3]);
                    *(u32x4*)(hb + (size_t)row * DM + col0 + bj * HALF) = w;
                    ss += ((v0[0] * v0[0] + v0[1] * v0[1]) + (v0[2] * v0[2] + v0[3] * v0[3])) + ((v1[0] * v1[0] + v1[1] * v1[1]) + (v1[2] * v1[2] + v1[3] * v1[3])); }
                ss += __shfl_xor(ss, 16); ss += __shfl_xor(ss, 32);
                if (fq == 0) (void)__hip_atomic_fetch_add(ssq + row, ss, __ATOMIC_RELAXED, __HIP_MEMORY_SCOPE_AGENT); }
            asm volatile("" ::: "memory"); }
    }
};
struct EpiSwiglu {
    static constexpr bool PERM = true, AFTER_DRAIN = false;
    bf16_t* O; const float* ssq;
    __device__ __forceinline__ void operator()(const f32x4 (&acc)[2][2][4][2], const Unit& u, int wr, int wc, int fr, int fq) const {
        const int row0 = u.pm * BM + wr * 64 + fr, col0 = u.pn * HALF + wc * 32 + 8 * fq;
        float rs[2][4];
#pragma unroll
        for (int ai = 0; ai < 2; ++ai)
#pragma unroll
            for (int m = 0; m < 4; ++m) rs[ai][m] = ssq[row0 + ai * HALF + m * 16];
#pragma unroll
        for (int ai = 0; ai < 2; ++ai)
#pragma unroll
            for (int m = 0; m < 4; ++m) { bf16_t* rowp = O + (size_t)(row0 + ai * HALF + m * 16) * DFF + col0; const float r = 1.0f / sqrtf(rs[ai][m] * (1.f / DM) + 1e-6f);
                const f32x4 g0 = acc[ai][0][m][0] * r, g1 = acc[ai][0][m][1] * r, u0 = acc[ai][1][m][0] * r, u1 = acc[ai][1][m][1] * r;
                f32x4 a0, a1;
#pragma unroll
                for (int j = 0; j < 4; ++j) { a0[j] = silu_f(g0[j]) * u0[j]; a1[j] = silu_f(g1[j]) * u1[j]; }
                u32x4 w; w.x = cvt_pk_bf16(a0[0], a0[1]); w.y = cvt_pk_bf16(a0[2], a0[3]); w.z = cvt_pk_bf16(a1[0], a1[1]); w.w = cvt_pk_bf16(a1[2], a1[3]);
                *(u32x4*)rowp = w; }
    }
};
struct EpiKVFQ {
    static constexpr bool PERM = false, AFTER_DRAIN = false;
    float* kP; float* vP; float* lfP; float* kS; float* vS; float* lfS; bf16_t* KB; bf16_t* VB; bf16_t* KALL; bf16_t* VALL; bf16_t* QB; const float* bf; const float* ssq;
    __device__ __forceinline__ void operator()(const f32x4 (&acc)[2][2][4][2], const Unit& u, int wr, int wc, int fr, int fq) const {
        const int row0 = u.pm * BM + wr * 64 + fr;
        float rs[2][4];
#pragma unroll
        for (int ai = 0; ai < 2; ++ai)
#pragma unroll
            for (int m = 0; m < 4; ++m) rs[ai][m] = 1.0f / sqrtf(ssq[row0 + ai * HALF + m * 16] * (1.f / DM) + 1e-6f);
        if (u.pn >= 5) {
            const int col0 = (u.pn - 5) * BM + wc * 32 + 4 * fq;
#pragma unroll
            for (int ai = 0; ai < 2; ++ai)
#pragma unroll
                for (int m = 0; m < 4; ++m) { bf16_t* bo = QB + (size_t)(row0 + ai * HALF + m * 16) * DM + col0;
#pragma unroll
                    for (int bj = 0; bj < 2; ++bj)
#pragma unroll
                        for (int n = 0; n < 2; ++n) { const f32x4 v = acc[ai][bj][m][n] * rs[ai][m]; u32x2 w; w.x = cvt_pk_bf16(v[0], v[1]); w.y = cvt_pk_bf16(v[2], v[3]); *(u32x2*)(bo + bj * HALF + n * 16) = w; } }
        } else if (u.pn < 4) {
            const bool isv = u.pn >= 2; const int col0 = (u.pn & 1) * BM + wc * 32 + 4 * fq;
            float* fP = isv ? vP : kP; float* fS = isv ? vS : kS; bf16_t* bP = isv ? VB : KB; bf16_t* bA = isv ? VALL : KALL;
#pragma unroll
            for (int ai = 0; ai < 2; ++ai)
#pragma unroll
                for (int m = 0; m < 4; ++m) { const int row = row0 + ai * HALF + m * 16; float* fo; bf16_t* bo;
                    if (row < TP) { fo = fP + (size_t)row * 512 + col0; bo = bP + (size_t)row * 512 + col0; }
                    else { const int r2 = row - TP; fo = fS + (size_t)r2 * 512 + col0; bo = bA + ((size_t)(r2 >> 5) * LKS + PASTL + (r2 & 31)) * 512 + col0; }
#pragma unroll
                    for (int bj = 0; bj < 2; ++bj)
#pragma unroll
                        for (int n = 0; n < 2; ++n) { const f32x4 v = acc[ai][bj][m][n] * rs[ai][m]; *(f32x4*)(fo + bj * HALF + n * 16) = v;
                            u32x2 w; w.x = cvt_pk_bf16(v[0], v[1]); w.y = cvt_pk_bf16(v[2], v[3]); *(u32x2*)(bo + bj * HALF + n * 16) = w; } }
        } else if (wc == 0) {
            const f32x4 bb = *(const f32x4*)(bf + 4 * fq);
#pragma unroll
            for (int ai = 0; ai < 2; ++ai)
#pragma unroll
                for (int m = 0; m < 4; ++m) { const int row = row0 + ai * HALF + m * 16; const f32x4 z = acc[ai][0][m][0] * rs[ai][m] + bb; f32x4 r;
#pragma unroll
                    for (int j = 0; j < 4; ++j) r[j] = fminf(z[j], 0.f) - log1pf(__expf(-fabsf(z[j])));
                    float* o = row < TP ? lfP + (size_t)row * 16 : lfS + (size_t)(row - TP) * 16; *(f32x4*)(o + 4 * fq) = r; }
        }
    }
};
}
namespace fox {
enum { ORDER_NATURAL = 0, ORDER_REVERSED = 1, ORDER_PAIRED = 2, ORDER_XCD = 4 };
constexpr int D = 128, QS = 2048, KS = 512, OS = 2048;
constexpr float THR = 8.f;
constexpr bool WSKIP = false;
constexpr float SCALE = 0.08838834764831845f;
constexpr int NW = 8, QBLK = 32, KVBLK = 64, QB = NW * QBLK;
constexpr int SHM_V = KVBLK * D * 2, SHM_K = KVBLK * D * 2;
constexpr int LDS_BYTES = 2 * SHM_V + 2 * SHM_K + NW * 64 * 4 + 2 * 64 * 4;
typedef unsigned short bf16;
typedef short bf16x8 __attribute__((ext_vector_type(8)));
typedef short s16x4 __attribute__((ext_vector_type(4)));
typedef float f32x16 __attribute__((ext_vector_type(16)));
typedef float f32x4 __attribute__((ext_vector_type(4)));
typedef unsigned u32x4 __attribute__((ext_vector_type(4)));
template <class A, class Bt> struct same_t { static constexpr bool v = false; };
template <class A> struct same_t<A, A> { static constexpr bool v = true; };

#define KSWZ(row, colB) ((row) * 256 + ((colB) ^ (((row) & 7) << 4)))
#define SBAR() __builtin_amdgcn_sched_barrier(0)
__device__ __forceinline__ int v_st(int k, int c) { const int kk = (k & ~0xC) | ((k & 4) << 1) | ((k & 8) >> 1); return ((kk >> 3) * 4 + (c >> 5)) * 512 + ((kk & 7) * 32 + (c & 31)) * 2; }
__device__ __forceinline__ int v_rd_base(int lane) { return ((lane & 3) << 3) | (((lane >> 2) & 3) << 6) | (((lane >> 4) & 1) << 5) | (((lane >> 5) & 1) << 8); }
constexpr int v_rd_off(int d0, int ks, int half) { return d0 * 512 + ks * 4096 + half * 2048; }
__device__ __forceinline__ int crow(int r, int hi) { return (r & 3) + 8 * (r >> 2) + 4 * hi; }
__device__ __forceinline__ unsigned cvtpk(float lo, float hi) {
    unsigned r; asm volatile("v_cvt_pk_bf16_f32 %0, %1, %2" : "=v"(r) : "v"(lo), "v"(hi)); return r;
}
__device__ __forceinline__ bf16x8 pack8(f32x4 a, f32x4 b) {
    u32x4 w = {cvtpk(a[0], a[1]), cvtpk(a[2], a[3]), cvtpk(b[0], b[1]), cvtpk(b[2], b[3])};
    return *reinterpret_cast<bf16x8*>(&w);
}
template <class T> __device__ __forceinline__ bf16x8 load8(const T* p) {
    if constexpr (same_t<T, float>::v) { return pack8(*(const f32x4*)p, *(const f32x4*)(p + 4)); }
    else { return *reinterpret_cast<const bf16x8*>(p); }
}
__device__ __forceinline__ void mask_tile(f32x16& p0, f32x16& p1, int dq, unsigned W) {
    const float NEG = -__builtin_inff();
#pragma unroll
    for (int r = 0; r < 16; ++r) {
        const int c = (r & 3) + 8 * (r >> 2);
        if ((unsigned)(dq - c) >= W) p0[r] = NEG;
        if ((unsigned)(dq - c - 32) >= W) p1[r] = NEG;
    }
}
__device__ __forceinline__ void partialSM(f32x16& p0, f32x16& p1, float& m_reg, float& mn, float& alpha) {
    float pmax = p0[0]; for (int r = 1; r < 16; ++r) pmax = fmaxf(pmax, p0[r]); for (int r = 0; r < 16; ++r) pmax = fmaxf(pmax, p1[r]);
    { auto rr = __builtin_amdgcn_permlane32_swap(__float_as_uint(pmax), __float_as_uint(pmax), false, false);
      pmax = fmaxf(__uint_as_float(rr[0]), __uint_as_float(rr[1])); }
    constexpr float C2 = 1.4426950408889634f * SCALE;
    if (__builtin_expect(__all((pmax - m_reg) * SCALE <= THR), 1)) { mn = m_reg; alpha = 1.f; }
    else { mn = fmaxf(m_reg, pmax); alpha = __builtin_amdgcn_exp2f((m_reg - mn) * C2); m_reg = mn; }
    const float mnL = -mn * C2;
    for (int r = 0; r < 16; ++r) p0[r] = fmaf(p0[r], C2, mnL); for (int r = 0; r < 16; ++r) p1[r] = fmaf(p1[r], C2, mnL);
    for (int r = 0; r < 16; ++r) p0[r] = __builtin_amdgcn_exp2f(p0[r]);
}
__device__ __forceinline__ void finishSM(f32x16& p0, f32x16& p1, float alpha, float& l_reg, bf16x8& pa0, bf16x8& pa1, bf16x8& pa2, bf16x8& pa3) {
    for (int r = 0; r < 16; ++r) p1[r] = __builtin_amdgcn_exp2f(p1[r]);
    float ps = 0; for (int r = 0; r < 16; ++r) ps += p0[r]; for (int r = 0; r < 16; ++r) ps += p1[r];
    { auto rr = __builtin_amdgcn_permlane32_swap(__float_as_uint(ps), __float_as_uint(ps), false, false);
      ps = __uint_as_float(rr[0]) + __uint_as_float(rr[1]); }
    l_reg = l_reg * alpha + ps;
#define PK4(P, B_, OUT) do { unsigned a0 = cvtpk(P[B_+0], P[B_+1]), a1 = cvtpk(P[B_+2], P[B_+3]);                          \
        unsigned b0 = cvtpk(P[B_+4], P[B_+5]), b1 = cvtpk(P[B_+6], P[B_+7]);                                             \
        auto r0 = __builtin_amdgcn_permlane32_swap(a0, b0, false, false); auto r1 = __builtin_amdgcn_permlane32_swap(a1, b1, false, false); \
        u32x4 w = {r0[0], r1[0], r0[1], r1[1]}; OUT = *reinterpret_cast<bf16x8*>(&w); } while (0)
    PK4(p0, 0, pa0); PK4(p0, 8, pa1); PK4(p1, 0, pa2); PK4(p1, 8, pa3);
#undef PK4
}
template <int KB, bool SK>
__device__ __forceinline__ void qkt(f32x16& p0, f32x16& p1, const char* K_lds, int r32, int hi, const bf16x8* qr, bool act) {
    if (SK && !act) { const float NEG = -__builtin_inff();
#pragma unroll
        for (int r = 0; r < 16; ++r) { p0[r] = NEG; p1[r] = NEG; } return; }
    { const float* bb_ = (const float*)(K_lds + 2 * SHM_K + NW * 64 * 4) + KB * 64 + 4 * hi;
#pragma unroll
      for (int q_ = 0; q_ < 4; ++q_) { const f32x4 b0_ = *(const f32x4*)(bb_ + 8 * q_), b1_ = *(const f32x4*)(bb_ + 32 + 8 * q_);
#pragma unroll
        for (int i_ = 0; i_ < 4; ++i_) { p0[4 * q_ + i_] = b0_[i_]; p1[4 * q_ + i_] = b1_[i_]; } } }
    const char* kb[4];
#pragma unroll
    for (int dd = 0; dd < 4; ++dd) kb[dd] = K_lds + KB * SHM_K + KSWZ(r32, (dd * 16 + hi * 8) * 2);
#pragma unroll
    for (int d0 = 0; d0 < 8; ++d0) { const char* a = kb[d0 & 3] + (d0 >> 2) * 128;
        bf16x8 b0 = *reinterpret_cast<const bf16x8*>(a);
        bf16x8 b1 = *reinterpret_cast<const bf16x8*>(a + 32 * 256);
        p0 = __builtin_amdgcn_mfma_f32_32x32x16_bf16(b0, qr[d0], p0, 0, 0, 0);
        p1 = __builtin_amdgcn_mfma_f32_32x32x16_bf16(b1, qr[d0], p1, 0, 0, 0); }
}
template <int VB, bool SK>
__device__ __forceinline__ void pv_tile(f32x16* o, int vb0, bf16x8 pa0, bf16x8 pa1, bf16x8 pa2, bf16x8 pa3, bool act) {
    if (SK && !act) return;
#define TRRD(dst, off) asm volatile("ds_read_b64_tr_b16 %0, %1 offset:%2" : "=&v"(dst) : "v"(vb0), "i"(off) : "memory")
#define PV_D0(d0) do { s16x4 l0, l1, l2, l3, h0, h1, h2, h3; constexpr int b_ = VB * SHM_V + v_rd_off(d0, 0, 0);     \
        TRRD(l0, b_); TRRD(h0, b_ + 2048); TRRD(l1, b_ + 4096); TRRD(h1, b_ + 6144); TRRD(l2, b_ + 8192); TRRD(h2, b_ + 10240); TRRD(l3, b_ + 12288); TRRD(h3, b_ + 14336); \
        asm volatile("s_waitcnt lgkmcnt(0)" ::: "memory"); SBAR();                 \
        o[d0] = __builtin_amdgcn_mfma_f32_32x32x16_bf16(pa0, (bf16x8){l0[0], l0[1], l0[2], l0[3], h0[0], h0[1], h0[2], h0[3]}, o[d0], 0, 0, 0);   \
        o[d0] = __builtin_amdgcn_mfma_f32_32x32x16_bf16(pa1, (bf16x8){l1[0], l1[1], l1[2], l1[3], h1[0], h1[1], h1[2], h1[3]}, o[d0], 0, 0, 0);   \
        o[d0] = __builtin_amdgcn_mfma_f32_32x32x16_bf16(pa2, (bf16x8){l2[0], l2[1], l2[2], l2[3], h2[0], h2[1], h2[2], h2[3]}, o[d0], 0, 0, 0);   \
        o[d0] = __builtin_amdgcn_mfma_f32_32x32x16_bf16(pa3, (bf16x8){l3[0], l3[1], l3[2], l3[3], h3[0], h3[1], h3[2], h3[3]}, o[d0], 0, 0, 0); } while (0)
    PV_D0(0); PV_D0(1); PV_D0(2); PV_D0(3);
#undef PV_D0
#undef TRRD
}
template <class TIn, class TOut> struct BlockRef { const TIn* Q; const TIn* K; const TIn* V; TOut* O; const float* FB; int P0; };
template <class TIn> struct Seam {
    bf16x8 qr[8];
    bf16x8 st_v0, st_v1, st_k0, st_k1; float st_f; f32x4 sf0, sf1, sf2, sf3;
    f32x4 tq[16];
};
__device__ __forceinline__ int swa_jlo(int P0, int W) { const int lowk = P0 - W + 1; return lowk > 0 ? lowk / KVBLK : 0; }
#define ROW(p, k0, rr) ((p) + (size_t)((k0) + (rr)) * KS + sc)
#define VMW() asm volatile("s_waitcnt vmcnt(0)" ::: "memory")
#define VMWN(n) asm volatile("s_waitcnt vmcnt(%0)" :: "i"(n) : "memory")
#define SLOAD_H(Kp, Vp, Fp, k0) do { S.st_f = (Fp)[(k0) + (tid & 63)]; S.st_v0 = load8<TIn>(ROW(Vp, k0, sr)); S.st_v1 = load8<TIn>(ROW(Vp, k0, 32 + sr));              \
                         S.st_k0 = load8<TIn>(ROW(Kp, k0, sr)); S.st_k1 = load8<TIn>(ROW(Kp, k0, 32 + sr)); } while (0)
#define SWRITE_HK(bf) do { ((float*)(K_lds + 2 * SHM_K + NW * 64 * 4))[(bf) * 64 + (tid & 63)] = S.st_f; *(bf16x8*)(K_lds + (bf) * SHM_K + kws) = S.st_k0; *(bf16x8*)(K_lds + (bf) * SHM_K + kws + 32 * 256) = S.st_k1; } while (0)
#define SWRITE_HV(bf) do { *(bf16x8*)(V_lds + (bf) * SHM_V + vst0) = S.st_v0; *(bf16x8*)(V_lds + (bf) * SHM_V + vst1) = S.st_v1; } while (0)
#define SWRITE_H(bf) do { SWRITE_HV(bf); SWRITE_HK(bf); } while (0)
#define SLOAD_F(p, k0) do { S.sf0 = *(const f32x4*)ROW(p, k0, sr); S.sf1 = *(const f32x4*)(ROW(p, k0, sr) + 4);                \
                            S.sf2 = *(const f32x4*)ROW(p, k0, 32 + sr); S.sf3 = *(const f32x4*)(ROW(p, k0, 32 + sr) + 4); } while (0)
#define SWRITE_KF(bf) do { *(bf16x8*)(K_lds + (bf) * SHM_K + kws) = pack8(S.sf0, S.sf1); *(bf16x8*)(K_lds + (bf) * SHM_K + kws + 32 * 256) = pack8(S.sf2, S.sf3); } while (0)
#define SWRITE_VF(bf) do { *(bf16x8*)(V_lds + (bf) * SHM_V + vst0) = pack8(S.sf0, S.sf1); *(bf16x8*)(V_lds + (bf) * SHM_V + vst1) = pack8(S.sf2, S.sf3); } while (0)
template <class TIn, class TOut>
__device__ __forceinline__ void causal_swa_prime(const BlockRef<TIn, TOut>& cur, int W, char* lds, Seam<TIn>& S) {
    constexpr bool F32 = same_t<TIn, float>::v;
    const int tid = opaque_tid(), wid = __builtin_amdgcn_readfirstlane(tid >> 6), lane = tid & 63, r32 = lane & 31, hi = lane >> 5;
    const int sr = tid >> 4, sc = (tid & 15) * 8, kws = KSWZ(sr, sc * 2); char* K_lds = lds + 2 * SHM_V;
    const int kb0 = swa_jlo(cur.P0, W) * KVBLK;
    for (int d0 = 0; d0 < 8; ++d0) S.qr[d0] = load8<TIn>(cur.Q + (size_t)(wid * QBLK + r32) * QS + d0 * 16 + hi * 8);
    if constexpr (F32) { SLOAD_F((const float*)cur.K, kb0); VMW(); SWRITE_KF(0); SBAR(); SLOAD_F((const float*)cur.V, kb0); }
    else { SLOAD_H(cur.K, cur.V, cur.FB, kb0); VMW(); SWRITE_HK(0); }
    __syncthreads();
}
template <class TIn, class TOut>
__device__ __forceinline__ void causal_swa_block(const BlockRef<TIn, TOut>& cur, const BlockRef<TIn, TOut>& nxt, int skv, int W, char* lds, Seam<TIn>& S) {
    constexpr bool F32 = same_t<TIn, float>::v;
    const int tid = opaque_tid(), wid = __builtin_amdgcn_readfirstlane(tid >> 6), lane = tid & 63, r32 = lane & 31, hi = lane >> 5;
    const int j_lo = swa_jlo(cur.P0, W);
    int j_hi = (cur.P0 + QB - 1) / KVBLK + 1; if (j_hi > skv / KVBLK) j_hi = skv / KVBLK;
    const int NT = j_hi - j_lo;
    const int kbn = swa_jlo(nxt.P0, W) * KVBLK;
    const int qlo = cur.P0 + wid * QBLK, qm = qlo + r32 - 4 * hi;
    char* V_lds = lds; char* K_lds = lds + 2 * SHM_V;
    float* ws = (float*)(lds + 2 * SHM_V + 2 * SHM_K) + wid * 64; float* li_l = ws, * al_l = ws + 32;
    float m_reg = -1e30f, l_reg = 0; f32x16 o[4] = {};
    const int sr = tid >> 4, sc = (tid & 15) * 8, vst0 = v_st(sr, sc), vst1 = v_st(32 + sr, sc), kws = KSWZ(sr, sc * 2);
    const int vb0 = (int)(uintptr_t)V_lds + v_rd_base(lane);
    const TIn* Kh = cur.K; const TIn* Vh = cur.V;
#define RESC(a) do { if (__any((a) < 1.f)) { if (hi == 0) al_l[r32] = (a); asm volatile("s_waitcnt lgkmcnt(0)" ::: "memory");              \
                     for (int d_ = 0; d_ < 4; ++d_) for (int r = 0; r < 16; ++r) o[d_][r] *= al_l[crow(r, hi)]; } } while (0)
#define KBASE(t) ((j_lo + (t)) * KVBLK)
#define ACT(t) (KBASE(t) <= qlo + QBLK - 1 && KBASE(t) + KVBLK - 1 >= qlo - W + 1)
#define MASKT(P0_, P1_, t) do { const int kb_ = KBASE(t); if ((!SK || ACT(t)) && (kb_ + KVBLK - 1 > qlo || kb_ <= qlo + QBLK - 1 - W)) mask_tile(P0_, P1_, qm - kb_, (unsigned)W); } while (0)
    constexpr int NQL = F32 ? 16 : 8;
    constexpr bool SK = WSKIP && !F32;
#define SEAM_K0() do { VMWN(NQL); if constexpr (F32) { SWRITE_KF(0); SBAR(); SLOAD_F((const float*)nxt.V, kbn); } else { SWRITE_HK(0); } SBAR(); } while (0)
    f32x16 pA0, pA1, pB0, pB1; float mnA, mnB, alA, alB; bf16x8 pa0, pa1, pa2, pa3;
    if constexpr (F32) { VMW(); SWRITE_VF(0); SBAR(); } else { SWRITE_HV(0); SBAR(); }
    if (NT > 1) { if constexpr (F32) SLOAD_F((const float*)Kh, KBASE(1)); else SLOAD_H(Kh, Vh, cur.FB, KBASE(1)); }
    SBAR(); qkt<0, SK>(pA0, pA1, K_lds, r32, hi, S.qr, ACT(0));
    if constexpr (F32) { if (NT > 1) { VMW(); SWRITE_KF(1); SBAR(); SLOAD_F((const float*)Vh, KBASE(1)); } }
    MASKT(pA0, pA1, 0); partialSM(pA0, pA1, m_reg, mnA, alA);
    if (NT > 1) { VMW(); if constexpr (F32) { SWRITE_VF(1); SBAR(); if (NT > 2) SLOAD_F((const float*)Kh, KBASE(2)); } else SWRITE_H(1); }
    __syncthreads();
#define HALF_STEP(PX0, PX1, mnX, alX, PY0, PY1, alY, t, KB, VB, SB) do {                                                      \
        SBAR(); qkt<KB, SK>(PX0, PX1, K_lds, r32, hi, S.qr, ACT(t));                                             \
        finishSM(PY0, PY1, alY, l_reg, pa0, pa1, pa2, pa3); SBAR();                                                           \
        if ((t) + 1 < NT) { if constexpr (F32) { VMW(); SWRITE_KF(SB); SBAR(); SLOAD_F((const float*)Vh, KBASE((t) + 1)); }  \
                            else { SLOAD_H(Kh, Vh, cur.FB, KBASE((t) + 1)); } SBAR(); }                                               \
        pv_tile<VB, SK>(o, vb0, pa0, pa1, pa2, pa3, ACT((t) - 1)); MASKT(PX0, PX1, (t)); partialSM(PX0, PX1, m_reg, mnX, alX);                                        \
        __syncthreads();                                                                                                      \
        if ((t) + 1 < NT) { VMW(); if constexpr (F32) { SWRITE_VF(SB); SBAR(); if ((t) + 2 < NT) SLOAD_F((const float*)Kh, KBASE((t) + 2)); } \
                            else { SWRITE_H(SB); } }                                                                          \
        RESC(alX); __syncthreads(); } while (0)
    for (int t = 1; t + 1 < NT; t += 2) {
        HALF_STEP(pB0, pB1, mnB, alB, pA0, pA1, alA, t, 1, 0, 0);
        HALF_STEP(pA0, pA1, mnA, alA, pB0, pB1, alB, t + 1, 0, 1, 1);
    }
    const bool even = (NT & 1) == 0;
    if (even) { SBAR(); qkt<1, SK>(pB0, pB1, K_lds, r32, hi, S.qr, ACT(NT - 1)); SBAR(); }
#define QROW(e) (nxt.Q + (size_t)(wid * QBLK + r32) * D + ((e) >> 1) * 16 + hi * 8 + ((e) & 1) * 4)
    if constexpr (F32) { SLOAD_F((const float*)nxt.K, kbn); SBAR();
#pragma unroll
        for (int e = 0; e < 8; ++e) S.tq[e] = *(const f32x4*)QROW(e); }
    else { SLOAD_H(nxt.K, nxt.V, nxt.FB, kbn); SBAR();
#pragma unroll
        for (int d0 = 0; d0 < 8; ++d0) S.qr[d0] = load8<TIn>(nxt.Q + (size_t)(wid * QBLK + r32) * QS + d0 * 16 + hi * 8); }
    SBAR();
    finishSM(pA0, pA1, alA, l_reg, pa0, pa1, pa2, pa3); SBAR();
    if constexpr (F32) {
#pragma unroll
        for (int e = 8; e < 16; ++e) S.tq[e] = *(const f32x4*)QROW(e); SBAR(); }
#undef QROW
    pv_tile<0, SK>(o, vb0, pa0, pa1, pa2, pa3, ACT(even ? NT - 2 : NT - 1));
    if (even) { MASKT(pB0, pB1, NT - 1); partialSM(pB0, pB1, m_reg, mnB, alB); __syncthreads(); RESC(alB);
        finishSM(pB0, pB1, alB, l_reg, pa0, pa1, pa2, pa3); SBAR(); pv_tile<1, SK>(o, vb0, pa0, pa1, pa2, pa3, ACT(NT - 1)); }
    SBAR(); SEAM_K0();
    if (hi == 0) li_l[r32] = l_reg; asm volatile("s_waitcnt lgkmcnt(0)" ::: "memory");
    float rli[16];
#pragma unroll
    for (int r = 0; r < 16; ++r) rli[r] = __builtin_amdgcn_rcpf(li_l[crow(r, hi)]);
    TOut* Ow = cur.O + (size_t)(wid * QBLK) * OS;
#pragma unroll
    for (int r = 0; r < 16; ++r) { const int orow = crow(r, hi);
#pragma unroll
        for (int d0 = 0; d0 < 4; ++d0) { const float v = o[d0][r] * rli[r];
            if constexpr (same_t<TOut, float>::v) { Ow[(size_t)orow * OS + d0 * 32 + r32] = v; }
            else { const float vn = __shfl_xor(v, 1);
                   if ((r32 & 1) == 0) *(unsigned*)(Ow + (size_t)orow * OS + d0 * 32 + r32) = cvtpk(v, vn); } } }
    if constexpr (F32) {
#pragma unroll
        for (int d0 = 0; d0 < 8; ++d0) S.qr[d0] = pack8(S.tq[2 * d0], S.tq[2 * d0 + 1]); }
    __syncthreads();
#undef RESC
#undef KBASE
#undef ACT
#undef MASKT
#undef SEAM_K0
#undef HALF_STEP
}
#undef ROW
#undef VMW
#undef VMWN
#undef SLOAD_H
#undef SWRITE_HK
#undef SWRITE_HV
#undef SWRITE_H
#undef SLOAD_F
#undef SWRITE_KF
#undef SWRITE_VF

__host__ __device__ inline int swa_nramp(int nqb, int W, int qoff) { const int t = W - 1 - qoff; const int n = t < 0 ? 0 : t / QB + 1; return n > nqb ? nqb : n; }
__host__ __device__ inline int swa_nx(int nqb, int nramp, int order) { return (order & ORDER_PAIRED) ? (nramp + 1) / 2 + (nqb - nramp) : nqb; }
struct SwaItem { int bh, qb0, qb1; };
__device__ __forceinline__ SwaItem swa_decode(int L, int nb, int nh, int nhkv, int nqb, int nx, int nramp, int order) {
    const int G = nh / nhkv; SwaItem it; int x;
    if ((order & ORDER_XCD) && (nb * nhkv) % 8 == 0) { const int xcd = L & 7, k = L >> 3, per = G * nx, gi = k / per, r = k - gi * per;
        it.bh = (gi * 8 + xcd) * G + r / nx; x = r % nx; }
    else { it.bh = L / nx; x = L - it.bh * nx; }
    if (order & ORDER_PAIRED) { const int ns = nqb - nramp;
        if (x < ns) { it.qb0 = it.qb1 = nqb - 1 - x; } else { it.qb0 = x - ns; it.qb1 = nramp - 1 - it.qb0; } }
    else { it.qb0 = it.qb1 = ((order & 3) == ORDER_REVERSED) ? nqb - 1 - x : x; }
    return it;
}
typedef unsigned short bf16;
__device__ __forceinline__ BlockRef<bf16, bf16> mk_ref(const SwaItem& it, int pass, const bf16* Q, const bf16* K, const bf16* V, bf16* O, const float* FB) {
    const int qb = pass ? it.qb1 : it.qb0, b = it.bh >> 4, h = it.bh & 15, kvh = h >> 2;
    BlockRef<bf16, bf16> r;
    r.Q = Q + ((size_t)b * 8192 + (size_t)qb * QB) * QS + h * 128; r.O = O + ((size_t)b * 8192 + (size_t)qb * QB) * OS + h * 128;
    r.K = K + (size_t)b * 8192 * KS + kvh * 128; r.V = V + (size_t)b * 8192 * KS + kvh * 128; r.FB = FB + (size_t)it.bh * 8192; r.P0 = qb * QB;
    return r;
}
__device__ __forceinline__ void attn_phase(char* lds, const bf16* Q, const bf16* K, const bf16* V, bf16* O, const float* FB) {
    constexpr int nb = 4, nh = 16, nhkv = 4, nqb = 32, W = 8192, order = ORDER_PAIRED | ORDER_XCD;
    const int nramp = swa_nramp(nqb, W, 0), nx = swa_nx(nqb, nramp, order), total = nx * nb * nh, stride = gridDim.x;
    int L = blockIdx.x; if (L >= total) return;
    SwaItem it = swa_decode(L, nb, nh, nhkv, nqb, nx, nramp, order); int pass = 0;
    BlockRef<bf16, bf16> cur = mk_ref(it, 0, Q, K, V, O, FB);
    Seam<bf16> S;
    causal_swa_prime<bf16, bf16>(cur, W, lds, S);
    for (;;) {
        const bool more_pass = pass == 0 && it.qb1 != it.qb0, more_item = L + stride < total, last = !more_pass && !more_item;
        SwaItem itn = it; int passn = pass + 1, Ln = L;
        if (!more_pass) { passn = 0; Ln = more_item ? L + stride : L; itn = swa_decode(Ln, nb, nh, nhkv, nqb, nx, nramp, order); }
        const BlockRef<bf16, bf16> nxt = last ? cur : mk_ref(itn, passn, Q, K, V, O, FB);
        causal_swa_block<bf16, bf16>(cur, nxt, 8192, W, lds, S);
        if (last) break;
        cur = nxt; it = itn; pass = passn; L = Ln;
    }
}
}
constexpr size_t WS_WIN = 0, WS_WRO = 50331648, WS_WGU0 = 67108864, WS_WGU1 = 113246208, WS_WDN0 = 159383552, WS_WDN1 = 182452224,
                 WS_WO = 205520896, WS_WKVF = 213909504  , WS_COS = 227540992, WS_SIN = 231735296, WS_FB = 235929600, WS_FS = WS_FB + 2097152,
                 WS_BIG = 239075328;
constexpr size_t SZ_ROWS2K = (size_t)TALL * DM * 2;
constexpr size_t BIG_XN = 0, BIG_ACT = SZ_ROWS2K, BIG_HKV = BIG_ACT + (size_t)TALL * DFF * 2, BIG_KB = BIG_HKV + SZ_ROWS2K, BIG_VB = BIG_KB + (size_t)TP * 512 * 2,
                 BIG_KALL = BIG_VB + (size_t)TP * 512 * 2, BIG_VALL = BIG_KALL + (size_t)8 * LKS * 512 * 2, BIG_END = BIG_VALL + (size_t)8 * LKS * 512 * 2;
static_assert(BIG_END <= (size_t)TALL * NPROJ * 2, "layer-1 buffers fit in the PROJ region");
constexpr size_t WS_SSQ = WS_BIG + (size_t)TALL * NPROJ * 2  , WS_BAR = WS_SSQ + (size_t)4 * TALL * 4  , WS_END = WS_BAR + 16384;
static_assert(WS_FS + 540672 <= WS_BIG && WS_BAR % 256 == 0, "small arrays end before the big region");
static_assert(WS_END <= (size_t)1073741824, "workspace fits 1 GiB");
constexpr size_t OUT_Y = 0, OUT_SP = 67633152, OUT_KP = 71827456, OUT_VP = 88604672, OUT_LFP = 105381888, OUT_SS = 105906176, OUT_KS = 114294784, OUT_VS = 114425856, OUT_LFS = 114556928;
constexpr int NWAVES = 8, LDS_BYTES = 149504;

struct Params { const float* in[21]; float* out; unsigned char* ws; };

__device__ __forceinline__ float wave_sum(float v) {
#pragma unroll
    for (int o = 1; o < 64; o <<= 1) v += __shfl_xor(v, o);
    return v;
}
__device__ __forceinline__ float bf2f(unsigned short b) { return __uint_as_float(((unsigned)b) << 16); }
__device__ __forceinline__ unsigned pk2(float lo, float hi) { return pg8::cvt_pk_bf16(lo, hi); }

__device__ __forceinline__ void transpose_item(const float* W, int K, int N, bf16_t* WT, int k0, int n0, int drow0, LAS float* scr, int lane, const float* gain = nullptr) {
    float wv[32];
#pragma unroll
    for (int i = 0; i < 32; ++i) { const int kk = 2 * i + (lane >> 5); wv[i] = W[(size_t)(k0 + kk) * N + n0 + (lane & 31)] * (gain ? gain[k0 + kk] : 1.f); }
#pragma unroll
    for (int i = 0; i < 32; ++i) { const int kk = 2 * i + (lane >> 5); scr[kk * 33 + (lane & 31)] = wv[i]; }
    asm volatile("s_waitcnt lgkmcnt(0)" ::: "memory");
    const int c = lane & 7;
#pragma unroll
    for (int j = 0; j < 4; ++j) { const int n = (lane >> 3) + 8 * j; const LAS float* s = scr + (8 * c) * 33 + n;
        u32x4 o; o.x = pk2(s[0 * 33], s[1 * 33]); o.y = pk2(s[2 * 33], s[3 * 33]); o.z = pk2(s[4 * 33], s[5 * 33]); o.w = pk2(s[6 * 33], s[7 * 33]);
        *(u32x4*)(WT + (size_t)(drow0 + n) * K + k0 + 8 * c) = o; }
    asm volatile("s_waitcnt lgkmcnt(0)" ::: "memory");
}
__device__ __forceinline__ void tr_plain(const float* W, int K, int N, bf16_t* WT, int row_off, LAS float* scr, int item, int lane, const float* gain = nullptr) {
    const int nblk = N / 32, kb = item / nblk, nb = item % nblk; transpose_item(W, K, N, WT, 64 * kb, 32 * nb, row_off + 32 * nb, scr, lane, gain);
}
__device__ __forceinline__ void tr_gu(const float* W, bf16_t* WT, int up, LAS float* scr, int item, int lane, const float* gain) {
    const int nblk = DFF / 32, kb = item / nblk, nb = item % nblk, n0 = 32 * nb; transpose_item(W, DM, DFF, WT, 64 * kb, n0, (n0 >> 7) * 256 + up * 128 + (n0 & 127), scr, lane, gain);
}
template <int MODE  >
__device__ __forceinline__ void rms_row(const float* xrow, const float* g1, bf16_t* o1, const float* g2, bf16_t* o2, float* of, int lane) {
    const f32x4* xr = (const f32x4*)xrow + lane;
    f32x4 v[8]; float s = 0.f;
#pragma unroll
    for (int j = 0; j < 8; ++j) { v[j] = xr[64 * j]; s += (v[j].x * v[j].x + v[j].y * v[j].y) + (v[j].z * v[j].z + v[j].w * v[j].w); }
    const float rs = 1.0f / sqrtf(wave_sum(s) * (1.f / DM) + 1e-6f);
#pragma unroll
    for (int j = 0; j < 8; ++j) { const f32x4 ga = ((const f32x4*)g1)[64 * j + lane]; const f32x4 y = v[j] * rs;
        if (MODE == 2) { ((f32x4*)of)[64 * j + lane] = y * ga; }
        else { u32x2 w; w.x = pk2(y.x * ga.x, y.y * ga.y); w.y = pk2(y.z * ga.z, y.w * ga.w); ((u32x2*)o1)[64 * j + lane] = w;
            if (MODE == 1) { const f32x4 gb = ((const f32x4*)g2)[64 * j + lane]; u32x2 w2; w2.x = pk2(y.x * gb.x, y.y * gb.y); w2.y = pk2(y.z * gb.z, y.w * gb.w); ((u32x2*)o2)[64 * j + lane] = w2; } } }
}

namespace ret {
constexpr int KOFF = 0, STOFF = 32768, VOFF = 65536, POFF = 74752, VS = 144;
typedef short v4i16_t __attribute__((ext_vector_type(4)));
__device__ __forceinline__ bf16x8 frag_rm(const LAS char* base, int stride, int i0, int k0, int fr, int fq) { return *(const LAS bf16x8*)(base + (i0 + fr) * stride + (k0 + 8 * fq) * 2); }
__device__ __forceinline__ bf16x8 frag_sw(const LAS char* base, int i0, int k0, int fr, int fq) { return *(const LAS bf16x8*)(base + (i0 + fr) * 512 + ((((k0 >> 3) + fq) ^ fr) << 4)); }
__device__ __forceinline__ s16x4 tr4(const LAS char* p) { return __builtin_bit_cast(s16x4, __builtin_amdgcn_ds_read_tr16_b64_v4i16((LAS v4i16_t*)p)); }
__device__ __forceinline__ bf16x8 frag_tr(const LAS char* base, int stride, int k0, int i0, int fr, int fq) {
    const LAS char* p = base + (k0 + 8 * fq + (fr >> 2)) * stride + (i0 + 4 * (fr & 3)) * 2;
    const s16x4 a = tr4(p), b = tr4(p + 4 * stride);
    return (bf16x8){a[0], a[1], a[2], a[3], b[0], b[1], b[2], b[3]};
}
__device__ __forceinline__ bf16x8 frag_tr_sw(const LAS char* base, int k0, int i0, int fr, int fq) {
    const int m = k0 + 8 * fq + (fr >> 2), d = i0 + 4 * (fr & 3);
    const s16x4 a = tr4(base + m * 512 + ((((d >> 3) ^ (m & 15))) << 4) + (d & 7) * 2), b = tr4(base + (m + 4) * 512 + ((((d >> 3) ^ ((m + 4) & 15))) << 4) + (d & 7) * 2);
    return (bf16x8){a[0], a[1], a[2], a[3], b[0], b[1], b[2], b[3]};
}
#define RET_BAR() do { asm volatile("s_waitcnt lgkmcnt(0)" ::: "memory"); __builtin_amdgcn_s_barrier(); asm volatile("" ::: "memory"); } while (0)
#define MFMA16(X, Y, C) __builtin_amdgcn_mfma_f32_16x16x32_bf16(X, Y, C, 0, 0, 0)
__device__ __forceinline__ void ret_item(LAS char* lds, const bf16_t* proj, size_t hr0  , bf16_t* oh  , int nchunks, int c, int h, int es, const float* S0, float* Sout) {
    const int tid = opaque_tid(), wid = __builtin_amdgcn_readfirstlane(tid >> 6), lane = tid & 63, fr = lane & 15, fq = lane >> 4, lt = wid >> 1, half = wid & 1;
    const float lg2 = __log2f(1.0f - exp2f(-5.0f - (float)h)), gam = exp2f(lg2), gc1 = exp2f(lg2 * (float)(c - 1));
    f32x4 accT[8];
    const int eT = 16 * lt + fr;
#pragma unroll
    for (int i = 0; i < 8; ++i) { const int d0 = 16 * (8 * half + i) + 4 * fq;
#pragma unroll
        for (int r = 0; r < 4; ++r) accT[i][r] = S0 ? S0[(size_t)(d0 + r) * 512 + es * 64 + eT] : 0.f;
        u32x2 w; w.x = pk2(accT[i][0], accT[i][1]); w.y = pk2(accT[i][2], accT[i][3]); *(LAS u32x2*)(lds + STOFF + eT * 512 + (((d0 >> 3) ^ fr) << 4) + (d0 & 7) * 2) = w; }
    u32x4 rk[4], rv; bf16x8 yq[8];
    const bf16_t* gq = proj + PJ_Q + (hr0 + eT) * 256 + 8 * fq; const bf16_t* gk = proj + PJ_K + hr0 * 256; const bf16_t* gv = proj + PJ_V + hr0 * 512 + es * 64; bf16_t* pout = oh + hr0 * 512 + es * 64;
    const bool qok = eT < c;
#define RET_LOADQ(n) do { _Pragma("unroll") for (int ks = 0; ks < 8; ++ks) yq[ks] = qok ? *(const bf16x8*)(gq + (size_t)(n) * 64 * 256 + 32 * ks) : (bf16x8){0, 0, 0, 0, 0, 0, 0, 0}; } while (0)
#define RET_LOAD(n) do { _Pragma("unroll") for (int i = 0; i < 4; ++i) { const int p = tid + 512 * i, row = p >> 5, ch = p & 31; \
            if (row < c) rk[i] = *(const u32x4*)(gk + (size_t)((n) * 64 + row) * 256 + ch * 8); else rk[i] = (u32x4){0u, 0u, 0u, 0u}; } \
        { const int row = tid >> 3, ch = tid & 7; if (row < c) rv = *(const u32x4*)(gv + (size_t)((n) * 64 + row) * 512 + ch * 8); else rv = (u32x4){0u, 0u, 0u, 0u}; } } while (0)
    RET_LOAD(0); RET_LOADQ(0);
    for (int n = 0; n < nchunks; ++n) {
#pragma unroll
        for (int i = 0; i < 4; ++i) { const int p = tid + 512 * i, row = p >> 5, ch = p & 31; *(LAS u32x4*)(lds + KOFF + row * 512 + ((ch ^ (row & 15)) << 4)) = rk[i]; }
        *(LAS u32x4*)(lds + VOFF + (tid >> 3) * VS + (tid & 7) * 16) = rv;
        if (n + 1 < nchunks) RET_LOAD(n + 1);
        RET_BAR();
        f32x4 accS[2], accC[2];
#pragma unroll
        for (int j = 0; j < 2; ++j) { accS[j] = (f32x4){0.f, 0.f, 0.f, 0.f}; accC[j] = (f32x4){0.f, 0.f, 0.f, 0.f}; }
#pragma unroll
        for (int kb = 0; kb < 8; kb += 2) {
            bf16x8 xk[2][2], xs[2][2];
#pragma unroll
            for (int ks = 0; ks < 2; ++ks)
#pragma unroll
                for (int j = 0; j < 2; ++j) { xk[ks][j] = frag_sw(lds + KOFF, 16 * (2 * half + j), 32 * (kb + ks), fr, fq); xs[ks][j] = frag_sw(lds + STOFF, 16 * (2 * half + j), 32 * (kb + ks), fr, fq); }
            __builtin_amdgcn_sched_barrier(0);
#pragma unroll
            for (int ks = 0; ks < 2; ++ks)
#pragma unroll
                for (int j = 0; j < 2; ++j) { accS[j] = MFMA16(xk[ks][j], yq[kb + ks], accS[j]); accC[j] = MFMA16(xs[ks][j], yq[kb + ks], accC[j]); }
            __builtin_amdgcn_sched_barrier(0);
        }
        if (n + 1 < nchunks) RET_LOADQ(n + 1);
        const int lrow = eT;
#pragma unroll
        for (int j = 0; j < 2; ++j) { const int m0 = 16 * (2 * half + j) + 4 * fq; f32x4 sv = accS[j];
#pragma unroll
            for (int r = 0; r < 4; ++r) sv[r] = (m0 + r <= lrow) ? sv[r] : 0.f;
            u32x2 w; w.x = pk2(sv[0], sv[1]); w.y = pk2(sv[2], sv[3]); *(LAS u32x2*)(lds + POFF + lrow * VS + m0 * 2) = w; }
        RET_BAR();
        f32x4 accO[2];
#pragma unroll
        for (int j = 0; j < 2; ++j) accO[j] = accC[j] * gam;
#pragma unroll
        for (int ks = 0; ks < 2; ++ks) { const int k0 = 32 * ks;
            const bf16x8 yp = frag_rm(lds + POFF, VS, 16 * lt, k0, fr, fq);
#pragma unroll
            for (int j = 0; j < 2; ++j) { const bf16x8 xv = frag_tr(lds + VOFF, VS, k0, 16 * (2 * half + j), fr, fq); accO[j] = MFMA16(xv, yp, accO[j]); } }
        if (lrow < c) {
#pragma unroll
            for (int j = 0; j < 2; ++j) { u32x2 w; w.x = pk2(accO[j][0], accO[j][1]); w.y = pk2(accO[j][2], accO[j][3]);
                *(u32x2*)(pout + (size_t)(n * 64 + lrow) * 512 + 16 * (2 * half + j) + 4 * fq) = w; } }
#pragma unroll
        for (int i = 0; i < 8; ++i) accT[i] = accT[i] * gam;
#pragma unroll
        for (int ks = 0; ks < 2; ++ks) {
            bf16x8 xk[8]; const bf16x8 yv = frag_tr(lds + VOFF, VS, 32 * ks, 16 * lt, fr, fq);
#pragma unroll
            for (int i = 0; i < 8; ++i) xk[i] = frag_tr_sw(lds + KOFF, 32 * ks, 16 * (8 * half + i), fr, fq);
            __builtin_amdgcn_sched_barrier(0);
#pragma unroll
            for (int i = 0; i < 8; ++i) accT[i] = MFMA16(xk[i], yv, accT[i]);
            __builtin_amdgcn_sched_barrier(0);
        }
#pragma unroll
        for (int i = 0; i < 8; ++i) { accT[i] = accT[i] * gc1; const int d0 = 16 * (8 * half + i) + 4 * fq;
            u32x2 w; w.x = pk2(accT[i][0], accT[i][1]); w.y = pk2(accT[i][2], accT[i][3]); *(LAS u32x2*)(lds + STOFF + eT * 512 + (((d0 >> 3) ^ fr) << 4) + (d0 & 7) * 2) = w; }
        RET_BAR();
    }
#undef RET_LOAD
#undef RET_LOADQ
#pragma unroll
    for (int i = 0; i < 8; ++i) { const int d0 = 16 * (8 * half + i) + 4 * fq;
#pragma unroll
        for (int r = 0; r < 4; ++r) Sout[(size_t)(d0 + r) * 512 + es * 64 + eT] = accT[i][r]; }
}
}
__device__ __forceinline__ void sample_attn(LAS char* lds, const bf16_t* QBp, const bf16_t* KALL, const bf16_t* VALL, const float* FS, bf16_t* AO) {
    const int tid = opaque_tid(), wid = __builtin_amdgcn_readfirstlane(tid >> 6), lane = tid & 63;
    LAS float* qf = (LAS float*)(lds + wid * 5120); LAS float* pf = qf + 128;
    const int gw = blockIdx.x * NWAVES + wid, NGW = gridDim.x * NWAVES;
    for (int item = gw; item < 8 * 16 * 32; item += NGW) {
        const int b = item >> 9, h = (item >> 5) & 15, qi = item & 31, kvh = h >> 2, qpos = PASTL + qi, row = TP + b * 32 + qi;
        const bf16_t* q = QBp + (size_t)row * DM + h * 128;
        qf[lane] = bf2f(q[lane]); qf[lane + 64] = bf2f(q[lane + 64]);
        asm volatile("s_waitcnt lgkmcnt(0)" ::: "memory");
        const float* F = FS + (size_t)(b * 16 + h) * LKS; const float Fq = F[qpos];
        const bf16_t* Kb = KALL + (size_t)b * LKS * 512 + kvh * 128; const bf16_t* Vb = VALL + (size_t)b * LKS * 512 + kvh * 128;
        float mx = -1e30f;
#pragma unroll 1
        for (int t = 0; t < 17; ++t) { const int j = lane + 64 * t; float s = -__builtin_inff();
            if (j <= qpos) { const u32x4* kr = (const u32x4*)(Kb + (size_t)j * 512); float a = 0.f; u32x4 kvv[16];
#pragma unroll
                for (int c8 = 0; c8 < 16; ++c8) kvv[c8] = kr[c8];
#pragma unroll
                for (int c8 = 0; c8 < 16; ++c8) { const u32x4 kv = kvv[c8]; const LAS f32x4* qq = (const LAS f32x4*)(qf + 8 * c8); const f32x4 q0 = qq[0], q1 = qq[1];
                    a += __uint_as_float(kv.x << 16) * q0.x + __uint_as_float(kv.x & 0xffff0000u) * q0.y + __uint_as_float(kv.y << 16) * q0.z + __uint_as_float(kv.y & 0xffff0000u) * q0.w
                       + __uint_as_float(kv.z << 16) * q1.x + __uint_as_float(kv.z & 0xffff0000u) * q1.y + __uint_as_float(kv.w << 16) * q1.z + __uint_as_float(kv.w & 0xffff0000u) * q1.w; }
                s = a * 0.08838834764831845f + (Fq - F[j]); }
            pf[j] = s; mx = fmaxf(mx, s); }
#pragma unroll
        for (int o = 1; o < 64; o <<= 1) mx = fmaxf(mx, __shfl_xor(mx, o));
        float sum = 0.f;
#pragma unroll 1
        for (int t = 0; t < 17; ++t) { const float p = __expf(pf[lane + 64 * t] - mx); sum += p; pf[lane + 64 * t] = p; }
        sum = wave_sum(sum);
        asm volatile("s_waitcnt lgkmcnt(0)" ::: "memory");
        float oa[8];
#pragma unroll
        for (int e = 0; e < 8; ++e) oa[e] = 0.f;
        const int kg = lane >> 4, dg = lane & 15;
        for (int j = 0; j < PASTL + 32; j += 32) {
            u32x4 vv[8]; float p[8];
#pragma unroll
            for (int u = 0; u < 8; ++u) { vv[u] = *(const u32x4*)(Vb + (size_t)(j + 4 * u + kg) * 512 + 8 * dg); p[u] = pf[j + 4 * u + kg]; }
#pragma unroll
            for (int u = 0; u < 8; ++u) { const unsigned w4[4] = {vv[u].x, vv[u].y, vv[u].z, vv[u].w};
#pragma unroll
                for (int e = 0; e < 4; ++e) { oa[2 * e] += p[u] * __uint_as_float(w4[e] << 16); oa[2 * e + 1] += p[u] * __uint_as_float(w4[e] & 0xffff0000u); } } }
#pragma unroll
        for (int e = 0; e < 8; ++e) { oa[e] += __shfl_xor(oa[e], 16); oa[e] += __shfl_xor(oa[e], 32); }
        const float inv = 1.0f / sum;
        if (kg == 0) { u32x4 w; w.x = pk2(oa[0] * inv, oa[1] * inv); w.y = pk2(oa[2] * inv, oa[3] * inv); w.z = pk2(oa[4] * inv, oa[5] * inv); w.w = pk2(oa[6] * inv, oa[7] * inv);
            *(u32x4*)(AO + (size_t)row * DM + h * 128 + 8 * dg) = w; }
        asm volatile("s_waitcnt lgkmcnt(0)" ::: "memory");
    }
}

#define XB_TMO      128
#define XB_XCNT(j)  (256  + 64 * (j))
#define XB_XSUB(j)  (1280 + 64 * (j))
#define XB_XGEN(j)  (2304 + 64 * (j))
#define XB_TOP      3328
#define XB_TOPGEN   3392
#define XCD_BAR_WORDS 3456
#define XB_SPIN_CAP (1u << 18)

__device__ __forceinline__ unsigned xb_ld(unsigned* p)              { return __hip_atomic_load(p, __ATOMIC_RELAXED, __HIP_MEMORY_SCOPE_AGENT); }
__device__ __forceinline__ unsigned xb_add(unsigned* p, unsigned v) { return __hip_atomic_fetch_add(p, v, __ATOMIC_RELAXED, __HIP_MEMORY_SCOPE_AGENT); }
__device__ __forceinline__ unsigned xb_xcc_id() { return (unsigned)__builtin_amdgcn_s_getreg((3 << 11) | 20) & 0xFu; }
#define XB_SPIN(cond, bar) do { unsigned _sp = 0; while (cond) { __builtin_amdgcn_s_sleep(1); \
    if ((++_sp & 255u) == 0u) { if (xb_ld(&(bar)[XB_TMO])) break; if (_sp > XB_SPIN_CAP) { atomicAdd(&(bar)[XB_TMO], 1u); break; } } } } while (0)

struct XcdBarrier {
    unsigned* bar; unsigned x;
    volatile LAS unsigned* st;
};

__device__ __forceinline__ XcdBarrier xcd_barrier_post(unsigned* bar, volatile LAS unsigned* st) {
    XcdBarrier b; b.bar = bar; b.x = xb_xcc_id(); b.st = st;
    if (threadIdx.x == 0) (void)xb_add(&bar[XB_XCNT(b.x)], 1u);
    return b;
}
__device__ __forceinline__ void xcd_barrier_complete(unsigned* bar, unsigned x, unsigned& nloc, unsigned& nx) {
    const unsigned G = gridDim.x * gridDim.y * gridDim.z;
    unsigned sum, cnt, mine, sp = 0u;
    for (;;) {
        sum = 0u; cnt = 0u; mine = 0u;
#pragma unroll
        for (unsigned j = 0; j < 16; ++j) { const unsigned c = xb_ld(&bar[XB_XCNT(j)]); sum += c; cnt += (c > 0u) ? 1u : 0u; mine = (j == x) ? c : mine; }
        if (sum == G) break;
        __builtin_amdgcn_s_sleep(1);
        if ((++sp & 255u) == 0u) { if (xb_ld(&bar[XB_TMO])) break; if (sp > XB_SPIN_CAP) { atomicAdd(&bar[XB_TMO], 1u); break; } }
    }
    nloc = mine > 0u ? mine : 1u; nx = cnt > 0u ? cnt : 1u;
}

__device__ __forceinline__ void xcd_barrier(const XcdBarrier& b) {
    asm volatile("s_waitcnt vmcnt(0)" ::: "memory");
    __syncthreads();
    if (threadIdx.x == 0) {
        unsigned* bar = b.bar;
        __builtin_amdgcn_s_waitcnt(0);
        unsigned nloc = b.st[0], nx = b.st[1];
        if (nloc == 0u) { xcd_barrier_complete(bar, b.x, nloc, nx); b.st[0] = nloc; b.st[1] = nx; }
        const unsigned old = xb_add(&bar[XB_XSUB(b.x)], 1u);
        const unsigned gen = old / nloc;
        if (old + 1u == (gen + 1u) * nloc) {
            __builtin_amdgcn_fence(__ATOMIC_RELEASE, "agent");
            asm volatile("s_waitcnt vmcnt(0)" ::: "memory");
            const unsigned og = xb_add(&bar[XB_TOP], 1u);
            const unsigned tg = og / nx;
            if (og + 1u == (tg + 1u) * nx) xb_add(&bar[XB_TOPGEN], 1u);
            else XB_SPIN(xb_ld(&bar[XB_TOPGEN]) == tg, bar);
            __builtin_amdgcn_fence(__ATOMIC_ACQUIRE, "agent");
            xb_add(&bar[XB_XGEN(b.x)], 1u);
            asm volatile("s_waitcnt vmcnt(0)" ::: "memory");
        } else {
            XB_SPIN(xb_ld(&bar[XB_XGEN(b.x)]) == gen, bar);
            __builtin_amdgcn_fence(__ATOMIC_ACQUIRE, "agent");
            asm volatile("s_waitcnt vmcnt(0)" ::: "memory");
        }
    }
    __syncthreads();
}

#define KARG(i) ((unsigned char*)(__attribute__((address_space(1))) unsigned char*)(((const volatile __attribute__((address_space(4))) unsigned long long*)__builtin_amdgcn_kernarg_segment_ptr())[i]))
#define INF(i) ((const float*)KARG(i))
#define OUTP ((float*)KARG(21))
#define WSP (KARG(22))
#define BIGP (KARG(22) + WS_BIG)
#define PH_IDS const int tid = opaque_tid(), lane = tid & 63, wave = __builtin_amdgcn_readfirstlane(tid >> 6); const int G = gridDim.x, gw = blockIdx.x * NWAVES + wave, NGW = G * NWAVES; const size_t gt = (size_t)blockIdx.x * 512 + tid, NGT = (size_t)G * 512; (void)lane; (void)gw; (void)NGW; (void)gt; (void)NGT

__device__ __forceinline__ void ph_prologue(LAS unsigned char* lds) {
    PH_IDS; unsigned char* ws = WSP;
    bf16_t* WIN = (bf16_t*)(ws + WS_WIN); bf16_t* WKVF = (bf16_t*)(ws + WS_WKVF);
    LAS float* scr = (LAS float*)(lds + wave * 16384);
    constexpr int I0 = 32 * 384;
    for (int it = gw; it < I0; it += NGW) tr_plain(INF(10), DM, NPROJ, WIN, 0, scr, it, lane);
    { const float* wf = INF(14); const float* nkv = INF(8);
      for (size_t i = gt; i < (size_t)256 * DM; i += NGT) { const int r = (int)(i >> 11), k = (int)(i & 2047); WKVF[(size_t)(1024 + r) * DM + k] = r < 16 ? (bf16_t)(pk2(wf[k * 16 + r] * nkv[k], 0.f) & 0xffffu) : (bf16_t)0; }
      float* ssq = (float*)(ws + WS_SSQ); for (size_t i = gt; i < (size_t)4 * TALL; i += NGT) ssq[i] = 0.f; }
    { float* COS = (float*)(ws + WS_COS); float* SIN = (float*)(ws + WS_SIN);
      for (size_t i = gt; i < (size_t)SEQ * 128; i += NGT) { const int pos = (int)(i >> 7), d = (int)(i & 127);
        const float inv = exp2f(-(float)d * (13.287712379549449f / 128.f));
        const double rev = (double)pos * (double)inv * 0.15915494309189535; const float fr = (float)(rev - __builtin_floor(rev));
        COS[i] = __builtin_amdgcn_cosf(fr); SIN[i] = __builtin_amdgcn_sinf(fr); } }
    { const float* x_p = INF(0); const float* x_s = INF(1); const float* nm = INF(6); bf16_t* XN0 = (bf16_t*)OUTP;
      for (int m = gw; m < TALL; m += NGW) rms_row<0>(m < TP ? x_p + (size_t)m * DM : x_s + (size_t)(m - TP) * DM, nm, XN0 + (size_t)m * DM, nullptr, nullptr, nullptr, lane); }
}
template <int JOB> __device__ __forceinline__ void ph_conv(LAS unsigned char* lds) {
    const int tid = opaque_tid(), lane = tid & 63, wave = __builtin_amdgcn_readfirstlane(tid >> 6);
    const int G = gridDim.x, first = G > 160 ? (JOB == 1 ? 48 : JOB == 3 ? 141 : 44) : 0;
    if ((int)blockIdx.x < first) return;
    const int gw = ((int)blockIdx.x - first) * NWAVES + wave, NGW = (G - first) * NWAVES;
    unsigned char* ws = WSP; LAS float* scr = (LAS float*)(lds + wave * 16384);
    constexpr int IG = 32 * 176, ID = 88 * 64, IQ = 32 * 64, IK = 32 * 16;
    if (JOB == 1) {
        bf16_t* WRO = (bf16_t*)(ws + WS_WRO); bf16_t* WGU0 = (bf16_t*)(ws + WS_WGU0);
        for (int it = gw; it < 64 * 64 + 2 * IG; it += NGW) { int r = it;
            if (r < 64 * 64) { tr_plain(INF(11), 4096, DM, WRO, 0, scr, r, lane); continue; } r -= 64 * 64;
            if (r < IG) { tr_gu(INF(18), WGU0, 0, scr, r, lane, INF(7)); continue; } r -= IG;
            tr_gu(INF(19), WGU0, 1, scr, r, lane, INF(7)); }
    } else if (JOB == 2) {
        bf16_t* WDN0 = (bf16_t*)(ws + WS_WDN0); bf16_t* WGU1 = (bf16_t*)(ws + WS_WGU1); bf16_t* WO = (bf16_t*)(ws + WS_WO); bf16_t* WKVF = (bf16_t*)(ws + WS_WKVF);
        for (int it = gw; it < ID + 2 * IQ + 2 * IK + IG; it += NGW) { int r = it;
            if (r < ID) { tr_plain(INF(20), DFF, DM, WDN0, 0, scr, r, lane); continue; } r -= ID;
            if (r < IQ) { tr_plain(INF(16), DM, DM, WKVF, 1280, scr, r, lane, INF(6) + DM); continue; } r -= IQ;
            if (r < IK) { tr_plain(INF(12), DM, 512, WKVF, 0, scr, r, lane, INF(8)); continue; } r -= IK;
            if (r < IK) { tr_plain(INF(13), DM, 512, WKVF, 512, scr, r, lane, INF(8)); continue; } r -= IK;
            if (r < IQ) { tr_plain(INF(17), DM, DM, WO, 0, scr, r, lane); continue; } r -= IQ;
            tr_gu(INF(18) + (size_t)DM * DFF, WGU1, 0, scr, r, lane, INF(7) + DM); }
    } else if (JOB == 3) {
        bf16_t* WGU1 = (bf16_t*)(ws + WS_WGU1);
        for (int it = gw; it < IG; it += NGW) tr_gu(INF(19) + (size_t)DM * DFF, WGU1, 1, scr, it, lane, INF(7) + DM);
    } else {
        bf16_t* WDN1 = (bf16_t*)(ws + WS_WDN1);
        for (int it = gw; it < ID; it += NGW) tr_plain(INF(20) + (size_t)DFF * DM, DFF, DM, WDN1, 0, scr, it, lane);
    }
}
__device__ __forceinline__ void ph_retin(LAS unsigned char* lds) {
    unsigned char* ws = WSP;
    pg8::Gemm g{(const bf16_t*)OUTP, (const bf16_t*)(ws + WS_WIN), TALL, NPROJ, DM, DM}; pg8::StaticOrder S; S.init(TALL, NPROJ, (int)gridDim.x, (int)blockIdx.x);
    pg8::EpiRetIn E{(bf16_t*)(ws + WS_BIG), (const float*)(ws + WS_COS), (const float*)(ws + WS_SIN)};
    pg8::gemm_phase<pg8::EpiRetIn, pg8::StaticOrder, true, true>(lds, g, S, E);
}
__device__ __forceinline__ void ph_retention(LAS unsigned char* lds) {
    const int G = gridDim.x;
    for (int it = blockIdx.x; it < 256; it += G) { const int bh = (it & 7) * 4 + (it >> 6), es = (it >> 3) & 7, b = bh >> 3, h = bh & 7;
        ret::ret_item((LAS char*)lds, (const bf16_t*)BIGP, (size_t)(b * 8 + h) * SEQ, (bf16_t*)OUTP, 128, 64, h, es, nullptr, OUTP + OUT_SP + (size_t)(b * 8 + h) * 256 * 512); }
    for (int it = blockIdx.x; it < 512; it += G) { const int bh = (it & 7) * 8 + (it >> 6), es = (it >> 3) & 7, b = bh >> 3, h = bh & 7;
        ret::ret_item((LAS char*)lds, (const bf16_t*)BIGP, (size_t)262144 + (size_t)(b * 8 + h) * 32, (bf16_t*)OUTP, 1, 32, h, es, INF(2) + (size_t)(b * 8 + h) * 256 * 512, OUTP + OUT_SS + (size_t)(b * 8 + h) * 256 * 512); }
}
__device__ __forceinline__ void ph_groupnorm() {
    PH_IDS; bf16_t* PROJ = (bf16_t*)BIGP; const bf16_t* OB = (const bf16_t*)OUTP;
    for (int it0 = gw * 4; it0 < TALL * 8; it0 += NGW * 4) {
        u32x4 ovv[4], gvv[4];
#pragma unroll
        for (int q = 0; q < 4; ++q) { const int it = it0 + q, row = it >> 3, h = it & 7;
            ovv[q] = *(const u32x4*)(OB + hrow(row, h) * 512 + lane * 8); gvv[q] = *(const u32x4*)(PROJ + PJ_G + (size_t)row * 4096 + h * 512 + lane * 8); }
#pragma unroll
        for (int q = 0; q < 4; ++q) { const int it = it0 + q, row = it >> 3, h = it & 7; const u32x4 ov = ovv[q], gv = gvv[q];
            bf16_t* op = PROJ + PJ_G + (size_t)row * 4096 + h * 512 + lane * 8;
            float o[8], g[8]; const unsigned ow[4] = {ov.x, ov.y, ov.z, ov.w}, gwd[4] = {gv.x, gv.y, gv.z, gv.w};
#pragma unroll
            for (int j = 0; j < 4; ++j) { o[2 * j] = __uint_as_float(ow[j] << 16); o[2 * j + 1] = __uint_as_float(ow[j] & 0xffff0000u); g[2 * j] = __uint_as_float(gwd[j] << 16); g[2 * j + 1] = __uint_as_float(gwd[j] & 0xffff0000u); }
            float s = 0.f;
#pragma unroll
            for (int j = 0; j < 8; ++j) s += o[j];
            const float mu = wave_sum(s) * (1.f / 512.f); float qq = 0.f;
#pragma unroll
            for (int j = 0; j < 8; ++j) { o[j] -= mu; qq += o[j] * o[j]; }
            const float rstd = 1.0f / sqrtf(wave_sum(qq) * (1.f / 512.f) + 1e-5f);
#pragma unroll
            for (int j = 0; j < 8; ++j) o[j] = o[j] * rstd * pg8::silu_f(g[j]);
            u32x4 w; w.x = pk2(o[0], o[1]); w.y = pk2(o[2], o[3]); w.z = pk2(o[4], o[5]); w.w = pk2(o[6], o[7]); *(u32x4*)op = w; } }
}
template <bool FIRST, int MROWS = TALL> __device__ __forceinline__ void ph_res_gemm(LAS unsigned char* lds, unsigned char* a_ptr, size_t w_off, int K, int lda, const bf16_t* base_h, bf16_t* hb, int ssq_idx) {
    unsigned char* ws = WSP;
    pg8::Gemm g{(const bf16_t*)a_ptr, (const bf16_t*)(ws + w_off), MROWS, DM, K, lda}; pg8::StaticOrder S; S.init(MROWS, DM, (int)gridDim.x, (int)blockIdx.x);
    pg8::EpiRes<!FIRST> E{FIRST ? INF(0) : nullptr, FIRST ? INF(1) : nullptr, base_h, hb, (float*)(ws + WS_SSQ) + (size_t)ssq_idx * TALL};
    pg8::gemm_phase<pg8::EpiRes<!FIRST>, pg8::StaticOrder, true, true>(lds, g, S, E);
}
template <bool FIRST = false> __device__ __forceinline__ void ph_sample_res(const unsigned char* a_ptr, int lda, size_t w_off, int K, const bf16_t* base_h, bf16_t* hb, int ssq_idx) {
    const int tid = opaque_tid(), lane = tid & 63, wave = __builtin_amdgcn_readfirstlane(tid >> 6), fr = lane & 15, fq = lane >> 4;
    unsigned char* ws = WSP;
    const bf16_t* A = (const bf16_t*)a_ptr; const bf16_t* Wt = (const bf16_t*)(ws + w_off);
    float* ssq = (float*)(ws + WS_SSQ) + (size_t)ssq_idx * TALL + TP;
    for (int it = blockIdx.x; it < 256; it += gridDim.x) {
        const int n0 = (it >> 1) * 16, row = (it & 1) * 128 + 16 * wave + fr;
        const bf16_t* bp = Wt + (size_t)(n0 + fr) * K + 8 * fq; const bf16_t* ap = A + (size_t)row * lda + 8 * fq;
        f32x4 acc = {0.f, 0.f, 0.f, 0.f};
        bf16x8 bA[8], aA[8], bB[8], aB[8];
#define SR_LOAD(B_, A_, kk) do { _Pragma("unroll") for (int s_ = 0; s_ < 8; ++s_) { B_[s_] = *(const bf16x8*)(bp + (kk) + 32 * s_); A_[s_] = *(const bf16x8*)(ap + (kk) + 32 * s_); } } while (0)
#define SR_MMA(B_, A_) do { _Pragma("unroll") for (int s_ = 0; s_ < 8; ++s_) acc = __builtin_amdgcn_mfma_f32_16x16x32_bf16(B_[s_], A_[s_], acc, 0, 0, 0); } while (0)
        SR_LOAD(bA, aA, 0);
        for (int k0 = 0; k0 < K; k0 += 512) {
            SR_LOAD(bB, aB, k0 + 256);
            SR_MMA(bA, aA);
            if (k0 + 512 < K) SR_LOAD(bA, aA, k0 + 512);
            SR_MMA(bB, aB);
        }
#undef SR_LOAD
#undef SR_MMA
        f32x4 bvv;
        if (FIRST) bvv = *(const f32x4*)(INF(1) + (size_t)row * DM + n0 + 4 * fq);
        else { const u32x2 t = *(const u32x2*)(base_h + (size_t)(TP + row) * DM + n0 + 4 * fq); bvv = (f32x4){__uint_as_float(t.x << 16), __uint_as_float(t.x & 0xffff0000u), __uint_as_float(t.y << 16), __uint_as_float(t.y & 0xffff0000u)}; }
        const f32x4 v = bvv + acc;
        { u32x2 w; w.x = pk2(v[0], v[1]); w.y = pk2(v[2], v[3]); *(u32x2*)(hb + (size_t)(TP + row) * DM + n0 + 4 * fq) = w; }
        { float ss = (v[0] * v[0] + v[1] * v[1]) + (v[2] * v[2] + v[3] * v[3]); ss += __shfl_xor(ss, 16); ss += __shfl_xor(ss, 32);
            if (fq == 0) (void)__hip_atomic_fetch_add(ssq + row, ss, __ATOMIC_RELAXED, __HIP_MEMORY_SCOPE_AGENT); }
    }
}
template <int MODE> __device__ __forceinline__ void ph_rms(const float* g1, size_t o1_off, const float* g2, size_t o2_off) {
    PH_IDS; float* Hres = OUTP + OUT_Y; unsigned char* ws = WSP;
    for (int m = gw; m < TALL; m += NGW) rms_row<MODE>(Hres + (size_t)m * DM, g1, (bf16_t*)(ws + o1_off) + (size_t)m * DM, g2, (bf16_t*)(ws + o2_off) + (size_t)m * DM, Hres + (size_t)m * DM, lane);
}
__device__ __forceinline__ void ph_cache_cvt() {
    PH_IDS; const float* cache_k = INF(3); const float* cache_v = INF(4); bf16_t* KALL = (bf16_t*)(BIGP + BIG_KALL); bf16_t* VALL = (bf16_t*)(BIGP + BIG_VALL);
    for (size_t i = gt; i < (size_t)8 * PASTL * 512 / 4; i += NGT) { const size_t e = i * 4, b = e / ((size_t)PASTL * 512), r = e % ((size_t)PASTL * 512);
        const f32x4 kv = *(const f32x4*)(cache_k + e), vv = *(const f32x4*)(cache_v + e); u32x2 w; w.x = pk2(kv.x, kv.y); w.y = pk2(kv.z, kv.w); *(u32x2*)(KALL + b * LKS * 512 + r) = w;
        w.x = pk2(vv.x, vv.y); w.y = pk2(vv.z, vv.w); *(u32x2*)(VALL + b * LKS * 512 + r) = w; }
}
__device__ __forceinline__ void ph_kvfq(LAS unsigned char* lds) {
    unsigned char* ws = WSP; unsigned char* big = ws + WS_BIG; float* out = OUTP;
    pg8::Gemm g{(const bf16_t*)(big + BIG_XN), (const bf16_t*)(ws + WS_WKVF), TALL, 3328, DM, DM}; pg8::StaticOrder S; S.init(TALL, 3328, (int)gridDim.x, (int)blockIdx.x);
    pg8::EpiKVFQ E{out + OUT_KP, out + OUT_VP, out + OUT_LFP, out + OUT_KS, out + OUT_VS, out + OUT_LFS, (bf16_t*)(big + BIG_KB), (bf16_t*)(big + BIG_VB), (bf16_t*)(big + BIG_KALL), (bf16_t*)(big + BIG_VALL),
                    (bf16_t*)(big + BIG_ACT), INF(15), (const float*)(ws + WS_SSQ) + (size_t)1 * TALL};
    pg8::gemm_phase<pg8::EpiKVFQ, pg8::StaticOrder, true, true>(lds, g, S, E);
}
__device__ __forceinline__ void ph_cumsum(LAS unsigned char* lds) {
    PH_IDS; const float* cache_lf = INF(5); const float* out = OUTP; float* FB = (float*)(WSP + WS_FB); float* FS = (float*)(WSP + WS_FS);
    for (int it = blockIdx.x; it < 64 + 128; it += G) {
        LAS float* wtot = (LAS float*)lds;
        const bool smp = it >= 64; const int bh = smp ? it - 64 : it, b = bh >> 4, h = bh & 15, Ls = smp ? LKS : SEQ, per = smp ? 3 : 16, j0 = tid * per;
        float v[16]; float s = 0.f;
#pragma unroll
        for (int i = 0; i < 16; ++i) { const int j = j0 + i; float x = 0.f;
            if (i < per && j < Ls) x = smp ? (j < PASTL ? cache_lf[((size_t)b * PASTL + j) * 16 + h] : out[OUT_LFS + ((size_t)b * 32 + (j - PASTL)) * 16 + h]) : out[OUT_LFP + ((size_t)b * SEQ + j) * 16 + h];
            s += x; v[i] = s; }
        float inc = s;
#pragma unroll
        for (int o = 1; o < 64; o <<= 1) { const float t = __shfl_up(inc, o); if (lane >= o) inc += t; }
        if (lane == 63) wtot[wave] = inc;
        __syncthreads();
        float base = inc - s;
        for (int w = 0; w < wave; ++w) base += wtot[w];
#pragma unroll
        for (int i = 0; i < 16; ++i) { const int j = j0 + i; if (i < per && j < Ls) { const float F = base + v[i];
            if (smp) FS[(size_t)bh * LKS + j] = F; else FB[(size_t)bh * SEQ + j] = -F * 11.313708498984761f; } }
        __syncthreads();
    }
}
__device__ __forceinline__ void ph_attn(unsigned char* lds_raw) {
    unsigned char* ws = WSP; unsigned char* big = ws + WS_BIG;
    fox::attn_phase((char*)lds_raw, (const bf16_t*)(big + BIG_ACT), (const bf16_t*)(big + BIG_KB), (const bf16_t*)(big + BIG_VB), (bf16_t*)OUTP  , (const float*)(ws + WS_FB));
}
__device__ __forceinline__ void ph_sattn(LAS unsigned char* lds) {
    unsigned char* ws = WSP; unsigned char* big = ws + WS_BIG;
    sample_attn((LAS char*)lds, (const bf16_t*)(big + BIG_ACT), (const bf16_t*)(big + BIG_KALL), (const bf16_t*)(big + BIG_VALL), (const float*)(ws + WS_FS), (bf16_t*)OUTP);
}
__device__ __forceinline__ void ph_gateup(LAS unsigned char* lds, const unsigned char* a_ptr, size_t w_off, int ssq_idx) {
    unsigned char* ws = WSP; unsigned char* big = ws + WS_BIG;
    pg8::Gemm g{(const bf16_t*)a_ptr, (const bf16_t*)(ws + w_off), TALL, 2 * DFF, DM, DM}; pg8::StaticOrder S; S.init(TALL, 2 * DFF, (int)gridDim.x, (int)blockIdx.x);
    pg8::EpiSwiglu E{(bf16_t*)(big + BIG_ACT), (const float*)(ws + WS_SSQ) + (size_t)ssq_idx * TALL};
    pg8::gemm_phase<pg8::EpiSwiglu, pg8::StaticOrder, true, true>(lds, g, S, E);
}

__device__ __forceinline__ void ph_final() {
    PH_IDS; const bf16_t* H4 = (const bf16_t*)(BIGP + BIG_XN); const float* ssq = (const float*)(WSP + WS_SSQ) + (size_t)3 * TALL; const float* g = INF(9); float* Y = OUTP + OUT_Y;
    for (int m = gw; m < TALL; m += NGW) {
        const u32x4* hr = (const u32x4*)(H4 + (size_t)m * DM); u32x4 hv[4];
#pragma unroll
        for (int j = 0; j < 4; ++j) hv[j] = hr[64 * j + lane];
        const float rs = 1.0f / sqrtf(ssq[m] * (1.f / DM) + 1e-6f);
#pragma unroll
        for (int j = 0; j < 4; ++j) { const int c0 = (64 * j + lane) * 8; const f32x4 g0 = *(const f32x4*)(g + c0), g1 = *(const f32x4*)(g + c0 + 4);
            f32x4 y0, y1; y0.x = __uint_as_float(hv[j].x << 16); y0.y = __uint_as_float(hv[j].x & 0xffff0000u); y0.z = __uint_as_float(hv[j].y << 16); y0.w = __uint_as_float(hv[j].y & 0xffff0000u);
            y1.x = __uint_as_float(hv[j].z << 16); y1.y = __uint_as_float(hv[j].z & 0xffff0000u); y1.z = __uint_as_float(hv[j].w << 16); y1.w = __uint_as_float(hv[j].w & 0xffff0000u);
            *(f32x4*)(Y + (size_t)m * DM + c0) = y0 * rs * g0; *(f32x4*)(Y + (size_t)m * DM + c0 + 4) = y1 * rs * g1; } }
}
__global__ void __launch_bounds__(NWAVES * 64, 2) yoco_fwd(Params P) {
    extern __shared__ __attribute__((aligned(16))) unsigned char lds_raw[];
    cg::grid_group grid = cg::this_grid();
    LAS unsigned char* lds = (LAS unsigned char*)lds_raw;
    volatile LAS unsigned* bst = (volatile LAS unsigned*)(lds + 148480);
    if (opaque_tid() < 2) bst[opaque_tid()] = 0u;
    __syncthreads();
    const XcdBarrier xbar = xcd_barrier_post((unsigned*)(WSP + WS_BAR), bst);
#define GSYNC() xcd_barrier(xbar)
    ph_prologue(lds);                                                                                   GSYNC();
    if (WSP == nullptr) grid.sync();
    ph_retin(lds); ph_conv<1>(lds);                                                                                      GSYNC();
    ph_retention(lds);                                                                                  GSYNC();
    ph_groupnorm();                                                                                     GSYNC();
    ph_res_gemm<true, TP>(lds, BIGP + PJ_G * 2, WS_WRO, 4096, 4096, nullptr, (bf16_t*)(OUTP + OUT_KP), 0); ph_sample_res<true>(BIGP + (PJ_G + (size_t)TP * 4096) * 2, 4096, WS_WRO, 4096, nullptr, (bf16_t*)(OUTP + OUT_KP), 0);   GSYNC();
    ph_gateup(lds, (const unsigned char*)(OUTP + OUT_KP), WS_WGU0, 0); ph_conv<2>(lds);                                  GSYNC();
    ph_res_gemm<false, TP>(lds, BIGP + BIG_ACT, WS_WDN0, DFF, DFF, (const bf16_t*)(OUTP + OUT_KP), (bf16_t*)(BIGP + BIG_XN), 1); ph_sample_res(BIGP + BIG_ACT + (size_t)TP * DFF * 2, DFF, WS_WDN0, DFF, (const bf16_t*)(OUTP + OUT_KP), (bf16_t*)(BIGP + BIG_XN), 1); ph_cache_cvt();   GSYNC();
    ph_kvfq(lds); ph_conv<3>(lds);                                                                                       GSYNC();
    ph_cumsum(lds);                                                                                     GSYNC();
    ph_attn(lds_raw); __syncthreads(); ph_sattn(lds);                                                   GSYNC();
    ph_res_gemm<false, TP>(lds, (unsigned char*)OUTP, WS_WO, DM, DM, (const bf16_t*)(BIGP + BIG_XN), (bf16_t*)(BIGP + BIG_HKV), 2); ph_sample_res((const unsigned char*)OUTP + (size_t)TP * DM * 2, DM, WS_WO, DM, (const bf16_t*)(BIGP + BIG_XN), (bf16_t*)(BIGP + BIG_HKV), 2);   GSYNC();
    ph_gateup(lds, BIGP + BIG_HKV, WS_WGU1, 2); ph_conv<4>(lds);                                                         GSYNC();
    ph_res_gemm<false, TP>(lds, BIGP + BIG_ACT, WS_WDN1, DFF, DFF, (const bf16_t*)(BIGP + BIG_HKV), (bf16_t*)(BIGP + BIG_XN), 3); ph_sample_res(BIGP + BIG_ACT + (size_t)TP * DFF * 2, DFF, WS_WDN1, DFF, (const bf16_t*)(BIGP + BIG_HKV), (bf16_t*)(BIGP + BIG_XN), 3);   GSYNC();
    ph_final();
}

extern "C" void kernel_launch(void* const* d_in, const int* in_sizes, int n_in, void* d_out, int out_size, void* d_ws, size_t ws_size, hipStream_t stream) {
    static int grid = 0;
    if (grid == 0) {
        if (n_in != 21 || ws_size < WS_END) { fprintf(stderr, "kernel_launch: unexpected n_in %d / ws_size %zu (need %zu)\n", n_in, ws_size, (size_t)WS_END); grid = -1; return; }
        int dev = 0, cus = 0, per_cu = 0;
        (void)hipGetDevice(&dev); (void)hipDeviceGetAttribute(&cus, hipDeviceAttributeMultiprocessorCount, dev);
        if (hipFuncSetAttribute((const void*)yoco_fwd, hipFuncAttributeMaxDynamicSharedMemorySize, LDS_BYTES) != hipSuccess) { fprintf(stderr, "kernel_launch: hipFuncSetAttribute failed\n"); grid = -1; return; }
        if (hipOccupancyMaxActiveBlocksPerMultiprocessor(&per_cu, (const void*)yoco_fwd, NWAVES * 64, LDS_BYTES) != hipSuccess || per_cu < 1) { fprintf(stderr, "kernel_launch: occupancy query says %d\n", per_cu); per_cu = 1; }
        (void)hipGetLastError();
        grid = cus > 0 ? cus : 256;
    }
    if (grid < 0) return;
    if (hipMemsetAsync((char*)d_ws + WS_BAR, 0, XCD_BAR_WORDS * 4, stream) != hipSuccess) { fprintf(stderr, "kernel_launch: memset of the barrier words failed\n"); return; }
    Params p{};
    for (int i = 0; i < 21; ++i) p.in[i] = (const float*)d_in[i];
    p.out = (float*)d_out; p.ws = (unsigned char*)d_ws;
    void* args[] = {&p};
    hipError_t e = hipLaunchCooperativeKernel((const void*)yoco_fwd, dim3(grid), dim3(NWAVES * 64), args, LDS_BYTES, stream);
    if (e != hipSuccess) fprintf(stderr, "cooperative launch failed: %s (grid %d)\n", hipGetErrorString(e), grid);
}
```

```cpp
#include <hip/hip_runtime.h>
#include <hip/hip_cooperative_groups.h>
#include <cstdio>
#include <cstdint>
namespace cg = cooperative_groups;
__device__ __forceinline__ int opaque_tid() { int t = threadIdx.x; asm volatile("" : "+v"(t)); return t; }
namespace pg8 {
#define PG8_LAS __attribute__((address_space(3)))
typedef unsigned short bf16_t;
typedef short bf16x8 __attribute__((ext_vector_type(8)));
typedef float f32x4 __attribute__((ext_vector_type(4)));
typedef unsigned u32x4 __attribute__((ext_vector_type(4)));
constexpr int BM = 256, BK = 64, HALF = 128, HTB = HALF * BK * 2  , STAGE_BYTES = 8 * HTB, NXCD = 8, WGM = 4;

__host__ __device__ __forceinline__ int lds_byte(int r, int c) { const int st = (r >> 4) * 2 + (c >> 5), rr = r & 15, cc = c & 31, ob = rr * 64 + cc * 2; return st * 1024 + (ob ^ (((ob >> 9) & 1) << 5)); }
__host__ __device__ __forceinline__ void stage_rc(int b, int& R, int& C) { const int st = b / 1024, sb = b % 1024, swz = sb ^ (((sb >> 9) & 1) << 5); R = (st >> 1) * 16 + swz / 64; C = (st & 1) * 32 + (swz % 64) / 2; }
__host__ __device__ __forceinline__ int perm32(int rho) { const int n = rho >> 4, i = rho & 15; return 8 * (i >> 2) + 4 * n + (i & 3); }

struct Unit { int pm, pn; };
struct Gemm { const bf16_t* A; const bf16_t* Bt; int M, N, K, lda; };

struct StaticOrder {
    int nM, nN, nwg, G, c;
    __host__ __device__ void init(int M, int N, int G_, int c_) { nM = M / BM; nN = N / BM; nwg = nM * nN; G = G_; c = c_; }
    __host__ __device__ bool next(int i, Unit& u) const {
        const long L = (long)i * G + c; if (L >= nwg) return false;
        int wgid = (int)L; { const int q = nwg / NXCD, r = nwg % NXCD, xcd = wgid % NXCD, off = wgid / NXCD; wgid = (xcd < r ? xcd * (q + 1) : r * (q + 1) + (xcd - r) * q) + off; }
        const int nig = WGM * nN, gid = wgid / nig, fm = gid * WGM, gsz = (nM - fm) < WGM ? (nM - fm) : WGM;
        u.pm = fm + ((wgid % nig) % gsz); u.pn = (wgid % nig) / gsz; return true;
    }
    __device__ __forceinline__ void a_ready(const Unit&) const {}
    __device__ __forceinline__ void done(const Unit&) const {}
};

__device__ __forceinline__ unsigned cvt_pk_bf16(float lo, float hi) { unsigned r; asm volatile("v_cvt_pk_bf16_f32 %0, %1, %2" : "=v"(r) : "v"(lo), "v"(hi)); return r; }
template <class Epi, class Sched, bool ALIGN_EPI = false, bool SP2 = false>
__device__ __forceinline__ void gemm_phase(PG8_LAS unsigned char* lds, const Gemm g, const Sched& S, const Epi& E) {
    const int tid = opaque_tid(), wid = __builtin_amdgcn_readfirstlane(tid >> 6), lane = tid & 63, wr = wid >> 2, wc = wid & 3, fr = lane & 15, fq = lane >> 4;
    const int K = g.K, nt = K / BK;
    unsigned voffA[2], voffB[2];
#pragma unroll
    for (int i = 0; i < 2; ++i) { int R, C; stage_rc(tid * 16 + i * 8192, R, C); const int Rb = Epi::PERM ? ((R & ~31) + perm32(R & 31)) : R;
        voffA[i] = (unsigned)(R * g.lda + C) * 2u; voffB[i] = (unsigned)(Rb * K + C) * 2u; }
    const size_t kstep = (size_t)(BK * 2);
    const size_t hstep = (size_t)HALF * K * 2, hstepA = (size_t)HALF * g.lda * 2;
    const size_t tstep = 2 * hstep, tstepA = 2 * hstepA;
    const unsigned ldsw = (unsigned)wid * 1024u;
    const int aoff = lds_byte(wr * 64 + fr, fq * 8), boff = lds_byte(wc * 32 + fr, fq * 8);
#define PG8_SA(b, h) (((b) * 2 + (h)) * HTB)
#define PG8_SB(b, h) ((4 + (b) * 2 + (h)) * HTB)
#define PG8_STAGE(bufoff, gbase, voff) do { _Pragma("unroll") for (int _i = 0; _i < 2; ++_i) \
        __builtin_amdgcn_global_load_lds((const unsigned*)((const char*)(gbase) + (voff)[_i]), (PG8_LAS unsigned*)(lds + (bufoff) + ldsw + _i * 8192), 16, 0, 0); } while (0)
#define PG8_LDA(dst, b, h) do { _Pragma("unroll") for (int m = 0; m < 4; ++m) _Pragma("unroll") for (int k = 0; k < 2; ++k) dst[m][k] = *(const PG8_LAS bf16x8*)(lds + PG8_SA(b, h) + aoff + m * 2048 + k * 1024); } while (0)
#define PG8_LDB(dst, b, h) do { _Pragma("unroll") for (int n = 0; n < 2; ++n) _Pragma("unroll") for (int k = 0; k < 2; ++k) dst[n][k] = *(const PG8_LAS bf16x8*)(lds + PG8_SB(b, h) + boff + n * 2048 + k * 1024); } while (0)
#define PG8_MMA(ai, bj, At, Bt) do { __builtin_amdgcn_s_setprio(1); _Pragma("unroll") for (int m = 0; m < 4; ++m) _Pragma("unroll") for (int n = 0; n < 2; ++n) _Pragma("unroll") for (int k = 0; k < 2; ++k) \
        acc[ai][bj][m][n] = __builtin_amdgcn_mfma_f32_16x16x32_bf16(Bt[n][k], At[m][k], acc[ai][bj][m][n], 0, 0, 0); __builtin_amdgcn_s_setprio(0); } while (0)
#define PG8_WAIT_V(n) asm volatile("s_waitcnt vmcnt(" #n ")" ::: "memory")
#define PG8_WAIT_L(n) asm volatile("s_waitcnt lgkmcnt(" #n ")" ::: "memory")
#define PG8_BAR __builtin_amdgcn_s_barrier()
#define PG8_SCHED __builtin_amdgcn_sched_barrier(0)
    Unit cur, nxt; int ui = 0;
    if (!S.next(0, cur)) return;
    f32x4 acc[2][2][4][2];
#pragma unroll
    for (int a = 0; a < 2; ++a)
#pragma unroll
        for (int b = 0; b < 2; ++b)
#pragma unroll
            for (int m = 0; m < 4; ++m)
#pragma unroll
                for (int n = 0; n < 2; ++n) acc[a][b][m][n] = (f32x4){0.f, 0.f, 0.f, 0.f};
    bf16x8 At[4][2], B0[2][2], B1[2][2];
    const char* cA = (const char*)g.A + (size_t)cur.pm * tstepA; const char* cB = (const char*)g.Bt + (size_t)cur.pn * tstep;
    S.a_ready(cur);
    if constexpr (SP2) {
        PG8_STAGE(PG8_SB(0, 0), cB, voffB); PG8_STAGE(PG8_SB(0, 1), cB + hstep, voffB); PG8_STAGE(PG8_SA(0, 0), cA, voffA); PG8_STAGE(PG8_SA(0, 1), cA + hstepA, voffA);
        if (wr == 1) PG8_BAR;
        PG8_WAIT_V(2); PG8_BAR;
        PG8_STAGE(PG8_SB(1, 0), cB + kstep, voffB); PG8_STAGE(PG8_SA(1, 0), cA + kstep, voffA); PG8_STAGE(PG8_SB(1, 1), cB + hstep + kstep, voffB);
        PG8_WAIT_V(6); PG8_BAR;
    } else {
        PG8_STAGE(PG8_SB(0, 0), cB, voffB); PG8_STAGE(PG8_SA(0, 0), cA, voffA); PG8_STAGE(PG8_SB(0, 1), cB + hstep, voffB); PG8_STAGE(PG8_SA(0, 1), cA + hstepA, voffA);
        if (wr == 1) PG8_BAR;
        PG8_WAIT_V(4); PG8_BAR;
        PG8_STAGE(PG8_SB(1, 0), cB + kstep, voffB); PG8_STAGE(PG8_SA(1, 0), cA + kstep, voffA); PG8_STAGE(PG8_SB(1, 1), cB + hstep + kstep, voffB);
        PG8_WAIT_V(6); PG8_BAR;
    }
    for (;;) {
        const bool has_next = S.next(ui + 1, nxt);
        const char* nA = has_next ? (const char*)g.A + (size_t)nxt.pm * tstepA : cA; const char* nB = has_next ? (const char*)g.Bt + (size_t)nxt.pn * tstep : cB;
        for (int t = 0; t < nt; t += 2) {
            const bool last = (t == nt - 2);
            const char* a1 = cA + (size_t)(t + 1) * kstep;
            const char* a2 = last ? nA : cA + (size_t)(t + 2) * kstep; const char* b2 = last ? nB : cB + (size_t)(t + 2) * kstep;
            const char* a3 = a2 + kstep; const char* b3 = b2 + kstep;
            if (last && has_next) S.a_ready(nxt);
            if constexpr (SP2) {
            PG8_LDB(B0, 0, 0); PG8_LDB(B1, 0, 1); PG8_SCHED; PG8_LDA(At, 0, 0); PG8_STAGE(PG8_SA(1, 1), a1 + hstepA, voffA);
            PG8_WAIT_V(8); PG8_WAIT_L(0); PG8_BAR; PG8_MMA(0, 0, At, B0); PG8_MMA(0, 1, At, B1); PG8_BAR; PG8_SCHED;
            PG8_LDA(At, 0, 1); PG8_STAGE(PG8_SB(0, 0), b2, voffB); PG8_STAGE(PG8_SB(0, 1), b2 + hstep, voffB); PG8_STAGE(PG8_SA(0, 0), a2, voffA);
            PG8_WAIT_V(8); PG8_WAIT_L(0); PG8_BAR; PG8_MMA(1, 0, At, B0); PG8_MMA(1, 1, At, B1); PG8_BAR; PG8_SCHED;
            PG8_LDB(B0, 1, 0); PG8_LDB(B1, 1, 1); PG8_SCHED; PG8_LDA(At, 1, 0); PG8_STAGE(PG8_SA(0, 1), a2 + hstepA, voffA);
            PG8_WAIT_V(8); PG8_WAIT_L(0); PG8_BAR; PG8_MMA(0, 0, At, B0); PG8_MMA(0, 1, At, B1); PG8_BAR; PG8_SCHED;
            PG8_LDA(At, 1, 1); PG8_STAGE(PG8_SB(1, 0), b3, voffB); PG8_STAGE(PG8_SB(1, 1), b3 + hstep, voffB); PG8_STAGE(PG8_SA(1, 0), a3, voffA);
            PG8_WAIT_V(8); PG8_WAIT_L(0); PG8_BAR; PG8_MMA(1, 0, At, B0); PG8_MMA(1, 1, At, B1); PG8_BAR; PG8_SCHED;
            } else {
            PG8_LDB(B0, 0, 0); PG8_SCHED; PG8_LDA(At, 0, 0); PG8_STAGE(PG8_SA(1, 1), a1 + hstepA, voffA);
            PG8_WAIT_L(8); PG8_BAR; PG8_WAIT_L(0); PG8_MMA(0, 0, At, B0); PG8_BAR; PG8_SCHED;
            PG8_LDB(B1, 0, 1); PG8_STAGE(PG8_SB(0, 0), b2, voffB);
            PG8_BAR; PG8_WAIT_L(0); PG8_MMA(0, 1, At, B1); PG8_BAR;
            PG8_LDA(At, 0, 1); PG8_STAGE(PG8_SA(0, 0), a2, voffA);
            PG8_BAR; PG8_WAIT_L(0); PG8_MMA(1, 0, At, B0); PG8_BAR; PG8_SCHED;
            PG8_STAGE(PG8_SB(0, 1), b2 + hstep, voffB);
            PG8_WAIT_V(6); PG8_BAR; PG8_MMA(1, 1, At, B1); PG8_BAR;
            PG8_LDB(B0, 1, 0); PG8_SCHED; PG8_LDA(At, 1, 0); PG8_STAGE(PG8_SA(0, 1), a2 + hstepA, voffA);
            PG8_WAIT_L(8); PG8_BAR; PG8_WAIT_L(0); PG8_MMA(0, 0, At, B0); PG8_BAR; PG8_SCHED;
            PG8_LDB(B1, 1, 1); PG8_STAGE(PG8_SB(1, 0), b3, voffB);
            PG8_BAR; PG8_WAIT_L(0); PG8_MMA(0, 1, At, B1); PG8_BAR;
            PG8_LDA(At, 1, 1); PG8_STAGE(PG8_SA(1, 0), a3, voffA);
            PG8_BAR; PG8_WAIT_L(0); PG8_MMA(1, 0, At, B0); PG8_BAR; PG8_SCHED;
            PG8_STAGE(PG8_SB(1, 1), b3 + hstep, voffB);
            PG8_WAIT_V(6); PG8_BAR; PG8_MMA(1, 1, At, B1); PG8_BAR;
            }
        }
        if constexpr (ALIGN_EPI) { if (wr == 0) PG8_BAR; }
        if constexpr (!Epi::AFTER_DRAIN) { E(acc, cur, wr, wc, fr, fq); S.done(cur); }
        if (!has_next) break;
#pragma unroll
        for (int a = 0; a < 2; ++a)
#pragma unroll
            for (int b = 0; b < 2; ++b)
#pragma unroll
                for (int m = 0; m < 4; ++m)
#pragma unroll
                    for (int n = 0; n < 2; ++n) acc[a][b][m][n] = (f32x4){0.f, 0.f, 0.f, 0.f};
        cur = nxt; cA = nA; cB = nB; ++ui;
        if constexpr (ALIGN_EPI) { if (wr == 1) PG8_BAR; }
    }
    PG8_WAIT_V(0);
    if constexpr (!ALIGN_EPI) { if (wr == 0) PG8_BAR; }
    PG8_BAR;
    if constexpr (Epi::AFTER_DRAIN) { E.fused(acc, cur, wr, wc, fr, fq, lds, wid, lane); S.done(cur); }
#undef PG8_SA
#undef PG8_SB
#undef PG8_STAGE
#undef PG8_LDA
#undef PG8_LDB
#undef PG8_MMA
#undef PG8_WAIT_V
#undef PG8_WAIT_L
#undef PG8_BAR
#undef PG8_SCHED
}
}
constexpr int DM = 2048, TP = 32768, TSMP = 256, TALL = 33024, SEQ = 8192, NPROJ = 12288, DFF = 5632, PASTL = 1024, LKS = 1056;
constexpr size_t PJ_Q = 0, PJ_K = (size_t)TALL * 2048, PJ_V = (size_t)TALL * 4096, PJ_G = (size_t)TALL * 8192;
__device__ __forceinline__ size_t hrow(int row, int h) { return row < TP ? ((size_t)((row >> 13) * 8 + h) << 13) + (row & 8191) : (size_t)262144 + (size_t)((((row - TP) >> 5) * 8 + h) << 5) + ((row - TP) & 31); }
#define GAS __attribute__((address_space(1)))
#define LAS __attribute__((address_space(3)))
typedef unsigned short bf16_t;
typedef float f32x4 __attribute__((ext_vector_type(4)));
typedef unsigned u32x4 __attribute__((ext_vector_type(4)));
typedef unsigned u32x2 __attribute__((ext_vector_type(2)));
typedef short bf16x8 __attribute__((ext_vector_type(8)));
typedef short s16x4 __attribute__((ext_vector_type(4)));

namespace pg8 {
__device__ __forceinline__ float silu_f(float g) { return g * __builtin_amdgcn_rcpf(1.0f + __builtin_amdgcn_exp2f(-1.4426950408889634f * g)); }
struct EpiBf16P {
    static constexpr bool PERM = true, AFTER_DRAIN = false;
    bf16_t* O; int ldc;
    __device__ __forceinline__ void operator()(const f32x4 (&acc)[2][2][4][2], const Unit& u, int wr, int wc, int fr, int fq) const {
        const int row0 = u.pm * BM + wr * 64 + fr, col0 = u.pn * BM + wc * 32 + 8 * fq;
#pragma unroll
        for (int ai = 0; ai < 2; ++ai)
#pragma unroll
            for (int m = 0; m < 4; ++m) { bf16_t* rowp = O + (size_t)(row0 + ai * HALF + m * 16) * ldc + col0;
#pragma unroll
                for (int bj = 0; bj < 2; ++bj) { const f32x4 v0 = acc[ai][bj][m][0], v1 = acc[ai][bj][m][1];
                    u32x4 w; w.x = cvt_pk_bf16(v0[0], v0[1]); w.y = cvt_pk_bf16(v0[2], v0[3]); w.z = cvt_pk_bf16(v1[0], v1[1]); w.w = cvt_pk_bf16(v1[2], v1[3]);
                    *(u32x4*)(rowp + bj * HALF) = w; } }
    }
};
struct EpiRetIn {
    static constexpr bool PERM = true, AFTER_DRAIN = false;
    bf16_t* O; const float* cosT; const float* sinT;
    __device__ __forceinline__ void operator()(const f32x4 (&acc)[2][2][4][2], const Unit& u, int wr, int wc, int fr, int fq) const {
        const int row0 = u.pm * BM + wr * 64 + fr, cl = wc * 32 + 8 * fq;
        if (u.pn < 16) {
            const bool isk = u.pn >= 8; const int h = u.pn & 7;
            const float lg2 = __log2f(1.0f - exp2f(-5.0f - (float)h));
#pragma unroll
            for (int ai = 0; ai < 2; ++ai) {
                f32x4 cs[4][4]; float scv[4];
#pragma unroll
                for (int m = 0; m < 4; ++m) {
                    const int row = row0 + ai * HALF + m * 16; int pos, l;
                    if (row < TP) { pos = row & (SEQ - 1); l = row & 63; } else { const int s = (row - TP) & 31; pos = PASTL + s; l = s; }
                    scv[m] = isk ? exp2f(-lg2 * (float)l) * 0.0625f : exp2f(lg2 * (float)l);
                    const float* cp = cosT + (size_t)pos * 128 + cl; const float* sp = sinT + (size_t)pos * 128 + cl;
                    cs[m][0] = *(const f32x4*)cp; cs[m][1] = *(const f32x4*)(cp + 4); cs[m][2] = *(const f32x4*)sp; cs[m][3] = *(const f32x4*)(sp + 4); }
#pragma unroll
                for (int m = 0; m < 4; ++m) {
                    const int row = row0 + ai * HALF + m * 16; const float sc = scv[m];
                    const f32x4 c0 = cs[m][0], c1 = cs[m][1], s0 = cs[m][2], s1 = cs[m][3];
                    const f32x4 x1a = acc[ai][0][m][0], x1b = acc[ai][0][m][1], x2a = acc[ai][1][m][0], x2b = acc[ai][1][m][1];
                    const f32x4 o1a = (x1a * c0 - x2a * s0) * sc, o1b = (x1b * c1 - x2b * s1) * sc, o2a = (x1a * s0 + x2a * c0) * sc, o2b = (x1b * s1 + x2b * c1) * sc;
                    bf16_t* rowp = O + (isk ? PJ_K : PJ_Q) + hrow(row, h) * 256 + cl;
                    u32x4 w; w.x = cvt_pk_bf16(o1a[0], o1a[1]); w.y = cvt_pk_bf16(o1a[2], o1a[3]); w.z = cvt_pk_bf16(o1b[0], o1b[1]); w.w = cvt_pk_bf16(o1b[2], o1b[3]);
                    *(u32x4*)rowp = w;
                    w.x = cvt_pk_bf16(o2a[0], o2a[1]); w.y = cvt_pk_bf16(o2a[2], o2a[3]); w.z = cvt_pk_bf16(o2b[0], o2b[1]); w.w = cvt_pk_bf16(o2b[2], o2b[3]);
                    *(u32x4*)(rowp + HALF) = w; }
                asm volatile("" ::: "memory"); }
        } else {
            const bool isv = u.pn < 32; const int hv = (u.pn - 16) >> 1, e0 = ((u.pn - 16) & 1) * 256 + cl;
#pragma unroll
            for (int ai = 0; ai < 2; ++ai)
#pragma unroll
                for (int m = 0; m < 4; ++m) { const int row = row0 + ai * HALF + m * 16;
                    bf16_t* rowp = isv ? O + PJ_V + hrow(row, hv) * 512 + e0 : O + PJ_G + (size_t)row * 4096 + (u.pn - 32) * BM + cl;
#pragma unroll
                    for (int bj = 0; bj < 2; ++bj) { const f32x4 v0 = acc[ai][bj][m][0], v1 = acc[ai][bj][m][1];
                        u32x4 w; w.x = cvt_pk_bf16(v0[0], v0[1]); w.y = cvt_pk_bf16(v0[2], v0[3]); w.z = cvt_pk_bf16(v1[0], v1[1]); w.w = cvt_pk_bf16(v1[2], v1[3]);
                        *(u32x4*)(rowp + bj * HALF) = w; } }
        }
    }
};
template <bool BASEBF> struct EpiRes {
    static constexpr bool PERM = true, AFTER_DRAIN = false;
    const float* baseP; const float* baseS; const bf16_t* baseH; bf16_t* hb; float* ssq;
    __device__ __forceinline__ void operator()(const f32x4 (&acc)[2][2][4][2], const Unit& u, int wr, int wc, int fr, int fq) const {
        const int row0 = u.pm * BM + wr * 64 + fr, col0 = u.pn * BM + wc * 32 + 8 * fq;
#pragma unroll
        for (int ai = 0; ai < 2; ++ai) {
            f32x4 bv[4][2][2];
#pragma unroll
            for (int m = 0; m < 4; ++m) { const int row = row0 + ai * HALF + m * 16;
                if (BASEBF) { const bf16_t* b = baseH + (size_t)row * DM + col0;
#pragma unroll
                    for (int bj = 0; bj < 2; ++bj) { const u32x4 t = *(const u32x4*)(b + bj * HALF);
                        bv[m][bj][0] = (f32x4){__uint_as_float(t.x << 16), __uint_as_float(t.x & 0xffff0000u), __uint_as_float(t.y << 16), __uint_as_float(t.y & 0xffff0000u)};
                        bv[m][bj][1] = (f32x4){__uint_as_float(t.z << 16), __uint_as_float(t.z & 0xffff0000u), __uint_as_float(t.w << 16), __uint_as_float(t.w & 0xffff0000u)}; } }
                else { const float* b = (row < TP ? baseP + (size_t)row * DM : baseS + (size_t)(row - TP) * DM) + col0;
#pragma unroll
                    for (int bj = 0; bj < 2; ++bj)
#pragma unroll
                        for (int n = 0; n < 2; ++n) bv[m][bj][n] = *(const f32x4*)(b + bj * HALF + n * 4); } }
#pragma unroll
            for (int m = 0; m < 4; ++m) { const int row = row0 + ai * HALF + m * 16; float ss = 0.f;
#pragma unroll
                for (int bj = 0; bj < 2; ++bj) { const f32x4 v0 = bv[m][bj][0] + acc[ai][bj][m][0], v1 = bv[m][bj][1] + acc[ai][bj][m][1];
                    u32x4 w; w.x = cvt_pk_bf16(v0[0], v0[1]); w.y = cvt_pk_bf16(v0[2], v0[3]); w.z = cvt_pk_bf16(v1[0], v1[1]); w.w = cvt_pk_bf16(v1[2], v1[3]);
                    *(u32x4*)(hb + (size_t)row * DM + col0 + bj * HALF) = w;
                    ss += ((v0[0] * v0[0] + v0[1] * v0[1]) + (v0[2] * v0[2] + v0[3] * v0[3])) + ((v1[0] * v1[0] + v1[1] * v1[1]) + (v1[2] * v1[2] + v1[3] * v1[3])); }
                ss += __shfl_xor(ss, 16); ss += __shfl_xor(ss, 32);
                if (fq == 0) (void)__hip_atomic_fetch_add(ssq + row, ss, __ATOMIC_RELAXED, __HIP_MEMORY_SCOPE_AGENT); }
            asm volatile("" ::: "memory"); }
    }
};
struct EpiSwiglu {
    static constexpr bool PERM = true, AFTER_DRAIN = false;
    bf16_t* O; const float* ssq;
    __device__ __forceinline__ void operator()(const f32x4 (&acc)[2][2][4][2], const Unit& u, int wr, int wc, int fr, int fq) const {
        const int row0 = u.pm * BM + wr * 64 + fr, col0 = u.pn * HALF + wc * 32 + 8 * fq;
        float rs[2][4];
#pragma unroll
        for (int ai = 0; ai < 2; ++ai)
#pragma unroll
            for (int m = 0; m < 4; ++m) rs[ai][m] = ssq[row0 + ai * HALF + m * 16];
#pragma unroll
        for (int ai = 0; ai < 2; ++ai)
#pragma unroll
            for (int m = 0; m < 4; ++m) { bf16_t* rowp = O + (size_t)(row0 + ai * HALF + m * 16) * DFF + col0; const float r = 1.0f / sqrtf(rs[ai][m] * (1.f / DM) + 1e-6f);
                const f32x4 g0 = acc[ai][0][m][0] * r, g1 = acc[ai][0][m][1] * r, u0 = acc[ai][1][m][0] * r, u1 = acc[ai][1][m][1] * r;
                f32x4 a0, a1;
#pragma unroll
                for (int j = 0; j < 4; ++j) { a0[j] = silu_f(g0[j]) * u0[j]; a1[j] = silu_f(g1[j]) * u1[j]; }
                u32x4 w; w.x = cvt_pk_bf16(a0[0], a0[1]); w.y = cvt_pk_bf16(a0[2], a0[3]); w.z = cvt_pk_bf16(a1[0], a1[1]); w.w = cvt_pk_bf16(a1[2], a1[3]);
                *(u32x4*)rowp = w; }
    }
};
struct EpiKVFQ {
    static constexpr bool PERM = true, AFTER_DRAIN = false;
    float* kP; float* vP; float* lfP; float* kS; float* vS; float* lfS; bf16_t* KB; bf16_t* VB; bf16_t* KALL; bf16_t* VALL; bf16_t* QB; const float* bf; const float* ssq;
    __device__ __forceinline__ void operator()(const f32x4 (&acc)[2][2][4][2], const Unit& u, int wr, int wc, int fr, int fq) const {
        const int row0 = u.pm * BM + wr * 64 + fr;
        float rs[2][4];
#pragma unroll
        for (int ai = 0; ai < 2; ++ai)
#pragma unroll
            for (int m = 0; m < 4; ++m) rs[ai][m] = 1.0f / sqrtf(ssq[row0 + ai * HALF + m * 16] * (1.f / DM) + 1e-6f);
        if (u.pn >= 5) {
            const int col0 = (u.pn - 5) * BM + wc * 32 + 8 * fq;
#pragma unroll
            for (int ai = 0; ai < 2; ++ai)
#pragma unroll
                for (int m = 0; m < 4; ++m) { bf16_t* bo = QB + (size_t)(row0 + ai * HALF + m * 16) * DM + col0;
#pragma unroll
                    for (int bj = 0; bj < 2; ++bj) { const f32x4 v0 = acc[ai][bj][m][0] * rs[ai][m], v1 = acc[ai][bj][m][1] * rs[ai][m];
                        u32x4 w; w.x = cvt_pk_bf16(v0[0], v0[1]); w.y = cvt_pk_bf16(v0[2], v0[3]); w.z = cvt_pk_bf16(v1[0], v1[1]); w.w = cvt_pk_bf16(v1[2], v1[3]); *(u32x4*)(bo + bj * HALF) = w; } }
        } else if (u.pn < 4) {
            const bool isv = u.pn >= 2; const int col0 = (u.pn & 1) * BM + wc * 32 + 8 * fq;
            float* fP = isv ? vP : kP; float* fS = isv ? vS : kS; bf16_t* bP = isv ? VB : KB; bf16_t* bA = isv ? VALL : KALL;
#pragma unroll
            for (int ai = 0; ai < 2; ++ai)
#pragma unroll
                for (int m = 0; m < 4; ++m) { const int row = row0 + ai * HALF + m * 16; float* fo; bf16_t* bo;
                    if (row < TP) { fo = fP + (size_t)row * 512 + col0; bo = bP + (size_t)row * 512 + col0; }
                    else { const int r2 = row - TP; fo = fS + (size_t)r2 * 512 + col0; bo = bA + ((size_t)(r2 >> 5) * LKS + PASTL + (r2 & 31)) * 512 + col0; }
#pragma unroll
                    for (int bj = 0; bj < 2; ++bj) { const f32x4 v0 = acc[ai][bj][m][0] * rs[ai][m], v1 = acc[ai][bj][m][1] * rs[ai][m];
                        *(f32x4*)(fo + bj * HALF) = v0; *(f32x4*)(fo + bj * HALF + 4) = v1;
                        u32x4 w; w.x = cvt_pk_bf16(v0[0], v0[1]); w.y = cvt_pk_bf16(v0[2], v0[3]); w.z = cvt_pk_bf16(v1[0], v1[1]); w.w = cvt_pk_bf16(v1[2], v1[3]); *(u32x4*)(bo + bj * HALF) = w; } }
        } else if (wc == 0 && fq < 2) {
#pragma unroll
            for (int n = 0; n < 2; ++n) { const f32x4 bb = *(const f32x4*)(bf + 8 * fq + 4 * n);
#pragma unroll
                for (int ai = 0; ai < 2; ++ai)
#pragma unroll
                    for (int m = 0; m < 4; ++m) { const int row = row0 + ai * HALF + m * 16; const f32x4 z = acc[ai][0][m][n] * rs[ai][m] + bb; f32x4 r;
#pragma unroll
                        for (int j = 0; j < 4; ++j) r[j] = fminf(z[j], 0.f) - log1pf(__expf(-fabsf(z[j])));
                        float* o = row < TP ? lfP + (size_t)row * 16 : lfS + (size_t)(row - TP) * 16; *(f32x4*)(o + 8 * fq + 4 * n) = r; } }
        }
    }
};
}
namespace fox {
enum { ORDER_NATURAL = 0, ORDER_REVERSED = 1, ORDER_PAIRED = 2, ORDER_XCD = 4 };
constexpr int D = 128, QS = 2048, KS = 512, OS = 2048;
constexpr float THR = 8.f;
constexpr bool WSKIP = false;
constexpr float SCALE = 0.08838834764831845f;
constexpr int NW = 8, QBLK = 32, KVBLK = 64, QB = NW * QBLK;
constexpr int SHM_V = KVBLK * D * 2, SHM_K = KVBLK * D * 2;
constexpr int LDS_BYTES = 2 * SHM_V + 2 * SHM_K + NW * 64 * 4 + 2 * 64 * 4;
typedef unsigned short bf16;
typedef short bf16x8 __attribute__((ext_vector_type(8)));
typedef short s16x4 __attribute__((ext_vector_type(4)));
typedef float f32x16 __attribute__((ext_vector_type(16)));
typedef float f32x4 __attribute__((ext_vector_type(4)));
typedef unsigned u32x4 __attribute__((ext_vector_type(4)));
template <class A, class Bt> struct same_t { static constexpr bool v = false; };
template <class A> struct same_t<A, A> { static constexpr bool v = true; };

#define KSWZ(row, colB) ((row) * 256 + ((colB) ^ (((row) & 7) << 4)))
#define SBAR() __builtin_amdgcn_sched_barrier(0)
__device__ __forceinline__ int v_st(int k, int c) { const int kk = (k & ~0xC) | ((k & 4) << 1) | ((k & 8) >> 1); return ((kk >> 3) * 4 + (c >> 5)) * 512 + ((kk & 7) * 32 + (c & 31)) * 2; }
__device__ __forceinline__ int v_rd_base(int lane) { return ((lane & 3) << 3) | (((lane >> 2) & 3) << 6) | (((lane >> 4) & 1) << 5) | (((lane >> 5) & 1) << 8); }
constexpr int v_rd_off(int d0, int ks, int half) { return d0 * 512 + ks * 4096 + half * 2048; }
__device__ __forceinline__ int crow(int r, int hi) { return (r & 3) + 8 * (r >> 2) + 4 * hi; }
__device__ __forceinline__ unsigned cvtpk(float lo, float hi) {
    unsigned r; asm volatile("v_cvt_pk_bf16_f32 %0, %1, %2" : "=v"(r) : "v"(lo), "v"(hi)); return r;
}
__device__ __forceinline__ bf16x8 pack8(f32x4 a, f32x4 b) {
    u32x4 w = {cvtpk(a[0], a[1]), cvtpk(a[2], a[3]), cvtpk(b[0], b[1]), cvtpk(b[2], b[3])};
    return *reinterpret_cast<bf16x8*>(&w);
}
template <class T> __device__ __forceinline__ bf16x8 load8(const T* p) {
    if constexpr (same_t<T, float>::v) { return pack8(*(const f32x4*)p, *(const f32x4*)(p + 4)); }
    else { return *reinterpret_cast<const bf16x8*>(p); }
}
__device__ __forceinline__ void mask_tile(f32x16& p0, f32x16& p1, int dq, unsigned W) {
    const float NEG = -__builtin_inff();
#pragma unroll
    for (int r = 0; r < 16; ++r) {
        const int c = (r & 3) + 8 * (r >> 2);
        if ((unsigned)(dq - c) >= W) p0[r] = NEG;
        if ((unsigned)(dq - c - 32) >= W) p1[r] = NEG;
    }
}
__device__ __forceinline__ void partialSM(f32x16& p0, f32x16& p1, float& m_reg, float& mn, float& alpha) {
    float pmax = p0[0]; for (int r = 1; r < 16; ++r) pmax = fmaxf(pmax, p0[r]); for (int r = 0; r < 16; ++r) pmax = fmaxf(pmax, p1[r]);
    { auto rr = __builtin_amdgcn_permlane32_swap(__float_as_uint(pmax), __float_as_uint(pmax), false, false);
      pmax = fmaxf(__uint_as_float(rr[0]), __uint_as_float(rr[1])); }
    constexpr float C2 = 1.4426950408889634f * SCALE;
    if (__builtin_expect(__all((pmax - m_reg) * SCALE <= THR), 1)) { mn = m_reg; alpha = 1.f; }
    else { mn = fmaxf(m_reg, pmax); alpha = __builtin_amdgcn_exp2f((m_reg - mn) * C2); m_reg = mn; }
    const float mnL = -mn * C2;
    for (int r = 0; r < 16; ++r) p0[r] = fmaf(p0[r], C2, mnL); for (int r = 0; r < 16; ++r) p1[r] = fmaf(p1[r], C2, mnL);
    for (int r = 0; r < 16; ++r) p0[r] = __builtin_amdgcn_exp2f(p0[r]);
}
__device__ __forceinline__ void finishSM(f32x16& p0, f32x16& p1, float alpha, float& l_reg, bf16x8& pa0, bf16x8& pa1, bf16x8& pa2, bf16x8& pa3) {
    for (int r = 0; r < 16; ++r) p1[r] = __builtin_amdgcn_exp2f(p1[r]);
    float ps = 0; for (int r = 0; r < 16; ++r) ps += p0[r]; for (int r = 0; r < 16; ++r) ps += p1[r];
    { auto rr = __builtin_amdgcn_permlane32_swap(__float_as_uint(ps), __float_as_uint(ps), false, false);
      ps = __uint_as_float(rr[0]) + __uint_as_float(rr[1]); }
    l_reg = l_reg * alpha + ps;
#define PK4(P, B_, OUT) do { unsigned a0 = cvtpk(P[B_+0], P[B_+1]), a1 = cvtpk(P[B_+2], P[B_+3]);                          \
        unsigned b0 = cvtpk(P[B_+4], P[B_+5]), b1 = cvtpk(P[B_+6], P[B_+7]);                                             \
        auto r0 = __builtin_amdgcn_permlane32_swap(a0, b0, false, false); auto r1 = __builtin_amdgcn_permlane32_swap(a1, b1, false, false); \
        u32x4 w = {r0[0], r1[0], r0[1], r1[1]}; OUT = *reinterpret_cast<bf16x8*>(&w); } while (0)
    PK4(p0, 0, pa0); PK4(p0, 8, pa1); PK4(p1, 0, pa2); PK4(p1, 8, pa3);
#undef PK4
}
template <int KB, bool SK>
__device__ __forceinline__ void qkt(f32x16& p0, f32x16& p1, const char* K_lds, int r32, int hi, const bf16x8* qr, bool act) {
    if (SK && !act) { const float NEG = -__builtin_inff();
#pragma unroll
        for (int r = 0; r < 16; ++r) { p0[r] = NEG; p1[r] = NEG; } return; }
    { const float* bb_ = (const float*)(K_lds + 2 * SHM_K + NW * 64 * 4) + KB * 64 + 4 * hi;
#pragma unroll
      for (int q_ = 0; q_ < 4; ++q_) { const f32x4 b0_ = *(const f32x4*)(bb_ + 8 * q_), b1_ = *(const f32x4*)(bb_ + 32 + 8 * q_);
#pragma unroll
        for (int i_ = 0; i_ < 4; ++i_) { p0[4 * q_ + i_] = b0_[i_]; p1[4 * q_ + i_] = b1_[i_]; } } }
    const char* kb[4];
#pragma unroll
    for (int dd = 0; dd < 4; ++dd) kb[dd] = K_lds + KB * SHM_K + KSWZ(r32, (dd * 16 + hi * 8) * 2);
#pragma unroll
    for (int d0 = 0; d0 < 8; ++d0) { const char* a = kb[d0 & 3] + (d0 >> 2) * 128;
        bf16x8 b0 = *reinterpret_cast<const bf16x8*>(a);
        bf16x8 b1 = *reinterpret_cast<const bf16x8*>(a + 32 * 256);
        p0 = __builtin_amdgcn_mfma_f32_32x32x16_bf16(b0, qr[d0], p0, 0, 0, 0);
        p1 = __builtin_amdgcn_mfma_f32_32x32x16_bf16(b1, qr[d0], p1, 0, 0, 0); }
}
template <int VB, bool SK>
__device__ __forceinline__ void pv_tile(f32x16* o, int vb0, bf16x8 pa0, bf16x8 pa1, bf16x8 pa2, bf16x8 pa3, bool act) {
    if (SK && !act) return;
#define TRRD(dst, off) asm volatile("ds_read_b64_tr_b16 %0, %1 offset:%2" : "=&v"(dst) : "v"(vb0), "i"(off) : "memory")
#define PV_D0(d0) do { s16x4 l0, l1, l2, l3, h0, h1, h2, h3; constexpr int b_ = VB * SHM_V + v_rd_off(d0, 0, 0);     \
        TRRD(l0, b_); TRRD(h0, b_ + 2048); TRRD(l1, b_ + 4096); TRRD(h1, b_ + 6144); TRRD(l2, b_ + 8192); TRRD(h2, b_ + 10240); TRRD(l3, b_ + 12288); TRRD(h3, b_ + 14336); \
        asm volatile("s_waitcnt lgkmcnt(0)" ::: "memory"); SBAR();                 \
        o[d0] = __builtin_amdgcn_mfma_f32_32x32x16_bf16(pa0, (bf16x8){l0[0], l0[1], l0[2], l0[3], h0[0], h0[1], h0[2], h0[3]}, o[d0], 0, 0, 0);   \
        o[d0] = __builtin_amdgcn_mfma_f32_32x32x16_bf16(pa1, (bf16x8){l1[0], l1[1], l1[2], l1[3], h1[0], h1[1], h1[2], h1[3]}, o[d0], 0, 0, 0);   \
        o[d0] = __builtin_amdgcn_mfma_f32_32x32x16_bf16(pa2, (bf16x8){l2[0], l2[1], l2[2], l2[3], h2[0], h2[1], h2[2], h2[3]}, o[d0], 0, 0, 0);   \
        o[d0] = __builtin_amdgcn_mfma_f32_32x32x16_bf16(pa3, (bf16x8){l3[0], l3[1], l3[2], l3[3], h3[0], h3[1], h3[2], h3[3]}, o[d0], 0, 0, 0); } while (0)
    PV_D0(0); PV_D0(1); PV_D0(2); PV_D0(3);
#undef PV_D0
#undef TRRD
}
template <class TIn, class TOut> struct BlockRef { const TIn* Q; const TIn* K; const TIn* V; TOut* O; const float* FB; int P0; };
template <class TIn> struct Seam {
    bf16x8 qr[8];
    bf16x8 st_v0, st_v1, st_k0, st_k1; float st_f; f32x4 sf0, sf1, sf2, sf3;
    f32x4 tq[16];
};
__device__ __forceinline__ int swa_jlo(int P0, int W) { const int lowk = P0 - W + 1; return lowk > 0 ? lowk / KVBLK : 0; }
#define ROW(p, k0, rr) ((p) + (size_t)((k0) + (rr)) * KS + sc)
#define VMW() asm volatile("s_waitcnt vmcnt(0)" ::: "memory")
#define VMWN(n) asm volatile("s_waitcnt vmcnt(%0)" :: "i"(n) : "memory")
#define SLOAD_H(Kp, Vp, Fp, k0) do { S.st_f = (Fp)[(k0) + (tid & 63)]; S.st_v0 = load8<TIn>(ROW(Vp, k0, sr)); S.st_v1 = load8<TIn>(ROW(Vp, k0, 32 + sr));              \
                         S.st_k0 = load8<TIn>(ROW(Kp, k0, sr)); S.st_k1 = load8<TIn>(ROW(Kp, k0, 32 + sr)); } while (0)
#define SWRITE_HK(bf) do { ((float*)(K_lds + 2 * SHM_K + NW * 64 * 4))[(bf) * 64 + (tid & 63)] = S.st_f; *(bf16x8*)(K_lds + (bf) * SHM_K + kws) = S.st_k0; *(bf16x8*)(K_lds + (bf) * SHM_K + kws + 32 * 256) = S.st_k1; } while (0)
#define SWRITE_HV(bf) do { *(bf16x8*)(V_lds + (bf) * SHM_V + vst0) = S.st_v0; *(bf16x8*)(V_lds + (bf) * SHM_V + vst1) = S.st_v1; } while (0)
#define SWRITE_H(bf) do { SWRITE_HV(bf); SWRITE_HK(bf); } while (0)
#define SLOAD_F(p, k0) do { S.sf0 = *(const f32x4*)ROW(p, k0, sr); S.sf1 = *(const f32x4*)(ROW(p, k0, sr) + 4);                \
                            S.sf2 = *(const f32x4*)ROW(p, k0, 32 + sr); S.sf3 = *(const f32x4*)(ROW(p, k0, 32 + sr) + 4); } while (0)
#define SWRITE_KF(bf) do { *(bf16x8*)(K_lds + (bf) * SHM_K + kws) = pack8(S.sf0, S.sf1); *(bf16x8*)(K_lds + (bf) * SHM_K + kws + 32 * 256) = pack8(S.sf2, S.sf3); } while (0)
#define SWRITE_VF(bf) do { *(bf16x8*)(V_lds + (bf) * SHM_V + vst0) = pack8(S.sf0, S.sf1); *(bf16x8*)(V_lds + (bf) * SHM_V + vst1) = pack8(S.sf2, S.sf3); } while (0)
template <class TIn, class TOut>
__device__ __forceinline__ void causal_swa_prime(const BlockRef<TIn, TOut>& cur, int W, char* lds, Seam<TIn>& S) {
    constexpr bool F32 = same_t<TIn, float>::v;
    const int tid = opaque_tid(), wid = __builtin_amdgcn_readfirstlane(tid >> 6), lane = tid & 63, r32 = lane & 31, hi = lane >> 5;
    const int sr = tid >> 4, sc = (tid & 15) * 8, kws = KSWZ(sr, sc * 2); char* K_lds = lds + 2 * SHM_V;
    const int kb0 = swa_jlo(cur.P0, W) * KVBLK;
    for (int d0 = 0; d0 < 8; ++d0) S.qr[d0] = load8<TIn>(cur.Q + (size_t)(wid * QBLK + r32) * QS + d0 * 16 + hi * 8);
    if constexpr (F32) { SLOAD_F((const float*)cur.K, kb0); VMW(); SWRITE_KF(0); SBAR(); SLOAD_F((const float*)cur.V, kb0); }
    else { SLOAD_H(cur.K, cur.V, cur.FB, kb0); VMW(); SWRITE_HK(0); }
    __syncthreads();
}
template <class TIn, class TOut>
__device__ __forceinline__ void causal_swa_block(const BlockRef<TIn, TOut>& cur, const BlockRef<TIn, TOut>& nxt, int skv, int W, char* lds, Seam<TIn>& S) {
    constexpr bool F32 = same_t<TIn, float>::v;
    const int tid = opaque_tid(), wid = __builtin_amdgcn_readfirstlane(tid >> 6), lane = tid & 63, r32 = lane & 31, hi = lane >> 5;
    const int j_lo = swa_jlo(cur.P0, W);
    int j_hi = (cur.P0 + QB - 1) / KVBLK + 1; if (j_hi > skv / KVBLK) j_hi = skv / KVBLK;
    const int NT = j_hi - j_lo;
    const int kbn = swa_jlo(nxt.P0, W) * KVBLK;
    const int qlo = cur.P0 + wid * QBLK, qm = qlo + r32 - 4 * hi;
    char* V_lds = lds; char* K_lds = lds + 2 * SHM_V;
    float* ws = (float*)(lds + 2 * SHM_V + 2 * SHM_K) + wid * 64; float* li_l = ws, * al_l = ws + 32;
    float m_reg = -1e30f, l_reg = 0; f32x16 o[4] = {};
    const int sr = tid >> 4, sc = (tid & 15) * 8, vst0 = v_st(sr, sc), vst1 = v_st(32 + sr, sc), kws = KSWZ(sr, sc * 2);
    const int vb0 = (int)(uintptr_t)V_lds + v_rd_base(lane);
    const TIn* Kh = cur.K; const TIn* Vh = cur.V;
#define RESC(a) do { if (__any((a) < 1.f)) { if (hi == 0) al_l[r32] = (a); asm volatile("s_waitcnt lgkmcnt(0)" ::: "memory");              \
                     for (int d_ = 0; d_ < 4; ++d_) for (int r = 0; r < 16; ++r) o[d_][r] *= al_l[crow(r, hi)]; } } while (0)
#define KBASE(t) ((j_lo + (t)) * KVBLK)
#define ACT(t) (KBASE(t) <= qlo + QBLK - 1 && KBASE(t) + KVBLK - 1 >= qlo - W + 1)
#define MASKT(P0_, P1_, t) do { const int kb_ = KBASE(t); if ((!SK || ACT(t)) && (kb_ + KVBLK - 1 > qlo || kb_ <= qlo + QBLK - 1 - W)) mask_tile(P0_, P1_, qm - kb_, (unsigned)W); } while (0)
    constexpr int NQL = F32 ? 16 : 8;
    constexpr bool SK = WSKIP && !F32;
#define SEAM_K0() do { VMWN(NQL); if constexpr (F32) { SWRITE_KF(0); SBAR(); SLOAD_F((const float*)nxt.V, kbn); } else { SWRITE_HK(0); } SBAR(); } while (0)
    f32x16 pA0, pA1, pB0, pB1; float mnA, mnB, alA, alB; bf16x8 pa0, pa1, pa2, pa3;
    if constexpr (F32) { VMW(); SWRITE_VF(0); SBAR(); } else { SWRITE_HV(0); SBAR(); }
    if (NT > 1) { if constexpr (F32) SLOAD_F((const float*)Kh, KBASE(1)); else SLOAD_H(Kh, Vh, cur.FB, KBASE(1)); }
    SBAR(); qkt<0, SK>(pA0, pA1, K_lds, r32, hi, S.qr, ACT(0));
    if constexpr (F32) { if (NT > 1) { VMW(); SWRITE_KF(1); SBAR(); SLOAD_F((const float*)Vh, KBASE(1)); } }
    MASKT(pA0, pA1, 0); partialSM(pA0, pA1, m_reg, mnA, alA);
    if (NT > 1) { VMW(); if constexpr (F32) { SWRITE_VF(1); SBAR(); if (NT > 2) SLOAD_F((const float*)Kh, KBASE(2)); } else SWRITE_H(1); }
    __syncthreads();
#define HALF_STEP(PX0, PX1, mnX, alX, PY0, PY1, alY, t, KB, VB, SB) do {                                                      \
        SBAR(); qkt<KB, SK>(PX0, PX1, K_lds, r32, hi, S.qr, ACT(t));                                             \
        finishSM(PY0, PY1, alY, l_reg, pa0, pa1, pa2, pa3); SBAR();                                                           \
        if ((t) + 1 < NT) { if constexpr (F32) { VMW(); SWRITE_KF(SB); SBAR(); SLOAD_F((const float*)Vh, KBASE((t) + 1)); }  \
                            else { SLOAD_H(Kh, Vh, cur.FB, KBASE((t) + 1)); } SBAR(); }                                               \
        pv_tile<VB, SK>(o, vb0, pa0, pa1, pa2, pa3, ACT((t) - 1)); MASKT(PX0, PX1, (t)); partialSM(PX0, PX1, m_reg, mnX, alX);                                        \
        __syncthreads();                                                                                                      \
        if ((t) + 1 < NT) { VMW(); if constexpr (F32) { SWRITE_VF(SB); SBAR(); if ((t) + 2 < NT) SLOAD_F((const float*)Kh, KBASE((t) + 2)); } \
                            else { SWRITE_H(SB); } }                                                                          \
        RESC(alX); __syncthreads(); } while (0)
    for (int t = 1; t + 1 < NT; t += 2) {
        HALF_STEP(pB0, pB1, mnB, alB, pA0, pA1, alA, t, 1, 0, 0);
        HALF_STEP(pA0, pA1, mnA, alA, pB0, pB1, alB, t + 1, 0, 1, 1);
    }
    const bool even = (NT & 1) == 0;
    if (even) { SBAR(); qkt<1, SK>(pB0, pB1, K_lds, r32, hi, S.qr, ACT(NT - 1)); SBAR(); }
#define QROW(e) (nxt.Q + (size_t)(wid * QBLK + r32) * D + ((e) >> 1) * 16 + hi * 8 + ((e) & 1) * 4)
    if constexpr (F32) { SLOAD_F((const float*)nxt.K, kbn); SBAR();
#pragma unroll
        for (int e = 0; e < 8; ++e) S.tq[e] = *(const f32x4*)QROW(e); }
    else { SLOAD_H(nxt.K, nxt.V, nxt.FB, kbn); SBAR();
#pragma unroll
        for (int d0 = 0; d0 < 8; ++d0) S.qr[d0] = load8<TIn>(nxt.Q + (size_t)(wid * QBLK + r32) * QS + d0 * 16 + hi * 8); }
    SBAR();
    finishSM(pA0, pA1, alA, l_reg, pa0, pa1, pa2, pa3); SBAR();
    if constexpr (F32) {
#pragma unroll
        for (int e = 8; e < 16; ++e) S.tq[e] = *(const f32x4*)QROW(e); SBAR(); }
#undef QROW
    pv_tile<0, SK>(o, vb0, pa0, pa1, pa2, pa3, ACT(even ? NT - 2 : NT - 1));
    if (even) { MASKT(pB0, pB1, NT - 1); partialSM(pB0, pB1, m_reg, mnB, alB); __syncthreads(); RESC(alB);
        finishSM(pB0, pB1, alB, l_reg, pa0, pa1, pa2, pa3); SBAR(); pv_tile<1, SK>(o, vb0, pa0, pa1, pa2, pa3, ACT(NT - 1)); }
    SBAR(); SEAM_K0();
    if (hi == 0) li_l[r32] = l_reg; asm volatile("s_waitcnt lgkmcnt(0)" ::: "memory");
    float rli[16];
#pragma unroll
    for (int r = 0; r < 16; ++r) rli[r] = __builtin_amdgcn_rcpf(li_l[crow(r, hi)]);
    TOut* Ow = cur.O + (size_t)(wid * QBLK) * OS;
#pragma unroll
    for (int r = 0; r < 16; ++r) { const int orow = crow(r, hi);
#pragma unroll
        for (int d0 = 0; d0 < 4; ++d0) { const float v = o[d0][r] * rli[r];
            if constexpr (same_t<TOut, float>::v) { Ow[(size_t)orow * OS + d0 * 32 + r32] = v; }
            else { const float vn = __shfl_xor(v, 1);
                   if ((r32 & 1) == 0) *(unsigned*)(Ow + (size_t)orow * OS + d0 * 32 + r32) = cvtpk(v, vn); } } }
    if constexpr (F32) {
#pragma unroll
        for (int d0 = 0; d0 < 8; ++d0) S.qr[d0] = pack8(S.tq[2 * d0], S.tq[2 * d0 + 1]); }
    __syncthreads();
#undef RESC
#undef KBASE
#undef ACT
#undef MASKT
#undef SEAM_K0
#undef HALF_STEP
}
#undef ROW
#undef VMW
#undef VMWN
#undef SLOAD_H
#undef SWRITE_HK
#undef SWRITE_HV
#undef SWRITE_H
#undef SLOAD_F
#undef SWRITE_KF
#undef SWRITE_VF

__host__ __device__ inline int swa_nramp(int nqb, int W, int qoff) { const int t = W - 1 - qoff; const int n = t < 0 ? 0 : t / QB + 1; return n > nqb ? nqb : n; }
__host__ __device__ inline int swa_nx(int nqb, int nramp, int order) { return (order & ORDER_PAIRED) ? (nramp + 1) / 2 + (nqb - nramp) : nqb; }
struct SwaItem { int bh, qb0, qb1; };
__device__ __forceinline__ SwaItem swa_decode(int L, int nb, int nh, int nhkv, int nqb, int nx, int nramp, int order) {
    const int G = nh / nhkv; SwaItem it; int x;
    if ((order & ORDER_XCD) && (nb * nhkv) % 8 == 0) { const int xcd = L & 7, k = L >> 3, per = G * nx, gi = k / per, r = k - gi * per;
        it.bh = (gi * 8 + xcd) * G + r / nx; x = r % nx; }
    else { it.bh = L / nx; x = L - it.bh * nx; }
    if (order & ORDER_PAIRED) { const int ns = nqb - nramp;
        if (x < ns) { it.qb0 = it.qb1 = nqb - 1 - x; } else { it.qb0 = x - ns; it.qb1 = nramp - 1 - it.qb0; } }
    else { it.qb0 = it.qb1 = ((order & 3) == ORDER_REVERSED) ? nqb - 1 - x : x; }
    return it;
}
typedef unsigned short bf16;
__device__ __forceinline__ BlockRef<bf16, bf16> mk_ref(const SwaItem& it, int pass, const bf16* Q, const bf16* K, const bf16* V, bf16* O, const float* FB) {
    const int qb = pass ? it.qb1 : it.qb0, b = it.bh >> 4, h = it.bh & 15, kvh = h >> 2;
    BlockRef<bf16, bf16> r;
    r.Q = Q + ((size_t)b * 8192 + (size_t)qb * QB) * QS + h * 128; r.O = O + ((size_t)b * 8192 + (size_t)qb * QB) * OS + h * 128;
    r.K = K + (size_t)b * 8192 * KS + kvh * 128; r.V = V + (size_t)b * 8192 * KS + kvh * 128; r.FB = FB + (size_t)it.bh * 8192; r.P0 = qb * QB;
    return r;
}
__device__ __forceinline__ void attn_phase(char* lds, const bf16* Q, const bf16* K, const bf16* V, bf16* O, const float* FB) {
    constexpr int nb = 4, nh = 16, nhkv = 4, nqb = 32, W = 8192, order = ORDER_PAIRED | ORDER_XCD;
    const int nramp = swa_nramp(nqb, W, 0), nx = swa_nx(nqb, nramp, order), total = nx * nb * nh, stride = gridDim.x;
    int L = blockIdx.x; if (L >= total) return;
    SwaItem it = swa_decode(L, nb, nh, nhkv, nqb, nx, nramp, order); int pass = 0;
    BlockRef<bf16, bf16> cur = mk_ref(it, 0, Q, K, V, O, FB);
    Seam<bf16> S;
    causal_swa_prime<bf16, bf16>(cur, W, lds, S);
    for (;;) {
        const bool more_pass = pass == 0 && it.qb1 != it.qb0, more_item = L + stride < total, last = !more_pass && !more_item;
        SwaItem itn = it; int passn = pass + 1, Ln = L;
        if (!more_pass) { passn = 0; Ln = more_item ? L + stride : L; itn = swa_decode(Ln, nb, nh, nhkv, nqb, nx, nramp, order); }
        const BlockRef<bf16, bf16> nxt = last ? cur : mk_ref(itn, passn, Q, K, V, O, FB);
        causal_swa_block<bf16, bf16>(cur, nxt, 8192, W, lds, S);
        if (last) break;
        cur = nxt; it = itn; pass = passn; L = Ln;
    }
}
}
constexpr size_t WS_WIN = 0, WS_WRO = 50331648, WS_WGU0 = 67108864, WS_WGU1 = 113246208, WS_WDN0 = 159383552, WS_WDN1 = 182452224,
                 WS_WO = 205520896, WS_WKVF = 213909504  , WS_COS = 227540992, WS_SIN = 231735296, WS_FB = 235929600, WS_FS = WS_FB + 2097152,
                 WS_BIG = 239075328;
constexpr size_t SZ_ROWS2K = (size_t)TALL * DM * 2;
constexpr size_t BIG_XN = 0, BIG_ACT = SZ_ROWS2K, BIG_HKV = BIG_ACT + (size_t)TALL * DFF * 2, BIG_KB = BIG_HKV + SZ_ROWS2K, BIG_VB = BIG_KB + (size_t)TP * 512 * 2,
                 BIG_KALL = BIG_VB + (size_t)TP * 512 * 2, BIG_VALL = BIG_KALL + (size_t)8 * LKS * 512 * 2, BIG_END = BIG_VALL + (size_t)8 * LKS * 512 * 2;
static_assert(BIG_END <= (size_t)TALL * NPROJ * 2, "layer-1 buffers fit in the PROJ region");
constexpr size_t WS_SSQ = WS_BIG + (size_t)TALL * NPROJ * 2  , WS_BAR = WS_SSQ + (size_t)4 * TALL * 4  , WS_END = WS_BAR + 16384;
static_assert(WS_FS + 540672 <= WS_BIG && WS_BAR % 256 == 0, "small arrays end before the big region");
static_assert(WS_END <= (size_t)1073741824, "workspace fits 1 GiB");
constexpr size_t OUT_Y = 0, OUT_SP = 67633152, OUT_KP = 71827456, OUT_VP = 88604672, OUT_LFP = 105381888, OUT_SS = 105906176, OUT_KS = 114294784, OUT_VS = 114425856, OUT_LFS = 114556928;
constexpr int NWAVES = 8, LDS_BYTES = 149504;

struct Params { const float* in[21]; float* out; unsigned char* ws; };

__device__ __forceinline__ float wave_sum(float v) {
#pragma unroll
    for (int o = 1; o < 64; o <<= 1) v += __shfl_xor(v, o);
    return v;
}
__device__ __forceinline__ float bf2f(unsigned short b) { return __uint_as_float(((unsigned)b) << 16); }
__device__ __forceinline__ unsigned pk2(float lo, float hi) { return pg8::cvt_pk_bf16(lo, hi); }

__device__ __forceinline__ void transpose_item(const float* W, int K, int N, bf16_t* WT, int k0, int n0, int drow0, LAS float* scr, int lane, const float* gain = nullptr) {
    float wv[32];
#pragma unroll
    for (int i = 0; i < 32; ++i) { const int kk = 2 * i + (lane >> 5); wv[i] = W[(size_t)(k0 + kk) * N + n0 + (lane & 31)] * (gain ? gain[k0 + kk] : 1.f); }
#pragma unroll
    for (int i = 0; i < 32; ++i) { const int kk = 2 * i + (lane >> 5); scr[kk * 33 + (lane & 31)] = wv[i]; }
    asm volatile("s_waitcnt lgkmcnt(0)" ::: "memory");
    const int c = lane & 7;
#pragma unroll
    for (int j = 0; j < 4; ++j) { const int n = (lane >> 3) + 8 * j; const LAS float* s = scr + (8 * c) * 33 + n;
        u32x4 o; o.x = pk2(s[0 * 33], s[1 * 33]); o.y = pk2(s[2 * 33], s[3 * 33]); o.z = pk2(s[4 * 33], s[5 * 33]); o.w = pk2(s[6 * 33], s[7 * 33]);
        *(u32x4*)(WT + (size_t)(drow0 + n) * K + k0 + 8 * c) = o; }
    asm volatile("s_waitcnt lgkmcnt(0)" ::: "memory");
}
__device__ __forceinline__ void tr_plain(const float* W, int K, int N, bf16_t* WT, int row_off, LAS float* scr, int item, int lane, const float* gain = nullptr) {
    const int nblk = N / 32, kb = item / nblk, nb = item % nblk; transpose_item(W, K, N, WT, 64 * kb, 32 * nb, row_off + 32 * nb, scr, lane, gain);
}
__device__ __forceinline__ void tr_gu(const float* W, bf16_t* WT, int up, LAS float* scr, int item, int lane, const float* gain) {
    const int nblk = DFF / 32, kb = item / nblk, nb = item % nblk, n0 = 32 * nb; transpose_item(W, DM, DFF, WT, 64 * kb, n0, (n0 >> 7) * 256 + up * 128 + (n0 & 127), scr, lane, gain);
}
template <int MODE  >
__device__ __forceinline__ void rms_row(const float* xrow, const float* g1, bf16_t* o1, const float* g2, bf16_t* o2, float* of, int lane) {
    const f32x4* xr = (const f32x4*)xrow + lane;
    f32x4 v[8]; float s = 0.f;
#pragma unroll
    for (int j = 0; j < 8; ++j) { v[j] = xr[64 * j]; s += (v[j].x * v[j].x + v[j].y * v[j].y) + (v[j].z * v[j].z + v[j].w * v[j].w); }
    const float rs = 1.0f / sqrtf(wave_sum(s) * (1.f / DM) + 1e-6f);
#pragma unroll
    for (int j = 0; j < 8; ++j) { const f32x4 ga = ((const f32x4*)g1)[64 * j + lane]; const f32x4 y = v[j] * rs;
        if (MODE == 2) { ((f32x4*)of)[64 * j + lane] = y * ga; }
        else { u32x2 w; w.x = pk2(y.x * ga.x, y.y * ga.y); w.y = pk2(y.z * ga.z, y.w * ga.w); ((u32x2*)o1)[64 * j + lane] = w;
            if (MODE == 1) { const f32x4 gb = ((const f32x4*)g2)[64 * j + lane]; u32x2 w2; w2.x = pk2(y.x * gb.x, y.y * gb.y); w2.y = pk2(y.z * gb.z, y.w * gb.w); ((u32x2*)o2)[64 * j + lane] = w2; } } }
}

namespace ret {
constexpr int KOFF = 0, STOFF = 32768, VOFF = 65536, POFF = 74752, VS = 144;
typedef short v4i16_t __attribute__((ext_vector_type(4)));
__device__ __forceinline__ bf16x8 frag_rm(const LAS char* base, int stride, int i0, int k0, int fr, int fq) { return *(const LAS bf16x8*)(base + (i0 + fr) * stride + (k0 + 8 * fq) * 2); }
__device__ __forceinline__ bf16x8 frag_sw(const LAS char* base, int i0, int k0, int fr, int fq) { return *(const LAS bf16x8*)(base + (i0 + fr) * 512 + ((((k0 >> 3) + fq) ^ fr) << 4)); }
__device__ __forceinline__ s16x4 tr4(const LAS char* p) { return __builtin_bit_cast(s16x4, __builtin_amdgcn_ds_read_tr16_b64_v4i16((LAS v4i16_t*)p)); }
__device__ __forceinline__ bf16x8 frag_tr(const LAS char* base, int stride, int k0, int i0, int fr, int fq) {
    const LAS char* p = base + (k0 + 8 * fq + (fr >> 2)) * stride + (i0 + 4 * (fr & 3)) * 2;
    const s16x4 a = tr4(p), b = tr4(p + 4 * stride);
    return (bf16x8){a[0], a[1], a[2], a[3], b[0], b[1], b[2], b[3]};
}
__device__ __forceinline__ bf16x8 frag_tr_sw(const LAS char* base, int k0, int i0, int fr, int fq) {
    const int m = k0 + 8 * fq + (fr >> 2), d = i0 + 4 * (fr & 3);
    const s16x4 a = tr4(base + m * 512 + ((((d >> 3) ^ (m & 15))) << 4) + (d & 7) * 2), b = tr4(base + (m + 4) * 512 + ((((d >> 3) ^ ((m + 4) & 15))) << 4) + (d & 7) * 2);
    return (bf16x8){a[0], a[1], a[2], a[3], b[0], b[1], b[2], b[3]};
}
#define RET_BAR() do { asm volatile("s_waitcnt lgkmcnt(0)" ::: "memory"); __builtin_amdgcn_s_barrier(); asm volatile("" ::: "memory"); } while (0)
#define MFMA16(X, Y, C) __builtin_amdgcn_mfma_f32_16x16x32_bf16(X, Y, C, 0, 0, 0)
__device__ __forceinline__ void ret_item(LAS char* lds, const bf16_t* proj, size_t hr0  , bf16_t* oh  , int nchunks, int c, int h, int es, const float* S0, float* Sout) {
    const int tid = opaque_tid(), wid = __builtin_amdgcn_readfirstlane(tid >> 6), lane = tid & 63, fr = lane & 15, fq = lane >> 4, lt = wid >> 1, half = wid & 1;
    const float lg2 = __log2f(1.0f - exp2f(-5.0f - (float)h)), gam = exp2f(lg2), gc1 = exp2f(lg2 * (float)(c - 1));
    f32x4 accT[8];
    const int eT = 16 * lt + fr;
#pragma unroll
    for (int i = 0; i < 8; ++i) { const int d0 = 16 * (8 * half + i) + 4 * fq;
#pragma unroll
        for (int r = 0; r < 4; ++r) accT[i][r] = S0 ? S0[(size_t)(d0 + r) * 512 + es * 64 + eT] : 0.f;
        u32x2 w; w.x = pk2(accT[i][0], accT[i][1]); w.y = pk2(accT[i][2], accT[i][3]); *(LAS u32x2*)(lds + STOFF + eT * 512 + (((d0 >> 3) ^ fr) << 4) + (d0 & 7) * 2) = w; }
    u32x4 rk[4], rv; bf16x8 yq[8];
    const bf16_t* gq = proj + PJ_Q + (hr0 + eT) * 256 + 8 * fq; const bf16_t* gk = proj + PJ_K + hr0 * 256; const bf16_t* gv = proj + PJ_V + hr0 * 512 + es * 64; bf16_t* pout = oh + hr0 * 512 + es * 64;
    const bool qok = eT < c;
#define RET_LOADQ(n) do { _Pragma("unroll") for (int ks = 0; ks < 8; ++ks) yq[ks] = qok ? *(const bf16x8*)(gq + (size_t)(n) * 64 * 256 + 32 * ks) : (bf16x8){0, 0, 0, 0, 0, 0, 0, 0}; } while (0)
#define RET_LOAD(n) do { _Pragma("unroll") for (int i = 0; i < 4; ++i) { const int p = tid + 512 * i, row = p >> 5, ch = p & 31; \
            if (row < c) rk[i] = *(const u32x4*)(gk + (size_t)((n) * 64 + row) * 256 + ch * 8); else rk[i] = (u32x4){0u, 0u, 0u, 0u}; } \
        { const int row = tid >> 3, ch = tid & 7; if (row < c) rv = *(const u32x4*)(gv + (size_t)((n) * 64 + row) * 512 + ch * 8); else rv = (u32x4){0u, 0u, 0u, 0u}; } } while (0)
    RET_LOAD(0); RET_LOADQ(0);
    for (int n = 0; n < nchunks; ++n) {
#pragma unroll
        for (int i = 0; i < 4; ++i) { const int p = tid + 512 * i, row = p >> 5, ch = p & 31; *(LAS u32x4*)(lds + KOFF + row * 512 + ((ch ^ (row & 15)) << 4)) = rk[i]; }
        *(LAS u32x4*)(lds + VOFF + (tid >> 3) * VS + (tid & 7) * 16) = rv;
        if (n + 1 < nchunks) RET_LOAD(n + 1);
        RET_BAR();
        f32x4 accS[2], accC[2];
#pragma unroll
        for (int j = 0; j < 2; ++j) { accS[j] = (f32x4){0.f, 0.f, 0.f, 0.f}; accC[j] = (f32x4){0.f, 0.f, 0.f, 0.f}; }
#pragma unroll
        for (int kb = 0; kb < 8; kb += 2) {
            bf16x8 xk[2][2], xs[2][2];
#pragma unroll
            for (int ks = 0; ks < 2; ++ks)
#pragma unroll
                for (int j = 0; j < 2; ++j) { xk[ks][j] = frag_sw(lds + KOFF, 16 * (2 * half + j), 32 * (kb + ks), fr, fq); xs[ks][j] = frag_sw(lds + STOFF, 16 * (2 * half + j), 32 * (kb + ks), fr, fq); }
            __builtin_amdgcn_sched_barrier(0);
#pragma unroll
            for (int ks = 0; ks < 2; ++ks)
#pragma unroll
                for (int j = 0; j < 2; ++j) { accS[j] = MFMA16(xk[ks][j], yq[kb + ks], accS[j]); accC[j] = MFMA16(xs[ks][j], yq[kb + ks], accC[j]); }
            __builtin_amdgcn_sched_barrier(0);
        }
        if (n + 1 < nchunks) RET_LOADQ(n + 1);
        const int lrow = eT;
#pragma unroll
        for (int j = 0; j < 2; ++j) { const int m0 = 16 * (2 * half + j) + 4 * fq; f32x4 sv = accS[j];
#pragma unroll
            for (int r = 0; r < 4; ++r) sv[r] = (m0 + r <= lrow) ? sv[r] : 0.f;
            u32x2 w; w.x = pk2(sv[0], sv[1]); w.y = pk2(sv[2], sv[3]); *(LAS u32x2*)(lds + POFF + lrow * VS + m0 * 2) = w; }
        RET_BAR();
        f32x4 accO[2];
#pragma unroll
        for (int j = 0; j < 2; ++j) accO[j] = accC[j] * gam;
#pragma unroll
        for (int ks = 0; ks < 2; ++ks) { const int k0 = 32 * ks;
            const bf16x8 yp = frag_rm(lds + POFF, VS, 16 * lt, k0, fr, fq);
#pragma unroll
            for (int j = 0; j < 2; ++j) { const bf16x8 xv = frag_tr(lds + VOFF, VS, k0, 16 * (2 * half + j), fr, fq); accO[j] = MFMA16(xv, yp, accO[j]); } }
        if (lrow < c) {
#pragma unroll
            for (int j = 0; j < 2; ++j) { u32x2 w; w.x = pk2(accO[j][0], accO[j][1]); w.y = pk2(accO[j][2], accO[j][3]);
                *(u32x2*)(pout + (size_t)(n * 64 + lrow) * 512 + 16 * (2 * half + j) + 4 * fq) = w; } }
#pragma unroll
        for (int i = 0; i < 8; ++i) accT[i] = accT[i] * gam;
#pragma unroll
        for (int ks = 0; ks < 2; ++ks) {
            bf16x8 xk[8]; const bf16x8 yv = frag_tr(lds + VOFF, VS, 32 * ks, 16 * lt, fr, fq);
#pragma unroll
            for (int i = 0; i < 8; ++i) xk[i] = frag_tr_sw(lds + KOFF, 32 * ks, 16 * (8 * half + i), fr, fq);
            __builtin_amdgcn_sched_barrier(0);
#pragma unroll
            for (int i = 0; i < 8; ++i) accT[i] = MFMA16(xk[i], yv, accT[i]);
            __builtin_amdgcn_sched_barrier(0);
        }
#pragma unroll
        for (int i = 0; i < 8; ++i) { accT[i] = accT[i] * gc1; const int d0 = 16 * (8 * half + i) + 4 * fq;
            u32x2 w; w.x = pk2(accT[i][0], accT[i][1]); w.y = pk2(accT[i][2], accT[i][3]); *(LAS u32x2*)(lds + STOFF + eT * 512 + (((d0 >> 3) ^ fr) << 4) + (d0 & 7) * 2) = w; }
        RET_BAR();
    }
#undef RET_LOAD
#undef RET_LOADQ
#pragma unroll
    for (int i = 0; i < 8; ++i) { const int d0 = 16 * (8 * half + i) + 4 * fq;
#pragma unroll
        for (int r = 0; r < 4; ++r) Sout[(size_t)(d0 + r) * 512 + es * 64 + eT] = accT[i][r]; }
}
}
__device__ __forceinline__ void sample_attn(LAS char* lds, const bf16_t* QBp, const bf16_t* KALL, const bf16_t* VALL, const float* FS, bf16_t* AO) {
    const int tid = opaque_tid(), wid = __builtin_amdgcn_readfirstlane(tid >> 6), lane = tid & 63;
    LAS float* qf = (LAS float*)(lds + wid * 5120); LAS float* pf = qf + 128;
    const int gw = blockIdx.x * NWAVES + wid, NGW = gridDim.x * NWAVES;
    for (int item = gw; item < 8 * 16 * 32; item += NGW) {
        const int b = item >> 9, h = (item >> 5) & 15, qi = item & 31, kvh = h >> 2, qpos = PASTL + qi, row = TP + b * 32 + qi;
        const bf16_t* q = QBp + (size_t)row * DM + h * 128;
        qf[lane] = bf2f(q[lane]); qf[lane + 64] = bf2f(q[lane + 64]);
        asm volatile("s_waitcnt lgkmcnt(0)" ::: "memory");
        const float* F = FS + (size_t)(b * 16 + h) * LKS; const float Fq = F[qpos];
        const bf16_t* Kb = KALL + (size_t)b * LKS * 512 + kvh * 128; const bf16_t* Vb = VALL + (size_t)b * LKS * 512 + kvh * 128;
        float mx = -1e30f;
#pragma unroll 1
        for (int t = 0; t < 17; ++t) { const int j = lane + 64 * t; float s = -__builtin_inff();
            if (j <= qpos) { const u32x4* kr = (const u32x4*)(Kb + (size_t)j * 512); float a = 0.f; u32x4 kvv[16];
#pragma unroll
                for (int c8 = 0; c8 < 16; ++c8) kvv[c8] = kr[c8];
#pragma unroll
                for (int c8 = 0; c8 < 16; ++c8) { const u32x4 kv = kvv[c8]; const LAS f32x4* qq = (const LAS f32x4*)(qf + 8 * c8); const f32x4 q0 = qq[0], q1 = qq[1];
                    a += __uint_as_float(kv.x << 16) * q0.x + __uint_as_float(kv.x & 0xffff0000u) * q0.y + __uint_as_float(kv.y << 16) * q0.z + __uint_as_float(kv.y & 0xffff0000u) * q0.w
                       + __uint_as_float(kv.z << 16) * q1.x + __uint_as_float(kv.z & 0xffff0000u) * q1.y + __uint_as_float(kv.w << 16) * q1.z + __uint_as_float(kv.w & 0xffff0000u) * q1.w; }
                s = a * 0.08838834764831845f + (Fq - F[j]); }
            pf[j] = s; mx = fmaxf(mx, s); }
#pragma unroll
        for (int o = 1; o < 64; o <<= 1) mx = fmaxf(mx, __shfl_xor(mx, o));
        float sum = 0.f;
#pragma unroll 1
        for (int t = 0; t < 17; ++t) { const float p = __expf(pf[lane + 64 * t] - mx); sum += p; pf[lane + 64 * t] = p; }
        sum = wave_sum(sum);
        asm volatile("s_waitcnt lgkmcnt(0)" ::: "memory");
        float oa[8];
#pragma unroll
        for (int e = 0; e < 8; ++e) oa[e] = 0.f;
        const int kg = lane >> 4, dg = lane & 15;
        for (int j = 0; j < PASTL + 32; j += 32) {
            u32x4 vv[8]; float p[8];
#pragma unroll
            for (int u = 0; u < 8; ++u) { vv[u] = *(const u32x4*)(Vb + (size_t)(j + 4 * u + kg) * 512 + 8 * dg); p[u] = pf[j + 4 * u + kg]; }
#pragma unroll
            for (int u = 0; u < 8; ++u) { const unsigned w4[4] = {vv[u].x, vv[u].y, vv[u].z, vv[u].w};
#pragma unroll
                for (int e = 0; e < 4; ++e) { oa[2 * e] += p[u] * __uint_as_float(w4[e] << 16); oa[2 * e + 1] += p[u] * __uint_as_float(w4[e] & 0xffff0000u); } } }
#pragma unroll
        for (int e = 0; e < 8; ++e) { oa[e] += __shfl_xor(oa[e], 16); oa[e] += __shfl_xor(oa[e], 32); }
        const float inv = 1.0f / sum;
        if (kg == 0) { u32x4 w; w.x = pk2(oa[0] * inv, oa[1] * inv); w.y = pk2(oa[2] * inv, oa[3] * inv); w.z = pk2(oa[4] * inv, oa[5] * inv); w.w = pk2(oa[6] * inv, oa[7] * inv);
            *(u32x4*)(AO + (size_t)row * DM + h * 128 + 8 * dg) = w; }
        asm volatile("s_waitcnt lgkmcnt(0)" ::: "memory");
    }
}

#define XB_TMO      128
#define XB_XCNT(j)  (256  + 64 * (j))
#define XB_XSUB(j)  (1280 + 64 * (j))
#define XB_XGEN(j)  (2304 + 64 * (j))
#define XB_TOP      3328
#define XB_TOPGEN   3392
#define XCD_BAR_WORDS 3456
#define XB_SPIN_CAP (1u << 18)

__device__ __forceinline__ unsigned xb_ld(unsigned* p)              { return __hip_atomic_load(p, __ATOMIC_RELAXED, __HIP_MEMORY_SCOPE_AGENT); }
__device__ __forceinline__ unsigned xb_add(unsigned* p, unsigned v) { return __hip_atomic_fetch_add(p, v, __ATOMIC_RELAXED, __HIP_MEMORY_SCOPE_AGENT); }
__device__ __forceinline__ unsigned xb_xcc_id() { return (unsigned)__builtin_amdgcn_s_getreg((3 << 11) | 20) & 0xFu; }
#define XB_SPIN(cond, bar) do { unsigned _sp = 0; while (cond) { __builtin_amdgcn_s_sleep(1); \
    if ((++_sp & 255u) == 0u) { if (xb_ld(&(bar)[XB_TMO])) break; if (_sp > XB_SPIN_CAP) { atomicAdd(&(bar)[XB_TMO], 1u); break; } } } } while (0)

struct XcdBarrier {
    unsigned* bar; unsigned x;
    volatile LAS unsigned* st;
};

__device__ __forceinline__ XcdBarrier xcd_barrier_post(unsigned* bar, volatile LAS unsigned* st) {
    XcdBarrier b; b.bar = bar; b.x = xb_xcc_id(); b.st = st;
    if (threadIdx.x == 0) (void)xb_add(&bar[XB_XCNT(b.x)], 1u);
    return b;
}
__device__ __forceinline__ void xcd_barrier_complete(unsigned* bar, unsigned x, unsigned& nloc, unsigned& nx) {
    const unsigned G = gridDim.x * gridDim.y * gridDim.z;
    unsigned sum, cnt, mine, sp = 0u;
    for (;;) {
        sum = 0u; cnt = 0u; mine = 0u;
#pragma unroll
        for (unsigned j = 0; j < 16; ++j) { const unsigned c = xb_ld(&bar[XB_XCNT(j)]); sum += c; cnt += (c > 0u) ? 1u : 0u; mine = (j == x) ? c : mine; }
        if (sum == G) break;
        __builtin_amdgcn_s_sleep(1);
        if ((++sp & 255u) == 0u) { if (xb_ld(&bar[XB_TMO])) break; if (sp > XB_SPIN_CAP) { atomicAdd(&bar[XB_TMO], 1u); break; } }
    }
    nloc = mine > 0u ? mine : 1u; nx = cnt > 0u ? cnt : 1u;
}

__device__ __forceinline__ void xcd_barrier(const XcdBarrier& b) {
    asm volatile("s_waitcnt vmcnt(0)" ::: "memory");
    __syncthreads();
    if (threadIdx.x == 0) {
        unsigned* bar = b.bar;
        __builtin_amdgcn_s_waitcnt(0);
        unsigned nloc = b.st[0], nx = b.st[1];
        if (nloc == 0u) { xcd_barrier_complete(bar, b.x, nloc, nx); b.st[0] = nloc; b.st[1] = nx; }
        const unsigned old = xb_add(&bar[XB_XSUB(b.x)], 1u);
        const unsigned gen = old / nloc;
        if (old + 1u == (gen + 1u) * nloc) {
            __builtin_amdgcn_fence(__ATOMIC_RELEASE, "agent");
            asm volatile("s_waitcnt vmcnt(0)" ::: "memory");
            const unsigned og = xb_add(&bar[XB_TOP], 1u);
            const unsigned tg = og / nx;
            if (og + 1u == (tg + 1u) * nx) xb_add(&bar[XB_TOPGEN], 1u);
            else XB_SPIN(xb_ld(&bar[XB_TOPGEN]) == tg, bar);
            __builtin_amdgcn_fence(__ATOMIC_ACQUIRE, "agent");
            xb_add(&bar[XB_XGEN(b.x)], 1u);
            asm volatile("s_waitcnt vmcnt(0)" ::: "memory");
        } else {
            XB_SPIN(xb_ld(&bar[XB_XGEN(b.x)]) == gen, bar);
            __builtin_amdgcn_fence(__ATOMIC_ACQUIRE, "agent");
            asm volatile("s_waitcnt vmcnt(0)" ::: "memory");
        }
    }
    __syncthreads();
}

#define KARG(i) ((unsigned char*)(__attribute__((address_space(1))) unsigned char*)(((const volatile __attribute__((address_space(4))) unsigned long long*)__builtin_amdgcn_kernarg_segment_ptr())[i]))
#define INF(i) ((const float*)KARG(i))
#define OUTP ((float*)KARG(21))
#define WSP (KARG(22))
#define BIGP (KARG(22) + WS_BIG)
#define PH_IDS const int tid = opaque_tid(), lane = tid & 63, wave = __builtin_amdgcn_readfirstlane(tid >> 6); const int G = gridDim.x, gw = blockIdx.x * NWAVES + wave, NGW = G * NWAVES; const size_t gt = (size_t)blockIdx.x * 512 + tid, NGT = (size_t)G * 512; (void)lane; (void)gw; (void)NGW; (void)gt; (void)NGT

__device__ __forceinline__ void ph_prologue(LAS unsigned char* lds) {
    PH_IDS; unsigned char* ws = WSP;
    bf16_t* WIN = (bf16_t*)(ws + WS_WIN); bf16_t* WKVF = (bf16_t*)(ws + WS_WKVF);
    LAS float* scr = (LAS float*)(lds + wave * 16384);
    constexpr int I0 = 32 * 384;
    for (int it = gw; it < I0; it += NGW) tr_plain(INF(10), DM, NPROJ, WIN, 0, scr, it, lane);
    { const float* wf = INF(14); const float* nkv = INF(8);
      for (size_t i = gt; i < (size_t)256 * DM; i += NGT) { const int r = (int)(i >> 11), k = (int)(i & 2047); WKVF[(size_t)(1024 + r) * DM + k] = r < 16 ? (bf16_t)(pk2(wf[k * 16 + r] * nkv[k], 0.f) & 0xffffu) : (bf16_t)0; }
      float* ssq = (float*)(ws + WS_SSQ); for (size_t i = gt; i < (size_t)4 * TALL; i += NGT) ssq[i] = 0.f; }
    { float* COS = (float*)(ws + WS_COS); float* SIN = (float*)(ws + WS_SIN);
      for (size_t i = gt; i < (size_t)SEQ * 128; i += NGT) { const int pos = (int)(i >> 7), d = (int)(i & 127);
        const float inv = exp2f(-(float)d * (13.287712379549449f / 128.f));
        const double rev = (double)pos * (double)inv * 0.15915494309189535; const float fr = (float)(rev - __builtin_floor(rev));
        COS[i] = __builtin_amdgcn_cosf(fr); SIN[i] = __builtin_amdgcn_sinf(fr); } }
    { const float* x_p = INF(0); const float* x_s = INF(1); const float* nm = INF(6); bf16_t* XN0 = (bf16_t*)OUTP;
      for (int m = gw; m < TALL; m += NGW) rms_row<0>(m < TP ? x_p + (size_t)m * DM : x_s + (size_t)(m - TP) * DM, nm, XN0 + (size_t)m * DM, nullptr, nullptr, nullptr, lane); }
}
template <int JOB> __device__ __forceinline__ void ph_conv(LAS unsigned char* lds) {
    const int tid = opaque_tid(), lane = tid & 63, wave = __builtin_amdgcn_readfirstlane(tid >> 6);
    const int G = gridDim.x, first = G > 160 ? (JOB == 1 ? 48 : JOB == 3 ? 141 : 44) : 0;
    if ((int)blockIdx.x < first) return;
    const int gw = ((int)blockIdx.x - first) * NWAVES + wave, NGW = (G - first) * NWAVES;
    unsigned char* ws = WSP; LAS float* scr = (LAS float*)(lds + wave * 16384);
    constexpr int IG = 32 * 176, ID = 88 * 64, IQ = 32 * 64, IK = 32 * 16;
    if (JOB == 1) {
        bf16_t* WRO = (bf16_t*)(ws + WS_WRO); bf16_t* WGU0 = (bf16_t*)(ws + WS_WGU0);
        for (int it = gw; it < 64 * 64 + 2 * IG; it += NGW) { int r = it;
            if (r < 64 * 64) { tr_plain(INF(11), 4096, DM, WRO, 0, scr, r, lane); continue; } r -= 64 * 64;
            if (r < IG) { tr_gu(INF(18), WGU0, 0, scr, r, lane, INF(7)); continue; } r -= IG;
            tr_gu(INF(19), WGU0, 1, scr, r, lane, INF(7)); }
    } else if (JOB == 2) {
        bf16_t* WDN0 = (bf16_t*)(ws + WS_WDN0); bf16_t* WGU1 = (bf16_t*)(ws + WS_WGU1); bf16_t* WO = (bf16_t*)(ws + WS_WO); bf16_t* WKVF = (bf16_t*)(ws + WS_WKVF);
        for (int it = gw; it < ID + 2 * IQ + 2 * IK + IG; it += NGW) { int r = it;
            if (r < ID) { tr_plain(INF(20), DFF, DM, WDN0, 0, scr, r, lane); continue; } r -= ID;
            if (r < IQ) { tr_plain(INF(16), DM, DM, WKVF, 1280, scr, r, lane, INF(6) + DM); continue; } r -= IQ;
            if (r < IK) { tr_plain(INF(12), DM, 512, WKVF, 0, scr, r, lane, INF(8)); continue; } r -= IK;
            if (r < IK) { tr_plain(INF(13), DM, 512, WKVF, 512, scr, r, lane, INF(8)); continue; } r -= IK;
            if (r < IQ) { tr_plain(INF(17), DM, DM, WO, 0, scr, r, lane); continue; } r -= IQ;
            tr_gu(INF(18) + (size_t)DM * DFF, WGU1, 0, scr, r, lane, INF(7) + DM); }
    } else if (JOB == 3) {
        bf16_t* WGU1 = (bf16_t*)(ws + WS_WGU1);
        for (int it = gw; it < IG; it += NGW) tr_gu(INF(19) + (size_t)DM * DFF, WGU1, 1, scr, it, lane, INF(7) + DM);
    } else {
        bf16_t* WDN1 = (bf16_t*)(ws + WS_WDN1);
        for (int it = gw; it < ID; it += NGW) tr_plain(INF(20) + (size_t)DFF * DM, DFF, DM, WDN1, 0, scr, it, lane);
    }
}
__device__ __forceinline__ void ph_retin(LAS unsigned char* lds) {
    unsigned char* ws = WSP;
    pg8::Gemm g{(const bf16_t*)OUTP, (const bf16_t*)(ws + WS_WIN), TALL, NPROJ, DM, DM}; pg8::StaticOrder S; S.init(TALL, NPROJ, (int)gridDim.x, (int)blockIdx.x);
    pg8::EpiRetIn E{(bf16_t*)(ws + WS_BIG), (const float*)(ws + WS_COS), (const float*)(ws + WS_SIN)};
    pg8::gemm_phase<pg8::EpiRetIn, pg8::StaticOrder, true, true>(lds, g, S, E);
}
__device__ __forceinline__ void ph_retention(LAS unsigned char* lds) {
    const int G = gridDim.x;
    for (int it = blockIdx.x; it < 256; it += G) { const int bh = (it & 7) * 4 + (it >> 6), es = (it >> 3) & 7, b = bh >> 3, h = bh & 7;
        ret::ret_item((LAS char*)lds, (const bf16_t*)BIGP, (size_t)(b * 8 + h) * SEQ, (bf16_t*)OUTP, 128, 64, h, es, nullptr, OUTP + OUT_SP + (size_t)(b * 8 + h) * 256 * 512); }
    for (int it = blockIdx.x; it < 512; it += G) { const int bh = (it & 7) * 8 + (it >> 6), es = (it >> 3) & 7, b = bh >> 3, h = bh & 7;
        ret::ret_item((LAS char*)lds, (const bf16_t*)BIGP, (size_t)262144 + (size_t)(b * 8 + h) * 32, (bf16_t*)OUTP, 1, 32, h, es, INF(2) + (size_t)(b * 8 + h) * 256 * 512, OUTP + OUT_SS + (size_t)(b * 8 + h) * 256 * 512); }
}
__device__ __forceinline__ void ph_groupnorm() {
    PH_IDS; bf16_t* PROJ = (bf16_t*)BIGP; const bf16_t* OB = (const bf16_t*)OUTP;
    for (int it0 = gw * 4; it0 < TALL * 8; it0 += NGW * 4) {
        u32x4 ovv[4], gvv[4];
#pragma unroll
        for (int q = 0; q < 4; ++q) { const int it = it0 + q, row = it >> 3, h = it & 7;
            ovv[q] = *(const u32x4*)(OB + hrow(row, h) * 512 + lane * 8); gvv[q] = *(const u32x4*)(PROJ + PJ_G + (size_t)row * 4096 + h * 512 + lane * 8); }
#pragma unroll
        for (int q = 0; q < 4; ++q) { const int it = it0 + q, row = it >> 3, h = it & 7; const u32x4 ov = ovv[q], gv = gvv[q];
            bf16_t* op = PROJ + PJ_G + (size_t)row * 4096 + h * 512 + lane * 8;
            float o[8], g[8]; const unsigned ow[4] = {ov.x, ov.y, ov.z, ov.w}, gwd[4] = {gv.x, gv.y, gv.z, gv.w};
#pragma unroll
            for (int j = 0; j < 4; ++j) { o[2 * j] = __uint_as_float(ow[j] << 16); o[2 * j + 1] = __uint_as_float(ow[j] & 0xffff0000u); g[2 * j] = __uint_as_float(gwd[j] << 16); g[2 * j + 1] = __uint_as_float(gwd[j] & 0xffff0000u); }
            float s = 0.f;
#pragma unroll
            for (int j = 0; j < 8; ++j) s += o[j];
            const float mu = wave_sum(s) * (1.f / 512.f); float qq = 0.f;
#pragma unroll
            for (int j = 0; j < 8; ++j) { o[j] -= mu; qq += o[j] * o[j]; }
            const float rstd = 1.0f / sqrtf(wave_sum(qq) * (1.f / 512.f) + 1e-5f);
#pragma unroll
            for (int j = 0; j < 8; ++j) o[j] = o[j] * rstd * pg8::silu_f(g[j]);
            u32x4 w; w.x = pk2(o[0], o[1]); w.y = pk2(o[2], o[3]); w.z = pk2(o[4], o[5]); w.w = pk2(o[6], o[7]); *(u32x4*)op = w; } }
}
template <bool FIRST, int MROWS = TALL> __device__ __forceinline__ void ph_res_gemm(LAS unsigned char* lds, unsigned char* a_ptr, size_t w_off, int K, int lda, const bf16_t* base_h, bf16_t* hb, int ssq_idx) {
    unsigned char* ws = WSP;
    pg8::Gemm g{(const bf16_t*)a_ptr, (const bf16_t*)(ws + w_off), MROWS, DM, K, lda}; pg8::StaticOrder S; S.init(MROWS, DM, (int)gridDim.x, (int)blockIdx.x);
    pg8::EpiRes<!FIRST> E{FIRST ? INF(0) : nullptr, FIRST ? INF(1) : nullptr, base_h, hb, (float*)(ws + WS_SSQ) + (size_t)ssq_idx * TALL};
    pg8::gemm_phase<pg8::EpiRes<!FIRST>, pg8::StaticOrder, true, true>(lds, g, S, E);
}
template <bool FIRST = false> __device__ __forceinline__ void ph_sample_res(const unsigned char* a_ptr, int lda, size_t w_off, int K, const bf16_t* base_h, bf16_t* hb, int ssq_idx) {
    const int tid = opaque_tid(), lane = tid & 63, wave = __builtin_amdgcn_readfirstlane(tid >> 6), fr = lane & 15, fq = lane >> 4;
    unsigned char* ws = WSP;
    const bf16_t* A = (const bf16_t*)a_ptr; const bf16_t* Wt = (const bf16_t*)(ws + w_off);
    float* ssq = (float*)(ws + WS_SSQ) + (size_t)ssq_idx * TALL + TP;
    for (int it = blockIdx.x; it < 256; it += gridDim.x) {
        const int n0 = (it >> 1) * 16, row = (it & 1) * 128 + 16 * wave + fr;
        const bf16_t* bp = Wt + (size_t)(n0 + fr) * K + 8 * fq; const bf16_t* ap = A + (size_t)row * lda + 8 * fq;
        f32x4 acc = {0.f, 0.f, 0.f, 0.f};
        bf16x8 bA[8], aA[8], bB[8], aB[8];
#define SR_LOAD(B_, A_, kk) do { _Pragma("unroll") for (int s_ = 0; s_ < 8; ++s_) { B_[s_] = *(const bf16x8*)(bp + (kk) + 32 * s_); A_[s_] = *(const bf16x8*)(ap + (kk) + 32 * s_); } } while (0)
#define SR_MMA(B_, A_) do { _Pragma("unroll") for (int s_ = 0; s_ < 8; ++s_) acc = __builtin_amdgcn_mfma_f32_16x16x32_bf16(B_[s_], A_[s_], acc, 0, 0, 0); } while (0)
        SR_LOAD(bA, aA, 0);
        for (int k0 = 0; k0 < K; k0 += 512) {
            SR_LOAD(bB, aB, k0 + 256);
            SR_MMA(bA, aA);
            if (k0 + 512 < K) SR_LOAD(bA, aA, k0 + 512);
            SR_MMA(bB, aB);
        }
#undef SR_LOAD
#undef SR_MMA
        f32x4 bvv;
        if (FIRST) bvv = *(const f32x4*)(INF(1) + (size_t)row * DM + n0 + 4 * fq);
        else { const u32x2 t = *(const u32x2*)(base_h + (size_t)(TP + row) * DM + n0 + 4 * fq); bvv = (f32x4){__uint_as_float(t.x << 16), __uint_as_float(t.x & 0xffff0000u), __uint_as_float(t.y << 16), __uint_as_float(t.y & 0xffff0000u)}; }
        const f32x4 v = bvv + acc;
        { u32x2 w; w.x = pk2(v[0], v[1]); w.y = pk2(v[2], v[3]); *(u32x2*)(hb + (size_t)(TP + row) * DM + n0 + 4 * fq) = w; }
        { float ss = (v[0] * v[0] + v[1] * v[1]) + (v[2] * v[2] + v[3] * v[3]); ss += __shfl_xor(ss, 16); ss += __shfl_xor(ss, 32);
            if (fq == 0) (void)__hip_atomic_fetch_add(ssq + row, ss, __ATOMIC_RELAXED, __HIP_MEMORY_SCOPE_AGENT); }
    }
}
template <int MODE> __device__ __forceinline__ void ph_rms(const float* g1, size_t o1_off, const float* g2, size_t o2_off) {
    PH_IDS; float* Hres = OUTP + OUT_Y; unsigned char* ws = WSP;
    for (int m = gw; m < TALL; m += NGW) rms_row<MODE>(Hres + (size_t)m * DM, g1, (bf16_t*)(ws + o1_off) + (size_t)m * DM, g2, (bf16_t*)(ws + o2_off) + (size_t)m * DM, Hres + (size_t)m * DM, lane);
}
__device__ __forceinline__ void ph_cache_cvt() {
    PH_IDS; const float* cache_k = INF(3); const float* cache_v = INF(4); bf16_t* KALL = (bf16_t*)(BIGP + BIG_KALL); bf16_t* VALL = (bf16_t*)(BIGP + BIG_VALL);
    for (size_t i = gt; i < (size_t)8 * PASTL * 512 / 4; i += NGT) { const size_t e = i * 4, b = e / ((size_t)PASTL * 512), r = e % ((size_t)PASTL * 512);
        const f32x4 kv = *(const f32x4*)(cache_k + e), vv = *(const f32x4*)(cache_v + e); u32x2 w; w.x = pk2(kv.x, kv.y); w.y = pk2(kv.z, kv.w); *(u32x2*)(KALL + b * LKS * 512 + r) = w;
        w.x = pk2(vv.x, vv.y); w.y = pk2(vv.z, vv.w); *(u32x2*)(VALL + b * LKS * 512 + r) = w; }
}
__device__ __forceinline__ void ph_kvfq(LAS unsigned char* lds) {
    unsigned char* ws = WSP; unsigned char* big = ws + WS_BIG; float* out = OUTP;
    pg8::Gemm g{(const bf16_t*)(big + BIG_XN), (const bf16_t*)(ws + WS_WKVF), TALL, 3328, DM, DM}; pg8::StaticOrder S; S.init(TALL, 3328, (int)gridDim.x, (int)blockIdx.x);
    pg8::EpiKVFQ E{out + OUT_KP, out + OUT_VP, out + OUT_LFP, out + OUT_KS, out + OUT_VS, out + OUT_LFS, (bf16_t*)(big + BIG_KB), (bf16_t*)(big + BIG_VB), (bf16_t*)(big + BIG_KALL), (bf16_t*)(big + BIG_VALL),
                    (bf16_t*)(big + BIG_ACT), INF(15), (const float*)(ws + WS_SSQ) + (size_t)1 * TALL};
    pg8::gemm_phase<pg8::EpiKVFQ, pg8::StaticOrder, true, true>(lds, g, S, E);
}
__device__ __forceinline__ void ph_cumsum(LAS unsigned char* lds) {
    PH_IDS; const float* cache_lf = INF(5); const float* out = OUTP; float* FB = (float*)(WSP + WS_FB); float* FS = (float*)(WSP + WS_FS);
    for (int it = blockIdx.x; it < 64 + 128; it += G) {
        LAS float* wtot = (LAS float*)lds;
        const bool smp = it >= 64; const int bh = smp ? it - 64 : it, b = bh >> 4, h = bh & 15, Ls = smp ? LKS : SEQ, per = smp ? 3 : 16, j0 = tid * per;
        float v[16]; float s = 0.f;
#pragma unroll
        for (int i = 0; i < 16; ++i) { const int j = j0 + i; float x = 0.f;
            if (i < per && j < Ls) x = smp ? (j < PASTL ? cache_lf[((size_t)b * PASTL + j) * 16 + h] : out[OUT_LFS + ((size_t)b * 32 + (j - PASTL)) * 16 + h]) : out[OUT_LFP + ((size_t)b * SEQ + j) * 16 + h];
            s += x; v[i] = s; }
        float inc = s;
#pragma unroll
        for (int o = 1; o < 64; o <<= 1) { const float t = __shfl_up(inc, o); if (lane >= o) inc += t; }
        if (lane == 63) wtot[wave] = inc;
        __syncthreads();
        float base = inc - s;
        for (int w = 0; w < wave; ++w) base += wtot[w];
#pragma unroll
        for (int i = 0; i < 16; ++i) { const int j = j0 + i; if (i < per && j < Ls) { const float F = base + v[i];
            if (smp) FS[(size_t)bh * LKS + j] = F; else FB[(size_t)bh * SEQ + j] = -F * 11.313708498984761f; } }
        __syncthreads();
    }
}
__device__ __forceinline__ void ph_attn(unsigned char* lds_raw) {
    unsigned char* ws = WSP; unsigned char* big = ws + WS_BIG;
    fox::attn_phase((char*)lds_raw, (const bf16_t*)(big + BIG_ACT), (const bf16_t*)(big + BIG_KB), (const bf16_t*)(big + BIG_VB), (bf16_t*)OUTP  , (const float*)(ws + WS_FB));
}
__device__ __forceinline__ void ph_sattn(LAS unsigned char* lds) {
    unsigned char* ws = WSP; unsigned char* big = ws + WS_BIG;
    sample_attn((LAS char*)lds, (const bf16_t*)(big + BIG_ACT), (const bf16_t*)(big + BIG_KALL), (const bf16_t*)(big + BIG_VALL), (const float*)(ws + WS_FS), (bf16_t*)OUTP);
}
__device__ __forceinline__ void ph_gateup(LAS unsigned char* lds, const unsigned char* a_ptr, size_t w_off, int ssq_idx) {
    unsigned char* ws = WSP; unsigned char* big = ws + WS_BIG;
    pg8::Gemm g{(const bf16_t*)a_ptr, (const bf16_t*)(ws + w_off), TALL, 2 * DFF, DM, DM}; pg8::StaticOrder S; S.init(TALL, 2 * DFF, (int)gridDim.x, (int)blockIdx.x);
    pg8::EpiSwiglu E{(bf16_t*)(big + BIG_ACT), (const float*)(ws + WS_SSQ) + (size_t)ssq_idx * TALL};
    pg8::gemm_phase<pg8::EpiSwiglu, pg8::StaticOrder, true, true>(lds, g, S, E);
}

__device__ __forceinline__ void ph_final() {
    PH_IDS; const bf16_t* H4 = (const bf16_t*)(BIGP + BIG_XN); const float* ssq = (const float*)(WSP + WS_SSQ) + (size_t)3 * TALL; const float* g = INF(9); float* Y = OUTP + OUT_Y;
    for (int m = gw; m < TALL; m += NGW) {
        const u32x4* hr = (const u32x4*)(H4 + (size_t)m * DM); u32x4 hv[4];
#pragma unroll
        for (int j = 0; j < 4; ++j) hv[j] = hr[64 * j + lane];
        const float rs = 1.0f / sqrtf(ssq[m] * (1.f / DM) + 1e-6f);
#pragma unroll
        for (int j = 0; j < 4; ++j) { const int c0 = (64 * j + lane) * 8; const f32x4 g0 = *(const f32x4*)(g + c0), g1 = *(const f32x4*)(g + c0 + 4);
            f32x4 y0, y1; y0.x = __uint_as_float(hv[j].x << 16); y0.y = __uint_as_float(hv[j].x & 0xffff0000u); y0.z = __uint_as_float(hv[j].y << 16); y0.w = __uint_as_float(hv[j].y & 0xffff0000u);
            y1.x = __uint_as_float(hv[j].z << 16); y1.y = __uint_as_float(hv[j].z & 0xffff0000u); y1.z = __uint_as_float(hv[j].w << 16); y1.w = __uint_as_float(hv[j].w & 0xffff0000u);
            *(f32x4*)(Y + (size_t)m * DM + c0) = y0 * rs * g0; *(f32x4*)(Y + (size_t)m * DM + c0 + 4) = y1 * rs * g1; } }
}
__global__ void __launch_bounds__(NWAVES * 64, 2) yoco_fwd(Params P) {
    extern __shared__ __attribute__((aligned(16))) unsigned char lds_raw[];
    cg::grid_group grid = cg::this_grid();
    LAS unsigned char* lds = (LAS unsigned char*)lds_raw;
    volatile LAS unsigned* bst = (volatile LAS unsigned*)(lds + 148480);
    if (opaque_tid() < 2) bst[opaque_tid()] = 0u;
    __syncthreads();
    const XcdBarrier xbar = xcd_barrier_post((unsigned*)(WSP + WS_BAR), bst);
#define GSYNC() xcd_barrier(xbar)
    ph_prologue(lds);                                                                                   GSYNC();
    if (WSP == nullptr) grid.sync();
    ph_retin(lds); ph_conv<1>(lds);                                                                                      GSYNC();
    ph_retention(lds);                                                                                  GSYNC();
    ph_groupnorm();                                                                                     GSYNC();
    ph_res_gemm<true, TP>(lds, BIGP + PJ_G * 2, WS_WRO, 4096, 4096, nullptr, (bf16_t*)(OUTP + OUT_KP), 0); ph_sample_res<true>(BIGP + (PJ_G + (size_t)TP * 4096) * 2, 4096, WS_WRO, 4096, nullptr, (bf16_t*)(OUTP + OUT_KP), 0);   GSYNC();
    ph_gateup(lds, (const unsigned char*)(OUTP + OUT_KP), WS_WGU0, 0); ph_conv<2>(lds);                                  GSYNC();
    ph_res_gemm<false, TP>(lds, BIGP + BIG_ACT, WS_WDN0, DFF, DFF, (const bf16_t*)(OUTP + OUT_KP), (bf16_t*)(BIGP + BIG_XN), 1); ph_sample_res(BIGP + BIG_ACT + (size_t)TP * DFF * 2, DFF, WS_WDN0, DFF, (const bf16_t*)(OUTP + OUT_KP), (bf16_t*)(BIGP + BIG_XN), 1); ph_cache_cvt();   GSYNC();
    ph_kvfq(lds); ph_conv<3>(lds);                                                                                       GSYNC();
    ph_cumsum(lds);                                                                                     GSYNC();
    ph_attn(lds_raw); __syncthreads(); ph_sattn(lds);                                                   GSYNC();
    ph_res_gemm<false, TP>(lds, (unsigned char*)OUTP, WS_WO, DM, DM, (const bf16_t*)(BIGP + BIG_XN), (bf16_t*)(BIGP + BIG_HKV), 2); ph_sample_res((const unsigned char*)OUTP + (size_t)TP * DM * 2, DM, WS_WO, DM, (const bf16_t*)(BIGP + BIG_XN), (bf16_t*)(BIGP + BIG_HKV), 2);   GSYNC();
    ph_gateup(lds, BIGP + BIG_HKV, WS_WGU1, 2); ph_conv<4>(lds);                                                         GSYNC();
    ph_res_gemm<false, TP>(lds, BIGP + BIG_ACT, WS_WDN1, DFF, DFF, (const bf16_t*)(BIGP + BIG_HKV), (bf16_t*)(BIGP + BIG_XN), 3); ph_sample_res(BIGP + BIG_ACT + (size_t)TP * DFF * 2, DFF, WS_WDN1, DFF, (const bf16_t*)(BIGP + BIG_HKV), (bf16_t*)(BIGP + BIG_XN), 3);   GSYNC();
    ph_final();
}

extern "C" void kernel_launch(void* const* d_in, const int* in_sizes, int n_in, void* d_out, int out_size, void* d_ws, size_t ws_size, hipStream_t stream) {
    static int grid = 0;
    if (grid == 0) {
        if (n_in != 21 || ws_size < WS_END) { fprintf(stderr, "kernel_launch: unexpected n_in %d / ws_size %zu (need %zu)\n", n_in, ws_size, (size_t)WS_END); grid = -1; return; }
        int dev = 0, cus = 0, per_cu = 0;
        (void)hipGetDevice(&dev); (void)hipDeviceGetAttribute(&cus, hipDeviceAttributeMultiprocessorCount, dev);
        if (hipFuncSetAttribute((const void*)yoco_fwd, hipFuncAttributeMaxDynamicSharedMemorySize, LDS_BYTES) != hipSuccess) { fprintf(stderr, "kernel_launch: hipFuncSetAttribute failed\n"); grid = -1; return; }
        if (hipOccupancyMaxActiveBlocksPerMultiprocessor(&per_cu, (const void*)yoco_fwd, NWAVES * 64, LDS_BYTES) != hipSuccess || per_cu < 1) { fprintf(stderr, "kernel_launch: occupancy query says %d\n", per_cu); per_cu = 1; }
        (void)hipGetLastError();
        grid = cus > 0 ? cus : 256;
    }
    if (grid < 0) return;
    if (hipMemsetAsync((char*)d_ws + WS_BAR, 0, XCD_BAR_WORDS * 4, stream) != hipSuccess) { fprintf(stderr, "kernel_launch: memset of the barrier words failed\n"); return; }
    Params p{};
    for (int i = 0; i < 21; ++i) p.in[i] = (const float*)d_in[i];
    p.out = (float*)d_out; p.ws = (unsigned char*)d_ws;
    void* args[] = {&p};
    hipError_t e = hipLaunchCooperativeKernel((const void*)yoco_fwd, dim3(grid), dim3(NWAVES * 64), args, LDS_BYTES, stream);
    if (e != hipSuccess) fprintf(stderr, "cooperative launch failed: %s (grid %d)\n", hipGetErrorString(e), grid);
}
```

```cpp
#include <hip/hip_runtime.h>
#include <hip/hip_cooperative_groups.h>
#include <cstdio>
#include <cstdint>
namespace cg = cooperative_groups;
__device__ __forceinline__ int opaque_tid() { int t = threadIdx.x; asm volatile("" : "+v"(t)); return t; }
namespace pg8 {
#define PG8_LAS __attribute__((address_space(3)))
typedef unsigned short bf16_t;
typedef short bf16x8 __attribute__((ext_vector_type(8)));
typedef float f32x4 __attribute__((ext_vector_type(4)));
typedef unsigned u32x4 __attribute__((ext_vector_type(4)));
constexpr int BM = 256, BK = 64, HALF = 128, HTB = HALF * BK * 2  , STAGE_BYTES = 8 * HTB, NXCD = 8, WGM = 4;

__host__ __device__ __forceinline__ int lds_byte(int r, int c) { const int st = (r >> 4) * 2 + (c >> 5), rr = r & 15, cc = c & 31, ob = rr * 64 + cc * 2; return st * 1024 + (ob ^ (((ob >> 9) & 1) << 5)); }
__host__ __device__ __forceinline__ void stage_rc(int b, int& R, int& C) { const int st = b / 1024, sb = b % 1024, swz = sb ^ (((sb >> 9) & 1) << 5); R = (st >> 1) * 16 + swz / 64; C = (st & 1) * 32 + (swz % 64) / 2; }
__host__ __device__ __forceinline__ int perm32(int rho) { const int n = rho >> 4, i = rho & 15; return 8 * (i >> 2) + 4 * n + (i & 3); }

struct Unit { int pm, pn; };
struct Gemm { const bf16_t* A; const bf16_t* Bt; int M, N, K, lda; };

struct StaticOrder {
    int nM, nN, nwg, G, c;
    __host__ __device__ void init(int M, int N, int G_, int c_) { nM = M / BM; nN = N / BM; nwg = nM * nN; G = G_; c = c_; }
    __host__ __device__ bool next(int i, Unit& u) const {
        const long L = (long)i * G + c; if (L >= nwg) return false;
        int wgid = (int)L; { const int q = nwg / NXCD, r = nwg % NXCD, xcd = wgid % NXCD, off = wgid / NXCD; wgid = (xcd < r ? xcd * (q + 1) : r * (q + 1) + (xcd - r) * q) + off; }
        const int nig = WGM * nN, gid = wgid / nig, fm = gid * WGM, gsz = (nM - fm) < WGM ? (nM - fm) : WGM;
        u.pm = fm + ((wgid % nig) % gsz); u.pn = (wgid % nig) / gsz; return true;
    }
    __device__ __forceinline__ void a_ready(const Unit&) const {}
    __device__ __forceinline__ void done(const Unit&) const {}
};

__device__ __forceinline__ unsigned cvt_pk_bf16(float lo, float hi) { unsigned r; asm volatile("v_cvt_pk_bf16_f32 %0, %1, %2" : "=v"(r) : "v"(lo), "v"(hi)); return r; }
template <class Epi, class Sched, bool ALIGN_EPI = false, bool SP2 = false>
__device__ __forceinline__ void gemm_phase(PG8_LAS unsigned char* lds, const Gemm g, const Sched& S, const Epi& E) {
    const int tid = opaque_tid(), wid = __builtin_amdgcn_readfirstlane(tid >> 6), lane = tid & 63, wr = wid >> 2, wc = wid & 3, fr = lane & 15, fq = lane >> 4;
    const int K = g.K, nt = K / BK;
    unsigned voffA[2], voffB[2];
#pragma unroll
    for (int i = 0; i < 2; ++i) { int R, C; stage_rc(tid * 16 + i * 8192, R, C); const int Rb = Epi::PERM ? ((R & ~31) + perm32(R & 31)) : R;
        voffA[i] = (unsigned)(R * g.lda + C) * 2u; voffB[i] = (unsigned)(Rb * K + C) * 2u; }
    const size_t kstep = (size_t)(BK * 2);
    const size_t hstep = (size_t)HALF * K * 2, hstepA = (size_t)HALF * g.lda * 2;
    const size_t tstep = 2 * hstep, tstepA = 2 * hstepA;
    const unsigned ldsw = (unsigned)wid * 1024u;
    const int aoff = lds_byte(wr * 64 + fr, fq * 8), boff = lds_byte(wc * 32 + fr, fq * 8);
#define PG8_SA(b, h) (((b) * 2 + (h)) * HTB)
#define PG8_SB(b, h) ((4 + (b) * 2 + (h)) * HTB)
#define PG8_STAGE(bufoff, gbase, voff) do { _Pragma("unroll") for (int _i = 0; _i < 2; ++_i) \
        __builtin_amdgcn_global_load_lds((const unsigned*)((const char*)(gbase) + (voff)[_i]), (PG8_LAS unsigned*)(lds + (bufoff) + ldsw + _i * 8192), 16, 0, 0); } while (0)
#define PG8_LDA(dst, b, h) do { _Pragma("unroll") for (int m = 0; m < 4; ++m) _Pragma("unroll") for (int k = 0; k < 2; ++k) dst[m][k] = *(const PG8_LAS bf16x8*)(lds + PG8_SA(b, h) + aoff + m * 2048 + k * 1024); } while (0)
#define PG8_LDB(dst, b, h) do { _Pragma("unroll") for (int n = 0; n < 2; ++n) _Pragma("unroll") for (int k = 0; k < 2; ++k) dst[n][k] = *(const PG8_LAS bf16x8*)(lds + PG8_SB(b, h) + boff + n * 2048 + k * 1024); } while (0)
#define PG8_MMA(ai, bj, At, Bt) do { __builtin_amdgcn_s_setprio(1); _Pragma("unroll") for (int m = 0; m < 4; ++m) _Pragma("unroll") for (int n = 0; n < 2; ++n) _Pragma("unroll") for (int k = 0; k < 2; ++k) \
        acc[ai][bj][m][n] = __builtin_amdgcn_mfma_f32_16x16x32_bf16(Bt[n][k], At[m][k], acc[ai][bj][m][n], 0, 0, 0); __builtin_amdgcn_s_setprio(0); } while (0)
#define PG8_WAIT_V(n) asm volatile("s_waitcnt vmcnt(" #n ")" ::: "memory")
#define PG8_WAIT_L(n) asm volatile("s_waitcnt lgkmcnt(" #n ")" ::: "memory")
#define PG8_BAR __builtin_amdgcn_s_barrier()
#define PG8_SCHED __builtin_amdgcn_sched_barrier(0)
    Unit cur, nxt; int ui = 0;
    if (!S.next(0, cur)) return;
    f32x4 acc[2][2][4][2];
#pragma unroll
    for (int a = 0; a < 2; ++a)
#pragma unroll
        for (int b = 0; b < 2; ++b)
#pragma unroll
            for (int m = 0; m < 4; ++m)
#pragma unroll
                for (int n = 0; n < 2; ++n) acc[a][b][m][n] = (f32x4){0.f, 0.f, 0.f, 0.f};
    bf16x8 At[4][2], B0[2][2], B1[2][2];
    const char* cA = (const char*)g.A + (size_t)cur.pm * tstepA; const char* cB = (const char*)g.Bt + (size_t)cur.pn * tstep;
    S.a_ready(cur);
    if constexpr (SP2) {
        PG8_STAGE(PG8_SB(0, 0), cB, voffB); PG8_STAGE(PG8_SB(0, 1), cB + hstep, voffB); PG8_STAGE(PG8_SA(0, 0), cA, voffA); PG8_STAGE(PG8_SA(0, 1), cA + hstepA, voffA);
        if (wr == 1) PG8_BAR;
        PG8_WAIT_V(2); PG8_BAR;
        PG8_STAGE(PG8_SB(1, 0), cB + kstep, voffB); PG8_STAGE(PG8_SA(1, 0), cA + kstep, voffA); PG8_STAGE(PG8_SB(1, 1), cB + hstep + kstep, voffB);
        PG8_WAIT_V(6); PG8_BAR;
    } else {
        PG8_STAGE(PG8_SB(0, 0), cB, voffB); PG8_STAGE(PG8_SA(0, 0), cA, voffA); PG8_STAGE(PG8_SB(0, 1), cB + hstep, voffB); PG8_STAGE(PG8_SA(0, 1), cA + hstepA, voffA);
        if (wr == 1) PG8_BAR;
        PG8_WAIT_V(4); PG8_BAR;
        PG8_STAGE(PG8_SB(1, 0), cB + kstep, voffB); PG8_STAGE(PG8_SA(1, 0), cA + kstep, voffA); PG8_STAGE(PG8_SB(1, 1), cB + hstep + kstep, voffB);
        PG8_WAIT_V(6); PG8_BAR;
    }
    for (;;) {
        const bool has_next = S.next(ui + 1, nxt);
        const char* nA = has_next ? (const char*)g.A + (size_t)nxt.pm * tstepA : cA; const char* nB = has_next ? (const char*)g.Bt + (size_t)nxt.pn * tstep : cB;
        for (int t = 0; t < nt; t += 2) {
            const bool last = (t == nt - 2);
            const char* a1 = cA + (size_t)(t + 1) * kstep;
            const char* a2 = last ? nA : cA + (size_t)(t + 2) * kstep; const char* b2 = last ? nB : cB + (size_t)(t + 2) * kstep;
            const char* a3 = a2 + kstep; const char* b3 = b2 + kstep;
            if (last && has_next) S.a_ready(nxt);
            if constexpr (SP2) {
            PG8_LDB(B0, 0, 0); PG8_LDB(B1, 0, 1); PG8_SCHED; PG8_LDA(At, 0, 0); PG8_STAGE(PG8_SA(1, 1), a1 + hstepA, voffA);
            PG8_WAIT_V(8); PG8_WAIT_L(0); PG8_BAR; PG8_MMA(0, 0, At, B0); PG8_MMA(0, 1, At, B1); PG8_BAR; PG8_SCHED;
            PG8_LDA(At, 0, 1); PG8_STAGE(PG8_SB(0, 0), b2, voffB); PG8_STAGE(PG8_SB(0, 1), b2 + hstep, voffB); PG8_STAGE(PG8_SA(0, 0), a2, voffA);
            PG8_WAIT_V(8); PG8_WAIT_L(0); PG8_BAR; PG8_MMA(1, 0, At, B0); PG8_MMA(1, 1, At, B1); PG8_BAR; PG8_SCHED;
            PG8_LDB(B0, 1, 0); PG8_LDB(B1, 1, 1); PG8_SCHED; PG8_LDA(At, 1, 0); PG8_STAGE(PG8_SA(0, 1), a2 + hstepA, voffA);
            PG8_WAIT_V(8); PG8_WAIT_L(0); PG8_BAR; PG8_MMA(0, 0, At, B0); PG8_MMA(0, 1, At, B1); PG8_BAR; PG8_SCHED;
            PG8_LDA(At, 1, 1); PG8_STAGE(PG8_SB(1, 0), b3, voffB); PG8_STAGE(PG8_SB(1, 1), b3 + hstep, voffB); PG8_STAGE(PG8_SA(1, 0), a3, voffA);
            PG8_WAIT_V(8); PG8_WAIT_L(0); PG8_BAR; PG8_MMA(1, 0, At, B0); PG8_MMA(1, 1, At, B1); PG8_BAR; PG8_SCHED;
            } else {
            PG8_LDB(B0, 0, 0); PG8_SCHED; PG8_LDA(At, 0, 0); PG8_STAGE(PG8_SA(1, 1), a1 + hstepA, voffA);
            PG8_WAIT_L(8); PG8_BAR; PG8_WAIT_L(0); PG8_MMA(0, 0, At, B0); PG8_BAR; PG8_SCHED;
            PG8_LDB(B1, 0, 1); PG8_STAGE(PG8_SB(0, 0), b2, voffB);
            PG8_BAR; PG8_WAIT_L(0); PG8_MMA(0, 1, At, B1); PG8_BAR;
            PG8_LDA(At, 0, 1); PG8_STAGE(PG8_SA(0, 0), a2, voffA);
            PG8_BAR; PG8_WAIT_L(0); PG8_MMA(1, 0, At, B0); PG8_BAR; PG8_SCHED;
            PG8_STAGE(PG8_SB(0, 1), b2 + hstep, voffB);
            PG8_WAIT_V(6); PG8_BAR; PG8_MMA(1, 1, At, B1); PG8_BAR;
            PG8_LDB(B0, 1, 0); PG8_SCHED; PG8_LDA(At, 1, 0); PG8_STAGE(PG8_SA(0, 1), a2 + hstepA, voffA);
            PG8_WAIT_L(8); PG8_BAR; PG8_WAIT_L(0); PG8_MMA(0, 0, At, B0); PG8_BAR; PG8_SCHED;
            PG8_LDB(B1, 1, 1); PG8_STAGE(PG8_SB(1, 0), b3, voffB);
            PG8_BAR; PG8_WAIT_L(0); PG8_MMA(0, 1, At, B1); PG8_BAR;
            PG8_LDA(At, 1, 1); PG8_STAGE(PG8_SA(1, 0), a3, voffA);
            PG8_BAR; PG8_WAIT_L(0); PG8_MMA(1, 0, At, B0); PG8_BAR; PG8_SCHED;
            PG8_STAGE(PG8_SB(1, 1), b3 + hstep, voffB);
            PG8_WAIT_V(6); PG8_BAR; PG8_MMA(1, 1, At, B1); PG8_BAR;
            }
        }
        if constexpr (ALIGN_EPI) { if (wr == 0) PG8_BAR; }
        if constexpr (!Epi::AFTER_DRAIN) { E(acc, cur, wr, wc, fr, fq); S.done(cur); }
        if (!has_next) break;
#pragma unroll
        for (int a = 0; a < 2; ++a)
#pragma unroll
            for (int b = 0; b < 2; ++b)
#pragma unroll
                for (int m = 0; m < 4; ++m)
#pragma unroll
                    for (int n = 0; n < 2; ++n) acc[a][b][m][n] = (f32x4){0.f, 0.f, 0.f, 0.f};
        cur = nxt; cA = nA; cB = nB; ++ui;
        if constexpr (ALIGN_EPI) { if (wr == 1) PG8_BAR; }
    }
    PG8_WAIT_V(0);
    if constexpr (!ALIGN_EPI) { if (wr == 0) PG8_BAR; }
    PG8_BAR;
    if constexpr (Epi::AFTER_DRAIN) { E.fused(acc, cur, wr, wc, fr, fq, lds, wid, lane); S.done(cur); }
#undef PG8_SA
#undef PG8_SB
#undef PG8_STAGE
#undef PG8_LDA
#undef PG8_LDB
#undef PG8_MMA
#undef PG8_WAIT_V
#undef PG8_WAIT_L
#undef PG8_BAR
#undef PG8_SCHED
}
}
constexpr int DM = 2048, TP = 32768, TSMP = 256, TALL = 33024, SEQ = 8192, NPROJ = 12288, DFF = 5632, PASTL = 1024, LKS = 1056;
constexpr size_t PJ_Q = 0, PJ_K = (size_t)TALL * 2048, PJ_V = (size_t)TALL * 4096, PJ_G = (size_t)TALL * 8192;
__device__ __forceinline__ size_t hrow(int row, int h) { return row < TP ? ((size_t)((row >> 13) * 8 + h) << 13) + (row & 8191) : (size_t)262144 + (size_t)((((row - TP) >> 5) * 8 + h) << 5) + ((row - TP) & 31); }
#define GAS __attribute__((address_space(1)))
#define LAS __attribute__((address_space(3)))
typedef unsigned short bf16_t;
typedef float f32x4 __attribute__((ext_vector_type(4)));
typedef unsigned u32x4 __attribute__((ext_vector_type(4)));
typedef unsigned u32x2 __attribute__((ext_vector_type(2)));
typedef short bf16x8 __attribute__((ext_vector_type(8)));
typedef short s16x4 __attribute__((ext_vector_type(4)));

namespace pg8 {
__device__ __forceinline__ float silu_f(float g) { return g * __builtin_amdgcn_rcpf(1.0f + __builtin_amdgcn_exp2f(-1.4426950408889634f * g)); }
struct EpiBf16P {
    static constexpr bool PERM = true, AFTER_DRAIN = false;
    bf16_t* O; int ldc;
    __device__ __forceinline__ void operator()(const f32x4 (&acc)[2][2][4][2], const Unit& u, int wr, int wc, int fr, int fq) const {
        const int row0 = u.pm * BM + wr * 64 + fr, col0 = u.pn * BM + wc * 32 + 8 * fq;
#pragma unroll
        for (int ai = 0; ai < 2; ++ai)
#pragma unroll
            for (int m = 0; m < 4; ++m) { bf16_t* rowp = O + (size_t)(row0 + ai * HALF + m * 16) * ldc + col0;
#pragma unroll
                for (int bj = 0; bj < 2; ++bj) { const f32x4 v0 = acc[ai][bj][m][0], v1 = acc[ai][bj][m][1];
                    u32x4 w; w.x = cvt_pk_bf16(v0[0], v0[1]); w.y = cvt_pk_bf16(v0[2], v0[3]); w.z = cvt_pk_bf16(v1[0], v1[1]); w.w = cvt_pk_bf16(v1[2], v1[3]);
                    *(u32x4*)(rowp + bj * HALF) = w; } }
    }
};
struct EpiRetIn {
    static constexpr bool PERM = true, AFTER_DRAIN = false;
    bf16_t* O; const float* cosT; const float* sinT;
    __device__ __forceinline__ void operator()(const f32x4 (&acc)[2][2][4][2], const Unit& u, int wr, int wc, int fr, int fq) const {
        const int row0 = u.pm * BM + wr * 64 + fr, cl = wc * 32 + 8 * fq;
        if (u.pn < 16) {
            const bool isk = u.pn >= 8; const int h = u.pn & 7;
            const float lg2 = __log2f(1.0f - exp2f(-5.0f - (float)h));
#pragma unroll
            for (int ai = 0; ai < 2; ++ai) {
                f32x4 cs[4][4]; float scv[4];
#pragma unroll
                for (int m = 0; m < 4; ++m) {
                    const int row = row0 + ai * HALF + m * 16; int pos, l;
                    if (row < TP) { pos = row & (SEQ - 1); l = row & 63; } else { const int s = (row - TP) & 31; pos = PASTL + s; l = s; }
                    scv[m] = isk ? exp2f(-lg2 * (float)l) * 0.0625f : exp2f(lg2 * (float)l);
                    const float* cp = cosT + (size_t)pos * 128 + cl; const float* sp = sinT + (size_t)pos * 128 + cl;
                    cs[m][0] = *(const f32x4*)cp; cs[m][1] = *(const f32x4*)(cp + 4); cs[m][2] = *(const f32x4*)sp; cs[m][3] = *(const f32x4*)(sp + 4); }
#pragma unroll
                for (int m = 0; m < 4; ++m) {
                    const int row = row0 + ai * HALF + m * 16; const float sc = scv[m];
                    const f32x4 c0 = cs[m][0], c1 = cs[m][1], s0 = cs[m][2], s1 = cs[m][3];
                    const f32x4 x1a = acc[ai][0][m][0], x1b = acc[ai][0][m][1], x2a = acc[ai][1][m][0], x2b = acc[ai][1][m][1];
                    const f32x4 o1a = (x1a * c0 - x2a * s0) * sc, o1b = (x1b * c1 - x2b * s1) * sc, o2a = (x1a * s0 + x2a * c0) * sc, o2b = (x1b * s1 + x2b * c1) * sc;
                    bf16_t* rowp = O + (isk ? PJ_K : PJ_Q) + hrow(row, h) * 256 + cl;
                    u32x4 w; w.x = cvt_pk_bf16(o1a[0], o1a[1]); w.y = cvt_pk_bf16(o1a[2], o1a[3]); w.z = cvt_pk_bf16(o1b[0], o1b[1]); w.w = cvt_pk_bf16(o1b[2], o1b[3]);
                    *(u32x4*)rowp = w;
                    w.x = cvt_pk_bf16(o2a[0], o2a[1]); w.y = cvt_pk_bf16(o2a[2], o2a[3]); w.z = cvt_pk_bf16(o2b[0], o2b[1]); w.w = cvt_pk_bf16(o2b[2], o2b[3]);
                    *(u32x4*)(rowp + HALF) = w; }
                asm volatile("" ::: "memory"); }
        } else {
            const bool isv = u.pn < 32; const int hv = (u.pn - 16) >> 1, e0 = ((u.pn - 16) & 1) * 256 + cl;
#pragma unroll
            for (int ai = 0; ai < 2; ++ai)
#pragma unroll
                for (int m = 0; m < 4; ++m) { const int row = row0 + ai * HALF + m * 16;
                    bf16_t* rowp = isv ? O + PJ_V + hrow(row, hv) * 512 + e0 : O + PJ_G + (size_t)row * 4096 + (u.pn - 32) * BM + cl;
#pragma unroll
                    for (int bj = 0; bj < 2; ++bj) { const f32x4 v0 = acc[ai][bj][m][0], v1 = acc[ai][bj][m][1];
                        u32x4 w; w.x = cvt_pk_bf16(v0[0], v0[1]); w.y = cvt_pk_bf16(v0[2], v0[3]); w.z = cvt_pk_bf16(v1[0], v1[1]); w.w = cvt_pk_bf16(v1[2], v1[3]);
                        *(u32x4*)(rowp + bj * HALF) = w; } }
        }
    }
};
template <bool BASEBF> struct EpiRes {
    static constexpr bool PERM = true, AFTER_DRAIN = false;
    const float* baseP; const float* baseS; const bf16_t* baseH; bf16_t* hb; float* ssq;
    __device__ __forceinline__ void operator()(const f32x4 (&acc)[2][2][4][2], const Unit& u, int wr, int wc, int fr, int fq) const {
        const int row0 = u.pm * BM + wr * 64 + fr, col0 = u.pn * BM + wc * 32 + 8 * fq;
#pragma unroll
        for (int ai = 0; ai < 2; ++ai) {
            f32x4 bv[4][2][2];
#pragma unroll
            for (int m = 0; m < 4; ++m) { const int row = row0 + ai * HALF + m * 16;
                if (BASEBF) { const bf16_t* b = baseH + (size_t)row * DM + col0;
#pragma unroll
                    for (int bj = 0; bj < 2; ++bj) { const u32x4 t = *(const u32x4*)(b + bj * HALF);
                        bv[m][bj][0] = (f32x4){__uint_as_float(t.x << 16), __uint_as_float(t.x & 0xffff0000u), __uint_as_float(t.y << 16), __uint_as_float(t.y & 0xffff0000u)};
                        bv[m][bj][1] = (f32x4){__uint_as_float(t.z << 16), __uint_as_float(t.z & 0xffff0000u), __uint_as_float(t.w << 16), __uint_as_float(t.w & 0xffff0000u)}; } }
                else { const float* b = (row < TP ? baseP + (size_t)row * DM : baseS + (size_t)(row - TP) * DM) + col0;
#pragma unroll
                    for (int bj = 0; bj < 2; ++bj)
#pragma unroll
                        for (int n = 0; n < 2; ++n) bv[m][bj][n] = *(const f32x4*)(b + bj * HALF + n * 4); } }
#pragma unroll
            for (int m = 0; m < 4; ++m) { const int row = row0 + ai * HALF + m * 16; float ss = 0.f;
#pragma unroll
                for (int bj = 0; bj < 2; ++bj) { const f32x4 v0 = bv[m][bj][0] + acc[ai][bj][m][0], v1 = bv[m][bj][1] + acc[ai][bj][m][1];
                    u32x4 w; w.x = cvt_pk_bf16(v0[0], v0[1]); w.y = cvt_pk_bf16(v0[2], v0[3]); w.z = cvt_pk_bf16(v1[0], v1[1]); w.w = cvt_pk_bf16(v1[2], v1[3]);
                    *(u32x4*)(hb + (size_t)row * DM + col0 + bj * HALF) = w;
                    ss += ((v0[0] * v0[0] + v0[1] * v0[1]) + (v0[2] * v0[2] + v0[3] * v0[3])) + ((v1[0] * v1[0] + v1[1] * v1[1]) + (v1[2] * v1[2] + v1[3] * v1[3])); }
                ss += __shfl_xor(ss, 16); ss += __shfl_xor(ss, 32);
                if (fq == 0) (void)__hip_atomic_fetch_add(ssq + row, ss, __ATOMIC_RELAXED, __HIP_MEMORY_SCOPE_AGENT); }
            asm volatile("" ::: "memory"); }
    }
};
struct EpiSwiglu {
    static constexpr bool PERM = true, AFTER_DRAIN = false;
    bf16_t* O; const float* ssq;
    __device__ __forceinline__ void operator()(const f32x4 (&acc)[2][2][4][2], const Unit& u, int wr, int wc, int fr, int fq) const {
        const int row0 = u.pm * BM + wr * 64 + fr, col0 = u.pn * HALF + wc * 32 + 8 * fq;
        float rs[2][4];
#pragma unroll
        for (int ai = 0; ai < 2; ++ai)
#pragma unroll
            for (int m = 0; m < 4; ++m) rs[ai][m] = ssq[row0 + ai * HALF + m * 16];
#pragma unroll
        for (int ai = 0; ai < 2; ++ai)
#pragma unroll
            for (int m = 0; m < 4; ++m) { bf16_t* rowp = O + (size_t)(row0 + ai * HALF + m * 16) * DFF + col0; const float r = 1.0f / sqrtf(rs[ai][m] * (1.f / DM) + 1e-6f);
                const f32x4 g0 = acc[ai][0][m][0] * r, g1 = acc[ai][0][m][1] * r, u0 = acc[ai][1][m][0] * r, u1 = acc[ai][1][m][1] * r;
                f32x4 a0, a1;
#pragma unroll
                for (int j = 0; j < 4; ++j) { a0[j] = silu_f(g0[j]) * u0[j]; a1[j] = silu_f(g1[j]) * u1[j]; }
                u32x4 w; w.x = cvt_pk_bf16(a0[0], a0[1]); w.y = cvt_pk_bf16(a0[2], a0[3]); w.z = cvt_pk_bf16(a1[0], a1[1]); w.w = cvt_pk_bf16(a1[2], a1[3]);
                *(u32x4*)rowp = w; }
    }
};
struct EpiKVFQ {
    static constexpr bool PERM = true, AFTER_DRAIN = false;
    float* kP; float* vP; float* lfP; float* kS; float* vS; float* lfS; bf16_t* KB; bf16_t* VB; bf16_t* KALL; bf16_t* VALL; bf16_t* QB; const float* bf; const float* ssq;
    __device__ __forceinline__ void operator()(const f32x4 (&acc)[2][2][4][2], const Unit& u, int wr, int wc, int fr, int fq) const {
        const int row0 = u.pm * BM + wr * 64 + fr;
        float rs[2][4];
#pragma unroll
        for (int ai = 0; ai < 2; ++ai)
#pragma unroll
            for (int m = 0; m < 4; ++m) rs[ai][m] = 1.0f / sqrtf(ssq[row0 + ai * HALF + m * 16] * (1.f / DM) + 1e-6f);
        if (u.pn >= 5) {
            const int col0 = (u.pn - 5) * BM + wc * 32 + 8 * fq;
#pragma unroll
            for (int ai = 0; ai < 2; ++ai)
#pragma unroll
                for (int m = 0; m < 4; ++m) { bf16_t* bo = QB + (size_t)(row0 + ai * HALF + m * 16) * DM + col0;
#pragma unroll
                    for (int bj = 0; bj < 2; ++bj) { const f32x4 v0 = acc[ai][bj][m][0] * rs[ai][m], v1 = acc[ai][bj][m][1] * rs[ai][m];
                        u32x4 w; w.x = cvt_pk_bf16(v0[0], v0[1]); w.y = cvt_pk_bf16(v0[2], v0[3]); w.z = cvt_pk_bf16(v1[0], v1[1]); w.w = cvt_pk_bf16(v1[2], v1[3]); *(u32x4*)(bo + bj * HALF) = w; } }
        } else if (u.pn < 4) {
            const bool isv = u.pn >= 2; const int col0 = (u.pn & 1) * BM + wc * 32 + 8 * fq;
            float* fP = isv ? vP : kP; float* fS = isv ? vS : kS; bf16_t* bP = isv ? VB : KB; bf16_t* bA = isv ? VALL : KALL;
#pragma unroll
            for (int ai = 0; ai < 2; ++ai)
#pragma unroll
                for (int m = 0; m < 4; ++m) { const int row = row0 + ai * HALF + m * 16; float* fo; bf16_t* bo;
                    if (row < TP) { fo = fP + (size_t)row * 512 + col0; bo = bP + (size_t)row * 512 + col0; }
                    else { const int r2 = row - TP; fo = fS + (size_t)r2 * 512 + col0; bo = bA + ((size_t)(r2 >> 5) * LKS + PASTL + (r2 & 31)) * 512 + col0; }
#pragma unroll
                    for (int bj = 0; bj < 2; ++bj) { const f32x4 v0 = acc[ai][bj][m][0] * rs[ai][m], v1 = acc[ai][bj][m][1] * rs[ai][m];
                        __builtin_nontemporal_store(v0, (f32x4*)(fo + bj * HALF)); __builtin_nontemporal_store(v1, (f32x4*)(fo + bj * HALF + 4));
                        u32x4 w; w.x = cvt_pk_bf16(v0[0], v0[1]); w.y = cvt_pk_bf16(v0[2], v0[3]); w.z = cvt_pk_bf16(v1[0], v1[1]); w.w = cvt_pk_bf16(v1[2], v1[3]); *(u32x4*)(bo + bj * HALF) = w; } }
        } else if (wc == 0 && fq < 2) {
#pragma unroll
            for (int n = 0; n < 2; ++n) { const f32x4 bb = *(const f32x4*)(bf + 8 * fq + 4 * n);
#pragma unroll
                for (int ai = 0; ai < 2; ++ai)
#pragma unroll
                    for (int m = 0; m < 4; ++m) { const int row = row0 + ai * HALF + m * 16; const f32x4 z = acc[ai][0][m][n] * rs[ai][m] + bb; f32x4 r;
#pragma unroll
                        for (int j = 0; j < 4; ++j) r[j] = fminf(z[j], 0.f) - log1pf(__expf(-fabsf(z[j])));
                        float* o = row < TP ? lfP + (size_t)row * 16 : lfS + (size_t)(row - TP) * 16; *(f32x4*)(o + 8 * fq + 4 * n) = r; } }
        }
    }
};
}
namespace fox {
enum { ORDER_NATURAL = 0, ORDER_REVERSED = 1, ORDER_PAIRED = 2, ORDER_XCD = 4 };
constexpr int D = 128, QS = 2048, KS = 512, OS = 2048;
constexpr float THR = 8.f;
constexpr bool WSKIP = false;
constexpr float SCALE = 0.08838834764831845f;
constexpr int NW = 8, QBLK = 32, KVBLK = 64, QB = NW * QBLK;
constexpr int SHM_V = KVBLK * D * 2, SHM_K = KVBLK * D * 2;
constexpr int LDS_BYTES = 2 * SHM_V + 2 * SHM_K + NW * 64 * 4 + 2 * 64 * 4;
typedef unsigned short bf16;
typedef short bf16x8 __attribute__((ext_vector_type(8)));
typedef short s16x4 __attribute__((ext_vector_type(4)));
typedef float f32x16 __attribute__((ext_vector_type(16)));
typedef float f32x4 __attribute__((ext_vector_type(4)));
typedef unsigned u32x4 __attribute__((ext_vector_type(4)));
template <class A, class Bt> struct same_t { static constexpr bool v = false; };
template <class A> struct same_t<A, A> { static constexpr bool v = true; };

#define KSWZ(row, colB) ((row) * 256 + ((colB) ^ (((row) & 7) << 4)))
#define SBAR() __builtin_amdgcn_sched_barrier(0)
__device__ __forceinline__ int v_st(int k, int c) { const int kk = (k & ~0xC) | ((k & 4) << 1) | ((k & 8) >> 1); return ((kk >> 3) * 4 + (c >> 5)) * 512 + ((kk & 7) * 32 + (c & 31)) * 2; }
__device__ __forceinline__ int v_rd_base(int lane) { return ((lane & 3) << 3) | (((lane >> 2) & 3) << 6) | (((lane >> 4) & 1) << 5) | (((lane >> 5) & 1) << 8); }
constexpr int v_rd_off(int d0, int ks, int half) { return d0 * 512 + ks * 4096 + half * 2048; }
__device__ __forceinline__ int crow(int r, int hi) { return (r & 3) + 8 * (r >> 2) + 4 * hi; }
__device__ __forceinline__ unsigned cvtpk(float lo, float hi) {
    unsigned r; asm volatile("v_cvt_pk_bf16_f32 %0, %1, %2" : "=v"(r) : "v"(lo), "v"(hi)); return r;
}
__device__ __forceinline__ bf16x8 pack8(f32x4 a, f32x4 b) {
    u32x4 w = {cvtpk(a[0], a[1]), cvtpk(a[2], a[3]), cvtpk(b[0], b[1]), cvtpk(b[2], b[3])};
    return *reinterpret_cast<bf16x8*>(&w);
}
template <class T> __device__ __forceinline__ bf16x8 load8(const T* p) {
    if constexpr (same_t<T, float>::v) { return pack8(*(const f32x4*)p, *(const f32x4*)(p + 4)); }
    else { return *reinterpret_cast<const bf16x8*>(p); }
}
__device__ __forceinline__ void mask_tile(f32x16& p0, f32x16& p1, int dq, unsigned W) {
    const float NEG = -__builtin_inff();
#pragma unroll
    for (int r = 0; r < 16; ++r) {
        const int c = (r & 3) + 8 * (r >> 2);
        if ((unsigned)(dq - c) >= W) p0[r] = NEG;
        if ((unsigned)(dq - c - 32) >= W) p1[r] = NEG;
    }
}
__device__ __forceinline__ void partialSM(f32x16& p0, f32x16& p1, float& m_reg, float& mn, float& alpha) {
    float pmax = p0[0]; for (int r = 1; r < 16; ++r) pmax = fmaxf(pmax, p0[r]); for (int r = 0; r < 16; ++r) pmax = fmaxf(pmax, p1[r]);
    { auto rr = __builtin_amdgcn_permlane32_swap(__float_as_uint(pmax), __float_as_uint(pmax), false, false);
      pmax = fmaxf(__uint_as_float(rr[0]), __uint_as_float(rr[1])); }
    constexpr float C2 = 1.4426950408889634f * SCALE;
    if (__builtin_expect(__all((pmax - m_reg) * SCALE <= THR), 1)) { mn = m_reg; alpha = 1.f; }
    else { mn = fmaxf(m_reg, pmax); alpha = __builtin_amdgcn_exp2f((m_reg - mn) * C2); m_reg = mn; }
    const float mnL = -mn * C2;
    for (int r = 0; r < 16; ++r) p0[r] = fmaf(p0[r], C2, mnL); for (int r = 0; r < 16; ++r) p1[r] = fmaf(p1[r], C2, mnL);
    for (int r = 0; r < 16; ++r) p0[r] = __builtin_amdgcn_exp2f(p0[r]);
}
__device__ __forceinline__ void finishSM(f32x16& p0, f32x16& p1, float alpha, float& l_reg, bf16x8& pa0, bf16x8& pa1, bf16x8& pa2, bf16x8& pa3) {
    for (int r = 0; r < 16; ++r) p1[r] = __builtin_amdgcn_exp2f(p1[r]);
    float ps = 0; for (int r = 0; r < 16; ++r) ps += p0[r]; for (int r = 0; r < 16; ++r) ps += p1[r];
    { auto rr = __builtin_amdgcn_permlane32_swap(__float_as_uint(ps), __float_as_uint(ps), false, false);
      ps = __uint_as_float(rr[0]) + __uint_as_float(rr[1]); }
    l_reg = l_reg * alpha + ps;
#define PK4(P, B_, OUT) do { unsigned a0 = cvtpk(P[B_+0], P[B_+1]), a1 = cvtpk(P[B_+2], P[B_+3]);                          \
        unsigned b0 = cvtpk(P[B_+4], P[B_+5]), b1 = cvtpk(P[B_+6], P[B_+7]);                                             \
        auto r0 = __builtin_amdgcn_permlane32_swap(a0, b0, false, false); auto r1 = __builtin_amdgcn_permlane32_swap(a1, b1, false, false); \
        u32x4 w = {r0[0], r1[0], r0[1], r1[1]}; OUT = *reinterpret_cast<bf16x8*>(&w); } while (0)
    PK4(p0, 0, pa0); PK4(p0, 8, pa1); PK4(p1, 0, pa2); PK4(p1, 8, pa3);
#undef PK4
}
template <int KB, bool SK>
__device__ __forceinline__ void qkt(f32x16& p0, f32x16& p1, const char* K_lds, int r32, int hi, const bf16x8* qr, bool act) {
    if (SK && !act) { const float NEG = -__builtin_inff();
#pragma unroll
        for (int r = 0; r < 16; ++r) { p0[r] = NEG; p1[r] = NEG; } return; }
    { const float* bb_ = (const float*)(K_lds + 2 * SHM_K + NW * 64 * 4) + KB * 64 + 4 * hi;
#pragma unroll
      for (int q_ = 0; q_ < 4; ++q_) { const f32x4 b0_ = *(const f32x4*)(bb_ + 8 * q_), b1_ = *(const f32x4*)(bb_ + 32 + 8 * q_);
#pragma unroll
        for (int i_ = 0; i_ < 4; ++i_) { p0[4 * q_ + i_] = b0_[i_]; p1[4 * q_ + i_] = b1_[i_]; } } }
    const char* kb[4];
#pragma unroll
    for (int dd = 0; dd < 4; ++dd) kb[dd] = K_lds + KB * SHM_K + KSWZ(r32, (dd * 16 + hi * 8) * 2);
#pragma unroll
    for (int d0 = 0; d0 < 8; ++d0) { const char* a = kb[d0 & 3] + (d0 >> 2) * 128;
        bf16x8 b0 = *reinterpret_cast<const bf16x8*>(a);
        bf16x8 b1 = *reinterpret_cast<const bf16x8*>(a + 32 * 256);
        p0 = __builtin_amdgcn_mfma_f32_32x32x16_bf16(b0, qr[d0], p0, 0, 0, 0);
        p1 = __builtin_amdgcn_mfma_f32_32x32x16_bf16(b1, qr[d0], p1, 0, 0, 0); }
}
template <int VB, bool SK>
__device__ __forceinline__ void pv_tile(f32x16* o, int vb0, bf16x8 pa0, bf16x8 pa1, bf16x8 pa2, bf16x8 pa3, bool act) {
    if (SK && !act) return;
#define TRRD(dst, off) asm volatile("ds_read_b64_tr_b16 %0, %1 offset:%2" : "=&v"(dst) : "v"(vb0), "i"(off) : "memory")
#define PV_D0(d0) do { s16x4 l0, l1, l2, l3, h0, h1, h2, h3; constexpr int b_ = VB * SHM_V + v_rd_off(d0, 0, 0);     \
        TRRD(l0, b_); TRRD(h0, b_ + 2048); TRRD(l1, b_ + 4096); TRRD(h1, b_ + 6144); TRRD(l2, b_ + 8192); TRRD(h2, b_ + 10240); TRRD(l3, b_ + 12288); TRRD(h3, b_ + 14336); \
        asm volatile("s_waitcnt lgkmcnt(0)" ::: "memory"); SBAR();                 \
        o[d0] = __builtin_amdgcn_mfma_f32_32x32x16_bf16(pa0, (bf16x8){l0[0], l0[1], l0[2], l0[3], h0[0], h0[1], h0[2], h0[3]}, o[d0], 0, 0, 0);   \
        o[d0] = __builtin_amdgcn_mfma_f32_32x32x16_bf16(pa1, (bf16x8){l1[0], l1[1], l1[2], l1[3], h1[0], h1[1], h1[2], h1[3]}, o[d0], 0, 0, 0);   \
        o[d0] = __builtin_amdgcn_mfma_f32_32x32x16_bf16(pa2, (bf16x8){l2[0], l2[1], l2[2], l2[3], h2[0], h2[1], h2[2], h2[3]}, o[d0], 0, 0, 0);   \
        o[d0] = __builtin_amdgcn_mfma_f32_32x32x16_bf16(pa3, (bf16x8){l3[0], l3[1], l3[2], l3[3], h3[0], h3[1], h3[2], h3[3]}, o[d0], 0, 0, 0); } while (0)
    PV_D0(0); PV_D0(1); PV_D0(2); PV_D0(3);
#undef PV_D0
#undef TRRD
}
template <class TIn, class TOut> struct BlockRef { const TIn* Q; const TIn* K; const TIn* V; TOut* O; const float* FB; int P0; };
template <class TIn> struct Seam {
    bf16x8 qr[8];
    bf16x8 st_v0, st_v1, st_k0, st_k1; float st_f; f32x4 sf0, sf1, sf2, sf3;
    f32x4 tq[16];
};
__device__ __forceinline__ int swa_jlo(int P0, int W) { const int lowk = P0 - W + 1; return lowk > 0 ? lowk / KVBLK : 0; }
#define ROW(p, k0, rr) ((p) + (size_t)((k0) + (rr)) * KS + sc)
#define VMW() asm volatile("s_waitcnt vmcnt(0)" ::: "memory")
#define VMWN(n) asm volatile("s_waitcnt vmcnt(%0)" :: "i"(n) : "memory")
#define SLOAD_H(Kp, Vp, Fp, k0) do { S.st_f = (Fp)[(k0) + (tid & 63)]; S.st_v0 = load8<TIn>(ROW(Vp, k0, sr)); S.st_v1 = load8<TIn>(ROW(Vp, k0, 32 + sr));              \
                         S.st_k0 = load8<TIn>(ROW(Kp, k0, sr)); S.st_k1 = load8<TIn>(ROW(Kp, k0, 32 + sr)); } while (0)
#define SWRITE_HK(bf) do { ((float*)(K_lds + 2 * SHM_K + NW * 64 * 4))[(bf) * 64 + (tid & 63)] = S.st_f; *(bf16x8*)(K_lds + (bf) * SHM_K + kws) = S.st_k0; *(bf16x8*)(K_lds + (bf) * SHM_K + kws + 32 * 256) = S.st_k1; } while (0)
#define SWRITE_HV(bf) do { *(bf16x8*)(V_lds + (bf) * SHM_V + vst0) = S.st_v0; *(bf16x8*)(V_lds + (bf) * SHM_V + vst1) = S.st_v1; } while (0)
#define SWRITE_H(bf) do { SWRITE_HV(bf); SWRITE_HK(bf); } while (0)
#define SLOAD_F(p, k0) do { S.sf0 = *(const f32x4*)ROW(p, k0, sr); S.sf1 = *(const f32x4*)(ROW(p, k0, sr) + 4);                \
                            S.sf2 = *(const f32x4*)ROW(p, k0, 32 + sr); S.sf3 = *(const f32x4*)(ROW(p, k0, 32 + sr) + 4); } while (0)
#define SWRITE_KF(bf) do { *(bf16x8*)(K_lds + (bf) * SHM_K + kws) = pack8(S.sf0, S.sf1); *(bf16x8*)(K_lds + (bf) * SHM_K + kws + 32 * 256) = pack8(S.sf2, S.sf3); } while (0)
#define SWRITE_VF(bf) do { *(bf16x8*)(V_lds + (bf) * SHM_V + vst0) = pack8(S.sf0, S.sf1); *(bf16x8*)(V_lds + (bf) * SHM_V + vst1) = pack8(S.sf2, S.sf3); } while (0)
template <class TIn, class TOut>
__device__ __forceinline__ void causal_swa_prime(const BlockRef<TIn, TOut>& cur, int W, char* lds, Seam<TIn>& S) {
    constexpr bool F32 = same_t<TIn, float>::v;
    const int tid = opaque_tid(), wid = __builtin_amdgcn_readfirstlane(tid >> 6), lane = tid & 63, r32 = lane & 31, hi = lane >> 5;
    const int sr = tid >> 4, sc = (tid & 15) * 8, kws = KSWZ(sr, sc * 2); char* K_lds = lds + 2 * SHM_V;
    const int kb0 = swa_jlo(cur.P0, W) * KVBLK;
    for (int d0 = 0; d0 < 8; ++d0) S.qr[d0] = load8<TIn>(cur.Q + (size_t)(wid * QBLK + r32) * QS + d0 * 16 + hi * 8);
    if constexpr (F32) { SLOAD_F((const float*)cur.K, kb0); VMW(); SWRITE_KF(0); SBAR(); SLOAD_F((const float*)cur.V, kb0); }
    else { SLOAD_H(cur.K, cur.V, cur.FB, kb0); VMW(); SWRITE_HK(0); }
    __syncthreads();
}
template <class TIn, class TOut>
__device__ __forceinline__ void causal_swa_block(const BlockRef<TIn, TOut>& cur, const BlockRef<TIn, TOut>& nxt, int skv, int W, char* lds, Seam<TIn>& S) {
    constexpr bool F32 = same_t<TIn, float>::v;
    const int tid = opaque_tid(), wid = __builtin_amdgcn_readfirstlane(tid >> 6), lane = tid & 63, r32 = lane & 31, hi = lane >> 5;
    const int j_lo = swa_jlo(cur.P0, W);
    int j_hi = (cur.P0 + QB - 1) / KVBLK + 1; if (j_hi > skv / KVBLK) j_hi = skv / KVBLK;
    const int NT = j_hi - j_lo;
    const int kbn = swa_jlo(nxt.P0, W) * KVBLK;
    const int qlo = cur.P0 + wid * QBLK, qm = qlo + r32 - 4 * hi;
    char* V_lds = lds; char* K_lds = lds + 2 * SHM_V;
    float* ws = (float*)(lds + 2 * SHM_V + 2 * SHM_K) + wid * 64; float* li_l = ws, * al_l = ws + 32;
    float m_reg = -1e30f, l_reg = 0; f32x16 o[4] = {};
    const int sr = tid >> 4, sc = (tid & 15) * 8, vst0 = v_st(sr, sc), vst1 = v_st(32 + sr, sc), kws = KSWZ(sr, sc * 2);
    const int vb0 = (int)(uintptr_t)V_lds + v_rd_base(lane);
    const TIn* Kh = cur.K; const TIn* Vh = cur.V;
#define RESC(a) do { if (__any((a) < 1.f)) { if (hi == 0) al_l[r32] = (a); asm volatile("s_waitcnt lgkmcnt(0)" ::: "memory");              \
                     for (int d_ = 0; d_ < 4; ++d_) for (int r = 0; r < 16; ++r) o[d_][r] *= al_l[crow(r, hi)]; } } while (0)
#define KBASE(t) ((j_lo + (t)) * KVBLK)
#define ACT(t) (KBASE(t) <= qlo + QBLK - 1 && KBASE(t) + KVBLK - 1 >= qlo - W + 1)
#define MASKT(P0_, P1_, t) do { const int kb_ = KBASE(t); if ((!SK || ACT(t)) && (kb_ + KVBLK - 1 > qlo || kb_ <= qlo + QBLK - 1 - W)) mask_tile(P0_, P1_, qm - kb_, (unsigned)W); } while (0)
    constexpr int NQL = F32 ? 16 : 8;
    constexpr bool SK = WSKIP && !F32;
#define SEAM_K0() do { VMWN(NQL); if constexpr (F32) { SWRITE_KF(0); SBAR(); SLOAD_F((const float*)nxt.V, kbn); } else { SWRITE_HK(0); } SBAR(); } while (0)
    f32x16 pA0, pA1, pB0, pB1; float mnA, mnB, alA, alB; bf16x8 pa0, pa1, pa2, pa3;
    if constexpr (F32) { VMW(); SWRITE_VF(0); SBAR(); } else { SWRITE_HV(0); SBAR(); }
    if (NT > 1) { if constexpr (F32) SLOAD_F((const float*)Kh, KBASE(1)); else SLOAD_H(Kh, Vh, cur.FB, KBASE(1)); }
    SBAR(); qkt<0, SK>(pA0, pA1, K_lds, r32, hi, S.qr, ACT(0));
    if constexpr (F32) { if (NT > 1) { VMW(); SWRITE_KF(1); SBAR(); SLOAD_F((const float*)Vh, KBASE(1)); } }
    MASKT(pA0, pA1, 0); partialSM(pA0, pA1, m_reg, mnA, alA);
    if (NT > 1) { VMW(); if constexpr (F32) { SWRITE_VF(1); SBAR(); if (NT > 2) SLOAD_F((const float*)Kh, KBASE(2)); } else SWRITE_H(1); }
    __syncthreads();
#define HALF_STEP(PX0, PX1, mnX, alX, PY0, PY1, alY, t, KB, VB, SB) do {                                                      \
        SBAR(); qkt<KB, SK>(PX0, PX1, K_lds, r32, hi, S.qr, ACT(t));                                             \
        finishSM(PY0, PY1, alY, l_reg, pa0, pa1, pa2, pa3); SBAR();                                                           \
        if ((t) + 1 < NT) { if constexpr (F32) { VMW(); SWRITE_KF(SB); SBAR(); SLOAD_F((const float*)Vh, KBASE((t) + 1)); }  \
                            else { SLOAD_H(Kh, Vh, cur.FB, KBASE((t) + 1)); } SBAR(); }                                               \
        pv_tile<VB, SK>(o, vb0, pa0, pa1, pa2, pa3, ACT((t) - 1)); MASKT(PX0, PX1, (t)); partialSM(PX0, PX1, m_reg, mnX, alX);                                        \
        __syncthreads();                                                                                                      \
        if ((t) + 1 < NT) { VMW(); if constexpr (F32) { SWRITE_VF(SB); SBAR(); if ((t) + 2 < NT) SLOAD_F((const float*)Kh, KBASE((t) + 2)); } \
                            else { SWRITE_H(SB); } }                                                                          \
        RESC(alX); __syncthreads(); } while (0)
    for (int t = 1; t + 1 < NT; t += 2) {
        HALF_STEP(pB0, pB1, mnB, alB, pA0, pA1, alA, t, 1, 0, 0);
        HALF_STEP(pA0, pA1, mnA, alA, pB0, pB1, alB, t + 1, 0, 1, 1);
    }
    const bool even = (NT & 1) == 0;
    if (even) { SBAR(); qkt<1, SK>(pB0, pB1, K_lds, r32, hi, S.qr, ACT(NT - 1)); SBAR(); }
#define QROW(e) (nxt.Q + (size_t)(wid * QBLK + r32) * D + ((e) >> 1) * 16 + hi * 8 + ((e) & 1) * 4)
    if constexpr (F32) { SLOAD_F((const float*)nxt.K, kbn); SBAR();
#pragma unroll
        for (int e = 0; e < 8; ++e) S.tq[e] = *(const f32x4*)QROW(e); }
    else { SLOAD_H(nxt.K, nxt.V, nxt.FB, kbn); SBAR();
#pragma unroll
        for (int d0 = 0; d0 < 8; ++d0) S.qr[d0] = load8<TIn>(nxt.Q + (size_t)(wid * QBLK + r32) * QS + d0 * 16 + hi * 8); }
    SBAR();
    finishSM(pA0, pA1, alA, l_reg, pa0, pa1, pa2, pa3); SBAR();
    if constexpr (F32) {
#pragma unroll
        for (int e = 8; e < 16; ++e) S.tq[e] = *(const f32x4*)QROW(e); SBAR(); }
#undef QROW
    pv_tile<0, SK>(o, vb0, pa0, pa1, pa2, pa3, ACT(even ? NT - 2 : NT - 1));
    if (even) { MASKT(pB0, pB1, NT - 1); partialSM(pB0, pB1, m_reg, mnB, alB); __syncthreads(); RESC(alB);
        finishSM(pB0, pB1, alB, l_reg, pa0, pa1, pa2, pa3); SBAR(); pv_tile<1, SK>(o, vb0, pa0, pa1, pa2, pa3, ACT(NT - 1)); }
    SBAR(); SEAM_K0();
    if (hi == 0) li_l[r32] = l_reg; asm volatile("s_waitcnt lgkmcnt(0)" ::: "memory");
    float rli[16];
#pragma unroll
    for (int r = 0; r < 16; ++r) rli[r] = __builtin_amdgcn_rcpf(li_l[crow(r, hi)]);
    TOut* Ow = cur.O + (size_t)(wid * QBLK) * OS;
#pragma unroll
    for (int r = 0; r < 16; ++r) { const int orow = crow(r, hi);
#pragma unroll
        for (int d0 = 0; d0 < 4; ++d0) { const float v = o[d0][r] * rli[r];
            if constexpr (same_t<TOut, float>::v) { Ow[(size_t)orow * OS + d0 * 32 + r32] = v; }
            else { const float vn = __shfl_xor(v, 1);
                   if ((r32 & 1) == 0) *(unsigned*)(Ow + (size_t)orow * OS + d0 * 32 + r32) = cvtpk(v, vn); } } }
    if constexpr (F32) {
#pragma unroll
        for (int d0 = 0; d0 < 8; ++d0) S.qr[d0] = pack8(S.tq[2 * d0], S.tq[2 * d0 + 1]); }
    __syncthreads();
#undef RESC
#undef KBASE
#undef ACT
#undef MASKT
#undef SEAM_K0
#undef HALF_STEP
}
#undef ROW
#undef VMW
#undef VMWN
#undef SLOAD_H
#undef SWRITE_HK
#undef SWRITE_HV
#undef SWRITE_H
#undef SLOAD_F
#undef SWRITE_KF
#undef SWRITE_VF

__host__ __device__ inline int swa_nramp(int nqb, int W, int qoff) { const int t = W - 1 - qoff; const int n = t < 0 ? 0 : t / QB + 1; return n > nqb ? nqb : n; }
__host__ __device__ inline int swa_nx(int nqb, int nramp, int order) { return (order & ORDER_PAIRED) ? (nramp + 1) / 2 + (nqb - nramp) : nqb; }
struct SwaItem { int bh, qb0, qb1; };
__device__ __forceinline__ SwaItem swa_decode(int L, int nb, int nh, int nhkv, int nqb, int nx, int nramp, int order) {
    const int G = nh / nhkv; SwaItem it; int x;
    if ((order & ORDER_XCD) && (nb * nhkv) % 8 == 0) { const int xcd = L & 7, k = L >> 3, per = G * nx, gi = k / per, r = k - gi * per;
        it.bh = (gi * 8 + xcd) * G + r / nx; x = r % nx; }
    else { it.bh = L / nx; x = L - it.bh * nx; }
    if (order & ORDER_PAIRED) { const int ns = nqb - nramp;
        if (x < ns) { it.qb0 = it.qb1 = nqb - 1 - x; } else { it.qb0 = x - ns; it.qb1 = nramp - 1 - it.qb0; } }
    else { it.qb0 = it.qb1 = ((order & 3) == ORDER_REVERSED) ? nqb - 1 - x : x; }
    return it;
}
typedef unsigned short bf16;
__device__ __forceinline__ BlockRef<bf16, bf16> mk_ref(const SwaItem& it, int pass, const bf16* Q, const bf16* K, const bf16* V, bf16* O, const float* FB) {
    const int qb = pass ? it.qb1 : it.qb0, b = it.bh >> 4, h = it.bh & 15, kvh = h >> 2;
    BlockRef<bf16, bf16> r;
    r.Q = Q + ((size_t)b * 8192 + (size_t)qb * QB) * QS + h * 128; r.O = O + ((size_t)b * 8192 + (size_t)qb * QB) * OS + h * 128;
    r.K = K + (size_t)b * 8192 * KS + kvh * 128; r.V = V + (size_t)b * 8192 * KS + kvh * 128; r.FB = FB + (size_t)it.bh * 8192; r.P0 = qb * QB;
    return r;
}
__device__ __forceinline__ void attn_phase(char* lds, const bf16* Q, const bf16* K, const bf16* V, bf16* O, const float* FB) {
    constexpr int nb = 4, nh = 16, nhkv = 4, nqb = 32, W = 8192, order = ORDER_PAIRED | ORDER_XCD;
    const int nramp = swa_nramp(nqb, W, 0), nx = swa_nx(nqb, nramp, order), total = nx * nb * nh, stride = gridDim.x;
    int L = blockIdx.x; if (L >= total) return;
    SwaItem it = swa_decode(L, nb, nh, nhkv, nqb, nx, nramp, order); int pass = 0;
    BlockRef<bf16, bf16> cur = mk_ref(it, 0, Q, K, V, O, FB);
    Seam<bf16> S;
    causal_swa_prime<bf16, bf16>(cur, W, lds, S);
    for (;;) {
        const bool more_pass = pass == 0 && it.qb1 != it.qb0, more_item = L + stride < total, last = !more_pass && !more_item;
        SwaItem itn = it; int passn = pass + 1, Ln = L;
        if (!more_pass) { passn = 0; Ln = more_item ? L + stride : L; itn = swa_decode(Ln, nb, nh, nhkv, nqb, nx, nramp, order); }
        const BlockRef<bf16, bf16> nxt = last ? cur : mk_ref(itn, passn, Q, K, V, O, FB);
        causal_swa_block<bf16, bf16>(cur, nxt, 8192, W, lds, S);
        if (last) break;
        cur = nxt; it = itn; pass = passn; L = Ln;
    }
}
}
constexpr size_t WS_WIN = 0, WS_WRO = 50331648, WS_WGU0 = 67108864, WS_WGU1 = 113246208, WS_WDN0 = 159383552, WS_WDN1 = 182452224,
                 WS_WO = 205520896, WS_WKVF = 213909504  , WS_COS = 227540992, WS_SIN = 231735296, WS_FB = 235929600, WS_FS = WS_FB + 2097152,
                 WS_BIG = 239075328;
constexpr size_t SZ_ROWS2K = (size_t)TALL * DM * 2;
constexpr size_t BIG_XN = 0, BIG_ACT = SZ_ROWS2K, BIG_HKV = BIG_ACT + (size_t)TALL * DFF * 2, BIG_KB = BIG_HKV + SZ_ROWS2K, BIG_VB = BIG_KB + (size_t)TP * 512 * 2,
                 BIG_KALL = BIG_VB + (size_t)TP * 512 * 2, BIG_VALL = BIG_KALL + (size_t)8 * LKS * 512 * 2, BIG_END = BIG_VALL + (size_t)8 * LKS * 512 * 2;
static_assert(BIG_END <= (size_t)TALL * NPROJ * 2, "layer-1 buffers fit in the PROJ region");
constexpr size_t WS_SSQ = WS_BIG + (size_t)TALL * NPROJ * 2  , WS_BAR = WS_SSQ + (size_t)4 * TALL * 4  , WS_END = WS_BAR + 16384;
static_assert(WS_FS + 540672 <= WS_BIG && WS_BAR % 256 == 0, "small arrays end before the big region");
static_assert(WS_END <= (size_t)1073741824, "workspace fits 1 GiB");
constexpr size_t OUT_Y = 0, OUT_SP = 67633152, OUT_KP = 71827456, OUT_VP = 88604672, OUT_LFP = 105381888, OUT_SS = 105906176, OUT_KS = 114294784, OUT_VS = 114425856, OUT_LFS = 114556928;
constexpr int NWAVES = 8, LDS_BYTES = 149504;

struct Params { const float* in[21]; float* out; unsigned char* ws; };

__device__ __forceinline__ float wave_sum(float v) {
#pragma unroll
    for (int o = 1; o < 64; o <<= 1) v += __shfl_xor(v, o);
    return v;
}
__device__ __forceinline__ float bf2f(unsigned short b) { return __uint_as_float(((unsigned)b) << 16); }
__device__ __forceinline__ unsigned pk2(float lo, float hi) { return pg8::cvt_pk_bf16(lo, hi); }

__device__ __forceinline__ void transpose_item(const float* W, int K, int N, bf16_t* WT, int k0, int n0, int drow0, LAS float* scr, int lane, const float* gain = nullptr) {
    float wv[32];
#pragma unroll
    for (int i = 0; i < 32; ++i) { const int kk = 2 * i + (lane >> 5); wv[i] = __builtin_nontemporal_load(W + (size_t)(k0 + kk) * N + n0 + (lane & 31)) * (gain ? gain[k0 + kk] : 1.f); }
#pragma unroll
    for (int i = 0; i < 32; ++i) { const int kk = 2 * i + (lane >> 5); scr[kk * 33 + (lane & 31)] = wv[i]; }
    asm volatile("s_waitcnt lgkmcnt(0)" ::: "memory");
    const int c = lane & 7;
#pragma unroll
    for (int j = 0; j < 4; ++j) { const int n = (lane >> 3) + 8 * j; const LAS float* s = scr + (8 * c) * 33 + n;
        u32x4 o; o.x = pk2(s[0 * 33], s[1 * 33]); o.y = pk2(s[2 * 33], s[3 * 33]); o.z = pk2(s[4 * 33], s[5 * 33]); o.w = pk2(s[6 * 33], s[7 * 33]);
        *(u32x4*)(WT + (size_t)(drow0 + n) * K + k0 + 8 * c) = o; }
    asm volatile("s_waitcnt lgkmcnt(0)" ::: "memory");
}
__device__ __forceinline__ void tr_plain(const float* W, int K, int N, bf16_t* WT, int row_off, LAS float* scr, int item, int lane, const float* gain = nullptr) {
    const int nblk = N / 32, kb = item / nblk, nb = item % nblk; transpose_item(W, K, N, WT, 64 * kb, 32 * nb, row_off + 32 * nb, scr, lane, gain);
}
__device__ __forceinline__ void tr_gu(const float* W, bf16_t* WT, int up, LAS float* scr, int item, int lane, const float* gain) {
    const int nblk = DFF / 32, kb = item / nblk, nb = item % nblk, n0 = 32 * nb; transpose_item(W, DM, DFF, WT, 64 * kb, n0, (n0 >> 7) * 256 + up * 128 + (n0 & 127), scr, lane, gain);
}
template <int MODE  >
__device__ __forceinline__ void rms_row(const float* xrow, const float* g1, bf16_t* o1, const float* g2, bf16_t* o2, float* of, int lane) {
    const f32x4* xr = (const f32x4*)xrow + lane;
    f32x4 v[8]; float s = 0.f;
#pragma unroll
    for (int j = 0; j < 8; ++j) { v[j] = xr[64 * j]; s += (v[j].x * v[j].x + v[j].y * v[j].y) + (v[j].z * v[j].z + v[j].w * v[j].w); }
    const float rs = 1.0f / sqrtf(wave_sum(s) * (1.f / DM) + 1e-6f);
#pragma unroll
    for (int j = 0; j < 8; ++j) { const f32x4 ga = ((const f32x4*)g1)[64 * j + lane]; const f32x4 y = v[j] * rs;
        if (MODE == 2) { ((f32x4*)of)[64 * j + lane] = y * ga; }
        else { u32x2 w; w.x = pk2(y.x * ga.x, y.y * ga.y); w.y = pk2(y.z * ga.z, y.w * ga.w); ((u32x2*)o1)[64 * j + lane] = w;
            if (MODE == 1) { const f32x4 gb = ((const f32x4*)g2)[64 * j + lane]; u32x2 w2; w2.x = pk2(y.x * gb.x, y.y * gb.y); w2.y = pk2(y.z * gb.z, y.w * gb.w); ((u32x2*)o2)[64 * j + lane] = w2; } } }
}

namespace ret {
constexpr int KOFF = 0, STOFF = 32768, VOFF = 65536, POFF = 74752, VS = 144;
typedef short v4i16_t __attribute__((ext_vector_type(4)));
__device__ __forceinline__ bf16x8 frag_rm(const LAS char* base, int stride, int i0, int k0, int fr, int fq) { return *(const LAS bf16x8*)(base + (i0 + fr) * stride + (k0 + 8 * fq) * 2); }
__device__ __forceinline__ bf16x8 frag_sw(const LAS char* base, int i0, int k0, int fr, int fq) { return *(const LAS bf16x8*)(base + (i0 + fr) * 512 + ((((k0 >> 3) + fq) ^ fr) << 4)); }
__device__ __forceinline__ s16x4 tr4(const LAS char* p) { return __builtin_bit_cast(s16x4, __builtin_amdgcn_ds_read_tr16_b64_v4i16((LAS v4i16_t*)p)); }
__device__ __forceinline__ bf16x8 frag_tr(const LAS char* base, int stride, int k0, int i0, int fr, int fq) {
    const LAS char* p = base + (k0 + 8 * fq + (fr >> 2)) * stride + (i0 + 4 * (fr & 3)) * 2;
    const s16x4 a = tr4(p), b = tr4(p + 4 * stride);
    return (bf16x8){a[0], a[1], a[2], a[3], b[0], b[1], b[2], b[3]};
}
__device__ __forceinline__ bf16x8 frag_tr_sw(const LAS char* base, int k0, int i0, int fr, int fq) {
    const int m = k0 + 8 * fq + (fr >> 2), d = i0 + 4 * (fr & 3);
    const s16x4 a = tr4(base + m * 512 + ((((d >> 3) ^ (m & 15))) << 4) + (d & 7) * 2), b = tr4(base + (m + 4) * 512 + ((((d >> 3) ^ ((m + 4) & 15))) << 4) + (d & 7) * 2);
    return (bf16x8){a[0], a[1], a[2], a[3], b[0], b[1], b[2], b[3]};
}
#define RET_BAR() do { asm volatile("s_waitcnt lgkmcnt(0)" ::: "memory"); __builtin_amdgcn_s_barrier(); asm volatile("" ::: "memory"); } while (0)
#define MFMA16(X, Y, C) __builtin_amdgcn_mfma_f32_16x16x32_bf16(X, Y, C, 0, 0, 0)
__device__ __forceinline__ void ret_item(LAS char* lds, const bf16_t* proj, size_t hr0  , bf16_t* oh  , int nchunks, int c, int h, int es, const float* S0, float* Sout) {
    const int tid = opaque_tid(), wid = __builtin_amdgcn_readfirstlane(tid >> 6), lane = tid & 63, fr = lane & 15, fq = lane >> 4, lt = wid >> 1, half = wid & 1;
    const float lg2 = __log2f(1.0f - exp2f(-5.0f - (float)h)), gam = exp2f(lg2), gc1 = exp2f(lg2 * (float)(c - 1));
    f32x4 accT[8];
    const int eT = 16 * lt + fr;
#pragma unroll
    for (int i = 0; i < 8; ++i) { const int d0 = 16 * (8 * half + i) + 4 * fq;
#pragma unroll
        for (int r = 0; r < 4; ++r) accT[i][r] = S0 ? S0[(size_t)(d0 + r) * 512 + es * 64 + eT] : 0.f;
        u32x2 w; w.x = pk2(accT[i][0], accT[i][1]); w.y = pk2(accT[i][2], accT[i][3]); *(LAS u32x2*)(lds + STOFF + eT * 512 + (((d0 >> 3) ^ fr) << 4) + (d0 & 7) * 2) = w; }
    u32x4 rk[4], rv; bf16x8 yq[8];
    const bf16_t* gq = proj + PJ_Q + (hr0 + eT) * 256 + 8 * fq; const bf16_t* gk = proj + PJ_K + hr0 * 256; const bf16_t* gv = proj + PJ_V + hr0 * 512 + es * 64; bf16_t* pout = oh + hr0 * 512 + es * 64;
    const bool qok = eT < c;
#define RET_LOADQ(n) do { _Pragma("unroll") for (int ks = 0; ks < 8; ++ks) yq[ks] = qok ? *(const bf16x8*)(gq + (size_t)(n) * 64 * 256 + 32 * ks) : (bf16x8){0, 0, 0, 0, 0, 0, 0, 0}; } while (0)
#define RET_LOAD(n) do { _Pragma("unroll") for (int i = 0; i < 4; ++i) { const int p = tid + 512 * i, row = p >> 5, ch = p & 31; \
            if (row < c) rk[i] = *(const u32x4*)(gk + (size_t)((n) * 64 + row) * 256 + ch * 8); else rk[i] = (u32x4){0u, 0u, 0u, 0u}; } \
        { const int row = tid >> 3, ch = tid & 7; if (row < c) rv = *(const u32x4*)(gv + (size_t)((n) * 64 + row) * 512 + ch * 8); else rv = (u32x4){0u, 0u, 0u, 0u}; } } while (0)
    RET_LOAD(0); RET_LOADQ(0);
    for (int n = 0; n < nchunks; ++n) {
#pragma unroll
        for (int i = 0; i < 4; ++i) { const int p = tid + 512 * i, row = p >> 5, ch = p & 31; *(LAS u32x4*)(lds + KOFF + row * 512 + ((ch ^ (row & 15)) << 4)) = rk[i]; }
        *(LAS u32x4*)(lds + VOFF + (tid >> 3) * VS + (tid & 7) * 16) = rv;
        if (n + 1 < nchunks) RET_LOAD(n + 1);
        RET_BAR();
        f32x4 accS[2], accC[2];
#pragma unroll
        for (int j = 0; j < 2; ++j) { accS[j] = (f32x4){0.f, 0.f, 0.f, 0.f}; accC[j] = (f32x4){0.f, 0.f, 0.f, 0.f}; }
#pragma unroll
        for (int kb = 0; kb < 8; kb += 2) {
            bf16x8 xk[2][2], xs[2][2];
#pragma unroll
            for (int ks = 0; ks < 2; ++ks)
#pragma unroll
                for (int j = 0; j < 2; ++j) { xk[ks][j] = frag_sw(lds + KOFF, 16 * (2 * half + j), 32 * (kb + ks), fr, fq); xs[ks][j] = frag_sw(lds + STOFF, 16 * (2 * half + j), 32 * (kb + ks), fr, fq); }
            __builtin_amdgcn_sched_barrier(0);
#pragma unroll
            for (int ks = 0; ks < 2; ++ks)
#pragma unroll
                for (int j = 0; j < 2; ++j) { accS[j] = MFMA16(xk[ks][j], yq[kb + ks], accS[j]); accC[j] = MFMA16(xs[ks][j], yq[kb + ks], accC[j]); }
            __builtin_amdgcn_sched_barrier(0);
        }
        if (n + 1 < nchunks) RET_LOADQ(n + 1);
        const int lrow = eT;
#pragma unroll
        for (int j = 0; j < 2; ++j) { const int m0 = 16 * (2 * half + j) + 4 * fq; f32x4 sv = accS[j];
#pragma unroll
            for (int r = 0; r < 4; ++r) sv[r] = (m0 + r <= lrow) ? sv[r] : 0.f;
            u32x2 w; w.x = pk2(sv[0], sv[1]); w.y = pk2(sv[2], sv[3]); *(LAS u32x2*)(lds + POFF + lrow * VS + m0 * 2) = w; }
        RET_BAR();
        f32x4 accO[2];
#pragma unroll
        for (int j = 0; j < 2; ++j) accO[j] = accC[j] * gam;
#pragma unroll
        for (int ks = 0; ks < 2; ++ks) { const int k0 = 32 * ks;
            const bf16x8 yp = frag_rm(lds + POFF, VS, 16 * lt, k0, fr, fq);
#pragma unroll
            for (int j = 0; j < 2; ++j) { const bf16x8 xv = frag_tr(lds + VOFF, VS, k0, 16 * (2 * half + j), fr, fq); accO[j] = MFMA16(xv, yp, accO[j]); } }
        if (lrow < c) {
#pragma unroll
            for (int j = 0; j < 2; ++j) { u32x2 w; w.x = pk2(accO[j][0], accO[j][1]); w.y = pk2(accO[j][2], accO[j][3]);
                *(u32x2*)(pout + (size_t)(n * 64 + lrow) * 512 + 16 * (2 * half + j) + 4 * fq) = w; } }
#pragma unroll
        for (int i = 0; i < 8; ++i) accT[i] = accT[i] * gam;
#pragma unroll
        for (int ks = 0; ks < 2; ++ks) {
            bf16x8 xk[8]; const bf16x8 yv = frag_tr(lds + VOFF, VS, 32 * ks, 16 * lt, fr, fq);
#pragma unroll
            for (int i = 0; i < 8; ++i) xk[i] = frag_tr_sw(lds + KOFF, 32 * ks, 16 * (8 * half + i), fr, fq);
            __builtin_amdgcn_sched_barrier(0);
#pragma unroll
            for (int i = 0; i < 8; ++i) accT[i] = MFMA16(xk[i], yv, accT[i]);
            __builtin_amdgcn_sched_barrier(0);
        }
#pragma unroll
        for (int i = 0; i < 8; ++i) { accT[i] = accT[i] * gc1; const int d0 = 16 * (8 * half + i) + 4 * fq;
            u32x2 w; w.x = pk2(accT[i][0], accT[i][1]); w.y = pk2(accT[i][2], accT[i][3]); *(LAS u32x2*)(lds + STOFF + eT * 512 + (((d0 >> 3) ^ fr) << 4) + (d0 & 7) * 2) = w; }
        RET_BAR();
    }
#undef RET_LOAD
#undef RET_LOADQ
#pragma unroll
    for (int i = 0; i < 8; ++i) { const int d0 = 16 * (8 * half + i) + 4 * fq;
#pragma unroll
        for (int r = 0; r < 4; ++r) Sout[(size_t)(d0 + r) * 512 + es * 64 + eT] = accT[i][r]; }
}
}
__device__ __forceinline__ void sample_attn(LAS char* lds, const bf16_t* QBp, const bf16_t* KALL, const bf16_t* VALL, const float* FS, bf16_t* AO) {
    const int tid = opaque_tid(), wid = __builtin_amdgcn_readfirstlane(tid >> 6), lane = tid & 63;
    LAS float* qf = (LAS float*)(lds + wid * 5120); LAS float* pf = qf + 128;
    const int gw = blockIdx.x * NWAVES + wid, NGW = gridDim.x * NWAVES;
    for (int item = gw; item < 8 * 16 * 32; item += NGW) {
        const int b = item >> 9, h = (item >> 5) & 15, qi = item & 31, kvh = h >> 2, qpos = PASTL + qi, row = TP + b * 32 + qi;
        const bf16_t* q = QBp + (size_t)row * DM + h * 128;
        qf[lane] = bf2f(q[lane]); qf[lane + 64] = bf2f(q[lane + 64]);
        asm volatile("s_waitcnt lgkmcnt(0)" ::: "memory");
        const float* F = FS + (size_t)(b * 16 + h) * LKS; const float Fq = F[qpos];
        const bf16_t* Kb = KALL + (size_t)b * LKS * 512 + kvh * 128; const bf16_t* Vb = VALL + (size_t)b * LKS * 512 + kvh * 128;
        float mx = -1e30f;
#pragma unroll 1
        for (int t = 0; t < 17; ++t) { const int j = lane + 64 * t; float s = -__builtin_inff();
            if (j <= qpos) { const u32x4* kr = (const u32x4*)(Kb + (size_t)j * 512); float a = 0.f; u32x4 kvv[16];
#pragma unroll
                for (int c8 = 0; c8 < 16; ++c8) kvv[c8] = kr[c8];
#pragma unroll
                for (int c8 = 0; c8 < 16; ++c8) { const u32x4 kv = kvv[c8]; const LAS f32x4* qq = (const LAS f32x4*)(qf + 8 * c8); const f32x4 q0 = qq[0], q1 = qq[1];
                    a += __uint_as_float(kv.x << 16) * q0.x + __uint_as_float(kv.x & 0xffff0000u) * q0.y + __uint_as_float(kv.y << 16) * q0.z + __uint_as_float(kv.y & 0xffff0000u) * q0.w
                       + __uint_as_float(kv.z << 16) * q1.x + __uint_as_float(kv.z & 0xffff0000u) * q1.y + __uint_as_float(kv.w << 16) * q1.z + __uint_as_float(kv.w & 0xffff0000u) * q1.w; }
                s = a * 0.08838834764831845f + (Fq - F[j]); }
            pf[j] = s; mx = fmaxf(mx, s); }
#pragma unroll
        for (int o = 1; o < 64; o <<= 1) mx = fmaxf(mx, __shfl_xor(mx, o));
        float sum = 0.f;
#pragma unroll 1
        for (int t = 0; t < 17; ++t) { const float p = __expf(pf[lane + 64 * t] - mx); sum += p; pf[lane + 64 * t] = p; }
        sum = wave_sum(sum);
        asm volatile("s_waitcnt lgkmcnt(0)" ::: "memory");
        float oa[8];
#pragma unroll
        for (int e = 0; e < 8; ++e) oa[e] = 0.f;
        const int kg = lane >> 4, dg = lane & 15;
        for (int j = 0; j < PASTL + 32; j += 32) {
            u32x4 vv[8]; float p[8];
#pragma unroll
            for (int u = 0; u < 8; ++u) { vv[u] = *(const u32x4*)(Vb + (size_t)(j + 4 * u + kg) * 512 + 8 * dg); p[u] = pf[j + 4 * u + kg]; }
#pragma unroll
            for (int u = 0; u < 8; ++u) { const unsigned w4[4] = {vv[u].x, vv[u].y, vv[u].z, vv[u].w};
#pragma unroll
                for (int e = 0; e < 4; ++e) { oa[2 * e] += p[u] * __uint_as_float(w4[e] << 16); oa[2 * e + 1] += p[u] * __uint_as_float(w4[e] & 0xffff0000u); } } }
#pragma unroll
        for (int e = 0; e < 8; ++e) { oa[e] += __shfl_xor(oa[e], 16); oa[e] += __shfl_xor(oa[e], 32); }
        const float inv = 1.0f / sum;
        if (kg == 0) { u32x4 w; w.x = pk2(oa[0] * inv, oa[1] * inv); w.y = pk2(oa[2] * inv, oa[3] * inv); w.z = pk2(oa[4] * inv, oa[5] * inv); w.w = pk2(oa[6] * inv, oa[7] * inv);
            *(u32x4*)(AO + (size_t)row * DM + h * 128 + 8 * dg) = w; }
        asm volatile("s_waitcnt lgkmcnt(0)" ::: "memory");
    }
}

#define XB_TMO      128
#define XB_XCNT(j)  (256  + 64 * (j))
#define XB_XSUB(j)  (1280 + 64 * (j))
#define XB_XGEN(j)  (2304 + 64 * (j))
#define XB_TOP      3328
#define XB_TOPGEN   3392
#define XCD_BAR_WORDS 3456
#define XB_SPIN_CAP (1u << 18)

__device__ __forceinline__ unsigned xb_ld(unsigned* p)              { return __hip_atomic_load(p, __ATOMIC_RELAXED, __HIP_MEMORY_SCOPE_AGENT); }
__device__ __forceinline__ unsigned xb_add(unsigned* p, unsigned v) { return __hip_atomic_fetch_add(p, v, __ATOMIC_RELAXED, __HIP_MEMORY_SCOPE_AGENT); }
__device__ __forceinline__ unsigned xb_xcc_id() { return (unsigned)__builtin_amdgcn_s_getreg((3 << 11) | 20) & 0xFu; }
#define XB_SPIN(cond, bar) do { unsigned _sp = 0; while (cond) { __builtin_amdgcn_s_sleep(1); \
    if ((++_sp & 255u) == 0u) { if (xb_ld(&(bar)[XB_TMO])) break; if (_sp > XB_SPIN_CAP) { atomicAdd(&(bar)[XB_TMO], 1u); break; } } } } while (0)

struct XcdBarrier {
    unsigned* bar; unsigned x;
    volatile LAS unsigned* st;
};

__device__ __forceinline__ XcdBarrier xcd_barrier_post(unsigned* bar, volatile LAS unsigned* st) {
    XcdBarrier b; b.bar = bar; b.x = xb_xcc_id(); b.st = st;
    if (threadIdx.x == 0) (void)xb_add(&bar[XB_XCNT(b.x)], 1u);
    return b;
}
__device__ __forceinline__ void xcd_barrier_complete(unsigned* bar, unsigned x, unsigned& nloc, unsigned& nx) {
    const unsigned G = gridDim.x * gridDim.y * gridDim.z;
    unsigned sum, cnt, mine, sp = 0u;
    for (;;) {
        sum = 0u; cnt = 0u; mine = 0u;
#pragma unroll
        for (unsigned j = 0; j < 16; ++j) { const unsigned c = xb_ld(&bar[XB_XCNT(j)]); sum += c; cnt += (c > 0u) ? 1u : 0u; mine = (j == x) ? c : mine; }
        if (sum == G) break;
        __builtin_amdgcn_s_sleep(1);
        if ((++sp & 255u) == 0u) { if (xb_ld(&bar[XB_TMO])) break; if (sp > XB_SPIN_CAP) { atomicAdd(&bar[XB_TMO], 1u); break; } }
    }
    nloc = mine > 0u ? mine : 1u; nx = cnt > 0u ? cnt : 1u;
}

__device__ __forceinline__ void xcd_barrier(const XcdBarrier& b) {
    asm volatile("s_waitcnt vmcnt(0)" ::: "memory");
    __syncthreads();
    if (threadIdx.x == 0) {
        unsigned* bar = b.bar;
        __builtin_amdgcn_s_waitcnt(0);
        unsigned nloc = b.st[0], nx = b.st[1];
        if (nloc == 0u) { xcd_barrier_complete(bar, b.x, nloc, nx); b.st[0] = nloc; b.st[1] = nx; }
        const unsigned old = xb_add(&bar[XB_XSUB(b.x)], 1u);
        const unsigned gen = old / nloc;
        if (old + 1u == (gen + 1u) * nloc) {
            __builtin_amdgcn_fence(__ATOMIC_RELEASE, "agent");
            asm volatile("s_waitcnt vmcnt(0)" ::: "memory");
            const unsigned og = xb_add(&bar[XB_TOP], 1u);
            const unsigned tg = og / nx;
            if (og + 1u == (tg + 1u) * nx) xb_add(&bar[XB_TOPGEN], 1u);
            else XB_SPIN(xb_ld(&bar[XB_TOPGEN]) == tg, bar);
            __builtin_amdgcn_fence(__ATOMIC_ACQUIRE, "agent");
            xb_add(&bar[XB_XGEN(b.x)], 1u);
            asm volatile("s_waitcnt vmcnt(0)" ::: "memory");
        } else {
            XB_SPIN(xb_ld(&bar[XB_XGEN(b.x)]) == gen, bar);
            __builtin_amdgcn_fence(__ATOMIC_ACQUIRE, "agent");
            asm volatile("s_waitcnt vmcnt(0)" ::: "memory");
        }
    }
    __syncthreads();
}

#define KARG(i) ((unsigned char*)(__attribute__((address_space(1))) unsigned char*)(((const volatile __attribute__((address_space(4))) unsigned long long*)__builtin_amdgcn_kernarg_segment_ptr())[i]))
#define INF(i) ((const float*)KARG(i))
#define OUTP ((float*)KARG(21))
#define WSP (KARG(22))
#define BIGP (KARG(22) + WS_BIG)
#define PH_IDS const int tid = opaque_tid(), lane = tid & 63, wave = __builtin_amdgcn_readfirstlane(tid >> 6); const int G = gridDim.x, gw = blockIdx.x * NWAVES + wave, NGW = G * NWAVES; const size_t gt = (size_t)blockIdx.x * 512 + tid, NGT = (size_t)G * 512; (void)lane; (void)gw; (void)NGW; (void)gt; (void)NGT

__device__ __forceinline__ void ph_prologue(LAS unsigned char* lds) {
    PH_IDS; unsigned char* ws = WSP;
    bf16_t* WIN = (bf16_t*)(ws + WS_WIN); bf16_t* WKVF = (bf16_t*)(ws + WS_WKVF);
    LAS float* scr = (LAS float*)(lds + wave * 16384);
    constexpr int I0 = 32 * 384;
    for (int it = gw; it < I0; it += NGW) tr_plain(INF(10), DM, NPROJ, WIN, 0, scr, it, lane);
    { const float* wf = INF(14); const float* nkv = INF(8);
      for (size_t i = gt; i < (size_t)256 * DM; i += NGT) { const int r = (int)(i >> 11), k = (int)(i & 2047); WKVF[(size_t)(1024 + r) * DM + k] = r < 16 ? (bf16_t)(pk2(wf[k * 16 + r] * nkv[k], 0.f) & 0xffffu) : (bf16_t)0; }
      float* ssq = (float*)(ws + WS_SSQ); for (size_t i = gt; i < (size_t)4 * TALL; i += NGT) ssq[i] = 0.f; }
    { float* COS = (float*)(ws + WS_COS); float* SIN = (float*)(ws + WS_SIN);
      for (size_t i = gt; i < (size_t)SEQ * 128; i += NGT) { const int pos = (int)(i >> 7), d = (int)(i & 127);
        const float inv = exp2f(-(float)d * (13.287712379549449f / 128.f));
        const double rev = (double)pos * (double)inv * 0.15915494309189535; const float fr = (float)(rev - __builtin_floor(rev));
        COS[i] = __builtin_amdgcn_cosf(fr); SIN[i] = __builtin_amdgcn_sinf(fr); } }
    { const float* x_p = INF(0); const float* x_s = INF(1); const float* nm = INF(6); bf16_t* XN0 = (bf16_t*)OUTP;
      for (int m = gw; m < TALL; m += NGW) rms_row<0>(m < TP ? x_p + (size_t)m * DM : x_s + (size_t)(m - TP) * DM, nm, XN0 + (size_t)m * DM, nullptr, nullptr, nullptr, lane); }
}
template <int JOB> __device__ __forceinline__ void ph_conv(LAS unsigned char* lds) {
    const int tid = opaque_tid(), lane = tid & 63, wave = __builtin_amdgcn_readfirstlane(tid >> 6);
    const int G = gridDim.x, first = G > 160 ? (JOB == 1 ? 48 : JOB == 3 ? 141 : 44) : 0;
    if ((int)blockIdx.x < first) return;
    const int gw = ((int)blockIdx.x - first) * NWAVES + wave, NGW = (G - first) * NWAVES;
    unsigned char* ws = WSP; LAS float* scr = (LAS float*)(lds + wave * 16384);
    constexpr int IG = 32 * 176, ID = 88 * 64, IQ = 32 * 64, IK = 32 * 16;
    if (JOB == 1) {
        bf16_t* WRO = (bf16_t*)(ws + WS_WRO); bf16_t* WGU0 = (bf16_t*)(ws + WS_WGU0);
        for (int it = gw; it < 64 * 64 + 2 * IG; it += NGW) { int r = it;
            if (r < 64 * 64) { tr_plain(INF(11), 4096, DM, WRO, 0, scr, r, lane); continue; } r -= 64 * 64;
            if (r < IG) { tr_gu(INF(18), WGU0, 0, scr, r, lane, INF(7)); continue; } r -= IG;
            tr_gu(INF(19), WGU0, 1, scr, r, lane, INF(7)); }
    } else if (JOB == 2) {
        bf16_t* WDN0 = (bf16_t*)(ws + WS_WDN0); bf16_t* WGU1 = (bf16_t*)(ws + WS_WGU1); bf16_t* WO = (bf16_t*)(ws + WS_WO); bf16_t* WKVF = (bf16_t*)(ws + WS_WKVF);
        for (int it = gw; it < ID + 2 * IQ + 2 * IK + IG; it += NGW) { int r = it;
            if (r < ID) { tr_plain(INF(20), DFF, DM, WDN0, 0, scr, r, lane); continue; } r -= ID;
            if (r < IQ) { tr_plain(INF(16), DM, DM, WKVF, 1280, scr, r, lane, INF(6) + DM); continue; } r -= IQ;
            if (r < IK) { tr_plain(INF(12), DM, 512, WKVF, 0, scr, r, lane, INF(8)); continue; } r -= IK;
            if (r < IK) { tr_plain(INF(13), DM, 512, WKVF, 512, scr, r, lane, INF(8)); continue; } r -= IK;
            if (r < IQ) { tr_plain(INF(17), DM, DM, WO, 0, scr, r, lane); continue; } r -= IQ;
            tr_gu(INF(18) + (size_t)DM * DFF, WGU1, 0, scr, r, lane, INF(7) + DM); }
    } else if (JOB == 3) {
        bf16_t* WGU1 = (bf16_t*)(ws + WS_WGU1);
        for (int it = gw; it < IG; it += NGW) tr_gu(INF(19) + (size_t)DM * DFF, WGU1, 1, scr, it, lane, INF(7) + DM);
    } else {
        bf16_t* WDN1 = (bf16_t*)(ws + WS_WDN1);
        for (int it = gw; it < ID; it += NGW) tr_plain(INF(20) + (size_t)DFF * DM, DFF, DM, WDN1, 0, scr, it, lane);
    }
}
__device__ __forceinline__ void ph_retin(LAS unsigned char* lds) {
    unsigned char* ws = WSP;
    pg8::Gemm g{(const bf16_t*)OUTP, (const bf16_t*)(ws + WS_WIN), TALL, NPROJ, DM, DM}; pg8::StaticOrder S; S.init(TALL, NPROJ, (int)gridDim.x, (int)blockIdx.x);
    pg8::EpiRetIn E{(bf16_t*)(ws + WS_BIG), (const float*)(ws + WS_COS), (const float*)(ws + WS_SIN)};
    pg8::gemm_phase<pg8::EpiRetIn, pg8::StaticOrder, true, true>(lds, g, S, E);
}
__device__ __forceinline__ void ph_retention(LAS unsigned char* lds) {
    const int G = gridDim.x;
    for (int it = blockIdx.x; it < 256; it += G) { const int bh = (it & 7) * 4 + (it >> 6), es = (it >> 3) & 7, b = bh >> 3, h = bh & 7;
        ret::ret_item((LAS char*)lds, (const bf16_t*)BIGP, (size_t)(b * 8 + h) * SEQ, (bf16_t*)OUTP, 128, 64, h, es, nullptr, OUTP + OUT_SP + (size_t)(b * 8 + h) * 256 * 512); }
    for (int it = blockIdx.x; it < 512; it += G) { const int bh = (it & 7) * 8 + (it >> 6), es = (it >> 3) & 7, b = bh >> 3, h = bh & 7;
        ret::ret_item((LAS char*)lds, (const bf16_t*)BIGP, (size_t)262144 + (size_t)(b * 8 + h) * 32, (bf16_t*)OUTP, 1, 32, h, es, INF(2) + (size_t)(b * 8 + h) * 256 * 512, OUTP + OUT_SS + (size_t)(b * 8 + h) * 256 * 512); }
}
__device__ __forceinline__ void ph_groupnorm() {
    PH_IDS; bf16_t* PROJ = (bf16_t*)BIGP; const bf16_t* OB = (const bf16_t*)OUTP;
    for (int it0 = gw * 4; it0 < TALL * 8; it0 += NGW * 4) {
        u32x4 ovv[4], gvv[4];
#pragma unroll
        for (int q = 0; q < 4; ++q) { const int it = it0 + q, row = it >> 3, h = it & 7;
            ovv[q] = *(const u32x4*)(OB + hrow(row, h) * 512 + lane * 8); gvv[q] = *(const u32x4*)(PROJ + PJ_G + (size_t)row * 4096 + h * 512 + lane * 8); }
#pragma unroll
        for (int q = 0; q < 4; ++q) { const int it = it0 + q, row = it >> 3, h = it & 7; const u32x4 ov = ovv[q], gv = gvv[q];
            bf16_t* op = PROJ + PJ_G + (size_t)row * 4096 + h * 512 + lane * 8;
            float o[8], g[8]; const unsigned ow[4] = {ov.x, ov.y, ov.z, ov.w}, gwd[4] = {gv.x, gv.y, gv.z, gv.w};
#pragma unroll
            for (int j = 0; j < 4; ++j) { o[2 * j] = __uint_as_float(ow[j] << 16); o[2 * j + 1] = __uint_as_float(ow[j] & 0xffff0000u); g[2 * j] = __uint_as_float(gwd[j] << 16); g[2 * j + 1] = __uint_as_float(gwd[j] & 0xffff0000u); }
            float s = 0.f;
#pragma unroll
            for (int j = 0; j < 8; ++j) s += o[j];
            const float mu = wave_sum(s) * (1.f / 512.f); float qq = 0.f;
#pragma unroll
            for (int j = 0; j < 8; ++j) { o[j] -= mu; qq += o[j] * o[j]; }
            const float rstd = 1.0f / sqrtf(wave_sum(qq) * (1.f / 512.f) + 1e-5f);
#pragma unroll
            for (int j = 0; j < 8; ++j) o[j] = o[j] * rstd * pg8::silu_f(g[j]);
            u32x4 w; w.x = pk2(o[0], o[1]); w.y = pk2(o[2], o[3]); w.z = pk2(o[4], o[5]); w.w = pk2(o[6], o[7]); *(u32x4*)op = w; } }
}
template <bool FIRST, int MROWS = TALL> __device__ __forceinline__ void ph_res_gemm(LAS unsigned char* lds, unsigned char* a_ptr, size_t w_off, int K, int lda, const bf16_t* base_h, bf16_t* hb, int ssq_idx) {
    unsigned char* ws = WSP;
    pg8::Gemm g{(const bf16_t*)a_ptr, (const bf16_t*)(ws + w_off), MROWS, DM, K, lda}; pg8::StaticOrder S; S.init(MROWS, DM, (int)gridDim.x, (int)blockIdx.x);
    pg8::EpiRes<!FIRST> E{FIRST ? INF(0) : nullptr, FIRST ? INF(1) : nullptr, base_h, hb, (float*)(ws + WS_SSQ) + (size_t)ssq_idx * TALL};
    pg8::gemm_phase<pg8::EpiRes<!FIRST>, pg8::StaticOrder, true, true>(lds, g, S, E);
}
template <bool FIRST = false> __device__ __forceinline__ void ph_sample_res(const unsigned char* a_ptr, int lda, size_t w_off, int K, const bf16_t* base_h, bf16_t* hb, int ssq_idx) {
    const int tid = opaque_tid(), lane = tid & 63, wave = __builtin_amdgcn_readfirstlane(tid >> 6), fr = lane & 15, fq = lane >> 4;
    unsigned char* ws = WSP;
    const bf16_t* A = (const bf16_t*)a_ptr; const bf16_t* Wt = (const bf16_t*)(ws + w_off);
    float* ssq = (float*)(ws + WS_SSQ) + (size_t)ssq_idx * TALL + TP;
    for (int it = blockIdx.x; it < 256; it += gridDim.x) {
        const int n0 = (it >> 1) * 16, row = (it & 1) * 128 + 16 * wave + fr;
        const bf16_t* bp = Wt + (size_t)(n0 + fr) * K + 8 * fq; const bf16_t* ap = A + (size_t)row * lda + 8 * fq;
        f32x4 acc = {0.f, 0.f, 0.f, 0.f};
        bf16x8 bA[8], aA[8], bB[8], aB[8];
#define SR_LOAD(B_, A_, kk) do { _Pragma("unroll") for (int s_ = 0; s_ < 8; ++s_) { B_[s_] = *(const bf16x8*)(bp + (kk) + 32 * s_); A_[s_] = *(const bf16x8*)(ap + (kk) + 32 * s_); } } while (0)
#define SR_MMA(B_, A_) do { _Pragma("unroll") for (int s_ = 0; s_ < 8; ++s_) acc = __builtin_amdgcn_mfma_f32_16x16x32_bf16(B_[s_], A_[s_], acc, 0, 0, 0); } while (0)
        SR_LOAD(bA, aA, 0);
        for (int k0 = 0; k0 < K; k0 += 512) {
            SR_LOAD(bB, aB, k0 + 256);
            SR_MMA(bA, aA);
            if (k0 + 512 < K) SR_LOAD(bA, aA, k0 + 512);
            SR_MMA(bB, aB);
        }
#undef SR_LOAD
#undef SR_MMA
        f32x4 bvv;
        if (FIRST) bvv = *(const f32x4*)(INF(1) + (size_t)row * DM + n0 + 4 * fq);
        else { const u32x2 t = *(const u32x2*)(base_h + (size_t)(TP + row) * DM + n0 + 4 * fq); bvv = (f32x4){__uint_as_float(t.x << 16), __uint_as_float(t.x & 0xffff0000u), __uint_as_float(t.y << 16), __uint_as_float(t.y & 0xffff0000u)}; }
        const f32x4 v = bvv + acc;
        { u32x2 w; w.x = pk2(v[0], v[1]); w.y = pk2(v[2], v[3]); *(u32x2*)(hb + (size_t)(TP + row) * DM + n0 + 4 * fq) = w; }
        { float ss = (v[0] * v[0] + v[1] * v[1]) + (v[2] * v[2] + v[3] * v[3]); ss += __shfl_xor(ss, 16); ss += __shfl_xor(ss, 32);
            if (fq == 0) (void)__hip_atomic_fetch_add(ssq + row, ss, __ATOMIC_RELAXED, __HIP_MEMORY_SCOPE_AGENT); }
    }
}
template <int MODE> __device__ __forceinline__ void ph_rms(const float* g1, size_t o1_off, const float* g2, size_t o2_off) {
    PH_IDS; float* Hres = OUTP + OUT_Y; unsigned char* ws = WSP;
    for (int m = gw; m < TALL; m += NGW) rms_row<MODE>(Hres + (size_t)m * DM, g1, (bf16_t*)(ws + o1_off) + (size_t)m * DM, g2, (bf16_t*)(ws + o2_off) + (size_t)m * DM, Hres + (size_t)m * DM, lane);
}
__device__ __forceinline__ void ph_cache_cvt() {
    PH_IDS; const float* cache_k = INF(3); const float* cache_v = INF(4); bf16_t* KALL = (bf16_t*)(BIGP + BIG_KALL); bf16_t* VALL = (bf16_t*)(BIGP + BIG_VALL);
    for (size_t i = gt; i < (size_t)8 * PASTL * 512 / 4; i += NGT) { const size_t e = i * 4, b = e / ((size_t)PASTL * 512), r = e % ((size_t)PASTL * 512);
        const f32x4 kv = *(const f32x4*)(cache_k + e), vv = *(const f32x4*)(cache_v + e); u32x2 w; w.x = pk2(kv.x, kv.y); w.y = pk2(kv.z, kv.w); *(u32x2*)(KALL + b * LKS * 512 + r) = w;
        w.x = pk2(vv.x, vv.y); w.y = pk2(vv.z, vv.w); *(u32x2*)(VALL + b * LKS * 512 + r) = w; }
}
__device__ __forceinline__ void ph_kvfq(LAS unsigned char* lds) {
    unsigned char* ws = WSP; unsigned char* big = ws + WS_BIG; float* out = OUTP;
    pg8::Gemm g{(const bf16_t*)(big + BIG_XN), (const bf16_t*)(ws + WS_WKVF), TALL, 3328, DM, DM}; pg8::StaticOrder S; S.init(TALL, 3328, (int)gridDim.x, (int)blockIdx.x);
    pg8::EpiKVFQ E{out + OUT_KP, out + OUT_VP, out + OUT_LFP, out + OUT_KS, out + OUT_VS, out + OUT_LFS, (bf16_t*)(big + BIG_KB), (bf16_t*)(big + BIG_VB), (bf16_t*)(big + BIG_KALL), (bf16_t*)(big + BIG_VALL),
                    (bf16_t*)(big + BIG_ACT), INF(15), (const float*)(ws + WS_SSQ) + (size_t)1 * TALL};
    pg8::gemm_phase<pg8::EpiKVFQ, pg8::StaticOrder, true, true>(lds, g, S, E);
}
__device__ __forceinline__ void ph_cumsum(LAS unsigned char* lds) {
    PH_IDS; const float* cache_lf = INF(5); const float* out = OUTP; float* FB = (float*)(WSP + WS_FB); float* FS = (float*)(WSP + WS_FS);
    for (int it = blockIdx.x; it < 64 + 128; it += G) {
        LAS float* wtot = (LAS float*)lds;
        const bool smp = it >= 64; const int bh = smp ? it - 64 : it, b = bh >> 4, h = bh & 15, Ls = smp ? LKS : SEQ, per = smp ? 3 : 16, j0 = tid * per;
        float v[16]; float s = 0.f;
#pragma unroll
        for (int i = 0; i < 16; ++i) { const int j = j0 + i; float x = 0.f;
            if (i < per && j < Ls) x = smp ? (j < PASTL ? cache_lf[((size_t)b * PASTL + j) * 16 + h] : out[OUT_LFS + ((size_t)b * 32 + (j - PASTL)) * 16 + h]) : out[OUT_LFP + ((size_t)b * SEQ + j) * 16 + h];
            s += x; v[i] = s; }
        float inc = s;
#pragma unroll
        for (int o = 1; o < 64; o <<= 1) { const float t = __shfl_up(inc, o); if (lane >= o) inc += t; }
        if (lane == 63) wtot[wave] = inc;
        __syncthreads();
        float base = inc - s;
        for (int w = 0; w < wave; ++w) base += wtot[w];
#pragma unroll
        for (int i = 0; i < 16; ++i) { const int j = j0 + i; if (i < per && j < Ls) { const float F = base + v[i];
            if (smp) FS[(size_t)bh * LKS + j] = F; else FB[(size_t)bh * SEQ + j] = -F * 11.313708498984761f; } }
        __syncthreads();
    }
}
__device__ __forceinline__ void ph_attn(unsigned char* lds_raw) {
    unsigned char* ws = WSP; unsigned char* big = ws + WS_BIG;
    fox::attn_phase((char*)lds_raw, (const bf16_t*)(big + BIG_ACT), (const bf16_t*)(big + BIG_KB), (const bf16_t*)(big + BIG_VB), (bf16_t*)OUTP  , (const float*)(ws + WS_FB));
}
__device__ __forceinline__ void ph_sattn(LAS unsigned char* lds) {
    unsigned char* ws = WSP; unsigned char* big = ws + WS_BIG;
    sample_attn((LAS char*)lds, (const bf16_t*)(big + BIG_ACT), (const bf16_t*)(big + BIG_KALL), (const bf16_t*)(big + BIG_VALL), (const float*)(ws + WS_FS), (bf16_t*)OUTP);
}
__device__ __forceinline__ void ph_gateup(LAS unsigned char* lds, const unsigned char* a_ptr, size_t w_off, int ssq_idx) {
    unsigned char* ws = WSP; unsigned char* big = ws + WS_BIG;
    pg8::Gemm g{(const bf16_t*)a_ptr, (const bf16_t*)(ws + w_off), TALL, 2 * DFF, DM, DM}; pg8::StaticOrder S; S.init(TALL, 2 * DFF, (int)gridDim.x, (int)blockIdx.x);
    pg8::EpiSwiglu E{(bf16_t*)(big + BIG_ACT), (const float*)(ws + WS_SSQ) + (size_t)ssq_idx * TALL};
    pg8::gemm_phase<pg8::EpiSwiglu, pg8::StaticOrder, true, true>(lds, g, S, E);
}

__device__ __forceinline__ void ph_final() {
    PH_IDS; const bf16_t* H4 = (const bf16_t*)(BIGP + BIG_XN); const float* ssq = (const float*)(WSP + WS_SSQ) + (size_t)3 * TALL; const float* g = INF(9); float* Y = OUTP + OUT_Y;
    for (int m = gw; m < TALL; m += NGW) {
        const u32x4* hr = (const u32x4*)(H4 + (size_t)m * DM); u32x4 hv[4];
#pragma unroll
        for (int j = 0; j < 4; ++j) hv[j] = hr[64 * j + lane];
        const float rs = 1.0f / sqrtf(ssq[m] * (1.f / DM) + 1e-6f);
#pragma unroll
        for (int j = 0; j < 4; ++j) { const int c0 = (64 * j + lane) * 8; const f32x4 g0 = *(const f32x4*)(g + c0), g1 = *(const f32x4*)(g + c0 + 4);
            f32x4 y0, y1; y0.x = __uint_as_float(hv[j].x << 16); y0.y = __uint_as_float(hv[j].x & 0xffff0000u); y0.z = __uint_as_float(hv[j].y << 16); y0.w = __uint_as_float(hv[j].y & 0xffff0000u);
            y1.x = __uint_as_float(hv[j].z << 16); y1.y = __uint_as_float(hv[j].z & 0xffff0000u); y1.z = __uint_as_float(hv[j].w << 16); y1.w = __uint_as_float(hv[j].w & 0xffff0000u);
            __builtin_nontemporal_store(y0 * rs * g0, (f32x4*)(Y + (size_t)m * DM + c0)); __builtin_nontemporal_store(y1 * rs * g1, (f32x4*)(Y + (size_t)m * DM + c0 + 4)); } }
}
__global__ void __launch_bounds__(NWAVES * 64, 2) yoco_fwd(Params P) {
    extern __shared__ __attribute__((aligned(16))) unsigned char lds_raw[];
    cg::grid_group grid = cg::this_grid();
    LAS unsigned char* lds = (LAS unsigned char*)lds_raw;
    volatile LAS unsigned* bst = (volatile LAS unsigned*)(lds + 148480);
    if (opaque_tid() < 2) bst[opaque_tid()] = 0u;
    __syncthreads();
    const XcdBarrier xbar = xcd_barrier_post((unsigned*)(WSP + WS_BAR), bst);
#define GSYNC() xcd_barrier(xbar)
    ph_prologue(lds);                                                                                   GSYNC();
    if (WSP == nullptr) grid.sync();
    ph_retin(lds); ph_conv<1>(lds);                                                                                      GSYNC();
    ph_retention(lds);                                                                                  GSYNC();
    ph_groupnorm();                                                                                     GSYNC();
    ph_res_gemm<true, TP>(lds, BIGP + PJ_G * 2, WS_WRO, 4096, 4096, nullptr, (bf16_t*)(OUTP + OUT_KP), 0); ph_sample_res<true>(BIGP + (PJ_G + (size_t)TP * 4096) * 2, 4096, WS_WRO, 4096, nullptr, (bf16_t*)(OUTP + OUT_KP), 0);   GSYNC();
    ph_gateup(lds, (const unsigned char*)(OUTP + OUT_KP), WS_WGU0, 0); ph_conv<2>(lds);                                  GSYNC();
    ph_res_gemm<false, TP>(lds, BIGP + BIG_ACT, WS_WDN0, DFF, DFF, (const bf16_t*)(OUTP + OUT_KP), (bf16_t*)(BIGP + BIG_XN), 1); ph_sample_res(BIGP + BIG_ACT + (size_t)TP * DFF * 2, DFF, WS_WDN0, DFF, (const bf16_t*)(OUTP + OUT_KP), (bf16_t*)(BIGP + BIG_XN), 1); ph_cache_cvt();   GSYNC();
    ph_kvfq(lds); ph_conv<3>(lds);                                                                                       GSYNC();
    ph_cumsum(lds);                                                                                     GSYNC();
    ph_attn(lds_raw); __syncthreads(); ph_sattn(lds);                                                   GSYNC();
    ph_res_gemm<false, TP>(lds, (unsigned char*)OUTP, WS_WO, DM, DM, (const bf16_t*)(BIGP + BIG_XN), (bf16_t*)(BIGP + BIG_HKV), 2); ph_sample_res((const unsigned char*)OUTP + (size_t)TP * DM * 2, DM, WS_WO, DM, (const bf16_t*)(BIGP + BIG_XN), (bf16_t*)(BIGP + BIG_HKV), 2);   GSYNC();
    ph_gateup(lds, BIGP + BIG_HKV, WS_WGU1, 2); ph_conv<4>(lds);                                                         GSYNC();
    ph_res_gemm<false, TP>(lds, BIGP + BIG_ACT, WS_WDN1, DFF, DFF, (const bf16_t*)(BIGP + BIG_HKV), (bf16_t*)(BIGP + BIG_XN), 3); ph_sample_res(BIGP + BIG_ACT + (size_t)TP * DFF * 2, DFF, WS_WDN1, DFF, (const bf16_t*)(BIGP + BIG_HKV), (bf16_t*)(BIGP + BIG_XN), 3);   GSYNC();
    ph_final();
}

extern "C" void kernel_launch(void* const* d_in, const int* in_sizes, int n_in, void* d_out, int out_size, void* d_ws, size_t ws_size, hipStream_t stream) {
    static int grid = 0;
    if (grid == 0) {
        if (n_in != 21 || ws_size < WS_END) { fprintf(stderr, "kernel_launch: unexpected n_in %d / ws_size %zu (need %zu)\n", n_in, ws_size, (size_t)WS_END); grid = -1; return; }
        int dev = 0, cus = 0, per_cu = 0;
        (void)hipGetDevice(&dev); (void)hipDeviceGetAttribute(&cus, hipDeviceAttributeMultiprocessorCount, dev);
        if (hipFuncSetAttribute((const void*)yoco_fwd, hipFuncAttributeMaxDynamicSharedMemorySize, LDS_BYTES) != hipSuccess) { fprintf(stderr, "kernel_launch: hipFuncSetAttribute failed\n"); grid = -1; return; }
        if (hipOccupancyMaxActiveBlocksPerMultiprocessor(&per_cu, (const void*)yoco_fwd, NWAVES * 64, LDS_BYTES) != hipSuccess || per_cu < 1) { fprintf(stderr, "kernel_launch: occupancy query says %d\n", per_cu); per_cu = 1; }
        (void)hipGetLastError();
        grid = cus > 0 ? cus : 256;
    }
    if (grid < 0) return;
    if (hipMemsetAsync((char*)d_ws + WS_BAR, 0, XCD_BAR_WORDS * 4, stream) != hipSuccess) { fprintf(stderr, "kernel_launch: memset of the barrier words failed\n"); return; }
    Params p{};
    for (int i = 0; i < 21; ++i) p.in[i] = (const float*)d_in[i];
    p.out = (float*)d_out; p.ws = (unsigned char*)d_ws;
    void* args[] = {&p};
    hipError_t e = hipLaunchCooperativeKernel((const void*)yoco_fwd, dim3(grid), dim3(NWAVES * 64), args, LDS_BYTES, stream);
    if (e != hipSuccess) fprintf(stderr, "cooperative launch failed: %s (grid %d)\n", hipGetErrorString(e), grid);
}
```

```cpp
#include <hip/hip_runtime.h>
#include <hip/hip_cooperative_groups.h>
#include <cstdio>
#include <cstdint>
namespace cg = cooperative_groups;
__device__ __forceinline__ int opaque_tid() { int t = threadIdx.x; asm volatile("" : "+v"(t)); return t; }
namespace pg8 {
#define PG8_LAS __attribute__((address_space(3)))
typedef unsigned short bf16_t;
typedef short bf16x8 __attribute__((ext_vector_type(8)));
typedef float f32x4 __attribute__((ext_vector_type(4)));
typedef unsigned u32x4 __attribute__((ext_vector_type(4)));
constexpr int BM = 256, BK = 64, HALF = 128, HTB = HALF * BK * 2  , STAGE_BYTES = 8 * HTB, NXCD = 8, WGM = 4;

__host__ __device__ __forceinline__ int lds_byte(int r, int c) { const int st = (r >> 4) * 2 + (c >> 5), rr = r & 15, cc = c & 31, ob = rr * 64 + cc * 2; return st * 1024 + (ob ^ (((ob >> 9) & 1) << 5)); }
__host__ __device__ __forceinline__ void stage_rc(int b, int& R, int& C) { const int st = b / 1024, sb = b % 1024, swz = sb ^ (((sb >> 9) & 1) << 5); R = (st >> 1) * 16 + swz / 64; C = (st & 1) * 32 + (swz % 64) / 2; }
__host__ __device__ __forceinline__ int perm32(int rho) { const int n = rho >> 4, i = rho & 15; return 8 * (i >> 2) + 4 * n + (i & 3); }

struct Unit { int pm, pn; };
struct Gemm { const bf16_t* A; const bf16_t* Bt; int M, N, K, lda; };

struct StaticOrder {
    int nM, nN, nwg, G, c;
    __host__ __device__ void init(int M, int N, int G_, int c_) { nM = M / BM; nN = N / BM; nwg = nM * nN; G = G_; c = c_; }
    __host__ __device__ bool next(int i, Unit& u) const {
        const long L = (long)i * G + c; if (L >= nwg) return false;
        int wgid = (int)L; { const int q = nwg / NXCD, r = nwg % NXCD, xcd = wgid % NXCD, off = wgid / NXCD; wgid = (xcd < r ? xcd * (q + 1) : r * (q + 1) + (xcd - r) * q) + off; }
        const int nig = WGM * nN, gid = wgid / nig, fm = gid * WGM, gsz = (nM - fm) < WGM ? (nM - fm) : WGM;
        u.pm = fm + ((wgid % nig) % gsz); u.pn = (wgid % nig) / gsz; return true;
    }
    __device__ __forceinline__ void a_ready(const Unit&) const {}
    __device__ __forceinline__ void done(const Unit&) const {}
};

__device__ __forceinline__ unsigned cvt_pk_bf16(float lo, float hi) { unsigned r; asm volatile("v_cvt_pk_bf16_f32 %0, %1, %2" : "=v"(r) : "v"(lo), "v"(hi)); return r; }
template <class Epi, class Sched, bool ALIGN_EPI = false, bool SP2 = false>
__device__ __forceinline__ void gemm_phase(PG8_LAS unsigned char* lds, const Gemm g, const Sched& S, const Epi& E) {
    const int tid = opaque_tid(), wid = __builtin_amdgcn_readfirstlane(tid >> 6), lane = tid & 63, wr = wid >> 2, wc = wid & 3, fr = lane & 15, fq = lane >> 4;
    const int K = g.K, nt = K / BK;
    unsigned voffA[2], voffB[2];
#pragma unroll
    for (int i = 0; i < 2; ++i) { int R, C; stage_rc(tid * 16 + i * 8192, R, C); const int Rb = Epi::PERM ? ((R & ~31) + perm32(R & 31)) : R;
        voffA[i] = (unsigned)(R * g.lda + C) * 2u; voffB[i] = (unsigned)(Rb * K + C) * 2u; }
    const size_t kstep = (size_t)(BK * 2);
    const size_t hstep = (size_t)HALF * K * 2, hstepA = (size_t)HALF * g.lda * 2;
    const size_t tstep = 2 * hstep, tstepA = 2 * hstepA;
    const unsigned ldsw = (unsigned)wid * 1024u;
    const int aoff = lds_byte(wr * 64 + fr, fq * 8), boff = lds_byte(wc * 32 + fr, fq * 8);
#define PG8_SA(b, h) (((b) * 2 + (h)) * HTB)
#define PG8_SB(b, h) ((4 + (b) * 2 + (h)) * HTB)
#define PG8_STAGE(bufoff, gbase, voff) do { _Pragma("unroll") for (int _i = 0; _i < 2; ++_i) \
        __builtin_amdgcn_global_load_lds((const unsigned*)((const char*)(gbase) + (voff)[_i]), (PG8_LAS unsigned*)(lds + (bufoff) + ldsw + _i * 8192), 16, 0, 0); } while (0)
#define PG8_LDA(dst, b, h) do { _Pragma("unroll") for (int m = 0; m < 4; ++m) _Pragma("unroll") for (int k = 0; k < 2; ++k) dst[m][k] = *(const PG8_LAS bf16x8*)(lds + PG8_SA(b, h) + aoff + m * 2048 + k * 1024); } while (0)
#define PG8_LDB(dst, b, h) do { _Pragma("unroll") for (int n = 0; n < 2; ++n) _Pragma("unroll") for (int k = 0; k < 2; ++k) dst[n][k] = *(const PG8_LAS bf16x8*)(lds + PG8_SB(b, h) + boff + n * 2048 + k * 1024); } while (0)
#define PG8_MMA(ai, bj, At, Bt) do { __builtin_amdgcn_s_setprio(1); _Pragma("unroll") for (int m = 0; m < 4; ++m) _Pragma("unroll") for (int n = 0; n < 2; ++n) _Pragma("unroll") for (int k = 0; k < 2; ++k) \
        acc[ai][bj][m][n] = __builtin_amdgcn_mfma_f32_16x16x32_bf16(Bt[n][k], At[m][k], acc[ai][bj][m][n], 0, 0, 0); __builtin_amdgcn_s_setprio(0); } while (0)
#define PG8_WAIT_V(n) asm volatile("s_waitcnt vmcnt(" #n ")" ::: "memory")
#define PG8_WAIT_L(n) asm volatile("s_waitcnt lgkmcnt(" #n ")" ::: "memory")
#define PG8_BAR __builtin_amdgcn_s_barrier()
#define PG8_SCHED __builtin_amdgcn_sched_barrier(0)
    Unit cur, nxt; int ui = 0;
    if (!S.next(0, cur)) return;
    f32x4 acc[2][2][4][2];
#pragma unroll
    for (int a = 0; a < 2; ++a)
#pragma unroll
        for (int b = 0; b < 2; ++b)
#pragma unroll
            for (int m = 0; m < 4; ++m)
#pragma unroll
                for (int n = 0; n < 2; ++n) acc[a][b][m][n] = (f32x4){0.f, 0.f, 0.f, 0.f};
    bf16x8 At[4][2], B0[2][2], B1[2][2];
    const char* cA = (const char*)g.A + (size_t)cur.pm * tstepA; const char* cB = (const char*)g.Bt + (size_t)cur.pn * tstep;
    S.a_ready(cur);
    if constexpr (SP2) {
        PG8_STAGE(PG8_SB(0, 0), cB, voffB); PG8_STAGE(PG8_SB(0, 1), cB + hstep, voffB); PG8_STAGE(PG8_SA(0, 0), cA, voffA); PG8_STAGE(PG8_SA(0, 1), cA + hstepA, voffA);
        if (wr == 1) PG8_BAR;
        PG8_WAIT_V(2); PG8_BAR;
        PG8_STAGE(PG8_SB(1, 0), cB + kstep, voffB); PG8_STAGE(PG8_SA(1, 0), cA + kstep, voffA); PG8_STAGE(PG8_SB(1, 1), cB + hstep + kstep, voffB);
        PG8_WAIT_V(6); PG8_BAR;
    } else {
        PG8_STAGE(PG8_SB(0, 0), cB, voffB); PG8_STAGE(PG8_SA(0, 0), cA, voffA); PG8_STAGE(PG8_SB(0, 1), cB + hstep, voffB); PG8_STAGE(PG8_SA(0, 1), cA + hstepA, voffA);
        if (wr == 1) PG8_BAR;
        PG8_WAIT_V(4); PG8_BAR;
        PG8_STAGE(PG8_SB(1, 0), cB + kstep, voffB); PG8_STAGE(PG8_SA(1, 0), cA + kstep, voffA); PG8_STAGE(PG8_SB(1, 1), cB + hstep + kstep, voffB);
        PG8_WAIT_V(6); PG8_BAR;
    }
    for (;;) {
        const bool has_next = S.next(ui + 1, nxt);
        const char* nA = has_next ? (const char*)g.A + (size_t)nxt.pm * tstepA : cA; const char* nB = has_next ? (const char*)g.Bt + (size_t)nxt.pn * tstep : cB;
        for (int t = 0; t < nt; t += 2) {
            const bool last = (t == nt - 2);
            const char* a1 = cA + (size_t)(t + 1) * kstep;
            const char* a2 = last ? nA : cA + (size_t)(t + 2) * kstep; const char* b2 = last ? nB : cB + (size_t)(t + 2) * kstep;
            const char* a3 = a2 + kstep; const char* b3 = b2 + kstep;
            if (last && has_next) S.a_ready(nxt);
            if constexpr (SP2) {
            PG8_LDB(B0, 0, 0); PG8_LDB(B1, 0, 1); PG8_SCHED; PG8_LDA(At, 0, 0); PG8_STAGE(PG8_SA(1, 1), a1 + hstepA, voffA);
            PG8_WAIT_V(8); PG8_WAIT_L(0); PG8_BAR; PG8_MMA(0, 0, At, B0); PG8_MMA(0, 1, At, B1); PG8_BAR; PG8_SCHED;
            PG8_LDA(At, 0, 1); PG8_STAGE(PG8_SB(0, 0), b2, voffB); PG8_STAGE(PG8_SB(0, 1), b2 + hstep, voffB); PG8_STAGE(PG8_SA(0, 0), a2, voffA);
            PG8_WAIT_V(8); PG8_WAIT_L(0); PG8_BAR; PG8_MMA(1, 0, At, B0); PG8_MMA(1, 1, At, B1); PG8_BAR; PG8_SCHED;
            PG8_LDB(B0, 1, 0); PG8_LDB(B1, 1, 1); PG8_SCHED; PG8_LDA(At, 1, 0); PG8_STAGE(PG8_SA(0, 1), a2 + hstepA, voffA);
            PG8_WAIT_V(8); PG8_WAIT_L(0); PG8_BAR; PG8_MMA(0, 0, At, B0); PG8_MMA(0, 1, At, B1); PG8_BAR; PG8_SCHED;
            PG8_LDA(At, 1, 1); PG8_STAGE(PG8_SB(1, 0), b3, voffB); PG8_STAGE(PG8_SB(1, 1), b3 + hstep, voffB); PG8_STAGE(PG8_SA(1, 0), a3, voffA);
            PG8_WAIT_V(8); PG8_WAIT_L(0); PG8_BAR; PG8_MMA(1, 0, At, B0); PG8_MMA(1, 1, At, B1); PG8_BAR; PG8_SCHED;
            } else {
            PG8_LDB(B0, 0, 0); PG8_SCHED; PG8_LDA(At, 0, 0); PG8_STAGE(PG8_SA(1, 1), a1 + hstepA, voffA);
            PG8_WAIT_L(8); PG8_BAR; PG8_WAIT_L(0); PG8_MMA(0, 0, At, B0); PG8_BAR; PG8_SCHED;
            PG8_LDB(B1, 0, 1); PG8_STAGE(PG8_SB(0, 0), b2, voffB);
            PG8_BAR; PG8_WAIT_L(0); PG8_MMA(0, 1, At, B1); PG8_BAR;
            PG8_LDA(At, 0, 1); PG8_STAGE(PG8_SA(0, 0), a2, voffA);
            PG8_BAR; PG8_WAIT_L(0); PG8_MMA(1, 0, At, B0); PG8_BAR; PG8_SCHED;
            PG8_STAGE(PG8_SB(0, 1), b2 + hstep, voffB);
            PG8_WAIT_V(6); PG8_BAR; PG8_MMA(1, 1, At, B1); PG8_BAR;
            PG8_LDB(B0, 1, 0); PG8_SCHED; PG8_LDA(At, 1, 0); PG8_STAGE(PG8_SA(0, 1), a2 + hstepA, voffA);
            PG8_WAIT_L(8); PG8_BAR; PG8_WAIT_L(0); PG8_MMA(0, 0, At, B0); PG8_BAR; PG8_SCHED;
            PG8_LDB(B1, 1, 1); PG8_STAGE(PG8_SB(1, 0), b3, voffB);
            PG8_BAR; PG8_WAIT_L(0); PG8_MMA(0, 1, At, B1); PG8_BAR;
            PG8_LDA(At, 1, 1); PG8_STAGE(PG8_SA(1, 0), a3, voffA);
            PG8_BAR; PG8_WAIT_L(0); PG8_MMA(1, 0, At, B0); PG8_BAR; PG8_SCHED;
            PG8_STAGE(PG8_SB(1, 1), b3 + hstep, voffB);
            PG8_WAIT_V(6); PG8_BAR; PG8_MMA(1, 1, At, B1); PG8_BAR;
            }
        }
        if constexpr (ALIGN_EPI) { if (wr == 0) PG8_BAR; }
        if constexpr (!Epi::AFTER_DRAIN) { E(acc, cur, wr, wc, fr, fq); S.done(cur); }
        if (!has_next) break;
#pragma unroll
        for (int a = 0; a < 2; ++a)
#pragma unroll
            for (int b = 0; b < 2; ++b)
#pragma unroll
                for (int m = 0; m < 4; ++m)
#pragma unroll
                    for (int n = 0; n < 2; ++n) acc[a][b][m][n] = (f32x4){0.f, 0.f, 0.f, 0.f};
        cur = nxt; cA = nA; cB = nB; ++ui;
        if constexpr (ALIGN_EPI) { if (wr == 1) PG8_BAR; }
    }
    PG8_WAIT_V(0);
    if constexpr (!ALIGN_EPI) { if (wr == 0) PG8_BAR; }
    PG8_BAR;
    if constexpr (Epi::AFTER_DRAIN) { E.fused(acc, cur, wr, wc, fr, fq, lds, wid, lane); S.done(cur); }
#undef PG8_SA
#undef PG8_SB
#undef PG8_STAGE
#undef PG8_LDA
#undef PG8_LDB
#undef PG8_MMA
#undef PG8_WAIT_V
#undef PG8_WAIT_L
#undef PG8_BAR
#undef PG8_SCHED
}
}
constexpr int DM = 2048, TP = 32768, TSMP = 256, TALL = 33024, SEQ = 8192, NPROJ = 12288, DFF = 5632, PASTL = 1024, LKS = 1056;
constexpr size_t PJ_Q = 0, PJ_K = (size_t)TALL * 2048, PJ_V = (size_t)TALL * 4096, PJ_G = (size_t)TALL * 8192;
__device__ __forceinline__ size_t hrow(int row, int h) { return row < TP ? ((size_t)((row >> 13) * 8 + h) << 13) + (row & 8191) : (size_t)262144 + (size_t)((((row - TP) >> 5) * 8 + h) << 5) + ((row - TP) & 31); }
#define GAS __attribute__((address_space(1)))
#define LAS __attribute__((address_space(3)))
typedef unsigned short bf16_t;
typedef float f32x4 __attribute__((ext_vector_type(4)));
typedef unsigned u32x4 __attribute__((ext_vector_type(4)));
typedef unsigned u32x2 __attribute__((ext_vector_type(2)));
typedef short bf16x8 __attribute__((ext_vector_type(8)));
typedef short s16x4 __attribute__((ext_vector_type(4)));

namespace pg8 {
__device__ __forceinline__ float silu_f(float g) { return g * __builtin_amdgcn_rcpf(1.0f + __builtin_amdgcn_exp2f(-1.4426950408889634f * g)); }
struct EpiBf16P {
    static constexpr bool PERM = true, AFTER_DRAIN = false;
    bf16_t* O; int ldc;
    __device__ __forceinline__ void operator()(const f32x4 (&acc)[2][2][4][2], const Unit& u, int wr, int wc, int fr, int fq) const {
        const int row0 = u.pm * BM + wr * 64 + fr, col0 = u.pn * BM + wc * 32 + 8 * fq;
#pragma unroll
        for (int ai = 0; ai < 2; ++ai)
#pragma unroll
            for (int m = 0; m < 4; ++m) { bf16_t* rowp = O + (size_t)(row0 + ai * HALF + m * 16) * ldc + col0;
#pragma unroll
                for (int bj = 0; bj < 2; ++bj) { const f32x4 v0 = acc[ai][bj][m][0], v1 = acc[ai][bj][m][1];
                    u32x4 w; w.x = cvt_pk_bf16(v0[0], v0[1]); w.y = cvt_pk_bf16(v0[2], v0[3]); w.z = cvt_pk_bf16(v1[0], v1[1]); w.w = cvt_pk_bf16(v1[2], v1[3]);
                    *(u32x4*)(rowp + bj * HALF) = w; } }
    }
};
struct EpiRetIn {
    static constexpr bool PERM = true, AFTER_DRAIN = false;
    bf16_t* O; const float* cosT; const float* sinT;
    __device__ __forceinline__ void operator()(const f32x4 (&acc)[2][2][4][2], const Unit& u, int wr, int wc, int fr, int fq) const {
        const int row0 = u.pm * BM + wr * 64 + fr, cl = wc * 32 + 8 * fq;
        if (u.pn < 16) {
            const bool isk = u.pn >= 8; const int h = u.pn & 7;
            const float lg2 = __log2f(1.0f - exp2f(-5.0f - (float)h));
#pragma unroll
            for (int ai = 0; ai < 2; ++ai) {
                f32x4 cs[4][4]; float scv[4];
#pragma unroll
                for (int m = 0; m < 4; ++m) {
                    const int row = row0 + ai * HALF + m * 16; int pos, l;
                    if (row < TP) { pos = row & (SEQ - 1); l = row & 63; } else { const int s = (row - TP) & 31; pos = PASTL + s; l = s; }
                    scv[m] = isk ? exp2f(-lg2 * (float)l) * 0.0625f : exp2f(lg2 * (float)l);
                    const float* cp = cosT + (size_t)pos * 128 + cl; const float* sp = sinT + (size_t)pos * 128 + cl;
                    cs[m][0] = *(const f32x4*)cp; cs[m][1] = *(const f32x4*)(cp + 4); cs[m][2] = *(const f32x4*)sp; cs[m][3] = *(const f32x4*)(sp + 4); }
#pragma unroll
                for (int m = 0; m < 4; ++m) {
                    const int row = row0 + ai * HALF + m * 16; const float sc = scv[m];
                    const f32x4 c0 = cs[m][0], c1 = cs[m][1], s0 = cs[m][2], s1 = cs[m][3];
                    const f32x4 x1a = acc[ai][0][m][0], x1b = acc[ai][0][m][1], x2a = acc[ai][1][m][0], x2b = acc[ai][1][m][1];
                    const f32x4 o1a = (x1a * c0 - x2a * s0) * sc, o1b = (x1b * c1 - x2b * s1) * sc, o2a = (x1a * s0 + x2a * c0) * sc, o2b = (x1b * s1 + x2b * c1) * sc;
                    bf16_t* rowp = O + (isk ? PJ_K : PJ_Q) + hrow(row, h) * 256 + cl;
                    u32x4 w; w.x = cvt_pk_bf16(o1a[0], o1a[1]); w.y = cvt_pk_bf16(o1a[2], o1a[3]); w.z = cvt_pk_bf16(o1b[0], o1b[1]); w.w = cvt_pk_bf16(o1b[2], o1b[3]);
                    *(u32x4*)rowp = w;
                    w.x = cvt_pk_bf16(o2a[0], o2a[1]); w.y = cvt_pk_bf16(o2a[2], o2a[3]); w.z = cvt_pk_bf16(o2b[0], o2b[1]); w.w = cvt_pk_bf16(o2b[2], o2b[3]);
                    *(u32x4*)(rowp + HALF) = w; }
                asm volatile("" ::: "memory"); }
        } else {
            const bool isv = u.pn < 32; const int hv = (u.pn - 16) >> 1, e0 = ((u.pn - 16) & 1) * 256 + cl;
#pragma unroll
            for (int ai = 0; ai < 2; ++ai)
#pragma unroll
                for (int m = 0; m < 4; ++m) { const int row = row0 + ai * HALF + m * 16;
                    bf16_t* rowp = isv ? O + PJ_V + hrow(row, hv) * 512 + e0 : O + PJ_G + (size_t)row * 4096 + (u.pn - 32) * BM + cl;
#pragma unroll
                    for (int bj = 0; bj < 2; ++bj) { const f32x4 v0 = acc[ai][bj][m][0], v1 = acc[ai][bj][m][1];
                        u32x4 w; w.x = cvt_pk_bf16(v0[0], v0[1]); w.y = cvt_pk_bf16(v0[2], v0[3]); w.z = cvt_pk_bf16(v1[0], v1[1]); w.w = cvt_pk_bf16(v1[2], v1[3]);
                        *(u32x4*)(rowp + bj * HALF) = w; } }
        }
    }
};
template <bool BASEBF> struct EpiRes {
    static constexpr bool PERM = true, AFTER_DRAIN = false;
    const float* baseP; const float* baseS; const bf16_t* baseH; bf16_t* hb; float* ssq;
    __device__ __forceinline__ void operator()(const f32x4 (&acc)[2][2][4][2], const Unit& u, int wr, int wc, int fr, int fq) const {
        const int row0 = u.pm * BM + wr * 64 + fr, col0 = u.pn * BM + wc * 32 + 8 * fq;
#pragma unroll
        for (int ai = 0; ai < 2; ++ai) {
            f32x4 bv[4][2][2];
#pragma unroll
            for (int m = 0; m < 4; ++m) { const int row = row0 + ai * HALF + m * 16;
                if (BASEBF) { const bf16_t* b = baseH + (size_t)row * DM + col0;
#pragma unroll
                    for (int bj = 0; bj < 2; ++bj) { const u32x4 t = __builtin_nontemporal_load((const u32x4*)(b + bj * HALF));
                        bv[m][bj][0] = (f32x4){__uint_as_float(t.x << 16), __uint_as_float(t.x & 0xffff0000u), __uint_as_float(t.y << 16), __uint_as_float(t.y & 0xffff0000u)};
                        bv[m][bj][1] = (f32x4){__uint_as_float(t.z << 16), __uint_as_float(t.z & 0xffff0000u), __uint_as_float(t.w << 16), __uint_as_float(t.w & 0xffff0000u)}; } }
                else { const float* b = (row < TP ? baseP + (size_t)row * DM : baseS + (size_t)(row - TP) * DM) + col0;
#pragma unroll
                    for (int bj = 0; bj < 2; ++bj)
#pragma unroll
                        for (int n = 0; n < 2; ++n) bv[m][bj][n] = __builtin_nontemporal_load((const f32x4*)(b + bj * HALF + n * 4)); } }
#pragma unroll
            for (int m = 0; m < 4; ++m) { const int row = row0 + ai * HALF + m * 16; float ss = 0.f;
#pragma unroll
                for (int bj = 0; bj < 2; ++bj) { const f32x4 v0 = bv[m][bj][0] + acc[ai][bj][m][0], v1 = bv[m][bj][1] + acc[ai][bj][m][1];
                    u32x4 w; w.x = cvt_pk_bf16(v0[0], v0[1]); w.y = cvt_pk_bf16(v0[2], v0[3]); w.z = cvt_pk_bf16(v1[0], v1[1]); w.w = cvt_pk_bf16(v1[2], v1[3]);
                    *(u32x4*)(hb + (size_t)row * DM + col0 + bj * HALF) = w;
                    ss += ((v0[0] * v0[0] + v0[1] * v0[1]) + (v0[2] * v0[2] + v0[3] * v0[3])) + ((v1[0] * v1[0] + v1[1] * v1[1]) + (v1[2] * v1[2] + v1[3] * v1[3])); }
                ss += __shfl_xor(ss, 16); ss += __shfl_xor(ss, 32);
                if (fq == 0) (void)__hip_atomic_fetch_add(ssq + row, ss, __ATOMIC_RELAXED, __HIP_MEMORY_SCOPE_AGENT); }
            asm volatile("" ::: "memory"); }
    }
};
struct EpiSwiglu {
    static constexpr bool PERM = true, AFTER_DRAIN = false;
    bf16_t* O; const float* ssq;
    __device__ __forceinline__ void operator()(const f32x4 (&acc)[2][2][4][2], const Unit& u, int wr, int wc, int fr, int fq) const {
        const int row0 = u.pm * BM + wr * 64 + fr, col0 = u.pn * HALF + wc * 32 + 8 * fq;
        float rs[2][4];
#pragma unroll
        for (int ai = 0; ai < 2; ++ai)
#pragma unroll
            for (int m = 0; m < 4; ++m) rs[ai][m] = ssq[row0 + ai * HALF + m * 16];
#pragma unroll
        for (int ai = 0; ai < 2; ++ai)
#pragma unroll
            for (int m = 0; m < 4; ++m) { bf16_t* rowp = O + (size_t)(row0 + ai * HALF + m * 16) * DFF + col0; const float r = 1.0f / sqrtf(rs[ai][m] * (1.f / DM) + 1e-6f);
                const f32x4 g0 = acc[ai][0][m][0] * r, g1 = acc[ai][0][m][1] * r, u0 = acc[ai][1][m][0] * r, u1 = acc[ai][1][m][1] * r;
                f32x4 a0, a1;
#pragma unroll
                for (int j = 0; j < 4; ++j) { a0[j] = silu_f(g0[j]) * u0[j]; a1[j] = silu_f(g1[j]) * u1[j]; }
                u32x4 w; w.x = cvt_pk_bf16(a0[0], a0[1]); w.y = cvt_pk_bf16(a0[2], a0[3]); w.z = cvt_pk_bf16(a1[0], a1[1]); w.w = cvt_pk_bf16(a1[2], a1[3]);
                *(u32x4*)rowp = w; }
    }
};
struct EpiKVFQ {
    static constexpr bool PERM = true, AFTER_DRAIN = false;
    float* kP; float* vP; float* lfP; float* kS; float* vS; float* lfS; bf16_t* KB; bf16_t* VB; bf16_t* KALL; bf16_t* VALL; bf16_t* QB; const float* bf; const float* ssq;
    __device__ __forceinline__ void operator()(const f32x4 (&acc)[2][2][4][2], const Unit& u, int wr, int wc, int fr, int fq) const {
        const int row0 = u.pm * BM + wr * 64 + fr;
        float rs[2][4];
#pragma unroll
        for (int ai = 0; ai < 2; ++ai)
#pragma unroll
            for (int m = 0; m < 4; ++m) rs[ai][m] = 1.0f / sqrtf(ssq[row0 + ai * HALF + m * 16] * (1.f / DM) + 1e-6f);
        if (u.pn >= 5) {
            const int col0 = (u.pn - 5) * BM + wc * 32 + 8 * fq;
#pragma unroll
            for (int ai = 0; ai < 2; ++ai)
#pragma unroll
                for (int m = 0; m < 4; ++m) { bf16_t* bo = QB + (size_t)(row0 + ai * HALF + m * 16) * DM + col0;
#pragma unroll
                    for (int bj = 0; bj < 2; ++bj) { const f32x4 v0 = acc[ai][bj][m][0] * rs[ai][m], v1 = acc[ai][bj][m][1] * rs[ai][m];
                        u32x4 w; w.x = cvt_pk_bf16(v0[0], v0[1]); w.y = cvt_pk_bf16(v0[2], v0[3]); w.z = cvt_pk_bf16(v1[0], v1[1]); w.w = cvt_pk_bf16(v1[2], v1[3]); *(u32x4*)(bo + bj * HALF) = w; } }
        } else if (u.pn < 4) {
            const bool isv = u.pn >= 2; const int col0 = (u.pn & 1) * BM + wc * 32 + 8 * fq;
            float* fP = isv ? vP : kP; float* fS = isv ? vS : kS; bf16_t* bP = isv ? VB : KB; bf16_t* bA = isv ? VALL : KALL;
#pragma unroll
            for (int ai = 0; ai < 2; ++ai)
#pragma unroll
                for (int m = 0; m < 4; ++m) { const int row = row0 + ai * HALF + m * 16; float* fo; bf16_t* bo;
                    if (row < TP) { fo = fP + (size_t)row * 512 + col0; bo = bP + (size_t)row * 512 + col0; }
                    else { const int r2 = row - TP; fo = fS + (size_t)r2 * 512 + col0; bo = bA + ((size_t)(r2 >> 5) * LKS + PASTL + (r2 & 31)) * 512 + col0; }
#pragma unroll
                    for (int bj = 0; bj < 2; ++bj) { const f32x4 v0 = acc[ai][bj][m][0] * rs[ai][m], v1 = acc[ai][bj][m][1] * rs[ai][m];
                        __builtin_nontemporal_store(v0, (f32x4*)(fo + bj * HALF)); __builtin_nontemporal_store(v1, (f32x4*)(fo + bj * HALF + 4));
                        u32x4 w; w.x = cvt_pk_bf16(v0[0], v0[1]); w.y = cvt_pk_bf16(v0[2], v0[3]); w.z = cvt_pk_bf16(v1[0], v1[1]); w.w = cvt_pk_bf16(v1[2], v1[3]); *(u32x4*)(bo + bj * HALF) = w; } }
        } else if (wc == 0 && fq < 2) {
#pragma unroll
            for (int n = 0; n < 2; ++n) { const f32x4 bb = *(const f32x4*)(bf + 8 * fq + 4 * n);
#pragma unroll
                for (int ai = 0; ai < 2; ++ai)
#pragma unroll
                    for (int m = 0; m < 4; ++m) { const int row = row0 + ai * HALF + m * 16; const f32x4 z = acc[ai][0][m][n] * rs[ai][m] + bb; f32x4 r;
#pragma unroll
                        for (int j = 0; j < 4; ++j) r[j] = fminf(z[j], 0.f) - log1pf(__expf(-fabsf(z[j])));
                        float* o = row < TP ? lfP + (size_t)row * 16 : lfS + (size_t)(row - TP) * 16; *(f32x4*)(o + 8 * fq + 4 * n) = r; } }
        }
    }
};
}
namespace fox {
enum { ORDER_NATURAL = 0, ORDER_REVERSED = 1, ORDER_PAIRED = 2, ORDER_XCD = 4 };
constexpr int D = 128, QS = 2048, KS = 512, OS = 2048;
constexpr float THR = 8.f;
constexpr bool WSKIP = false;
constexpr float SCALE = 0.08838834764831845f;
constexpr int NW = 8, QBLK = 32, KVBLK = 64, QB = NW * QBLK;
constexpr int SHM_V = KVBLK * D * 2, SHM_K = KVBLK * D * 2;
constexpr int LDS_BYTES = 2 * SHM_V + 2 * SHM_K + NW * 64 * 4 + 2 * 64 * 4;
typedef unsigned short bf16;
typedef short bf16x8 __attribute__((ext_vector_type(8)));
typedef short s16x4 __attribute__((ext_vector_type(4)));
typedef float f32x16 __attribute__((ext_vector_type(16)));
typedef float f32x4 __attribute__((ext_vector_type(4)));
typedef unsigned u32x4 __attribute__((ext_vector_type(4)));
template <class A, class Bt> struct same_t { static constexpr bool v = false; };
template <class A> struct same_t<A, A> { static constexpr bool v = true; };

#define KSWZ(row, colB) ((row) * 256 + ((colB) ^ (((row) & 7) << 4)))
#define SBAR() __builtin_amdgcn_sched_barrier(0)
__device__ __forceinline__ int v_st(int k, int c) { const int kk = (k & ~0xC) | ((k & 4) << 1) | ((k & 8) >> 1); return ((kk >> 3) * 4 + (c >> 5)) * 512 + ((kk & 7) * 32 + (c & 31)) * 2; }
__device__ __forceinline__ int v_rd_base(int lane) { return ((lane & 3) << 3) | (((lane >> 2) & 3) << 6) | (((lane >> 4) & 1) << 5) | (((lane >> 5) & 1) << 8); }
constexpr int v_rd_off(int d0, int ks, int half) { return d0 * 512 + ks * 4096 + half * 2048; }
__device__ __forceinline__ int crow(int r, int hi) { return (r & 3) + 8 * (r >> 2) + 4 * hi; }
__device__ __forceinline__ unsigned cvtpk(float lo, float hi) {
    unsigned r; asm volatile("v_cvt_pk_bf16_f32 %0, %1, %2" : "=v"(r) : "v"(lo), "v"(hi)); return r;
}
__device__ __forceinline__ bf16x8 pack8(f32x4 a, f32x4 b) {
    u32x4 w = {cvtpk(a[0], a[1]), cvtpk(a[2], a[3]), cvtpk(b[0], b[1]), cvtpk(b[2], b[3])};
    return *reinterpret_cast<bf16x8*>(&w);
}
template <class T> __device__ __forceinline__ bf16x8 load8(const T* p) {
    if constexpr (same_t<T, float>::v) { return pack8(*(const f32x4*)p, *(const f32x4*)(p + 4)); }
    else { return *reinterpret_cast<const bf16x8*>(p); }
}
__device__ __forceinline__ void mask_tile(f32x16& p0, f32x16& p1, int dq, unsigned W) {
    const float NEG = -__builtin_inff();
#pragma unroll
    for (int r = 0; r < 16; ++r) {
        const int c = (r & 3) + 8 * (r >> 2);
        if ((unsigned)(dq - c) >= W) p0[r] = NEG;
        if ((unsigned)(dq - c - 32) >= W) p1[r] = NEG;
    }
}
__device__ __forceinline__ void partialSM(f32x16& p0, f32x16& p1, float& m_reg, float& mn, float& alpha) {
    float pmax = p0[0]; for (int r = 1; r < 16; ++r) pmax = fmaxf(pmax, p0[r]); for (int r = 0; r < 16; ++r) pmax = fmaxf(pmax, p1[r]);
    { auto rr = __builtin_amdgcn_permlane32_swap(__float_as_uint(pmax), __float_as_uint(pmax), false, false);
      pmax = fmaxf(__uint_as_float(rr[0]), __uint_as_float(rr[1])); }
    constexpr float C2 = 1.4426950408889634f * SCALE;
    if (__builtin_expect(__all((pmax - m_reg) * SCALE <= THR), 1)) { mn = m_reg; alpha = 1.f; }
    else { mn = fmaxf(m_reg, pmax); alpha = __builtin_amdgcn_exp2f((m_reg - mn) * C2); m_reg = mn; }
    const float mnL = -mn * C2;
    for (int r = 0; r < 16; ++r) p0[r] = fmaf(p0[r], C2, mnL); for (int r = 0; r < 16; ++r) p1[r] = fmaf(p1[r], C2, mnL);
    for (int r = 0; r < 16; ++r) p0[r] = __builtin_amdgcn_exp2f(p0[r]);
}
__device__ __forceinline__ void finishSM(f32x16& p0, f32x16& p1, float alpha, float& l_reg, bf16x8& pa0, bf16x8& pa1, bf16x8& pa2, bf16x8& pa3) {
    for (int r = 0; r < 16; ++r) p1[r] = __builtin_amdgcn_exp2f(p1[r]);
    float ps = 0; for (int r = 0; r < 16; ++r) ps += p0[r]; for (int r = 0; r < 16; ++r) ps += p1[r];
    { auto rr = __builtin_amdgcn_permlane32_swap(__float_as_uint(ps), __float_as_uint(ps), false, false);
      ps = __uint_as_float(rr[0]) + __uint_as_float(rr[1]); }
    l_reg = l_reg * alpha + ps;
#define PK4(P, B_, OUT) do { unsigned a0 = cvtpk(P[B_+0], P[B_+1]), a1 = cvtpk(P[B_+2], P[B_+3]);                          \
        unsigned b0 = cvtpk(P[B_+4], P[B_+5]), b1 = cvtpk(P[B_+6], P[B_+7]);                                             \
        auto r0 = __builtin_amdgcn_permlane32_swap(a0, b0, false, false); auto r1 = __builtin_amdgcn_permlane32_swap(a1, b1, false, false); \
        u32x4 w = {r0[0], r1[0], r0[1], r1[1]}; OUT = *reinterpret_cast<bf16x8*>(&w); } while (0)
    PK4(p0, 0, pa0); PK4(p0, 8, pa1); PK4(p1, 0, pa2); PK4(p1, 8, pa3);
#undef PK4
}
template <int KB, bool SK>
__device__ __forceinline__ void qkt(f32x16& p0, f32x16& p1, const char* K_lds, int r32, int hi, const bf16x8* qr, bool act) {
    if (SK && !act) { const float NEG = -__builtin_inff();
#pragma unroll
        for (int r = 0; r < 16; ++r) { p0[r] = NEG; p1[r] = NEG; } return; }
    { const float* bb_ = (const float*)(K_lds + 2 * SHM_K + NW * 64 * 4) + KB * 64 + 4 * hi;
#pragma unroll
      for (int q_ = 0; q_ < 4; ++q_) { const f32x4 b0_ = *(const f32x4*)(bb_ + 8 * q_), b1_ = *(const f32x4*)(bb_ + 32 + 8 * q_);
#pragma unroll
        for (int i_ = 0; i_ < 4; ++i_) { p0[4 * q_ + i_] = b0_[i_]; p1[4 * q_ + i_] = b1_[i_]; } } }
    const char* kb[4];
#pragma unroll
    for (int dd = 0; dd < 4; ++dd) kb[dd] = K_lds + KB * SHM_K + KSWZ(r32, (dd * 16 + hi * 8) * 2);
#pragma unroll
    for (int d0 = 0; d0 < 8; ++d0) { const char* a = kb[d0 & 3] + (d0 >> 2) * 128;
        bf16x8 b0 = *reinterpret_cast<const bf16x8*>(a);
        bf16x8 b1 = *reinterpret_cast<const bf16x8*>(a + 32 * 256);
        p0 = __builtin_amdgcn_mfma_f32_32x32x16_bf16(b0, qr[d0], p0, 0, 0, 0);
        p1 = __builtin_amdgcn_mfma_f32_32x32x16_bf16(b1, qr[d0], p1, 0, 0, 0); }
}
template <int VB, bool SK>
__device__ __forceinline__ void pv_tile(f32x16* o, int vb0, bf16x8 pa0, bf16x8 pa1, bf16x8 pa2, bf16x8 pa3, bool act) {
    if (SK && !act) return;
#define TRRD(dst, off) asm volatile("ds_read_b64_tr_b16 %0, %1 offset:%2" : "=&v"(dst) : "v"(vb0), "i"(off) : "memory")
#define PV_D0(d0) do { s16x4 l0, l1, l2, l3, h0, h1, h2, h3; constexpr int b_ = VB * SHM_V + v_rd_off(d0, 0, 0);     \
        TRRD(l0, b_); TRRD(h0, b_ + 2048); TRRD(l1, b_ + 4096); TRRD(h1, b_ + 6144); TRRD(l2, b_ + 8192); TRRD(h2, b_ + 10240); TRRD(l3, b_ + 12288); TRRD(h3, b_ + 14336); \
        asm volatile("s_waitcnt lgkmcnt(0)" ::: "memory"); SBAR();                 \
        o[d0] = __builtin_amdgcn_mfma_f32_32x32x16_bf16(pa0, (bf16x8){l0[0], l0[1], l0[2], l0[3], h0[0], h0[1], h0[2], h0[3]}, o[d0], 0, 0, 0);   \
        o[d0] = __builtin_amdgcn_mfma_f32_32x32x16_bf16(pa1, (bf16x8){l1[0], l1[1], l1[2], l1[3], h1[0], h1[1], h1[2], h1[3]}, o[d0], 0, 0, 0);   \
        o[d0] = __builtin_amdgcn_mfma_f32_32x32x16_bf16(pa2, (bf16x8){l2[0], l2[1], l2[2], l2[3], h2[0], h2[1], h2[2], h2[3]}, o[d0], 0, 0, 0);   \
        o[d0] = __builtin_amdgcn_mfma_f32_32x32x16_bf16(pa3, (bf16x8){l3[0], l3[1], l3[2], l3[3], h3[0], h3[1], h3[2], h3[3]}, o[d0], 0, 0, 0); } while (0)
    PV_D0(0); PV_D0(1); PV_D0(2); PV_D0(3);
#undef PV_D0
#undef TRRD
}
template <class TIn, class TOut> struct BlockRef { const TIn* Q; const TIn* K; const TIn* V; TOut* O; const float* FB; int P0; };
template <class TIn> struct Seam {
    bf16x8 qr[8];
    bf16x8 st_v0, st_v1, st_k0, st_k1; float st_f; f32x4 sf0, sf1, sf2, sf3;
    f32x4 tq[16];
};
__device__ __forceinline__ int swa_jlo(int P0, int W) { const int lowk = P0 - W + 1; return lowk > 0 ? lowk / KVBLK : 0; }
#define ROW(p, k0, rr) ((p) + (size_t)((k0) + (rr)) * KS + sc)
#define VMW() asm volatile("s_waitcnt vmcnt(0)" ::: "memory")
#define VMWN(n) asm volatile("s_waitcnt vmcnt(%0)" :: "i"(n) : "memory")
#define SLOAD_H(Kp, Vp, Fp, k0) do { S.st_f = (Fp)[(k0) + (tid & 63)]; S.st_v0 = load8<TIn>(ROW(Vp, k0, sr)); S.st_v1 = load8<TIn>(ROW(Vp, k0, 32 + sr));              \
                         S.st_k0 = load8<TIn>(ROW(Kp, k0, sr)); S.st_k1 = load8<TIn>(ROW(Kp, k0, 32 + sr)); } while (0)
#define SWRITE_HK(bf) do { ((float*)(K_lds + 2 * SHM_K + NW * 64 * 4))[(bf) * 64 + (tid & 63)] = S.st_f; *(bf16x8*)(K_lds + (bf) * SHM_K + kws) = S.st_k0; *(bf16x8*)(K_lds + (bf) * SHM_K + kws + 32 * 256) = S.st_k1; } while (0)
#define SWRITE_HV(bf) do { *(bf16x8*)(V_lds + (bf) * SHM_V + vst0) = S.st_v0; *(bf16x8*)(V_lds + (bf) * SHM_V + vst1) = S.st_v1; } while (0)
#define SWRITE_H(bf) do { SWRITE_HV(bf); SWRITE_HK(bf); } while (0)
#define SLOAD_F(p, k0) do { S.sf0 = *(const f32x4*)ROW(p, k0, sr); S.sf1 = *(const f32x4*)(ROW(p, k0, sr) + 4);                \
                            S.sf2 = *(const f32x4*)ROW(p, k0, 32 + sr); S.sf3 = *(const f32x4*)(ROW(p, k0, 32 + sr) + 4); } while (0)
#define SWRITE_KF(bf) do { *(bf16x8*)(K_lds + (bf) * SHM_K + kws) = pack8(S.sf0, S.sf1); *(bf16x8*)(K_lds + (bf) * SHM_K + kws + 32 * 256) = pack8(S.sf2, S.sf3); } while (0)
#define SWRITE_VF(bf) do { *(bf16x8*)(V_lds + (bf) * SHM_V + vst0) = pack8(S.sf0, S.sf1); *(bf16x8*)(V_lds + (bf) * SHM_V + vst1) = pack8(S.sf2, S.sf3); } while (0)
template <class TIn, class TOut>
__device__ __forceinline__ void causal_swa_prime(const BlockRef<TIn, TOut>& cur, int W, char* lds, Seam<TIn>& S) {
    constexpr bool F32 = same_t<TIn, float>::v;
    const int tid = opaque_tid(), wid = __builtin_amdgcn_readfirstlane(tid >> 6), lane = tid & 63, r32 = lane & 31, hi = lane >> 5;
    const int sr = tid >> 4, sc = (tid & 15) * 8, kws = KSWZ(sr, sc * 2); char* K_lds = lds + 2 * SHM_V;
    const int kb0 = swa_jlo(cur.P0, W) * KVBLK;
    for (int d0 = 0; d0 < 8; ++d0) S.qr[d0] = load8<TIn>(cur.Q + (size_t)(wid * QBLK + r32) * QS + d0 * 16 + hi * 8);
    if constexpr (F32) { SLOAD_F((const float*)cur.K, kb0); VMW(); SWRITE_KF(0); SBAR(); SLOAD_F((const float*)cur.V, kb0); }
    else { SLOAD_H(cur.K, cur.V, cur.FB, kb0); VMW(); SWRITE_HK(0); }
    __syncthreads();
}
template <class TIn, class TOut>
__device__ __forceinline__ void causal_swa_block(const BlockRef<TIn, TOut>& cur, const BlockRef<TIn, TOut>& nxt, int skv, int W, char* lds, Seam<TIn>& S) {
    constexpr bool F32 = same_t<TIn, float>::v;
    const int tid = opaque_tid(), wid = __builtin_amdgcn_readfirstlane(tid >> 6), lane = tid & 63, r32 = lane & 31, hi = lane >> 5;
    const int j_lo = swa_jlo(cur.P0, W);
    int j_hi = (cur.P0 + QB - 1) / KVBLK + 1; if (j_hi > skv / KVBLK) j_hi = skv / KVBLK;
    const int NT = j_hi - j_lo;
    const int kbn = swa_jlo(nxt.P0, W) * KVBLK;
    const int qlo = cur.P0 + wid * QBLK, qm = qlo + r32 - 4 * hi;
    char* V_lds = lds; char* K_lds = lds + 2 * SHM_V;
    float* ws = (float*)(lds + 2 * SHM_V + 2 * SHM_K) + wid * 64; float* li_l = ws, * al_l = ws + 32;
    float m_reg = -1e30f, l_reg = 0; f32x16 o[4] = {};
    const int sr = tid >> 4, sc = (tid & 15) * 8, vst0 = v_st(sr, sc), vst1 = v_st(32 + sr, sc), kws = KSWZ(sr, sc * 2);
    const int vb0 = (int)(uintptr_t)V_lds + v_rd_base(lane);
    const TIn* Kh = cur.K; const TIn* Vh = cur.V;
#define RESC(a) do { if (__any((a) < 1.f)) { if (hi == 0) al_l[r32] = (a); asm volatile("s_waitcnt lgkmcnt(0)" ::: "memory");              \
                     for (int d_ = 0; d_ < 4; ++d_) for (int r = 0; r < 16; ++r) o[d_][r] *= al_l[crow(r, hi)]; } } while (0)
#define KBASE(t) ((j_lo + (t)) * KVBLK)
#define ACT(t) (KBASE(t) <= qlo + QBLK - 1 && KBASE(t) + KVBLK - 1 >= qlo - W + 1)
#define MASKT(P0_, P1_, t) do { const int kb_ = KBASE(t); if ((!SK || ACT(t)) && (kb_ + KVBLK - 1 > qlo || kb_ <= qlo + QBLK - 1 - W)) mask_tile(P0_, P1_, qm - kb_, (unsigned)W); } while (0)
    constexpr int NQL = F32 ? 16 : 8;
    constexpr bool SK = WSKIP && !F32;
#define SEAM_K0() do { VMWN(NQL); if constexpr (F32) { SWRITE_KF(0); SBAR(); SLOAD_F((const float*)nxt.V, kbn); } else { SWRITE_HK(0); } SBAR(); } while (0)
    f32x16 pA0, pA1, pB0, pB1; float mnA, mnB, alA, alB; bf16x8 pa0, pa1, pa2, pa3;
    if constexpr (F32) { VMW(); SWRITE_VF(0); SBAR(); } else { SWRITE_HV(0); SBAR(); }
    if (NT > 1) { if constexpr (F32) SLOAD_F((const float*)Kh, KBASE(1)); else SLOAD_H(Kh, Vh, cur.FB, KBASE(1)); }
    SBAR(); qkt<0, SK>(pA0, pA1, K_lds, r32, hi, S.qr, ACT(0));
    if constexpr (F32) { if (NT > 1) { VMW(); SWRITE_KF(1); SBAR(); SLOAD_F((const float*)Vh, KBASE(1)); } }
    MASKT(pA0, pA1, 0); partialSM(pA0, pA1, m_reg, mnA, alA);
    if (NT > 1) { VMW(); if constexpr (F32) { SWRITE_VF(1); SBAR(); if (NT > 2) SLOAD_F((const float*)Kh, KBASE(2)); } else SWRITE_H(1); }
    __syncthreads();
#define HALF_STEP(PX0, PX1, mnX, alX, PY0, PY1, alY, t, KB, VB, SB) do {                                                      \
        SBAR(); qkt<KB, SK>(PX0, PX1, K_lds, r32, hi, S.qr, ACT(t));                                             \
        finishSM(PY0, PY1, alY, l_reg, pa0, pa1, pa2, pa3); SBAR();                                                           \
        if ((t) + 1 < NT) { if constexpr (F32) { VMW(); SWRITE_KF(SB); SBAR(); SLOAD_F((const float*)Vh, KBASE((t) + 1)); }  \
                            else { SLOAD_H(Kh, Vh, cur.FB, KBASE((t) + 1)); } SBAR(); }                                               \
        pv_tile<VB, SK>(o, vb0, pa0, pa1, pa2, pa3, ACT((t) - 1)); MASKT(PX0, PX1, (t)); partialSM(PX0, PX1, m_reg, mnX, alX);                                        \
        __syncthreads();                                                                                                      \
        if ((t) + 1 < NT) { VMW(); if constexpr (F32) { SWRITE_VF(SB); SBAR(); if ((t) + 2 < NT) SLOAD_F((const float*)Kh, KBASE((t) + 2)); } \
                            else { SWRITE_H(SB); } }                                                                          \
        RESC(alX); __syncthreads(); } while (0)
    for (int t = 1; t + 1 < NT; t += 2) {
        HALF_STEP(pB0, pB1, mnB, alB, pA0, pA1, alA, t, 1, 0, 0);
        HALF_STEP(pA0, pA1, mnA, alA, pB0, pB1, alB, t + 1, 0, 1, 1);
    }
    const bool even = (NT & 1) == 0;
    if (even) { SBAR(); qkt<1, SK>(pB0, pB1, K_lds, r32, hi, S.qr, ACT(NT - 1)); SBAR(); }
#define QROW(e) (nxt.Q + (size_t)(wid * QBLK + r32) * D + ((e) >> 1) * 16 + hi * 8 + ((e) & 1) * 4)
    if constexpr (F32) { SLOAD_F((const float*)nxt.K, kbn); SBAR();
#pragma unroll
        for (int e = 0; e < 8; ++e) S.tq[e] = *(const f32x4*)QROW(e); }
    else { SLOAD_H(nxt.K, nxt.V, nxt.FB, kbn); SBAR();
#pragma unroll
        for (int d0 = 0; d0 < 8; ++d0) S.qr[d0] = load8<TIn>(nxt.Q + (size_t)(wid * QBLK + r32) * QS + d0 * 16 + hi * 8); }
    SBAR();
    finishSM(pA0, pA1, alA, l_reg, pa0, pa1, pa2, pa3); SBAR();
    if constexpr (F32) {
#pragma unroll
        for (int e = 8; e < 16; ++e) S.tq[e] = *(const f32x4*)QROW(e); SBAR(); }
#undef QROW
    pv_tile<0, SK>(o, vb0, pa0, pa1, pa2, pa3, ACT(even ? NT - 2 : NT - 1));
    if (even) { MASKT(pB0, pB1, NT - 1); partialSM(pB0, pB1, m_reg, mnB, alB); __syncthreads(); RESC(alB);
        finishSM(pB0, pB1, alB, l_reg, pa0, pa1, pa2, pa3); SBAR(); pv_tile<1, SK>(o, vb0, pa0, pa1, pa2, pa3, ACT(NT - 1)); }
    SBAR(); SEAM_K0();
    if (hi == 0) li_l[r32] = l_reg; asm volatile("s_waitcnt lgkmcnt(0)" ::: "memory");
    float rli[16];
#pragma unroll
    for (int r = 0; r < 16; ++r) rli[r] = __builtin_amdgcn_rcpf(li_l[crow(r, hi)]);
    TOut* Ow = cur.O + (size_t)(wid * QBLK) * OS;
#pragma unroll
    for (int r = 0; r < 16; ++r) { const int orow = crow(r, hi);
#pragma unroll
        for (int d0 = 0; d0 < 4; ++d0) { const float v = o[d0][r] * rli[r];
            if constexpr (same_t<TOut, float>::v) { Ow[(size_t)orow * OS + d0 * 32 + r32] = v; }
            else { const float vn = __shfl_xor(v, 1);
                   if ((r32 & 1) == 0) *(unsigned*)(Ow + (size_t)orow * OS + d0 * 32 + r32) = cvtpk(v, vn); } } }
    if constexpr (F32) {
#pragma unroll
        for (int d0 = 0; d0 < 8; ++d0) S.qr[d0] = pack8(S.tq[2 * d0], S.tq[2 * d0 + 1]); }
    __syncthreads();
#undef RESC
#undef KBASE
#undef ACT
#undef MASKT
#undef SEAM_K0
#undef HALF_STEP
}
#undef ROW
#undef VMW
#undef VMWN
#undef SLOAD_H
#undef SWRITE_HK
#undef SWRITE_HV
#undef SWRITE_H
#undef SLOAD_F
#undef SWRITE_KF
#undef SWRITE_VF

__host__ __device__ inline int swa_nramp(int nqb, int W, int qoff) { const int t = W - 1 - qoff; const int n = t < 0 ? 0 : t / QB + 1; return n > nqb ? nqb : n; }
__host__ __device__ inline int swa_nx(int nqb, int nramp, int order) { return (order & ORDER_PAIRED) ? (nramp + 1) / 2 + (nqb - nramp) : nqb; }
struct SwaItem { int bh, qb0, qb1; };
__device__ __forceinline__ SwaItem swa_decode(int L, int nb, int nh, int nhkv, int nqb, int nx, int nramp, int order) {
    const int G = nh / nhkv; SwaItem it; int x;
    if ((order & ORDER_XCD) && (nb * nhkv) % 8 == 0) { const int xcd = L & 7, k = L >> 3, per = G * nx, gi = k / per, r = k - gi * per;
        it.bh = (gi * 8 + xcd) * G + r / nx; x = r % nx; }
    else { it.bh = L / nx; x = L - it.bh * nx; }
    if (order & ORDER_PAIRED) { const int ns = nqb - nramp;
        if (x < ns) { it.qb0 = it.qb1 = nqb - 1 - x; } else { it.qb0 = x - ns; it.qb1 = nramp - 1 - it.qb0; } }
    else { it.qb0 = it.qb1 = ((order & 3) == ORDER_REVERSED) ? nqb - 1 - x : x; }
    return it;
}
typedef unsigned short bf16;
__device__ __forceinline__ BlockRef<bf16, bf16> mk_ref(const SwaItem& it, int pass, const bf16* Q, const bf16* K, const bf16* V, bf16* O, const float* FB) {
    const int qb = pass ? it.qb1 : it.qb0, b = it.bh >> 4, h = it.bh & 15, kvh = h >> 2;
    BlockRef<bf16, bf16> r;
    r.Q = Q + ((size_t)b * 8192 + (size_t)qb * QB) * QS + h * 128; r.O = O + ((size_t)b * 8192 + (size_t)qb * QB) * OS + h * 128;
    r.K = K + (size_t)b * 8192 * KS + kvh * 128; r.V = V + (size_t)b * 8192 * KS + kvh * 128; r.FB = FB + (size_t)it.bh * 8192; r.P0 = qb * QB;
    return r;
}
__device__ __forceinline__ void attn_phase(char* lds, const bf16* Q, const bf16* K, const bf16* V, bf16* O, const float* FB) {
    constexpr int nb = 4, nh = 16, nhkv = 4, nqb = 32, W = 8192, order = ORDER_PAIRED | ORDER_XCD;
    const int nramp = swa_nramp(nqb, W, 0), nx = swa_nx(nqb, nramp, order), total = nx * nb * nh, stride = gridDim.x;
    int L = blockIdx.x; if (L >= total) return;
    SwaItem it = swa_decode(L, nb, nh, nhkv, nqb, nx, nramp, order); int pass = 0;
    BlockRef<bf16, bf16> cur = mk_ref(it, 0, Q, K, V, O, FB);
    Seam<bf16> S;
    causal_swa_prime<bf16, bf16>(cur, W, lds, S);
    for (;;) {
        const bool more_pass = pass == 0 && it.qb1 != it.qb0, more_item = L + stride < total, last = !more_pass && !more_item;
        SwaItem itn = it; int passn = pass + 1, Ln = L;
        if (!more_pass) { passn = 0; Ln = more_item ? L + stride : L; itn = swa_decode(Ln, nb, nh, nhkv, nqb, nx, nramp, order); }
        const BlockRef<bf16, bf16> nxt = last ? cur : mk_ref(itn, passn, Q, K, V, O, FB);
        causal_swa_block<bf16, bf16>(cur, nxt, 8192, W, lds, S);
        if (last) break;
        cur = nxt; it = itn; pass = passn; L = Ln;
    }
}
}
constexpr size_t WS_WIN = 0, WS_WRO = 50331648, WS_WGU0 = 67108864, WS_WGU1 = 113246208, WS_WDN0 = 159383552, WS_WDN1 = 182452224,
                 WS_WO = 205520896, WS_WKVF = 213909504  , WS_COS = 227540992, WS_SIN = 231735296, WS_FB = 235929600, WS_FS = WS_FB + 2097152,
                 WS_BIG = 239075328;
constexpr size_t SZ_ROWS2K = (size_t)TALL * DM * 2;
constexpr size_t BIG_XN = 0, BIG_ACT = SZ_ROWS2K, BIG_HKV = BIG_ACT + (size_t)TALL * DFF * 2, BIG_KB = BIG_HKV + SZ_ROWS2K, BIG_VB = BIG_KB + (size_t)TP * 512 * 2,
                 BIG_KALL = BIG_VB + (size_t)TP * 512 * 2, BIG_VALL = BIG_KALL + (size_t)8 * LKS * 512 * 2, BIG_END = BIG_VALL + (size_t)8 * LKS * 512 * 2;
static_assert(BIG_END <= (size_t)TALL * NPROJ * 2, "layer-1 buffers fit in the PROJ region");
constexpr size_t WS_SSQ = WS_BIG + (size_t)TALL * NPROJ * 2  , WS_BAR = WS_SSQ + (size_t)4 * TALL * 4  , WS_END = WS_BAR + 16384;
static_assert(WS_FS + 540672 <= WS_BIG && WS_BAR % 256 == 0, "small arrays end before the big region");
static_assert(WS_END <= (size_t)1073741824, "workspace fits 1 GiB");
constexpr size_t OUT_Y = 0, OUT_SP = 67633152, OUT_KP = 71827456, OUT_VP = 88604672, OUT_LFP = 105381888, OUT_SS = 105906176, OUT_KS = 114294784, OUT_VS = 114425856, OUT_LFS = 114556928;
constexpr int NWAVES = 8, LDS_BYTES = 149504;

struct Params { const float* in[21]; float* out; unsigned char* ws; };

__device__ __forceinline__ float wave_sum(float v) {
#pragma unroll
    for (int o = 1; o < 64; o <<= 1) v += __shfl_xor(v, o);
    return v;
}
__device__ __forceinline__ float bf2f(unsigned short b) { return __uint_as_float(((unsigned)b) << 16); }
__device__ __forceinline__ unsigned pk2(float lo, float hi) { return pg8::cvt_pk_bf16(lo, hi); }

__device__ __forceinline__ void transpose_item(const float* W, int K, int N, bf16_t* WT, int k0, int n0, int drow0, LAS float* scr, int lane, const float* gain = nullptr) {
    float wv[32];
#pragma unroll
    for (int i = 0; i < 32; ++i) { const int kk = 2 * i + (lane >> 5); wv[i] = __builtin_nontemporal_load(W + (size_t)(k0 + kk) * N + n0 + (lane & 31)) * (gain ? gain[k0 + kk] : 1.f); }
#pragma unroll
    for (int i = 0; i < 32; ++i) { const int kk = 2 * i + (lane >> 5); scr[kk * 33 + (lane & 31)] = wv[i]; }
    asm volatile("s_waitcnt lgkmcnt(0)" ::: "memory");
    const int c = lane & 7;
#pragma unroll
    for (int j = 0; j < 4; ++j) { const int n = (lane >> 3) + 8 * j; const LAS float* s = scr + (8 * c) * 33 + n;
        u32x4 o; o.x = pk2(s[0 * 33], s[1 * 33]); o.y = pk2(s[2 * 33], s[3 * 33]); o.z = pk2(s[4 * 33], s[5 * 33]); o.w = pk2(s[6 * 33], s[7 * 33]);
        *(u32x4*)(WT + (size_t)(drow0 + n) * K + k0 + 8 * c) = o; }
    asm volatile("s_waitcnt lgkmcnt(0)" ::: "memory");
}
__device__ __forceinline__ void tr_plain(const float* W, int K, int N, bf16_t* WT, int row_off, LAS float* scr, int item, int lane, const float* gain = nullptr) {
    const int nblk = N / 32, kb = item / nblk, nb = item % nblk; transpose_item(W, K, N, WT, 64 * kb, 32 * nb, row_off + 32 * nb, scr, lane, gain);
}
__device__ __forceinline__ void tr_gu(const float* W, bf16_t* WT, int up, LAS float* scr, int item, int lane, const float* gain) {
    const int nblk = DFF / 32, kb = item / nblk, nb = item % nblk, n0 = 32 * nb; transpose_item(W, DM, DFF, WT, 64 * kb, n0, (n0 >> 7) * 256 + up * 128 + (n0 & 127), scr, lane, gain);
}
template <int MODE  >
__device__ __forceinline__ void rms_row(const float* xrow, const float* g1, bf16_t* o1, const float* g2, bf16_t* o2, float* of, int lane) {
    const f32x4* xr = (const f32x4*)xrow + lane;
    f32x4 v[8]; float s = 0.f;
#pragma unroll
    for (int j = 0; j < 8; ++j) { v[j] = __builtin_nontemporal_load(xr + 64 * j); s += (v[j].x * v[j].x + v[j].y * v[j].y) + (v[j].z * v[j].z + v[j].w * v[j].w); }
    const float rs = 1.0f / sqrtf(wave_sum(s) * (1.f / DM) + 1e-6f);
#pragma unroll
    for (int j = 0; j < 8; ++j) { const f32x4 ga = ((const f32x4*)g1)[64 * j + lane]; const f32x4 y = v[j] * rs;
        if (MODE == 2) { ((f32x4*)of)[64 * j + lane] = y * ga; }
        else { u32x2 w; w.x = pk2(y.x * ga.x, y.y * ga.y); w.y = pk2(y.z * ga.z, y.w * ga.w); ((u32x2*)o1)[64 * j + lane] = w;
            if (MODE == 1) { const f32x4 gb = ((const f32x4*)g2)[64 * j + lane]; u32x2 w2; w2.x = pk2(y.x * gb.x, y.y * gb.y); w2.y = pk2(y.z * gb.z, y.w * gb.w); ((u32x2*)o2)[64 * j + lane] = w2; } } }
}

namespace ret {
constexpr int KOFF = 0, STOFF = 32768, VOFF = 65536, POFF = 74752, VS = 144;
typedef short v4i16_t __attribute__((ext_vector_type(4)));
__device__ __forceinline__ bf16x8 frag_rm(const LAS char* base, int stride, int i0, int k0, int fr, int fq) { return *(const LAS bf16x8*)(base + (i0 + fr) * stride + (k0 + 8 * fq) * 2); }
__device__ __forceinline__ bf16x8 frag_sw(const LAS char* base, int i0, int k0, int fr, int fq) { return *(const LAS bf16x8*)(base + (i0 + fr) * 512 + ((((k0 >> 3) + fq) ^ fr) << 4)); }
__device__ __forceinline__ s16x4 tr4(const LAS char* p) { return __builtin_bit_cast(s16x4, __builtin_amdgcn_ds_read_tr16_b64_v4i16((LAS v4i16_t*)p)); }
__device__ __forceinline__ bf16x8 frag_tr(const LAS char* base, int stride, int k0, int i0, int fr, int fq) {
    const LAS char* p = base + (k0 + 8 * fq + (fr >> 2)) * stride + (i0 + 4 * (fr & 3)) * 2;
    const s16x4 a = tr4(p), b = tr4(p + 4 * stride);
    return (bf16x8){a[0], a[1], a[2], a[3], b[0], b[1], b[2], b[3]};
}
__device__ __forceinline__ bf16x8 frag_tr_sw(const LAS char* base, int k0, int i0, int fr, int fq) {
    const int m = k0 + 8 * fq + (fr >> 2), d = i0 + 4 * (fr & 3);
    const s16x4 a = tr4(base + m * 512 + ((((d >> 3) ^ (m & 15))) << 4) + (d & 7) * 2), b = tr4(base + (m + 4) * 512 + ((((d >> 3) ^ ((m + 4) & 15))) << 4) + (d & 7) * 2);
    return (bf16x8){a[0], a[1], a[2], a[3], b[0], b[1], b[2], b[3]};
}
#define RET_BAR() do { asm volatile("s_waitcnt lgkmcnt(0)" ::: "memory"); __builtin_amdgcn_s_barrier(); asm volatile("" ::: "memory"); } while (0)
#define MFMA16(X, Y, C) __builtin_amdgcn_mfma_f32_16x16x32_bf16(X, Y, C, 0, 0, 0)
__device__ __forceinline__ void ret_item(LAS char* lds, const bf16_t* proj, size_t hr0  , bf16_t* oh  , int nchunks, int c, int h, int es, const float* S0, float* Sout) {
    const int tid = opaque_tid(), wid = __builtin_amdgcn_readfirstlane(tid >> 6), lane = tid & 63, fr = lane & 15, fq = lane >> 4, lt = wid >> 1, half = wid & 1;
    const float lg2 = __log2f(1.0f - exp2f(-5.0f - (float)h)), gam = exp2f(lg2), gc1 = exp2f(lg2 * (float)(c - 1));
    f32x4 accT[8];
    const int eT = 16 * lt + fr;
#pragma unroll
    for (int i = 0; i < 8; ++i) { const int d0 = 16 * (8 * half + i) + 4 * fq;
#pragma unroll
        for (int r = 0; r < 4; ++r) accT[i][r] = S0 ? S0[(size_t)(d0 + r) * 512 + es * 64 + eT] : 0.f;
        u32x2 w; w.x = pk2(accT[i][0], accT[i][1]); w.y = pk2(accT[i][2], accT[i][3]); *(LAS u32x2*)(lds + STOFF + eT * 512 + (((d0 >> 3) ^ fr) << 4) + (d0 & 7) * 2) = w; }
    u32x4 rk[4], rv; bf16x8 yq[8];
    const bf16_t* gq = proj + PJ_Q + (hr0 + eT) * 256 + 8 * fq; const bf16_t* gk = proj + PJ_K + hr0 * 256; const bf16_t* gv = proj + PJ_V + hr0 * 512 + es * 64; bf16_t* pout = oh + hr0 * 512 + es * 64;
    const bool qok = eT < c;
#define RET_LOADQ(n) do { _Pragma("unroll") for (int ks = 0; ks < 8; ++ks) yq[ks] = qok ? *(const bf16x8*)(gq + (size_t)(n) * 64 * 256 + 32 * ks) : (bf16x8){0, 0, 0, 0, 0, 0, 0, 0}; } while (0)
#define RET_LOAD(n) do { _Pragma("unroll") for (int i = 0; i < 4; ++i) { const int p = tid + 512 * i, row = p >> 5, ch = p & 31; \
            if (row < c) rk[i] = *(const u32x4*)(gk + (size_t)((n) * 64 + row) * 256 + ch * 8); else rk[i] = (u32x4){0u, 0u, 0u, 0u}; } \
        { const int row = tid >> 3, ch = tid & 7; if (row < c) rv = *(const u32x4*)(gv + (size_t)((n) * 64 + row) * 512 + ch * 8); else rv = (u32x4){0u, 0u, 0u, 0u}; } } while (0)
    RET_LOAD(0); RET_LOADQ(0);
    for (int n = 0; n < nchunks; ++n) {
#pragma unroll
        for (int i = 0; i < 4; ++i) { const int p = tid + 512 * i, row = p >> 5, ch = p & 31; *(LAS u32x4*)(lds + KOFF + row * 512 + ((ch ^ (row & 15)) << 4)) = rk[i]; }
        *(LAS u32x4*)(lds + VOFF + (tid >> 3) * VS + (tid & 7) * 16) = rv;
        if (n + 1 < nchunks) RET_LOAD(n + 1);
        RET_BAR();
        f32x4 accS[2], accC[2];
#pragma unroll
        for (int j = 0; j < 2; ++j) { accS[j] = (f32x4){0.f, 0.f, 0.f, 0.f}; accC[j] = (f32x4){0.f, 0.f, 0.f, 0.f}; }
#pragma unroll
        for (int kb = 0; kb < 8; kb += 2) {
            bf16x8 xk[2][2], xs[2][2];
#pragma unroll
            for (int ks = 0; ks < 2; ++ks)
#pragma unroll
                for (int j = 0; j < 2; ++j) { xk[ks][j] = frag_sw(lds + KOFF, 16 * (2 * half + j), 32 * (kb + ks), fr, fq); xs[ks][j] = frag_sw(lds + STOFF, 16 * (2 * half + j), 32 * (kb + ks), fr, fq); }
            __builtin_amdgcn_sched_barrier(0);
#pragma unroll
            for (int ks = 0; ks < 2; ++ks)
#pragma unroll
                for (int j = 0; j < 2; ++j) { accS[j] = MFMA16(xk[ks][j], yq[kb + ks], accS[j]); accC[j] = MFMA16(xs[ks][j], yq[kb + ks], accC[j]); }
            __builtin_amdgcn_sched_barrier(0);
        }
        if (n + 1 < nchunks) RET_LOADQ(n + 1);
        const int lrow = eT;
#pragma unroll
        for (int j = 0; j < 2; ++j) { const int m0 = 16 * (2 * half + j) + 4 * fq; f32x4 sv = accS[j];
#pragma unroll
            for (int r = 0; r < 4; ++r) sv[r] = (m0 + r <= lrow) ? sv[r] : 0.f;
            u32x2 w; w.x = pk2(sv[0], sv[1]); w.y = pk2(sv[2], sv[3]); *(LAS u32x2*)(lds + POFF + lrow * VS + m0 * 2) = w; }
        RET_BAR();
        f32x4 accO[2];
#pragma unroll
        for (int j = 0; j < 2; ++j) accO[j] = accC[j] * gam;
#pragma unroll
        for (int ks = 0; ks < 2; ++ks) { const int k0 = 32 * ks;
            const bf16x8 yp = frag_rm(lds + POFF, VS, 16 * lt, k0, fr, fq);
#pragma unroll
            for (int j = 0; j < 2; ++j) { const bf16x8 xv = frag_tr(lds + VOFF, VS, k0, 16 * (2 * half + j), fr, fq); accO[j] = MFMA16(xv, yp, accO[j]); } }
        if (lrow < c) {
#pragma unroll
            for (int j = 0; j < 2; ++j) { u32x2 w; w.x = pk2(accO[j][0], accO[j][1]); w.y = pk2(accO[j][2], accO[j][3]);
                *(u32x2*)(pout + (size_t)(n * 64 + lrow) * 512 + 16 * (2 * half + j) + 4 * fq) = w; } }
#pragma unroll
        for (int i = 0; i < 8; ++i) accT[i] = accT[i] * gam;
#pragma unroll
        for (int ks = 0; ks < 2; ++ks) {
            bf16x8 xk[8]; const bf16x8 yv = frag_tr(lds + VOFF, VS, 32 * ks, 16 * lt, fr, fq);
#pragma unroll
            for (int i = 0; i < 8; ++i) xk[i] = frag_tr_sw(lds + KOFF, 32 * ks, 16 * (8 * half + i), fr, fq);
            __builtin_amdgcn_sched_barrier(0);
#pragma unroll
            for (int i = 0; i < 8; ++i) accT[i] = MFMA16(xk[i], yv, accT[i]);
            __builtin_amdgcn_sched_barrier(0);
        }
#pragma unroll
        for (int i = 0; i < 8; ++i) { accT[i] = accT[i] * gc1; const int d0 = 16 * (8 * half + i) + 4 * fq;
            u32x2 w; w.x = pk2(accT[i][0], accT[i][1]); w.y = pk2(accT[i][2], accT[i][3]); *(LAS u32x2*)(lds + STOFF + eT * 512 + (((d0 >> 3) ^ fr) << 4) + (d0 & 7) * 2) = w; }
        RET_BAR();
    }
#undef RET_LOAD
#undef RET_LOADQ
#pragma unroll
    for (int i = 0; i < 8; ++i) { const int d0 = 16 * (8 * half + i) + 4 * fq;
#pragma unroll
        for (int r = 0; r < 4; ++r) Sout[(size_t)(d0 + r) * 512 + es * 64 + eT] = accT[i][r]; }
}
}
__device__ __forceinline__ void sample_attn(LAS char* lds, const bf16_t* QBp, const bf16_t* KALL, const bf16_t* VALL, const float* FS, bf16_t* AO) {
    const int tid = opaque_tid(), wid = __builtin_amdgcn_readfirstlane(tid >> 6), lane = tid & 63;
    LAS float* qf = (LAS float*)(lds + wid * 5120); LAS float* pf = qf + 128;
    const int gw = blockIdx.x * NWAVES + wid, NGW = gridDim.x * NWAVES;
    for (int item = gw; item < 8 * 16 * 32; item += NGW) {
        const int b = item >> 9, h = (item >> 5) & 15, qi = item & 31, kvh = h >> 2, qpos = PASTL + qi, row = TP + b * 32 + qi;
        const bf16_t* q = QBp + (size_t)row * DM + h * 128;
        qf[lane] = bf2f(q[lane]); qf[lane + 64] = bf2f(q[lane + 64]);
        asm volatile("s_waitcnt lgkmcnt(0)" ::: "memory");
        const float* F = FS + (size_t)(b * 16 + h) * LKS; const float Fq = F[qpos];
        const bf16_t* Kb = KALL + (size_t)b * LKS * 512 + kvh * 128; const bf16_t* Vb = VALL + (size_t)b * LKS * 512 + kvh * 128;
        float mx = -1e30f;
#pragma unroll 1
        for (int t = 0; t < 17; ++t) { const int j = lane + 64 * t; float s = -__builtin_inff();
            if (j <= qpos) { const u32x4* kr = (const u32x4*)(Kb + (size_t)j * 512); float a = 0.f; u32x4 kvv[16];
#pragma unroll
                for (int c8 = 0; c8 < 16; ++c8) kvv[c8] = kr[c8];
#pragma unroll
                for (int c8 = 0; c8 < 16; ++c8) { const u32x4 kv = kvv[c8]; const LAS f32x4* qq = (const LAS f32x4*)(qf + 8 * c8); const f32x4 q0 = qq[0], q1 = qq[1];
                    a += __uint_as_float(kv.x << 16) * q0.x + __uint_as_float(kv.x & 0xffff0000u) * q0.y + __uint_as_float(kv.y << 16) * q0.z + __uint_as_float(kv.y & 0xffff0000u) * q0.w
                       + __uint_as_float(kv.z << 16) * q1.x + __uint_as_float(kv.z & 0xffff0000u) * q1.y + __uint_as_float(kv.w << 16) * q1.z + __uint_as_float(kv.w & 0xffff0000u) * q1.w; }
                s = a * 0.08838834764831845f + (Fq - F[j]); }
            pf[j] = s; mx = fmaxf(mx, s); }
#pragma unroll
        for (int o = 1; o < 64; o <<= 1) mx = fmaxf(mx, __shfl_xor(mx, o));
        float sum = 0.f;
#pragma unroll 1
        for (int t = 0; t < 17; ++t) { const float p = __expf(pf[lane + 64 * t] - mx); sum += p; pf[lane + 64 * t] = p; }
        sum = wave_sum(sum);
        asm volatile("s_waitcnt lgkmcnt(0)" ::: "memory");
        float oa[8];
#pragma unroll
        for (int e = 0; e < 8; ++e) oa[e] = 0.f;
        const int kg = lane >> 4, dg = lane & 15;
        for (int j = 0; j < PASTL + 32; j += 32) {
            u32x4 vv[8]; float p[8];
#pragma unroll
            for (int u = 0; u < 8; ++u) { vv[u] = *(const u32x4*)(Vb + (size_t)(j + 4 * u + kg) * 512 + 8 * dg); p[u] = pf[j + 4 * u + kg]; }
#pragma unroll
            for (int u = 0; u < 8; ++u) { const unsigned w4[4] = {vv[u].x, vv[u].y, vv[u].z, vv[u].w};
#pragma unroll
                for (int e = 0; e < 4; ++e) { oa[2 * e] += p[u] * __uint_as_float(w4[e] << 16); oa[2 * e + 1] += p[u] * __uint_as_float(w4[e] & 0xffff0000u); } } }
#pragma unroll
        for (int e = 0; e < 8; ++e) { oa[e] += __shfl_xor(oa[e], 16); oa[e] += __shfl_xor(oa[e], 32); }
        const float inv = 1.0f / sum;
        if (kg == 0) { u32x4 w; w.x = pk2(oa[0] * inv, oa[1] * inv); w.y = pk2(oa[2] * inv, oa[3] * inv); w.z = pk2(oa[4] * inv, oa[5] * inv); w.w = pk2(oa[6] * inv, oa[7] * inv);
            *(u32x4*)(AO + (size_t)row * DM + h * 128 + 8 * dg) = w; }
        asm volatile("s_waitcnt lgkmcnt(0)" ::: "memory");
    }
}

#define XB_TMO      128
#define XB_XCNT(j)  (256  + 64 * (j))
#define XB_XSUB(j)  (1280 + 64 * (j))
#define XB_XGEN(j)  (2304 + 64 * (j))
#define XB_TOP      3328
#define XB_TOPGEN   3392
#define XCD_BAR_WORDS 3456
#define XB_SPIN_CAP (1u << 18)

__device__ __forceinline__ unsigned xb_ld(unsigned* p)              { return __hip_atomic_load(p, __ATOMIC_RELAXED, __HIP_MEMORY_SCOPE_AGENT); }
__device__ __forceinline__ unsigned xb_add(unsigned* p, unsigned v) { return __hip_atomic_fetch_add(p, v, __ATOMIC_RELAXED, __HIP_MEMORY_SCOPE_AGENT); }
__device__ __forceinline__ unsigned xb_xcc_id() { return (unsigned)__builtin_amdgcn_s_getreg((3 << 11) | 20) & 0xFu; }
#define XB_SPIN(cond, bar) do { unsigned _sp = 0; while (cond) { __builtin_amdgcn_s_sleep(1); \
    if ((++_sp & 255u) == 0u) { if (xb_ld(&(bar)[XB_TMO])) break; if (_sp > XB_SPIN_CAP) { atomicAdd(&(bar)[XB_TMO], 1u); break; } } } } while (0)

struct XcdBarrier {
    unsigned* bar; unsigned x;
    volatile LAS unsigned* st;
};

__device__ __forceinline__ XcdBarrier xcd_barrier_post(unsigned* bar, volatile LAS unsigned* st) {
    XcdBarrier b; b.bar = bar; b.x = xb_xcc_id(); b.st = st;
    if (threadIdx.x == 0) (void)xb_add(&bar[XB_XCNT(b.x)], 1u);
    return b;
}
__device__ __forceinline__ void xcd_barrier_complete(unsigned* bar, unsigned x, unsigned& nloc, unsigned& nx) {
    const unsigned G = gridDim.x * gridDim.y * gridDim.z;
    unsigned sum, cnt, mine, sp = 0u;
    for (;;) {
        sum = 0u; cnt = 0u; mine = 0u;
#pragma unroll
        for (unsigned j = 0; j < 16; ++j) { const unsigned c = xb_ld(&bar[XB_XCNT(j)]); sum += c; cnt += (c > 0u) ? 1u : 0u; mine = (j == x) ? c : mine; }
        if (sum == G) break;
        __builtin_amdgcn_s_sleep(1);
        if ((++sp & 255u) == 0u) { if (xb_ld(&bar[XB_TMO])) break; if (sp > XB_SPIN_CAP) { atomicAdd(&bar[XB_TMO], 1u); break; } }
    }
    nloc = mine > 0u ? mine : 1u; nx = cnt > 0u ? cnt : 1u;
}

__device__ __forceinline__ void xcd_barrier(const XcdBarrier& b) {
    asm volatile("s_waitcnt vmcnt(0)" ::: "memory");
    __syncthreads();
    if (threadIdx.x == 0) {
        unsigned* bar = b.bar;
        __builtin_amdgcn_s_waitcnt(0);
        unsigned nloc = b.st[0], nx = b.st[1];
        if (nloc == 0u) { xcd_barrier_complete(bar, b.x, nloc, nx); b.st[0] = nloc; b.st[1] = nx; }
        const unsigned old = xb_add(&bar[XB_XSUB(b.x)], 1u);
        const unsigned gen = old / nloc;
        if (old + 1u == (gen + 1u) * nloc) {
            __builtin_amdgcn_fence(__ATOMIC_RELEASE, "agent");
            asm volatile("s_waitcnt vmcnt(0)" ::: "memory");
            const unsigned og = xb_add(&bar[XB_TOP], 1u);
            const unsigned tg = og / nx;
            if (og + 1u == (tg + 1u) * nx) xb_add(&bar[XB_TOPGEN], 1u);
            else XB_SPIN(xb_ld(&bar[XB_TOPGEN]) == tg, bar);
            __builtin_amdgcn_fence(__ATOMIC_ACQUIRE, "agent");
            xb_add(&bar[XB_XGEN(b.x)], 1u);
            asm volatile("s_waitcnt vmcnt(0)" ::: "memory");
        } else {
            XB_SPIN(xb_ld(&bar[XB_XGEN(b.x)]) == gen, bar);
            __builtin_amdgcn_fence(__ATOMIC_ACQUIRE, "agent");
            asm volatile("s_waitcnt vmcnt(0)" ::: "memory");
        }
    }
    __syncthreads();
}

#define KARG(i) ((unsigned char*)(__attribute__((address_space(1))) unsigned char*)(((const volatile __attribute__((address_space(4))) unsigned long long*)__builtin_amdgcn_kernarg_segment_ptr())[i]))
#define INF(i) ((const float*)KARG(i))
#define OUTP ((float*)KARG(21))
#define WSP (KARG(22))
#define BIGP (KARG(22) + WS_BIG)
#define PH_IDS const int tid = opaque_tid(), lane = tid & 63, wave = __builtin_amdgcn_readfirstlane(tid >> 6); const int G = gridDim.x, gw = blockIdx.x * NWAVES + wave, NGW = G * NWAVES; const size_t gt = (size_t)blockIdx.x * 512 + tid, NGT = (size_t)G * 512; (void)lane; (void)gw; (void)NGW; (void)gt; (void)NGT

__device__ __forceinline__ void ph_prologue(LAS unsigned char* lds) {
    PH_IDS; unsigned char* ws = WSP;
    bf16_t* WIN = (bf16_t*)(ws + WS_WIN); bf16_t* WKVF = (bf16_t*)(ws + WS_WKVF);
    LAS float* scr = (LAS float*)(lds + wave * 16384);
    constexpr int I0 = 32 * 384;
    for (int it = gw; it < I0; it += NGW) tr_plain(INF(10), DM, NPROJ, WIN, 0, scr, it, lane);
    { const float* wf = INF(14); const float* nkv = INF(8);
      for (size_t i = gt; i < (size_t)256 * DM; i += NGT) { const int r = (int)(i >> 11), k = (int)(i & 2047); WKVF[(size_t)(1024 + r) * DM + k] = r < 16 ? (bf16_t)(pk2(wf[k * 16 + r] * nkv[k], 0.f) & 0xffffu) : (bf16_t)0; }
      float* ssq = (float*)(ws + WS_SSQ); for (size_t i = gt; i < (size_t)4 * TALL; i += NGT) ssq[i] = 0.f; }
    { float* COS = (float*)(ws + WS_COS); float* SIN = (float*)(ws + WS_SIN);
      for (size_t i = gt; i < (size_t)SEQ * 128; i += NGT) { const int pos = (int)(i >> 7), d = (int)(i & 127);
        const float inv = exp2f(-(float)d * (13.287712379549449f / 128.f));
        const double rev = (double)pos * (double)inv * 0.15915494309189535; const float fr = (float)(rev - __builtin_floor(rev));
        COS[i] = __builtin_amdgcn_cosf(fr); SIN[i] = __builtin_amdgcn_sinf(fr); } }
    { const float* x_p = INF(0); const float* x_s = INF(1); const float* nm = INF(6); bf16_t* XN0 = (bf16_t*)OUTP;
      for (int m = gw; m < TALL; m += NGW) rms_row<0>(m < TP ? x_p + (size_t)m * DM : x_s + (size_t)(m - TP) * DM, nm, XN0 + (size_t)m * DM, nullptr, nullptr, nullptr, lane); }
}
template <int JOB> __device__ __forceinline__ void ph_conv(LAS unsigned char* lds) {
    const int tid = opaque_tid(), lane = tid & 63, wave = __builtin_amdgcn_readfirstlane(tid >> 6);
    const int G = gridDim.x, first = G > 160 ? (JOB == 1 ? 48 : JOB == 3 ? 141 : 44) : 0;
    if ((int)blockIdx.x < first) return;
    const int gw = ((int)blockIdx.x - first) * NWAVES + wave, NGW = (G - first) * NWAVES;
    unsigned char* ws = WSP; LAS float* scr = (LAS float*)(lds + wave * 16384);
    constexpr int IG = 32 * 176, ID = 88 * 64, IQ = 32 * 64, IK = 32 * 16;
    if (JOB == 1) {
        bf16_t* WRO = (bf16_t*)(ws + WS_WRO); bf16_t* WGU0 = (bf16_t*)(ws + WS_WGU0);
        for (int it = gw; it < 64 * 64 + 2 * IG; it += NGW) { int r = it;
            if (r < 64 * 64) { tr_plain(INF(11), 4096, DM, WRO, 0, scr, r, lane); continue; } r -= 64 * 64;
            if (r < IG) { tr_gu(INF(18), WGU0, 0, scr, r, lane, INF(7)); continue; } r -= IG;
            tr_gu(INF(19), WGU0, 1, scr, r, lane, INF(7)); }
    } else if (JOB == 2) {
        bf16_t* WDN0 = (bf16_t*)(ws + WS_WDN0); bf16_t* WGU1 = (bf16_t*)(ws + WS_WGU1); bf16_t* WO = (bf16_t*)(ws + WS_WO); bf16_t* WKVF = (bf16_t*)(ws + WS_WKVF);
        for (int it = gw; it < ID + 2 * IQ + 2 * IK + IG; it += NGW) { int r = it;
            if (r < ID) { tr_plain(INF(20), DFF, DM, WDN0, 0, scr, r, lane); continue; } r -= ID;
            if (r < IQ) { tr_plain(INF(16), DM, DM, WKVF, 1280, scr, r, lane, INF(6) + DM); continue; } r -= IQ;
            if (r < IK) { tr_plain(INF(12), DM, 512, WKVF, 0, scr, r, lane, INF(8)); continue; } r -= IK;
            if (r < IK) { tr_plain(INF(13), DM, 512, WKVF, 512, scr, r, lane, INF(8)); continue; } r -= IK;
            if (r < IQ) { tr_plain(INF(17), DM, DM, WO, 0, scr, r, lane); continue; } r -= IQ;
            tr_gu(INF(18) + (size_t)DM * DFF, WGU1, 0, scr, r, lane, INF(7) + DM); }
    } else if (JOB == 3) {
        bf16_t* WGU1 = (bf16_t*)(ws + WS_WGU1);
        for (int it = gw; it < IG; it += NGW) tr_gu(INF(19) + (size_t)DM * DFF, WGU1, 1, scr, it, lane, INF(7) + DM);
    } else {
        bf16_t* WDN1 = (bf16_t*)(ws + WS_WDN1);
        for (int it = gw; it < ID; it += NGW) tr_plain(INF(20) + (size_t)DFF * DM, DFF, DM, WDN1, 0, scr, it, lane);
    }
}
__device__ __forceinline__ void ph_retin(LAS unsigned char* lds) {
    unsigned char* ws = WSP;
    pg8::Gemm g{(const bf16_t*)OUTP, (const bf16_t*)(ws + WS_WIN), TALL, NPROJ, DM, DM}; pg8::StaticOrder S; S.init(TALL, NPROJ, (int)gridDim.x, (int)blockIdx.x);
    pg8::EpiRetIn E{(bf16_t*)(ws + WS_BIG), (const float*)(ws + WS_COS), (const float*)(ws + WS_SIN)};
    pg8::gemm_phase<pg8::EpiRetIn, pg8::StaticOrder, true, true>(lds, g, S, E);
}
__device__ __forceinline__ void ph_retention(LAS unsigned char* lds) {
    const int G = gridDim.x;
    for (int it = blockIdx.x; it < 256; it += G) { const int bh = (it & 7) * 4 + (it >> 6), es = (it >> 3) & 7, b = bh >> 3, h = bh & 7;
        ret::ret_item((LAS char*)lds, (const bf16_t*)BIGP, (size_t)(b * 8 + h) * SEQ, (bf16_t*)OUTP, 128, 64, h, es, nullptr, OUTP + OUT_SP + (size_t)(b * 8 + h) * 256 * 512); }
    for (int it = blockIdx.x; it < 512; it += G) { const int bh = (it & 7) * 8 + (it >> 6), es = (it >> 3) & 7, b = bh >> 3, h = bh & 7;
        ret::ret_item((LAS char*)lds, (const bf16_t*)BIGP, (size_t)262144 + (size_t)(b * 8 + h) * 32, (bf16_t*)OUTP, 1, 32, h, es, INF(2) + (size_t)(b * 8 + h) * 256 * 512, OUTP + OUT_SS + (size_t)(b * 8 + h) * 256 * 512); }
}
__device__ __forceinline__ void ph_groupnorm() {
    PH_IDS; bf16_t* PROJ = (bf16_t*)BIGP; const bf16_t* OB = (const bf16_t*)OUTP;
    for (int it0 = gw * 4; it0 < TALL * 8; it0 += NGW * 4) {
        u32x4 ovv[4], gvv[4];
#pragma unroll
        for (int q = 0; q < 4; ++q) { const int it = it0 + q, row = it >> 3, h = it & 7;
            ovv[q] = __builtin_nontemporal_load((const u32x4*)(OB + hrow(row, h) * 512 + lane * 8)); gvv[q] = __builtin_nontemporal_load((const u32x4*)(PROJ + PJ_G + (size_t)row * 4096 + h * 512 + lane * 8)); }
#pragma unroll
        for (int q = 0; q < 4; ++q) { const int it = it0 + q, row = it >> 3, h = it & 7; const u32x4 ov = ovv[q], gv = gvv[q];
            bf16_t* op = PROJ + PJ_G + (size_t)row * 4096 + h * 512 + lane * 8;
            float o[8], g[8]; const unsigned ow[4] = {ov.x, ov.y, ov.z, ov.w}, gwd[4] = {gv.x, gv.y, gv.z, gv.w};
#pragma unroll
            for (int j = 0; j < 4; ++j) { o[2 * j] = __uint_as_float(ow[j] << 16); o[2 * j + 1] = __uint_as_float(ow[j] & 0xffff0000u); g[2 * j] = __uint_as_float(gwd[j] << 16); g[2 * j + 1] = __uint_as_float(gwd[j] & 0xffff0000u); }
            float s = 0.f;
#pragma unroll
            for (int j = 0; j < 8; ++j) s += o[j];
            const float mu = wave_sum(s) * (1.f / 512.f); float qq = 0.f;
#pragma unroll
            for (int j = 0; j < 8; ++j) { o[j] -= mu; qq += o[j] * o[j]; }
            const float rstd = 1.0f / sqrtf(wave_sum(qq) * (1.f / 512.f) + 1e-5f);
#pragma unroll
            for (int j = 0; j < 8; ++j) o[j] = o[j] * rstd * pg8::silu_f(g[j]);
            u32x4 w; w.x = pk2(o[0], o[1]); w.y = pk2(o[2], o[3]); w.z = pk2(o[4], o[5]); w.w = pk2(o[6], o[7]); *(u32x4*)op = w; } }
}
template <bool FIRST, int MROWS = TALL> __device__ __forceinline__ void ph_res_gemm(LAS unsigned char* lds, unsigned char* a_ptr, size_t w_off, int K, int lda, const bf16_t* base_h, bf16_t* hb, int ssq_idx) {
    unsigned char* ws = WSP;
    pg8::Gemm g{(const bf16_t*)a_ptr, (const bf16_t*)(ws + w_off), MROWS, DM, K, lda}; pg8::StaticOrder S; S.init(MROWS, DM, (int)gridDim.x, (int)blockIdx.x);
    pg8::EpiRes<!FIRST> E{FIRST ? INF(0) : nullptr, FIRST ? INF(1) : nullptr, base_h, hb, (float*)(ws + WS_SSQ) + (size_t)ssq_idx * TALL};
    pg8::gemm_phase<pg8::EpiRes<!FIRST>, pg8::StaticOrder, true, true>(lds, g, S, E);
}
template <bool FIRST = false> __device__ __forceinline__ void ph_sample_res(const unsigned char* a_ptr, int lda, size_t w_off, int K, const bf16_t* base_h, bf16_t* hb, int ssq_idx) {
    const int tid = opaque_tid(), lane = tid & 63, wave = __builtin_amdgcn_readfirstlane(tid >> 6), fr = lane & 15, fq = lane >> 4;
    unsigned char* ws = WSP;
    const bf16_t* A = (const bf16_t*)a_ptr; const bf16_t* Wt = (const bf16_t*)(ws + w_off);
    float* ssq = (float*)(ws + WS_SSQ) + (size_t)ssq_idx * TALL + TP;
    for (int it = blockIdx.x; it < 256; it += gridDim.x) {
        const int n0 = (it >> 1) * 16, row = (it & 1) * 128 + 16 * wave + fr;
        const bf16_t* bp = Wt + (size_t)(n0 + fr) * K + 8 * fq; const bf16_t* ap = A + (size_t)row * lda + 8 * fq;
        f32x4 acc = {0.f, 0.f, 0.f, 0.f};
        bf16x8 bA[8], aA[8], bB[8], aB[8];
#define SR_LOAD(B_, A_, kk) do { _Pragma("unroll") for (int s_ = 0; s_ < 8; ++s_) { B_[s_] = *(const bf16x8*)(bp + (kk) + 32 * s_); A_[s_] = *(const bf16x8*)(ap + (kk) + 32 * s_); } } while (0)
#define SR_MMA(B_, A_) do { _Pragma("unroll") for (int s_ = 0; s_ < 8; ++s_) acc = __builtin_amdgcn_mfma_f32_16x16x32_bf16(B_[s_], A_[s_], acc, 0, 0, 0); } while (0)
        SR_LOAD(bA, aA, 0);
        for (int k0 = 0; k0 < K; k0 += 512) {
            SR_LOAD(bB, aB, k0 + 256);
            SR_MMA(bA, aA);
            if (k0 + 512 < K) SR_LOAD(bA, aA, k0 + 512);
            SR_MMA(bB, aB);
        }
#undef SR_LOAD
#undef SR_MMA
        f32x4 bvv;
        if (FIRST) bvv = *(const f32x4*)(INF(1) + (size_t)row * DM + n0 + 4 * fq);
        else { const u32x2 t = *(const u32x2*)(base_h + (size_t)(TP + row) * DM + n0 + 4 * fq); bvv = (f32x4){__uint_as_float(t.x << 16), __uint_as_float(t.x & 0xffff0000u), __uint_as_float(t.y << 16), __uint_as_float(t.y & 0xffff0000u)}; }
        const f32x4 v = bvv + acc;
        { u32x2 w; w.x = pk2(v[0], v[1]); w.y = pk2(v[2], v[3]); *(u32x2*)(hb + (size_t)(TP + row) * DM + n0 + 4 * fq) = w; }
        { float ss = (v[0] * v[0] + v[1] * v[1]) + (v[2] * v[2] + v[3] * v[3]); ss += __shfl_xor(ss, 16); ss += __shfl_xor(ss, 32);
            if (fq == 0) (void)__hip_atomic_fetch_add(ssq + row, ss, __ATOMIC_RELAXED, __HIP_MEMORY_SCOPE_AGENT); }
    }
}
template <int MODE> __device__ __forceinline__ void ph_rms(const float* g1, size_t o1_off, const float* g2, size_t o2_off) {
    PH_IDS; float* Hres = OUTP + OUT_Y; unsigned char* ws = WSP;
    for (int m = gw; m < TALL; m += NGW) rms_row<MODE>(Hres + (size_t)m * DM, g1, (bf16_t*)(ws + o1_off) + (size_t)m * DM, g2, (bf16_t*)(ws + o2_off) + (size_t)m * DM, Hres + (size_t)m * DM, lane);
}
__device__ __forceinline__ void ph_cache_cvt() {
    PH_IDS; const float* cache_k = INF(3); const float* cache_v = INF(4); bf16_t* KALL = (bf16_t*)(BIGP + BIG_KALL); bf16_t* VALL = (bf16_t*)(BIGP + BIG_VALL);
    for (size_t i = gt; i < (size_t)8 * PASTL * 512 / 4; i += NGT) { const size_t e = i * 4, b = e / ((size_t)PASTL * 512), r = e % ((size_t)PASTL * 512);
        const f32x4 kv = *(const f32x4*)(cache_k + e), vv = *(const f32x4*)(cache_v + e); u32x2 w; w.x = pk2(kv.x, kv.y); w.y = pk2(kv.z, kv.w); *(u32x2*)(KALL + b * LKS * 512 + r) = w;
        w.x = pk2(vv.x, vv.y); w.y = pk2(vv.z, vv.w); *(u32x2*)(VALL + b * LKS * 512 + r) = w; }
}
__device__ __forceinline__ void ph_kvfq(LAS unsigned char* lds) {
    unsigned char* ws = WSP; unsigned char* big = ws + WS_BIG; float* out = OUTP;
    pg8::Gemm g{(const bf16_t*)(big + BIG_XN), (const bf16_t*)(ws + WS_WKVF), TALL, 3328, DM, DM}; pg8::StaticOrder S; S.init(TALL, 3328, (int)gridDim.x, (int)blockIdx.x);
    pg8::EpiKVFQ E{out + OUT_KP, out + OUT_VP, out + OUT_LFP, out + OUT_KS, out + OUT_VS, out + OUT_LFS, (bf16_t*)(big + BIG_KB), (bf16_t*)(big + BIG_VB), (bf16_t*)(big + BIG_KALL), (bf16_t*)(big + BIG_VALL),
                    (bf16_t*)(big + BIG_ACT), INF(15), (const float*)(ws + WS_SSQ) + (size_t)1 * TALL};
    pg8::gemm_phase<pg8::EpiKVFQ, pg8::StaticOrder, true, true>(lds, g, S, E);
}
__device__ __forceinline__ void ph_cumsum(LAS unsigned char* lds) {
    PH_IDS; const float* cache_lf = INF(5); const float* out = OUTP; float* FB = (float*)(WSP + WS_FB); float* FS = (float*)(WSP + WS_FS);
    for (int it = blockIdx.x; it < 64 + 128; it += G) {
        LAS float* wtot = (LAS float*)lds;
        const bool smp = it >= 64; const int bh = smp ? it - 64 : it, b = bh >> 4, h = bh & 15, Ls = smp ? LKS : SEQ, per = smp ? 3 : 16, j0 = tid * per;
        float v[16]; float s = 0.f;
#pragma unroll
        for (int i = 0; i < 16; ++i) { const int j = j0 + i; float x = 0.f;
            if (i < per && j < Ls) x = smp ? (j < PASTL ? cache_lf[((size_t)b * PASTL + j) * 16 + h] : out[OUT_LFS + ((size_t)b * 32 + (j - PASTL)) * 16 + h]) : out[OUT_LFP + ((size_t)b * SEQ + j) * 16 + h];
            s += x; v[i] = s; }
        float inc = s;
#pragma unroll
        for (int o = 1; o < 64; o <<= 1) { const float t = __shfl_up(inc, o); if (lane >= o) inc += t; }
        if (lane == 63) wtot[wave] = inc;
        __syncthreads();
        float base = inc - s;
        for (int w = 0; w < wave; ++w) base += wtot[w];
#pragma unroll
        for (int i = 0; i < 16; ++i) { const int j = j0 + i; if (i < per && j < Ls) { const float F = base + v[i];
            if (smp) FS[(size_t)bh * LKS + j] = F; else FB[(size_t)bh * SEQ + j] = -F * 11.313708498984761f; } }
        __syncthreads();
    }
}
__device__ __forceinline__ void ph_attn(unsigned char* lds_raw) {
    unsigned char* ws = WSP; unsigned char* big = ws + WS_BIG;
    fox::attn_phase((char*)lds_raw, (const bf16_t*)(big + BIG_ACT), (const bf16_t*)(big + BIG_KB), (const bf16_t*)(big + BIG_VB), (bf16_t*)OUTP  , (const float*)(ws + WS_FB));
}
__device__ __forceinline__ void ph_sattn(LAS unsigned char* lds) {
    unsigned char* ws = WSP; unsigned char* big = ws + WS_BIG;
    sample_attn((LAS char*)lds, (const bf16_t*)(big + BIG_ACT), (const bf16_t*)(big + BIG_KALL), (const bf16_t*)(big + BIG_VALL), (const float*)(ws + WS_FS), (bf16_t*)OUTP);
}
__device__ __forceinline__ void ph_gateup(LAS unsigned char* lds, const unsigned char* a_ptr, size_t w_off, int ssq_idx) {
    unsigned char* ws = WSP; unsigned char* big = ws + WS_BIG;
    pg8::Gemm g{(const bf16_t*)a_ptr, (const bf16_t*)(ws + w_off), TALL, 2 * DFF, DM, DM}; pg8::StaticOrder S; S.init(TALL, 2 * DFF, (int)gridDim.x, (int)blockIdx.x);
    pg8::EpiSwiglu E{(bf16_t*)(big + BIG_ACT), (const float*)(ws + WS_SSQ) + (size_t)ssq_idx * TALL};
    pg8::gemm_phase<pg8::EpiSwiglu, pg8::StaticOrder, true, true>(lds, g, S, E);
}

__device__ __forceinline__ void ph_final() {
    PH_IDS; const bf16_t* H4 = (const bf16_t*)(BIGP + BIG_XN); const float* ssq = (const float*)(WSP + WS_SSQ) + (size_t)3 * TALL; const float* g = INF(9); float* Y = OUTP + OUT_Y;
    for (int m = gw; m < TALL; m += NGW) {
        const u32x4* hr = (const u32x4*)(H4 + (size_t)m * DM); u32x4 hv[4];
#pragma unroll
        for (int j = 0; j < 4; ++j) hv[j] = __builtin_nontemporal_load(hr + 64 * j + lane);
        const float rs = 1.0f / sqrtf(ssq[m] * (1.f / DM) + 1e-6f);
#pragma unroll
        for (int j = 0; j < 4; ++j) { const int c0 = (64 * j + lane) * 8; const f32x4 g0 = *(const f32x4*)(g + c0), g1 = *(const f32x4*)(g + c0 + 4);
            f32x4 y0, y1; y0.x = __uint_as_float(hv[j].x << 16); y0.y = __uint_as_float(hv[j].x & 0xffff0000u); y0.z = __uint_as_float(hv[j].y << 16); y0.w = __uint_as_float(hv[j].y & 0xffff0000u);
            y1.x = __uint_as_float(hv[j].z << 16); y1.y = __uint_as_float(hv[j].z & 0xffff0000u); y1.z = __uint_as_float(hv[j].w << 16); y1.w = __uint_as_float(hv[j].w & 0xffff0000u);
            __builtin_nontemporal_store(y0 * rs * g0, (f32x4*)(Y + (size_t)m * DM + c0)); __builtin_nontemporal_store(y1 * rs * g1, (f32x4*)(Y + (size_t)m * DM + c0 + 4)); } }
}
__global__ void __launch_bounds__(NWAVES * 64, 2) yoco_fwd(Params P) {
    extern __shared__ __attribute__((aligned(16))) unsigned char lds_raw[];
    cg::grid_group grid = cg::this_grid();
    LAS unsigned char* lds = (LAS unsigned char*)lds_raw;
    volatile LAS unsigned* bst = (volatile LAS unsigned*)(lds + 148480);
    if (opaque_tid() < 2) bst[opaque_tid()] = 0u;
    __syncthreads();
    const XcdBarrier xbar = xcd_barrier_post((unsigned*)(WSP + WS_BAR), bst);
#define GSYNC() xcd_barrier(xbar)
    ph_prologue(lds);                                                                                   GSYNC();
    if (WSP == nullptr) grid.sync();
    ph_retin(lds); ph_conv<1>(lds);                                                                                      GSYNC();
    ph_retention(lds);                                                                                  GSYNC();
    ph_groupnorm();                                                                                     GSYNC();
    ph_res_gemm<true, TP>(lds, BIGP + PJ_G * 2, WS_WRO, 4096, 4096, nullptr, (bf16_t*)(OUTP + OUT_KP), 0); ph_sample_res<true>(BIGP + (PJ_G + (size_t)TP * 4096) * 2, 4096, WS_WRO, 4096, nullptr, (bf16_t*)(OUTP + OUT_KP), 0);   GSYNC();
    ph_gateup(lds, (const unsigned char*)(OUTP + OUT_KP), WS_WGU0, 0); ph_conv<2>(lds);                                  GSYNC();
    ph_res_gemm<false, TP>(lds, BIGP + BIG_ACT, WS_WDN0, DFF, DFF, (const bf16_t*)(OUTP + OUT_KP), (bf16_t*)(BIGP + BIG_XN), 1); ph_sample_res(BIGP + BIG_ACT + (size_t)TP * DFF * 2, DFF, WS_WDN0, DFF, (const bf16_t*)(OUTP + OUT_KP), (bf16_t*)(BIGP + BIG_XN), 1); ph_cache_cvt();   GSYNC();
    ph_kvfq(lds); ph_conv<3>(lds);                                                                                       GSYNC();
    ph_cumsum(lds);                                                                                     GSYNC();
    ph_attn(lds_raw); __syncthreads(); ph_sattn(lds);                                                   GSYNC();
    ph_res_gemm<false, TP>(lds, (unsigned char*)OUTP, WS_WO, DM, DM, (const bf16_t*)(BIGP + BIG_XN), (bf16_t*)(BIGP + BIG_HKV), 2); ph_sample_res((const unsigned char*)OUTP + (size_t)TP * DM * 2, DM, WS_WO, DM, (const bf16_t*)(BIGP + BIG_XN), (bf16_t*)(BIGP + BIG_HKV), 2);   GSYNC();
    ph_gateup(lds, BIGP + BIG_HKV, WS_WGU1, 2); ph_conv<4>(lds);                                                         GSYNC();
    ph_res_gemm<false, TP>(lds, BIGP + BIG_ACT, WS_WDN1, DFF, DFF, (const bf16_t*)(BIGP + BIG_HKV), (bf16_t*)(BIGP + BIG_XN), 3); ph_sample_res(BIGP + BIG_ACT + (size_t)TP * DFF * 2, DFF, WS_WDN1, DFF, (const bf16_t*)(BIGP + BIG_HKV), (bf16_t*)(BIGP + BIG_XN), 3);   GSYNC();
    ph_final();
}

extern "C" void kernel_launch(void* const* d_in, const int* in_sizes, int n_in, void* d_out, int out_size, void* d_ws, size_t ws_size, hipStream_t stream) {
    static int grid = 0;
    if (grid == 0) {
        if (n_in != 21 || ws_size < WS_END) { fprintf(stderr, "kernel_launch: unexpected n_in %d / ws_size %zu (need %zu)\n", n_in, ws_size, (size_t)WS_END); grid = -1; return; }
        int dev = 0, cus = 0, per_cu = 0;
        (void)hipGetDevice(&dev); (void)hipDeviceGetAttribute(&cus, hipDeviceAttributeMultiprocessorCount, dev);
        if (hipFuncSetAttribute((const void*)yoco_fwd, hipFuncAttributeMaxDynamicSharedMemorySize, LDS_BYTES) != hipSuccess) { fprintf(stderr, "kernel_launch: hipFuncSetAttribute failed\n"); grid = -1; return; }
        if (hipOccupancyMaxActiveBlocksPerMultiprocessor(&per_cu, (const void*)yoco_fwd, NWAVES * 64, LDS_BYTES) != hipSuccess || per_cu < 1) { fprintf(stderr, "kernel_launch: occupancy query says %d\n", per_cu); per_cu = 1; }
        (void)hipGetLastError();
        grid = cus > 0 ? cus : 256;
    }
    if (grid < 0) return;
    if (hipMemsetAsync((char*)d_ws + WS_BAR, 0, XCD_BAR_WORDS * 4, stream) != hipSuccess) { fprintf(stderr, "kernel_launch: memset of the barrier words failed\n"); return; }
    Params p{};
    for (int i = 0; i < 21; ++i) p.in[i] = (const float*)d_in[i];
    p.out = (float*)d_out; p.ws = (unsigned char*)d_ws;
    void* args[] = {&p};
    hipError_t e = hipLaunchCooperativeKernel((const void*)yoco_fwd, dim3(grid), dim3(NWAVES * 64), args, LDS_BYTES, stream);
    if (e != hipSuccess) fprintf(stderr, "cooperative launch failed: %s (grid %d)\n", hipGetErrorString(e), grid);
}
```
